# Optimizing an MI355X kernel written in HIP

```python
import jax, jax.numpy as jnp
from jax import lax
import numpy as np

D_MODEL = 1024
BATCH = 2
SEQ = 8192
DEPTH = 1

HG_HEADS = 8
HG_DK = 128
HG_DV = 128
HG_CHUNK = 64
RET_HEADS = 4
RET_DK = 256
RET_DV = 512
RET_CHUNK = 128
ROPE_BASE = 10000.0
PEER_HEADS = 8
PEER_NKEYS = 128
PEER_N_EXPERTS = PEER_NKEYS * PEER_NKEYS
PEER_QDIM = 256
PEER_HALF = PEER_QDIM // 2
PEER_TOPK = 16
PEER_BLOCK = 128
NORM_EPS = 1e-6

IN_SIZES = (HG_HEADS * HG_DK, HG_HEADS * HG_DK, HG_HEADS * HG_DV, HG_HEADS * HG_DV,
            RET_HEADS * RET_DK, RET_HEADS * RET_DK, RET_HEADS * RET_DV, RET_HEADS * RET_DV,
            D_MODEL, D_MODEL)
IN_WIDTH = (2 * HG_HEADS * HG_DK + 2 * HG_HEADS * HG_DV + 2 * RET_HEADS * RET_DK
            + 2 * RET_HEADS * RET_DV + 2 * D_MODEL)

kernel_name = "hybrid_hgrn2_retnet_peer"


def rmsnorm(x, w):
    xf = x.astype(jnp.float32)
    y = xf * lax.rsqrt(jnp.mean(xf * xf, axis=-1, keepdims=True) + NORM_EPS)
    return (y * w.astype(jnp.float32)).astype(x.dtype)


def head_rms(x):
    return x * lax.rsqrt(jnp.mean(x * x, axis=-1, keepdims=True) + NORM_EPS)


def split_cols(t, sizes):
    outs, start = [], 0
    for n in sizes:
        outs.append(t[..., start:start + n])
        start += n
    return outs


def to_chunks(t, chunk):
    B, S, H, d = t.shape
    return t.reshape(B, S // chunk, chunk, H, d).transpose(1, 0, 3, 2, 4)


def from_chunks(t):
    nc, B, H, C, d = t.shape
    return t.transpose(1, 0, 3, 2, 4).reshape(B, nc * C, H, d)


def hgrn2_mix(q, f_logit, i, lb):
    B, S, _ = q.shape
    f = lb + (1.0 - lb) * jax.nn.sigmoid(f_logit)
    k = 1.0 - f
    logf = jnp.log(f)
    qc = to_chunks((q * HG_DK ** -0.5).reshape(B, S, HG_HEADS, HG_DK), HG_CHUNK)
    kc = to_chunks(k.reshape(B, S, HG_HEADS, HG_DK), HG_CHUNK)
    gc = to_chunks(logf.reshape(B, S, HG_HEADS, HG_DK), HG_CHUNK)
    vc = to_chunks(i.reshape(B, S, HG_HEADS, HG_DV), HG_CHUNK)
    causal = jnp.tril(jnp.ones((HG_CHUNK, HG_CHUNK), dtype=bool))

    def step(state, inp):
        qb, kb, gb, vb = inp
        b = jnp.cumsum(gb, axis=2)
        diff = b[:, :, :, None, :] - b[:, :, None, :, :]
        decay = jnp.exp(jnp.where(causal[:, :, None], diff, -jnp.inf))
        a = jnp.einsum('bhtd,bhsd,bhtsd->bhts', qb, kb, decay)
        o = (jnp.einsum('bhts,bhsv->bhtv', a, vb)
             + jnp.einsum('bhtd,bhdv->bhtv', qb * jnp.exp(b), state))
        b_last = b[:, :, -1:, :]
        state = (jnp.exp(b_last[:, :, 0, :])[..., None] * state
                 + jnp.einsum('bhsd,bhsv->bhdv', kb * jnp.exp(b_last - b), vb))
        return state, o

    s0 = jnp.zeros((B, HG_HEADS, HG_DK, HG_DV), jnp.float32)
    _, o = lax.scan(step, s0, (qc, kc, gc, vc))
    return from_chunks(o)


def rotary(x, pos):
    half = x.shape[-1] // 2
    inv = ROPE_BASE ** (-jnp.arange(half, dtype=jnp.float32) / half)
    ang = pos[:, None] * inv[None, :]
    cos = jnp.cos(ang)[None, :, None, :]
    sin = jnp.sin(ang)[None, :, None, :]
    x1, x2 = x[..., :half], x[..., half:]
    return jnp.concatenate([x1 * cos - x2 * sin, x1 * sin + x2 * cos], axis=-1)


def retention_mix(q, k, v):
    C = RET_CHUNK
    log_g = jnp.log(1.0 - jnp.exp2(-5.0 - jnp.arange(RET_HEADS, dtype=jnp.float32)))
    idx = jnp.arange(C, dtype=jnp.float32)
    rel = idx[:, None] - idx[None, :]
    dmask = jnp.where(rel >= 0, jnp.exp(log_g[:, None, None] * jnp.maximum(rel, 0.0)), 0.0)
    q_decay = jnp.exp(log_g[:, None] * (idx + 1.0))[None, :, :, None]
    k_decay = jnp.exp(log_g[:, None] * (C - 1.0 - idx))[None, :, :, None]
    chunk_decay = jnp.exp(log_g * C)[None, :, None, None]
    qc, kc, vc = to_chunks(q, C), to_chunks(k, C), to_chunks(v, C)

    def step(state, inp):
        qb, kb, vb = inp
        a = jnp.einsum('bhtd,bhsd->bhts', qb, kb) * dmask[None]
        o = (jnp.einsum('bhts,bhsv->bhtv', a, vb)
             + jnp.einsum('bhtd,bhdv->bhtv', qb * q_decay, state))
        state = chunk_decay * state + jnp.einsum('bhsd,bhsv->bhdv', kb * k_decay, vb)
        return state, o

    B = q.shape[0]
    s0 = jnp.zeros((B, RET_HEADS, RET_DK, RET_DV), jnp.float32)
    _, o = lax.scan(step, s0, (qc, kc, vc))
    return from_chunks(o)


def peer_ffn(h, w_q, sub_keys, expert_u, expert_v):
    B, S, D = h.shape
    T = B * S
    ht = h.reshape(T, D)
    q = (ht @ w_q).astype(jnp.float32).reshape(T, PEER_HEADS, 2, PEER_HALF)
    s = jnp.einsum('thpd,hpkd->thpk', q, sub_keys.astype(jnp.float32))
    top_s, top_i = lax.top_k(s, PEER_TOPK)
    cand = top_s[:, :, 0, :, None] + top_s[:, :, 1, None, :]
    cand_idx = top_i[:, :, 0, :, None] * PEER_NKEYS + top_i[:, :, 1, None, :]
    best_s, best_c = lax.top_k(cand.reshape(T, PEER_HEADS, PEER_TOPK * PEER_TOPK), PEER_TOPK)
    expert_idx = jnp.take_along_axis(
        cand_idx.reshape(T, PEER_HEADS, PEER_TOPK * PEER_TOPK), best_c, axis=-1)
    gates = jax.nn.softmax(best_s, axis=-1)
    nb = T // PEER_BLOCK

    def block_fn(args):
        xb, ib, gb = args
        u = jnp.take(expert_u, ib, axis=0)
        act = jax.nn.gelu(jnp.einsum('td,thkd->thk', xb, u).astype(jnp.float32))
        w = (gb * act).astype(xb.dtype)
        v = jnp.take(expert_v, ib, axis=0)
        return jnp.einsum('thk,thkd->td', w, v)

    out = lax.map(block_fn, (ht.reshape(nb, PEER_BLOCK, D),
                             expert_idx.reshape(nb, PEER_BLOCK, PEER_HEADS, PEER_TOPK),
                             gates.reshape(nb, PEER_BLOCK, PEER_HEADS, PEER_TOPK)))
    return out.reshape(B, S, D)


def setup_inputs(seed: int = 0) -> dict:
    key = jax.random.key(seed)
    ks = jax.random.split(key, 14)
    f32 = jnp.float32

    def nrm(k, shape, scale):
        return jax.random.normal(k, shape, f32) * scale

    return {
        "x": nrm(ks[0], (BATCH, SEQ, D_MODEL), 1.0),
        "norm_mix_w": 1.0 + nrm(ks[1], (DEPTH, D_MODEL), 0.02),
        "w_in": nrm(ks[2], (DEPTH, D_MODEL, IN_WIDTH), D_MODEL ** -0.5),
        "hg_lower_bounds": nrm(ks[3], (DEPTH + 1, HG_HEADS * HG_DK), 0.1),
        "hg_norm_w": 1.0 + nrm(ks[4], (DEPTH, HG_HEADS * HG_DV), 0.02),
        "w_branch_hg": nrm(ks[5], (DEPTH, HG_HEADS * HG_DV, D_MODEL), (HG_HEADS * HG_DV) ** -0.5),
        "w_branch_ret": nrm(ks[6], (DEPTH, RET_HEADS * RET_DV, D_MODEL), (RET_HEADS * RET_DV) ** -0.5),
        "w_out": nrm(ks[7], (DEPTH, D_MODEL, D_MODEL), D_MODEL ** -0.5),
        "norm_ffn_w": 1.0 + nrm(ks[8], (DEPTH, D_MODEL), 0.02),
        "peer_w_q": nrm(ks[9], (DEPTH, D_MODEL, PEER_HEADS * PEER_QDIM), D_MODEL ** -0.5),
        "peer_sub_keys": nrm(ks[10], (DEPTH, PEER_HEADS, 2, PEER_NKEYS, PEER_HALF), PEER_HALF ** -0.5),
        "expert_u": nrm(ks[11], (DEPTH, PEER_N_EXPERTS, D_MODEL), D_MODEL ** -0.5),
        "expert_v": nrm(ks[12], (DEPTH, PEER_N_EXPERTS, D_MODEL), PEER_HEADS ** -0.5),
        "final_norm_w": 1.0 + nrm(ks[13], (D_MODEL,), 0.02),
    }


def reference(x, norm_mix_w, w_in, hg_lower_bounds, hg_norm_w, w_branch_hg, w_branch_ret,
              w_out, norm_ffn_w, peer_w_q, peer_sub_keys, expert_u, expert_v, final_norm_w):
    B, S, _ = x.shape
    f32 = jnp.float32
    lbs = jnp.cumsum(jax.nn.softmax(hg_lower_bounds.astype(f32), axis=0), axis=0)
    pos = jnp.arange(S, dtype=f32)
    for l in range(DEPTH):
        h = rmsnorm(x, norm_mix_w[l])
        proj = h @ w_in[l]
        hq, hf, hi, hg, rq, rk, rv, rg, gate_a, gate_b = split_cols(proj, IN_SIZES)

        o_hg = hgrn2_mix(hq.astype(f32), hf.astype(f32), hi.astype(f32), lbs[l])
        o_hg = (head_rms(o_hg).reshape(B, S, HG_HEADS * HG_DV) * hg_norm_w[l].astype(f32)
                * jax.nn.silu(hg.astype(f32)))

        q = rotary(rq.astype(f32).reshape(B, S, RET_HEADS, RET_DK), pos)
        k = rotary(rk.astype(f32).reshape(B, S, RET_HEADS, RET_DK), pos) * RET_DK ** -0.5
        v = rv.astype(f32).reshape(B, S, RET_HEADS, RET_DV)
        o_ret = retention_mix(q, k, v)
        o_ret = head_rms(o_ret).reshape(B, S, RET_HEADS * RET_DV) * jax.nn.silu(rg.astype(f32))

        y_hg = o_hg.astype(x.dtype) @ w_branch_hg[l]
        y_ret = o_ret.astype(x.dtype) @ w_branch_ret[l]
        merged = jax.nn.sigmoid(gate_a) * y_hg + jax.nn.sigmoid(gate_b) * y_ret
        x = x + merged @ w_out[l]

        h = rmsnorm(x, norm_ffn_w[l])
        x = x + peer_ffn(h, peer_w_q[l], peer_sub_keys[l], expert_u[l], expert_v[l])
    return rmsnorm(x, final_norm_w)
```

```cpp
#include <hip/hip_runtime.h>
#include <hip/hip_cooperative_groups.h>
#include <cstdio>
#include <cstdint>
namespace cg = cooperative_groups;

#define DI __device__ __forceinline__
#define LAS __attribute__((address_space(3)))
typedef unsigned short bf16;
typedef float f32x4 __attribute__((ext_vector_type(4)));
typedef float f32x2 __attribute__((ext_vector_type(2)));
typedef float f32x16 __attribute__((ext_vector_type(16)));
typedef short bf16x8 __attribute__((ext_vector_type(8)));
typedef short s16x4 __attribute__((ext_vector_type(4)));
typedef unsigned u32x4 __attribute__((ext_vector_type(4)));
typedef unsigned u32x2 __attribute__((ext_vector_type(2)));
typedef __bf16 nbf16x2 __attribute__((ext_vector_type(2)));

constexpr int D = 1024, NB = 2, SEQ = 8192, T = NB * SEQ;
constexpr int HG_H = 8, HG_DK = 128, HG_DV = 128, HG_C = 64, HG_NC = SEQ / HG_C;
constexpr int RT_H = 4, RT_DK = 256, RT_DV = 512, RT_L = 512, RT_NS = SEQ / RT_L;
constexpr int PE_H = 8, PE_NK = 128, PE_K = 16, PE_Q = 256, PE_HALF = 128, PE_NE = PE_NK * PE_NK;
constexpr float EPS = 1e-6f;
constexpr int NTHREADS = 512, NWAVES = 8;
constexpr int LDS_BYTES = 147456;

constexpr size_t MiB = 1u << 20;
constexpr size_t WS_CTL = 0;
constexpr size_t WS_DEC = 1 * MiB;
constexpr size_t WS_SSQP = 2 * MiB;
constexpr size_t WS_SSQX = 3 * MiB;
constexpr size_t WS_HN = 4 * MiB;
constexpr size_t WS_WINT = 36 * MiB;
constexpr size_t WS_ROPE = 60 * MiB;
constexpr size_t WS_A = 68 * MiB, WS_B = 100 * MiB, WS_C = 132 * MiB;
constexpr size_t WS_STH = 164 * MiB;
constexpr size_t WS_STR = 196 * MiB;
constexpr size_t WS_OHG = 228 * MiB;
constexpr size_t WS_GA = 68 * MiB, WS_GB = 100 * MiB;
constexpr size_t WS_W2 = 132 * MiB;
constexpr size_t WS_WHG = WS_W2, WS_WRET = WS_W2 + 2 * MiB, WS_WOUT = WS_W2 + 6 * MiB, WS_WQ = WS_W2 + 8 * MiB, WS_SK = WS_W2 + 12 * MiB;
constexpr size_t WS_EV = 145 * MiB;
constexpr size_t WS_MERGED = 177 * MiB;
constexpr size_t WS_EU = 209 * MiB;
constexpr size_t WS_M1 = 4 * MiB;
constexpr size_t WS_X1 = 4 * MiB;
constexpr size_t WS_XW = 68 * MiB;
constexpr size_t WS_TOPS = 100 * MiB, WS_TOPI = 116 * MiB;
constexpr size_t WS_EIDX = 177 * MiB, WS_EGATE = 185 * MiB;
constexpr size_t WS_END = 260 * MiB;

DI int fresh_tid() { int t = threadIdx.x; asm volatile("" : "+v"(t)); return t; }
DI float sigmoidf_(float x) { return 1.f / (1.f + __expf(-x)); }
DI float siluf_(float x) { return x / (1.f + __expf(-x)); }
DI unsigned pk2(float lo, float hi) { f32x2 v = {lo, hi}; nbf16x2 b = __builtin_convertvector(v, nbf16x2); return __builtin_bit_cast(unsigned, b); }
DI bf16 f2bf(float f) { return (bf16)(pk2(f, 0.f) & 0xffffu); }
DI float bf2f(bf16 b) { return __uint_as_float(((unsigned)b) << 16); }
DI float bflo(unsigned u) { return __uint_as_float(u << 16); }
DI float bfhi(unsigned u) { return __uint_as_float(u & 0xffff0000u); }
DI float wave_sum(float v) {
#pragma unroll
    for (int o = 1; o < 64; o <<= 1) v += __shfl_xor(v, o);
    return v;
}
DI int crow(int reg, int h) { return (reg & 3) + 8 * (reg >> 2) + 4 * h; }

namespace pg8 {
#define PG8_LAS __attribute__((address_space(3)))
typedef unsigned short bf16_t;
typedef short bf16x8 __attribute__((ext_vector_type(8)));
typedef float f32x4 __attribute__((ext_vector_type(4)));
typedef unsigned u32x4 __attribute__((ext_vector_type(4)));
constexpr int BM = 256, BK = 64, HALF = 128, HTB = HALF * BK * 2  , STAGE_BYTES = 8 * HTB, NXCD = 8, WGM = 8;

__host__ __device__ __forceinline__ int lds_byte(int r, int c) { const int st = (r >> 4) * 2 + (c >> 5), rr = r & 15, cc = c & 31, ob = rr * 64 + cc * 2; return st * 1024 + (ob ^ (((ob >> 9) & 1) << 5)); }
__host__ __device__ __forceinline__ void stage_rc(int b, int& R, int& C) { const int st = b / 1024, sb = b % 1024, swz = sb ^ (((sb >> 9) & 1) << 5); R = (st >> 1) * 16 + swz / 64; C = (st & 1) * 32 + (swz % 64) / 2; }
__host__ __device__ __forceinline__ int perm32(int rho) { const int n = rho >> 4, i = rho & 15; return 8 * (i >> 2) + 4 * n + (i & 3); }

struct Unit { int pm, pn; };
struct Gemm { const bf16_t* A; const bf16_t* Bt; int M, N, K; };

struct StaticOrder {
    int nM, nN, nwg, G, c;
    __host__ __device__ void init(int M, int N, int G_, int c_) { nM = M / BM; nN = N / BM; nwg = nM * nN; G = G_; c = c_; }
    __host__ __device__ bool next(int i, Unit& u) const {
        const long L = (long)i * G + c; if (L >= nwg) return false;
        int wgid = (int)L; { const int q = nwg / NXCD, r = nwg % NXCD, xcd = wgid % NXCD, off = wgid / NXCD; wgid = (xcd < r ? xcd * (q + 1) : r * (q + 1) + (xcd - r) * q) + off; }
        const int nig = WGM * nN, gid = wgid / nig, fm = gid * WGM, gsz = (nM - fm) < WGM ? (nM - fm) : WGM;
        u.pm = fm + ((wgid % nig) % gsz); u.pn = (wgid % nig) / gsz; return true;
    }
    __device__ __forceinline__ void a_ready(const Unit&) const {}
    __device__ __forceinline__ void done(const Unit&) const {}
};

__device__ __forceinline__ unsigned cvt_pk_bf16(float lo, float hi) { unsigned r; asm volatile("v_cvt_pk_bf16_f32 %0, %1, %2" : "=v"(r) : "v"(lo), "v"(hi)); return r; }
typedef float f32x2 __attribute__((ext_vector_type(2)));
template <class Epi, class Sched, bool ALIGN_EPI = false, bool SP2 = false>
__device__ __forceinline__ void gemm_phase(PG8_LAS unsigned char* lds, const Gemm g, const Sched& S, const Epi& E) {
    const int tid = fresh_tid(), wid = __builtin_amdgcn_readfirstlane(tid >> 6), lane = tid & 63, wr = wid >> 2, wc = wid & 3, fr = lane & 15, fq = lane >> 4;
    const int K = g.K, nt = K / BK;
    unsigned voffA[2], voffB[2];
#pragma unroll
    for (int i = 0; i < 2; ++i) { int R, C; stage_rc(tid * 16 + i * 8192, R, C); const int Rb = Epi::PERM ? ((R & ~31) + perm32(R & 31)) : R;
        voffA[i] = (unsigned)(R * K + C) * 2u; voffB[i] = (unsigned)(Rb * K + C) * 2u; }
    const size_t kstep = (size_t)(BK * 2);
    const size_t hstep = (size_t)HALF * K * 2;
    const size_t tstep = 2 * hstep;
    const unsigned ldsw = (unsigned)wid * 1024u;
    const int aoff = lds_byte(wr * 64 + fr, fq * 8), boff = lds_byte(wc * 32 + fr, fq * 8);
#define PG8_SA(b, h) (((b) * 2 + (h)) * HTB)
#define PG8_SB(b, h) ((4 + (b) * 2 + (h)) * HTB)
#define PG8_STAGE(bufoff, gbase, voff) do { _Pragma("unroll") for (int _i = 0; _i < 2; ++_i) \
        __builtin_amdgcn_global_load_lds((const unsigned*)((const char*)(gbase) + (voff)[_i]), (PG8_LAS unsigned*)(lds + (bufoff) + ldsw + _i * 8192), 16, 0, 0); } while (0)
#define PG8_LDA(dst, b, h) do { _Pragma("unroll") for (int m = 0; m < 4; ++m) _Pragma("unroll") for (int k = 0; k < 2; ++k) dst[m][k] = *(const PG8_LAS bf16x8*)(lds + PG8_SA(b, h) + aoff + m * 2048 + k * 1024); } while (0)
#define PG8_LDB(dst, b, h) do { _Pragma("unroll") for (int n = 0; n < 2; ++n) _Pragma("unroll") for (int k = 0; k < 2; ++k) dst[n][k] = *(const PG8_LAS bf16x8*)(lds + PG8_SB(b, h) + boff + n * 2048 + k * 1024); } while (0)
#define PG8_MMA(ai, bj, At, Bt) do { __builtin_amdgcn_s_setprio(1); _Pragma("unroll") for (int m = 0; m < 4; ++m) _Pragma("unroll") for (int n = 0; n < 2; ++n) _Pragma("unroll") for (int k = 0; k < 2; ++k) \
        acc[ai][bj][m][n] = __builtin_amdgcn_mfma_f32_16x16x32_bf16(Bt[n][k], At[m][k], acc[ai][bj][m][n], 0, 0, 0); __builtin_amdgcn_s_setprio(0); } while (0)
#define PG8_WAIT_V(n) asm volatile("s_waitcnt vmcnt(" #n ")" ::: "memory")
#define PG8_WAIT_L(n) asm volatile("s_waitcnt lgkmcnt(" #n ")" ::: "memory")
#define PG8_BAR __builtin_amdgcn_s_barrier()
#define PG8_SCHED __builtin_amdgcn_sched_barrier(0)
    Unit cur, nxt; int ui = 0;
    if (!S.next(0, cur)) return;
    f32x4 acc[2][2][4][2];
#pragma unroll
    for (int a = 0; a < 2; ++a)
#pragma unroll
        for (int b = 0; b < 2; ++b)
#pragma unroll
            for (int m = 0; m < 4; ++m)
#pragma unroll
                for (int n = 0; n < 2; ++n) acc[a][b][m][n] = (f32x4){0.f, 0.f, 0.f, 0.f};
    bf16x8 At[4][2], B0[2][2], B1[2][2];
    const char* cA = (const char*)g.A + (size_t)cur.pm * tstep; const char* cB = (const char*)g.Bt + (size_t)cur.pn * tstep;
    S.a_ready(cur);
    if constexpr (SP2) {
        PG8_STAGE(PG8_SB(0, 0), cB, voffB); PG8_STAGE(PG8_SB(0, 1), cB + hstep, voffB); PG8_STAGE(PG8_SA(0, 0), cA, voffA); PG8_STAGE(PG8_SA(0, 1), cA + hstep, voffA);
        if (wr == 1) PG8_BAR;
        PG8_WAIT_V(2); PG8_BAR;
        PG8_STAGE(PG8_SB(1, 0), cB + kstep, voffB); PG8_STAGE(PG8_SA(1, 0), cA + kstep, voffA); PG8_STAGE(PG8_SB(1, 1), cB + hstep + kstep, voffB);
        PG8_WAIT_V(6); PG8_BAR;
    } else {
        PG8_STAGE(PG8_SB(0, 0), cB, voffB); PG8_STAGE(PG8_SA(0, 0), cA, voffA); PG8_STAGE(PG8_SB(0, 1), cB + hstep, voffB); PG8_STAGE(PG8_SA(0, 1), cA + hstep, voffA);
        if (wr == 1) PG8_BAR;
        PG8_WAIT_V(4); PG8_BAR;
        PG8_STAGE(PG8_SB(1, 0), cB + kstep, voffB); PG8_STAGE(PG8_SA(1, 0), cA + kstep, voffA); PG8_STAGE(PG8_SB(1, 1), cB + hstep + kstep, voffB);
        PG8_WAIT_V(6); PG8_BAR;
    }
    for (;;) {
        const bool has_next = S.next(ui + 1, nxt);
        const char* nA = has_next ? (const char*)g.A + (size_t)nxt.pm * tstep : cA; const char* nB = has_next ? (const char*)g.Bt + (size_t)nxt.pn * tstep : cB;
        for (int t = 0; t < nt; t += 2) {
            const bool last = (t == nt - 2);
            const char* a1 = cA + (size_t)(t + 1) * kstep;
            const char* a2 = last ? nA : cA + (size_t)(t + 2) * kstep; const char* b2 = last ? nB : cB + (size_t)(t + 2) * kstep;
            const char* a3 = a2 + kstep; const char* b3 = b2 + kstep;
            if (last && has_next) S.a_ready(nxt);
            if constexpr (SP2) {
            PG8_LDB(B0, 0, 0); PG8_LDB(B1, 0, 1); PG8_SCHED; PG8_LDA(At, 0, 0); PG8_STAGE(PG8_SA(1, 1), a1 + hstep, voffA);
            PG8_WAIT_V(8); PG8_WAIT_L(0); PG8_BAR; PG8_MMA(0, 0, At, B0); PG8_MMA(0, 1, At, B1); PG8_BAR; PG8_SCHED;
            PG8_LDA(At, 0, 1); PG8_STAGE(PG8_SB(0, 0), b2, voffB); PG8_STAGE(PG8_SB(0, 1), b2 + hstep, voffB); PG8_STAGE(PG8_SA(0, 0), a2, voffA);
            PG8_WAIT_V(8); PG8_WAIT_L(0); PG8_BAR; PG8_MMA(1, 0, At, B0); PG8_MMA(1, 1, At, B1); PG8_BAR; PG8_SCHED;
            PG8_LDB(B0, 1, 0); PG8_LDB(B1, 1, 1); PG8_SCHED; PG8_LDA(At, 1, 0); PG8_STAGE(PG8_SA(0, 1), a2 + hstep, voffA);
            PG8_WAIT_V(8); PG8_WAIT_L(0); PG8_BAR; PG8_MMA(0, 0, At, B0); PG8_MMA(0, 1, At, B1); PG8_BAR; PG8_SCHED;
            PG8_LDA(At, 1, 1); PG8_STAGE(PG8_SB(1, 0), b3, voffB); PG8_STAGE(PG8_SB(1, 1), b3 + hstep, voffB); PG8_STAGE(PG8_SA(1, 0), a3, voffA);
            PG8_WAIT_V(8); PG8_WAIT_L(0); PG8_BAR; PG8_MMA(1, 0, At, B0); PG8_MMA(1, 1, At, B1); PG8_BAR; PG8_SCHED;
            } else {
            PG8_LDB(B0, 0, 0); PG8_SCHED; PG8_LDA(At, 0, 0); PG8_STAGE(PG8_SA(1, 1), a1 + hstep, voffA);
            PG8_WAIT_L(8); PG8_BAR; PG8_WAIT_L(0); PG8_MMA(0, 0, At, B0); PG8_BAR; PG8_SCHED;
            PG8_LDB(B1, 0, 1); PG8_STAGE(PG8_SB(0, 0), b2, voffB);
            PG8_BAR; PG8_WAIT_L(0); PG8_MMA(0, 1, At, B1); PG8_BAR;
            PG8_LDA(At, 0, 1); PG8_STAGE(PG8_SA(0, 0), a2, voffA);
            PG8_BAR; PG8_WAIT_L(0); PG8_MMA(1, 0, At, B0); PG8_BAR; PG8_SCHED;
            PG8_STAGE(PG8_SB(0, 1), b2 + hstep, voffB);
            PG8_WAIT_V(6); PG8_BAR; PG8_MMA(1, 1, At, B1); PG8_BAR;
            PG8_LDB(B0, 1, 0); PG8_SCHED; PG8_LDA(At, 1, 0); PG8_STAGE(PG8_SA(0, 1), a2 + hstep, voffA);
            PG8_WAIT_L(8); PG8_BAR; PG8_WAIT_L(0); PG8_MMA(0, 0, At, B0); PG8_BAR; PG8_SCHED;
            PG8_LDB(B1, 1, 1); PG8_STAGE(PG8_SB(1, 0), b3, voffB);
            PG8_BAR; PG8_WAIT_L(0); PG8_MMA(0, 1, At, B1); PG8_BAR;
            PG8_LDA(At, 1, 1); PG8_STAGE(PG8_SA(1, 0), a3, voffA);
            PG8_BAR; PG8_WAIT_L(0); PG8_MMA(1, 0, At, B0); PG8_BAR; PG8_SCHED;
            PG8_STAGE(PG8_SB(1, 1), b3 + hstep, voffB);
            PG8_WAIT_V(6); PG8_BAR; PG8_MMA(1, 1, At, B1); PG8_BAR;
            }
        }
        if constexpr (ALIGN_EPI) { if (wr == 0) PG8_BAR; }
        if constexpr (!Epi::AFTER_DRAIN) { E(acc, cur, wr, wc, fr, fq); S.done(cur); }
        if (!has_next) break;
#pragma unroll
        for (int a = 0; a < 2; ++a)
#pragma unroll
            for (int b = 0; b < 2; ++b)
#pragma unroll
                for (int m = 0; m < 4; ++m)
#pragma unroll
                    for (int n = 0; n < 2; ++n) acc[a][b][m][n] = (f32x4){0.f, 0.f, 0.f, 0.f};
        cur = nxt; cA = nA; cB = nB; ++ui;
        if constexpr (ALIGN_EPI) { if (wr == 1) PG8_BAR; }
    }
    PG8_WAIT_V(0);
    if constexpr (!ALIGN_EPI) { if (wr == 0) PG8_BAR; }
    PG8_BAR;
    if constexpr (Epi::AFTER_DRAIN) { E.fused(acc, cur, wr, wc, fr, fq, lds, wid, lane); S.done(cur); }
#undef PG8_SA
#undef PG8_SB
#undef PG8_STAGE
#undef PG8_LDA
#undef PG8_LDB
#undef PG8_MMA
#undef PG8_WAIT_V
#undef PG8_WAIT_L
#undef PG8_BAR
#undef PG8_SCHED
}
}

using pg8::Unit;
typedef f32x4 Acc[2][2][4][2];

DI u32x4 pack8(const f32x4& a, const f32x4& b) { u32x4 w; w.x = pk2(a[0], a[1]); w.y = pk2(a[2], a[3]); w.z = pk2(b[0], b[1]); w.w = pk2(b[2], b[3]); return w; }

struct EpiH {
    static constexpr bool PERM = true, AFTER_DRAIN = false;
    bf16* Qh; bf16* Kh; bf16* VTh; float* DEC; const float* hlb;
    DI void operator()(Acc& acc, const Unit& u, int wr, int wc, int fr, int fq) const {
        if (u.pn < 8) {
            const int h = u.pn, dbase = wc * 32 + 8 * fq;
#pragma unroll
            for (int ai = 0; ai < 2; ++ai) {
                const int row0 = u.pm * 256 + ai * 128 + wr * 64;
                const int bidx = row0 >> 13, chunk = (row0 & (SEQ - 1)) >> 6;
#pragma unroll
                for (int n = 0; n < 2; ++n) {
                    f32x4 ebl;
#pragma unroll
                    for (int e = 0; e < 4; ++e) {
                        const int c = h * 128 + dbase + 4 * n + e;
                        const float lb = sigmoidf_(hlb[c] - hlb[1024 + c]);
                        float carry = 0.f, eb = 0.f;
#pragma unroll
                        for (int m = 0; m < 4; ++m) {
                            const float sg = sigmoidf_(acc[ai][1][m][n][e]);
                            const float f = lb + (1.f - lb) * sg;
                            const float kk = (1.f - lb) * (1.f - sg);
                            float s = __logf(f);
#pragma unroll
                            for (int dl = 1; dl < 16; dl <<= 1) { const float o = __shfl_up(s, dl, 16); if (fr >= dl) s += o; }
                            const float b = s + carry;
                            carry += __shfl(s, 15, 16);
                            eb = __expf(b);
                            acc[ai][0][m][n][e] = acc[ai][0][m][n][e] * 0.08838834764831845f * eb;
                            acc[ai][1][m][n][e] = kk * __expf(-b);
                        }
                        ebl[e] = eb;
                        __builtin_amdgcn_sched_barrier(0);
                    }
                    if (fr == 15) *(f32x4*)(DEC + ((size_t)((bidx * HG_H + h) * HG_NC + chunk)) * 128 + dbase + 4 * n) = ebl;
#pragma unroll
                    for (int m = 0; m < 4; ++m) {
                        const size_t row = (size_t)(row0 + m * 16 + fr);
                        const f32x4 qv = acc[ai][0][m][n], kv = acc[ai][1][m][n];
                        u32x2 oq, ok; oq.x = pk2(qv[0], qv[1]); oq.y = pk2(qv[2], qv[3]); ok.x = pk2(kv[0], kv[1]); ok.y = pk2(kv[2], kv[3]);
                        *(u32x2*)(Qh + row * 1024 + h * 128 + dbase + 4 * n) = oq;
                        *(u32x2*)(Kh + row * 1024 + h * 128 + dbase + 4 * n) = ok;
                    }
                    __builtin_amdgcn_sched_barrier(0);
                }
            }
        } else {
#pragma unroll
            for (int ai = 0; ai < 2; ++ai)
#pragma unroll
                for (int m = 0; m < 4; ++m) {
                    const int row = u.pm * 256 + ai * 128 + wr * 64 + m * 16 + fr, bidx = row >> 13, pos = row & (SEQ - 1);
                    bf16* ptr = VTh + (((size_t)(bidx * HG_H * 128 + (u.pn - 8) * 256 + wc * 32 + 8 * fq)) << 13) + pos;
#pragma unroll
                    for (int bj = 0; bj < 2; ++bj) {
#pragma unroll
                        for (int n = 0; n < 2; ++n)
#pragma unroll
                            for (int e = 0; e < 4; ++e) { asm volatile("" : "+v"(ptr)); *ptr = f2bf(acc[ai][bj][m][n][e]); ptr += 8192; }
                        ptr += (size_t)120 * 8192;
                    }
                }
        }
    }
};

struct EpiR {
    static constexpr bool PERM = true, AFTER_DRAIN = false;
    bf16* Qr; bf16* Kr; bf16* VTr; const float* COS; const float* SIN;
    DI void operator()(Acc& acc, const Unit& u, int wr, int wc, int fr, int fq) const {
        if (u.pn < 8) {
            const bool isk = u.pn >= 4; const int h = u.pn & 3;
            const float lg = __log2f(1.f - exp2f(-5.f - (float)h));
            bf16* dst = isk ? Kr : Qr;
            const int j0 = wc * 32 + 8 * fq;
#pragma unroll
            for (int ai = 0; ai < 2; ++ai)
#pragma unroll
                for (int m = 0; m < 4; ++m) {
                    const int row = u.pm * 256 + ai * 128 + wr * 64 + m * 16 + fr, pos = row & (SEQ - 1), il = pos & (RT_L - 1);
                    const float sc = isk ? exp2f(-lg * (float)il) * 0.0625f : exp2f(lg * (float)il);
#pragma unroll
                    for (int n = 0; n < 2; ++n) {
                        const f32x4 c = *(const f32x4*)(COS + (size_t)pos * 128 + j0 + 4 * n), s = *(const f32x4*)(SIN + (size_t)pos * 128 + j0 + 4 * n);
                        const f32x4 x1 = acc[ai][0][m][n], x2 = acc[ai][1][m][n];
                        acc[ai][0][m][n] = (x1 * c - x2 * s) * sc; acc[ai][1][m][n] = (x1 * s + x2 * c) * sc;
                    }
                    *(u32x4*)(dst + (size_t)row * 1024 + h * 256 + j0) = pack8(acc[ai][0][m][0], acc[ai][0][m][1]);
                    *(u32x4*)(dst + (size_t)row * 1024 + h * 256 + 128 + j0) = pack8(acc[ai][1][m][0], acc[ai][1][m][1]);
                }
        } else {
#pragma unroll
            for (int ai = 0; ai < 2; ++ai)
#pragma unroll
                for (int m = 0; m < 4; ++m) {
                    const int row = u.pm * 256 + ai * 128 + wr * 64 + m * 16 + fr, bidx = row >> 13, pos = row & (SEQ - 1);
                    bf16* ptr = VTr + (((size_t)(bidx * RT_H * 512 + (u.pn - 8) * 256 + wc * 32 + 8 * fq)) << 13) + pos;
#pragma unroll
                    for (int bj = 0; bj < 2; ++bj) {
#pragma unroll
                        for (int n = 0; n < 2; ++n)
#pragma unroll
                            for (int e = 0; e < 4; ++e) { asm volatile("" : "+v"(ptr)); *ptr = f2bf(acc[ai][bj][m][n][e]); ptr += 8192; }
                        ptr += (size_t)120 * 8192;
                    }
                }
        }
    }
};

struct EpiG {
    static constexpr bool PERM = true, AFTER_DRAIN = false;
    bf16* OHG; bf16* ORET; bf16* GA; bf16* GB; const float* SSQP;
    DI void operator()(Acc& acc, const Unit& u, int wr, int wc, int fr, int fq) const {
        const int cb = wc * 32 + 8 * fq;
#pragma unroll
        for (int ai = 0; ai < 2; ++ai)
#pragma unroll
            for (int m = 0; m < 4; ++m) {
                const size_t row = (size_t)(u.pm * 256 + ai * 128 + wr * 64 + m * 16 + fr);
#pragma unroll
                for (int bj = 0; bj < 2; ++bj) {
                    f32x4 a0 = acc[ai][bj][m][0], a1 = acc[ai][bj][m][1];
                    if (u.pn < 12) {
                        bf16* p; float rs = 1.f;
                        if (u.pn < 4) p = OHG + row * 1024 + u.pn * 256 + bj * 128 + cb;
                        else { const int c = (u.pn - 4) * 256 + bj * 128 + cb, h = c >> 9; p = ORET + row * 2048 + c;
                               rs = rsqrtf((SSQP[row * 8 + h * 2] + SSQP[row * 8 + h * 2 + 1]) * (1.f / 512.f) + EPS); }
                        const u32x4 o = *(const u32x4*)p;
#pragma unroll
                        for (int e = 0; e < 4; ++e) { a0[e] = siluf_(a0[e]) * rs; a1[e] = siluf_(a1[e]) * rs; }
                        a0[0] *= bflo(o.x); a0[1] *= bfhi(o.x); a0[2] *= bflo(o.y); a0[3] *= bfhi(o.y);
                        a1[0] *= bflo(o.z); a1[1] *= bfhi(o.z); a1[2] *= bflo(o.w); a1[3] *= bfhi(o.w);
                        *(u32x4*)p = pack8(a0, a1);
                    } else {
                        bf16* p = (u.pn < 16 ? GA + row * 1024 + (u.pn - 12) * 256 : GB + row * 1024 + (u.pn - 16) * 256) + bj * 128 + cb;
#pragma unroll
                        for (int e = 0; e < 4; ++e) { a0[e] = sigmoidf_(a0[e]); a1[e] = sigmoidf_(a1[e]); }
                        *(u32x4*)p = pack8(a0, a1);
                    }
                }
            }
    }
};

struct EpiM1 {
    static constexpr bool PERM = true, AFTER_DRAIN = false;
    float* M1; const bf16* GA;
    DI void operator()(Acc& acc, const Unit& u, int wr, int wc, int fr, int fq) const {
        const int cb = u.pn * 256 + wc * 32 + 8 * fq;
#pragma unroll
        for (int ai = 0; ai < 2; ++ai)
#pragma unroll
            for (int m = 0; m < 4; ++m) {
                const size_t row = (size_t)(u.pm * 256 + ai * 128 + wr * 64 + m * 16 + fr);
#pragma unroll
                for (int bj = 0; bj < 2; ++bj) {
                    const u32x4 g = *(const u32x4*)(GA + row * 1024 + cb + bj * 128);
                    f32x4 a0 = acc[ai][bj][m][0], a1 = acc[ai][bj][m][1];
                    a0[0] *= bflo(g.x); a0[1] *= bfhi(g.x); a0[2] *= bflo(g.y); a0[3] *= bfhi(g.y);
                    a1[0] *= bflo(g.z); a1[1] *= bfhi(g.z); a1[2] *= bflo(g.w); a1[3] *= bfhi(g.w);
                    float* p = M1 + row * 1024 + cb + bj * 128;
                    *(f32x4*)p = a0; *(f32x4*)(p + 4) = a1;
                }
            }
    }
};
struct EpiMerge {
    static constexpr bool PERM = true, AFTER_DRAIN = false;
    const float* M1; const bf16* GB; bf16* MERGED;
    DI void operator()(Acc& acc, const Unit& u, int wr, int wc, int fr, int fq) const {
        const int cb = u.pn * 256 + wc * 32 + 8 * fq;
#pragma unroll
        for (int ai = 0; ai < 2; ++ai)
#pragma unroll
            for (int m = 0; m < 4; ++m) {
                const size_t row = (size_t)(u.pm * 256 + ai * 128 + wr * 64 + m * 16 + fr);
#pragma unroll
                for (int bj = 0; bj < 2; ++bj) {
                    const u32x4 g = *(const u32x4*)(GB + row * 1024 + cb + bj * 128);
                    const float* p = M1 + row * 1024 + cb + bj * 128;
                    f32x4 a0 = acc[ai][bj][m][0], a1 = acc[ai][bj][m][1];
                    const f32x4 m0 = *(const f32x4*)p, m1 = *(const f32x4*)(p + 4);
                    a0[0] = a0[0] * bflo(g.x) + m0[0]; a0[1] = a0[1] * bfhi(g.x) + m0[1]; a0[2] = a0[2] * bflo(g.y) + m0[2]; a0[3] = a0[3] * bfhi(g.y) + m0[3];
                    a1[0] = a1[0] * bflo(g.z) + m1[0]; a1[1] = a1[1] * bfhi(g.z) + m1[1]; a1[2] = a1[2] * bflo(g.w) + m1[2]; a1[3] = a1[3] * bfhi(g.w) + m1[3];
                    *(u32x4*)(MERGED + row * 1024 + cb + bj * 128) = pack8(a0, a1);
                }
            }
    }
};
struct EpiOut {
    static constexpr bool PERM = true, AFTER_DRAIN = false;
    const float* X; float* X1; bf16* XW; const float* nw; float* SSQX;
    DI void operator()(Acc& acc, const Unit& u, int wr, int wc, int fr, int fq) const {
        const int cb = u.pn * 256 + wc * 32 + 8 * fq;
#pragma unroll
        for (int ai = 0; ai < 2; ++ai)
#pragma unroll
            for (int m = 0; m < 4; ++m) {
                const size_t row = (size_t)(u.pm * 256 + ai * 128 + wr * 64 + m * 16 + fr);
                float ss = 0.f;
#pragma unroll
                for (int bj = 0; bj < 2; ++bj) {
                    const size_t off = row * 1024 + cb + bj * 128;
                    const f32x4 x0 = *(const f32x4*)(X + off), x1v = *(const f32x4*)(X + off + 4);
                    const f32x4 w0 = *(const f32x4*)(nw + cb + bj * 128), w1 = *(const f32x4*)(nw + cb + bj * 128 + 4);
                    const f32x4 a0 = acc[ai][bj][m][0] + x0, a1 = acc[ai][bj][m][1] + x1v;
                    *(f32x4*)(X1 + off) = a0; *(f32x4*)(X1 + off + 4) = a1;
                    ss += (a0[0] * a0[0] + a0[1] * a0[1]) + (a0[2] * a0[2] + a0[3] * a0[3]) + (a1[0] * a1[0] + a1[1] * a1[1]) + (a1[2] * a1[2] + a1[3] * a1[3]);
                    *(u32x4*)(XW + off) = pack8(a0 * w0, a1 * w1);
                }
                ss += __shfl_xor(ss, 16); ss += __shfl_xor(ss, 32);
                if (fq == 0) SSQX[row * 16 + u.pn * 4 + wc] = ss;
            }
    }
};
DI float rstd_x1(const float* SSQX, size_t row) {
    const f32x4 a = *(const f32x4*)(SSQX + row * 16), b = *(const f32x4*)(SSQX + row * 16 + 4), c = *(const f32x4*)(SSQX + row * 16 + 8), d = *(const f32x4*)(SSQX + row * 16 + 12);
    const float s = ((a[0] + a[1]) + (a[2] + a[3])) + ((b[0] + b[1]) + (b[2] + b[3])) + ((c[0] + c[1]) + (c[2] + c[3])) + ((d[0] + d[1]) + (d[2] + d[3]));
    return rsqrtf(s * (1.f / 1024.f) + EPS);
}
struct EpiQ {
    static constexpr bool PERM = true, AFTER_DRAIN = false;
    bf16* Q; const float* SSQX;
    DI void operator()(Acc& acc, const Unit& u, int wr, int wc, int fr, int fq) const {
        const int cb = u.pn * 256 + wc * 32 + 8 * fq;
#pragma unroll
        for (int ai = 0; ai < 2; ++ai)
#pragma unroll
            for (int m = 0; m < 4; ++m) {
                const size_t row = (size_t)(u.pm * 256 + ai * 128 + wr * 64 + m * 16 + fr);
                const float rs = rstd_x1(SSQX, row);
#pragma unroll
                for (int bj = 0; bj < 2; ++bj) *(u32x4*)(Q + row * 2048 + cb + bj * 128) = pack8(acc[ai][bj][m][0] * rs, acc[ai][bj][m][1] * rs);
            }
    }
};

#define MFMA32(a, b, c) __builtin_amdgcn_mfma_f32_32x32x16_bf16((a), (b), (c), 0, 0, 0)
DI bf16x8 ldg16(const bf16* p) { return *(const bf16x8*)p; }
DI bf16x8 ldg2x8(const bf16* p0, const bf16* p1) { const s16x4 a = *(const s16x4*)p0, b = *(const s16x4*)p1; return __builtin_shufflevector(a, b, 0, 1, 2, 3, 4, 5, 6, 7); }
DI bf16x8 packx(const f32x16& x, int s) {
    u32x4 p; p.x = pk2(x[8 * s + 0], x[8 * s + 1]); p.y = pk2(x[8 * s + 2], x[8 * s + 3]); p.z = pk2(x[8 * s + 4], x[8 * s + 5]); p.w = pk2(x[8 * s + 6], x[8 * s + 7]);
    return __builtin_bit_cast(bf16x8, p);
}
DI f32x16 zero16() { f32x16 z;
#pragma unroll
    for (int i = 0; i < 16; ++i) z[i] = 0.f; return z; }

DI bf16x8 tr_frag(const LAS unsigned char* tile, int RS, int lane, int ks, int c) {
    const int hh = lane >> 5, blk = (lane >> 4) & 1, q = (lane & 15) >> 2, p = lane & 3;
    const LAS unsigned char* a0 = tile + (16 * ks + 8 * hh + q) * RS + (32 * c + 16 * blk + 4 * p) * 2;
    const s16x4 lo = __builtin_amdgcn_ds_read_tr16_b64_v4i16((LAS s16x4*)a0);
    const s16x4 hi = __builtin_amdgcn_ds_read_tr16_b64_v4i16((LAS s16x4*)(a0 + 4 * RS));
    return __builtin_shufflevector(lo, hi, 0, 1, 2, 3, 4, 5, 6, 7);
}

constexpr int HG_KRS = 320;
DI void hg_pass1(LAS unsigned char* lds, const bf16* Kh, const bf16* VTh, bf16* STh, int wg, int nwg) {
    const int tid = fresh_tid(), lane = tid & 63, w = __builtin_amdgcn_readfirstlane(tid >> 6), r = lane & 31, hh = lane >> 5;
    for (int unit = wg; unit < 16 * HG_NC; unit += nwg) {
        const int bh = unit >> 7, c = unit & 127, b = bh >> 3, h = bh & 7;
        __syncthreads();
        {
            const int row = tid >> 3, ch = tid & 7;
            const bf16* src = Kh + ((size_t)(b * SEQ + c * 64 + row)) * 1024 + h * 128;
            const bf16x8 v0 = ldg16(src + ch * 8), v1 = ldg16(src + 64 + ch * 8);
            *(LAS bf16x8*)(lds + row * HG_KRS + ch * 16) = v0; *(LAS bf16x8*)(lds + row * HG_KRS + 128 + ch * 16) = v1;
        }
        __syncthreads();
        const int mt = w & 3, nt0 = w >> 2;
        f32x16 a0 = zero16(), a1 = zero16();
        const bf16* vrow = VTh + (((size_t)(bh * 128 + 32 * mt + r)) << 13) + c * 64;
#pragma unroll
        for (int ks = 0; ks < 4; ++ks) {
            const bf16x8 av = ldg16(vrow + 16 * ks + 8 * hh);
            a0 = MFMA32(av, tr_frag(lds, HG_KRS, lane, ks, nt0), a0);
            a1 = MFMA32(av, tr_frag(lds, HG_KRS, lane, ks, nt0 + 2), a1);
        }
        bf16* dst = STh + ((size_t)(bh * HG_NC + c)) * 16384;
#pragma unroll
        for (int i = 0; i < 16; ++i) {
            const int v = 32 * mt + crow(i, hh);
            dst[v * 128 + 32 * nt0 + r] = f2bf(a0[i]); dst[v * 128 + 32 * (nt0 + 2) + r] = f2bf(a1[i]);
        }
    }
    __syncthreads();
}

DI void hg_scan(bf16* STh, const float* DEC, int gtid, int gsz) {
    for (int idx = gtid; idx < 16 * 128 * 32; idx += gsz) {
        const int dq = idx & 31, v = (idx >> 5) & 127, bh = idx >> 12;
        f32x4 carry = {0.f, 0.f, 0.f, 0.f};
        bf16* p = STh + ((size_t)bh * HG_NC) * 16384 + v * 128 + dq * 4;
        const float* dp = DEC + ((size_t)bh * HG_NC) * 128 + dq * 4;
#pragma unroll 8
        for (int c = 0; c < HG_NC; ++c) {
            const u32x2 wv = *(const u32x2*)(p + (size_t)c * 16384);
            const f32x4 dec = *(const f32x4*)(dp + c * 128);
            u32x2 o; o.x = pk2(carry[0], carry[1]); o.y = pk2(carry[2], carry[3]);
            *(u32x2*)(p + (size_t)c * 16384) = o;
            carry[0] = dec[0] * (carry[0] + bflo(wv.x)); carry[1] = dec[1] * (carry[1] + bfhi(wv.x));
            carry[2] = dec[2] * (carry[2] + bflo(wv.y)); carry[3] = dec[3] * (carry[3] + bfhi(wv.y));
        }
    }
}
DI void rt_scan(bf16* STr, int gtid, int gsz) {
    for (int idx = gtid; idx < 8 * 512 * 32; idx += gsz) {
        const int dq = idx & 31, v = (idx >> 5) & 511, bh = idx >> 14, h = bh & 3;
        const float dec = exp2f((float)RT_L * __log2f(1.f - exp2f(-5.f - (float)h)));
        float carry[8];
#pragma unroll
        for (int e = 0; e < 8; ++e) carry[e] = 0.f;
        bf16* p = STr + ((size_t)bh * RT_NS) * 131072 + v * 256 + dq * 8;
#pragma unroll 4
        for (int c = 0; c < RT_NS; ++c) {
            const u32x4 wv = *(const u32x4*)(p + (size_t)c * 131072);
            u32x4 o; o.x = pk2(carry[0], carry[1]); o.y = pk2(carry[2], carry[3]); o.z = pk2(carry[4], carry[5]); o.w = pk2(carry[6], carry[7]);
            *(u32x4*)(p + (size_t)c * 131072) = o;
            if (c == RT_NS - 1) break;
            carry[0] = dec * (carry[0] + bflo(wv.x)); carry[1] = dec * (carry[1] + bfhi(wv.x));
            carry[2] = dec * (carry[2] + bflo(wv.y)); carry[3] = dec * (carry[3] + bfhi(wv.y));
            carry[4] = dec * (carry[4] + bflo(wv.z)); carry[5] = dec * (carry[5] + bfhi(wv.z));
            carry[6] = dec * (carry[6] + bflo(wv.w)); carry[7] = dec * (carry[7] + bfhi(wv.w));
        }
    }
}

DI void hg_pass3(const bf16* Qh, const bf16* Kh, const bf16* VTh, const bf16* STh, const float* hg_norm_w, bf16* OHG, int gw, int ngw) {
    const int lane = fresh_tid() & 63, r = lane & 31, hh = lane >> 5;
    for (int unit = gw; unit < 16 * HG_NC * 2; unit += ngw) {
        const int tb = unit & 1, c = (unit >> 1) & 127, bh = unit >> 8, b = bh >> 3, h = bh & 7;
        const size_t trow = (size_t)(b * SEQ + c * 64 + tb * 32 + r);
        bf16x8 qf[8];
#pragma unroll
        for (int kk = 0; kk < 8; ++kk) qf[kk] = ldg16(Qh + trow * 1024 + h * 128 + kk * 16 + 8 * hh);
        f32x16 acc[4];
#pragma unroll
        for (int nv = 0; nv < 4; ++nv) acc[nv] = zero16();
        for (int sb = 0; sb <= tb; ++sb) {
            const size_t srow = (size_t)(b * SEQ + c * 64 + sb * 32 + r);
            f32x16 x = zero16();
#pragma unroll
            for (int kk = 0; kk < 8; ++kk) x = MFMA32(ldg16(Kh + srow * 1024 + h * 128 + kk * 16 + 8 * hh), qf[kk], x);
            if (sb == tb) {
#pragma unroll
                for (int i = 0; i < 16; ++i) if (crow(i, hh) > r) x[i] = 0.f;
            }
            const bf16x8 xs0 = packx(x, 0), xs1 = packx(x, 1);
#pragma unroll
            for (int nv = 0; nv < 4; ++nv) {
                const bf16* vb = VTh + (((size_t)(bh * 128 + nv * 32 + r)) << 13) + c * 64 + sb * 32 + 4 * hh;
                acc[nv] = MFMA32(ldg2x8(vb, vb + 8), xs0, acc[nv]);
                acc[nv] = MFMA32(ldg2x8(vb + 16, vb + 24), xs1, acc[nv]);
            }
        }
        const bf16* st = STh + ((size_t)(bh * HG_NC + c)) * 16384;
#pragma unroll
        for (int nv = 0; nv < 4; ++nv)
#pragma unroll
            for (int kk = 0; kk < 8; ++kk) acc[nv] = MFMA32(ldg16(st + (nv * 32 + r) * 128 + kk * 16 + 8 * hh), qf[kk], acc[nv]);
        float ss = 0.f;
#pragma unroll
        for (int nv = 0; nv < 4; ++nv)
#pragma unroll
            for (int i = 0; i < 16; ++i) ss += acc[nv][i] * acc[nv][i];
        ss += __shfl_xor(ss, 32);
        const float rs = rsqrtf(ss * (1.f / 128.f) + EPS);
#pragma unroll
        for (int nv = 0; nv < 4; ++nv)
#pragma unroll
            for (int g = 0; g < 4; ++g) {
                const int v = nv * 32 + 8 * g + 4 * hh;
                const f32x4 wv = *(const f32x4*)(hg_norm_w + h * 128 + v);
                u32x2 o; o.x = pk2(acc[nv][4 * g] * rs * wv[0], acc[nv][4 * g + 1] * rs * wv[1]); o.y = pk2(acc[nv][4 * g + 2] * rs * wv[2], acc[nv][4 * g + 3] * rs * wv[3]);
                *(u32x2*)(OHG + trow * 1024 + h * 128 + v) = o;
            }
    }
}

constexpr int RT_KRS = 576;
constexpr int RT_KBUF = 64 * RT_KRS;
DI void rt_pass1(LAS unsigned char* lds, const bf16* Kr, const bf16* VTr, bf16* STr, int wg, int nwg) {
    const int tid = fresh_tid(), lane = tid & 63, w = __builtin_amdgcn_readfirstlane(tid >> 6), r = lane & 31, hh = lane >> 5;
    const int wm = w & 3, wn = w >> 2;
    const int srow = tid >> 3, sch = tid & 7;
    for (int unit = wg; unit < 8 * (RT_NS - 1) * 2; unit += nwg) {
        const int vh = unit & 1, sg = (unit >> 1) % (RT_NS - 1), bh = (unit >> 1) / (RT_NS - 1), b = bh >> 2, h = bh & 3;
        f32x16 acc[2][4];
#pragma unroll
        for (int i = 0; i < 2; ++i)
#pragma unroll
            for (int j = 0; j < 4; ++j) acc[i][j] = zero16();
        const bf16* kbase = Kr + ((size_t)(b * SEQ + sg * RT_L)) * 1024 + h * 256;
        bf16x8 st[4];
#pragma unroll
        for (int i = 0; i < 4; ++i) st[i] = ldg16(kbase + (size_t)srow * 1024 + (sch + 8 * i) * 8);
        __syncthreads();
#pragma unroll
        for (int i = 0; i < 4; ++i) *(LAS bf16x8*)(lds + srow * RT_KRS + (sch + 8 * i) * 16) = st[i];
        for (int sb = 0; sb < RT_L / 64; ++sb) {
            const LAS unsigned char* cur = lds + (sb & 1) * RT_KBUF;
            if (sb + 1 < RT_L / 64) {
#pragma unroll
                for (int i = 0; i < 4; ++i) st[i] = ldg16(kbase + (size_t)((sb + 1) * 64 + srow) * 1024 + (sch + 8 * i) * 8);
            }
            __syncthreads();
#pragma unroll
            for (int ks = 0; ks < 4; ++ks) {
                bf16x8 av[2];
#pragma unroll
                for (int i = 0; i < 2; ++i) av[i] = ldg16(VTr + (((size_t)(bh * 512 + vh * 256 + wm * 64 + i * 32 + r)) << 13) + sg * RT_L + sb * 64 + 16 * ks + 8 * hh);
#pragma unroll
                for (int j = 0; j < 4; ++j) {
                    const bf16x8 bv = tr_frag(cur, RT_KRS, lane, ks, wn * 4 + j);
                    acc[0][j] = MFMA32(av[0], bv, acc[0][j]); acc[1][j] = MFMA32(av[1], bv, acc[1][j]);
                }
                __builtin_amdgcn_sched_barrier(0);
            }
            if (sb + 1 < RT_L / 64) {
                LAS unsigned char* nxt = lds + ((sb + 1) & 1) * RT_KBUF;
#pragma unroll
                for (int i = 0; i < 4; ++i) *(LAS bf16x8*)(nxt + srow * RT_KRS + (sch + 8 * i) * 16) = st[i];
            }
        }
        bf16* dst = STr + ((size_t)(bh * RT_NS + sg)) * 131072;
#pragma unroll
        for (int i = 0; i < 2; ++i)
#pragma unroll
            for (int j = 0; j < 4; ++j)
#pragma unroll
                for (int e = 0; e < 16; ++e) dst[(vh * 256 + wm * 64 + i * 32 + crow(e, hh)) * 256 + wn * 128 + j * 32 + r] = f2bf(acc[i][j][e]);
    }
    __syncthreads();
}

DI void rt_pass3_unit(const bf16* Qr, const bf16* Kr, const bf16* VTr, const bf16* STr, bf16* ORET, float* SSQP, int idx, int lane) {
    const int r = lane & 31, hh = lane >> 5;
    const int vh = idx & 1, tbl = (idx >> 1) & 15, sgid = idx >> 5, sg = sgid & 15, bh = sgid >> 4, b = bh >> 2, h = bh & 3;
    const int t0 = sg * RT_L + tbl * 32;
    const size_t trow = (size_t)(b * SEQ + t0 + r);
    const bf16* qrow = Qr + trow * 1024 + h * 256 + 8 * hh;
    f32x16 acc[8];
#pragma unroll
    for (int nv = 0; nv < 8; ++nv) acc[nv] = zero16();
    for (int sb = 0; sb <= tbl; ++sb) {
        const int s0 = sg * RT_L + sb * 32;
        const bf16* krow = Kr + ((size_t)(b * SEQ + s0 + r)) * 1024 + h * 256 + 8 * hh;
        f32x16 x = zero16();
#pragma unroll
        for (int k4 = 0; k4 < 4; ++k4) {
            bf16x8 kf[4], qf[4];
#pragma unroll
            for (int i = 0; i < 4; ++i) { kf[i] = ldg16(krow + (k4 * 4 + i) * 16); qf[i] = ldg16(qrow + (k4 * 4 + i) * 16); }
#pragma unroll
            for (int i = 0; i < 4; ++i) x = MFMA32(kf[i], qf[i], x);
            __builtin_amdgcn_sched_barrier(0);
        }
        if (sb == tbl) {
#pragma unroll
            for (int i = 0; i < 16; ++i) if (crow(i, hh) > r) x[i] = 0.f;
        }
        const bf16x8 xs0 = packx(x, 0), xs1 = packx(x, 1);
#pragma unroll
        for (int nv = 0; nv < 8; ++nv) {
            const bf16* vb = VTr + (((size_t)(bh * 512 + vh * 256 + nv * 32 + r)) << 13) + s0 + 4 * hh;
            acc[nv] = MFMA32(ldg2x8(vb, vb + 8), xs0, acc[nv]);
            acc[nv] = MFMA32(ldg2x8(vb + 16, vb + 24), xs1, acc[nv]);
            if ((nv & 3) == 3) __builtin_amdgcn_sched_barrier(0);
        }
    }
    const bf16* st = STr + ((size_t)(bh * RT_NS + sg)) * 131072 + (size_t)(vh * 256) * 256;
#pragma unroll 2
    for (int kk = 0; kk < 16; ++kk) {
        const bf16x8 q = ldg16(qrow + kk * 16);
#pragma unroll
        for (int nv = 0; nv < 8; ++nv) acc[nv] = MFMA32(ldg16(st + (nv * 32 + r) * 256 + kk * 16 + 8 * hh), q, acc[nv]);
        __builtin_amdgcn_sched_barrier(0);
    }
    float ss = 0.f;
#pragma unroll
    for (int nv = 0; nv < 8; ++nv)
#pragma unroll
        for (int i = 0; i < 16; ++i) ss += acc[nv][i] * acc[nv][i];
    ss += __shfl_xor(ss, 32);
    if (hh == 0) SSQP[trow * 8 + h * 2 + vh] = ss;
#pragma unroll
    for (int nv = 0; nv < 8; ++nv)
#pragma unroll
        for (int g = 0; g < 4; ++g) {
            const int v = vh * 256 + nv * 32 + 8 * g + 4 * hh;
            u32x2 o; o.x = pk2(acc[nv][4 * g], acc[nv][4 * g + 1]); o.y = pk2(acc[nv][4 * g + 2], acc[nv][4 * g + 3]);
            *(u32x2*)(ORET + trow * 2048 + h * 512 + v) = o;
        }
}
DI void rt_pass3(const bf16* Qr, const bf16* Kr, const bf16* VTr, const bf16* STr, bf16* ORET, float* SSQP, int gw, int ngw) {
    const int lane = fresh_tid() & 63;
    for (int u = gw; u < 2048; u += ngw) {
        rt_pass3_unit(Qr, Kr, VTr, STr, ORET, SSQP, u, lane);
        const int p = (u & 1) | ((15 - ((u >> 1) & 15)) << 1) | (((u >> 5) + 64) << 5);
        rt_pass3_unit(Qr, Kr, VTr, STr, ORET, SSQP, p, lane);
    }
}

DI float dot2bf(unsigned a, unsigned b, float c) {
#if __has_builtin(__builtin_amdgcn_fdot2_f32_bf16)
    typedef __bf16 nb2 __attribute__((ext_vector_type(2)));
    return __builtin_amdgcn_fdot2_f32_bf16(__builtin_bit_cast(nb2, a), __builtin_bit_cast(nb2, b), c, false);
#else
    return c + bflo(a) * bflo(b) + bfhi(a) * bfhi(b);
#endif
}
DI void wave_argmax(float& v, int& idx) {
#pragma unroll
    for (int o = 1; o < 64; o <<= 1) {
        const float ov = __shfl_xor(v, o); const int oi = __shfl_xor(idx, o);
        if (ov > v || (ov == v && oi < idx)) { v = ov; idx = oi; }
    }
}

DI void peer_topk1(const bf16* Q, const bf16* SK, float* TOPS, int* TOPI, int wg, int nwg) {
    const int tid = fresh_tid(), lane = tid & 63, w = __builtin_amdgcn_readfirstlane(tid >> 6);
    for (int unit = wg; unit < 16 * 16; unit += nwg) {
        const int hp = unit & 15, tblk = unit >> 4;
        unsigned k0[64], k1[64];
        {
            const u32x4* p0 = (const u32x4*)(SK + ((size_t)(hp * 128 + lane)) * 128);
            const u32x4* p1 = (const u32x4*)(SK + ((size_t)(hp * 128 + 64 + lane)) * 128);
#pragma unroll
            for (int i = 0; i < 16; ++i) { const u32x4 a = p0[i], b = p1[i]; k0[4 * i] = a.x; k0[4 * i + 1] = a.y; k0[4 * i + 2] = a.z; k0[4 * i + 3] = a.w; k1[4 * i] = b.x; k1[4 * i + 1] = b.y; k1[4 * i + 2] = b.z; k1[4 * i + 3] = b.w; }
        }
        for (int tt = 0; tt < 128; ++tt) {
            const int t = tblk * 1024 + w * 128 + tt;
            const u32x4* qp = (const u32x4*)(Q + (size_t)t * 2048 + hp * 128);
            float s0 = 0.f, s1 = 0.f;
#pragma unroll
            for (int i = 0; i < 16; ++i) {
                const u32x4 qv = qp[i];
                s0 = dot2bf(k0[4 * i], qv.x, s0); s0 = dot2bf(k0[4 * i + 1], qv.y, s0); s0 = dot2bf(k0[4 * i + 2], qv.z, s0); s0 = dot2bf(k0[4 * i + 3], qv.w, s0);
                s1 = dot2bf(k1[4 * i], qv.x, s1); s1 = dot2bf(k1[4 * i + 1], qv.y, s1); s1 = dot2bf(k1[4 * i + 2], qv.z, s1); s1 = dot2bf(k1[4 * i + 3], qv.w, s1);
            }
            float myv = 0.f; int myi = 0;
            for (int rnd = 0; rnd < 16; ++rnd) {
                float v; int idx;
                if (s0 >= s1) { v = s0; idx = lane; } else { v = s1; idx = lane + 64; }
                wave_argmax(v, idx);
                if (idx == lane) s0 = -3.0e38f;
                if (idx == lane + 64) s1 = -3.0e38f;
                if (lane == rnd) { myv = v; myi = idx; }
            }
            if (lane < 16) { TOPS[((size_t)t * 16 + hp) * 16 + lane] = myv; TOPI[((size_t)t * 16 + hp) * 16 + lane] = myi; }
        }
    }
}

DI void peer_cand(const float* TOPS, const int* TOPI, int* EIDX, float* EGATE, int gw, int ngw) {
    const int lane = fresh_tid() & 63;
    for (int unit = gw; unit < T * PE_H; unit += ngw) {
        const int t = unit >> 3, h = unit & 7;
        const float* s1p = TOPS + ((size_t)t * 16 + h * 2) * 16;
        const int i1 = lane >> 2, j0 = (lane & 3) * 4;
        const float a = s1p[i1];
        const f32x4 bq = *(const f32x4*)(s1p + 16 + j0);
        float c0 = a + bq[0], c1 = a + bq[1], c2 = a + bq[2], c3 = a + bq[3];
        float myv = 0.f; int myc = 0;
        for (int rnd = 0; rnd < 16; ++rnd) {
            float v = c0; int idx = 4 * lane;
            if (c1 > v) { v = c1; idx = 4 * lane + 1; }
            if (c2 > v) { v = c2; idx = 4 * lane + 2; }
            if (c3 > v) { v = c3; idx = 4 * lane + 3; }
            wave_argmax(v, idx);
            if (idx == 4 * lane) c0 = -3.0e38f;
            if (idx == 4 * lane + 1) c1 = -3.0e38f;
            if (idx == 4 * lane + 2) c2 = -3.0e38f;
            if (idx == 4 * lane + 3) c3 = -3.0e38f;
            if (lane == rnd) { myv = v; myc = idx; }
        }
        const float mx = __shfl(myv, 0);
        float ex = lane < 16 ? __expf(myv - mx) : 0.f;
        float sum = ex;
#pragma unroll
        for (int o = 1; o < 16; o <<= 1) sum += __shfl_xor(sum, o);
        if (lane < 16) {
            const int ci = myc >> 4, cj = myc & 15;
            const int e = TOPI[((size_t)t * 16 + h * 2) * 16 + ci] * PE_NK + TOPI[((size_t)t * 16 + h * 2 + 1) * 16 + cj];
            EIDX[(size_t)t * 128 + h * 16 + lane] = e;
            EGATE[(size_t)t * 128 + h * 16 + lane] = ex / sum;
        }
    }
}

DI float gelu_tanh(float x) {
    const float u = 0.7978845608028654f * (x + 0.044715f * x * x * x);
    const float e = __expf(2.f * u);
    const float th = 1.f - 2.f / (e + 1.f);
    return 0.5f * x * (1.f + th);
}

DI float bcast_f(float v, int j) { return __int_as_float(__builtin_amdgcn_readfirstlane(__float_as_int(__shfl(v, j)))); }
DI void peer_experts(const bf16* XW, const float* SSQX, const float* X1, const bf16* EU, const bf16* EV, const int* EIDX, const float* EGATE,
                     const float* fw, float* OUT, int gw, int ngw) {
    const int lane = fresh_tid() & 63;
    for (int t = gw; t < T; t += ngw) {
        const float rs = rstd_x1(SSQX, (size_t)t);
        const u32x4 xa = *(const u32x4*)(XW + (size_t)t * 1024 + lane * 16), xb = *(const u32x4*)(XW + (size_t)t * 1024 + lane * 16 + 8);
        const int e0 = EIDX[(size_t)t * 128 + lane], e1 = EIDX[(size_t)t * 128 + 64 + lane];
        const float g0 = EGATE[(size_t)t * 128 + lane], g1 = EGATE[(size_t)t * 128 + 64 + lane];
        float w0 = 0.f, w1 = 0.f;
#pragma unroll 1
        for (int jg = 0; jg < 128; jg += 8) {
            u32x4 ua[8], ub[8];
#pragma unroll
            for (int k = 0; k < 8; ++k) {
                const int j = jg + k;
                const int e = __builtin_amdgcn_readfirstlane(jg < 64 ? __shfl(e0, j & 63) : __shfl(e1, j & 63));
                const u32x4* up = (const u32x4*)(EU + (size_t)e * 1024 + lane * 16);
                ua[k] = up[0]; ub[k] = up[1];
            }
#pragma unroll
            for (int k = 0; k < 8; ++k) {
                const int j = jg + k;
                float s = 0.f;
                s = dot2bf(ua[k].x, xa.x, s); s = dot2bf(ua[k].y, xa.y, s); s = dot2bf(ua[k].z, xa.z, s); s = dot2bf(ua[k].w, xa.w, s);
                s = dot2bf(ub[k].x, xb.x, s); s = dot2bf(ub[k].y, xb.y, s); s = dot2bf(ub[k].z, xb.z, s); s = dot2bf(ub[k].w, xb.w, s);
                s = wave_sum(s);
                const float act = gelu_tanh(s * rs);
                if (jg < 64) { if (lane == j) w0 = g0 * act; } else { if (lane == j - 64) w1 = g1 * act; }
            }
        }
        float o[16];
#pragma unroll
        for (int i = 0; i < 16; ++i) o[i] = 0.f;
#pragma unroll 1
        for (int jg = 0; jg < 128; jg += 8) {
            u32x4 va[8], vb[8]; float wq[8];
#pragma unroll
            for (int k = 0; k < 8; ++k) {
                const int j = jg + k;
                const int e = __builtin_amdgcn_readfirstlane(jg < 64 ? __shfl(e0, j & 63) : __shfl(e1, j & 63));
                wq[k] = jg < 64 ? bcast_f(w0, j & 63) : bcast_f(w1, j & 63);
                const u32x4* vp = (const u32x4*)(EV + (size_t)e * 1024 + lane * 16);
                va[k] = vp[0]; vb[k] = vp[1];
            }
#pragma unroll
            for (int k = 0; k < 8; ++k) {
                const float q = wq[k];
                o[0] += q * bflo(va[k].x); o[1] += q * bfhi(va[k].x); o[2] += q * bflo(va[k].y); o[3] += q * bfhi(va[k].y);
                o[4] += q * bflo(va[k].z); o[5] += q * bfhi(va[k].z); o[6] += q * bflo(va[k].w); o[7] += q * bfhi(va[k].w);
                o[8] += q * bflo(vb[k].x); o[9] += q * bfhi(vb[k].x); o[10] += q * bflo(vb[k].y); o[11] += q * bfhi(vb[k].y);
                o[12] += q * bflo(vb[k].z); o[13] += q * bfhi(vb[k].z); o[14] += q * bflo(vb[k].w); o[15] += q * bfhi(vb[k].w);
            }
        }
        const float* xp = X1 + (size_t)t * 1024 + lane * 16;
        float ss = 0.f;
#pragma unroll
        for (int i = 0; i < 4; ++i) { const f32x4 xv = *(const f32x4*)(xp + 4 * i);
#pragma unroll
            for (int e = 0; e < 4; ++e) { o[4 * i + e] += xv[e]; ss += o[4 * i + e] * o[4 * i + e]; } }
        ss = wave_sum(ss);
        const float rf = rsqrtf(ss * (1.f / 1024.f) + EPS);
#pragma unroll
        for (int i = 0; i < 4; ++i) { const f32x4 wv = *(const f32x4*)(fw + lane * 16 + 4 * i);
            *(f32x4*)(OUT + (size_t)t * 1024 + lane * 16 + 4 * i) = (f32x4){o[4 * i] * rf * wv[0], o[4 * i + 1] * rf * wv[1], o[4 * i + 2] * rf * wv[2], o[4 * i + 3] * rf * wv[3]}; }
    }
}

DI void transpose_item(const float* W, int K, int N, bf16* WT, int n_src0, int n_dst0, int k0, LAS float* scr, int lane) {
#pragma unroll 8
    for (int i = 0; i < 32; ++i) { const int kk = 2 * i + (lane >> 5); scr[kk * 33 + (lane & 31)] = W[(size_t)(k0 + kk) * N + n_src0 + (lane & 31)]; }
    asm volatile("s_waitcnt lgkmcnt(0)" ::: "memory");
    const int c = lane & 7;
#pragma unroll
    for (int j = 0; j < 4; ++j) { const int n = (lane >> 3) + 8 * j; const LAS float* s = scr + (8 * c) * 33 + n;
        u32x4 o; o.x = pk2(s[0 * 33], s[1 * 33]); o.y = pk2(s[2 * 33], s[3 * 33]); o.z = pk2(s[4 * 33], s[5 * 33]); o.w = pk2(s[6 * 33], s[7 * 33]);
        *(u32x4*)(WT + (size_t)(n_dst0 + n) * K + k0 + 8 * c) = o; }
    asm volatile("s_waitcnt lgkmcnt(0)" ::: "memory");
}
DI int win_orig_col(int np) {
    if (np < 2048) { const int h = np >> 8, sel = (np >> 7) & 1, d = np & 127; return sel * 1024 + h * 128 + d; }
    if (np < 3072) return np;
    if (np < 7168) return np + 1024;
    if (np < 8192) return np - 4096;
    return np;
}
DI void rmsnorm_row_bf16(const float* xrow, const float* w, bf16* orow, int lane) {
    const f32x4* xr = (const f32x4*)xrow + lane; const f32x4* wr4 = (const f32x4*)w + lane;
    f32x4 v[4]; float s = 0.f;
#pragma unroll
    for (int j = 0; j < 4; ++j) { v[j] = xr[64 * j]; s += (v[j][0] * v[j][0] + v[j][1] * v[j][1]) + (v[j][2] * v[j][2] + v[j][3] * v[j][3]); }
    const float rs = rsqrtf(wave_sum(s) * (1.f / 1024.f) + EPS);
    u32x2* o8 = (u32x2*)orow + lane;
#pragma unroll
    for (int j = 0; j < 4; ++j) { const f32x4 ww = wr4[64 * j]; u32x2 o; o.x = pk2(v[j][0] * rs * ww[0], v[j][1] * rs * ww[1]); o.y = pk2(v[j][2] * rs * ww[2], v[j][3] * rs * ww[3]); o8[64 * j] = o; }
}
DI void convert_bf16(const float* src, bf16* dst, size_t n, size_t gtid, size_t gsz) {
    for (size_t i = gtid * 8; i < n; i += gsz * 8) {
        const f32x4 a = *(const f32x4*)(src + i), b = *(const f32x4*)(src + i + 4);
        *(u32x4*)(dst + i) = pack8(a, b);
    }
}

struct Params { const float* in[14]; float* out; unsigned char* ws; };

__global__ void __launch_bounds__(NTHREADS, 2) fwd_megakernel(Params p) {
    extern __shared__ __attribute__((aligned(16))) unsigned char lds_raw[];
    LAS unsigned char* lds = (LAS unsigned char*)lds_raw;
    cg::grid_group grid = cg::this_grid();
    const int G = gridDim.x, wg = blockIdx.x;
#define PHASE_IDS const int tid = fresh_tid(), lane = tid & 63, wave = __builtin_amdgcn_readfirstlane(tid >> 6); \
    const int gw = wg * NWAVES + wave, ngw = G * NWAVES; const size_t gtid = (size_t)wg * NTHREADS + tid, gsz = (size_t)G * NTHREADS; \
    (void)lane; (void)gw; (void)ngw; (void)gtid; (void)gsz;
    unsigned char* ws = p.ws;
    const float* x = p.in[0];
    bf16* HN = (bf16*)(ws + WS_HN); bf16* WinT = (bf16*)(ws + WS_WINT);
    float* COS = (float*)(ws + WS_ROPE); float* SIN = COS + 8192 * 128;
    float* DEC = (float*)(ws + WS_DEC); float* SSQP = (float*)(ws + WS_SSQP); float* SSQX = (float*)(ws + WS_SSQX);
    bf16* BA = (bf16*)(ws + WS_A); bf16* BB = (bf16*)(ws + WS_B); bf16* BC = (bf16*)(ws + WS_C);
    bf16* STh = (bf16*)(ws + WS_STH); bf16* STr = (bf16*)(ws + WS_STR);
    bf16* OHG = (bf16*)(ws + WS_OHG); bf16* ORET = (bf16*)p.out;
    bf16* GA = (bf16*)(ws + WS_GA); bf16* GB = (bf16*)(ws + WS_GB);
    bf16* WhgT = (bf16*)(ws + WS_WHG); bf16* WretT = (bf16*)(ws + WS_WRET); bf16* WoutT = (bf16*)(ws + WS_WOUT); bf16* WqT = (bf16*)(ws + WS_WQ); bf16* SK = (bf16*)(ws + WS_SK);
    bf16* EV = (bf16*)(ws + WS_EV); bf16* EU = (bf16*)(ws + WS_EU);
    float* M1 = (float*)(ws + WS_M1); bf16* MERGED = (bf16*)(ws + WS_MERGED);
    float* X1 = (float*)(ws + WS_X1); bf16* XW = (bf16*)(ws + WS_XW); bf16* Qp = (bf16*)p.out;
    float* TOPS = (float*)(ws + WS_TOPS); int* TOPI = (int*)(ws + WS_TOPI); int* EIDX = (int*)(ws + WS_EIDX); float* EGATE = (float*)(ws + WS_EGATE);

    { PHASE_IDS LAS float* scr = (LAS float*)(lds + wave * 16384);
    for (int it = gw; it < 16 * 384; it += ngw) {
        const int kb = it / 384, nb = it % 384;
        transpose_item(p.in[2], 1024, 12288, WinT, win_orig_col(nb * 32), nb * 32, kb * 64, scr, lane);
    }
    for (int m = gw; m < T; m += ngw) rmsnorm_row_bf16(x + (size_t)m * 1024, p.in[1], HN + (size_t)m * 1024, lane);
    for (size_t i = gtid; i < (size_t)8192 * 128; i += gsz) {
        const int pos = (int)(i >> 7), j = (int)(i & 127);
        const float inv = (float)exp(-(double)j * (9.210340371976184 / 128.0));
        const float ang = (float)pos * inv;
        double rev = (double)ang * 0.15915494309189535; rev -= rint(rev);
        COS[i] = __builtin_amdgcn_cosf((float)rev); SIN[i] = __builtin_amdgcn_sinf((float)rev);
    } }
    grid.sync();

    {
        pg8::Gemm g{HN, WinT, T, 3072, 1024}; pg8::StaticOrder S; S.init(T, 3072, G, wg);
        EpiH E{BA, BB, BC, DEC, p.in[3]};
        pg8::gemm_phase<EpiH, pg8::StaticOrder, true, true>(lds, g, S, E);
    }
    grid.sync();
    hg_pass1(lds, BB, BC, STh, wg, G);
    grid.sync();
    { PHASE_IDS hg_scan(STh, DEC, (int)gtid, (int)gsz); }
    grid.sync();
    { PHASE_IDS hg_pass3(BA, BB, BC, STh, p.in[4], OHG, gw, ngw); }
    grid.sync();

    {
        pg8::Gemm g{HN, WinT + (size_t)3072 * 1024, T, 4096, 1024}; pg8::StaticOrder S; S.init(T, 4096, G, wg);
        EpiR E{BA, BB, BC, COS, SIN};
        pg8::gemm_phase<EpiR, pg8::StaticOrder, true, true>(lds, g, S, E);
    }
    grid.sync();
    rt_pass1(lds, BB, BC, STr, wg, G);
    grid.sync();
    { PHASE_IDS rt_scan(STr, (int)gtid, (int)gsz); }
    grid.sync();
    { PHASE_IDS rt_pass3(BA, BB, BC, STr, ORET, SSQP, gw, ngw); }
    grid.sync();

    { PHASE_IDS LAS float* scr = (LAS float*)(lds + wave * 16384);
    for (int it = gw; it < 3072; it += ngw) {
        int r = it;
        if (r < 512) { transpose_item(p.in[5], 1024, 1024, WhgT, (r % 32) * 32, (r % 32) * 32, (r / 32) * 64, scr, lane); continue; } r -= 512;
        if (r < 1024) { transpose_item(p.in[6], 2048, 1024, WretT, (r % 32) * 32, (r % 32) * 32, (r / 32) * 64, scr, lane); continue; } r -= 1024;
        if (r < 512) { transpose_item(p.in[7], 1024, 1024, WoutT, (r % 32) * 32, (r % 32) * 32, (r / 32) * 64, scr, lane); continue; } r -= 512;
        transpose_item(p.in[9], 1024, 2048, WqT, (r % 64) * 32, (r % 64) * 32, (r / 64) * 64, scr, lane);
    }
    convert_bf16(p.in[10], SK, (size_t)16 * 128 * 128, gtid, gsz);
    convert_bf16(p.in[12], EV, (size_t)PE_NE * 1024, gtid, gsz); }
    __syncthreads();
    {
        pg8::Gemm g{HN, WinT + (size_t)7168 * 1024, T, 5120, 1024}; pg8::StaticOrder S; S.init(T, 5120, G, wg);
        EpiG E{OHG, ORET, GA, GB, SSQP};
        pg8::gemm_phase<EpiG, pg8::StaticOrder, true, true>(lds, g, S, E);
    }
    grid.sync();

    {
        pg8::Gemm g{OHG, WhgT, T, 1024, 1024}; pg8::StaticOrder S; S.init(T, 1024, G, wg);
        EpiM1 E{M1, GA};
        pg8::gemm_phase<EpiM1, pg8::StaticOrder, false, true>(lds, g, S, E);
    }
    __syncthreads();
    {
        pg8::Gemm g{ORET, WretT, T, 1024, 2048}; pg8::StaticOrder S; S.init(T, 1024, G, wg);
        EpiMerge E{M1, GB, MERGED};
        pg8::gemm_phase<EpiMerge, pg8::StaticOrder, false, true>(lds, g, S, E);
    }
    grid.sync();
    {
        pg8::Gemm g{MERGED, WoutT, T, 1024, 1024}; pg8::StaticOrder S; S.init(T, 1024, G, wg);
        EpiOut E{x, X1, XW, p.in[8], SSQX};
        pg8::gemm_phase<EpiOut, pg8::StaticOrder, false, true>(lds, g, S, E);
    }
    grid.sync();
    { PHASE_IDS convert_bf16(p.in[11], EU, (size_t)PE_NE * 1024, gtid, gsz); }
    __syncthreads();
    {
        pg8::Gemm g{XW, WqT, T, 2048, 1024}; pg8::StaticOrder S; S.init(T, 2048, G, wg);
        EpiQ E{Qp, SSQX};
        pg8::gemm_phase<EpiQ, pg8::StaticOrder, true, true>(lds, g, S, E);
    }
    grid.sync();
    peer_topk1(Qp, SK, TOPS, TOPI, wg, G);
    grid.sync();
    { PHASE_IDS peer_cand(TOPS, TOPI, EIDX, EGATE, gw, ngw); }
    grid.sync();
    { PHASE_IDS peer_experts(XW, SSQX, X1, EU, EV, EIDX, EGATE, p.in[13], p.out, gw, ngw); }
}

extern "C" void kernel_launch(void* const* d_in, const int* in_sizes, int n_in, void* d_out, int out_size, void* d_ws, size_t ws_size, hipStream_t stream) {
    static int grid_blocks = 0;
    if (!grid_blocks) {
        int dev = 0, cus = 0, per_cu = 0;
        (void)hipGetDevice(&dev);
        (void)hipDeviceGetAttribute(&cus, hipDeviceAttributeMultiprocessorCount, dev);
        (void)hipFuncSetAttribute((const void*)fwd_megakernel, hipFuncAttributeMaxDynamicSharedMemorySize, LDS_BYTES);
        (void)hipOccupancyMaxActiveBlocksPerMultiprocessor(&per_cu, (const void*)fwd_megakernel, NTHREADS, LDS_BYTES);
        if (per_cu < 1) per_cu = 1;
        grid_blocks = cus * 1;
        if (ws_size < WS_END || n_in != 14) { fprintf(stderr, "kernel_launch: unexpected ws_size %zu (need %zu) or n_in %d\n", ws_size, (size_t)WS_END, n_in); }
    }
    Params p{};
    for (int i = 0; i < 14; ++i) p.in[i] = (const float*)d_in[i];
    p.out = (float*)d_out; p.ws = (unsigned char*)d_ws;
    void* args[] = {&p};
    hipError_t e = hipLaunchCooperativeKernel((const void*)fwd_megakernel, dim3(grid_blocks), dim3(NTHREADS), args, LDS_BYTES, stream);
    if (e != hipSuccess) fprintf(stderr, "cooperative launch failed: %s (grid %d)\n", hipGetErrorString(e), grid_blocks);
}
```

```cpp
#include <hip/hip_runtime.h>
#include <hip/hip_cooperative_groups.h>
#include <cstdio>
#include <cstdint>
namespace cg = cooperative_groups;
#ifndef USE_CG_SYNC
#define USE_CG_SYNC 0
#endif
#ifndef PROBE_MASK
#define PROBE_MASK 0
#endif

#define DI __device__ __forceinline__
#define LAS __attribute__((address_space(3)))
typedef unsigned short bf16;
typedef float f32x4 __attribute__((ext_vector_type(4)));
typedef float f32x2 __attribute__((ext_vector_type(2)));
typedef float f32x16 __attribute__((ext_vector_type(16)));
typedef short bf16x8 __attribute__((ext_vector_type(8)));
typedef short s16x4 __attribute__((ext_vector_type(4)));
typedef unsigned u32x4 __attribute__((ext_vector_type(4)));
typedef unsigned u32x2 __attribute__((ext_vector_type(2)));
typedef __bf16 nbf16x2 __attribute__((ext_vector_type(2)));

constexpr int D = 1024, NB = 2, SEQ = 8192, T = NB * SEQ;
constexpr int HG_H = 8, HG_DK = 128, HG_DV = 128, HG_C = 64, HG_NC = SEQ / HG_C;
constexpr int RT_H = 4, RT_DK = 256, RT_DV = 512, RT_L = 512, RT_NS = SEQ / RT_L;
constexpr int PE_H = 8, PE_NK = 128, PE_K = 16, PE_Q = 256, PE_HALF = 128, PE_NE = PE_NK * PE_NK;
constexpr float EPS = 1e-6f;
constexpr int NTHREADS = 512, NWAVES = 8;
constexpr int LDS_BYTES = 147456;

constexpr size_t MiB = 1u << 20;
constexpr size_t WS_CTL = 0;
constexpr size_t WS_DEC = 1 * MiB;
constexpr size_t WS_SSQP = 2 * MiB;
constexpr size_t WS_SSQX = 3 * MiB;
constexpr size_t WS_HN = 4 * MiB;
constexpr size_t WS_WINT = 36 * MiB;
constexpr size_t WS_ROPE = 60 * MiB;
constexpr size_t WS_A = 68 * MiB, WS_B = 100 * MiB, WS_C = 132 * MiB;
constexpr size_t WS_STH = 164 * MiB;
constexpr size_t WS_STR = 196 * MiB;
constexpr size_t WS_OHG = 228 * MiB;
constexpr size_t WS_GA = 68 * MiB, WS_GB = 100 * MiB;
constexpr size_t WS_W2 = 132 * MiB;
constexpr size_t WS_WHG = WS_W2, WS_WRET = WS_W2 + 2 * MiB, WS_WOUT = WS_W2 + 6 * MiB, WS_WQ = WS_W2 + 8 * MiB, WS_SK = WS_W2 + 12 * MiB;
constexpr size_t WS_EV = 145 * MiB;
constexpr size_t WS_MERGED = 177 * MiB;
constexpr size_t WS_EU = 209 * MiB;
constexpr size_t WS_M1 = 4 * MiB;
constexpr size_t WS_X1 = 4 * MiB;
constexpr size_t WS_XW = 68 * MiB;
constexpr size_t WS_TOPS = 100 * MiB, WS_TOPI = 116 * MiB;
constexpr size_t WS_EIDX = 177 * MiB, WS_EGATE = 185 * MiB;
constexpr size_t WS_END = 260 * MiB;

DI int fresh_tid() { int t = threadIdx.x; asm volatile("" : "+v"(t)); return t; }
DI float sigmoidf_(float x) { return 1.f / (1.f + __expf(-x)); }
DI float siluf_(float x) { return x / (1.f + __expf(-x)); }
DI unsigned pk2(float lo, float hi) { f32x2 v = {lo, hi}; nbf16x2 b = __builtin_convertvector(v, nbf16x2); return __builtin_bit_cast(unsigned, b); }
DI bf16 f2bf(float f) { return (bf16)(pk2(f, 0.f) & 0xffffu); }
DI float bf2f(bf16 b) { return __uint_as_float(((unsigned)b) << 16); }
DI float bflo(unsigned u) { return __uint_as_float(u << 16); }
DI float bfhi(unsigned u) { return __uint_as_float(u & 0xffff0000u); }
DI float wave_sum(float v) {
#pragma unroll
    for (int o = 1; o < 64; o <<= 1) v += __shfl_xor(v, o);
    return v;
}
DI int crow(int reg, int h) { return (reg & 3) + 8 * (reg >> 2) + 4 * h; }

namespace pg8 {
#define PG8_LAS __attribute__((address_space(3)))
typedef unsigned short bf16_t;
typedef short bf16x8 __attribute__((ext_vector_type(8)));
typedef float f32x4 __attribute__((ext_vector_type(4)));
typedef unsigned u32x4 __attribute__((ext_vector_type(4)));
constexpr int BM = 256, BK = 64, HALF = 128, HTB = HALF * BK * 2  , STAGE_BYTES = 8 * HTB, NXCD = 8, WGM = 8;

__host__ __device__ __forceinline__ int lds_byte(int r, int c) { const int st = (r >> 4) * 2 + (c >> 5), rr = r & 15, cc = c & 31, ob = rr * 64 + cc * 2; return st * 1024 + (ob ^ (((ob >> 9) & 1) << 5)); }
__host__ __device__ __forceinline__ void stage_rc(int b, int& R, int& C) { const int st = b / 1024, sb = b % 1024, swz = sb ^ (((sb >> 9) & 1) << 5); R = (st >> 1) * 16 + swz / 64; C = (st & 1) * 32 + (swz % 64) / 2; }
__host__ __device__ __forceinline__ int perm32(int rho) { const int n = rho >> 4, i = rho & 15; return 8 * (i >> 2) + 4 * n + (i & 3); }

struct Unit { int pm, pn; };
struct Gemm { const bf16_t* A; const bf16_t* Bt; int M, N, K; };

struct StaticOrder {
    int nM, nN, nwg, G, c;
    __host__ __device__ void init(int M, int N, int G_, int c_) { nM = M / BM; nN = N / BM; nwg = nM * nN; G = G_; c = c_; }
    __host__ __device__ bool next(int i, Unit& u) const {
        const long L = (long)i * G + c; if (L >= nwg) return false;
        int wgid = (int)L; { const int q = nwg / NXCD, r = nwg % NXCD, xcd = wgid % NXCD, off = wgid / NXCD; wgid = (xcd < r ? xcd * (q + 1) : r * (q + 1) + (xcd - r) * q) + off; }
        const int nig = WGM * nN, gid = wgid / nig, fm = gid * WGM, gsz = (nM - fm) < WGM ? (nM - fm) : WGM;
        u.pm = fm + ((wgid % nig) % gsz); u.pn = (wgid % nig) / gsz; return true;
    }
    __device__ __forceinline__ void a_ready(const Unit&) const {}
    __device__ __forceinline__ void done(const Unit&) const {}
};

__device__ __forceinline__ unsigned cvt_pk_bf16(float lo, float hi) { unsigned r; asm volatile("v_cvt_pk_bf16_f32 %0, %1, %2" : "=v"(r) : "v"(lo), "v"(hi)); return r; }
typedef float f32x2 __attribute__((ext_vector_type(2)));
template <class Epi, class Sched, bool ALIGN_EPI = false, bool SP2 = false>
__device__ __forceinline__ void gemm_phase(PG8_LAS unsigned char* lds, const Gemm g, const Sched& S, const Epi& E) {
    const int tid = fresh_tid(), wid = __builtin_amdgcn_readfirstlane(tid >> 6), lane = tid & 63, wr = wid >> 2, wc = wid & 3, fr = lane & 15, fq = lane >> 4;
    const int K = g.K, nt = K / BK;
    unsigned voffA[2], voffB[2];
#pragma unroll
    for (int i = 0; i < 2; ++i) { int R, C; stage_rc(tid * 16 + i * 8192, R, C); const int Rb = Epi::PERM ? ((R & ~31) + perm32(R & 31)) : R;
        voffA[i] = (unsigned)(R * K + C) * 2u; voffB[i] = (unsigned)(Rb * K + C) * 2u; }
    const size_t kstep = (size_t)(BK * 2);
    const size_t hstep = (size_t)HALF * K * 2;
    const size_t tstep = 2 * hstep;
    const unsigned ldsw = (unsigned)wid * 1024u;
    const int aoff = lds_byte(wr * 64 + fr, fq * 8), boff = lds_byte(wc * 32 + fr, fq * 8);
#define PG8_SA(b, h) (((b) * 2 + (h)) * HTB)
#define PG8_SB(b, h) ((4 + (b) * 2 + (h)) * HTB)
#define PG8_STAGE(bufoff, gbase, voff) do { _Pragma("unroll") for (int _i = 0; _i < 2; ++_i) \
        __builtin_amdgcn_global_load_lds((const unsigned*)((const char*)(gbase) + (voff)[_i]), (PG8_LAS unsigned*)(lds + (bufoff) + ldsw + _i * 8192), 16, 0, 0); } while (0)
#define PG8_LDA(dst, b, h) do { _Pragma("unroll") for (int m = 0; m < 4; ++m) _Pragma("unroll") for (int k = 0; k < 2; ++k) dst[m][k] = *(const PG8_LAS bf16x8*)(lds + PG8_SA(b, h) + aoff + m * 2048 + k * 1024); } while (0)
#define PG8_LDB(dst, b, h) do { _Pragma("unroll") for (int n = 0; n < 2; ++n) _Pragma("unroll") for (int k = 0; k < 2; ++k) dst[n][k] = *(const PG8_LAS bf16x8*)(lds + PG8_SB(b, h) + boff + n * 2048 + k * 1024); } while (0)
#define PG8_MMA(ai, bj, At, Bt) do { __builtin_amdgcn_s_setprio(1); _Pragma("unroll") for (int m = 0; m < 4; ++m) _Pragma("unroll") for (int n = 0; n < 2; ++n) _Pragma("unroll") for (int k = 0; k < 2; ++k) \
        acc[ai][bj][m][n] = __builtin_amdgcn_mfma_f32_16x16x32_bf16(Bt[n][k], At[m][k], acc[ai][bj][m][n], 0, 0, 0); __builtin_amdgcn_s_setprio(0); } while (0)
#define PG8_WAIT_V(n) asm volatile("s_waitcnt vmcnt(" #n ")" ::: "memory")
#define PG8_WAIT_L(n) asm volatile("s_waitcnt lgkmcnt(" #n ")" ::: "memory")
#define PG8_BAR __builtin_amdgcn_s_barrier()
#define PG8_SCHED __builtin_amdgcn_sched_barrier(0)
    Unit cur, nxt; int ui = 0;
    if (!S.next(0, cur)) return;
    f32x4 acc[2][2][4][2];
#pragma unroll
    for (int a = 0; a < 2; ++a)
#pragma unroll
        for (int b = 0; b < 2; ++b)
#pragma unroll
            for (int m = 0; m < 4; ++m)
#pragma unroll
                for (int n = 0; n < 2; ++n) acc[a][b][m][n] = (f32x4){0.f, 0.f, 0.f, 0.f};
    bf16x8 At[4][2], B0[2][2], B1[2][2];
    const char* cA = (const char*)g.A + (size_t)cur.pm * tstep; const char* cB = (const char*)g.Bt + (size_t)cur.pn * tstep;
    S.a_ready(cur);
    if constexpr (SP2) {
        PG8_STAGE(PG8_SB(0, 0), cB, voffB); PG8_STAGE(PG8_SB(0, 1), cB + hstep, voffB); PG8_STAGE(PG8_SA(0, 0), cA, voffA); PG8_STAGE(PG8_SA(0, 1), cA + hstep, voffA);
        if (wr == 1) PG8_BAR;
        PG8_WAIT_V(2); PG8_BAR;
        PG8_STAGE(PG8_SB(1, 0), cB + kstep, voffB); PG8_STAGE(PG8_SA(1, 0), cA + kstep, voffA); PG8_STAGE(PG8_SB(1, 1), cB + hstep + kstep, voffB);
        PG8_WAIT_V(6); PG8_BAR;
    } else {
        PG8_STAGE(PG8_SB(0, 0), cB, voffB); PG8_STAGE(PG8_SA(0, 0), cA, voffA); PG8_STAGE(PG8_SB(0, 1), cB + hstep, voffB); PG8_STAGE(PG8_SA(0, 1), cA + hstep, voffA);
        if (wr == 1) PG8_BAR;
        PG8_WAIT_V(4); PG8_BAR;
        PG8_STAGE(PG8_SB(1, 0), cB + kstep, voffB); PG8_STAGE(PG8_SA(1, 0), cA + kstep, voffA); PG8_STAGE(PG8_SB(1, 1), cB + hstep + kstep, voffB);
        PG8_WAIT_V(6); PG8_BAR;
    }
    for (;;) {
        const bool has_next = S.next(ui + 1, nxt);
        const char* nA = has_next ? (const char*)g.A + (size_t)nxt.pm * tstep : cA; const char* nB = has_next ? (const char*)g.Bt + (size_t)nxt.pn * tstep : cB;
        for (int t = 0; t < nt; t += 2) {
            const bool last = (t == nt - 2);
            const char* a1 = cA + (size_t)(t + 1) * kstep;
            const char* a2 = last ? nA : cA + (size_t)(t + 2) * kstep; const char* b2 = last ? nB : cB + (size_t)(t + 2) * kstep;
            const char* a3 = a2 + kstep; const char* b3 = b2 + kstep;
            if (last && has_next) S.a_ready(nxt);
            if constexpr (SP2) {
            PG8_LDB(B0, 0, 0); PG8_LDB(B1, 0, 1); PG8_SCHED; PG8_LDA(At, 0, 0); PG8_STAGE(PG8_SA(1, 1), a1 + hstep, voffA);
            PG8_WAIT_V(8); PG8_WAIT_L(0); PG8_BAR; PG8_MMA(0, 0, At, B0); PG8_MMA(0, 1, At, B1); PG8_BAR; PG8_SCHED;
            PG8_LDA(At, 0, 1); PG8_STAGE(PG8_SB(0, 0), b2, voffB); PG8_STAGE(PG8_SB(0, 1), b2 + hstep, voffB); PG8_STAGE(PG8_SA(0, 0), a2, voffA);
            PG8_WAIT_V(8); PG8_WAIT_L(0); PG8_BAR; PG8_MMA(1, 0, At, B0); PG8_MMA(1, 1, At, B1); PG8_BAR; PG8_SCHED;
            PG8_LDB(B0, 1, 0); PG8_LDB(B1, 1, 1); PG8_SCHED; PG8_LDA(At, 1, 0); PG8_STAGE(PG8_SA(0, 1), a2 + hstep, voffA);
            PG8_WAIT_V(8); PG8_WAIT_L(0); PG8_BAR; PG8_MMA(0, 0, At, B0); PG8_MMA(0, 1, At, B1); PG8_BAR; PG8_SCHED;
            PG8_LDA(At, 1, 1); PG8_STAGE(PG8_SB(1, 0), b3, voffB); PG8_STAGE(PG8_SB(1, 1), b3 + hstep, voffB); PG8_STAGE(PG8_SA(1, 0), a3, voffA);
            PG8_WAIT_V(8); PG8_WAIT_L(0); PG8_BAR; PG8_MMA(1, 0, At, B0); PG8_MMA(1, 1, At, B1); PG8_BAR; PG8_SCHED;
            } else {
            PG8_LDB(B0, 0, 0); PG8_SCHED; PG8_LDA(At, 0, 0); PG8_STAGE(PG8_SA(1, 1), a1 + hstep, voffA);
            PG8_WAIT_L(8); PG8_BAR; PG8_WAIT_L(0); PG8_MMA(0, 0, At, B0); PG8_BAR; PG8_SCHED;
            PG8_LDB(B1, 0, 1); PG8_STAGE(PG8_SB(0, 0), b2, voffB);
            PG8_BAR; PG8_WAIT_L(0); PG8_MMA(0, 1, At, B1); PG8_BAR;
            PG8_LDA(At, 0, 1); PG8_STAGE(PG8_SA(0, 0), a2, voffA);
            PG8_BAR; PG8_WAIT_L(0); PG8_MMA(1, 0, At, B0); PG8_BAR; PG8_SCHED;
            PG8_STAGE(PG8_SB(0, 1), b2 + hstep, voffB);
            PG8_WAIT_V(6); PG8_BAR; PG8_MMA(1, 1, At, B1); PG8_BAR;
            PG8_LDB(B0, 1, 0); PG8_SCHED; PG8_LDA(At, 1, 0); PG8_STAGE(PG8_SA(0, 1), a2 + hstep, voffA);
            PG8_WAIT_L(8); PG8_BAR; PG8_WAIT_L(0); PG8_MMA(0, 0, At, B0); PG8_BAR; PG8_SCHED;
            PG8_LDB(B1, 1, 1); PG8_STAGE(PG8_SB(1, 0), b3, voffB);
            PG8_BAR; PG8_WAIT_L(0); PG8_MMA(0, 1, At, B1); PG8_BAR;
            PG8_LDA(At, 1, 1); PG8_STAGE(PG8_SA(1, 0), a3, voffA);
            PG8_BAR; PG8_WAIT_L(0); PG8_MMA(1, 0, At, B0); PG8_BAR; PG8_SCHED;
            PG8_STAGE(PG8_SB(1, 1), b3 + hstep, voffB);
            PG8_WAIT_V(6); PG8_BAR; PG8_MMA(1, 1, At, B1); PG8_BAR;
            }
        }
        if constexpr (ALIGN_EPI) { if (wr == 0) PG8_BAR; }
        if constexpr (!Epi::AFTER_DRAIN) { E(acc, cur, wr, wc, fr, fq); S.done(cur); }
        if (!has_next) break;
#pragma unroll
        for (int a = 0; a < 2; ++a)
#pragma unroll
            for (int b = 0; b < 2; ++b)
#pragma unroll
                for (int m = 0; m < 4; ++m)
#pragma unroll
                    for (int n = 0; n < 2; ++n) acc[a][b][m][n] = (f32x4){0.f, 0.f, 0.f, 0.f};
        cur = nxt; cA = nA; cB = nB; ++ui;
        if constexpr (ALIGN_EPI) { if (wr == 1) PG8_BAR; }
    }
    PG8_WAIT_V(0);
    if constexpr (!ALIGN_EPI) { if (wr == 0) PG8_BAR; }
    PG8_BAR;
    if constexpr (Epi::AFTER_DRAIN) { E.fused(acc, cur, wr, wc, fr, fq, lds, wid, lane); S.done(cur); }
#undef PG8_SA
#undef PG8_SB
#undef PG8_STAGE
#undef PG8_LDA
#undef PG8_LDB
#undef PG8_MMA
#undef PG8_WAIT_V
#undef PG8_WAIT_L
#undef PG8_BAR
#undef PG8_SCHED
}
}

using pg8::Unit;
typedef f32x4 Acc[2][2][4][2];

DI u32x4 pack8(const f32x4& a, const f32x4& b) { u32x4 w; w.x = pk2(a[0], a[1]); w.y = pk2(a[2], a[3]); w.z = pk2(b[0], b[1]); w.w = pk2(b[2], b[3]); return w; }

struct EpiH {
    static constexpr bool PERM = true, AFTER_DRAIN = false;
    bf16* Qh; bf16* Kh; bf16* VTh; float* DEC; const float* hlb;
    DI void operator()(Acc& acc, const Unit& u, int wr, int wc, int fr, int fq) const {
        if (u.pn < 8) {
            const int h = u.pn, dbase = wc * 32 + 8 * fq;
#pragma unroll
            for (int ai = 0; ai < 2; ++ai) {
                const int row0 = u.pm * 256 + ai * 128 + wr * 64;
                const int bidx = row0 >> 13, chunk = (row0 & (SEQ - 1)) >> 6;
#pragma unroll
                for (int n = 0; n < 2; ++n) {
                    f32x4 ebl;
#pragma unroll
                    for (int e = 0; e < 4; ++e) {
                        const int c = h * 128 + dbase + 4 * n + e;
                        const float lb = sigmoidf_(hlb[c] - hlb[1024 + c]);
                        float carry = 0.f, eb = 0.f;
#pragma unroll
                        for (int m = 0; m < 4; ++m) {
                            const float sg = sigmoidf_(acc[ai][1][m][n][e]);
                            const float f = lb + (1.f - lb) * sg;
                            const float kk = (1.f - lb) * (1.f - sg);
                            float s = __logf(f);
#pragma unroll
                            for (int dl = 1; dl < 16; dl <<= 1) { const float o = __shfl_up(s, dl, 16); if (fr >= dl) s += o; }
                            const float b = s + carry;
                            carry += __shfl(s, 15, 16);
                            eb = __expf(b);
                            acc[ai][0][m][n][e] = acc[ai][0][m][n][e] * 0.08838834764831845f * eb;
                            acc[ai][1][m][n][e] = kk * __expf(-b);
                        }
                        ebl[e] = eb;
                        __builtin_amdgcn_sched_barrier(0);
                    }
                    if (fr == 15) *(f32x4*)(DEC + ((size_t)((bidx * HG_H + h) * HG_NC + chunk)) * 128 + dbase + 4 * n) = ebl;
#pragma unroll
                    for (int m = 0; m < 4; ++m) {
                        const size_t row = (size_t)(row0 + m * 16 + fr);
                        const f32x4 qv = acc[ai][0][m][n], kv = acc[ai][1][m][n];
                        u32x2 oq, ok; oq.x = pk2(qv[0], qv[1]); oq.y = pk2(qv[2], qv[3]); ok.x = pk2(kv[0], kv[1]); ok.y = pk2(kv[2], kv[3]);
                        *(u32x2*)(Qh + row * 1024 + h * 128 + dbase + 4 * n) = oq;
                        *(u32x2*)(Kh + row * 1024 + h * 128 + dbase + 4 * n) = ok;
                    }
                    __builtin_amdgcn_sched_barrier(0);
                }
            }
        } else {
#pragma unroll
            for (int ai = 0; ai < 2; ++ai)
#pragma unroll
                for (int m = 0; m < 4; ++m) {
                    const int row = u.pm * 256 + ai * 128 + wr * 64 + m * 16 + fr, bidx = row >> 13, pos = row & (SEQ - 1);
                    bf16* ptr = VTh + (((size_t)(bidx * HG_H * 128 + (u.pn - 8) * 256 + wc * 32 + 8 * fq)) << 13) + pos;
#pragma unroll
                    for (int bj = 0; bj < 2; ++bj) {
#pragma unroll
                        for (int n = 0; n < 2; ++n)
#pragma unroll
                            for (int e = 0; e < 4; ++e) { asm volatile("" : "+v"(ptr)); *ptr = f2bf(acc[ai][bj][m][n][e]); ptr += 8192; }
                        ptr += (size_t)120 * 8192;
                    }
                }
        }
    }
};

struct EpiR {
    static constexpr bool PERM = true, AFTER_DRAIN = false;
    bf16* Qr; bf16* Kr; bf16* VTr; const float* COS; const float* SIN;
    DI void operator()(Acc& acc, const Unit& u, int wr, int wc, int fr, int fq) const {
        if (u.pn < 8) {
            const bool isk = u.pn >= 4; const int h = u.pn & 3;
            const float lg = __log2f(1.f - exp2f(-5.f - (float)h));
            bf16* dst = isk ? Kr : Qr;
            const int j0 = wc * 32 + 8 * fq;
#pragma unroll
            for (int ai = 0; ai < 2; ++ai)
#pragma unroll
                for (int m = 0; m < 4; ++m) {
                    const int row = u.pm * 256 + ai * 128 + wr * 64 + m * 16 + fr, pos = row & (SEQ - 1), il = pos & (RT_L - 1);
                    const float sc = isk ? exp2f(-lg * (float)il) * 0.0625f : exp2f(lg * (float)il);
#pragma unroll
                    for (int n = 0; n < 2; ++n) {
                        const f32x4 c = *(const f32x4*)(COS + (size_t)pos * 128 + j0 + 4 * n), s = *(const f32x4*)(SIN + (size_t)pos * 128 + j0 + 4 * n);
                        const f32x4 x1 = acc[ai][0][m][n], x2 = acc[ai][1][m][n];
                        acc[ai][0][m][n] = (x1 * c - x2 * s) * sc; acc[ai][1][m][n] = (x1 * s + x2 * c) * sc;
                    }
                    *(u32x4*)(dst + (size_t)row * 1024 + h * 256 + j0) = pack8(acc[ai][0][m][0], acc[ai][0][m][1]);
                    *(u32x4*)(dst + (size_t)row * 1024 + h * 256 + 128 + j0) = pack8(acc[ai][1][m][0], acc[ai][1][m][1]);
                }
        } else {
#pragma unroll
            for (int ai = 0; ai < 2; ++ai)
#pragma unroll
                for (int m = 0; m < 4; ++m) {
                    const int row = u.pm * 256 + ai * 128 + wr * 64 + m * 16 + fr, bidx = row >> 13, pos = row & (SEQ - 1);
                    bf16* ptr = VTr + (((size_t)(bidx * RT_H * 512 + (u.pn - 8) * 256 + wc * 32 + 8 * fq)) << 13) + pos;
#pragma unroll
                    for (int bj = 0; bj < 2; ++bj) {
#pragma unroll
                        for (int n = 0; n < 2; ++n)
#pragma unroll
                            for (int e = 0; e < 4; ++e) { asm volatile("" : "+v"(ptr)); *ptr = f2bf(acc[ai][bj][m][n][e]); ptr += 8192; }
                        ptr += (size_t)120 * 8192;
                    }
                }
        }
    }
};

struct EpiG {
    static constexpr bool PERM = true, AFTER_DRAIN = false;
    bf16* OHG; bf16* ORET; bf16* GA; bf16* GB; const float* SSQP;
    DI void operator()(Acc& acc, const Unit& u, int wr, int wc, int fr, int fq) const {
        const int cb = wc * 32 + 8 * fq;
#pragma unroll
        for (int ai = 0; ai < 2; ++ai)
#pragma unroll
            for (int m = 0; m < 4; ++m) {
                const size_t row = (size_t)(u.pm * 256 + ai * 128 + wr * 64 + m * 16 + fr);
#pragma unroll
                for (int bj = 0; bj < 2; ++bj) {
                    f32x4 a0 = acc[ai][bj][m][0], a1 = acc[ai][bj][m][1];
                    if (u.pn < 12) {
                        bf16* p; float rs = 1.f;
                        if (u.pn < 4) p = OHG + row * 1024 + u.pn * 256 + bj * 128 + cb;
                        else { const int c = (u.pn - 4) * 256 + bj * 128 + cb, h = c >> 9; p = ORET + row * 2048 + c;
                               rs = rsqrtf((SSQP[row * 8 + h * 2] + SSQP[row * 8 + h * 2 + 1]) * (1.f / 512.f) + EPS); }
                        const u32x4 o = *(const u32x4*)p;
#pragma unroll
                        for (int e = 0; e < 4; ++e) { a0[e] = siluf_(a0[e]) * rs; a1[e] = siluf_(a1[e]) * rs; }
                        a0[0] *= bflo(o.x); a0[1] *= bfhi(o.x); a0[2] *= bflo(o.y); a0[3] *= bfhi(o.y);
                        a1[0] *= bflo(o.z); a1[1] *= bfhi(o.z); a1[2] *= bflo(o.w); a1[3] *= bfhi(o.w);
                        *(u32x4*)p = pack8(a0, a1);
                    } else {
                        bf16* p = (u.pn < 16 ? GA + row * 1024 + (u.pn - 12) * 256 : GB + row * 1024 + (u.pn - 16) * 256) + bj * 128 + cb;
#pragma unroll
                        for (int e = 0; e < 4; ++e) { a0[e] = sigmoidf_(a0[e]); a1[e] = sigmoidf_(a1[e]); }
                        *(u32x4*)p = pack8(a0, a1);
                    }
                }
            }
    }
};

struct EpiM1 {
    static constexpr bool PERM = true, AFTER_DRAIN = false;
    float* M1; const bf16* GA;
    DI void operator()(Acc& acc, const Unit& u, int wr, int wc, int fr, int fq) const {
        const int cb = u.pn * 256 + wc * 32 + 8 * fq;
#pragma unroll
        for (int ai = 0; ai < 2; ++ai)
#pragma unroll
            for (int m = 0; m < 4; ++m) {
                const size_t row = (size_t)(u.pm * 256 + ai * 128 + wr * 64 + m * 16 + fr);
#pragma unroll
                for (int bj = 0; bj < 2; ++bj) {
                    const u32x4 g = *(const u32x4*)(GA + row * 1024 + cb + bj * 128);
                    f32x4 a0 = acc[ai][bj][m][0], a1 = acc[ai][bj][m][1];
                    a0[0] *= bflo(g.x); a0[1] *= bfhi(g.x); a0[2] *= bflo(g.y); a0[3] *= bfhi(g.y);
                    a1[0] *= bflo(g.z); a1[1] *= bfhi(g.z); a1[2] *= bflo(g.w); a1[3] *= bfhi(g.w);
                    float* p = M1 + row * 1024 + cb + bj * 128;
                    *(f32x4*)p = a0; *(f32x4*)(p + 4) = a1;
                }
            }
    }
};
struct EpiMerge {
    static constexpr bool PERM = true, AFTER_DRAIN = false;
    const float* M1; const bf16* GB; bf16* MERGED;
    DI void operator()(Acc& acc, const Unit& u, int wr, int wc, int fr, int fq) const {
        const int cb = u.pn * 256 + wc * 32 + 8 * fq;
#pragma unroll
        for (int ai = 0; ai < 2; ++ai)
#pragma unroll
            for (int m = 0; m < 4; ++m) {
                const size_t row = (size_t)(u.pm * 256 + ai * 128 + wr * 64 + m * 16 + fr);
#pragma unroll
                for (int bj = 0; bj < 2; ++bj) {
                    const u32x4 g = *(const u32x4*)(GB + row * 1024 + cb + bj * 128);
                    const float* p = M1 + row * 1024 + cb + bj * 128;
                    f32x4 a0 = acc[ai][bj][m][0], a1 = acc[ai][bj][m][1];
                    const f32x4 m0 = *(const f32x4*)p, m1 = *(const f32x4*)(p + 4);
                    a0[0] = a0[0] * bflo(g.x) + m0[0]; a0[1] = a0[1] * bfhi(g.x) + m0[1]; a0[2] = a0[2] * bflo(g.y) + m0[2]; a0[3] = a0[3] * bfhi(g.y) + m0[3];
                    a1[0] = a1[0] * bflo(g.z) + m1[0]; a1[1] = a1[1] * bfhi(g.z) + m1[1]; a1[2] = a1[2] * bflo(g.w) + m1[2]; a1[3] = a1[3] * bfhi(g.w) + m1[3];
                    *(u32x4*)(MERGED + row * 1024 + cb + bj * 128) = pack8(a0, a1);
                }
            }
    }
};
struct EpiOut {
    static constexpr bool PERM = true, AFTER_DRAIN = false;
    const float* X; float* X1; bf16* XW; const float* nw; float* SSQX;
    DI void operator()(Acc& acc, const Unit& u, int wr, int wc, int fr, int fq) const {
        const int cb = u.pn * 256 + wc * 32 + 8 * fq;
#pragma unroll
        for (int ai = 0; ai < 2; ++ai)
#pragma unroll
            for (int m = 0; m < 4; ++m) {
                const size_t row = (size_t)(u.pm * 256 + ai * 128 + wr * 64 + m * 16 + fr);
                float ss = 0.f;
#pragma unroll
                for (int bj = 0; bj < 2; ++bj) {
                    const size_t off = row * 1024 + cb + bj * 128;
                    const f32x4 x0 = *(const f32x4*)(X + off), x1v = *(const f32x4*)(X + off + 4);
                    const f32x4 w0 = *(const f32x4*)(nw + cb + bj * 128), w1 = *(const f32x4*)(nw + cb + bj * 128 + 4);
                    const f32x4 a0 = acc[ai][bj][m][0] + x0, a1 = acc[ai][bj][m][1] + x1v;
                    *(f32x4*)(X1 + off) = a0; *(f32x4*)(X1 + off + 4) = a1;
                    ss += (a0[0] * a0[0] + a0[1] * a0[1]) + (a0[2] * a0[2] + a0[3] * a0[3]) + (a1[0] * a1[0] + a1[1] * a1[1]) + (a1[2] * a1[2] + a1[3] * a1[3]);
                    *(u32x4*)(XW + off) = pack8(a0 * w0, a1 * w1);
                }
                ss += __shfl_xor(ss, 16); ss += __shfl_xor(ss, 32);
                if (fq == 0) SSQX[row * 16 + u.pn * 4 + wc] = ss;
            }
    }
};
DI float rstd_x1(const float* SSQX, size_t row) {
    const f32x4 a = *(const f32x4*)(SSQX + row * 16), b = *(const f32x4*)(SSQX + row * 16 + 4), c = *(const f32x4*)(SSQX + row * 16 + 8), d = *(const f32x4*)(SSQX + row * 16 + 12);
    const float s = ((a[0] + a[1]) + (a[2] + a[3])) + ((b[0] + b[1]) + (b[2] + b[3])) + ((c[0] + c[1]) + (c[2] + c[3])) + ((d[0] + d[1]) + (d[2] + d[3]));
    return rsqrtf(s * (1.f / 1024.f) + EPS);
}
struct EpiQ {
    static constexpr bool PERM = true, AFTER_DRAIN = false;
    bf16* Q; const float* SSQX;
    DI void operator()(Acc& acc, const Unit& u, int wr, int wc, int fr, int fq) const {
        const int cb = u.pn * 256 + wc * 32 + 8 * fq;
#pragma unroll
        for (int ai = 0; ai < 2; ++ai)
#pragma unroll
            for (int m = 0; m < 4; ++m) {
                const size_t row = (size_t)(u.pm * 256 + ai * 128 + wr * 64 + m * 16 + fr);
                const float rs = rstd_x1(SSQX, row);
#pragma unroll
                for (int bj = 0; bj < 2; ++bj) *(u32x4*)(Q + row * 2048 + cb + bj * 128) = pack8(acc[ai][bj][m][0] * rs, acc[ai][bj][m][1] * rs);
            }
    }
};

#define MFMA32(a, b, c) __builtin_amdgcn_mfma_f32_32x32x16_bf16((a), (b), (c), 0, 0, 0)
DI bf16x8 ldg16(const bf16* p) { return *(const bf16x8*)p; }
DI bf16x8 ldg2x8(const bf16* p0, const bf16* p1) { const s16x4 a = *(const s16x4*)p0, b = *(const s16x4*)p1; return __builtin_shufflevector(a, b, 0, 1, 2, 3, 4, 5, 6, 7); }
DI bf16x8 packx(const f32x16& x, int s) {
    u32x4 p; p.x = pk2(x[8 * s + 0], x[8 * s + 1]); p.y = pk2(x[8 * s + 2], x[8 * s + 3]); p.z = pk2(x[8 * s + 4], x[8 * s + 5]); p.w = pk2(x[8 * s + 6], x[8 * s + 7]);
    return __builtin_bit_cast(bf16x8, p);
}
DI f32x16 zero16() { f32x16 z;
#pragma unroll
    for (int i = 0; i < 16; ++i) z[i] = 0.f; return z; }

DI bf16x8 tr_frag(const LAS unsigned char* tile, int RS, int lane, int ks, int c) {
    const int hh = lane >> 5, blk = (lane >> 4) & 1, q = (lane & 15) >> 2, p = lane & 3;
    const LAS unsigned char* a0 = tile + (16 * ks + 8 * hh + q) * RS + (32 * c + 16 * blk + 4 * p) * 2;
    const s16x4 lo = __builtin_amdgcn_ds_read_tr16_b64_v4i16((LAS s16x4*)a0);
    const s16x4 hi = __builtin_amdgcn_ds_read_tr16_b64_v4i16((LAS s16x4*)(a0 + 4 * RS));
    return __builtin_shufflevector(lo, hi, 0, 1, 2, 3, 4, 5, 6, 7);
}

constexpr int HG_KRS = 320;
DI void hg_pass1(LAS unsigned char* lds, const bf16* Kh, const bf16* VTh, bf16* STh, int wg, int nwg) {
    const int tid = fresh_tid(), lane = tid & 63, w = __builtin_amdgcn_readfirstlane(tid >> 6), r = lane & 31, hh = lane >> 5;
    for (int unit = wg; unit < 16 * HG_NC; unit += nwg) {
        const int bh = unit >> 7, c = unit & 127, b = bh >> 3, h = bh & 7;
        __syncthreads();
        {
            const int row = tid >> 3, ch = tid & 7;
            const bf16* src = Kh + ((size_t)(b * SEQ + c * 64 + row)) * 1024 + h * 128;
            const bf16x8 v0 = ldg16(src + ch * 8), v1 = ldg16(src + 64 + ch * 8);
            *(LAS bf16x8*)(lds + row * HG_KRS + ch * 16) = v0; *(LAS bf16x8*)(lds + row * HG_KRS + 128 + ch * 16) = v1;
        }
        __syncthreads();
        const int mt = w & 3, nt0 = w >> 2;
        f32x16 a0 = zero16(), a1 = zero16();
        const bf16* vrow = VTh + (((size_t)(bh * 128 + 32 * mt + r)) << 13) + c * 64;
#pragma unroll
        for (int ks = 0; ks < 4; ++ks) {
            const bf16x8 av = ldg16(vrow + 16 * ks + 8 * hh);
            a0 = MFMA32(av, tr_frag(lds, HG_KRS, lane, ks, nt0), a0);
            a1 = MFMA32(av, tr_frag(lds, HG_KRS, lane, ks, nt0 + 2), a1);
        }
        bf16* dst = STh + ((size_t)(bh * HG_NC + c)) * 16384;
#pragma unroll
        for (int i = 0; i < 16; ++i) {
            const int v = 32 * mt + crow(i, hh);
            dst[v * 128 + 32 * nt0 + r] = f2bf(a0[i]); dst[v * 128 + 32 * (nt0 + 2) + r] = f2bf(a1[i]);
        }
    }
    __syncthreads();
}

DI void hg_scan(bf16* STh, const float* DEC, int gtid, int gsz) {
    for (int idx = gtid; idx < 16 * 128 * 32; idx += gsz) {
        const int dq = idx & 31, v = (idx >> 5) & 127, bh = idx >> 12;
        f32x4 carry = {0.f, 0.f, 0.f, 0.f};
        bf16* p = STh + ((size_t)bh * HG_NC) * 16384 + v * 128 + dq * 4;
        const float* dp = DEC + ((size_t)bh * HG_NC) * 128 + dq * 4;
#pragma unroll 8
        for (int c = 0; c < HG_NC; ++c) {
            const u32x2 wv = *(const u32x2*)(p + (size_t)c * 16384);
            const f32x4 dec = *(const f32x4*)(dp + c * 128);
            u32x2 o; o.x = pk2(carry[0], carry[1]); o.y = pk2(carry[2], carry[3]);
            *(u32x2*)(p + (size_t)c * 16384) = o;
            carry[0] = dec[0] * (carry[0] + bflo(wv.x)); carry[1] = dec[1] * (carry[1] + bfhi(wv.x));
            carry[2] = dec[2] * (carry[2] + bflo(wv.y)); carry[3] = dec[3] * (carry[3] + bfhi(wv.y));
        }
    }
}
DI void rt_scan(bf16* STr, int gtid, int gsz) {
    for (int idx = gtid; idx < 8 * 512 * 32; idx += gsz) {
        const int dq = idx & 31, v = (idx >> 5) & 511, bh = idx >> 14, h = bh & 3;
        const float dec = exp2f((float)RT_L * __log2f(1.f - exp2f(-5.f - (float)h)));
        float carry[8];
#pragma unroll
        for (int e = 0; e < 8; ++e) carry[e] = 0.f;
        bf16* p = STr + ((size_t)bh * RT_NS) * 131072 + v * 256 + dq * 8;
#pragma unroll 4
        for (int c = 0; c < RT_NS; ++c) {
            const u32x4 wv = *(const u32x4*)(p + (size_t)c * 131072);
            u32x4 o; o.x = pk2(carry[0], carry[1]); o.y = pk2(carry[2], carry[3]); o.z = pk2(carry[4], carry[5]); o.w = pk2(carry[6], carry[7]);
            *(u32x4*)(p + (size_t)c * 131072) = o;
            if (c == RT_NS - 1) break;
            carry[0] = dec * (carry[0] + bflo(wv.x)); carry[1] = dec * (carry[1] + bfhi(wv.x));
            carry[2] = dec * (carry[2] + bflo(wv.y)); carry[3] = dec * (carry[3] + bfhi(wv.y));
            carry[4] = dec * (carry[4] + bflo(wv.z)); carry[5] = dec * (carry[5] + bfhi(wv.z));
            carry[6] = dec * (carry[6] + bflo(wv.w)); carry[7] = dec * (carry[7] + bfhi(wv.w));
        }
    }
}

DI void hg_pass3(const bf16* Qh, const bf16* Kh, const bf16* VTh, const bf16* STh, const float* hg_norm_w, bf16* OHG, int gw, int ngw) {
    const int lane = fresh_tid() & 63, r = lane & 31, hh = lane >> 5;
    for (int unit = gw; unit < 16 * HG_NC * 2; unit += ngw) {
        const int tb = unit & 1, c = (unit >> 1) & 127, bh = unit >> 8, b = bh >> 3, h = bh & 7;
        const size_t trow = (size_t)(b * SEQ + c * 64 + tb * 32 + r);
        bf16x8 qf[8];
#pragma unroll
        for (int kk = 0; kk < 8; ++kk) qf[kk] = ldg16(Qh + trow * 1024 + h * 128 + kk * 16 + 8 * hh);
        f32x16 acc[4];
#pragma unroll
        for (int nv = 0; nv < 4; ++nv) acc[nv] = zero16();
        for (int sb = 0; sb <= tb; ++sb) {
            const size_t srow = (size_t)(b * SEQ + c * 64 + sb * 32 + r);
            f32x16 x = zero16();
#pragma unroll
            for (int kk = 0; kk < 8; ++kk) x = MFMA32(ldg16(Kh + srow * 1024 + h * 128 + kk * 16 + 8 * hh), qf[kk], x);
            if (sb == tb) {
#pragma unroll
                for (int i = 0; i < 16; ++i) if (crow(i, hh) > r) x[i] = 0.f;
            }
            const bf16x8 xs0 = packx(x, 0), xs1 = packx(x, 1);
#pragma unroll
            for (int nv = 0; nv < 4; ++nv) {
                const bf16* vb = VTh + (((size_t)(bh * 128 + nv * 32 + r)) << 13) + c * 64 + sb * 32 + 4 * hh;
                acc[nv] = MFMA32(ldg2x8(vb, vb + 8), xs0, acc[nv]);
                acc[nv] = MFMA32(ldg2x8(vb + 16, vb + 24), xs1, acc[nv]);
            }
        }
        const bf16* st = STh + ((size_t)(bh * HG_NC + c)) * 16384;
#pragma unroll
        for (int nv = 0; nv < 4; ++nv)
#pragma unroll
            for (int kk = 0; kk < 8; ++kk) acc[nv] = MFMA32(ldg16(st + (nv * 32 + r) * 128 + kk * 16 + 8 * hh), qf[kk], acc[nv]);
        float ss = 0.f;
#pragma unroll
        for (int nv = 0; nv < 4; ++nv)
#pragma unroll
            for (int i = 0; i < 16; ++i) ss += acc[nv][i] * acc[nv][i];
        ss += __shfl_xor(ss, 32);
        const float rs = rsqrtf(ss * (1.f / 128.f) + EPS);
#pragma unroll
        for (int nv = 0; nv < 4; ++nv)
#pragma unroll
            for (int g = 0; g < 4; ++g) {
                const int v = nv * 32 + 8 * g + 4 * hh;
                const f32x4 wv = *(const f32x4*)(hg_norm_w + h * 128 + v);
                u32x2 o; o.x = pk2(acc[nv][4 * g] * rs * wv[0], acc[nv][4 * g + 1] * rs * wv[1]); o.y = pk2(acc[nv][4 * g + 2] * rs * wv[2], acc[nv][4 * g + 3] * rs * wv[3]);
                *(u32x2*)(OHG + trow * 1024 + h * 128 + v) = o;
            }
    }
}

constexpr int RT_KRS = 576;
constexpr int RT_KBUF = 64 * RT_KRS;
DI void rt_pass1(LAS unsigned char* lds, const bf16* Kr, const bf16* VTr, bf16* STr, int wg, int nwg) {
    const int tid = fresh_tid(), lane = tid & 63, w = __builtin_amdgcn_readfirstlane(tid >> 6), r = lane & 31, hh = lane >> 5;
    const int wm = w & 3, wn = w >> 2;
    const int srow = tid >> 3, sch = tid & 7;
    for (int unit = wg; unit < 8 * (RT_NS - 1) * 2; unit += nwg) {
        const int vh = unit & 1, sg = (unit >> 1) % (RT_NS - 1), bh = (unit >> 1) / (RT_NS - 1), b = bh >> 2, h = bh & 3;
        f32x16 acc[2][4];
#pragma unroll
        for (int i = 0; i < 2; ++i)
#pragma unroll
            for (int j = 0; j < 4; ++j) acc[i][j] = zero16();
        const bf16* kbase = Kr + ((size_t)(b * SEQ + sg * RT_L)) * 1024 + h * 256;
        bf16x8 st[4];
#pragma unroll
        for (int i = 0; i < 4; ++i) st[i] = ldg16(kbase + (size_t)srow * 1024 + (sch + 8 * i) * 8);
        __syncthreads();
#pragma unroll
        for (int i = 0; i < 4; ++i) *(LAS bf16x8*)(lds + srow * RT_KRS + (sch + 8 * i) * 16) = st[i];
        for (int sb = 0; sb < RT_L / 64; ++sb) {
            const LAS unsigned char* cur = lds + (sb & 1) * RT_KBUF;
            if (sb + 1 < RT_L / 64) {
#pragma unroll
                for (int i = 0; i < 4; ++i) st[i] = ldg16(kbase + (size_t)((sb + 1) * 64 + srow) * 1024 + (sch + 8 * i) * 8);
            }
            __syncthreads();
#pragma unroll
            for (int ks = 0; ks < 4; ++ks) {
                bf16x8 av[2];
#pragma unroll
                for (int i = 0; i < 2; ++i) av[i] = ldg16(VTr + (((size_t)(bh * 512 + vh * 256 + wm * 64 + i * 32 + r)) << 13) + sg * RT_L + sb * 64 + 16 * ks + 8 * hh);
#pragma unroll
                for (int j = 0; j < 4; ++j) {
                    const bf16x8 bv = tr_frag(cur, RT_KRS, lane, ks, wn * 4 + j);
                    acc[0][j] = MFMA32(av[0], bv, acc[0][j]); acc[1][j] = MFMA32(av[1], bv, acc[1][j]);
                }
                __builtin_amdgcn_sched_barrier(0);
            }
            if (sb + 1 < RT_L / 64) {
                LAS unsigned char* nxt = lds + ((sb + 1) & 1) * RT_KBUF;
#pragma unroll
                for (int i = 0; i < 4; ++i) *(LAS bf16x8*)(nxt + srow * RT_KRS + (sch + 8 * i) * 16) = st[i];
            }
        }
        bf16* dst = STr + ((size_t)(bh * RT_NS + sg)) * 131072;
#pragma unroll
        for (int i = 0; i < 2; ++i)
#pragma unroll
            for (int j = 0; j < 4; ++j)
#pragma unroll
                for (int e = 0; e < 16; ++e) dst[(vh * 256 + wm * 64 + i * 32 + crow(e, hh)) * 256 + wn * 128 + j * 32 + r] = f2bf(acc[i][j][e]);
    }
    __syncthreads();
}

DI void rt_pass3_unit(const bf16* Qr, const bf16* Kr, const bf16* VTr, const bf16* STr, bf16* ORET, float* SSQP, int idx, int lane) {
    const int r = lane & 31, hh = lane >> 5;
    const int vh = idx & 1, tbl = (idx >> 1) & 15, sgid = idx >> 5, sg = sgid & 15, bh = sgid >> 4, b = bh >> 2, h = bh & 3;
    const int t0 = sg * RT_L + tbl * 32;
    const size_t trow = (size_t)(b * SEQ + t0 + r);
    const bf16* qrow = Qr + trow * 1024 + h * 256 + 8 * hh;
    f32x16 acc[8];
#pragma unroll
    for (int nv = 0; nv < 8; ++nv) acc[nv] = zero16();
    for (int sb = 0; sb <= tbl; ++sb) {
        const int s0 = sg * RT_L + sb * 32;
        const bf16* krow = Kr + ((size_t)(b * SEQ + s0 + r)) * 1024 + h * 256 + 8 * hh;
        f32x16 x = zero16();
#pragma unroll
        for (int k4 = 0; k4 < 4; ++k4) {
            bf16x8 kf[4], qf[4];
#pragma unroll
            for (int i = 0; i < 4; ++i) { kf[i] = ldg16(krow + (k4 * 4 + i) * 16); qf[i] = ldg16(qrow + (k4 * 4 + i) * 16); }
#pragma unroll
            for (int i = 0; i < 4; ++i) x = MFMA32(kf[i], qf[i], x);
            __builtin_amdgcn_sched_barrier(0);
        }
        if (sb == tbl) {
#pragma unroll
            for (int i = 0; i < 16; ++i) if (crow(i, hh) > r) x[i] = 0.f;
        }
        const bf16x8 xs0 = packx(x, 0), xs1 = packx(x, 1);
#pragma unroll
        for (int nv = 0; nv < 8; ++nv) {
            const bf16* vb = VTr + (((size_t)(bh * 512 + vh * 256 + nv * 32 + r)) << 13) + s0 + 4 * hh;
            acc[nv] = MFMA32(ldg2x8(vb, vb + 8), xs0, acc[nv]);
            acc[nv] = MFMA32(ldg2x8(vb + 16, vb + 24), xs1, acc[nv]);
            if ((nv & 3) == 3) __builtin_amdgcn_sched_barrier(0);
        }
    }
    const bf16* st = STr + ((size_t)(bh * RT_NS + sg)) * 131072 + (size_t)(vh * 256) * 256;
#pragma unroll 2
    for (int kk = 0; kk < 16; ++kk) {
        const bf16x8 q = ldg16(qrow + kk * 16);
#pragma unroll
        for (int nv = 0; nv < 8; ++nv) acc[nv] = MFMA32(ldg16(st + (nv * 32 + r) * 256 + kk * 16 + 8 * hh), q, acc[nv]);
        __builtin_amdgcn_sched_barrier(0);
    }
    float ss = 0.f;
#pragma unroll
    for (int nv = 0; nv < 8; ++nv)
#pragma unroll
        for (int i = 0; i < 16; ++i) ss += acc[nv][i] * acc[nv][i];
    ss += __shfl_xor(ss, 32);
    if (hh == 0) SSQP[trow * 8 + h * 2 + vh] = ss;
#pragma unroll
    for (int nv = 0; nv < 8; ++nv)
#pragma unroll
        for (int g = 0; g < 4; ++g) {
            const int v = vh * 256 + nv * 32 + 8 * g + 4 * hh;
            u32x2 o; o.x = pk2(acc[nv][4 * g], acc[nv][4 * g + 1]); o.y = pk2(acc[nv][4 * g + 2], acc[nv][4 * g + 3]);
            *(u32x2*)(ORET + trow * 2048 + h * 512 + v) = o;
        }
}
DI void rt_pass3(const bf16* Qr, const bf16* Kr, const bf16* VTr, const bf16* STr, bf16* ORET, float* SSQP, int gw, int ngw) {
    const int lane = fresh_tid() & 63;
    for (int u = gw; u < 2048; u += ngw) {
        rt_pass3_unit(Qr, Kr, VTr, STr, ORET, SSQP, u, lane);
        const int p = (u & 1) | ((15 - ((u >> 1) & 15)) << 1) | (((u >> 5) + 64) << 5);
        rt_pass3_unit(Qr, Kr, VTr, STr, ORET, SSQP, p, lane);
    }
}

DI float dot2bf(unsigned a, unsigned b, float c) {
#if __has_builtin(__builtin_amdgcn_fdot2_f32_bf16)
    typedef __bf16 nb2 __attribute__((ext_vector_type(2)));
    return __builtin_amdgcn_fdot2_f32_bf16(__builtin_bit_cast(nb2, a), __builtin_bit_cast(nb2, b), c, false);
#else
    return c + bflo(a) * bflo(b) + bfhi(a) * bfhi(b);
#endif
}
DI void wave_argmax(float& v, int& idx) {
#pragma unroll
    for (int o = 1; o < 64; o <<= 1) {
        const float ov = __shfl_xor(v, o); const int oi = __shfl_xor(idx, o);
        if (ov > v || (ov == v && oi < idx)) { v = ov; idx = oi; }
    }
}

DI void peer_topk1(const bf16* Q, const bf16* SK, float* TOPS, int* TOPI, int wg, int nwg) {
    const int tid = fresh_tid(), lane = tid & 63, w = __builtin_amdgcn_readfirstlane(tid >> 6);
    for (int unit = wg; unit < 16 * 16; unit += nwg) {
        const int hp = unit & 15, tblk = unit >> 4;
        unsigned k0[64], k1[64];
        {
            const u32x4* p0 = (const u32x4*)(SK + ((size_t)(hp * 128 + lane)) * 128);
            const u32x4* p1 = (const u32x4*)(SK + ((size_t)(hp * 128 + 64 + lane)) * 128);
#pragma unroll
            for (int i = 0; i < 16; ++i) { const u32x4 a = p0[i], b = p1[i]; k0[4 * i] = a.x; k0[4 * i + 1] = a.y; k0[4 * i + 2] = a.z; k0[4 * i + 3] = a.w; k1[4 * i] = b.x; k1[4 * i + 1] = b.y; k1[4 * i + 2] = b.z; k1[4 * i + 3] = b.w; }
        }
        for (int tt = 0; tt < 128; ++tt) {
            const int t = tblk * 1024 + w * 128 + tt;
            const u32x4* qp = (const u32x4*)(Q + (size_t)t * 2048 + hp * 128);
            float s0 = 0.f, s1 = 0.f;
#pragma unroll
            for (int i = 0; i < 16; ++i) {
                const u32x4 qv = qp[i];
                s0 = dot2bf(k0[4 * i], qv.x, s0); s0 = dot2bf(k0[4 * i + 1], qv.y, s0); s0 = dot2bf(k0[4 * i + 2], qv.z, s0); s0 = dot2bf(k0[4 * i + 3], qv.w, s0);
                s1 = dot2bf(k1[4 * i], qv.x, s1); s1 = dot2bf(k1[4 * i + 1], qv.y, s1); s1 = dot2bf(k1[4 * i + 2], qv.z, s1); s1 = dot2bf(k1[4 * i + 3], qv.w, s1);
            }
            float myv = 0.f; int myi = 0;
            for (int rnd = 0; rnd < 16; ++rnd) {
                float v; int idx;
                if (s0 >= s1) { v = s0; idx = lane; } else { v = s1; idx = lane + 64; }
                wave_argmax(v, idx);
                if (idx == lane) s0 = -3.0e38f;
                if (idx == lane + 64) s1 = -3.0e38f;
                if (lane == rnd) { myv = v; myi = idx; }
            }
            if (lane < 16) { TOPS[((size_t)t * 16 + hp) * 16 + lane] = myv; TOPI[((size_t)t * 16 + hp) * 16 + lane] = myi; }
        }
    }
}

DI void peer_cand(const float* TOPS, const int* TOPI, int* EIDX, float* EGATE, int gw, int ngw) {
    const int lane = fresh_tid() & 63;
    for (int unit = gw; unit < T * PE_H; unit += ngw) {
        const int t = unit >> 3, h = unit & 7;
        const float* s1p = TOPS + ((size_t)t * 16 + h * 2) * 16;
        const int i1 = lane >> 2, j0 = (lane & 3) * 4;
        const float a = s1p[i1];
        const f32x4 bq = *(const f32x4*)(s1p + 16 + j0);
        float c0 = a + bq[0], c1 = a + bq[1], c2 = a + bq[2], c3 = a + bq[3];
        float myv = 0.f; int myc = 0;
        for (int rnd = 0; rnd < 16; ++rnd) {
            float v = c0; int idx = 4 * lane;
            if (c1 > v) { v = c1; idx = 4 * lane + 1; }
            if (c2 > v) { v = c2; idx = 4 * lane + 2; }
            if (c3 > v) { v = c3; idx = 4 * lane + 3; }
            wave_argmax(v, idx);
            if (idx == 4 * lane) c0 = -3.0e38f;
            if (idx == 4 * lane + 1) c1 = -3.0e38f;
            if (idx == 4 * lane + 2) c2 = -3.0e38f;
            if (idx == 4 * lane + 3) c3 = -3.0e38f;
            if (lane == rnd) { myv = v; myc = idx; }
        }
        const float mx = __shfl(myv, 0);
        float ex = lane < 16 ? __expf(myv - mx) : 0.f;
        float sum = ex;
#pragma unroll
        for (int o = 1; o < 16; o <<= 1) sum += __shfl_xor(sum, o);
        if (lane < 16) {
            const int ci = myc >> 4, cj = myc & 15;
            const int e = TOPI[((size_t)t * 16 + h * 2) * 16 + ci] * PE_NK + TOPI[((size_t)t * 16 + h * 2 + 1) * 16 + cj];
            EIDX[(size_t)t * 128 + h * 16 + lane] = e;
            EGATE[(size_t)t * 128 + h * 16 + lane] = ex / sum;
        }
    }
}


DI unsigned key_pack(float s, unsigned lowbits, unsigned mask) {
    unsigned u = __float_as_uint(s); u = (u & 0x80000000u) ? ~u : (u | 0x80000000u);
    return (u & ~mask) | lowbits;
}
DI float key_val(unsigned k, unsigned mask) { unsigned u = k & ~mask; u = (u & 0x80000000u) ? (u & 0x7fffffffu) : ~u; return __uint_as_float(u); }
DI unsigned umin_(unsigned a, unsigned b) { return a < b ? a : b; }
DI unsigned umax_(unsigned a, unsigned b) { return a > b ? a : b; }
DI void ins16(unsigned (&t)[16], unsigned x) {
#pragma unroll
    for (int i = 15; i >= 1; --i) t[i] = umax_(umin_(t[i - 1], t[i]), umin_(umax_(t[i - 1], t[i]), x));
    t[0] = umax_(t[0], x);
}
DI void peer_retrieve(LAS unsigned char* lds, const bf16* Q, const bf16* SK, int* EIDX, float* EGATE, int gw, int ngw) {
    const int tid = fresh_tid(), lane = tid & 63, w = __builtin_amdgcn_readfirstlane(tid >> 6), r = lane & 31, hh = lane >> 5;
    LAS unsigned char* myl = lds + w * 2304 + lane * 36;
    for (int unit = gw; unit < (T / 32) * PE_H; unit += ngw) {
        const int h = unit & 7, tb = unit >> 3;
        const size_t trow = (size_t)(tb * 32 + r);
        unsigned L[2][16];
#pragma unroll
        for (int p = 0; p < 2; ++p) {
            f32x16 acc[4];
#pragma unroll
            for (int mt = 0; mt < 4; ++mt) acc[mt] = zero16();
            const bf16* qrow = Q + trow * 2048 + h * 256 + p * 128 + 8 * hh;
            const bf16* krow = SK + ((size_t)((h * 2 + p) * 128 + r)) * 128 + 8 * hh;
            asm volatile("" : "+v"(krow), "+v"(qrow));
#pragma unroll
            for (int kk = 0; kk < 8; ++kk) {
                const bf16x8 qf = ldg16(qrow + kk * 16);
#pragma unroll
                for (int mt = 0; mt < 4; ++mt) acc[mt] = MFMA32(ldg16(krow + mt * 32 * 128 + kk * 16), qf, acc[mt]);
                if (kk & 1) __builtin_amdgcn_sched_barrier(0);
            }
            unsigned t[16];
#pragma unroll
            for (int i = 0; i < 16; ++i) t[i] = 0u;
#pragma unroll
            for (int mt = 0; mt < 4; ++mt)
#pragma unroll
                for (int i = 0; i < 16; ++i) ins16(t, key_pack(acc[mt][i], (unsigned)(127 - 32 * mt - (i & 3) - 8 * (i >> 2)) - 4u * (unsigned)hh, 127u));
            unsigned o[16];
#pragma unroll
            for (int i = 0; i < 16; ++i) o[i] = (unsigned)__shfl_xor((int)t[i], 32);
#pragma unroll
            for (int i = 0; i < 16; ++i) ins16(t, o[i]);
#pragma unroll
            for (int i = 0; i < 16; ++i) L[p][i] = t[i];
        }
#pragma unroll
        for (int p = 0; p < 2; ++p)
#pragma unroll
            for (int g = 0; g < 4; ++g) {
                const unsigned v = (127u - (L[p][4 * g] & 127u)) | ((127u - (L[p][4 * g + 1] & 127u)) << 8) | ((127u - (L[p][4 * g + 2] & 127u)) << 16) | ((127u - (L[p][4 * g + 3] & 127u)) << 24);
                *(LAS unsigned*)(myl + p * 16 + g * 4) = v;
            }
        float a[16], b[16];
#pragma unroll
        for (int i = 0; i < 16; ++i) { a[i] = key_val(L[0][i], 127u); b[i] = key_val(L[1][i], 127u); }
        unsigned c[16];
#pragma unroll
        for (int i = 0; i < 16; ++i) c[i] = 0u;
#pragma unroll
        for (int i = 0; i < 16; ++i)
#pragma unroll
            for (int j = 0; j < 16; ++j)
                if ((i + 1) * (j + 1) <= 16) ins16(c, key_pack(a[i] + b[j], (unsigned)(255 - (16 * i + j)), 255u));
        float v[16];
        float sum = 0.f;
        const float mx = key_val(c[0], 255u);
#pragma unroll
        for (int k = 0; k < 16; ++k) { v[k] = __expf(key_val(c[k], 255u) - mx); sum += v[k]; }
        const float inv = 1.f / sum;
        asm volatile("s_waitcnt lgkmcnt(0)" ::: "memory");
        if (hh == 0) {
            int e[16];
#pragma unroll
            for (int k = 0; k < 16; ++k) {
                const unsigned cc = 255u - (c[k] & 255u);
                const unsigned i1 = *(LAS unsigned char*)(myl + (cc >> 4)), i2 = *(LAS unsigned char*)(myl + 16 + (cc & 15u));
                e[k] = (int)(i1 * 128u + i2);
            }
            int* ep = EIDX + trow * 128 + h * 16;
#pragma unroll
            for (int g = 0; g < 4; ++g) *(u32x4*)(ep + 4 * g) = (u32x4){(unsigned)e[4 * g], (unsigned)e[4 * g + 1], (unsigned)e[4 * g + 2], (unsigned)e[4 * g + 3]};
        } else {
            float* gp = EGATE + trow * 128 + h * 16;
#pragma unroll
            for (int g = 0; g < 4; ++g) *(f32x4*)(gp + 4 * g) = (f32x4){v[4 * g] * inv, v[4 * g + 1] * inv, v[4 * g + 2] * inv, v[4 * g + 3] * inv};
        }
        asm volatile("s_waitcnt lgkmcnt(0)" ::: "memory");
    }
}

DI float gelu_tanh(float x) {
    const float u = 0.7978845608028654f * (x + 0.044715f * x * x * x);
    const float e = __expf(2.f * u);
    const float th = 1.f - 2.f / (e + 1.f);
    return 0.5f * x * (1.f + th);
}

DI float bcast_f(float v, int j) { return __int_as_float(__builtin_amdgcn_readfirstlane(__float_as_int(__shfl(v, j)))); }
DI void peer_experts(const bf16* XW, const float* SSQX, const float* X1, const bf16* EU, const bf16* EV, const int* EIDX, const float* EGATE,
                     const float* fw, float* OUT, int gw, int ngw) {
    const int lane = fresh_tid() & 63;
#define PE_LOAD(dst_a, dst_b, TAB, jg_) do { _Pragma("unroll") for (int k = 0; k < 8; ++k) { \
        const int e_ = __builtin_amdgcn_readfirstlane((jg_) < 64 ? __shfl(e0, ((jg_) + k) & 63) : __shfl(e1, ((jg_) + k) & 63)); \
        const u32x4* p_ = (const u32x4*)(TAB + (size_t)e_ * 1024 + lane * 16); dst_a[k] = p_[0]; dst_b[k] = p_[1]; } } while (0)
    for (int t = gw; t < T; t += ngw) {
        const float rs = rstd_x1(SSQX, (size_t)t);
        const u32x4 xa = *(const u32x4*)(XW + (size_t)t * 1024 + lane * 16), xb = *(const u32x4*)(XW + (size_t)t * 1024 + lane * 16 + 8);
        const int e0 = EIDX[(size_t)t * 128 + lane], e1 = EIDX[(size_t)t * 128 + 64 + lane];
        const float g0 = EGATE[(size_t)t * 128 + lane], g1 = EGATE[(size_t)t * 128 + 64 + lane];
        float w0 = 0.f, w1 = 0.f;
        u32x4 ua[8], ub[8], na[8], nb[8];
        PE_LOAD(ua, ub, EU, 0);
#pragma unroll 1
        for (int jg = 0; jg < 128; jg += 8) {
            if (jg + 8 < 128) PE_LOAD(na, nb, EU, jg + 8); else PE_LOAD(na, nb, EV, 0);
#pragma unroll
            for (int k = 0; k < 8; ++k) {
                const int j = jg + k;
                float s = 0.f;
                s = dot2bf(ua[k].x, xa.x, s); s = dot2bf(ua[k].y, xa.y, s); s = dot2bf(ua[k].z, xa.z, s); s = dot2bf(ua[k].w, xa.w, s);
                s = dot2bf(ub[k].x, xb.x, s); s = dot2bf(ub[k].y, xb.y, s); s = dot2bf(ub[k].z, xb.z, s); s = dot2bf(ub[k].w, xb.w, s);
                s = wave_sum(s);
                const float act = gelu_tanh(s * rs);
                if (jg < 64) { if (lane == j) w0 = g0 * act; } else { if (lane == j - 64) w1 = g1 * act; }
            }
#pragma unroll
            for (int k = 0; k < 8; ++k) { ua[k] = na[k]; ub[k] = nb[k]; }
        }
        float o[16];
#pragma unroll
        for (int i = 0; i < 16; ++i) o[i] = 0.f;
#pragma unroll 1
        for (int jg = 0; jg < 128; jg += 8) {
            if (jg + 8 < 128) PE_LOAD(na, nb, EV, jg + 8);
#pragma unroll
            for (int k = 0; k < 8; ++k) {
                const float q = jg < 64 ? bcast_f(w0, (jg + k) & 63) : bcast_f(w1, (jg + k) & 63);
                o[0] += q * bflo(ua[k].x); o[1] += q * bfhi(ua[k].x); o[2] += q * bflo(ua[k].y); o[3] += q * bfhi(ua[k].y);
                o[4] += q * bflo(ua[k].z); o[5] += q * bfhi(ua[k].z); o[6] += q * bflo(ua[k].w); o[7] += q * bfhi(ua[k].w);
                o[8] += q * bflo(ub[k].x); o[9] += q * bfhi(ub[k].x); o[10] += q * bflo(ub[k].y); o[11] += q * bfhi(ub[k].y);
                o[12] += q * bflo(ub[k].z); o[13] += q * bfhi(ub[k].z); o[14] += q * bflo(ub[k].w); o[15] += q * bfhi(ub[k].w);
            }
#pragma unroll
            for (int k = 0; k < 8; ++k) { ua[k] = na[k]; ub[k] = nb[k]; }
        }
        const float* xp = X1 + (size_t)t * 1024 + lane * 16;
        float ss = 0.f;
#pragma unroll
        for (int i = 0; i < 4; ++i) { const f32x4 xv = *(const f32x4*)(xp + 4 * i);
#pragma unroll
            for (int e = 0; e < 4; ++e) { o[4 * i + e] += xv[e]; ss += o[4 * i + e] * o[4 * i + e]; } }
        ss = wave_sum(ss);
        const float rf = rsqrtf(ss * (1.f / 1024.f) + EPS);
#pragma unroll
        for (int i = 0; i < 4; ++i) { const f32x4 wv = *(const f32x4*)(fw + lane * 16 + 4 * i);
            *(f32x4*)(OUT + (size_t)t * 1024 + lane * 16 + 4 * i) = (f32x4){o[4 * i] * rf * wv[0], o[4 * i + 1] * rf * wv[1], o[4 * i + 2] * rf * wv[2], o[4 * i + 3] * rf * wv[3]}; }
    }
#undef PE_LOAD
}

DI void transpose_item(const float* W, int K, int N, bf16* WT, int n_src0, int n_dst0, int k0, LAS float* scr, int lane) {
#pragma unroll 8
    for (int i = 0; i < 32; ++i) { const int kk = 2 * i + (lane >> 5); scr[kk * 33 + (lane & 31)] = W[(size_t)(k0 + kk) * N + n_src0 + (lane & 31)]; }
    asm volatile("s_waitcnt lgkmcnt(0)" ::: "memory");
    const int c = lane & 7;
#pragma unroll
    for (int j = 0; j < 4; ++j) { const int n = (lane >> 3) + 8 * j; const LAS float* s = scr + (8 * c) * 33 + n;
        u32x4 o; o.x = pk2(s[0 * 33], s[1 * 33]); o.y = pk2(s[2 * 33], s[3 * 33]); o.z = pk2(s[4 * 33], s[5 * 33]); o.w = pk2(s[6 * 33], s[7 * 33]);
        *(u32x4*)(WT + (size_t)(n_dst0 + n) * K + k0 + 8 * c) = o; }
    asm volatile("s_waitcnt lgkmcnt(0)" ::: "memory");
}
DI int win_orig_col(int np) {
    if (np < 2048) { const int h = np >> 8, sel = (np >> 7) & 1, d = np & 127; return sel * 1024 + h * 128 + d; }
    if (np < 3072) return np;
    if (np < 7168) return np + 1024;
    if (np < 8192) return np - 4096;
    return np;
}
DI void rmsnorm_row_bf16(const float* xrow, const float* w, bf16* orow, int lane) {
    const f32x4* xr = (const f32x4*)xrow + lane; const f32x4* wr4 = (const f32x4*)w + lane;
    f32x4 v[4]; float s = 0.f;
#pragma unroll
    for (int j = 0; j < 4; ++j) { v[j] = xr[64 * j]; s += (v[j][0] * v[j][0] + v[j][1] * v[j][1]) + (v[j][2] * v[j][2] + v[j][3] * v[j][3]); }
    const float rs = rsqrtf(wave_sum(s) * (1.f / 1024.f) + EPS);
    u32x2* o8 = (u32x2*)orow + lane;
#pragma unroll
    for (int j = 0; j < 4; ++j) { const f32x4 ww = wr4[64 * j]; u32x2 o; o.x = pk2(v[j][0] * rs * ww[0], v[j][1] * rs * ww[1]); o.y = pk2(v[j][2] * rs * ww[2], v[j][3] * rs * ww[3]); o8[64 * j] = o; }
}
DI void convert_bf16(const float* src, bf16* dst, size_t n, size_t gtid, size_t gsz) {
    for (size_t i = gtid * 8; i < n; i += gsz * 8) {
        const f32x4 a = *(const f32x4*)(src + i), b = *(const f32x4*)(src + i + 4);
        *(u32x4*)(dst + i) = pack8(a, b);
    }
}

#define XB_TMO      128
#define XB_XCNT(j)  (256  + 64 * (j))
#define XB_XSUB(j)  (1280 + 64 * (j))
#define XB_XGEN(j)  (2304 + 64 * (j))
#define XB_TOP      3328
#define XB_TOPGEN   3392
#define XCD_BAR_WORDS 3456
#define XB_SPIN_CAP (1u << 18)

__device__ __forceinline__ unsigned xb_ld(unsigned* p)              { return __hip_atomic_load(p, __ATOMIC_RELAXED, __HIP_MEMORY_SCOPE_AGENT); }
__device__ __forceinline__ unsigned xb_add(unsigned* p, unsigned v) { return __hip_atomic_fetch_add(p, v, __ATOMIC_RELAXED, __HIP_MEMORY_SCOPE_AGENT); }
__device__ __forceinline__ unsigned xb_xcc_id() { return (unsigned)__builtin_amdgcn_s_getreg((3 << 11) | 20) & 0xFu; }
#define XB_SPIN(cond, bar) do { unsigned _sp = 0; while (cond) { __builtin_amdgcn_s_sleep(1); \
    if ((++_sp & 255u) == 0u) { if (xb_ld(&(bar)[XB_TMO])) break; if (_sp > XB_SPIN_CAP) { atomicAdd(&(bar)[XB_TMO], 1u); break; } } } } while (0)

struct XcdBarrier {
    unsigned* bar; unsigned x;
    volatile LAS unsigned* st;
};

__device__ __forceinline__ XcdBarrier xcd_barrier_post(unsigned* bar, volatile LAS unsigned* st) {
    XcdBarrier b; b.bar = bar; b.x = xb_xcc_id(); b.st = st;
    if (threadIdx.x == 0) (void)xb_add(&bar[XB_XCNT(b.x)], 1u);
    return b;
}
__device__ __forceinline__ void xcd_barrier_complete(unsigned* bar, unsigned x, unsigned& nloc, unsigned& nx) {
    const unsigned G = gridDim.x * gridDim.y * gridDim.z;
    unsigned sum, cnt, mine, sp = 0u;
    for (;;) {
        sum = 0u; cnt = 0u; mine = 0u;
#pragma unroll
        for (unsigned j = 0; j < 16; ++j) { const unsigned c = xb_ld(&bar[XB_XCNT(j)]); sum += c; cnt += (c > 0u) ? 1u : 0u; mine = (j == x) ? c : mine; }
        if (sum == G) break;
        __builtin_amdgcn_s_sleep(1);
        if ((++sp & 255u) == 0u) { if (xb_ld(&bar[XB_TMO])) break; if (sp > XB_SPIN_CAP) { atomicAdd(&bar[XB_TMO], 1u); break; } }
    }
    nloc = mine > 0u ? mine : 1u; nx = cnt > 0u ? cnt : 1u;
}

__device__ __forceinline__ void xcd_barrier(const XcdBarrier& b) {
    asm volatile("s_waitcnt vmcnt(0)" ::: "memory");
    __syncthreads();
    if (threadIdx.x == 0) {
        unsigned* bar = b.bar;
        __builtin_amdgcn_s_waitcnt(0);
        unsigned nloc = b.st[0], nx = b.st[1];
        if (nloc == 0u) { xcd_barrier_complete(bar, b.x, nloc, nx); b.st[0] = nloc; b.st[1] = nx; }
        const unsigned old = xb_add(&bar[XB_XSUB(b.x)], 1u);
        const unsigned gen = old / nloc;
        if (old + 1u == (gen + 1u) * nloc) {
            __builtin_amdgcn_fence(__ATOMIC_RELEASE, "agent");
            asm volatile("s_waitcnt vmcnt(0)" ::: "memory");
            const unsigned og = xb_add(&bar[XB_TOP], 1u);
            const unsigned tg = og / nx;
            if (og + 1u == (tg + 1u) * nx) xb_add(&bar[XB_TOPGEN], 1u);
            else XB_SPIN(xb_ld(&bar[XB_TOPGEN]) == tg, bar);
            __builtin_amdgcn_fence(__ATOMIC_ACQUIRE, "agent");
            xb_add(&bar[XB_XGEN(b.x)], 1u);
            asm volatile("s_waitcnt vmcnt(0)" ::: "memory");
        } else {
            XB_SPIN(xb_ld(&bar[XB_XGEN(b.x)]) == gen, bar);
            __builtin_amdgcn_fence(__ATOMIC_ACQUIRE, "agent");
            asm volatile("s_waitcnt vmcnt(0)" ::: "memory");
        }
    }
    __syncthreads();
}

struct Params { const float* in[14]; float* out; unsigned char* ws; };

__global__ void __launch_bounds__(NTHREADS, 2) fwd_megakernel(Params p) {
    extern __shared__ __attribute__((aligned(16))) unsigned char lds_raw[];
    LAS unsigned char* lds = (LAS unsigned char*)lds_raw;
    cg::grid_group grid = cg::this_grid();
    volatile LAS unsigned* bst = (volatile LAS unsigned*)(lds + LDS_BYTES - 64);
    if (threadIdx.x < 4) bst[threadIdx.x] = 0u;
    __syncthreads();
    XcdBarrier xbar = xcd_barrier_post((unsigned*)(p.ws + WS_CTL), bst);
#if USE_CG_SYNC
#define GRID_SYNC() grid.sync()
#else
#define GRID_SYNC() xcd_barrier(xbar)
#endif
    const int G = gridDim.x, wg = blockIdx.x;
#define PHASE_IDS const int tid = fresh_tid(), lane = tid & 63, wave = __builtin_amdgcn_readfirstlane(tid >> 6); \
    const int gw = wg * NWAVES + wave, ngw = G * NWAVES; const size_t gtid = (size_t)wg * NTHREADS + tid, gsz = (size_t)G * NTHREADS; \
    (void)lane; (void)gw; (void)ngw; (void)gtid; (void)gsz;
    unsigned char* ws = p.ws;
    const float* x = p.in[0];
    bf16* HN = (bf16*)(ws + WS_HN); bf16* WinT = (bf16*)(ws + WS_WINT);
    float* COS = (float*)(ws + WS_ROPE); float* SIN = COS + 8192 * 128;
    float* DEC = (float*)(ws + WS_DEC); float* SSQP = (float*)(ws + WS_SSQP); float* SSQX = (float*)(ws + WS_SSQX);
    bf16* BA = (bf16*)(ws + WS_A); bf16* BB = (bf16*)(ws + WS_B); bf16* BC = (bf16*)(ws + WS_C);
    bf16* STh = (bf16*)(ws + WS_STH); bf16* STr = (bf16*)(ws + WS_STR);
    bf16* OHG = (bf16*)(ws + WS_OHG); bf16* ORET = (bf16*)p.out;
    bf16* GA = (bf16*)(ws + WS_GA); bf16* GB = (bf16*)(ws + WS_GB);
    bf16* WhgT = (bf16*)(ws + WS_WHG); bf16* WretT = (bf16*)(ws + WS_WRET); bf16* WoutT = (bf16*)(ws + WS_WOUT); bf16* WqT = (bf16*)(ws + WS_WQ); bf16* SK = (bf16*)(ws + WS_SK);
    bf16* EV = (bf16*)(ws + WS_EV); bf16* EU = (bf16*)(ws + WS_EU);
    float* M1 = (float*)(ws + WS_M1); bf16* MERGED = (bf16*)(ws + WS_MERGED);
    float* X1 = (float*)(ws + WS_X1); bf16* XW = (bf16*)(ws + WS_XW); bf16* Qp = (bf16*)p.out;
    float* TOPS = (float*)(ws + WS_TOPS); int* TOPI = (int*)(ws + WS_TOPI); int* EIDX = (int*)(ws + WS_EIDX); float* EGATE = (float*)(ws + WS_EGATE);

    { PHASE_IDS LAS float* scr = (LAS float*)(lds + wave * 16384);
    for (int it = gw; it < 16 * 384; it += ngw) {
        const int kb = it / 384, nb = it % 384;
        transpose_item(p.in[2], 1024, 12288, WinT, win_orig_col(nb * 32), nb * 32, kb * 64, scr, lane);
    }
    for (int m = gw; m < T; m += ngw) rmsnorm_row_bf16(x + (size_t)m * 1024, p.in[1], HN + (size_t)m * 1024, lane);
    for (size_t i = gtid; i < (size_t)8192 * 128; i += gsz) {
        const int pos = (int)(i >> 7), j = (int)(i & 127);
        const float inv = (float)exp(-(double)j * (9.210340371976184 / 128.0));
        const float ang = (float)pos * inv;
        double rev = (double)ang * 0.15915494309189535; rev -= rint(rev);
        COS[i] = __builtin_amdgcn_cosf((float)rev); SIN[i] = __builtin_amdgcn_sinf((float)rev);
    } }
    grid.sync();

    {
        pg8::Gemm g{HN, WinT, T, 3072, 1024}; pg8::StaticOrder S; S.init(T, 3072, G, wg);
        EpiH E{BA, BB, BC, DEC, p.in[3]};
        pg8::gemm_phase<EpiH, pg8::StaticOrder, true, true>(lds, g, S, E);
    }
    GRID_SYNC();
    hg_pass1(lds, BB, BC, STh, wg, G);
#if PROBE_MASK & 4
    hg_pass1(lds, BB, BC, STh, wg, G);
#endif
    GRID_SYNC();
    { PHASE_IDS hg_scan(STh, DEC, (int)gtid, (int)gsz); }
    GRID_SYNC();
    { PHASE_IDS hg_pass3(BA, BB, BC, STh, p.in[4], OHG, gw, ngw); }
#if PROBE_MASK & 4
    { PHASE_IDS hg_pass3(BA, BB, BC, STh, p.in[4], OHG, gw, ngw); }
#endif
    GRID_SYNC();

    {
        pg8::Gemm g{HN, WinT + (size_t)3072 * 1024, T, 4096, 1024}; pg8::StaticOrder S; S.init(T, 4096, G, wg);
        EpiR E{BA, BB, BC, COS, SIN};
        pg8::gemm_phase<EpiR, pg8::StaticOrder, true, true>(lds, g, S, E);
    }
    GRID_SYNC();
    rt_pass1(lds, BB, BC, STr, wg, G);
#if PROBE_MASK & 8
    rt_pass1(lds, BB, BC, STr, wg, G);
#endif
    GRID_SYNC();
    { PHASE_IDS rt_scan(STr, (int)gtid, (int)gsz); }
    GRID_SYNC();
    { PHASE_IDS rt_pass3(BA, BB, BC, STr, ORET, SSQP, gw, ngw); }
#if PROBE_MASK & 8
    { PHASE_IDS rt_pass3(BA, BB, BC, STr, ORET, SSQP, gw, ngw); }
#endif
    GRID_SYNC();

    { PHASE_IDS LAS float* scr = (LAS float*)(lds + wave * 16384);
    for (int it = gw; it < 3072; it += ngw) {
        int r = it;
        if (r < 512) { transpose_item(p.in[5], 1024, 1024, WhgT, (r % 32) * 32, (r % 32) * 32, (r / 32) * 64, scr, lane); continue; } r -= 512;
        if (r < 1024) { transpose_item(p.in[6], 2048, 1024, WretT, (r % 32) * 32, (r % 32) * 32, (r / 32) * 64, scr, lane); continue; } r -= 1024;
        if (r < 512) { transpose_item(p.in[7], 1024, 1024, WoutT, (r % 32) * 32, (r % 32) * 32, (r / 32) * 64, scr, lane); continue; } r -= 512;
        transpose_item(p.in[9], 1024, 2048, WqT, (r % 64) * 32, (r % 64) * 32, (r / 64) * 64, scr, lane);
    }
    convert_bf16(p.in[10], SK, (size_t)16 * 128 * 128, gtid, gsz);
    convert_bf16(p.in[12], EV, (size_t)PE_NE * 1024, gtid, gsz); }
    __syncthreads();
    {
        pg8::Gemm g{HN, WinT + (size_t)7168 * 1024, T, 5120, 1024}; pg8::StaticOrder S; S.init(T, 5120, G, wg);
        EpiG E{OHG, ORET, GA, GB, SSQP};
        pg8::gemm_phase<EpiG, pg8::StaticOrder, true, true>(lds, g, S, E);
    }
    GRID_SYNC();

    {
        pg8::Gemm g{OHG, WhgT, T, 1024, 1024}; pg8::StaticOrder S; S.init(T, 1024, G, wg);
        EpiM1 E{M1, GA};
        pg8::gemm_phase<EpiM1, pg8::StaticOrder, false, true>(lds, g, S, E);
    }
    __syncthreads();
    {
        pg8::Gemm g{ORET, WretT, T, 1024, 2048}; pg8::StaticOrder S; S.init(T, 1024, G, wg);
        EpiMerge E{M1, GB, MERGED};
        pg8::gemm_phase<EpiMerge, pg8::StaticOrder, false, true>(lds, g, S, E);
    }
    GRID_SYNC();
    {
        pg8::Gemm g{MERGED, WoutT, T, 1024, 1024}; pg8::StaticOrder S; S.init(T, 1024, G, wg);
        EpiOut E{x, X1, XW, p.in[8], SSQX};
        pg8::gemm_phase<EpiOut, pg8::StaticOrder, false, true>(lds, g, S, E);
    }
    GRID_SYNC();
    { PHASE_IDS convert_bf16(p.in[11], EU, (size_t)PE_NE * 1024, gtid, gsz); }
    __syncthreads();
    {
        pg8::Gemm g{XW, WqT, T, 2048, 1024}; pg8::StaticOrder S; S.init(T, 2048, G, wg);
        EpiQ E{Qp, SSQX};
        pg8::gemm_phase<EpiQ, pg8::StaticOrder, true, true>(lds, g, S, E);
    }
    GRID_SYNC();
    { PHASE_IDS peer_retrieve(lds, Qp, SK, EIDX, EGATE, gw, ngw); }
#if PROBE_MASK & 2
    { PHASE_IDS peer_retrieve(lds, Qp, SK, EIDX, EGATE, gw, ngw); }
#endif
    GRID_SYNC();
    { PHASE_IDS peer_experts(XW, SSQX, X1, EU, EV, EIDX, EGATE, p.in[13], p.out, gw, ngw); }
#if PROBE_MASK & 1
    { PHASE_IDS peer_experts(XW, SSQX, X1, EU, EV, EIDX, EGATE, p.in[13], p.out, gw, ngw); }
#endif
#if PROBE_MASK & 16
    for (int i = 0; i < 15; ++i) GRID_SYNC();
#endif
}

extern "C" void kernel_launch(void* const* d_in, const int* in_sizes, int n_in, void* d_out, int out_size, void* d_ws, size_t ws_size, hipStream_t stream) {
    static int grid_blocks = 0;
    if (!grid_blocks) {
        int dev = 0, cus = 0, per_cu = 0;
        (void)hipGetDevice(&dev);
        (void)hipDeviceGetAttribute(&cus, hipDeviceAttributeMultiprocessorCount, dev);
        (void)hipFuncSetAttribute((const void*)fwd_megakernel, hipFuncAttributeMaxDynamicSharedMemorySize, LDS_BYTES);
        (void)hipOccupancyMaxActiveBlocksPerMultiprocessor(&per_cu, (const void*)fwd_megakernel, NTHREADS, LDS_BYTES);
        if (per_cu < 1) per_cu = 1;
        grid_blocks = cus * 1;
        if (ws_size < WS_END || n_in != 14) { fprintf(stderr, "kernel_launch: unexpected ws_size %zu (need %zu) or n_in %d\n", ws_size, (size_t)WS_END, n_in); }
    }
    (void)hipMemsetAsync((char*)d_ws + WS_CTL, 0, 16384, stream);
    Params p{};
    for (int i = 0; i < 14; ++i) p.in[i] = (const float*)d_in[i];
    p.out = (float*)d_out; p.ws = (unsigned char*)d_ws;
    void* args[] = {&p};
    hipError_t e = hipLaunchCooperativeKernel((const void*)fwd_megakernel, dim3(grid_blocks), dim3(NTHREADS), args, LDS_BYTES, stream);
    if (e != hipSuccess) fprintf(stderr, "cooperative launch failed: %s (grid %d)\n", hipGetErrorString(e), grid_blocks);
}
```

```cpp
#include <hip/hip_runtime.h>
#include <hip/hip_cooperative_groups.h>
#include <cstdio>
#include <cstdint>
namespace cg = cooperative_groups;
#ifndef USE_CG_SYNC
#define USE_CG_SYNC 0
#endif
#ifndef PROBE_MASK
#define PROBE_MASK 0
#endif

#define DI __device__ __forceinline__
#define LAS __attribute__((address_space(3)))
typedef unsigned short bf16;
typedef float f32x4 __attribute__((ext_vector_type(4)));
typedef float f32x2 __attribute__((ext_vector_type(2)));
typedef float f32x16 __attribute__((ext_vector_type(16)));
typedef short bf16x8 __attribute__((ext_vector_type(8)));
typedef short s16x4 __attribute__((ext_vector_type(4)));
typedef unsigned u32x4 __attribute__((ext_vector_type(4)));
typedef unsigned u32x2 __attribute__((ext_vector_type(2)));
typedef __bf16 nbf16x2 __attribute__((ext_vector_type(2)));

constexpr int D = 1024, NB = 2, SEQ = 8192, T = NB * SEQ;
constexpr int HG_H = 8, HG_DK = 128, HG_DV = 128, HG_C = 64, HG_NC = SEQ / HG_C;
constexpr int RT_H = 4, RT_DK = 256, RT_DV = 512, RT_L = 512, RT_NS = SEQ / RT_L;
constexpr int PE_H = 8, PE_NK = 128, PE_K = 16, PE_Q = 256, PE_HALF = 128, PE_NE = PE_NK * PE_NK;
constexpr float EPS = 1e-6f;
constexpr int NTHREADS = 512, NWAVES = 8;
constexpr int LDS_BYTES = 147456;

constexpr size_t MiB = 1u << 20;
constexpr size_t WS_CTL = 0;
constexpr size_t WS_DEC = 1 * MiB;
constexpr size_t WS_SSQP = 2 * MiB;
constexpr size_t WS_SCL = 2 * MiB + 512 * 1024;
constexpr size_t WS_SSQX = 3 * MiB;
constexpr size_t WS_HN = 4 * MiB;
constexpr size_t WS_WINT = 36 * MiB;
constexpr size_t WS_ROPE = 60 * MiB;
constexpr size_t WS_A = 68 * MiB, WS_B = 100 * MiB, WS_C = 132 * MiB;
constexpr size_t WS_STH = 164 * MiB;
constexpr size_t WS_STR = 196 * MiB;
constexpr size_t WS_OHG = 228 * MiB;
constexpr size_t WS_GA = 68 * MiB, WS_GB = 100 * MiB;
constexpr size_t WS_W2 = 132 * MiB;
constexpr size_t WS_WHG = WS_W2, WS_WRET = WS_W2 + 2 * MiB, WS_WOUT = WS_W2 + 6 * MiB, WS_WQ = WS_W2 + 8 * MiB, WS_SK = WS_W2 + 12 * MiB;
constexpr size_t WS_EV = 145 * MiB;
constexpr size_t WS_MERGED = 177 * MiB;
constexpr size_t WS_EU = 209 * MiB;
constexpr size_t WS_M1 = 4 * MiB;
constexpr size_t WS_X1 = 4 * MiB;
constexpr size_t WS_XW = 68 * MiB;
constexpr size_t WS_TOPS = 100 * MiB, WS_TOPI = 116 * MiB;
constexpr size_t WS_EIDX = 177 * MiB, WS_EGATE = 185 * MiB;
constexpr size_t WS_END = 260 * MiB;

DI int fresh_tid() { int t = threadIdx.x; asm volatile("" : "+v"(t)); return t; }
DI float sigmoidf_(float x) { return 1.f / (1.f + __expf(-x)); }
DI float siluf_(float x) { return x / (1.f + __expf(-x)); }
DI unsigned pk2(float lo, float hi) { f32x2 v = {lo, hi}; nbf16x2 b = __builtin_convertvector(v, nbf16x2); return __builtin_bit_cast(unsigned, b); }
DI bf16 f2bf(float f) { return (bf16)(pk2(f, 0.f) & 0xffffu); }
DI float bf2f(bf16 b) { return __uint_as_float(((unsigned)b) << 16); }
DI float bflo(unsigned u) { return __uint_as_float(u << 16); }
DI float bfhi(unsigned u) { return __uint_as_float(u & 0xffff0000u); }
DI float wave_sum(float v) {
#pragma unroll
    for (int o = 1; o < 64; o <<= 1) v += __shfl_xor(v, o);
    return v;
}
DI int crow(int reg, int h) { return (reg & 3) + 8 * (reg >> 2) + 4 * h; }

namespace pg8 {
#define PG8_LAS __attribute__((address_space(3)))
typedef unsigned short bf16_t;
typedef short bf16x8 __attribute__((ext_vector_type(8)));
typedef float f32x4 __attribute__((ext_vector_type(4)));
typedef unsigned u32x4 __attribute__((ext_vector_type(4)));
constexpr int BM = 256, BK = 64, HALF = 128, HTB = HALF * BK * 2  , STAGE_BYTES = 8 * HTB, NXCD = 8, WGM = 8;

__host__ __device__ __forceinline__ int lds_byte(int r, int c) { const int st = (r >> 4) * 2 + (c >> 5), rr = r & 15, cc = c & 31, ob = rr * 64 + cc * 2; return st * 1024 + (ob ^ (((ob >> 9) & 1) << 5)); }
__host__ __device__ __forceinline__ void stage_rc(int b, int& R, int& C) { const int st = b / 1024, sb = b % 1024, swz = sb ^ (((sb >> 9) & 1) << 5); R = (st >> 1) * 16 + swz / 64; C = (st & 1) * 32 + (swz % 64) / 2; }
__host__ __device__ __forceinline__ int perm32(int rho) { const int n = rho >> 4, i = rho & 15; return 8 * (i >> 2) + 4 * n + (i & 3); }

struct Unit { int pm, pn; };
struct Gemm { const bf16_t* A; const bf16_t* Bt; int M, N, K; };

struct StaticOrder {
    int nM, nN, nwg, G, c;
    __host__ __device__ void init(int M, int N, int G_, int c_) { nM = M / BM; nN = N / BM; nwg = nM * nN; G = G_; c = c_; }
    __host__ __device__ bool next(int i, Unit& u) const {
        const long L = (long)i * G + c; if (L >= nwg) return false;
        int wgid = (int)L; { const int q = nwg / NXCD, r = nwg % NXCD, xcd = wgid % NXCD, off = wgid / NXCD; wgid = (xcd < r ? xcd * (q + 1) : r * (q + 1) + (xcd - r) * q) + off; }
        const int nig = WGM * nN, gid = wgid / nig, fm = gid * WGM, gsz = (nM - fm) < WGM ? (nM - fm) : WGM;
        u.pm = fm + ((wgid % nig) % gsz); u.pn = (wgid % nig) / gsz; return true;
    }
    __device__ __forceinline__ void a_ready(const Unit&) const {}
    __device__ __forceinline__ void done(const Unit&) const {}
};

__device__ __forceinline__ unsigned cvt_pk_bf16(float lo, float hi) { unsigned r; asm volatile("v_cvt_pk_bf16_f32 %0, %1, %2" : "=v"(r) : "v"(lo), "v"(hi)); return r; }
typedef float f32x2 __attribute__((ext_vector_type(2)));
template <class Epi, class Sched, bool ALIGN_EPI = false, bool SP2 = false>
__device__ __forceinline__ void gemm_phase(PG8_LAS unsigned char* lds, const Gemm g, const Sched& S, const Epi& E) {
    const int tid = fresh_tid(), wid = __builtin_amdgcn_readfirstlane(tid >> 6), lane = tid & 63, wr = wid >> 2, wc = wid & 3, fr = lane & 15, fq = lane >> 4;
    const int K = g.K, nt = K / BK;
    unsigned voffA[2], voffB[2];
#pragma unroll
    for (int i = 0; i < 2; ++i) { int R, C; stage_rc(tid * 16 + i * 8192, R, C); const int Rb = Epi::PERM ? ((R & ~31) + perm32(R & 31)) : R;
        voffA[i] = (unsigned)(R * K + C) * 2u; voffB[i] = (unsigned)(Rb * K + C) * 2u; }
    const size_t kstep = (size_t)(BK * 2);
    const size_t hstep = (size_t)HALF * K * 2;
    const size_t tstep = 2 * hstep;
    const unsigned ldsw = (unsigned)wid * 1024u;
    const int aoff = lds_byte(wr * 64 + fr, fq * 8), boff = lds_byte(wc * 32 + fr, fq * 8);
#define PG8_SA(b, h) (((b) * 2 + (h)) * HTB)
#define PG8_SB(b, h) ((4 + (b) * 2 + (h)) * HTB)
#define PG8_STAGE(bufoff, gbase, voff) do { _Pragma("unroll") for (int _i = 0; _i < 2; ++_i) \
        __builtin_amdgcn_global_load_lds((const unsigned*)((const char*)(gbase) + (voff)[_i]), (PG8_LAS unsigned*)(lds + (bufoff) + ldsw + _i * 8192), 16, 0, 0); } while (0)
#define PG8_LDA(dst, b, h) do { _Pragma("unroll") for (int m = 0; m < 4; ++m) _Pragma("unroll") for (int k = 0; k < 2; ++k) dst[m][k] = *(const PG8_LAS bf16x8*)(lds + PG8_SA(b, h) + aoff + m * 2048 + k * 1024); } while (0)
#define PG8_LDB(dst, b, h) do { _Pragma("unroll") for (int n = 0; n < 2; ++n) _Pragma("unroll") for (int k = 0; k < 2; ++k) dst[n][k] = *(const PG8_LAS bf16x8*)(lds + PG8_SB(b, h) + boff + n * 2048 + k * 1024); } while (0)
#define PG8_MMA(ai, bj, At, Bt) do { __builtin_amdgcn_s_setprio(1); _Pragma("unroll") for (int m = 0; m < 4; ++m) _Pragma("unroll") for (int n = 0; n < 2; ++n) _Pragma("unroll") for (int k = 0; k < 2; ++k) \
        acc[ai][bj][m][n] = __builtin_amdgcn_mfma_f32_16x16x32_bf16(Bt[n][k], At[m][k], acc[ai][bj][m][n], 0, 0, 0); __builtin_amdgcn_s_setprio(0); } while (0)
#define PG8_WAIT_V(n) asm volatile("s_waitcnt vmcnt(" #n ")" ::: "memory")
#define PG8_WAIT_L(n) asm volatile("s_waitcnt lgkmcnt(" #n ")" ::: "memory")
#define PG8_BAR __builtin_amdgcn_s_barrier()
#define PG8_SCHED __builtin_amdgcn_sched_barrier(0)
    Unit cur, nxt; int ui = 0;
    if (!S.next(0, cur)) return;
    f32x4 acc[2][2][4][2];
#pragma unroll
    for (int a = 0; a < 2; ++a)
#pragma unroll
        for (int b = 0; b < 2; ++b)
#pragma unroll
            for (int m = 0; m < 4; ++m)
#pragma unroll
                for (int n = 0; n < 2; ++n) acc[a][b][m][n] = (f32x4){0.f, 0.f, 0.f, 0.f};
    bf16x8 At[4][2], B0[2][2], B1[2][2];
    const char* cA = (const char*)g.A + (size_t)cur.pm * tstep; const char* cB = (const char*)g.Bt + (size_t)cur.pn * tstep;
    S.a_ready(cur);
    if constexpr (SP2) {
        PG8_STAGE(PG8_SB(0, 0), cB, voffB); PG8_STAGE(PG8_SB(0, 1), cB + hstep, voffB); PG8_STAGE(PG8_SA(0, 0), cA, voffA); PG8_STAGE(PG8_SA(0, 1), cA + hstep, voffA);
        if (wr == 1) PG8_BAR;
        PG8_WAIT_V(2); PG8_BAR;
        PG8_STAGE(PG8_SB(1, 0), cB + kstep, voffB); PG8_STAGE(PG8_SA(1, 0), cA + kstep, voffA); PG8_STAGE(PG8_SB(1, 1), cB + hstep + kstep, voffB);
        PG8_WAIT_V(6); PG8_BAR;
    } else {
        PG8_STAGE(PG8_SB(0, 0), cB, voffB); PG8_STAGE(PG8_SA(0, 0), cA, voffA); PG8_STAGE(PG8_SB(0, 1), cB + hstep, voffB); PG8_STAGE(PG8_SA(0, 1), cA + hstep, voffA);
        if (wr == 1) PG8_BAR;
        PG8_WAIT_V(4); PG8_BAR;
        PG8_STAGE(PG8_SB(1, 0), cB + kstep, voffB); PG8_STAGE(PG8_SA(1, 0), cA + kstep, voffA); PG8_STAGE(PG8_SB(1, 1), cB + hstep + kstep, voffB);
        PG8_WAIT_V(6); PG8_BAR;
    }
    for (;;) {
        const bool has_next = S.next(ui + 1, nxt);
        const char* nA = has_next ? (const char*)g.A + (size_t)nxt.pm * tstep : cA; const char* nB = has_next ? (const char*)g.Bt + (size_t)nxt.pn * tstep : cB;
        for (int t = 0; t < nt; t += 2) {
            const bool last = (t == nt - 2);
            const char* a1 = cA + (size_t)(t + 1) * kstep;
            const char* a2 = last ? nA : cA + (size_t)(t + 2) * kstep; const char* b2 = last ? nB : cB + (size_t)(t + 2) * kstep;
            const char* a3 = a2 + kstep; const char* b3 = b2 + kstep;
            if (last && has_next) S.a_ready(nxt);
            if constexpr (SP2) {
            PG8_LDB(B0, 0, 0); PG8_LDB(B1, 0, 1); PG8_SCHED; PG8_LDA(At, 0, 0); PG8_STAGE(PG8_SA(1, 1), a1 + hstep, voffA);
            PG8_WAIT_V(8); PG8_WAIT_L(0); PG8_BAR; PG8_MMA(0, 0, At, B0); PG8_MMA(0, 1, At, B1); PG8_BAR; PG8_SCHED;
            PG8_LDA(At, 0, 1); PG8_STAGE(PG8_SB(0, 0), b2, voffB); PG8_STAGE(PG8_SB(0, 1), b2 + hstep, voffB); PG8_STAGE(PG8_SA(0, 0), a2, voffA);
            PG8_WAIT_V(8); PG8_WAIT_L(0); PG8_BAR; PG8_MMA(1, 0, At, B0); PG8_MMA(1, 1, At, B1); PG8_BAR; PG8_SCHED;
            PG8_LDB(B0, 1, 0); PG8_LDB(B1, 1, 1); PG8_SCHED; PG8_LDA(At, 1, 0); PG8_STAGE(PG8_SA(0, 1), a2 + hstep, voffA);
            PG8_WAIT_V(8); PG8_WAIT_L(0); PG8_BAR; PG8_MMA(0, 0, At, B0); PG8_MMA(0, 1, At, B1); PG8_BAR; PG8_SCHED;
            PG8_LDA(At, 1, 1); PG8_STAGE(PG8_SB(1, 0), b3, voffB); PG8_STAGE(PG8_SB(1, 1), b3 + hstep, voffB); PG8_STAGE(PG8_SA(1, 0), a3, voffA);
            PG8_WAIT_V(8); PG8_WAIT_L(0); PG8_BAR; PG8_MMA(1, 0, At, B0); PG8_MMA(1, 1, At, B1); PG8_BAR; PG8_SCHED;
            } else {
            PG8_LDB(B0, 0, 0); PG8_SCHED; PG8_LDA(At, 0, 0); PG8_STAGE(PG8_SA(1, 1), a1 + hstep, voffA);
            PG8_WAIT_L(8); PG8_BAR; PG8_WAIT_L(0); PG8_MMA(0, 0, At, B0); PG8_BAR; PG8_SCHED;
            PG8_LDB(B1, 0, 1); PG8_STAGE(PG8_SB(0, 0), b2, voffB);
            PG8_BAR; PG8_WAIT_L(0); PG8_MMA(0, 1, At, B1); PG8_BAR;
            PG8_LDA(At, 0, 1); PG8_STAGE(PG8_SA(0, 0), a2, voffA);
            PG8_BAR; PG8_WAIT_L(0); PG8_MMA(1, 0, At, B0); PG8_BAR; PG8_SCHED;
            PG8_STAGE(PG8_SB(0, 1), b2 + hstep, voffB);
            PG8_WAIT_V(6); PG8_BAR; PG8_MMA(1, 1, At, B1); PG8_BAR;
            PG8_LDB(B0, 1, 0); PG8_SCHED; PG8_LDA(At, 1, 0); PG8_STAGE(PG8_SA(0, 1), a2 + hstep, voffA);
            PG8_WAIT_L(8); PG8_BAR; PG8_WAIT_L(0); PG8_MMA(0, 0, At, B0); PG8_BAR; PG8_SCHED;
            PG8_LDB(B1, 1, 1); PG8_STAGE(PG8_SB(1, 0), b3, voffB);
            PG8_BAR; PG8_WAIT_L(0); PG8_MMA(0, 1, At, B1); PG8_BAR;
            PG8_LDA(At, 1, 1); PG8_STAGE(PG8_SA(1, 0), a3, voffA);
            PG8_BAR; PG8_WAIT_L(0); PG8_MMA(1, 0, At, B0); PG8_BAR; PG8_SCHED;
            PG8_STAGE(PG8_SB(1, 1), b3 + hstep, voffB);
            PG8_WAIT_V(6); PG8_BAR; PG8_MMA(1, 1, At, B1); PG8_BAR;
            }
        }
        if constexpr (ALIGN_EPI) { if (wr == 0) PG8_BAR; }
        if constexpr (!Epi::AFTER_DRAIN) { E(acc, cur, wr, wc, fr, fq); S.done(cur); }
        if (!has_next) break;
#pragma unroll
        for (int a = 0; a < 2; ++a)
#pragma unroll
            for (int b = 0; b < 2; ++b)
#pragma unroll
                for (int m = 0; m < 4; ++m)
#pragma unroll
                    for (int n = 0; n < 2; ++n) acc[a][b][m][n] = (f32x4){0.f, 0.f, 0.f, 0.f};
        cur = nxt; cA = nA; cB = nB; ++ui;
        if constexpr (ALIGN_EPI) { if (wr == 1) PG8_BAR; }
    }
    PG8_WAIT_V(0);
    if constexpr (!ALIGN_EPI) { if (wr == 0) PG8_BAR; }
    PG8_BAR;
    if constexpr (Epi::AFTER_DRAIN) { E.fused(acc, cur, wr, wc, fr, fq, lds, wid, lane); S.done(cur); }
#undef PG8_SA
#undef PG8_SB
#undef PG8_STAGE
#undef PG8_LDA
#undef PG8_LDB
#undef PG8_MMA
#undef PG8_WAIT_V
#undef PG8_WAIT_L
#undef PG8_BAR
#undef PG8_SCHED
}
}

using pg8::Unit;
typedef f32x4 Acc[2][2][4][2];

DI u32x4 pack8(const f32x4& a, const f32x4& b) { u32x4 w; w.x = pk2(a[0], a[1]); w.y = pk2(a[2], a[3]); w.z = pk2(b[0], b[1]); w.w = pk2(b[2], b[3]); return w; }

struct EpiH {
    static constexpr bool PERM = true, AFTER_DRAIN = false;
    bf16* Qh; bf16* Kh; bf16* VTh; float* DEC; const float* hlb;
    DI void operator()(Acc& acc, const Unit& u, int wr, int wc, int fr, int fq) const {
        if (u.pn < 8) {
            const int h = u.pn, dbase = wc * 32 + 8 * fq;
#pragma unroll
            for (int ai = 0; ai < 2; ++ai) {
                const int row0 = u.pm * 256 + ai * 128 + wr * 64;
                const int bidx = row0 >> 13, chunk = (row0 & (SEQ - 1)) >> 6;
#pragma unroll
                for (int n = 0; n < 2; ++n) {
                    f32x4 ebl;
#pragma unroll
                    for (int e = 0; e < 4; ++e) {
                        const int c = h * 128 + dbase + 4 * n + e;
                        const float lb = sigmoidf_(hlb[c] - hlb[1024 + c]);
                        float carry = 0.f, eb = 0.f;
#pragma unroll
                        for (int m = 0; m < 4; ++m) {
                            const float sg = sigmoidf_(acc[ai][1][m][n][e]);
                            const float f = lb + (1.f - lb) * sg;
                            const float kk = (1.f - lb) * (1.f - sg);
                            float s = __logf(f);
#pragma unroll
                            for (int dl = 1; dl < 16; dl <<= 1) { const float o = __shfl_up(s, dl, 16); if (fr >= dl) s += o; }
                            const float b = s + carry;
                            carry += __shfl(s, 15, 16);
                            eb = __expf(b);
                            acc[ai][0][m][n][e] = acc[ai][0][m][n][e] * 0.08838834764831845f * eb;
                            acc[ai][1][m][n][e] = kk * __expf(-b);
                        }
                        ebl[e] = eb;
                        __builtin_amdgcn_sched_barrier(0);
                    }
                    if (fr == 15) *(f32x4*)(DEC + ((size_t)((bidx * HG_H + h) * HG_NC + chunk)) * 128 + dbase + 4 * n) = ebl;
#pragma unroll
                    for (int m = 0; m < 4; ++m) {
                        const size_t row = (size_t)(row0 + m * 16 + fr);
                        const f32x4 qv = acc[ai][0][m][n], kv = acc[ai][1][m][n];
                        u32x2 oq, ok; oq.x = pk2(qv[0], qv[1]); oq.y = pk2(qv[2], qv[3]); ok.x = pk2(kv[0], kv[1]); ok.y = pk2(kv[2], kv[3]);
                        *(u32x2*)(Qh + row * 1024 + h * 128 + dbase + 4 * n) = oq;
                        *(u32x2*)(Kh + row * 1024 + h * 128 + dbase + 4 * n) = ok;
                    }
                    __builtin_amdgcn_sched_barrier(0);
                }
            }
        } else {
#pragma unroll
            for (int ai = 0; ai < 2; ++ai)
#pragma unroll
                for (int m = 0; m < 4; ++m) {
                    const int row = u.pm * 256 + ai * 128 + wr * 64 + m * 16 + fr, bidx = row >> 13, pos = row & (SEQ - 1);
                    bf16* ptr = VTh + (((size_t)(bidx * HG_H * 128 + (u.pn - 8) * 256 + wc * 32 + 8 * fq)) << 13) + pos;
#pragma unroll
                    for (int bj = 0; bj < 2; ++bj) {
#pragma unroll
                        for (int n = 0; n < 2; ++n)
#pragma unroll
                            for (int e = 0; e < 4; ++e) { asm volatile("" : "+v"(ptr)); *ptr = f2bf(acc[ai][bj][m][n][e]); ptr += 8192; }
                        ptr += (size_t)120 * 8192;
                    }
                }
        }
    }
};

struct EpiR {
    static constexpr bool PERM = true, AFTER_DRAIN = false;
    bf16* Qr; bf16* Kr; bf16* VTr; const float* COS; const float* SIN;
    DI void operator()(Acc& acc, const Unit& u, int wr, int wc, int fr, int fq) const {
        if (u.pn < 8) {
            const bool isk = u.pn >= 4; const int h = u.pn & 3;
            const float lg = __log2f(1.f - exp2f(-5.f - (float)h));
            bf16* dst = isk ? Kr : Qr;
            const int j0 = wc * 32 + 8 * fq;
#pragma unroll
            for (int ai = 0; ai < 2; ++ai)
#pragma unroll
                for (int m = 0; m < 4; ++m) {
                    const int row = u.pm * 256 + ai * 128 + wr * 64 + m * 16 + fr, pos = row & (SEQ - 1), il = pos & (RT_L - 1);
                    const float sc = isk ? exp2f(-lg * (float)il) * 0.0625f : exp2f(lg * (float)il);
#pragma unroll
                    for (int n = 0; n < 2; ++n) {
                        const f32x4 c = *(const f32x4*)(COS + (size_t)pos * 128 + j0 + 4 * n), s = *(const f32x4*)(SIN + (size_t)pos * 128 + j0 + 4 * n);
                        const f32x4 x1 = acc[ai][0][m][n], x2 = acc[ai][1][m][n];
                        acc[ai][0][m][n] = (x1 * c - x2 * s) * sc; acc[ai][1][m][n] = (x1 * s + x2 * c) * sc;
                    }
                    *(u32x4*)(dst + (size_t)row * 1024 + h * 256 + j0) = pack8(acc[ai][0][m][0], acc[ai][0][m][1]);
                    *(u32x4*)(dst + (size_t)row * 1024 + h * 256 + 128 + j0) = pack8(acc[ai][1][m][0], acc[ai][1][m][1]);
                }
        } else {
#pragma unroll
            for (int ai = 0; ai < 2; ++ai)
#pragma unroll
                for (int m = 0; m < 4; ++m) {
                    const int row = u.pm * 256 + ai * 128 + wr * 64 + m * 16 + fr, bidx = row >> 13, pos = row & (SEQ - 1);
                    bf16* ptr = VTr + (((size_t)(bidx * RT_H * 512 + (u.pn - 8) * 256 + wc * 32 + 8 * fq)) << 13) + pos;
#pragma unroll
                    for (int bj = 0; bj < 2; ++bj) {
#pragma unroll
                        for (int n = 0; n < 2; ++n)
#pragma unroll
                            for (int e = 0; e < 4; ++e) { asm volatile("" : "+v"(ptr)); *ptr = f2bf(acc[ai][bj][m][n][e]); ptr += 8192; }
                        ptr += (size_t)120 * 8192;
                    }
                }
        }
    }
};

struct EpiG {
    static constexpr bool PERM = true, AFTER_DRAIN = false;
    bf16* OHG; bf16* ORET; bf16* GA; bf16* GB; const float* SSQP;
    DI void operator()(Acc& acc, const Unit& u, int wr, int wc, int fr, int fq) const {
        const int cb = wc * 32 + 8 * fq;
#pragma unroll
        for (int ai = 0; ai < 2; ++ai)
#pragma unroll
            for (int m = 0; m < 4; ++m) {
                const size_t row = (size_t)(u.pm * 256 + ai * 128 + wr * 64 + m * 16 + fr);
#pragma unroll
                for (int bj = 0; bj < 2; ++bj) {
                    f32x4 a0 = acc[ai][bj][m][0], a1 = acc[ai][bj][m][1];
                    if (u.pn < 12) {
                        bf16* p; float rs = 1.f;
                        if (u.pn < 4) p = OHG + row * 1024 + u.pn * 256 + bj * 128 + cb;
                        else { const int c = (u.pn - 4) * 256 + bj * 128 + cb, h = c >> 9; p = ORET + row * 2048 + c;
                               rs = rsqrtf((SSQP[row * 8 + h * 2] + SSQP[row * 8 + h * 2 + 1]) * (1.f / 512.f) + EPS); }
                        const u32x4 o = *(const u32x4*)p;
#pragma unroll
                        for (int e = 0; e < 4; ++e) { a0[e] = siluf_(a0[e]) * rs; a1[e] = siluf_(a1[e]) * rs; }
                        a0[0] *= bflo(o.x); a0[1] *= bfhi(o.x); a0[2] *= bflo(o.y); a0[3] *= bfhi(o.y);
                        a1[0] *= bflo(o.z); a1[1] *= bfhi(o.z); a1[2] *= bflo(o.w); a1[3] *= bfhi(o.w);
                        *(u32x4*)p = pack8(a0, a1);
                    } else {
                        bf16* p = (u.pn < 16 ? GA + row * 1024 + (u.pn - 12) * 256 : GB + row * 1024 + (u.pn - 16) * 256) + bj * 128 + cb;
#pragma unroll
                        for (int e = 0; e < 4; ++e) { a0[e] = sigmoidf_(a0[e]); a1[e] = sigmoidf_(a1[e]); }
                        *(u32x4*)p = pack8(a0, a1);
                    }
                }
            }
    }
};

struct EpiM1 {
    static constexpr bool PERM = true, AFTER_DRAIN = false;
    float* M1; const bf16* GA;
    DI void operator()(Acc& acc, const Unit& u, int wr, int wc, int fr, int fq) const {
        const int cb = u.pn * 256 + wc * 32 + 8 * fq;
#pragma unroll
        for (int ai = 0; ai < 2; ++ai)
#pragma unroll
            for (int m = 0; m < 4; ++m) {
                const size_t row = (size_t)(u.pm * 256 + ai * 128 + wr * 64 + m * 16 + fr);
#pragma unroll
                for (int bj = 0; bj < 2; ++bj) {
                    const u32x4 g = *(const u32x4*)(GA + row * 1024 + cb + bj * 128);
                    f32x4 a0 = acc[ai][bj][m][0], a1 = acc[ai][bj][m][1];
                    a0[0] *= bflo(g.x); a0[1] *= bfhi(g.x); a0[2] *= bflo(g.y); a0[3] *= bfhi(g.y);
                    a1[0] *= bflo(g.z); a1[1] *= bfhi(g.z); a1[2] *= bflo(g.w); a1[3] *= bfhi(g.w);
                    float* p = M1 + row * 1024 + cb + bj * 128;
                    *(f32x4*)p = a0; *(f32x4*)(p + 4) = a1;
                }
            }
    }
};
struct EpiMerge {
    static constexpr bool PERM = true, AFTER_DRAIN = false;
    const float* M1; const bf16* GB; bf16* MERGED;
    DI void operator()(Acc& acc, const Unit& u, int wr, int wc, int fr, int fq) const {
        const int cb = u.pn * 256 + wc * 32 + 8 * fq;
#pragma unroll
        for (int ai = 0; ai < 2; ++ai)
#pragma unroll
            for (int m = 0; m < 4; ++m) {
                const size_t row = (size_t)(u.pm * 256 + ai * 128 + wr * 64 + m * 16 + fr);
#pragma unroll
                for (int bj = 0; bj < 2; ++bj) {
                    const u32x4 g = *(const u32x4*)(GB + row * 1024 + cb + bj * 128);
                    const float* p = M1 + row * 1024 + cb + bj * 128;
                    f32x4 a0 = acc[ai][bj][m][0], a1 = acc[ai][bj][m][1];
                    const f32x4 m0 = *(const f32x4*)p, m1 = *(const f32x4*)(p + 4);
                    a0[0] = a0[0] * bflo(g.x) + m0[0]; a0[1] = a0[1] * bfhi(g.x) + m0[1]; a0[2] = a0[2] * bflo(g.y) + m0[2]; a0[3] = a0[3] * bfhi(g.y) + m0[3];
                    a1[0] = a1[0] * bflo(g.z) + m1[0]; a1[1] = a1[1] * bfhi(g.z) + m1[1]; a1[2] = a1[2] * bflo(g.w) + m1[2]; a1[3] = a1[3] * bfhi(g.w) + m1[3];
                    *(u32x4*)(MERGED + row * 1024 + cb + bj * 128) = pack8(a0, a1);
                }
            }
    }
};
struct EpiOut {
    static constexpr bool PERM = true, AFTER_DRAIN = false;
    const float* X; float* X1; bf16* XW; const float* nw; float* SSQX;
    DI void operator()(Acc& acc, const Unit& u, int wr, int wc, int fr, int fq) const {
        const int cb = u.pn * 256 + wc * 32 + 8 * fq;
#pragma unroll
        for (int ai = 0; ai < 2; ++ai)
#pragma unroll
            for (int m = 0; m < 4; ++m) {
                const size_t row = (size_t)(u.pm * 256 + ai * 128 + wr * 64 + m * 16 + fr);
                float ss = 0.f;
#pragma unroll
                for (int bj = 0; bj < 2; ++bj) {
                    const size_t off = row * 1024 + cb + bj * 128;
                    const f32x4 x0 = *(const f32x4*)(X + off), x1v = *(const f32x4*)(X + off + 4);
                    const f32x4 w0 = *(const f32x4*)(nw + cb + bj * 128), w1 = *(const f32x4*)(nw + cb + bj * 128 + 4);
                    const f32x4 a0 = acc[ai][bj][m][0] + x0, a1 = acc[ai][bj][m][1] + x1v;
                    *(f32x4*)(X1 + off) = a0; *(f32x4*)(X1 + off + 4) = a1;
                    ss += (a0[0] * a0[0] + a0[1] * a0[1]) + (a0[2] * a0[2] + a0[3] * a0[3]) + (a1[0] * a1[0] + a1[1] * a1[1]) + (a1[2] * a1[2] + a1[3] * a1[3]);
                    *(u32x4*)(XW + off) = pack8(a0 * w0, a1 * w1);
                }
                ss += __shfl_xor(ss, 16); ss += __shfl_xor(ss, 32);
                if (fq == 0) SSQX[row * 16 + u.pn * 4 + wc] = ss;
            }
    }
};
DI float rstd_x1(const float* SSQX, size_t row) {
    const f32x4 a = *(const f32x4*)(SSQX + row * 16), b = *(const f32x4*)(SSQX + row * 16 + 4), c = *(const f32x4*)(SSQX + row * 16 + 8), d = *(const f32x4*)(SSQX + row * 16 + 12);
    const float s = ((a[0] + a[1]) + (a[2] + a[3])) + ((b[0] + b[1]) + (b[2] + b[3])) + ((c[0] + c[1]) + (c[2] + c[3])) + ((d[0] + d[1]) + (d[2] + d[3]));
    return rsqrtf(s * (1.f / 1024.f) + EPS);
}
struct EpiQ {
    static constexpr bool PERM = true, AFTER_DRAIN = false;
    bf16* Q; const float* SSQX;
    DI void operator()(Acc& acc, const Unit& u, int wr, int wc, int fr, int fq) const {
        const int cb = u.pn * 256 + wc * 32 + 8 * fq;
#pragma unroll
        for (int ai = 0; ai < 2; ++ai)
#pragma unroll
            for (int m = 0; m < 4; ++m) {
                const size_t row = (size_t)(u.pm * 256 + ai * 128 + wr * 64 + m * 16 + fr);
                const float rs = rstd_x1(SSQX, row);
#pragma unroll
                for (int bj = 0; bj < 2; ++bj) *(u32x4*)(Q + row * 2048 + cb + bj * 128) = pack8(acc[ai][bj][m][0] * rs, acc[ai][bj][m][1] * rs);
            }
    }
};

#define MFMA32(a, b, c) __builtin_amdgcn_mfma_f32_32x32x16_bf16((a), (b), (c), 0, 0, 0)
DI bf16x8 ldg16(const bf16* p) { return *(const bf16x8*)p; }
DI bf16x8 ldg2x8(const bf16* p0, const bf16* p1) { const s16x4 a = *(const s16x4*)p0, b = *(const s16x4*)p1; return __builtin_shufflevector(a, b, 0, 1, 2, 3, 4, 5, 6, 7); }
DI bf16x8 packx(const f32x16& x, int s) {
    u32x4 p; p.x = pk2(x[8 * s + 0], x[8 * s + 1]); p.y = pk2(x[8 * s + 2], x[8 * s + 3]); p.z = pk2(x[8 * s + 4], x[8 * s + 5]); p.w = pk2(x[8 * s + 6], x[8 * s + 7]);
    return __builtin_bit_cast(bf16x8, p);
}
DI f32x16 zero16() { f32x16 z;
#pragma unroll
    for (int i = 0; i < 16; ++i) z[i] = 0.f; return z; }

DI bf16x8 tr_frag(const LAS unsigned char* tile, int RS, int lane, int ks, int c) {
    const int hh = lane >> 5, blk = (lane >> 4) & 1, q = (lane & 15) >> 2, p = lane & 3;
    const LAS unsigned char* a0 = tile + (16 * ks + 8 * hh + q) * RS + (32 * c + 16 * blk + 4 * p) * 2;
    const s16x4 lo = __builtin_amdgcn_ds_read_tr16_b64_v4i16((LAS s16x4*)a0);
    const s16x4 hi = __builtin_amdgcn_ds_read_tr16_b64_v4i16((LAS s16x4*)(a0 + 4 * RS));
    return __builtin_shufflevector(lo, hi, 0, 1, 2, 3, 4, 5, 6, 7);
}

constexpr int HG_KRS = 320;
DI void hg_pass1(LAS unsigned char* lds, const bf16* Kh, const bf16* VTh, bf16* STh, int wg, int nwg) {
    const int tid = fresh_tid(), lane = tid & 63, w = __builtin_amdgcn_readfirstlane(tid >> 6), r = lane & 31, hh = lane >> 5;
    for (int unit = wg; unit < 16 * HG_NC; unit += nwg) {
        const int bh = unit >> 7, c = unit & 127, b = bh >> 3, h = bh & 7;
        __syncthreads();
        {
            const int row = tid >> 3, ch = tid & 7;
            const bf16* src = Kh + ((size_t)(b * SEQ + c * 64 + row)) * 1024 + h * 128;
            const bf16x8 v0 = ldg16(src + ch * 8), v1 = ldg16(src + 64 + ch * 8);
            *(LAS bf16x8*)(lds + row * HG_KRS + ch * 16) = v0; *(LAS bf16x8*)(lds + row * HG_KRS + 128 + ch * 16) = v1;
        }
        __syncthreads();
        const int mt = w & 3, nt0 = w >> 2;
        f32x16 a0 = zero16(), a1 = zero16();
        const bf16* vrow = VTh + (((size_t)(bh * 128 + 32 * mt + r)) << 13) + c * 64;
#pragma unroll
        for (int ks = 0; ks < 4; ++ks) {
            const bf16x8 av = ldg16(vrow + 16 * ks + 8 * hh);
            a0 = MFMA32(av, tr_frag(lds, HG_KRS, lane, ks, nt0), a0);
            a1 = MFMA32(av, tr_frag(lds, HG_KRS, lane, ks, nt0 + 2), a1);
        }
        bf16* dst = STh + ((size_t)(bh * HG_NC + c)) * 16384;
#pragma unroll
        for (int i = 0; i < 16; ++i) {
            const int v = 32 * mt + crow(i, hh);
            dst[v * 128 + 32 * nt0 + r] = f2bf(a0[i]); dst[v * 128 + 32 * (nt0 + 2) + r] = f2bf(a1[i]);
        }
    }
    __syncthreads();
}

DI void hg_scan(bf16* STh, const float* DEC, int gtid, int gsz) {
    for (int idx = gtid; idx < 16 * 128 * 32; idx += gsz) {
        const int dq = idx & 31, v = (idx >> 5) & 127, bh = idx >> 12;
        f32x4 carry = {0.f, 0.f, 0.f, 0.f};
        bf16* p = STh + ((size_t)bh * HG_NC) * 16384 + v * 128 + dq * 4;
        const float* dp = DEC + ((size_t)bh * HG_NC) * 128 + dq * 4;
#pragma unroll 8
        for (int c = 0; c < HG_NC; ++c) {
            const u32x2 wv = *(const u32x2*)(p + (size_t)c * 16384);
            const f32x4 dec = *(const f32x4*)(dp + c * 128);
            u32x2 o; o.x = pk2(carry[0], carry[1]); o.y = pk2(carry[2], carry[3]);
            *(u32x2*)(p + (size_t)c * 16384) = o;
            carry[0] = dec[0] * (carry[0] + bflo(wv.x)); carry[1] = dec[1] * (carry[1] + bfhi(wv.x));
            carry[2] = dec[2] * (carry[2] + bflo(wv.y)); carry[3] = dec[3] * (carry[3] + bfhi(wv.y));
        }
    }
}
DI void rt_scan(bf16* STr, int gtid, int gsz) {
    for (int idx = gtid; idx < 8 * 512 * 32; idx += gsz) {
        const int dq = idx & 31, v = (idx >> 5) & 511, bh = idx >> 14, h = bh & 3;
        const float dec = exp2f((float)RT_L * __log2f(1.f - exp2f(-5.f - (float)h)));
        float carry[8];
#pragma unroll
        for (int e = 0; e < 8; ++e) carry[e] = 0.f;
        bf16* p = STr + ((size_t)bh * RT_NS) * 131072 + v * 256 + dq * 8;
#pragma unroll 4
        for (int c = 0; c < RT_NS; ++c) {
            const u32x4 wv = *(const u32x4*)(p + (size_t)c * 131072);
            u32x4 o; o.x = pk2(carry[0], carry[1]); o.y = pk2(carry[2], carry[3]); o.z = pk2(carry[4], carry[5]); o.w = pk2(carry[6], carry[7]);
            *(u32x4*)(p + (size_t)c * 131072) = o;
            if (c == RT_NS - 1) break;
            carry[0] = dec * (carry[0] + bflo(wv.x)); carry[1] = dec * (carry[1] + bfhi(wv.x));
            carry[2] = dec * (carry[2] + bflo(wv.y)); carry[3] = dec * (carry[3] + bfhi(wv.y));
            carry[4] = dec * (carry[4] + bflo(wv.z)); carry[5] = dec * (carry[5] + bfhi(wv.z));
            carry[6] = dec * (carry[6] + bflo(wv.w)); carry[7] = dec * (carry[7] + bfhi(wv.w));
        }
    }
}

DI void hg_pass3(const bf16* Qh, const bf16* Kh, const bf16* VTh, const bf16* STh, const float* hg_norm_w, bf16* OHG, int gw, int ngw) {
    const int lane = fresh_tid() & 63, r = lane & 31, hh = lane >> 5;
    for (int unit = gw; unit < 16 * HG_NC * 2; unit += ngw) {
        const int tb = unit & 1, c = (unit >> 1) & 127, bh = unit >> 8, b = bh >> 3, h = bh & 7;
        const size_t trow = (size_t)(b * SEQ + c * 64 + tb * 32 + r);
        bf16x8 qf[8];
#pragma unroll
        for (int kk = 0; kk < 8; ++kk) qf[kk] = ldg16(Qh + trow * 1024 + h * 128 + kk * 16 + 8 * hh);
        f32x16 acc[4];
#pragma unroll
        for (int nv = 0; nv < 4; ++nv) acc[nv] = zero16();
        for (int sb = 0; sb <= tb; ++sb) {
            const size_t srow = (size_t)(b * SEQ + c * 64 + sb * 32 + r);
            f32x16 x = zero16();
#pragma unroll
            for (int kk = 0; kk < 8; ++kk) x = MFMA32(ldg16(Kh + srow * 1024 + h * 128 + kk * 16 + 8 * hh), qf[kk], x);
            if (sb == tb) {
#pragma unroll
                for (int i = 0; i < 16; ++i) if (crow(i, hh) > r) x[i] = 0.f;
            }
            const bf16x8 xs0 = packx(x, 0), xs1 = packx(x, 1);
#pragma unroll
            for (int nv = 0; nv < 4; ++nv) {
                const bf16* vb = VTh + (((size_t)(bh * 128 + nv * 32 + r)) << 13) + c * 64 + sb * 32 + 4 * hh;
                acc[nv] = MFMA32(ldg2x8(vb, vb + 8), xs0, acc[nv]);
                acc[nv] = MFMA32(ldg2x8(vb + 16, vb + 24), xs1, acc[nv]);
            }
        }
        const bf16* st = STh + ((size_t)(bh * HG_NC + c)) * 16384;
#pragma unroll
        for (int nv = 0; nv < 4; ++nv)
#pragma unroll
            for (int kk = 0; kk < 8; ++kk) acc[nv] = MFMA32(ldg16(st + (nv * 32 + r) * 128 + kk * 16 + 8 * hh), qf[kk], acc[nv]);
        float ss = 0.f;
#pragma unroll
        for (int nv = 0; nv < 4; ++nv)
#pragma unroll
            for (int i = 0; i < 16; ++i) ss += acc[nv][i] * acc[nv][i];
        ss += __shfl_xor(ss, 32);
        const float rs = rsqrtf(ss * (1.f / 128.f) + EPS);
#pragma unroll
        for (int nv = 0; nv < 4; ++nv)
#pragma unroll
            for (int g = 0; g < 4; ++g) {
                const int v = nv * 32 + 8 * g + 4 * hh;
                const f32x4 wv = *(const f32x4*)(hg_norm_w + h * 128 + v);
                u32x2 o; o.x = pk2(acc[nv][4 * g] * rs * wv[0], acc[nv][4 * g + 1] * rs * wv[1]); o.y = pk2(acc[nv][4 * g + 2] * rs * wv[2], acc[nv][4 * g + 3] * rs * wv[3]);
                *(u32x2*)(OHG + trow * 1024 + h * 128 + v) = o;
            }
    }
}

constexpr int RT_KRS = 576;
constexpr int RT_KBUF = 64 * RT_KRS;
DI void rt_pass1(LAS unsigned char* lds, const bf16* Kr, const bf16* VTr, bf16* STr, int wg, int nwg) {
    const int tid = fresh_tid(), lane = tid & 63, w = __builtin_amdgcn_readfirstlane(tid >> 6), r = lane & 31, hh = lane >> 5;
    const int wm = w & 3, wn = w >> 2;
    const int srow = tid >> 3, sch = tid & 7;
    for (int unit = wg; unit < 8 * (RT_NS - 1) * 2; unit += nwg) {
        const int vh = unit & 1, sg = (unit >> 1) % (RT_NS - 1), bh = (unit >> 1) / (RT_NS - 1), b = bh >> 2, h = bh & 3;
        f32x16 acc[2][4];
#pragma unroll
        for (int i = 0; i < 2; ++i)
#pragma unroll
            for (int j = 0; j < 4; ++j) acc[i][j] = zero16();
        const bf16* kbase = Kr + ((size_t)(b * SEQ + sg * RT_L)) * 1024 + h * 256;
        bf16x8 st[4];
#pragma unroll
        for (int i = 0; i < 4; ++i) st[i] = ldg16(kbase + (size_t)srow * 1024 + (sch + 8 * i) * 8);
        __syncthreads();
#pragma unroll
        for (int i = 0; i < 4; ++i) *(LAS bf16x8*)(lds + srow * RT_KRS + (sch + 8 * i) * 16) = st[i];
        for (int sb = 0; sb < RT_L / 64; ++sb) {
            const LAS unsigned char* cur = lds + (sb & 1) * RT_KBUF;
            if (sb + 1 < RT_L / 64) {
#pragma unroll
                for (int i = 0; i < 4; ++i) st[i] = ldg16(kbase + (size_t)((sb + 1) * 64 + srow) * 1024 + (sch + 8 * i) * 8);
            }
            __syncthreads();
#pragma unroll
            for (int ks = 0; ks < 4; ++ks) {
                bf16x8 av[2];
#pragma unroll
                for (int i = 0; i < 2; ++i) av[i] = ldg16(VTr + (((size_t)(bh * 512 + vh * 256 + wm * 64 + i * 32 + r)) << 13) + sg * RT_L + sb * 64 + 16 * ks + 8 * hh);
#pragma unroll
                for (int j = 0; j < 4; ++j) {
                    const bf16x8 bv = tr_frag(cur, RT_KRS, lane, ks, wn * 4 + j);
                    acc[0][j] = MFMA32(av[0], bv, acc[0][j]); acc[1][j] = MFMA32(av[1], bv, acc[1][j]);
                }
                __builtin_amdgcn_sched_barrier(0);
            }
            if (sb + 1 < RT_L / 64) {
                LAS unsigned char* nxt = lds + ((sb + 1) & 1) * RT_KBUF;
#pragma unroll
                for (int i = 0; i < 4; ++i) *(LAS bf16x8*)(nxt + srow * RT_KRS + (sch + 8 * i) * 16) = st[i];
            }
        }
        bf16* dst = STr + ((size_t)(bh * RT_NS + sg)) * 131072;
#pragma unroll
        for (int i = 0; i < 2; ++i)
#pragma unroll
            for (int j = 0; j < 4; ++j)
#pragma unroll
                for (int e = 0; e < 16; ++e) dst[(vh * 256 + wm * 64 + i * 32 + crow(e, hh)) * 256 + wn * 128 + j * 32 + r] = f2bf(acc[i][j][e]);
    }
    __syncthreads();
}

DI void rt_pass3_unit(const bf16* Qr, const bf16* Kr, const bf16* VTr, const bf16* STr, bf16* ORET, float* SSQP, int idx, int lane) {
    const int r = lane & 31, hh = lane >> 5;
    const int vh = idx & 1, tbl = (idx >> 1) & 15, sgid = idx >> 5, sg = sgid & 15, bh = sgid >> 4, b = bh >> 2, h = bh & 3;
    const int t0 = sg * RT_L + tbl * 32;
    const size_t trow = (size_t)(b * SEQ + t0 + r);
    const bf16* qrow = Qr + trow * 1024 + h * 256 + 8 * hh;
    f32x16 acc[8];
#pragma unroll
    for (int nv = 0; nv < 8; ++nv) acc[nv] = zero16();
    for (int sb = 0; sb <= tbl; ++sb) {
        const int s0 = sg * RT_L + sb * 32;
        const bf16* krow = Kr + ((size_t)(b * SEQ + s0 + r)) * 1024 + h * 256 + 8 * hh;
        f32x16 x = zero16();
#pragma unroll
        for (int k4 = 0; k4 < 4; ++k4) {
            bf16x8 kf[4], qf[4];
#pragma unroll
            for (int i = 0; i < 4; ++i) { kf[i] = ldg16(krow + (k4 * 4 + i) * 16); qf[i] = ldg16(qrow + (k4 * 4 + i) * 16); }
#pragma unroll
            for (int i = 0; i < 4; ++i) x = MFMA32(kf[i], qf[i], x);
            __builtin_amdgcn_sched_barrier(0);
        }
        if (sb == tbl) {
#pragma unroll
            for (int i = 0; i < 16; ++i) if (crow(i, hh) > r) x[i] = 0.f;
        }
        const bf16x8 xs0 = packx(x, 0), xs1 = packx(x, 1);
#pragma unroll
        for (int nv = 0; nv < 8; ++nv) {
            const bf16* vb = VTr + (((size_t)(bh * 512 + vh * 256 + nv * 32 + r)) << 13) + s0 + 4 * hh;
            acc[nv] = MFMA32(ldg2x8(vb, vb + 8), xs0, acc[nv]);
            acc[nv] = MFMA32(ldg2x8(vb + 16, vb + 24), xs1, acc[nv]);
            if ((nv & 3) == 3) __builtin_amdgcn_sched_barrier(0);
        }
    }
    const bf16* st = STr + ((size_t)(bh * RT_NS + sg)) * 131072 + (size_t)(vh * 256) * 256;
#pragma unroll 2
    for (int kk = 0; kk < 16; ++kk) {
        const bf16x8 q = ldg16(qrow + kk * 16);
#pragma unroll
        for (int nv = 0; nv < 8; ++nv) acc[nv] = MFMA32(ldg16(st + (nv * 32 + r) * 256 + kk * 16 + 8 * hh), q, acc[nv]);
        __builtin_amdgcn_sched_barrier(0);
    }
    float ss = 0.f;
#pragma unroll
    for (int nv = 0; nv < 8; ++nv)
#pragma unroll
        for (int i = 0; i < 16; ++i) ss += acc[nv][i] * acc[nv][i];
    ss += __shfl_xor(ss, 32);
    if (hh == 0) SSQP[trow * 8 + h * 2 + vh] = ss;
#pragma unroll
    for (int nv = 0; nv < 8; ++nv)
#pragma unroll
        for (int g = 0; g < 4; ++g) {
            const int v = vh * 256 + nv * 32 + 8 * g + 4 * hh;
            u32x2 o; o.x = pk2(acc[nv][4 * g], acc[nv][4 * g + 1]); o.y = pk2(acc[nv][4 * g + 2], acc[nv][4 * g + 3]);
            *(u32x2*)(ORET + trow * 2048 + h * 512 + v) = o;
        }
}
DI void rt_pass3(const bf16* Qr, const bf16* Kr, const bf16* VTr, const bf16* STr, bf16* ORET, float* SSQP, int gw, int ngw) {
    const int lane = fresh_tid() & 63;
    for (int u = gw; u < 2048; u += ngw) {
        rt_pass3_unit(Qr, Kr, VTr, STr, ORET, SSQP, u, lane);
        const int p = (u & 1) | ((15 - ((u >> 1) & 15)) << 1) | (((u >> 5) + 64) << 5);
        rt_pass3_unit(Qr, Kr, VTr, STr, ORET, SSQP, p, lane);
    }
}

DI float dot2bf(unsigned a, unsigned b, float c) {
#if __has_builtin(__builtin_amdgcn_fdot2_f32_bf16)
    typedef __bf16 nb2 __attribute__((ext_vector_type(2)));
    return __builtin_amdgcn_fdot2_f32_bf16(__builtin_bit_cast(nb2, a), __builtin_bit_cast(nb2, b), c, false);
#else
    return c + bflo(a) * bflo(b) + bfhi(a) * bfhi(b);
#endif
}
DI void wave_argmax(float& v, int& idx) {
#pragma unroll
    for (int o = 1; o < 64; o <<= 1) {
        const float ov = __shfl_xor(v, o); const int oi = __shfl_xor(idx, o);
        if (ov > v || (ov == v && oi < idx)) { v = ov; idx = oi; }
    }
}

DI void peer_topk1(const bf16* Q, const bf16* SK, float* TOPS, int* TOPI, int wg, int nwg) {
    const int tid = fresh_tid(), lane = tid & 63, w = __builtin_amdgcn_readfirstlane(tid >> 6);
    for (int unit = wg; unit < 16 * 16; unit += nwg) {
        const int hp = unit & 15, tblk = unit >> 4;
        unsigned k0[64], k1[64];
        {
            const u32x4* p0 = (const u32x4*)(SK + ((size_t)(hp * 128 + lane)) * 128);
            const u32x4* p1 = (const u32x4*)(SK + ((size_t)(hp * 128 + 64 + lane)) * 128);
#pragma unroll
            for (int i = 0; i < 16; ++i) { const u32x4 a = p0[i], b = p1[i]; k0[4 * i] = a.x; k0[4 * i + 1] = a.y; k0[4 * i + 2] = a.z; k0[4 * i + 3] = a.w; k1[4 * i] = b.x; k1[4 * i + 1] = b.y; k1[4 * i + 2] = b.z; k1[4 * i + 3] = b.w; }
        }
        for (int tt = 0; tt < 128; ++tt) {
            const int t = tblk * 1024 + w * 128 + tt;
            const u32x4* qp = (const u32x4*)(Q + (size_t)t * 2048 + hp * 128);
            float s0 = 0.f, s1 = 0.f;
#pragma unroll
            for (int i = 0; i < 16; ++i) {
                const u32x4 qv = qp[i];
                s0 = dot2bf(k0[4 * i], qv.x, s0); s0 = dot2bf(k0[4 * i + 1], qv.y, s0); s0 = dot2bf(k0[4 * i + 2], qv.z, s0); s0 = dot2bf(k0[4 * i + 3], qv.w, s0);
                s1 = dot2bf(k1[4 * i], qv.x, s1); s1 = dot2bf(k1[4 * i + 1], qv.y, s1); s1 = dot2bf(k1[4 * i + 2], qv.z, s1); s1 = dot2bf(k1[4 * i + 3], qv.w, s1);
            }
            float myv = 0.f; int myi = 0;
            for (int rnd = 0; rnd < 16; ++rnd) {
                float v; int idx;
                if (s0 >= s1) { v = s0; idx = lane; } else { v = s1; idx = lane + 64; }
                wave_argmax(v, idx);
                if (idx == lane) s0 = -3.0e38f;
                if (idx == lane + 64) s1 = -3.0e38f;
                if (lane == rnd) { myv = v; myi = idx; }
            }
            if (lane < 16) { TOPS[((size_t)t * 16 + hp) * 16 + lane] = myv; TOPI[((size_t)t * 16 + hp) * 16 + lane] = myi; }
        }
    }
}

DI void peer_cand(const float* TOPS, const int* TOPI, int* EIDX, float* EGATE, int gw, int ngw) {
    const int lane = fresh_tid() & 63;
    for (int unit = gw; unit < T * PE_H; unit += ngw) {
        const int t = unit >> 3, h = unit & 7;
        const float* s1p = TOPS + ((size_t)t * 16 + h * 2) * 16;
        const int i1 = lane >> 2, j0 = (lane & 3) * 4;
        const float a = s1p[i1];
        const f32x4 bq = *(const f32x4*)(s1p + 16 + j0);
        float c0 = a + bq[0], c1 = a + bq[1], c2 = a + bq[2], c3 = a + bq[3];
        float myv = 0.f; int myc = 0;
        for (int rnd = 0; rnd < 16; ++rnd) {
            float v = c0; int idx = 4 * lane;
            if (c1 > v) { v = c1; idx = 4 * lane + 1; }
            if (c2 > v) { v = c2; idx = 4 * lane + 2; }
            if (c3 > v) { v = c3; idx = 4 * lane + 3; }
            wave_argmax(v, idx);
            if (idx == 4 * lane) c0 = -3.0e38f;
            if (idx == 4 * lane + 1) c1 = -3.0e38f;
            if (idx == 4 * lane + 2) c2 = -3.0e38f;
            if (idx == 4 * lane + 3) c3 = -3.0e38f;
            if (lane == rnd) { myv = v; myc = idx; }
        }
        const float mx = __shfl(myv, 0);
        float ex = lane < 16 ? __expf(myv - mx) : 0.f;
        float sum = ex;
#pragma unroll
        for (int o = 1; o < 16; o <<= 1) sum += __shfl_xor(sum, o);
        if (lane < 16) {
            const int ci = myc >> 4, cj = myc & 15;
            const int e = TOPI[((size_t)t * 16 + h * 2) * 16 + ci] * PE_NK + TOPI[((size_t)t * 16 + h * 2 + 1) * 16 + cj];
            EIDX[(size_t)t * 128 + h * 16 + lane] = e;
            EGATE[(size_t)t * 128 + h * 16 + lane] = ex / sum;
        }
    }
}


DI unsigned key_pack(float s, unsigned lowbits, unsigned mask) {
    unsigned u = __float_as_uint(s); u = (u & 0x80000000u) ? ~u : (u | 0x80000000u);
    return (u & ~mask) | lowbits;
}
DI float key_val(unsigned k, unsigned mask) { unsigned u = k & ~mask; u = (u & 0x80000000u) ? (u & 0x7fffffffu) : ~u; return __uint_as_float(u); }
DI unsigned umin_(unsigned a, unsigned b) { return a < b ? a : b; }
DI unsigned umax_(unsigned a, unsigned b) { return a > b ? a : b; }
DI void ins16(unsigned (&t)[16], unsigned x) {
#pragma unroll
    for (int i = 15; i >= 1; --i) t[i] = umax_(umin_(t[i - 1], t[i]), umin_(umax_(t[i - 1], t[i]), x));
    t[0] = umax_(t[0], x);
}
DI void peer_retrieve(LAS unsigned char* lds, const bf16* Q, const bf16* SK, int* EIDX, float* EGATE, int gw, int ngw) {
    const int tid = fresh_tid(), lane = tid & 63, w = __builtin_amdgcn_readfirstlane(tid >> 6), r = lane & 31, hh = lane >> 5;
    LAS unsigned char* myl = lds + w * 2304 + lane * 36;
    for (int unit = gw; unit < (T / 32) * PE_H; unit += ngw) {
        const int h = unit & 7, tb = unit >> 3;
        const size_t trow = (size_t)(tb * 32 + r);
        unsigned L[2][16];
#pragma unroll
        for (int p = 0; p < 2; ++p) {
            f32x16 acc[4];
#pragma unroll
            for (int mt = 0; mt < 4; ++mt) acc[mt] = zero16();
            const bf16* qrow = Q + trow * 2048 + h * 256 + p * 128 + 8 * hh;
            const bf16* krow = SK + ((size_t)((h * 2 + p) * 128 + r)) * 128 + 8 * hh;
            asm volatile("" : "+v"(krow), "+v"(qrow));
#pragma unroll
            for (int kk = 0; kk < 8; ++kk) {
                const bf16x8 qf = ldg16(qrow + kk * 16);
#pragma unroll
                for (int mt = 0; mt < 4; ++mt) acc[mt] = MFMA32(ldg16(krow + mt * 32 * 128 + kk * 16), qf, acc[mt]);
                if (kk & 1) __builtin_amdgcn_sched_barrier(0);
            }
            unsigned t[16];
#pragma unroll
            for (int i = 0; i < 16; ++i) t[i] = 0u;
#pragma unroll
            for (int mt = 0; mt < 4; ++mt)
#pragma unroll
                for (int i = 0; i < 16; ++i) ins16(t, key_pack(acc[mt][i], (unsigned)(127 - 32 * mt - (i & 3) - 8 * (i >> 2)) - 4u * (unsigned)hh, 127u));
            unsigned o[16];
#pragma unroll
            for (int i = 0; i < 16; ++i) o[i] = (unsigned)__shfl_xor((int)t[i], 32);
#pragma unroll
            for (int i = 0; i < 16; ++i) ins16(t, o[i]);
#pragma unroll
            for (int i = 0; i < 16; ++i) L[p][i] = t[i];
        }
#pragma unroll
        for (int p = 0; p < 2; ++p)
#pragma unroll
            for (int g = 0; g < 4; ++g) {
                const unsigned v = (127u - (L[p][4 * g] & 127u)) | ((127u - (L[p][4 * g + 1] & 127u)) << 8) | ((127u - (L[p][4 * g + 2] & 127u)) << 16) | ((127u - (L[p][4 * g + 3] & 127u)) << 24);
                *(LAS unsigned*)(myl + p * 16 + g * 4) = v;
            }
        float a[16], b[16];
#pragma unroll
        for (int i = 0; i < 16; ++i) { a[i] = key_val(L[0][i], 127u); b[i] = key_val(L[1][i], 127u); }
        unsigned c[16];
#pragma unroll
        for (int i = 0; i < 16; ++i) c[i] = 0u;
#pragma unroll
        for (int i = 0; i < 16; ++i)
#pragma unroll
            for (int j = 0; j < 16; ++j)
                if ((i + 1) * (j + 1) <= 16) ins16(c, key_pack(a[i] + b[j], (unsigned)(255 - (16 * i + j)), 255u));
        float v[16];
        float sum = 0.f;
        const float mx = key_val(c[0], 255u);
#pragma unroll
        for (int k = 0; k < 16; ++k) { v[k] = __expf(key_val(c[k], 255u) - mx); sum += v[k]; }
        const float inv = 1.f / sum;
        asm volatile("s_waitcnt lgkmcnt(0)" ::: "memory");
        if (hh == 0) {
            int e[16];
#pragma unroll
            for (int k = 0; k < 16; ++k) {
                const unsigned cc = 255u - (c[k] & 255u);
                const unsigned i1 = *(LAS unsigned char*)(myl + (cc >> 4)), i2 = *(LAS unsigned char*)(myl + 16 + (cc & 15u));
                e[k] = (int)(i1 * 128u + i2);
            }
            int* ep = EIDX + trow * 128 + h * 16;
#pragma unroll
            for (int g = 0; g < 4; ++g) *(u32x4*)(ep + 4 * g) = (u32x4){(unsigned)e[4 * g], (unsigned)e[4 * g + 1], (unsigned)e[4 * g + 2], (unsigned)e[4 * g + 3]};
        } else {
            float* gp = EGATE + trow * 128 + h * 16;
#pragma unroll
            for (int g = 0; g < 4; ++g) *(f32x4*)(gp + 4 * g) = (f32x4){v[4 * g] * inv, v[4 * g + 1] * inv, v[4 * g + 2] * inv, v[4 * g + 3] * inv};
        }
        asm volatile("s_waitcnt lgkmcnt(0)" ::: "memory");
    }
}

DI float gelu_tanh(float x) {
    const float u = 0.7978845608028654f * (x + 0.044715f * x * x * x);
    const float e = __expf(2.f * u);
    const float th = 1.f - 2.f / (e + 1.f);
    return 0.5f * x * (1.f + th);
}

DI float bcast_f(float v, int j) { return __int_as_float(__builtin_amdgcn_readfirstlane(__float_as_int(__shfl(v, j)))); }
DI void quant_rows(const float* src, unsigned char* dst, float* scale, int nrows, int offs, int gw, int ngw, int lane) {
    for (int row = gw; row < nrows; row += ngw) {
        const f32x4* p = (const f32x4*)(src + (size_t)row * 1024 + lane * 16);
        f32x4 v[4]; float am = 0.f;
#pragma unroll
        for (int i = 0; i < 4; ++i) { v[i] = p[i];
#pragma unroll
            for (int e = 0; e < 4; ++e) am = fmaxf(am, fabsf(v[i][e])); }
#pragma unroll
        for (int o = 1; o < 64; o <<= 1) am = fmaxf(am, __shfl_xor(am, o));
        const float inv = am > 0.f ? 127.f / am : 0.f;
        u32x4 w;
#pragma unroll
        for (int i = 0; i < 4; ++i) {
            unsigned pk = 0u;
#pragma unroll
            for (int e = 0; e < 4; ++e) { const int q = (int)rintf(v[i][e] * inv) + offs; pk |= ((unsigned)q & 0xffu) << (8 * e); }
            w[i] = pk;
        }
        *(u32x4*)(dst + (size_t)row * 1024 + lane * 16) = w;
        if (lane == 0) scale[row] = am > 0.f ? am * (1.f / 127.f) : 0.f;
    }
}
DI int wave_sum_i(int v) {
#pragma unroll
    for (int o = 1; o < 64; o <<= 1) v += __shfl_xor(v, o);
    return v;
}
DI void peer_experts(const bf16* XW, const float* SSQX, const float* X1, const unsigned char* EU8, const float* SU, const unsigned char* EV8, const float* SV,
                     const int* EIDX, const float* EGATE, const float* fw, float* OUT, int gw, int ngw) {
    const int lane = fresh_tid() & 63;
#define PE_LOAD(dst, TAB, jg_) do { _Pragma("unroll") for (int k = 0; k < 16; ++k) { \
        const int e_ = __builtin_amdgcn_readfirstlane((jg_) < 64 ? __shfl(e0, ((jg_) + k) & 63) : __shfl(e1, ((jg_) + k) & 63)); \
        dst[k] = *(const u32x4*)(TAB + (size_t)e_ * 1024 + lane * 16); } } while (0)
    for (int t = gw; t < T; t += ngw) {
        const float rs = rstd_x1(SSQX, (size_t)t);
        const int e0 = EIDX[(size_t)t * 128 + lane], e1 = EIDX[(size_t)t * 128 + 64 + lane];
        u32x4 ua[16], na[16];
        PE_LOAD(ua, EU8, 0);
        const float g0 = EGATE[(size_t)t * 128 + lane], g1 = EGATE[(size_t)t * 128 + 64 + lane];
        const float su0 = SU[e0], su1 = SU[e1], sv0 = SV[e0], sv1 = SV[e1];
        int xq[4]; float xs;
        {
            const u32x4 xa = *(const u32x4*)(XW + (size_t)t * 1024 + lane * 16), xb = *(const u32x4*)(XW + (size_t)t * 1024 + lane * 16 + 8);
            float xf[16] = {bflo(xa.x), bfhi(xa.x), bflo(xa.y), bfhi(xa.y), bflo(xa.z), bfhi(xa.z), bflo(xa.w), bfhi(xa.w),
                            bflo(xb.x), bfhi(xb.x), bflo(xb.y), bfhi(xb.y), bflo(xb.z), bfhi(xb.z), bflo(xb.w), bfhi(xb.w)};
            float am = 0.f;
#pragma unroll
            for (int i = 0; i < 16; ++i) am = fmaxf(am, fabsf(xf[i]));
#pragma unroll
            for (int o = 1; o < 64; o <<= 1) am = fmaxf(am, __shfl_xor(am, o));
            const float inv = am > 0.f ? 127.f / am : 0.f; xs = am * (1.f / 127.f);
#pragma unroll
            for (int i = 0; i < 4; ++i) { unsigned pk = 0u;
#pragma unroll
                for (int e = 0; e < 4; ++e) pk |= ((unsigned)((int)rintf(xf[4 * i + e] * inv)) & 0xffu) << (8 * e);
                xq[i] = (int)pk; }
        }
        int d0 = 0, d1 = 0;
#pragma unroll 1
        for (int jg = 0; jg < 128; jg += 16) {
            if (jg + 16 < 128) PE_LOAD(na, EU8, jg + 16); else PE_LOAD(na, EV8, 0);
#pragma unroll
            for (int k = 0; k < 16; ++k) {
                int s = __builtin_amdgcn_sdot4((int)ua[k].x, xq[0], 0, false);
                s = __builtin_amdgcn_sdot4((int)ua[k].y, xq[1], s, false); s = __builtin_amdgcn_sdot4((int)ua[k].z, xq[2], s, false); s = __builtin_amdgcn_sdot4((int)ua[k].w, xq[3], s, false);
                s = wave_sum_i(s);
                if (jg < 64) { if (lane == jg + k) d0 = s; } else { if (lane == jg + k - 64) d1 = s; }
            }
#pragma unroll
            for (int k = 0; k < 16; ++k) ua[k] = na[k];
        }
        const float w0 = g0 * sv0 * gelu_tanh((float)d0 * (su0 * xs * rs)), w1 = g1 * sv1 * gelu_tanh((float)d1 * (su1 * xs * rs));
        float o[16]; float wsum = 0.f;
#pragma unroll
        for (int i = 0; i < 16; ++i) o[i] = 0.f;
#pragma unroll 1
        for (int jg = 0; jg < 128; jg += 16) {
            if (jg + 16 < 128) PE_LOAD(na, EV8, jg + 16);
#pragma unroll
            for (int k = 0; k < 16; ++k) {
                const float q = jg < 64 ? bcast_f(w0, (jg + k) & 63) : bcast_f(w1, (jg + k) & 63);
                wsum += q;
#pragma unroll
                for (int i = 0; i < 4; ++i) { const unsigned b = ua[k][i];
                    o[4 * i] += q * (float)(b & 0xffu); o[4 * i + 1] += q * (float)((b >> 8) & 0xffu); o[4 * i + 2] += q * (float)((b >> 16) & 0xffu); o[4 * i + 3] += q * (float)(b >> 24); }
            }
#pragma unroll
            for (int k = 0; k < 16; ++k) ua[k] = na[k];
        }
        const float* xp = X1 + (size_t)t * 1024 + lane * 16;
        float ss = 0.f;
#pragma unroll
        for (int i = 0; i < 4; ++i) { const f32x4 xv = *(const f32x4*)(xp + 4 * i);
#pragma unroll
            for (int e = 0; e < 4; ++e) { o[4 * i + e] = o[4 * i + e] - 128.f * wsum + xv[e]; ss += o[4 * i + e] * o[4 * i + e]; } }
        ss = wave_sum(ss);
        const float rf = rsqrtf(ss * (1.f / 1024.f) + EPS);
#pragma unroll
        for (int i = 0; i < 4; ++i) { const f32x4 wv = *(const f32x4*)(fw + lane * 16 + 4 * i);
            *(f32x4*)(OUT + (size_t)t * 1024 + lane * 16 + 4 * i) = (f32x4){o[4 * i] * rf * wv[0], o[4 * i + 1] * rf * wv[1], o[4 * i + 2] * rf * wv[2], o[4 * i + 3] * rf * wv[3]}; }
    }
#undef PE_LOAD
}

DI void transpose_item(const float* W, int K, int N, bf16* WT, int n_src0, int n_dst0, int k0, LAS float* scr, int lane) {
#pragma unroll 8
    for (int i = 0; i < 32; ++i) { const int kk = 2 * i + (lane >> 5); scr[kk * 33 + (lane & 31)] = W[(size_t)(k0 + kk) * N + n_src0 + (lane & 31)]; }
    asm volatile("s_waitcnt lgkmcnt(0)" ::: "memory");
    const int c = lane & 7;
#pragma unroll
    for (int j = 0; j < 4; ++j) { const int n = (lane >> 3) + 8 * j; const LAS float* s = scr + (8 * c) * 33 + n;
        u32x4 o; o.x = pk2(s[0 * 33], s[1 * 33]); o.y = pk2(s[2 * 33], s[3 * 33]); o.z = pk2(s[4 * 33], s[5 * 33]); o.w = pk2(s[6 * 33], s[7 * 33]);
        *(u32x4*)(WT + (size_t)(n_dst0 + n) * K + k0 + 8 * c) = o; }
    asm volatile("s_waitcnt lgkmcnt(0)" ::: "memory");
}
DI int win_orig_col(int np) {
    if (np < 2048) { const int h = np >> 8, sel = (np >> 7) & 1, d = np & 127; return sel * 1024 + h * 128 + d; }
    if (np < 3072) return np;
    if (np < 7168) return np + 1024;
    if (np < 8192) return np - 4096;
    return np;
}
DI void rmsnorm_row_bf16(const float* xrow, const float* w, bf16* orow, int lane) {
    const f32x4* xr = (const f32x4*)xrow + lane; const f32x4* wr4 = (const f32x4*)w + lane;
    f32x4 v[4]; float s = 0.f;
#pragma unroll
    for (int j = 0; j < 4; ++j) { v[j] = xr[64 * j]; s += (v[j][0] * v[j][0] + v[j][1] * v[j][1]) + (v[j][2] * v[j][2] + v[j][3] * v[j][3]); }
    const float rs = rsqrtf(wave_sum(s) * (1.f / 1024.f) + EPS);
    u32x2* o8 = (u32x2*)orow + lane;
#pragma unroll
    for (int j = 0; j < 4; ++j) { const f32x4 ww = wr4[64 * j]; u32x2 o; o.x = pk2(v[j][0] * rs * ww[0], v[j][1] * rs * ww[1]); o.y = pk2(v[j][2] * rs * ww[2], v[j][3] * rs * ww[3]); o8[64 * j] = o; }
}
DI void convert_bf16(const float* src, bf16* dst, size_t n, size_t gtid, size_t gsz) {
    for (size_t i = gtid * 8; i < n; i += gsz * 8) {
        const f32x4 a = *(const f32x4*)(src + i), b = *(const f32x4*)(src + i + 4);
        *(u32x4*)(dst + i) = pack8(a, b);
    }
}

#define XB_TMO      128
#define XB_XCNT(j)  (256  + 64 * (j))
#define XB_XSUB(j)  (1280 + 64 * (j))
#define XB_XGEN(j)  (2304 + 64 * (j))
#define XB_TOP      3328
#define XB_TOPGEN   3392
#define XCD_BAR_WORDS 3456
#define XB_SPIN_CAP (1u << 18)

__device__ __forceinline__ unsigned xb_ld(unsigned* p)              { return __hip_atomic_load(p, __ATOMIC_RELAXED, __HIP_MEMORY_SCOPE_AGENT); }
__device__ __forceinline__ unsigned xb_add(unsigned* p, unsigned v) { return __hip_atomic_fetch_add(p, v, __ATOMIC_RELAXED, __HIP_MEMORY_SCOPE_AGENT); }
__device__ __forceinline__ unsigned xb_xcc_id() { return (unsigned)__builtin_amdgcn_s_getreg((3 << 11) | 20) & 0xFu; }
#define XB_SPIN(cond, bar) do { unsigned _sp = 0; while (cond) { __builtin_amdgcn_s_sleep(1); \
    if ((++_sp & 255u) == 0u) { if (xb_ld(&(bar)[XB_TMO])) break; if (_sp > XB_SPIN_CAP) { atomicAdd(&(bar)[XB_TMO], 1u); break; } } } } while (0)

struct XcdBarrier {
    unsigned* bar; unsigned x;
    volatile LAS unsigned* st;
};

__device__ __forceinline__ XcdBarrier xcd_barrier_post(unsigned* bar, volatile LAS unsigned* st) {
    XcdBarrier b; b.bar = bar; b.x = xb_xcc_id(); b.st = st;
    if (threadIdx.x == 0) (void)xb_add(&bar[XB_XCNT(b.x)], 1u);
    return b;
}
__device__ __forceinline__ void xcd_barrier_complete(unsigned* bar, unsigned x, unsigned& nloc, unsigned& nx) {
    const unsigned G = gridDim.x * gridDim.y * gridDim.z;
    unsigned sum, cnt, mine, sp = 0u;
    for (;;) {
        sum = 0u; cnt = 0u; mine = 0u;
#pragma unroll
        for (unsigned j = 0; j < 16; ++j) { const unsigned c = xb_ld(&bar[XB_XCNT(j)]); sum += c; cnt += (c > 0u) ? 1u : 0u; mine = (j == x) ? c : mine; }
        if (sum == G) break;
        __builtin_amdgcn_s_sleep(1);
        if ((++sp & 255u) == 0u) { if (xb_ld(&bar[XB_TMO])) break; if (sp > XB_SPIN_CAP) { atomicAdd(&bar[XB_TMO], 1u); break; } }
    }
    nloc = mine > 0u ? mine : 1u; nx = cnt > 0u ? cnt : 1u;
}

__device__ __forceinline__ void xcd_barrier(const XcdBarrier& b) {
    asm volatile("s_waitcnt vmcnt(0)" ::: "memory");
    __syncthreads();
    if (threadIdx.x == 0) {
        unsigned* bar = b.bar;
        __builtin_amdgcn_s_waitcnt(0);
        unsigned nloc = b.st[0], nx = b.st[1];
        if (nloc == 0u) { xcd_barrier_complete(bar, b.x, nloc, nx); b.st[0] = nloc; b.st[1] = nx; }
        const unsigned old = xb_add(&bar[XB_XSUB(b.x)], 1u);
        const unsigned gen = old / nloc;
        if (old + 1u == (gen + 1u) * nloc) {
            __builtin_amdgcn_fence(__ATOMIC_RELEASE, "agent");
            asm volatile("s_waitcnt vmcnt(0)" ::: "memory");
            const unsigned og = xb_add(&bar[XB_TOP], 1u);
            const unsigned tg = og / nx;
            if (og + 1u == (tg + 1u) * nx) xb_add(&bar[XB_TOPGEN], 1u);
            else XB_SPIN(xb_ld(&bar[XB_TOPGEN]) == tg, bar);
            __builtin_amdgcn_fence(__ATOMIC_ACQUIRE, "agent");
            xb_add(&bar[XB_XGEN(b.x)], 1u);
            asm volatile("s_waitcnt vmcnt(0)" ::: "memory");
        } else {
            XB_SPIN(xb_ld(&bar[XB_XGEN(b.x)]) == gen, bar);
            __builtin_amdgcn_fence(__ATOMIC_ACQUIRE, "agent");
            asm volatile("s_waitcnt vmcnt(0)" ::: "memory");
        }
    }
    __syncthreads();
}

struct Params { const float* in[14]; float* out; unsigned char* ws; };

__global__ void __launch_bounds__(NTHREADS, 2) fwd_megakernel(Params p) {
    extern __shared__ __attribute__((aligned(16))) unsigned char lds_raw[];
    LAS unsigned char* lds = (LAS unsigned char*)lds_raw;
    cg::grid_group grid = cg::this_grid();
    volatile LAS unsigned* bst = (volatile LAS unsigned*)(lds + LDS_BYTES - 64);
    if (threadIdx.x < 4) bst[threadIdx.x] = 0u;
    __syncthreads();
    XcdBarrier xbar = xcd_barrier_post((unsigned*)(p.ws + WS_CTL), bst);
#if USE_CG_SYNC
#define GRID_SYNC() grid.sync()
#else
#define GRID_SYNC() xcd_barrier(xbar)
#endif
    const int G = gridDim.x, wg = blockIdx.x;
#define PHASE_IDS const int tid = fresh_tid(), lane = tid & 63, wave = __builtin_amdgcn_readfirstlane(tid >> 6); \
    const int gw = wg * NWAVES + wave, ngw = G * NWAVES; const size_t gtid = (size_t)wg * NTHREADS + tid, gsz = (size_t)G * NTHREADS; \
    (void)lane; (void)gw; (void)ngw; (void)gtid; (void)gsz;
    unsigned char* ws = p.ws;
    const float* x = p.in[0];
    bf16* HN = (bf16*)(ws + WS_HN); bf16* WinT = (bf16*)(ws + WS_WINT);
    float* COS = (float*)(ws + WS_ROPE); float* SIN = COS + 8192 * 128;
    float* DEC = (float*)(ws + WS_DEC); float* SSQP = (float*)(ws + WS_SSQP); float* SSQX = (float*)(ws + WS_SSQX);
    bf16* BA = (bf16*)(ws + WS_A); bf16* BB = (bf16*)(ws + WS_B); bf16* BC = (bf16*)(ws + WS_C);
    bf16* STh = (bf16*)(ws + WS_STH); bf16* STr = (bf16*)(ws + WS_STR);
    bf16* OHG = (bf16*)(ws + WS_OHG); bf16* ORET = (bf16*)p.out;
    bf16* GA = (bf16*)(ws + WS_GA); bf16* GB = (bf16*)(ws + WS_GB);
    bf16* WhgT = (bf16*)(ws + WS_WHG); bf16* WretT = (bf16*)(ws + WS_WRET); bf16* WoutT = (bf16*)(ws + WS_WOUT); bf16* WqT = (bf16*)(ws + WS_WQ); bf16* SK = (bf16*)(ws + WS_SK);
    unsigned char* EV8 = ws + WS_EV; unsigned char* EU8 = ws + WS_EU; float* SU = (float*)(ws + WS_SCL); float* SV = SU + PE_NE;
    float* M1 = (float*)(ws + WS_M1); bf16* MERGED = (bf16*)(ws + WS_MERGED);
    float* X1 = (float*)(ws + WS_X1); bf16* XW = (bf16*)(ws + WS_XW); bf16* Qp = (bf16*)p.out;
    float* TOPS = (float*)(ws + WS_TOPS); int* TOPI = (int*)(ws + WS_TOPI); int* EIDX = (int*)(ws + WS_EIDX); float* EGATE = (float*)(ws + WS_EGATE);

    for (int rep_ = 0; rep_ < ((PROBE_MASK & 32) ? 2 : 1); ++rep_) {
    { PHASE_IDS LAS float* scr = (LAS float*)(lds + wave * 16384);
    for (int it = gw; it < 16 * 384; it += ngw) {
        const int kb = it / 384, nb = it % 384;
        transpose_item(p.in[2], 1024, 12288, WinT, win_orig_col(nb * 32), nb * 32, kb * 64, scr, lane);
    }
    for (int m = gw; m < T; m += ngw) rmsnorm_row_bf16(x + (size_t)m * 1024, p.in[1], HN + (size_t)m * 1024, lane);
    for (size_t i = gtid; i < (size_t)8192 * 128; i += gsz) {
        const int pos = (int)(i >> 7), j = (int)(i & 127);
        const float inv = (float)exp(-(double)j * (9.210340371976184 / 128.0));
        const float ang = (float)pos * inv;
        double rev = (double)ang * 0.15915494309189535; rev -= rint(rev);
        COS[i] = __builtin_amdgcn_cosf((float)rev); SIN[i] = __builtin_amdgcn_sinf((float)rev);
    } }
    __syncthreads(); }
    grid.sync();

    for (int rep_ = 0; rep_ < ((PROBE_MASK & 128) ? 2 : 1); ++rep_) {
    {
        pg8::Gemm g{HN, WinT, T, 3072, 1024}; pg8::StaticOrder S; S.init(T, 3072, G, wg);
        EpiH E{BA, BB, BC, DEC, p.in[3]};
        pg8::gemm_phase<EpiH, pg8::StaticOrder, true, true>(lds, g, S, E);
    }
    __syncthreads(); }
    GRID_SYNC();
    hg_pass1(lds, BB, BC, STh, wg, G);
#if PROBE_MASK & 4
    hg_pass1(lds, BB, BC, STh, wg, G);
#endif
    GRID_SYNC();
    { PHASE_IDS hg_scan(STh, DEC, (int)gtid, (int)gsz); }
    GRID_SYNC();
    { PHASE_IDS hg_pass3(BA, BB, BC, STh, p.in[4], OHG, gw, ngw); }
#if PROBE_MASK & 4
    { PHASE_IDS hg_pass3(BA, BB, BC, STh, p.in[4], OHG, gw, ngw); }
#endif
    GRID_SYNC();

    for (int rep_ = 0; rep_ < ((PROBE_MASK & 128) ? 2 : 1); ++rep_) {
    {
        pg8::Gemm g{HN, WinT + (size_t)3072 * 1024, T, 4096, 1024}; pg8::StaticOrder S; S.init(T, 4096, G, wg);
        EpiR E{BA, BB, BC, COS, SIN};
        pg8::gemm_phase<EpiR, pg8::StaticOrder, true, true>(lds, g, S, E);
    }
    __syncthreads(); }
    GRID_SYNC();
    rt_pass1(lds, BB, BC, STr, wg, G);
#if PROBE_MASK & 8
    rt_pass1(lds, BB, BC, STr, wg, G);
#endif
    GRID_SYNC();
    { PHASE_IDS rt_scan(STr, (int)gtid, (int)gsz); }
    GRID_SYNC();
    { PHASE_IDS rt_pass3(BA, BB, BC, STr, ORET, SSQP, gw, ngw); }
#if PROBE_MASK & 8
    { PHASE_IDS rt_pass3(BA, BB, BC, STr, ORET, SSQP, gw, ngw); }
#endif
    GRID_SYNC();

    for (int rep_ = 0; rep_ < ((PROBE_MASK & 64) ? 2 : 1); ++rep_) {
    { PHASE_IDS LAS float* scr = (LAS float*)(lds + wave * 16384);
    for (int it = gw; it < 3072; it += ngw) {
        int r = it;
        if (r < 512) { transpose_item(p.in[5], 1024, 1024, WhgT, (r % 32) * 32, (r % 32) * 32, (r / 32) * 64, scr, lane); continue; } r -= 512;
        if (r < 1024) { transpose_item(p.in[6], 2048, 1024, WretT, (r % 32) * 32, (r % 32) * 32, (r / 32) * 64, scr, lane); continue; } r -= 1024;
        if (r < 512) { transpose_item(p.in[7], 1024, 1024, WoutT, (r % 32) * 32, (r % 32) * 32, (r / 32) * 64, scr, lane); continue; } r -= 512;
        transpose_item(p.in[9], 1024, 2048, WqT, (r % 64) * 32, (r % 64) * 32, (r / 64) * 64, scr, lane);
    }
    convert_bf16(p.in[10], SK, (size_t)16 * 128 * 128, gtid, gsz);
    quant_rows(p.in[12], EV8, SV, PE_NE, 128, gw, ngw, lane); }
    __syncthreads(); }
    __syncthreads();
    {
        pg8::Gemm g{HN, WinT + (size_t)7168 * 1024, T, 5120, 1024}; pg8::StaticOrder S; S.init(T, 5120, G, wg);
        EpiG E{OHG, ORET, GA, GB, SSQP};
        pg8::gemm_phase<EpiG, pg8::StaticOrder, true, true>(lds, g, S, E);
    }
    GRID_SYNC();

    for (int rep_ = 0; rep_ < ((PROBE_MASK & 256) ? 2 : 1); ++rep_) {
    {
        pg8::Gemm g{OHG, WhgT, T, 1024, 1024}; pg8::StaticOrder S; S.init(T, 1024, G, wg);
        EpiM1 E{M1, GA};
        pg8::gemm_phase<EpiM1, pg8::StaticOrder, false, true>(lds, g, S, E);
    }
    __syncthreads();
    {
        pg8::Gemm g{ORET, WretT, T, 1024, 2048}; pg8::StaticOrder S; S.init(T, 1024, G, wg);
        EpiMerge E{M1, GB, MERGED};
        pg8::gemm_phase<EpiMerge, pg8::StaticOrder, false, true>(lds, g, S, E);
    }
    __syncthreads(); }
    GRID_SYNC();
    for (int rep_ = 0; rep_ < ((PROBE_MASK & 256) ? 2 : 1); ++rep_) {
    {
        pg8::Gemm g{MERGED, WoutT, T, 1024, 1024}; pg8::StaticOrder S; S.init(T, 1024, G, wg);
        EpiOut E{x, X1, XW, p.in[8], SSQX};
        pg8::gemm_phase<EpiOut, pg8::StaticOrder, false, true>(lds, g, S, E);
    }
    __syncthreads(); }
    GRID_SYNC();
    for (int rep_ = 0; rep_ < ((PROBE_MASK & 64) ? 2 : 1); ++rep_) {
    { PHASE_IDS quant_rows(p.in[11], EU8, SU, PE_NE, 0, gw, ngw, lane); }
    __syncthreads(); }
    __syncthreads();
    for (int rep_ = 0; rep_ < ((PROBE_MASK & 256) ? 2 : 1); ++rep_) {
    {
        pg8::Gemm g{XW, WqT, T, 2048, 1024}; pg8::StaticOrder S; S.init(T, 2048, G, wg);
        EpiQ E{Qp, SSQX};
        pg8::gemm_phase<EpiQ, pg8::StaticOrder, true, true>(lds, g, S, E);
    }
    __syncthreads(); }
    GRID_SYNC();
    { PHASE_IDS peer_retrieve(lds, Qp, SK, EIDX, EGATE, gw, ngw); }
#if PROBE_MASK & 2
    { PHASE_IDS peer_retrieve(lds, Qp, SK, EIDX, EGATE, gw, ngw); }
#endif
    GRID_SYNC();
    { PHASE_IDS peer_experts(XW, SSQX, X1, EU8, SU, EV8, SV, EIDX, EGATE, p.in[13], p.out, gw, ngw); }
#if PROBE_MASK & 1
    { PHASE_IDS peer_experts(XW, SSQX, X1, EU8, SU, EV8, SV, EIDX, EGATE, p.in[13], p.out, gw, ngw); }
#endif
#if PROBE_MASK & 16
    for (int i = 0; i < 15; ++i) GRID_SYNC();
#endif
}

extern "C" void kernel_launch(void* const* d_in, const int* in_sizes, int n_in, void* d_out, int out_size, void* d_ws, size_t ws_size, hipStream_t stream) {
    static int grid_blocks = 0;
    if (!grid_blocks) {
        int dev = 0, cus = 0, per_cu = 0;
        (void)hipGetDevice(&dev);
        (void)hipDeviceGetAttribute(&cus, hipDeviceAttributeMultiprocessorCount, dev);
        (void)hipFuncSetAttribute((const void*)fwd_megakernel, hipFuncAttributeMaxDynamicSharedMemorySize, LDS_BYTES);
        (void)hipOccupancyMaxActiveBlocksPerMultiprocessor(&per_cu, (const void*)fwd_megakernel, NTHREADS, LDS_BYTES);
        if (per_cu < 1) per_cu = 1;
        grid_blocks = cus * 1;
        if (ws_size < WS_END || n_in != 14) { fprintf(stderr, "kernel_launch: unexpected ws_size %zu (need %zu) or n_in %d\n", ws_size, (size_t)WS_END, n_in); }
    }
    (void)hipMemsetAsync((char*)d_ws + WS_CTL, 0, 16384, stream);
    Params p{};
    for (int i = 0; i < 14; ++i) p.in[i] = (const float*)d_in[i];
    p.out = (float*)d_out; p.ws = (unsigned char*)d_ws;
    void* args[] = {&p};
    hipError_t e = hipLaunchCooperativeKernel((const void*)fwd_megakernel, dim3(grid_blocks), dim3(NTHREADS), args, LDS_BYTES, stream);
    if (e != hipSuccess) fprintf(stderr, "cooperative launch failed: %s (grid %d)\n", hipGetErrorString(e), grid_blocks);
}
```

```cpp
#include <hip/hip_runtime.h>
#include <hip/hip_cooperative_groups.h>
#include <cstdio>
#include <cstdint>
namespace cg = cooperative_groups;
#ifndef USE_CG_SYNC
#define USE_CG_SYNC 0
#endif
#ifndef PROBE_MASK
#define PROBE_MASK 0
#endif

#define DI __device__ __forceinline__
#define LAS __attribute__((address_space(3)))
typedef unsigned short bf16;
typedef float f32x4 __attribute__((ext_vector_type(4)));
typedef float f32x2 __attribute__((ext_vector_type(2)));
typedef float f32x16 __attribute__((ext_vector_type(16)));
typedef short bf16x8 __attribute__((ext_vector_type(8)));
typedef short s16x4 __attribute__((ext_vector_type(4)));
typedef unsigned u32x4 __attribute__((ext_vector_type(4)));
typedef unsigned u32x2 __attribute__((ext_vector_type(2)));
typedef __bf16 nbf16x2 __attribute__((ext_vector_type(2)));

constexpr int D = 1024, NB = 2, SEQ = 8192, T = NB * SEQ;
constexpr int HG_H = 8, HG_DK = 128, HG_DV = 128, HG_C = 64, HG_NC = SEQ / HG_C;
constexpr int RT_H = 4, RT_DK = 256, RT_DV = 512, RT_L = 512, RT_NS = SEQ / RT_L;
constexpr int PE_H = 8, PE_NK = 128, PE_K = 16, PE_Q = 256, PE_HALF = 128, PE_NE = PE_NK * PE_NK;
constexpr float EPS = 1e-6f;
constexpr int NTHREADS = 512, NWAVES = 8;
constexpr int LDS_BYTES = 147456;

constexpr size_t MiB = 1u << 20;
constexpr size_t WS_CTL = 0;
constexpr size_t WS_DEC = 1 * MiB;
constexpr size_t WS_SSQP = 2 * MiB;
constexpr size_t WS_SCL = 2 * MiB + 512 * 1024;
constexpr size_t WS_SSQX = 3 * MiB;
constexpr size_t WS_HN = 4 * MiB;
constexpr size_t WS_WINT = 36 * MiB;
constexpr size_t WS_ROPE = 60 * MiB;
constexpr size_t WS_A = 68 * MiB, WS_B = 100 * MiB, WS_C = 132 * MiB;
constexpr size_t WS_STH = 164 * MiB;
constexpr size_t WS_STR = 196 * MiB;
constexpr size_t WS_OHG = 228 * MiB;
constexpr size_t WS_GA = 68 * MiB, WS_GB = 100 * MiB;
constexpr size_t WS_W2 = 132 * MiB;
constexpr size_t WS_WHG = WS_W2, WS_WRET = WS_W2 + 2 * MiB, WS_WOUT = WS_W2 + 6 * MiB, WS_WQ = WS_W2 + 8 * MiB, WS_SK = WS_W2 + 12 * MiB;
constexpr size_t WS_EV = 145 * MiB;
constexpr size_t WS_MERGED = 177 * MiB;
constexpr size_t WS_EU = 209 * MiB;
constexpr size_t WS_M1 = 4 * MiB;
constexpr size_t WS_X1 = 4 * MiB;
constexpr size_t WS_XW = 68 * MiB;
constexpr size_t WS_TOPS = 100 * MiB, WS_TOPI = 116 * MiB;
constexpr size_t WS_EIDX = 177 * MiB, WS_EGATE = 185 * MiB;
constexpr size_t WS_END = 260 * MiB;

DI int fresh_tid() { int t = threadIdx.x; asm volatile("" : "+v"(t)); return t; }
DI float sigmoidf_(float x) { return 1.f / (1.f + __expf(-x)); }
DI float siluf_(float x) { return x / (1.f + __expf(-x)); }
DI unsigned pk2(float lo, float hi) { f32x2 v = {lo, hi}; nbf16x2 b = __builtin_convertvector(v, nbf16x2); return __builtin_bit_cast(unsigned, b); }
DI bf16 f2bf(float f) { return (bf16)(pk2(f, 0.f) & 0xffffu); }
DI float bf2f(bf16 b) { return __uint_as_float(((unsigned)b) << 16); }
DI float bflo(unsigned u) { return __uint_as_float(u << 16); }
DI float bfhi(unsigned u) { return __uint_as_float(u & 0xffff0000u); }
DI float wave_sum(float v) {
#pragma unroll
    for (int o = 1; o < 64; o <<= 1) v += __shfl_xor(v, o);
    return v;
}
DI int crow(int reg, int h) { return (reg & 3) + 8 * (reg >> 2) + 4 * h; }

namespace pg8 {
#define PG8_LAS __attribute__((address_space(3)))
typedef unsigned short bf16_t;
typedef short bf16x8 __attribute__((ext_vector_type(8)));
typedef float f32x4 __attribute__((ext_vector_type(4)));
typedef unsigned u32x4 __attribute__((ext_vector_type(4)));
constexpr int BM = 256, BK = 64, HALF = 128, HTB = HALF * BK * 2  , STAGE_BYTES = 8 * HTB, NXCD = 8, WGM = 8;

__host__ __device__ __forceinline__ int lds_byte(int r, int c) { const int st = (r >> 4) * 2 + (c >> 5), rr = r & 15, cc = c & 31, ob = rr * 64 + cc * 2; return st * 1024 + (ob ^ (((ob >> 9) & 1) << 5)); }
__host__ __device__ __forceinline__ void stage_rc(int b, int& R, int& C) { const int st = b / 1024, sb = b % 1024, swz = sb ^ (((sb >> 9) & 1) << 5); R = (st >> 1) * 16 + swz / 64; C = (st & 1) * 32 + (swz % 64) / 2; }
__host__ __device__ __forceinline__ int perm32(int rho) { const int n = rho >> 4, i = rho & 15; return 8 * (i >> 2) + 4 * n + (i & 3); }

struct Unit { int pm, pn; };
struct Gemm { const bf16_t* A; const bf16_t* Bt; int M, N, K; };

struct StaticOrder {
    int nM, nN, nwg, G, c;
    __host__ __device__ void init(int M, int N, int G_, int c_) { nM = M / BM; nN = N / BM; nwg = nM * nN; G = G_; c = c_; }
    __host__ __device__ bool next(int i, Unit& u) const {
        const long L = (long)i * G + c; if (L >= nwg) return false;
        int wgid = (int)L; { const int q = nwg / NXCD, r = nwg % NXCD, xcd = wgid % NXCD, off = wgid / NXCD; wgid = (xcd < r ? xcd * (q + 1) : r * (q + 1) + (xcd - r) * q) + off; }
        const int nig = WGM * nN, gid = wgid / nig, fm = gid * WGM, gsz = (nM - fm) < WGM ? (nM - fm) : WGM;
        u.pm = fm + ((wgid % nig) % gsz); u.pn = (wgid % nig) / gsz; return true;
    }
    __device__ __forceinline__ void a_ready(const Unit&) const {}
    __device__ __forceinline__ void done(const Unit&) const {}
};

__device__ __forceinline__ unsigned cvt_pk_bf16(float lo, float hi) { unsigned r; asm volatile("v_cvt_pk_bf16_f32 %0, %1, %2" : "=v"(r) : "v"(lo), "v"(hi)); return r; }
typedef float f32x2 __attribute__((ext_vector_type(2)));
template <class Epi, class Sched, bool ALIGN_EPI = false, bool SP2 = false>
__device__ __forceinline__ void gemm_phase(PG8_LAS unsigned char* lds, const Gemm g, const Sched& S, const Epi& E) {
    const int tid = fresh_tid(), wid = __builtin_amdgcn_readfirstlane(tid >> 6), lane = tid & 63, wr = wid >> 2, wc = wid & 3, fr = lane & 15, fq = lane >> 4;
    const int K = g.K, nt = K / BK;
    unsigned voffA[2], voffB[2];
#pragma unroll
    for (int i = 0; i < 2; ++i) { int R, C; stage_rc(tid * 16 + i * 8192, R, C); const int Rb = Epi::PERM ? ((R & ~31) + perm32(R & 31)) : R;
        voffA[i] = (unsigned)(R * K + C) * 2u; voffB[i] = (unsigned)(Rb * K + C) * 2u; }
    const size_t kstep = (size_t)(BK * 2);
    const size_t hstep = (size_t)HALF * K * 2;
    const size_t tstep = 2 * hstep;
    const unsigned ldsw = (unsigned)wid * 1024u;
    const int aoff = lds_byte(wr * 64 + fr, fq * 8), boff = lds_byte(wc * 32 + fr, fq * 8);
#define PG8_SA(b, h) (((b) * 2 + (h)) * HTB)
#define PG8_SB(b, h) ((4 + (b) * 2 + (h)) * HTB)
#define PG8_STAGE(bufoff, gbase, voff) do { _Pragma("unroll") for (int _i = 0; _i < 2; ++_i) \
        __builtin_amdgcn_global_load_lds((const unsigned*)((const char*)(gbase) + (voff)[_i]), (PG8_LAS unsigned*)(lds + (bufoff) + ldsw + _i * 8192), 16, 0, 0); } while (0)
#define PG8_LDA(dst, b, h) do { _Pragma("unroll") for (int m = 0; m < 4; ++m) _Pragma("unroll") for (int k = 0; k < 2; ++k) dst[m][k] = *(const PG8_LAS bf16x8*)(lds + PG8_SA(b, h) + aoff + m * 2048 + k * 1024); } while (0)
#define PG8_LDB(dst, b, h) do { _Pragma("unroll") for (int n = 0; n < 2; ++n) _Pragma("unroll") for (int k = 0; k < 2; ++k) dst[n][k] = *(const PG8_LAS bf16x8*)(lds + PG8_SB(b, h) + boff + n * 2048 + k * 1024); } while (0)
#define PG8_MMA(ai, bj, At, Bt) do { __builtin_amdgcn_s_setprio(1); _Pragma("unroll") for (int m = 0; m < 4; ++m) _Pragma("unroll") for (int n = 0; n < 2; ++n) _Pragma("unroll") for (int k = 0; k < 2; ++k) \
        acc[ai][bj][m][n] = __builtin_amdgcn_mfma_f32_16x16x32_bf16(Bt[n][k], At[m][k], acc[ai][bj][m][n], 0, 0, 0); __builtin_amdgcn_s_setprio(0); } while (0)
#define PG8_WAIT_V(n) asm volatile("s_waitcnt vmcnt(" #n ")" ::: "memory")
#define PG8_WAIT_L(n) asm volatile("s_waitcnt lgkmcnt(" #n ")" ::: "memory")
#define PG8_BAR __builtin_amdgcn_s_barrier()
#define PG8_SCHED __builtin_amdgcn_sched_barrier(0)
    Unit cur, nxt; int ui = 0;
    if (!S.next(0, cur)) return;
    f32x4 acc[2][2][4][2];
#pragma unroll
    for (int a = 0; a < 2; ++a)
#pragma unroll
        for (int b = 0; b < 2; ++b)
#pragma unroll
            for (int m = 0; m < 4; ++m)
#pragma unroll
                for (int n = 0; n < 2; ++n) acc[a][b][m][n] = (f32x4){0.f, 0.f, 0.f, 0.f};
    bf16x8 At[4][2], B0[2][2], B1[2][2];
    const char* cA = (const char*)g.A + (size_t)cur.pm * tstep; const char* cB = (const char*)g.Bt + (size_t)cur.pn * tstep;
    S.a_ready(cur);
    if constexpr (SP2) {
        PG8_STAGE(PG8_SB(0, 0), cB, voffB); PG8_STAGE(PG8_SB(0, 1), cB + hstep, voffB); PG8_STAGE(PG8_SA(0, 0), cA, voffA); PG8_STAGE(PG8_SA(0, 1), cA + hstep, voffA);
        if (wr == 1) PG8_BAR;
        PG8_WAIT_V(2); PG8_BAR;
        PG8_STAGE(PG8_SB(1, 0), cB + kstep, voffB); PG8_STAGE(PG8_SA(1, 0), cA + kstep, voffA); PG8_STAGE(PG8_SB(1, 1), cB + hstep + kstep, voffB);
        PG8_WAIT_V(6); PG8_BAR;
    } else {
        PG8_STAGE(PG8_SB(0, 0), cB, voffB); PG8_STAGE(PG8_SA(0, 0), cA, voffA); PG8_STAGE(PG8_SB(0, 1), cB + hstep, voffB); PG8_STAGE(PG8_SA(0, 1), cA + hstep, voffA);
        if (wr == 1) PG8_BAR;
        PG8_WAIT_V(4); PG8_BAR;
        PG8_STAGE(PG8_SB(1, 0), cB + kstep, voffB); PG8_STAGE(PG8_SA(1, 0), cA + kstep, voffA); PG8_STAGE(PG8_SB(1, 1), cB + hstep + kstep, voffB);
        PG8_WAIT_V(6); PG8_BAR;
    }
    for (;;) {
        const bool has_next = S.next(ui + 1, nxt);
        const char* nA = has_next ? (const char*)g.A + (size_t)nxt.pm * tstep : cA; const char* nB = has_next ? (const char*)g.Bt + (size_t)nxt.pn * tstep : cB;
        for (int t = 0; t < nt; t += 2) {
            const bool last = (t == nt - 2);
            const char* a1 = cA + (size_t)(t + 1) * kstep;
            const char* a2 = last ? nA : cA + (size_t)(t + 2) * kstep; const char* b2 = last ? nB : cB + (size_t)(t + 2) * kstep;
            const char* a3 = a2 + kstep; const char* b3 = b2 + kstep;
            if (last && has_next) S.a_ready(nxt);
            if constexpr (SP2) {
            PG8_LDB(B0, 0, 0); PG8_LDB(B1, 0, 1); PG8_SCHED; PG8_LDA(At, 0, 0); PG8_STAGE(PG8_SA(1, 1), a1 + hstep, voffA);
            PG8_WAIT_V(8); PG8_WAIT_L(0); PG8_BAR; PG8_MMA(0, 0, At, B0); PG8_MMA(0, 1, At, B1); PG8_BAR; PG8_SCHED;
            PG8_LDA(At, 0, 1); PG8_STAGE(PG8_SB(0, 0), b2, voffB); PG8_STAGE(PG8_SB(0, 1), b2 + hstep, voffB); PG8_STAGE(PG8_SA(0, 0), a2, voffA);
            PG8_WAIT_V(8); PG8_WAIT_L(0); PG8_BAR; PG8_MMA(1, 0, At, B0); PG8_MMA(1, 1, At, B1); PG8_BAR; PG8_SCHED;
            PG8_LDB(B0, 1, 0); PG8_LDB(B1, 1, 1); PG8_SCHED; PG8_LDA(At, 1, 0); PG8_STAGE(PG8_SA(0, 1), a2 + hstep, voffA);
            PG8_WAIT_V(8); PG8_WAIT_L(0); PG8_BAR; PG8_MMA(0, 0, At, B0); PG8_MMA(0, 1, At, B1); PG8_BAR; PG8_SCHED;
            PG8_LDA(At, 1, 1); PG8_STAGE(PG8_SB(1, 0), b3, voffB); PG8_STAGE(PG8_SB(1, 1), b3 + hstep, voffB); PG8_STAGE(PG8_SA(1, 0), a3, voffA);
            PG8_WAIT_V(8); PG8_WAIT_L(0); PG8_BAR; PG8_MMA(1, 0, At, B0); PG8_MMA(1, 1, At, B1); PG8_BAR; PG8_SCHED;
            } else {
            PG8_LDB(B0, 0, 0); PG8_SCHED; PG8_LDA(At, 0, 0); PG8_STAGE(PG8_SA(1, 1), a1 + hstep, voffA);
            PG8_WAIT_L(8); PG8_BAR; PG8_WAIT_L(0); PG8_MMA(0, 0, At, B0); PG8_BAR; PG8_SCHED;
            PG8_LDB(B1, 0, 1); PG8_STAGE(PG8_SB(0, 0), b2, voffB);
            PG8_BAR; PG8_WAIT_L(0); PG8_MMA(0, 1, At, B1); PG8_BAR;
            PG8_LDA(At, 0, 1); PG8_STAGE(PG8_SA(0, 0), a2, voffA);
            PG8_BAR; PG8_WAIT_L(0); PG8_MMA(1, 0, At, B0); PG8_BAR; PG8_SCHED;
            PG8_STAGE(PG8_SB(0, 1), b2 + hstep, voffB);
            PG8_WAIT_V(6); PG8_BAR; PG8_MMA(1, 1, At, B1); PG8_BAR;
            PG8_LDB(B0, 1, 0); PG8_SCHED; PG8_LDA(At, 1, 0); PG8_STAGE(PG8_SA(0, 1), a2 + hstep, voffA);
            PG8_WAIT_L(8); PG8_BAR; PG8_WAIT_L(0); PG8_MMA(0, 0, At, B0); PG8_BAR; PG8_SCHED;
            PG8_LDB(B1, 1, 1); PG8_STAGE(PG8_SB(1, 0), b3, voffB);
            PG8_BAR; PG8_WAIT_L(0); PG8_MMA(0, 1, At, B1); PG8_BAR;
            PG8_LDA(At, 1, 1); PG8_STAGE(PG8_SA(1, 0), a3, voffA);
            PG8_BAR; PG8_WAIT_L(0); PG8_MMA(1, 0, At, B0); PG8_BAR; PG8_SCHED;
            PG8_STAGE(PG8_SB(1, 1), b3 + hstep, voffB);
            PG8_WAIT_V(6); PG8_BAR; PG8_MMA(1, 1, At, B1); PG8_BAR;
            }
        }
        if constexpr (ALIGN_EPI) { if (wr == 0) PG8_BAR; }
        if constexpr (!Epi::AFTER_DRAIN) { E(acc, cur, wr, wc, fr, fq); S.done(cur); }
        if (!has_next) break;
#pragma unroll
        for (int a = 0; a < 2; ++a)
#pragma unroll
            for (int b = 0; b < 2; ++b)
#pragma unroll
                for (int m = 0; m < 4; ++m)
#pragma unroll
                    for (int n = 0; n < 2; ++n) acc[a][b][m][n] = (f32x4){0.f, 0.f, 0.f, 0.f};
        cur = nxt; cA = nA; cB = nB; ++ui;
        if constexpr (ALIGN_EPI) { if (wr == 1) PG8_BAR; }
    }
    PG8_WAIT_V(0);
    if constexpr (!ALIGN_EPI) { if (wr == 0) PG8_BAR; }
    PG8_BAR;
    if constexpr (Epi::AFTER_DRAIN) { E.fused(acc, cur, wr, wc, fr, fq, lds, wid, lane); S.done(cur); }
#undef PG8_SA
#undef PG8_SB
#undef PG8_STAGE
#undef PG8_LDA
#undef PG8_LDB
#undef PG8_MMA
#undef PG8_WAIT_V
#undef PG8_WAIT_L
#undef PG8_BAR
#undef PG8_SCHED
}
}

using pg8::Unit;
typedef f32x4 Acc[2][2][4][2];

DI u32x4 pack8(const f32x4& a, const f32x4& b) { u32x4 w; w.x = pk2(a[0], a[1]); w.y = pk2(a[2], a[3]); w.z = pk2(b[0], b[1]); w.w = pk2(b[2], b[3]); return w; }

struct EpiH {
    static constexpr bool PERM = true, AFTER_DRAIN = false;
    bf16* Qh; bf16* Kh; bf16* VTh; float* DEC; const float* hlb;
    DI void operator()(Acc& acc, const Unit& u, int wr, int wc, int fr, int fq) const {
        if (u.pn < 8) {
            const int h = u.pn, dbase = wc * 32 + 8 * fq;
#pragma unroll
            for (int ai = 0; ai < 2; ++ai) {
                const int row0 = u.pm * 256 + ai * 128 + wr * 64;
                const int bidx = row0 >> 13, chunk = (row0 & (SEQ - 1)) >> 6;
#pragma unroll
                for (int n = 0; n < 2; ++n) {
                    f32x4 ebl;
#pragma unroll
                    for (int e = 0; e < 4; ++e) {
                        const int c = h * 128 + dbase + 4 * n + e;
                        const float lb = sigmoidf_(hlb[c] - hlb[1024 + c]);
                        float carry = 0.f, eb = 0.f;
#pragma unroll
                        for (int m = 0; m < 4; ++m) {
                            const float sg = sigmoidf_(acc[ai][1][m][n][e]);
                            const float f = lb + (1.f - lb) * sg;
                            const float kk = (1.f - lb) * (1.f - sg);
                            float s = __logf(f);
#pragma unroll
                            for (int dl = 1; dl < 16; dl <<= 1) { const float o = __shfl_up(s, dl, 16); if (fr >= dl) s += o; }
                            const float b = s + carry;
                            carry += __shfl(s, 15, 16);
                            eb = __expf(b);
                            acc[ai][0][m][n][e] = acc[ai][0][m][n][e] * 0.08838834764831845f * eb;
                            acc[ai][1][m][n][e] = kk * __expf(-b);
                        }
                        ebl[e] = eb;
                        __builtin_amdgcn_sched_barrier(0);
                    }
                    if (fr == 15) *(f32x4*)(DEC + ((size_t)((bidx * HG_H + h) * HG_NC + chunk)) * 128 + dbase + 4 * n) = ebl;
#pragma unroll
                    for (int m = 0; m < 4; ++m) {
                        const size_t row = (size_t)(row0 + m * 16 + fr);
                        const f32x4 qv = acc[ai][0][m][n], kv = acc[ai][1][m][n];
                        u32x2 oq, ok; oq.x = pk2(qv[0], qv[1]); oq.y = pk2(qv[2], qv[3]); ok.x = pk2(kv[0], kv[1]); ok.y = pk2(kv[2], kv[3]);
                        *(u32x2*)(Qh + row * 1024 + h * 128 + dbase + 4 * n) = oq;
                        *(u32x2*)(Kh + row * 1024 + h * 128 + dbase + 4 * n) = ok;
                    }
                    __builtin_amdgcn_sched_barrier(0);
                }
            }
        } else {
#pragma unroll
            for (int ai = 0; ai < 2; ++ai)
#pragma unroll
                for (int m = 0; m < 4; ++m) {
                    const int row = u.pm * 256 + ai * 128 + wr * 64 + m * 16 + fr, bidx = row >> 13, pos = row & (SEQ - 1);
                    bf16* ptr = VTh + (((size_t)(bidx * HG_H * 128 + (u.pn - 8) * 256 + wc * 32 + 8 * fq)) << 13) + pos;
#pragma unroll
                    for (int bj = 0; bj < 2; ++bj) {
#pragma unroll
                        for (int n = 0; n < 2; ++n)
#pragma unroll
                            for (int e = 0; e < 4; ++e) { asm volatile("" : "+v"(ptr)); *ptr = f2bf(acc[ai][bj][m][n][e]); ptr += 8192; }
                        ptr += (size_t)120 * 8192;
                    }
                }
        }
    }
};

struct EpiR {
    static constexpr bool PERM = true, AFTER_DRAIN = false;
    bf16* Qr; bf16* Kr; bf16* VTr; const float* COS; const float* SIN;
    DI void operator()(Acc& acc, const Unit& u, int wr, int wc, int fr, int fq) const {
        if (u.pn < 8) {
            const bool isk = u.pn >= 4; const int h = u.pn & 3;
            const float lg = __log2f(1.f - exp2f(-5.f - (float)h));
            bf16* dst = isk ? Kr : Qr;
            const int j0 = wc * 32 + 8 * fq;
#pragma unroll
            for (int ai = 0; ai < 2; ++ai)
#pragma unroll
                for (int m = 0; m < 4; ++m) {
                    const int row = u.pm * 256 + ai * 128 + wr * 64 + m * 16 + fr, pos = row & (SEQ - 1), il = pos & (RT_L - 1);
                    const float sc = isk ? exp2f(-lg * (float)il) * 0.0625f : exp2f(lg * (float)il);
#pragma unroll
                    for (int n = 0; n < 2; ++n) {
                        const f32x4 c = *(const f32x4*)(COS + (size_t)pos * 128 + j0 + 4 * n), s = *(const f32x4*)(SIN + (size_t)pos * 128 + j0 + 4 * n);
                        const f32x4 x1 = acc[ai][0][m][n], x2 = acc[ai][1][m][n];
                        acc[ai][0][m][n] = (x1 * c - x2 * s) * sc; acc[ai][1][m][n] = (x1 * s + x2 * c) * sc;
                    }
                    *(u32x4*)(dst + (size_t)row * 1024 + h * 256 + j0) = pack8(acc[ai][0][m][0], acc[ai][0][m][1]);
                    *(u32x4*)(dst + (size_t)row * 1024 + h * 256 + 128 + j0) = pack8(acc[ai][1][m][0], acc[ai][1][m][1]);
                }
        } else {
#pragma unroll
            for (int ai = 0; ai < 2; ++ai)
#pragma unroll
                for (int m = 0; m < 4; ++m) {
                    const int row = u.pm * 256 + ai * 128 + wr * 64 + m * 16 + fr, bidx = row >> 13, pos = row & (SEQ - 1);
                    bf16* ptr = VTr + (((size_t)(bidx * RT_H * 512 + (u.pn - 8) * 256 + wc * 32 + 8 * fq)) << 13) + pos;
#pragma unroll
                    for (int bj = 0; bj < 2; ++bj) {
#pragma unroll
                        for (int n = 0; n < 2; ++n)
#pragma unroll
                            for (int e = 0; e < 4; ++e) { asm volatile("" : "+v"(ptr)); *ptr = f2bf(acc[ai][bj][m][n][e]); ptr += 8192; }
                        ptr += (size_t)120 * 8192;
                    }
                }
        }
    }
};

struct EpiG {
    static constexpr bool PERM = true, AFTER_DRAIN = false;
    bf16* OHG; bf16* ORET; bf16* GA; bf16* GB; const float* SSQP;
    DI void operator()(Acc& acc, const Unit& u, int wr, int wc, int fr, int fq) const {
        const int cb = wc * 32 + 8 * fq;
#pragma unroll
        for (int ai = 0; ai < 2; ++ai)
#pragma unroll
            for (int m = 0; m < 4; ++m) {
                const size_t row = (size_t)(u.pm * 256 + ai * 128 + wr * 64 + m * 16 + fr);
#pragma unroll
                for (int bj = 0; bj < 2; ++bj) {
                    f32x4 a0 = acc[ai][bj][m][0], a1 = acc[ai][bj][m][1];
                    if (u.pn < 12) {
                        bf16* p; float rs = 1.f;
                        if (u.pn < 4) p = OHG + row * 1024 + u.pn * 256 + bj * 128 + cb;
                        else { const int c = (u.pn - 4) * 256 + bj * 128 + cb, h = c >> 9; p = ORET + row * 2048 + c;
                               rs = rsqrtf((SSQP[row * 8 + h * 2] + SSQP[row * 8 + h * 2 + 1]) * (1.f / 512.f) + EPS); }
                        const u32x4 o = *(const u32x4*)p;
#pragma unroll
                        for (int e = 0; e < 4; ++e) { a0[e] = siluf_(a0[e]) * rs; a1[e] = siluf_(a1[e]) * rs; }
                        a0[0] *= bflo(o.x); a0[1] *= bfhi(o.x); a0[2] *= bflo(o.y); a0[3] *= bfhi(o.y);
                        a1[0] *= bflo(o.z); a1[1] *= bfhi(o.z); a1[2] *= bflo(o.w); a1[3] *= bfhi(o.w);
                        *(u32x4*)p = pack8(a0, a1);
                    } else {
                        bf16* p = (u.pn < 16 ? GA + row * 1024 + (u.pn - 12) * 256 : GB + row * 1024 + (u.pn - 16) * 256) + bj * 128 + cb;
#pragma unroll
                        for (int e = 0; e < 4; ++e) { a0[e] = sigmoidf_(a0[e]); a1[e] = sigmoidf_(a1[e]); }
                        *(u32x4*)p = pack8(a0, a1);
                    }
                }
            }
    }
};

struct EpiM1 {
    static constexpr bool PERM = true, AFTER_DRAIN = false;
    float* M1; const bf16* GA;
    DI void operator()(Acc& acc, const Unit& u, int wr, int wc, int fr, int fq) const {
        const int cb = u.pn * 256 + wc * 32 + 8 * fq;
#pragma unroll
        for (int ai = 0; ai < 2; ++ai)
#pragma unroll
            for (int m = 0; m < 4; ++m) {
                const size_t row = (size_t)(u.pm * 256 + ai * 128 + wr * 64 + m * 16 + fr);
#pragma unroll
                for (int bj = 0; bj < 2; ++bj) {
                    const u32x4 g = *(const u32x4*)(GA + row * 1024 + cb + bj * 128);
                    f32x4 a0 = acc[ai][bj][m][0], a1 = acc[ai][bj][m][1];
                    a0[0] *= bflo(g.x); a0[1] *= bfhi(g.x); a0[2] *= bflo(g.y); a0[3] *= bfhi(g.y);
                    a1[0] *= bflo(g.z); a1[1] *= bfhi(g.z); a1[2] *= bflo(g.w); a1[3] *= bfhi(g.w);
                    float* p = M1 + row * 1024 + cb + bj * 128;
                    *(f32x4*)p = a0; *(f32x4*)(p + 4) = a1;
                }
            }
    }
};
struct EpiMerge {
    static constexpr bool PERM = true, AFTER_DRAIN = false;
    const float* M1; const bf16* GB; bf16* MERGED;
    DI void operator()(Acc& acc, const Unit& u, int wr, int wc, int fr, int fq) const {
        const int cb = u.pn * 256 + wc * 32 + 8 * fq;
#pragma unroll
        for (int ai = 0; ai < 2; ++ai)
#pragma unroll
            for (int m = 0; m < 4; ++m) {
                const size_t row = (size_t)(u.pm * 256 + ai * 128 + wr * 64 + m * 16 + fr);
#pragma unroll
                for (int bj = 0; bj < 2; ++bj) {
                    const u32x4 g = *(const u32x4*)(GB + row * 1024 + cb + bj * 128);
                    const float* p = M1 + row * 1024 + cb + bj * 128;
                    f32x4 a0 = acc[ai][bj][m][0], a1 = acc[ai][bj][m][1];
                    const f32x4 m0 = *(const f32x4*)p, m1 = *(const f32x4*)(p + 4);
                    a0[0] = a0[0] * bflo(g.x) + m0[0]; a0[1] = a0[1] * bfhi(g.x) + m0[1]; a0[2] = a0[2] * bflo(g.y) + m0[2]; a0[3] = a0[3] * bfhi(g.y) + m0[3];
                    a1[0] = a1[0] * bflo(g.z) + m1[0]; a1[1] = a1[1] * bfhi(g.z) + m1[1]; a1[2] = a1[2] * bflo(g.w) + m1[2]; a1[3] = a1[3] * bfhi(g.w) + m1[3];
                    *(u32x4*)(MERGED + row * 1024 + cb + bj * 128) = pack8(a0, a1);
                }
            }
    }
};
struct EpiOut {
    static constexpr bool PERM = true, AFTER_DRAIN = false;
    const float* X; float* X1; bf16* XW; const float* nw; float* SSQX;
    DI void operator()(Acc& acc, const Unit& u, int wr, int wc, int fr, int fq) const {
        const int cb = u.pn * 256 + wc * 32 + 8 * fq;
#pragma unroll
        for (int ai = 0; ai < 2; ++ai)
#pragma unroll
            for (int m = 0; m < 4; ++m) {
                const size_t row = (size_t)(u.pm * 256 + ai * 128 + wr * 64 + m * 16 + fr);
                float ss = 0.f;
#pragma unroll
                for (int bj = 0; bj < 2; ++bj) {
                    const size_t off = row * 1024 + cb + bj * 128;
                    const f32x4 x0 = *(const f32x4*)(X + off), x1v = *(const f32x4*)(X + off + 4);
                    const f32x4 w0 = *(const f32x4*)(nw + cb + bj * 128), w1 = *(const f32x4*)(nw + cb + bj * 128 + 4);
                    const f32x4 a0 = acc[ai][bj][m][0] + x0, a1 = acc[ai][bj][m][1] + x1v;
                    *(f32x4*)(X1 + off) = a0; *(f32x4*)(X1 + off + 4) = a1;
                    ss += (a0[0] * a0[0] + a0[1] * a0[1]) + (a0[2] * a0[2] + a0[3] * a0[3]) + (a1[0] * a1[0] + a1[1] * a1[1]) + (a1[2] * a1[2] + a1[3] * a1[3]);
                    *(u32x4*)(XW + off) = pack8(a0 * w0, a1 * w1);
                }
                ss += __shfl_xor(ss, 16); ss += __shfl_xor(ss, 32);
                if (fq == 0) SSQX[row * 16 + u.pn * 4 + wc] = ss;
            }
    }
};
DI float rstd_x1(const float* SSQX, size_t row) {
    const f32x4 a = *(const f32x4*)(SSQX + row * 16), b = *(const f32x4*)(SSQX + row * 16 + 4), c = *(const f32x4*)(SSQX + row * 16 + 8), d = *(const f32x4*)(SSQX + row * 16 + 12);
    const float s = ((a[0] + a[1]) + (a[2] + a[3])) + ((b[0] + b[1]) + (b[2] + b[3])) + ((c[0] + c[1]) + (c[2] + c[3])) + ((d[0] + d[1]) + (d[2] + d[3]));
    return rsqrtf(s * (1.f / 1024.f) + EPS);
}
struct EpiQ {
    static constexpr bool PERM = true, AFTER_DRAIN = false;
    bf16* Q; const float* SSQX;
    DI void operator()(Acc& acc, const Unit& u, int wr, int wc, int fr, int fq) const {
        const int cb = u.pn * 256 + wc * 32 + 8 * fq;
#pragma unroll
        for (int ai = 0; ai < 2; ++ai)
#pragma unroll
            for (int m = 0; m < 4; ++m) {
                const size_t row = (size_t)(u.pm * 256 + ai * 128 + wr * 64 + m * 16 + fr);
                const float rs = rstd_x1(SSQX, row);
#pragma unroll
                for (int bj = 0; bj < 2; ++bj) *(u32x4*)(Q + row * 2048 + cb + bj * 128) = pack8(acc[ai][bj][m][0] * rs, acc[ai][bj][m][1] * rs);
            }
    }
};

#define MFMA32(a, b, c) __builtin_amdgcn_mfma_f32_32x32x16_bf16((a), (b), (c), 0, 0, 0)
DI bf16x8 ldg16(const bf16* p) { return *(const bf16x8*)p; }
DI bf16x8 ldg2x8(const bf16* p0, const bf16* p1) { const s16x4 a = *(const s16x4*)p0, b = *(const s16x4*)p1; return __builtin_shufflevector(a, b, 0, 1, 2, 3, 4, 5, 6, 7); }
DI bf16x8 packx(const f32x16& x, int s) {
    u32x4 p; p.x = pk2(x[8 * s + 0], x[8 * s + 1]); p.y = pk2(x[8 * s + 2], x[8 * s + 3]); p.z = pk2(x[8 * s + 4], x[8 * s + 5]); p.w = pk2(x[8 * s + 6], x[8 * s + 7]);
    return __builtin_bit_cast(bf16x8, p);
}
DI f32x16 zero16() { f32x16 z;
#pragma unroll
    for (int i = 0; i < 16; ++i) z[i] = 0.f; return z; }

DI bf16x8 tr_frag(const LAS unsigned char* tile, int RS, int lane, int ks, int c) {
    const int hh = lane >> 5, blk = (lane >> 4) & 1, q = (lane & 15) >> 2, p = lane & 3;
    const LAS unsigned char* a0 = tile + (16 * ks + 8 * hh + q) * RS + (32 * c + 16 * blk + 4 * p) * 2;
    const s16x4 lo = __builtin_amdgcn_ds_read_tr16_b64_v4i16((LAS s16x4*)a0);
    const s16x4 hi = __builtin_amdgcn_ds_read_tr16_b64_v4i16((LAS s16x4*)(a0 + 4 * RS));
    return __builtin_shufflevector(lo, hi, 0, 1, 2, 3, 4, 5, 6, 7);
}

constexpr int HG_KRS = 320;
DI void hg_pass1(LAS unsigned char* lds, const bf16* Kh, const bf16* VTh, bf16* STh, int wg, int nwg) {
    const int tid = fresh_tid(), lane = tid & 63, w = __builtin_amdgcn_readfirstlane(tid >> 6), r = lane & 31, hh = lane >> 5;
    for (int unit = wg; unit < 16 * HG_NC; unit += nwg) {
        const int bh = unit >> 7, c = unit & 127, b = bh >> 3, h = bh & 7;
        __syncthreads();
        {
            const int row = tid >> 3, ch = tid & 7;
            const bf16* src = Kh + ((size_t)(b * SEQ + c * 64 + row)) * 1024 + h * 128;
            const bf16x8 v0 = ldg16(src + ch * 8), v1 = ldg16(src + 64 + ch * 8);
            *(LAS bf16x8*)(lds + row * HG_KRS + ch * 16) = v0; *(LAS bf16x8*)(lds + row * HG_KRS + 128 + ch * 16) = v1;
        }
        __syncthreads();
        const int mt = w & 3, nt0 = w >> 2;
        f32x16 a0 = zero16(), a1 = zero16();
        const bf16* vrow = VTh + (((size_t)(bh * 128 + 32 * mt + r)) << 13) + c * 64;
#pragma unroll
        for (int ks = 0; ks < 4; ++ks) {
            const bf16x8 av = ldg16(vrow + 16 * ks + 8 * hh);
            a0 = MFMA32(av, tr_frag(lds, HG_KRS, lane, ks, nt0), a0);
            a1 = MFMA32(av, tr_frag(lds, HG_KRS, lane, ks, nt0 + 2), a1);
        }
        bf16* dst = STh + ((size_t)(bh * HG_NC + c)) * 16384;
#pragma unroll
        for (int i = 0; i < 16; ++i) {
            const int v = 32 * mt + crow(i, hh);
            dst[v * 128 + 32 * nt0 + r] = f2bf(a0[i]); dst[v * 128 + 32 * (nt0 + 2) + r] = f2bf(a1[i]);
        }
    }
    __syncthreads();
}

DI void hg_scan(bf16* STh, const float* DEC, int gtid, int gsz) {
    for (int idx = gtid; idx < 16 * 128 * 32; idx += gsz) {
        const int dq = idx & 31, v = (idx >> 5) & 127, bh = idx >> 12;
        f32x4 carry = {0.f, 0.f, 0.f, 0.f};
        bf16* p = STh + ((size_t)bh * HG_NC) * 16384 + v * 128 + dq * 4;
        const float* dp = DEC + ((size_t)bh * HG_NC) * 128 + dq * 4;
#pragma unroll 8
        for (int c = 0; c < HG_NC; ++c) {
            const u32x2 wv = *(const u32x2*)(p + (size_t)c * 16384);
            const f32x4 dec = *(const f32x4*)(dp + c * 128);
            u32x2 o; o.x = pk2(carry[0], carry[1]); o.y = pk2(carry[2], carry[3]);
            *(u32x2*)(p + (size_t)c * 16384) = o;
            carry[0] = dec[0] * (carry[0] + bflo(wv.x)); carry[1] = dec[1] * (carry[1] + bfhi(wv.x));
            carry[2] = dec[2] * (carry[2] + bflo(wv.y)); carry[3] = dec[3] * (carry[3] + bfhi(wv.y));
        }
    }
}
DI void rt_scan(bf16* STr, int gtid, int gsz) {
    for (int idx = gtid; idx < 8 * 512 * 32; idx += gsz) {
        const int dq = idx & 31, v = (idx >> 5) & 511, bh = idx >> 14, h = bh & 3;
        const float dec = exp2f((float)RT_L * __log2f(1.f - exp2f(-5.f - (float)h)));
        float carry[8];
#pragma unroll
        for (int e = 0; e < 8; ++e) carry[e] = 0.f;
        bf16* p = STr + ((size_t)bh * RT_NS) * 131072 + v * 256 + dq * 8;
#pragma unroll 4
        for (int c = 0; c < RT_NS; ++c) {
            const u32x4 wv = *(const u32x4*)(p + (size_t)c * 131072);
            u32x4 o; o.x = pk2(carry[0], carry[1]); o.y = pk2(carry[2], carry[3]); o.z = pk2(carry[4], carry[5]); o.w = pk2(carry[6], carry[7]);
            *(u32x4*)(p + (size_t)c * 131072) = o;
            if (c == RT_NS - 1) break;
            carry[0] = dec * (carry[0] + bflo(wv.x)); carry[1] = dec * (carry[1] + bfhi(wv.x));
            carry[2] = dec * (carry[2] + bflo(wv.y)); carry[3] = dec * (carry[3] + bfhi(wv.y));
            carry[4] = dec * (carry[4] + bflo(wv.z)); carry[5] = dec * (carry[5] + bfhi(wv.z));
            carry[6] = dec * (carry[6] + bflo(wv.w)); carry[7] = dec * (carry[7] + bfhi(wv.w));
        }
    }
}

DI void hg_pass3(const bf16* Qh, const bf16* Kh, const bf16* VTh, const bf16* STh, const float* hg_norm_w, bf16* OHG, int gw, int ngw) {
    const int lane = fresh_tid() & 63, r = lane & 31, hh = lane >> 5;
    for (int unit = gw; unit < 16 * HG_NC * 2; unit += ngw) {
        const int tb = unit & 1, c = (unit >> 1) & 127, bh = unit >> 8, b = bh >> 3, h = bh & 7;
        const size_t trow = (size_t)(b * SEQ + c * 64 + tb * 32 + r);
        bf16x8 qf[8];
#pragma unroll
        for (int kk = 0; kk < 8; ++kk) qf[kk] = ldg16(Qh + trow * 1024 + h * 128 + kk * 16 + 8 * hh);
        f32x16 acc[4];
#pragma unroll
        for (int nv = 0; nv < 4; ++nv) acc[nv] = zero16();
        for (int sb = 0; sb <= tb; ++sb) {
            const size_t srow = (size_t)(b * SEQ + c * 64 + sb * 32 + r);
            f32x16 x = zero16();
#pragma unroll
            for (int kk = 0; kk < 8; ++kk) x = MFMA32(ldg16(Kh + srow * 1024 + h * 128 + kk * 16 + 8 * hh), qf[kk], x);
            if (sb == tb) {
#pragma unroll
                for (int i = 0; i < 16; ++i) if (crow(i, hh) > r) x[i] = 0.f;
            }
            const bf16x8 xs0 = packx(x, 0), xs1 = packx(x, 1);
#pragma unroll
            for (int nv = 0; nv < 4; ++nv) {
                const bf16* vb = VTh + (((size_t)(bh * 128 + nv * 32 + r)) << 13) + c * 64 + sb * 32 + 4 * hh;
                acc[nv] = MFMA32(ldg2x8(vb, vb + 8), xs0, acc[nv]);
                acc[nv] = MFMA32(ldg2x8(vb + 16, vb + 24), xs1, acc[nv]);
            }
        }
        const bf16* st = STh + ((size_t)(bh * HG_NC + c)) * 16384;
#pragma unroll
        for (int nv = 0; nv < 4; ++nv)
#pragma unroll
            for (int kk = 0; kk < 8; ++kk) acc[nv] = MFMA32(ldg16(st + (nv * 32 + r) * 128 + kk * 16 + 8 * hh), qf[kk], acc[nv]);
        float ss = 0.f;
#pragma unroll
        for (int nv = 0; nv < 4; ++nv)
#pragma unroll
            for (int i = 0; i < 16; ++i) ss += acc[nv][i] * acc[nv][i];
        ss += __shfl_xor(ss, 32);
        const float rs = rsqrtf(ss * (1.f / 128.f) + EPS);
#pragma unroll
        for (int nv = 0; nv < 4; ++nv)
#pragma unroll
            for (int g = 0; g < 4; ++g) {
                const int v = nv * 32 + 8 * g + 4 * hh;
                const f32x4 wv = *(const f32x4*)(hg_norm_w + h * 128 + v);
                u32x2 o; o.x = pk2(acc[nv][4 * g] * rs * wv[0], acc[nv][4 * g + 1] * rs * wv[1]); o.y = pk2(acc[nv][4 * g + 2] * rs * wv[2], acc[nv][4 * g + 3] * rs * wv[3]);
                *(u32x2*)(OHG + trow * 1024 + h * 128 + v) = o;
            }
    }
}

constexpr int RT_KRS = 576;
constexpr int RT_KBUF = 64 * RT_KRS;
DI void rt_pass1(LAS unsigned char* lds, const bf16* Kr, const bf16* VTr, bf16* STr, int wg, int nwg) {
    const int tid = fresh_tid(), lane = tid & 63, w = __builtin_amdgcn_readfirstlane(tid >> 6), r = lane & 31, hh = lane >> 5;
    const int wm = w & 3, wn = w >> 2;
    const int srow = tid >> 3, sch = tid & 7;
    for (int unit = wg; unit < 8 * (RT_NS - 1) * 2; unit += nwg) {
        const int vh = unit & 1, sg = (unit >> 1) % (RT_NS - 1), bh = (unit >> 1) / (RT_NS - 1), b = bh >> 2, h = bh & 3;
        f32x16 acc[2][4];
#pragma unroll
        for (int i = 0; i < 2; ++i)
#pragma unroll
            for (int j = 0; j < 4; ++j) acc[i][j] = zero16();
        const bf16* kbase = Kr + ((size_t)(b * SEQ + sg * RT_L)) * 1024 + h * 256;
        bf16x8 st[4];
#pragma unroll
        for (int i = 0; i < 4; ++i) st[i] = ldg16(kbase + (size_t)srow * 1024 + (sch + 8 * i) * 8);
        __syncthreads();
#pragma unroll
        for (int i = 0; i < 4; ++i) *(LAS bf16x8*)(lds + srow * RT_KRS + (sch + 8 * i) * 16) = st[i];
        for (int sb = 0; sb < RT_L / 64; ++sb) {
            const LAS unsigned char* cur = lds + (sb & 1) * RT_KBUF;
            if (sb + 1 < RT_L / 64) {
#pragma unroll
                for (int i = 0; i < 4; ++i) st[i] = ldg16(kbase + (size_t)((sb + 1) * 64 + srow) * 1024 + (sch + 8 * i) * 8);
            }
            __syncthreads();
#pragma unroll
            for (int ks = 0; ks < 4; ++ks) {
                bf16x8 av[2];
#pragma unroll
                for (int i = 0; i < 2; ++i) av[i] = ldg16(VTr + (((size_t)(bh * 512 + vh * 256 + wm * 64 + i * 32 + r)) << 13) + sg * RT_L + sb * 64 + 16 * ks + 8 * hh);
#pragma unroll
                for (int j = 0; j < 4; ++j) {
                    const bf16x8 bv = tr_frag(cur, RT_KRS, lane, ks, wn * 4 + j);
                    acc[0][j] = MFMA32(av[0], bv, acc[0][j]); acc[1][j] = MFMA32(av[1], bv, acc[1][j]);
                }
                __builtin_amdgcn_sched_barrier(0);
            }
            if (sb + 1 < RT_L / 64) {
                LAS unsigned char* nxt = lds + ((sb + 1) & 1) * RT_KBUF;
#pragma unroll
                for (int i = 0; i < 4; ++i) *(LAS bf16x8*)(nxt + srow * RT_KRS + (sch + 8 * i) * 16) = st[i];
            }
        }
        bf16* dst = STr + ((size_t)(bh * RT_NS + sg)) * 131072;
#pragma unroll
        for (int i = 0; i < 2; ++i)
#pragma unroll
            for (int j = 0; j < 4; ++j)
#pragma unroll
                for (int e = 0; e < 16; ++e) dst[(vh * 256 + wm * 64 + i * 32 + crow(e, hh)) * 256 + wn * 128 + j * 32 + r] = f2bf(acc[i][j][e]);
    }
    __syncthreads();
}

DI void rt_pass3_unit(const bf16* Qr, const bf16* Kr, const bf16* VTr, const bf16* STr, bf16* ORET, float* SSQP, int idx, int lane) {
    const int r = lane & 31, hh = lane >> 5;
    const int vh = idx & 1, tbl = (idx >> 1) & 15, sgid = idx >> 5, sg = sgid & 15, bh = sgid >> 4, b = bh >> 2, h = bh & 3;
    const int t0 = sg * RT_L + tbl * 32;
    const size_t trow = (size_t)(b * SEQ + t0 + r);
    const bf16* qrow = Qr + trow * 1024 + h * 256 + 8 * hh;
    f32x16 acc[8];
#pragma unroll
    for (int nv = 0; nv < 8; ++nv) acc[nv] = zero16();
    for (int sb = 0; sb <= tbl; ++sb) {
        const int s0 = sg * RT_L + sb * 32;
        const bf16* krow = Kr + ((size_t)(b * SEQ + s0 + r)) * 1024 + h * 256 + 8 * hh;
        f32x16 x = zero16();
#pragma unroll
        for (int k4 = 0; k4 < 4; ++k4) {
            bf16x8 kf[4], qf[4];
#pragma unroll
            for (int i = 0; i < 4; ++i) { kf[i] = ldg16(krow + (k4 * 4 + i) * 16); qf[i] = ldg16(qrow + (k4 * 4 + i) * 16); }
#pragma unroll
            for (int i = 0; i < 4; ++i) x = MFMA32(kf[i], qf[i], x);
            __builtin_amdgcn_sched_barrier(0);
        }
        if (sb == tbl) {
#pragma unroll
            for (int i = 0; i < 16; ++i) if (crow(i, hh) > r) x[i] = 0.f;
        }
        const bf16x8 xs0 = packx(x, 0), xs1 = packx(x, 1);
#pragma unroll
        for (int nv = 0; nv < 8; ++nv) {
            const bf16* vb = VTr + (((size_t)(bh * 512 + vh * 256 + nv * 32 + r)) << 13) + s0 + 4 * hh;
            acc[nv] = MFMA32(ldg2x8(vb, vb + 8), xs0, acc[nv]);
            acc[nv] = MFMA32(ldg2x8(vb + 16, vb + 24), xs1, acc[nv]);
            if ((nv & 3) == 3) __builtin_amdgcn_sched_barrier(0);
        }
    }
    const bf16* st = STr + ((size_t)(bh * RT_NS + sg)) * 131072 + (size_t)(vh * 256) * 256;
#pragma unroll 2
    for (int kk = 0; kk < 16; ++kk) {
        const bf16x8 q = ldg16(qrow + kk * 16);
#pragma unroll
        for (int nv = 0; nv < 8; ++nv) acc[nv] = MFMA32(ldg16(st + (nv * 32 + r) * 256 + kk * 16 + 8 * hh), q, acc[nv]);
        __builtin_amdgcn_sched_barrier(0);
    }
    float ss = 0.f;
#pragma unroll
    for (int nv = 0; nv < 8; ++nv)
#pragma unroll
        for (int i = 0; i < 16; ++i) ss += acc[nv][i] * acc[nv][i];
    ss += __shfl_xor(ss, 32);
    if (hh == 0) SSQP[trow * 8 + h * 2 + vh] = ss;
#pragma unroll
    for (int nv = 0; nv < 8; ++nv)
#pragma unroll
        for (int g = 0; g < 4; ++g) {
            const int v = vh * 256 + nv * 32 + 8 * g + 4 * hh;
            u32x2 o; o.x = pk2(acc[nv][4 * g], acc[nv][4 * g + 1]); o.y = pk2(acc[nv][4 * g + 2], acc[nv][4 * g + 3]);
            *(u32x2*)(ORET + trow * 2048 + h * 512 + v) = o;
        }
}
DI void rt_pass3(const bf16* Qr, const bf16* Kr, const bf16* VTr, const bf16* STr, bf16* ORET, float* SSQP, int gw, int ngw) {
    const int lane = fresh_tid() & 63;
    for (int u = gw; u < 2048; u += ngw) {
        rt_pass3_unit(Qr, Kr, VTr, STr, ORET, SSQP, u, lane);
        const int p = (u & 1) | ((15 - ((u >> 1) & 15)) << 1) | (((u >> 5) + 64) << 5);
        rt_pass3_unit(Qr, Kr, VTr, STr, ORET, SSQP, p, lane);
    }
}

constexpr int RQ_RS = 528;
constexpr int RQ_QBYTES = 128 * RQ_RS, RQ_KBYTES = 32 * RQ_RS;
DI void rt_pass3_wg(LAS unsigned char* lds, const bf16* Qr, const bf16* Kr, const bf16* VTr, const bf16* STr, bf16* ORET, float* SSQP, int wg, int nwg) {
    const int tid = fresh_tid(), lane = tid & 63, w = __builtin_amdgcn_readfirstlane(tid >> 6), r = lane & 31, hh = lane >> 5;
    const int tsub = w & 3, vh = w >> 2;
    LAS unsigned char* Qs = lds;
    LAS unsigned char* Ks = lds + RQ_QBYTES;
    for (int pairidx = wg; pairidx < 256; pairidx += nwg) {
#pragma unroll 1
        for (int half = 0; half < 2; ++half) {
            const int sgid = pairidx >> 1, bh = sgid >> 4, sg = sgid & 15, b = bh >> 2, h = bh & 3;
            const int qq = half ? 3 - (pairidx & 1) : (pairidx & 1);
            const int pos0 = sg * RT_L + qq * 128, nsb = 4 * qq + 4, mysb = 4 * qq + tsub;
            const bf16* qsrc = Qr + ((size_t)(b * SEQ + pos0)) * 1024 + h * 256;
            const bf16* ksrc = Kr + ((size_t)(b * SEQ + sg * RT_L)) * 1024 + h * 256;
            unsigned stoff = (unsigned)((tid >> 5) * 1024 + (tid & 31) * 8);
            unsigned stlds = (unsigned)((tid >> 5) * RQ_RS + (tid & 31) * 16);
            asm volatile("" : "+v"(stoff), "+v"(stlds));
            __syncthreads();
#pragma unroll
            for (int i = 0; i < 8; ++i) *(LAS bf16x8*)(Qs + stlds + i * 16 * RQ_RS) = ldg16(qsrc + i * 16 * 1024 + stoff);
            bf16x8 kst[2];
#pragma unroll
            for (int i = 0; i < 2; ++i) *(LAS bf16x8*)(Ks + stlds + i * 16 * RQ_RS) = ldg16(ksrc + i * 16 * 1024 + stoff);
            f32x16 acc[8];
#pragma unroll
            for (int nv = 0; nv < 8; ++nv) acc[nv] = zero16();
            __syncthreads();
            const LAS unsigned char* qfr = Qs + (tsub * 32 + r) * RQ_RS + 16 * hh;
            {
                const bf16* st = STr + ((size_t)(bh * RT_NS + sg)) * 131072 + (size_t)(vh * 256) * 256;
                unsigned so = (unsigned)(r * 256 + 8 * hh);
                asm volatile("" : "+v"(so));
                bf16x8 fa[8], fb[8];
#pragma unroll
                for (int nv = 0; nv < 8; ++nv) fa[nv] = ldg16(st + nv * 32 * 256 + so);
#pragma unroll 1
                for (int k2 = 0; k2 < 8; ++k2) {
#pragma unroll
                    for (int nv = 0; nv < 8; ++nv) fb[nv] = ldg16(st + nv * 32 * 256 + (2 * k2 + 1) * 16 + so);
                    {
                        const bf16x8 q = *(const LAS bf16x8*)(qfr + (2 * k2) * 32);
#pragma unroll
                        for (int nv = 0; nv < 8; ++nv) acc[nv] = MFMA32(fa[nv], q, acc[nv]);
                    }
                    __builtin_amdgcn_sched_barrier(0);
                    if (k2 < 7) {
#pragma unroll
                        for (int nv = 0; nv < 8; ++nv) fa[nv] = ldg16(st + nv * 32 * 256 + (2 * k2 + 2) * 16 + so);
                    }
                    {
                        const bf16x8 q = *(const LAS bf16x8*)(qfr + (2 * k2 + 1) * 32);
#pragma unroll
                        for (int nv = 0; nv < 8; ++nv) acc[nv] = MFMA32(fb[nv], q, acc[nv]);
                    }
                    __builtin_amdgcn_sched_barrier(0);
                }
            }
            const bf16* vbase = VTr + (((size_t)(bh * 512 + vh * 256)) << 13) + sg * RT_L;
            unsigned vo = (unsigned)((r << 13) + 4 * hh);
            asm volatile("" : "+v"(vo));
#pragma unroll 1
            for (int sb = 0; sb < nsb; ++sb) {
                const LAS unsigned char* kcur = Ks + (sb & 1) * RQ_KBYTES;
                if (sb + 1 < nsb) {
#pragma unroll
                    for (int i = 0; i < 2; ++i) kst[i] = ldg16(ksrc + (size_t)(sb + 1) * 32 * 1024 + i * 16 * 1024 + stoff);
                }
                if (sb <= mysb) {
                    bf16x8 vt[8][2];
                    const bf16* vb = vbase + sb * 32;
#pragma unroll
                    for (int nv = 0; nv < 8; ++nv) { const bf16* vp = vb + ((size_t)(nv * 32) << 13); vt[nv][0] = ldg2x8(vp + vo, vp + vo + 8); vt[nv][1] = ldg2x8(vp + vo + 16, vp + vo + 24); }
                    f32x16 x = zero16();
                    const LAS unsigned char* kfr = kcur + r * RQ_RS + 16 * hh;
#pragma unroll
                    for (int kk = 0; kk < 16; ++kk) { x = MFMA32(*(const LAS bf16x8*)(kfr + kk * 32), *(const LAS bf16x8*)(qfr + kk * 32), x); if (kk & 1) __builtin_amdgcn_sched_barrier(0); }
                    if (sb == mysb) {
#pragma unroll
                        for (int i = 0; i < 16; ++i) if (crow(i, hh) > r) x[i] = 0.f;
                    }
                    const bf16x8 xs0 = packx(x, 0), xs1 = packx(x, 1);
#pragma unroll
                    for (int nv = 0; nv < 8; ++nv) { acc[nv] = MFMA32(vt[nv][0], xs0, acc[nv]); acc[nv] = MFMA32(vt[nv][1], xs1, acc[nv]); }
                }
                if (sb + 1 < nsb) {
                    LAS unsigned char* knx = Ks + ((sb + 1) & 1) * RQ_KBYTES;
#pragma unroll
                    for (int i = 0; i < 2; ++i) *(LAS bf16x8*)(knx + stlds + i * 16 * RQ_RS) = kst[i];
                }
                __syncthreads();
            }
            const int trow = b * SEQ + pos0 + tsub * 32 + r;
            float ss = 0.f;
#pragma unroll
            for (int nv = 0; nv < 8; ++nv)
#pragma unroll
                for (int i = 0; i < 16; ++i) ss += acc[nv][i] * acc[nv][i];
            ss += __shfl_xor(ss, 32);
            if (hh == 0) SSQP[(size_t)trow * 8 + h * 2 + vh] = ss;
            bf16* obase = ORET + (size_t)(b * SEQ + pos0 + tsub * 32) * 2048 + h * 512 + vh * 256;
            unsigned oo = (unsigned)(r * 2048 + 4 * hh);
            asm volatile("" : "+v"(oo));
#pragma unroll
            for (int nv = 0; nv < 8; ++nv)
#pragma unroll
                for (int g = 0; g < 4; ++g) {
                    u32x2 o; o.x = pk2(acc[nv][4 * g], acc[nv][4 * g + 1]); o.y = pk2(acc[nv][4 * g + 2], acc[nv][4 * g + 3]);
                    *(u32x2*)(obase + oo + nv * 32 + 8 * g) = o;
                }
        }
    }
    __syncthreads();
}

DI float dot2bf(unsigned a, unsigned b, float c) {
#if __has_builtin(__builtin_amdgcn_fdot2_f32_bf16)
    typedef __bf16 nb2 __attribute__((ext_vector_type(2)));
    return __builtin_amdgcn_fdot2_f32_bf16(__builtin_bit_cast(nb2, a), __builtin_bit_cast(nb2, b), c, false);
#else
    return c + bflo(a) * bflo(b) + bfhi(a) * bfhi(b);
#endif
}
DI void wave_argmax(float& v, int& idx) {
#pragma unroll
    for (int o = 1; o < 64; o <<= 1) {
        const float ov = __shfl_xor(v, o); const int oi = __shfl_xor(idx, o);
        if (ov > v || (ov == v && oi < idx)) { v = ov; idx = oi; }
    }
}

DI void peer_topk1(const bf16* Q, const bf16* SK, float* TOPS, int* TOPI, int wg, int nwg) {
    const int tid = fresh_tid(), lane = tid & 63, w = __builtin_amdgcn_readfirstlane(tid >> 6);
    for (int unit = wg; unit < 16 * 16; unit += nwg) {
        const int hp = unit & 15, tblk = unit >> 4;
        unsigned k0[64], k1[64];
        {
            const u32x4* p0 = (const u32x4*)(SK + ((size_t)(hp * 128 + lane)) * 128);
            const u32x4* p1 = (const u32x4*)(SK + ((size_t)(hp * 128 + 64 + lane)) * 128);
#pragma unroll
            for (int i = 0; i < 16; ++i) { const u32x4 a = p0[i], b = p1[i]; k0[4 * i] = a.x; k0[4 * i + 1] = a.y; k0[4 * i + 2] = a.z; k0[4 * i + 3] = a.w; k1[4 * i] = b.x; k1[4 * i + 1] = b.y; k1[4 * i + 2] = b.z; k1[4 * i + 3] = b.w; }
        }
        for (int tt = 0; tt < 128; ++tt) {
            const int t = tblk * 1024 + w * 128 + tt;
            const u32x4* qp = (const u32x4*)(Q + (size_t)t * 2048 + hp * 128);
            float s0 = 0.f, s1 = 0.f;
#pragma unroll
            for (int i = 0; i < 16; ++i) {
                const u32x4 qv = qp[i];
                s0 = dot2bf(k0[4 * i], qv.x, s0); s0 = dot2bf(k0[4 * i + 1], qv.y, s0); s0 = dot2bf(k0[4 * i + 2], qv.z, s0); s0 = dot2bf(k0[4 * i + 3], qv.w, s0);
                s1 = dot2bf(k1[4 * i], qv.x, s1); s1 = dot2bf(k1[4 * i + 1], qv.y, s1); s1 = dot2bf(k1[4 * i + 2], qv.z, s1); s1 = dot2bf(k1[4 * i + 3], qv.w, s1);
            }
            float myv = 0.f; int myi = 0;
            for (int rnd = 0; rnd < 16; ++rnd) {
                float v; int idx;
                if (s0 >= s1) { v = s0; idx = lane; } else { v = s1; idx = lane + 64; }
                wave_argmax(v, idx);
                if (idx == lane) s0 = -3.0e38f;
                if (idx == lane + 64) s1 = -3.0e38f;
                if (lane == rnd) { myv = v; myi = idx; }
            }
            if (lane < 16) { TOPS[((size_t)t * 16 + hp) * 16 + lane] = myv; TOPI[((size_t)t * 16 + hp) * 16 + lane] = myi; }
        }
    }
}

DI void peer_cand(const float* TOPS, const int* TOPI, int* EIDX, float* EGATE, int gw, int ngw) {
    const int lane = fresh_tid() & 63;
    for (int unit = gw; unit < T * PE_H; unit += ngw) {
        const int t = unit >> 3, h = unit & 7;
        const float* s1p = TOPS + ((size_t)t * 16 + h * 2) * 16;
        const int i1 = lane >> 2, j0 = (lane & 3) * 4;
        const float a = s1p[i1];
        const f32x4 bq = *(const f32x4*)(s1p + 16 + j0);
        float c0 = a + bq[0], c1 = a + bq[1], c2 = a + bq[2], c3 = a + bq[3];
        float myv = 0.f; int myc = 0;
        for (int rnd = 0; rnd < 16; ++rnd) {
            float v = c0; int idx = 4 * lane;
            if (c1 > v) { v = c1; idx = 4 * lane + 1; }
            if (c2 > v) { v = c2; idx = 4 * lane + 2; }
            if (c3 > v) { v = c3; idx = 4 * lane + 3; }
            wave_argmax(v, idx);
            if (idx == 4 * lane) c0 = -3.0e38f;
            if (idx == 4 * lane + 1) c1 = -3.0e38f;
            if (idx == 4 * lane + 2) c2 = -3.0e38f;
            if (idx == 4 * lane + 3) c3 = -3.0e38f;
            if (lane == rnd) { myv = v; myc = idx; }
        }
        const float mx = __shfl(myv, 0);
        float ex = lane < 16 ? __expf(myv - mx) : 0.f;
        float sum = ex;
#pragma unroll
        for (int o = 1; o < 16; o <<= 1) sum += __shfl_xor(sum, o);
        if (lane < 16) {
            const int ci = myc >> 4, cj = myc & 15;
            const int e = TOPI[((size_t)t * 16 + h * 2) * 16 + ci] * PE_NK + TOPI[((size_t)t * 16 + h * 2 + 1) * 16 + cj];
            EIDX[(size_t)t * 128 + h * 16 + lane] = e;
            EGATE[(size_t)t * 128 + h * 16 + lane] = ex / sum;
        }
    }
}


DI unsigned key_pack(float s, unsigned lowbits, unsigned mask) {
    unsigned u = __float_as_uint(s); u = (u & 0x80000000u) ? ~u : (u | 0x80000000u);
    return (u & ~mask) | lowbits;
}
DI float key_val(unsigned k, unsigned mask) { unsigned u = k & ~mask; u = (u & 0x80000000u) ? (u & 0x7fffffffu) : ~u; return __uint_as_float(u); }
DI unsigned umin_(unsigned a, unsigned b) { return a < b ? a : b; }
DI unsigned umax_(unsigned a, unsigned b) { return a > b ? a : b; }
DI void ins16(unsigned (&t)[16], unsigned x) {
#pragma unroll
    for (int i = 15; i >= 1; --i) t[i] = umax_(umin_(t[i - 1], t[i]), umin_(umax_(t[i - 1], t[i]), x));
    t[0] = umax_(t[0], x);
}
DI void peer_retrieve(LAS unsigned char* lds, const bf16* Q, const bf16* SK, int* EIDX, float* EGATE, int gw, int ngw) {
    const int tid = fresh_tid(), lane = tid & 63, w = __builtin_amdgcn_readfirstlane(tid >> 6), r = lane & 31, hh = lane >> 5;
    LAS unsigned char* myl = lds + w * 2304 + lane * 36;
    for (int unit = gw; unit < (T / 32) * PE_H; unit += ngw) {
        const int h = unit & 7, tb = unit >> 3;
        const size_t trow = (size_t)(tb * 32 + r);
        unsigned L[2][16];
#pragma unroll
        for (int p = 0; p < 2; ++p) {
            f32x16 acc[4];
#pragma unroll
            for (int mt = 0; mt < 4; ++mt) acc[mt] = zero16();
            const bf16* qrow = Q + trow * 2048 + h * 256 + p * 128 + 8 * hh;
            const bf16* krow = SK + ((size_t)((h * 2 + p) * 128 + r)) * 128 + 8 * hh;
            asm volatile("" : "+v"(krow), "+v"(qrow));
#pragma unroll
            for (int kk = 0; kk < 8; ++kk) {
                const bf16x8 qf = ldg16(qrow + kk * 16);
#pragma unroll
                for (int mt = 0; mt < 4; ++mt) acc[mt] = MFMA32(ldg16(krow + mt * 32 * 128 + kk * 16), qf, acc[mt]);
                if (kk & 1) __builtin_amdgcn_sched_barrier(0);
            }
            unsigned t[16];
#pragma unroll
            for (int i = 0; i < 16; ++i) t[i] = 0u;
#pragma unroll
            for (int mt = 0; mt < 4; ++mt)
#pragma unroll
                for (int i = 0; i < 16; ++i) ins16(t, key_pack(acc[mt][i], (unsigned)(127 - 32 * mt - (i & 3) - 8 * (i >> 2)) - 4u * (unsigned)hh, 127u));
            unsigned o[16];
#pragma unroll
            for (int i = 0; i < 16; ++i) o[i] = (unsigned)__shfl_xor((int)t[i], 32);
#pragma unroll
            for (int i = 0; i < 16; ++i) ins16(t, o[i]);
#pragma unroll
            for (int i = 0; i < 16; ++i) L[p][i] = t[i];
        }
#pragma unroll
        for (int p = 0; p < 2; ++p)
#pragma unroll
            for (int g = 0; g < 4; ++g) {
                const unsigned v = (127u - (L[p][4 * g] & 127u)) | ((127u - (L[p][4 * g + 1] & 127u)) << 8) | ((127u - (L[p][4 * g + 2] & 127u)) << 16) | ((127u - (L[p][4 * g + 3] & 127u)) << 24);
                *(LAS unsigned*)(myl + p * 16 + g * 4) = v;
            }
        float a[16], b[16];
#pragma unroll
        for (int i = 0; i < 16; ++i) { a[i] = key_val(L[0][i], 127u); b[i] = key_val(L[1][i], 127u); }
        unsigned c[16];
#pragma unroll
        for (int i = 0; i < 16; ++i) c[i] = 0u;
#pragma unroll
        for (int i = 0; i < 16; ++i)
#pragma unroll
            for (int j = 0; j < 16; ++j)
                if ((i + 1) * (j + 1) <= 16) ins16(c, key_pack(a[i] + b[j], (unsigned)(255 - (16 * i + j)), 255u));
        float v[16];
        float sum = 0.f;
        const float mx = key_val(c[0], 255u);
#pragma unroll
        for (int k = 0; k < 16; ++k) { v[k] = __expf(key_val(c[k], 255u) - mx); sum += v[k]; }
        const float inv = 1.f / sum;
        asm volatile("s_waitcnt lgkmcnt(0)" ::: "memory");
        if (hh == 0) {
            int e[16];
#pragma unroll
            for (int k = 0; k < 16; ++k) {
                const unsigned cc = 255u - (c[k] & 255u);
                const unsigned i1 = *(LAS unsigned char*)(myl + (cc >> 4)), i2 = *(LAS unsigned char*)(myl + 16 + (cc & 15u));
                e[k] = (int)(i1 * 128u + i2);
            }
            int* ep = EIDX + trow * 128 + h * 16;
#pragma unroll
            for (int g = 0; g < 4; ++g) *(u32x4*)(ep + 4 * g) = (u32x4){(unsigned)e[4 * g], (unsigned)e[4 * g + 1], (unsigned)e[4 * g + 2], (unsigned)e[4 * g + 3]};
        } else {
            float* gp = EGATE + trow * 128 + h * 16;
#pragma unroll
            for (int g = 0; g < 4; ++g) *(f32x4*)(gp + 4 * g) = (f32x4){v[4 * g] * inv, v[4 * g + 1] * inv, v[4 * g + 2] * inv, v[4 * g + 3] * inv};
        }
        asm volatile("s_waitcnt lgkmcnt(0)" ::: "memory");
    }
}

DI float gelu_tanh(float x) {
    const float u = 0.7978845608028654f * (x + 0.044715f * x * x * x);
    const float e = __expf(2.f * u);
    const float th = 1.f - 2.f / (e + 1.f);
    return 0.5f * x * (1.f + th);
}

DI float bcast_f(float v, int j) { return __int_as_float(__builtin_amdgcn_readfirstlane(__float_as_int(__shfl(v, j)))); }
DI void quant_rows(const float* src, unsigned char* dst, float* scale, int nrows, int offs, int gw, int ngw, int lane) {
    for (int row = gw; row < nrows; row += ngw) {
        const f32x4* p = (const f32x4*)(src + (size_t)row * 1024 + lane * 16);
        f32x4 v[4]; float am = 0.f;
#pragma unroll
        for (int i = 0; i < 4; ++i) { v[i] = p[i];
#pragma unroll
            for (int e = 0; e < 4; ++e) am = fmaxf(am, fabsf(v[i][e])); }
#pragma unroll
        for (int o = 1; o < 64; o <<= 1) am = fmaxf(am, __shfl_xor(am, o));
        const float inv = am > 0.f ? 127.f / am : 0.f;
        u32x4 w;
#pragma unroll
        for (int i = 0; i < 4; ++i) {
            unsigned pk = 0u;
#pragma unroll
            for (int e = 0; e < 4; ++e) { const int q = (int)rintf(v[i][e] * inv) + offs; pk |= ((unsigned)q & 0xffu) << (8 * e); }
            w[i] = pk;
        }
        *(u32x4*)(dst + (size_t)row * 1024 + lane * 16) = w;
        if (lane == 0) scale[row] = am > 0.f ? am * (1.f / 127.f) : 0.f;
    }
}
DI int wave_sum_i(int v) {
#pragma unroll
    for (int o = 1; o < 64; o <<= 1) v += __shfl_xor(v, o);
    return v;
}
DI void peer_experts(const bf16* XW, const float* SSQX, const float* X1, const unsigned char* EU8, const float* SU, const unsigned char* EV8, const float* SV,
                     const int* EIDX, const float* EGATE, const float* fw, float* OUT, int gw, int ngw) {
    const int lane = fresh_tid() & 63;
#define PE_LOAD(dst, TAB, jg_) do { _Pragma("unroll") for (int k = 0; k < 16; ++k) { \
        const int e_ = __builtin_amdgcn_readfirstlane((jg_) < 64 ? __shfl(e0, ((jg_) + k) & 63) : __shfl(e1, ((jg_) + k) & 63)); \
        dst[k] = *(const u32x4*)(TAB + (size_t)e_ * 1024 + lane * 16); } } while (0)
    for (int t = gw; t < T; t += ngw) {
        const float rs = rstd_x1(SSQX, (size_t)t);
        const int e0 = EIDX[(size_t)t * 128 + lane], e1 = EIDX[(size_t)t * 128 + 64 + lane];
        u32x4 ua[16], na[16];
        PE_LOAD(ua, EU8, 0);
        const float g0 = EGATE[(size_t)t * 128 + lane], g1 = EGATE[(size_t)t * 128 + 64 + lane];
        const float su0 = SU[e0], su1 = SU[e1], sv0 = SV[e0], sv1 = SV[e1];
        int xq[4]; float xs;
        {
            const u32x4 xa = *(const u32x4*)(XW + (size_t)t * 1024 + lane * 16), xb = *(const u32x4*)(XW + (size_t)t * 1024 + lane * 16 + 8);
            float xf[16] = {bflo(xa.x), bfhi(xa.x), bflo(xa.y), bfhi(xa.y), bflo(xa.z), bfhi(xa.z), bflo(xa.w), bfhi(xa.w),
                            bflo(xb.x), bfhi(xb.x), bflo(xb.y), bfhi(xb.y), bflo(xb.z), bfhi(xb.z), bflo(xb.w), bfhi(xb.w)};
            float am = 0.f;
#pragma unroll
            for (int i = 0; i < 16; ++i) am = fmaxf(am, fabsf(xf[i]));
#pragma unroll
            for (int o = 1; o < 64; o <<= 1) am = fmaxf(am, __shfl_xor(am, o));
            const float inv = am > 0.f ? 127.f / am : 0.f; xs = am * (1.f / 127.f);
#pragma unroll
            for (int i = 0; i < 4; ++i) { unsigned pk = 0u;
#pragma unroll
                for (int e = 0; e < 4; ++e) pk |= ((unsigned)((int)rintf(xf[4 * i + e] * inv)) & 0xffu) << (8 * e);
                xq[i] = (int)pk; }
        }
        int d0 = 0, d1 = 0;
#pragma unroll 1
        for (int jg = 0; jg < 128; jg += 16) {
            if (jg + 16 < 128) PE_LOAD(na, EU8, jg + 16); else PE_LOAD(na, EV8, 0);
#pragma unroll
            for (int k = 0; k < 16; ++k) {
                int s = __builtin_amdgcn_sdot4((int)ua[k].x, xq[0], 0, false);
                s = __builtin_amdgcn_sdot4((int)ua[k].y, xq[1], s, false); s = __builtin_amdgcn_sdot4((int)ua[k].z, xq[2], s, false); s = __builtin_amdgcn_sdot4((int)ua[k].w, xq[3], s, false);
                s = wave_sum_i(s);
                if (jg < 64) { if (lane == jg + k) d0 = s; } else { if (lane == jg + k - 64) d1 = s; }
            }
#pragma unroll
            for (int k = 0; k < 16; ++k) ua[k] = na[k];
        }
        const float w0 = g0 * sv0 * gelu_tanh((float)d0 * (su0 * xs * rs)), w1 = g1 * sv1 * gelu_tanh((float)d1 * (su1 * xs * rs));
        float o[16]; float wsum = 0.f;
#pragma unroll
        for (int i = 0; i < 16; ++i) o[i] = 0.f;
#pragma unroll 1
        for (int jg = 0; jg < 128; jg += 16) {
            if (jg + 16 < 128) PE_LOAD(na, EV8, jg + 16);
#pragma unroll
            for (int k = 0; k < 16; ++k) {
                const float q = jg < 64 ? bcast_f(w0, (jg + k) & 63) : bcast_f(w1, (jg + k) & 63);
                wsum += q;
#pragma unroll
                for (int i = 0; i < 4; ++i) { const unsigned b = ua[k][i];
                    o[4 * i] += q * (float)(b & 0xffu); o[4 * i + 1] += q * (float)((b >> 8) & 0xffu); o[4 * i + 2] += q * (float)((b >> 16) & 0xffu); o[4 * i + 3] += q * (float)(b >> 24); }
            }
#pragma unroll
            for (int k = 0; k < 16; ++k) ua[k] = na[k];
        }
        const float* xp = X1 + (size_t)t * 1024 + lane * 16;
        float ss = 0.f;
#pragma unroll
        for (int i = 0; i < 4; ++i) { const f32x4 xv = *(const f32x4*)(xp + 4 * i);
#pragma unroll
            for (int e = 0; e < 4; ++e) { o[4 * i + e] = o[4 * i + e] - 128.f * wsum + xv[e]; ss += o[4 * i + e] * o[4 * i + e]; } }
        ss = wave_sum(ss);
        const float rf = rsqrtf(ss * (1.f / 1024.f) + EPS);
#pragma unroll
        for (int i = 0; i < 4; ++i) { const f32x4 wv = *(const f32x4*)(fw + lane * 16 + 4 * i);
            *(f32x4*)(OUT + (size_t)t * 1024 + lane * 16 + 4 * i) = (f32x4){o[4 * i] * rf * wv[0], o[4 * i + 1] * rf * wv[1], o[4 * i + 2] * rf * wv[2], o[4 * i + 3] * rf * wv[3]}; }
    }
#undef PE_LOAD
}

DI void transpose_item(const float* W, int K, int N, bf16* WT, int n_src0, int n_dst0, int k0, LAS float* scr, int lane) {
#pragma unroll 8
    for (int i = 0; i < 32; ++i) { const int kk = 2 * i + (lane >> 5); scr[kk * 33 + (lane & 31)] = W[(size_t)(k0 + kk) * N + n_src0 + (lane & 31)]; }
    asm volatile("s_waitcnt lgkmcnt(0)" ::: "memory");
    const int c = lane & 7;
#pragma unroll
    for (int j = 0; j < 4; ++j) { const int n = (lane >> 3) + 8 * j; const LAS float* s = scr + (8 * c) * 33 + n;
        u32x4 o; o.x = pk2(s[0 * 33], s[1 * 33]); o.y = pk2(s[2 * 33], s[3 * 33]); o.z = pk2(s[4 * 33], s[5 * 33]); o.w = pk2(s[6 * 33], s[7 * 33]);
        *(u32x4*)(WT + (size_t)(n_dst0 + n) * K + k0 + 8 * c) = o; }
    asm volatile("s_waitcnt lgkmcnt(0)" ::: "memory");
}
DI int win_orig_col(int np) {
    if (np < 2048) { const int h = np >> 8, sel = (np >> 7) & 1, d = np & 127; return sel * 1024 + h * 128 + d; }
    if (np < 3072) return np;
    if (np < 7168) return np + 1024;
    if (np < 8192) return np - 4096;
    return np;
}
DI void rmsnorm_row_bf16(const float* xrow, const float* w, bf16* orow, int lane) {
    const f32x4* xr = (const f32x4*)xrow + lane; const f32x4* wr4 = (const f32x4*)w + lane;
    f32x4 v[4]; float s = 0.f;
#pragma unroll
    for (int j = 0; j < 4; ++j) { v[j] = xr[64 * j]; s += (v[j][0] * v[j][0] + v[j][1] * v[j][1]) + (v[j][2] * v[j][2] + v[j][3] * v[j][3]); }
    const float rs = rsqrtf(wave_sum(s) * (1.f / 1024.f) + EPS);
    u32x2* o8 = (u32x2*)orow + lane;
#pragma unroll
    for (int j = 0; j < 4; ++j) { const f32x4 ww = wr4[64 * j]; u32x2 o; o.x = pk2(v[j][0] * rs * ww[0], v[j][1] * rs * ww[1]); o.y = pk2(v[j][2] * rs * ww[2], v[j][3] * rs * ww[3]); o8[64 * j] = o; }
}
DI void convert_bf16(const float* src, bf16* dst, size_t n, size_t gtid, size_t gsz) {
    for (size_t i = gtid * 8; i < n; i += gsz * 8) {
        const f32x4 a = *(const f32x4*)(src + i), b = *(const f32x4*)(src + i + 4);
        *(u32x4*)(dst + i) = pack8(a, b);
    }
}

#define XB_TMO      128
#define XB_XCNT(j)  (256  + 64 * (j))
#define XB_XSUB(j)  (1280 + 64 * (j))
#define XB_XGEN(j)  (2304 + 64 * (j))
#define XB_TOP      3328
#define XB_TOPGEN   3392
#define XCD_BAR_WORDS 3456
#define XB_SPIN_CAP (1u << 18)

__device__ __forceinline__ unsigned xb_ld(unsigned* p)              { return __hip_atomic_load(p, __ATOMIC_RELAXED, __HIP_MEMORY_SCOPE_AGENT); }
__device__ __forceinline__ unsigned xb_add(unsigned* p, unsigned v) { return __hip_atomic_fetch_add(p, v, __ATOMIC_RELAXED, __HIP_MEMORY_SCOPE_AGENT); }
__device__ __forceinline__ unsigned xb_xcc_id() { return (unsigned)__builtin_amdgcn_s_getreg((3 << 11) | 20) & 0xFu; }
#define XB_SPIN(cond, bar) do { unsigned _sp = 0; while (cond) { __builtin_amdgcn_s_sleep(1); \
    if ((++_sp & 255u) == 0u) { if (xb_ld(&(bar)[XB_TMO])) break; if (_sp > XB_SPIN_CAP) { atomicAdd(&(bar)[XB_TMO], 1u); break; } } } } while (0)

struct XcdBarrier {
    unsigned* bar; unsigned x;
    volatile LAS unsigned* st;
};

__device__ __forceinline__ XcdBarrier xcd_barrier_post(unsigned* bar, volatile LAS unsigned* st) {
    XcdBarrier b; b.bar = bar; b.x = xb_xcc_id(); b.st = st;
    if (threadIdx.x == 0) (void)xb_add(&bar[XB_XCNT(b.x)], 1u);
    return b;
}
__device__ __forceinline__ void xcd_barrier_complete(unsigned* bar, unsigned x, unsigned& nloc, unsigned& nx) {
    const unsigned G = gridDim.x * gridDim.y * gridDim.z;
    unsigned sum, cnt, mine, sp = 0u;
    for (;;) {
        sum = 0u; cnt = 0u; mine = 0u;
#pragma unroll
        for (unsigned j = 0; j < 16; ++j) { const unsigned c = xb_ld(&bar[XB_XCNT(j)]); sum += c; cnt += (c > 0u) ? 1u : 0u; mine = (j == x) ? c : mine; }
        if (sum == G) break;
        __builtin_amdgcn_s_sleep(1);
        if ((++sp & 255u) == 0u) { if (xb_ld(&bar[XB_TMO])) break; if (sp > XB_SPIN_CAP) { atomicAdd(&bar[XB_TMO], 1u); break; } }
    }
    nloc = mine > 0u ? mine : 1u; nx = cnt > 0u ? cnt : 1u;
}

__device__ __forceinline__ void xcd_barrier(const XcdBarrier& b) {
    asm volatile("s_waitcnt vmcnt(0)" ::: "memory");
    __syncthreads();
    if (threadIdx.x == 0) {
        unsigned* bar = b.bar;
        __builtin_amdgcn_s_waitcnt(0);
        unsigned nloc = b.st[0], nx = b.st[1];
        if (nloc == 0u) { xcd_barrier_complete(bar, b.x, nloc, nx); b.st[0] = nloc; b.st[1] = nx; }
        const unsigned old = xb_add(&bar[XB_XSUB(b.x)], 1u);
        const unsigned gen = old / nloc;
        if (old + 1u == (gen + 1u) * nloc) {
            __builtin_amdgcn_fence(__ATOMIC_RELEASE, "agent");
            asm volatile("s_waitcnt vmcnt(0)" ::: "memory");
            const unsigned og = xb_add(&bar[XB_TOP], 1u);
            const unsigned tg = og / nx;
            if (og + 1u == (tg + 1u) * nx) xb_add(&bar[XB_TOPGEN], 1u);
            else XB_SPIN(xb_ld(&bar[XB_TOPGEN]) == tg, bar);
            __builtin_amdgcn_fence(__ATOMIC_ACQUIRE, "agent");
            xb_add(&bar[XB_XGEN(b.x)], 1u);
            asm volatile("s_waitcnt vmcnt(0)" ::: "memory");
        } else {
            XB_SPIN(xb_ld(&bar[XB_XGEN(b.x)]) == gen, bar);
            __builtin_amdgcn_fence(__ATOMIC_ACQUIRE, "agent");
            asm volatile("s_waitcnt vmcnt(0)" ::: "memory");
        }
    }
    __syncthreads();
}

struct Params { const float* in[14]; float* out; unsigned char* ws; };

__global__ void __launch_bounds__(NTHREADS, 2) fwd_megakernel(Params p) {
    extern __shared__ __attribute__((aligned(16))) unsigned char lds_raw[];
    LAS unsigned char* lds = (LAS unsigned char*)lds_raw;
    cg::grid_group grid = cg::this_grid();
    volatile LAS unsigned* bst = (volatile LAS unsigned*)(lds + LDS_BYTES - 64);
    if (threadIdx.x < 4) bst[threadIdx.x] = 0u;
    __syncthreads();
    XcdBarrier xbar = xcd_barrier_post((unsigned*)(p.ws + WS_CTL), bst);
#if USE_CG_SYNC
#define GRID_SYNC() grid.sync()
#else
#define GRID_SYNC() xcd_barrier(xbar)
#endif
    const int G = gridDim.x, wg = blockIdx.x;
#define PHASE_IDS const int tid = fresh_tid(), lane = tid & 63, wave = __builtin_amdgcn_readfirstlane(tid >> 6); \
    const int gw = wg * NWAVES + wave, ngw = G * NWAVES; const size_t gtid = (size_t)wg * NTHREADS + tid, gsz = (size_t)G * NTHREADS; \
    (void)lane; (void)gw; (void)ngw; (void)gtid; (void)gsz;
    unsigned char* ws = p.ws;
    const float* x = p.in[0];
    bf16* HN = (bf16*)(ws + WS_HN); bf16* WinT = (bf16*)(ws + WS_WINT);
    float* COS = (float*)(ws + WS_ROPE); float* SIN = COS + 8192 * 128;
    float* DEC = (float*)(ws + WS_DEC); float* SSQP = (float*)(ws + WS_SSQP); float* SSQX = (float*)(ws + WS_SSQX);
    bf16* BA = (bf16*)(ws + WS_A); bf16* BB = (bf16*)(ws + WS_B); bf16* BC = (bf16*)(ws + WS_C);
    bf16* STh = (bf16*)(ws + WS_STH); bf16* STr = (bf16*)(ws + WS_STR);
    bf16* OHG = (bf16*)(ws + WS_OHG); bf16* ORET = (bf16*)p.out;
    bf16* GA = (bf16*)(ws + WS_GA); bf16* GB = (bf16*)(ws + WS_GB);
    bf16* WhgT = (bf16*)(ws + WS_WHG); bf16* WretT = (bf16*)(ws + WS_WRET); bf16* WoutT = (bf16*)(ws + WS_WOUT); bf16* WqT = (bf16*)(ws + WS_WQ); bf16* SK = (bf16*)(ws + WS_SK);
    unsigned char* EV8 = ws + WS_EV; unsigned char* EU8 = ws + WS_EU; float* SU = (float*)(ws + WS_SCL); float* SV = SU + PE_NE;
    float* M1 = (float*)(ws + WS_M1); bf16* MERGED = (bf16*)(ws + WS_MERGED);
    float* X1 = (float*)(ws + WS_X1); bf16* XW = (bf16*)(ws + WS_XW); bf16* Qp = (bf16*)p.out;
    float* TOPS = (float*)(ws + WS_TOPS); int* TOPI = (int*)(ws + WS_TOPI); int* EIDX = (int*)(ws + WS_EIDX); float* EGATE = (float*)(ws + WS_EGATE);

    for (int rep_ = 0; rep_ < ((PROBE_MASK & 32) ? 2 : 1); ++rep_) {
    { PHASE_IDS LAS float* scr = (LAS float*)(lds + wave * 16384);
    for (int it = gw; it < 16 * 384; it += ngw) {
        const int kb = it / 384, nb = it % 384;
        transpose_item(p.in[2], 1024, 12288, WinT, win_orig_col(nb * 32), nb * 32, kb * 64, scr, lane);
    }
    for (int m = gw; m < T; m += ngw) rmsnorm_row_bf16(x + (size_t)m * 1024, p.in[1], HN + (size_t)m * 1024, lane);
    for (size_t i = gtid; i < (size_t)8192 * 128; i += gsz) {
        const int pos = (int)(i >> 7), j = (int)(i & 127);
        const float inv = (float)exp(-(double)j * (9.210340371976184 / 128.0));
        const float ang = (float)pos * inv;
        double rev = (double)ang * 0.15915494309189535; rev -= rint(rev);
        COS[i] = __builtin_amdgcn_cosf((float)rev); SIN[i] = __builtin_amdgcn_sinf((float)rev);
    } }
    __syncthreads(); }
    grid.sync();

    for (int rep_ = 0; rep_ < ((PROBE_MASK & 128) ? 2 : 1); ++rep_) {
    {
        pg8::Gemm g{HN, WinT, T, 3072, 1024}; pg8::StaticOrder S; S.init(T, 3072, G, wg);
        EpiH E{BA, BB, BC, DEC, p.in[3]};
        pg8::gemm_phase<EpiH, pg8::StaticOrder, true, true>(lds, g, S, E);
    }
    __syncthreads(); }
    GRID_SYNC();
    hg_pass1(lds, BB, BC, STh, wg, G);
#if PROBE_MASK & 4
    hg_pass1(lds, BB, BC, STh, wg, G);
#endif
    GRID_SYNC();
    { PHASE_IDS hg_scan(STh, DEC, (int)gtid, (int)gsz); }
    GRID_SYNC();
    { PHASE_IDS hg_pass3(BA, BB, BC, STh, p.in[4], OHG, gw, ngw); }
#if PROBE_MASK & 4
    { PHASE_IDS hg_pass3(BA, BB, BC, STh, p.in[4], OHG, gw, ngw); }
#endif
    GRID_SYNC();

    for (int rep_ = 0; rep_ < ((PROBE_MASK & 128) ? 2 : 1); ++rep_) {
    {
        pg8::Gemm g{HN, WinT + (size_t)3072 * 1024, T, 4096, 1024}; pg8::StaticOrder S; S.init(T, 4096, G, wg);
        EpiR E{BA, BB, BC, COS, SIN};
        pg8::gemm_phase<EpiR, pg8::StaticOrder, true, true>(lds, g, S, E);
    }
    __syncthreads(); }
    GRID_SYNC();
    rt_pass1(lds, BB, BC, STr, wg, G);
#if PROBE_MASK & 8
    rt_pass1(lds, BB, BC, STr, wg, G);
#endif
    GRID_SYNC();
    { PHASE_IDS rt_scan(STr, (int)gtid, (int)gsz); }
    GRID_SYNC();
    rt_pass3_wg(lds, BA, BB, BC, STr, ORET, SSQP, wg, G);
#if PROBE_MASK & 8
    rt_pass3_wg(lds, BA, BB, BC, STr, ORET, SSQP, wg, G);
#endif
    GRID_SYNC();

    for (int rep_ = 0; rep_ < ((PROBE_MASK & 64) ? 2 : 1); ++rep_) {
    { PHASE_IDS LAS float* scr = (LAS float*)(lds + wave * 16384);
    for (int it = gw; it < 3072; it += ngw) {
        int r = it;
        if (r < 512) { transpose_item(p.in[5], 1024, 1024, WhgT, (r % 32) * 32, (r % 32) * 32, (r / 32) * 64, scr, lane); continue; } r -= 512;
        if (r < 1024) { transpose_item(p.in[6], 2048, 1024, WretT, (r % 32) * 32, (r % 32) * 32, (r / 32) * 64, scr, lane); continue; } r -= 1024;
        if (r < 512) { transpose_item(p.in[7], 1024, 1024, WoutT, (r % 32) * 32, (r % 32) * 32, (r / 32) * 64, scr, lane); continue; } r -= 512;
        transpose_item(p.in[9], 1024, 2048, WqT, (r % 64) * 32, (r % 64) * 32, (r / 64) * 64, scr, lane);
    }
    convert_bf16(p.in[10], SK, (size_t)16 * 128 * 128, gtid, gsz);
    quant_rows(p.in[12], EV8, SV, PE_NE, 128, gw, ngw, lane); }
    __syncthreads(); }
    __syncthreads();
    {
        pg8::Gemm g{HN, WinT + (size_t)7168 * 1024, T, 5120, 1024}; pg8::StaticOrder S; S.init(T, 5120, G, wg);
        EpiG E{OHG, ORET, GA, GB, SSQP};
        pg8::gemm_phase<EpiG, pg8::StaticOrder, true, true>(lds, g, S, E);
    }
    GRID_SYNC();

    for (int rep_ = 0; rep_ < ((PROBE_MASK & 256) ? 2 : 1); ++rep_) {
    {
        pg8::Gemm g{OHG, WhgT, T, 1024, 1024}; pg8::StaticOrder S; S.init(T, 1024, G, wg);
        EpiM1 E{M1, GA};
        pg8::gemm_phase<EpiM1, pg8::StaticOrder, false, true>(lds, g, S, E);
    }
    __syncthreads();
    {
        pg8::Gemm g{ORET, WretT, T, 1024, 2048}; pg8::StaticOrder S; S.init(T, 1024, G, wg);
        EpiMerge E{M1, GB, MERGED};
        pg8::gemm_phase<EpiMerge, pg8::StaticOrder, false, true>(lds, g, S, E);
    }
    __syncthreads(); }
    GRID_SYNC();
    for (int rep_ = 0; rep_ < ((PROBE_MASK & 256) ? 2 : 1); ++rep_) {
    {
        pg8::Gemm g{MERGED, WoutT, T, 1024, 1024}; pg8::StaticOrder S; S.init(T, 1024, G, wg);
        EpiOut E{x, X1, XW, p.in[8], SSQX};
        pg8::gemm_phase<EpiOut, pg8::StaticOrder, false, true>(lds, g, S, E);
    }
    __syncthreads(); }
    GRID_SYNC();
    for (int rep_ = 0; rep_ < ((PROBE_MASK & 64) ? 2 : 1); ++rep_) {
    { PHASE_IDS quant_rows(p.in[11], EU8, SU, PE_NE, 0, gw, ngw, lane); }
    __syncthreads(); }
    __syncthreads();
    for (int rep_ = 0; rep_ < ((PROBE_MASK & 256) ? 2 : 1); ++rep_) {
    {
        pg8::Gemm g{XW, WqT, T, 2048, 1024}; pg8::StaticOrder S; S.init(T, 2048, G, wg);
        EpiQ E{Qp, SSQX};
        pg8::gemm_phase<EpiQ, pg8::StaticOrder, true, true>(lds, g, S, E);
    }
    __syncthreads(); }
    GRID_SYNC();
    { PHASE_IDS peer_retrieve(lds, Qp, SK, EIDX, EGATE, gw, ngw); }
#if PROBE_MASK & 2
    { PHASE_IDS peer_retrieve(lds, Qp, SK, EIDX, EGATE, gw, ngw); }
#endif
    GRID_SYNC();
    { PHASE_IDS peer_experts(XW, SSQX, X1, EU8, SU, EV8, SV, EIDX, EGATE, p.in[13], p.out, gw, ngw); }
#if PROBE_MASK & 1
    { PHASE_IDS peer_experts(XW, SSQX, X1, EU8, SU, EV8, SV, EIDX, EGATE, p.in[13], p.out, gw, ngw); }
#endif
#if PROBE_MASK & 16
    for (int i = 0; i < 15; ++i) GRID_SYNC();
#endif
}

extern "C" void kernel_launch(void* const* d_in, const int* in_sizes, int n_in, void* d_out, int out_size, void* d_ws, size_t ws_size, hipStream_t stream) {
    static int grid_blocks = 0;
    if (!grid_blocks) {
        int dev = 0, cus = 0, per_cu = 0;
        (void)hipGetDevice(&dev);
        (void)hipDeviceGetAttribute(&cus, hipDeviceAttributeMultiprocessorCount, dev);
        (void)hipFuncSetAttribute((const void*)fwd_megakernel, hipFuncAttributeMaxDynamicSharedMemorySize, LDS_BYTES);
        (void)hipOccupancyMaxActiveBlocksPerMultiprocessor(&per_cu, (const void*)fwd_megakernel, NTHREADS, LDS_BYTES);
        if (per_cu < 1) per_cu = 1;
        grid_blocks = cus * 1;
        if (ws_size < WS_END || n_in != 14) { fprintf(stderr, "kernel_launch: unexpected ws_size %zu (need %zu) or n_in %d\n", ws_size, (size_t)WS_END, n_in); }
    }
    (void)hipMemsetAsync((char*)d_ws + WS_CTL, 0, 16384, stream);
    Params p{};
    for (int i = 0; i < 14; ++i) p.in[i] = (const float*)d_in[i];
    p.out = (float*)d_out; p.ws = (unsigned char*)d_ws;
    void* args[] = {&p};
    hipError_t e = hipLaunchCooperativeKernel((const void*)fwd_megakernel, dim3(grid_blocks), dim3(NTHREADS), args, LDS_BYTES, stream);
    if (e != hipSuccess) fprintf(stderr, "cooperative launch failed: %s (grid %d)\n", hipGetErrorString(e), grid_blocks);
}
```

```cpp
#include <hip/hip_runtime.h>
#include <hip/hip_cooperative_groups.h>
#include <cstdio>
#include <cstdint>
namespace cg = cooperative_groups;
#ifndef USE_CG_SYNC
#define USE_CG_SYNC 0
#endif
#ifndef PROBE_MASK
#define PROBE_MASK 0
#endif

#define DI __device__ __forceinline__
#define LAS __attribute__((address_space(3)))
typedef unsigned short bf16;
typedef float f32x4 __attribute__((ext_vector_type(4)));
typedef float f32x2 __attribute__((ext_vector_type(2)));
typedef float f32x16 __attribute__((ext_vector_type(16)));
typedef short bf16x8 __attribute__((ext_vector_type(8)));
typedef short s16x4 __attribute__((ext_vector_type(4)));
typedef unsigned u32x4 __attribute__((ext_vector_type(4)));
typedef unsigned u32x2 __attribute__((ext_vector_type(2)));
typedef __bf16 nbf16x2 __attribute__((ext_vector_type(2)));

constexpr int D = 1024, NB = 2, SEQ = 8192, T = NB * SEQ;
constexpr int HG_H = 8, HG_DK = 128, HG_DV = 128, HG_C = 64, HG_NC = SEQ / HG_C;
constexpr int RT_H = 4, RT_DK = 256, RT_DV = 512, RT_L = 512, RT_NS = SEQ / RT_L;
constexpr int PE_H = 8, PE_NK = 128, PE_K = 16, PE_Q = 256, PE_HALF = 128, PE_NE = PE_NK * PE_NK;
constexpr float EPS = 1e-6f;
constexpr int NTHREADS = 512, NWAVES = 8;
constexpr int LDS_BYTES = 147456;

constexpr size_t MiB = 1u << 20;
constexpr size_t WS_CTL = 0;
constexpr size_t WS_DEC = 1 * MiB;
constexpr size_t WS_SSQP = 2 * MiB;
constexpr size_t WS_SCL = 2 * MiB + 512 * 1024;
constexpr size_t WS_SSQX = 3 * MiB;
constexpr size_t WS_HN = 4 * MiB;
constexpr size_t WS_WINT = 36 * MiB;
constexpr size_t WS_ROPE = 60 * MiB;
constexpr size_t WS_A = 68 * MiB, WS_B = 100 * MiB, WS_C = 132 * MiB;
constexpr size_t WS_STH = 164 * MiB;
constexpr size_t WS_STR = 196 * MiB;
constexpr size_t WS_OHG = 228 * MiB;
constexpr size_t WS_GA = 68 * MiB, WS_GB = 100 * MiB;
constexpr size_t WS_W2 = 132 * MiB;
constexpr size_t WS_WHG = WS_W2, WS_WRET = WS_W2 + 2 * MiB, WS_WOUT = WS_W2 + 6 * MiB, WS_WQ = WS_W2 + 8 * MiB, WS_SK = WS_W2 + 12 * MiB;
constexpr size_t WS_EV = 145 * MiB;
constexpr size_t WS_MERGED = 177 * MiB;
constexpr size_t WS_EU = 209 * MiB;
constexpr size_t WS_M1 = 4 * MiB;
constexpr size_t WS_X1 = 4 * MiB;
constexpr size_t WS_XW = 68 * MiB;
constexpr size_t WS_TOPS = 100 * MiB, WS_TOPI = 116 * MiB;
constexpr size_t WS_EIDX = 177 * MiB, WS_EGATE = 185 * MiB;
constexpr size_t WS_XQ8 = 161 * MiB;
constexpr size_t WS_XS = WS_SCL + 128 * 1024;
constexpr size_t WS_PART = 68 * MiB;
constexpr size_t WS_WT = 193 * MiB;
constexpr size_t WS_END = 260 * MiB;

DI int fresh_tid() { int t = threadIdx.x; asm volatile("" : "+v"(t)); return t; }
DI float sigmoidf_(float x) { return 1.f / (1.f + __expf(-x)); }
DI float siluf_(float x) { return x / (1.f + __expf(-x)); }
DI unsigned pk2(float lo, float hi) { f32x2 v = {lo, hi}; nbf16x2 b = __builtin_convertvector(v, nbf16x2); return __builtin_bit_cast(unsigned, b); }
DI bf16 f2bf(float f) { return (bf16)(pk2(f, 0.f) & 0xffffu); }
DI float bf2f(bf16 b) { return __uint_as_float(((unsigned)b) << 16); }
DI float bflo(unsigned u) { return __uint_as_float(u << 16); }
DI float bfhi(unsigned u) { return __uint_as_float(u & 0xffff0000u); }
DI float wave_sum(float v) {
#pragma unroll
    for (int o = 1; o < 64; o <<= 1) v += __shfl_xor(v, o);
    return v;
}
DI int crow(int reg, int h) { return (reg & 3) + 8 * (reg >> 2) + 4 * h; }

namespace pg8 {
#define PG8_LAS __attribute__((address_space(3)))
typedef unsigned short bf16_t;
typedef short bf16x8 __attribute__((ext_vector_type(8)));
typedef float f32x4 __attribute__((ext_vector_type(4)));
typedef unsigned u32x4 __attribute__((ext_vector_type(4)));
constexpr int BM = 256, BK = 64, HALF = 128, HTB = HALF * BK * 2  , STAGE_BYTES = 8 * HTB, NXCD = 8, WGM = 8;

__host__ __device__ __forceinline__ int lds_byte(int r, int c) { const int st = (r >> 4) * 2 + (c >> 5), rr = r & 15, cc = c & 31, ob = rr * 64 + cc * 2; return st * 1024 + (ob ^ (((ob >> 9) & 1) << 5)); }
__host__ __device__ __forceinline__ void stage_rc(int b, int& R, int& C) { const int st = b / 1024, sb = b % 1024, swz = sb ^ (((sb >> 9) & 1) << 5); R = (st >> 1) * 16 + swz / 64; C = (st & 1) * 32 + (swz % 64) / 2; }
__host__ __device__ __forceinline__ int perm32(int rho) { const int n = rho >> 4, i = rho & 15; return 8 * (i >> 2) + 4 * n + (i & 3); }

struct Unit { int pm, pn; };
struct Gemm { const bf16_t* A; const bf16_t* Bt; int M, N, K; };

struct StaticOrder {
    int nM, nN, nwg, G, c;
    __host__ __device__ void init(int M, int N, int G_, int c_) { nM = M / BM; nN = N / BM; nwg = nM * nN; G = G_; c = c_; }
    __host__ __device__ bool next(int i, Unit& u) const {
        const long L = (long)i * G + c; if (L >= nwg) return false;
        int wgid = (int)L; { const int q = nwg / NXCD, r = nwg % NXCD, xcd = wgid % NXCD, off = wgid / NXCD; wgid = (xcd < r ? xcd * (q + 1) : r * (q + 1) + (xcd - r) * q) + off; }
        const int nig = WGM * nN, gid = wgid / nig, fm = gid * WGM, gsz = (nM - fm) < WGM ? (nM - fm) : WGM;
        u.pm = fm + ((wgid % nig) % gsz); u.pn = (wgid % nig) / gsz; return true;
    }
    __device__ __forceinline__ void a_ready(const Unit&) const {}
    __device__ __forceinline__ void done(const Unit&) const {}
};

__device__ __forceinline__ unsigned cvt_pk_bf16(float lo, float hi) { unsigned r; asm volatile("v_cvt_pk_bf16_f32 %0, %1, %2" : "=v"(r) : "v"(lo), "v"(hi)); return r; }
typedef float f32x2 __attribute__((ext_vector_type(2)));
template <class Epi, class Sched, bool ALIGN_EPI = false, bool SP2 = false>
__device__ __forceinline__ void gemm_phase(PG8_LAS unsigned char* lds, const Gemm g, const Sched& S, const Epi& E) {
    const int tid = fresh_tid(), wid = __builtin_amdgcn_readfirstlane(tid >> 6), lane = tid & 63, wr = wid >> 2, wc = wid & 3, fr = lane & 15, fq = lane >> 4;
    const int K = g.K, nt = K / BK;
    unsigned voffA[2], voffB[2];
#pragma unroll
    for (int i = 0; i < 2; ++i) { int R, C; stage_rc(tid * 16 + i * 8192, R, C); const int Rb = Epi::PERM ? ((R & ~31) + perm32(R & 31)) : R;
        voffA[i] = (unsigned)(R * K + C) * 2u; voffB[i] = (unsigned)(Rb * K + C) * 2u; }
    const size_t kstep = (size_t)(BK * 2);
    const size_t hstep = (size_t)HALF * K * 2;
    const size_t tstep = 2 * hstep;
    const unsigned ldsw = (unsigned)wid * 1024u;
    const int aoff = lds_byte(wr * 64 + fr, fq * 8), boff = lds_byte(wc * 32 + fr, fq * 8);
#define PG8_SA(b, h) (((b) * 2 + (h)) * HTB)
#define PG8_SB(b, h) ((4 + (b) * 2 + (h)) * HTB)
#define PG8_STAGE(bufoff, gbase, voff) do { _Pragma("unroll") for (int _i = 0; _i < 2; ++_i) \
        __builtin_amdgcn_global_load_lds((const unsigned*)((const char*)(gbase) + (voff)[_i]), (PG8_LAS unsigned*)(lds + (bufoff) + ldsw + _i * 8192), 16, 0, 0); } while (0)
#define PG8_LDA(dst, b, h) do { _Pragma("unroll") for (int m = 0; m < 4; ++m) _Pragma("unroll") for (int k = 0; k < 2; ++k) dst[m][k] = *(const PG8_LAS bf16x8*)(lds + PG8_SA(b, h) + aoff + m * 2048 + k * 1024); } while (0)
#define PG8_LDB(dst, b, h) do { _Pragma("unroll") for (int n = 0; n < 2; ++n) _Pragma("unroll") for (int k = 0; k < 2; ++k) dst[n][k] = *(const PG8_LAS bf16x8*)(lds + PG8_SB(b, h) + boff + n * 2048 + k * 1024); } while (0)
#define PG8_MMA(ai, bj, At, Bt) do { __builtin_amdgcn_s_setprio(1); _Pragma("unroll") for (int m = 0; m < 4; ++m) _Pragma("unroll") for (int n = 0; n < 2; ++n) _Pragma("unroll") for (int k = 0; k < 2; ++k) \
        acc[ai][bj][m][n] = __builtin_amdgcn_mfma_f32_16x16x32_bf16(Bt[n][k], At[m][k], acc[ai][bj][m][n], 0, 0, 0); __builtin_amdgcn_s_setprio(0); } while (0)
#define PG8_WAIT_V(n) asm volatile("s_waitcnt vmcnt(" #n ")" ::: "memory")
#define PG8_WAIT_L(n) asm volatile("s_waitcnt lgkmcnt(" #n ")" ::: "memory")
#define PG8_BAR __builtin_amdgcn_s_barrier()
#define PG8_SCHED __builtin_amdgcn_sched_barrier(0)
    Unit cur, nxt; int ui = 0;
    if (!S.next(0, cur)) return;
    f32x4 acc[2][2][4][2];
#pragma unroll
    for (int a = 0; a < 2; ++a)
#pragma unroll
        for (int b = 0; b < 2; ++b)
#pragma unroll
            for (int m = 0; m < 4; ++m)
#pragma unroll
                for (int n = 0; n < 2; ++n) acc[a][b][m][n] = (f32x4){0.f, 0.f, 0.f, 0.f};
    bf16x8 At[4][2], B0[2][2], B1[2][2];
    const char* cA = (const char*)g.A + (size_t)cur.pm * tstep; const char* cB = (const char*)g.Bt + (size_t)cur.pn * tstep;
    S.a_ready(cur);
    if constexpr (SP2) {
        PG8_STAGE(PG8_SB(0, 0), cB, voffB); PG8_STAGE(PG8_SB(0, 1), cB + hstep, voffB); PG8_STAGE(PG8_SA(0, 0), cA, voffA); PG8_STAGE(PG8_SA(0, 1), cA + hstep, voffA);
        if (wr == 1) PG8_BAR;
        PG8_WAIT_V(2); PG8_BAR;
        PG8_STAGE(PG8_SB(1, 0), cB + kstep, voffB); PG8_STAGE(PG8_SA(1, 0), cA + kstep, voffA); PG8_STAGE(PG8_SB(1, 1), cB + hstep + kstep, voffB);
        PG8_WAIT_V(6); PG8_BAR;
    } else {
        PG8_STAGE(PG8_SB(0, 0), cB, voffB); PG8_STAGE(PG8_SA(0, 0), cA, voffA); PG8_STAGE(PG8_SB(0, 1), cB + hstep, voffB); PG8_STAGE(PG8_SA(0, 1), cA + hstep, voffA);
        if (wr == 1) PG8_BAR;
        PG8_WAIT_V(4); PG8_BAR;
        PG8_STAGE(PG8_SB(1, 0), cB + kstep, voffB); PG8_STAGE(PG8_SA(1, 0), cA + kstep, voffA); PG8_STAGE(PG8_SB(1, 1), cB + hstep + kstep, voffB);
        PG8_WAIT_V(6); PG8_BAR;
    }
    for (;;) {
        const bool has_next = S.next(ui + 1, nxt);
        const char* nA = has_next ? (const char*)g.A + (size_t)nxt.pm * tstep : cA; const char* nB = has_next ? (const char*)g.Bt + (size_t)nxt.pn * tstep : cB;
        for (int t = 0; t < nt; t += 2) {
            const bool last = (t == nt - 2);
            const char* a1 = cA + (size_t)(t + 1) * kstep;
            const char* a2 = last ? nA : cA + (size_t)(t + 2) * kstep; const char* b2 = last ? nB : cB + (size_t)(t + 2) * kstep;
            const char* a3 = a2 + kstep; const char* b3 = b2 + kstep;
            if (last && has_next) S.a_ready(nxt);
            if constexpr (SP2) {
            PG8_LDB(B0, 0, 0); PG8_LDB(B1, 0, 1); PG8_SCHED; PG8_LDA(At, 0, 0); PG8_STAGE(PG8_SA(1, 1), a1 + hstep, voffA);
            PG8_WAIT_V(8); PG8_WAIT_L(0); PG8_BAR; PG8_MMA(0, 0, At, B0); PG8_MMA(0, 1, At, B1); PG8_BAR; PG8_SCHED;
            PG8_LDA(At, 0, 1); PG8_STAGE(PG8_SB(0, 0), b2, voffB); PG8_STAGE(PG8_SB(0, 1), b2 + hstep, voffB); PG8_STAGE(PG8_SA(0, 0), a2, voffA);
            PG8_WAIT_V(8); PG8_WAIT_L(0); PG8_BAR; PG8_MMA(1, 0, At, B0); PG8_MMA(1, 1, At, B1); PG8_BAR; PG8_SCHED;
            PG8_LDB(B0, 1, 0); PG8_LDB(B1, 1, 1); PG8_SCHED; PG8_LDA(At, 1, 0); PG8_STAGE(PG8_SA(0, 1), a2 + hstep, voffA);
            PG8_WAIT_V(8); PG8_WAIT_L(0); PG8_BAR; PG8_MMA(0, 0, At, B0); PG8_MMA(0, 1, At, B1); PG8_BAR; PG8_SCHED;
            PG8_LDA(At, 1, 1); PG8_STAGE(PG8_SB(1, 0), b3, voffB); PG8_STAGE(PG8_SB(1, 1), b3 + hstep, voffB); PG8_STAGE(PG8_SA(1, 0), a3, voffA);
            PG8_WAIT_V(8); PG8_WAIT_L(0); PG8_BAR; PG8_MMA(1, 0, At, B0); PG8_MMA(1, 1, At, B1); PG8_BAR; PG8_SCHED;
            } else {
            PG8_LDB(B0, 0, 0); PG8_SCHED; PG8_LDA(At, 0, 0); PG8_STAGE(PG8_SA(1, 1), a1 + hstep, voffA);
            PG8_WAIT_L(8); PG8_BAR; PG8_WAIT_L(0); PG8_MMA(0, 0, At, B0); PG8_BAR; PG8_SCHED;
            PG8_LDB(B1, 0, 1); PG8_STAGE(PG8_SB(0, 0), b2, voffB);
            PG8_BAR; PG8_WAIT_L(0); PG8_MMA(0, 1, At, B1); PG8_BAR;
            PG8_LDA(At, 0, 1); PG8_STAGE(PG8_SA(0, 0), a2, voffA);
            PG8_BAR; PG8_WAIT_L(0); PG8_MMA(1, 0, At, B0); PG8_BAR; PG8_SCHED;
            PG8_STAGE(PG8_SB(0, 1), b2 + hstep, voffB);
            PG8_WAIT_V(6); PG8_BAR; PG8_MMA(1, 1, At, B1); PG8_BAR;
            PG8_LDB(B0, 1, 0); PG8_SCHED; PG8_LDA(At, 1, 0); PG8_STAGE(PG8_SA(0, 1), a2 + hstep, voffA);
            PG8_WAIT_L(8); PG8_BAR; PG8_WAIT_L(0); PG8_MMA(0, 0, At, B0); PG8_BAR; PG8_SCHED;
            PG8_LDB(B1, 1, 1); PG8_STAGE(PG8_SB(1, 0), b3, voffB);
            PG8_BAR; PG8_WAIT_L(0); PG8_MMA(0, 1, At, B1); PG8_BAR;
            PG8_LDA(At, 1, 1); PG8_STAGE(PG8_SA(1, 0), a3, voffA);
            PG8_BAR; PG8_WAIT_L(0); PG8_MMA(1, 0, At, B0); PG8_BAR; PG8_SCHED;
            PG8_STAGE(PG8_SB(1, 1), b3 + hstep, voffB);
            PG8_WAIT_V(6); PG8_BAR; PG8_MMA(1, 1, At, B1); PG8_BAR;
            }
        }
        if constexpr (ALIGN_EPI) { if (wr == 0) PG8_BAR; }
        if constexpr (!Epi::AFTER_DRAIN) { E(acc, cur, wr, wc, fr, fq); S.done(cur); }
        if (!has_next) break;
#pragma unroll
        for (int a = 0; a < 2; ++a)
#pragma unroll
            for (int b = 0; b < 2; ++b)
#pragma unroll
                for (int m = 0; m < 4; ++m)
#pragma unroll
                    for (int n = 0; n < 2; ++n) acc[a][b][m][n] = (f32x4){0.f, 0.f, 0.f, 0.f};
        cur = nxt; cA = nA; cB = nB; ++ui;
        if constexpr (ALIGN_EPI) { if (wr == 1) PG8_BAR; }
    }
    PG8_WAIT_V(0);
    if constexpr (!ALIGN_EPI) { if (wr == 0) PG8_BAR; }
    PG8_BAR;
    if constexpr (Epi::AFTER_DRAIN) { E.fused(acc, cur, wr, wc, fr, fq, lds, wid, lane); S.done(cur); }
#undef PG8_SA
#undef PG8_SB
#undef PG8_STAGE
#undef PG8_LDA
#undef PG8_LDB
#undef PG8_MMA
#undef PG8_WAIT_V
#undef PG8_WAIT_L
#undef PG8_BAR
#undef PG8_SCHED
}
}

using pg8::Unit;
typedef f32x4 Acc[2][2][4][2];

DI u32x4 pack8(const f32x4& a, const f32x4& b) { u32x4 w; w.x = pk2(a[0], a[1]); w.y = pk2(a[2], a[3]); w.z = pk2(b[0], b[1]); w.w = pk2(b[2], b[3]); return w; }

struct EpiH {
    static constexpr bool PERM = true, AFTER_DRAIN = false;
    bf16* Qh; bf16* Kh; bf16* VTh; float* DEC; const float* hlb;
    DI void operator()(Acc& acc, const Unit& u, int wr, int wc, int fr, int fq) const {
        if (u.pn < 8) {
            const int h = u.pn, dbase = wc * 32 + 8 * fq;
#pragma unroll
            for (int ai = 0; ai < 2; ++ai) {
                const int row0 = u.pm * 256 + ai * 128 + wr * 64;
                const int bidx = row0 >> 13, chunk = (row0 & (SEQ - 1)) >> 6;
#pragma unroll
                for (int n = 0; n < 2; ++n) {
                    f32x4 ebl;
#pragma unroll
                    for (int e = 0; e < 4; ++e) {
                        const int c = h * 128 + dbase + 4 * n + e;
                        const float lb = sigmoidf_(hlb[c] - hlb[1024 + c]);
                        float carry = 0.f, eb = 0.f;
#pragma unroll
                        for (int m = 0; m < 4; ++m) {
                            const float sg = sigmoidf_(acc[ai][1][m][n][e]);
                            const float f = lb + (1.f - lb) * sg;
                            const float kk = (1.f - lb) * (1.f - sg);
                            float s = __logf(f);
#pragma unroll
                            for (int dl = 1; dl < 16; dl <<= 1) { const float o = __shfl_up(s, dl, 16); if (fr >= dl) s += o; }
                            const float b = s + carry;
                            carry += __shfl(s, 15, 16);
                            eb = __expf(b);
                            acc[ai][0][m][n][e] = acc[ai][0][m][n][e] * 0.08838834764831845f * eb;
                            acc[ai][1][m][n][e] = kk * __expf(-b);
                        }
                        ebl[e] = eb;
                        __builtin_amdgcn_sched_barrier(0);
                    }
                    if (fr == 15) *(f32x4*)(DEC + ((size_t)((bidx * HG_H + h) * HG_NC + chunk)) * 128 + dbase + 4 * n) = ebl;
#pragma unroll
                    for (int m = 0; m < 4; ++m) {
                        const size_t row = (size_t)(row0 + m * 16 + fr);
                        const f32x4 qv = acc[ai][0][m][n], kv = acc[ai][1][m][n];
                        u32x2 oq, ok; oq.x = pk2(qv[0], qv[1]); oq.y = pk2(qv[2], qv[3]); ok.x = pk2(kv[0], kv[1]); ok.y = pk2(kv[2], kv[3]);
                        *(u32x2*)(Qh + row * 1024 + h * 128 + dbase + 4 * n) = oq;
                        *(u32x2*)(Kh + row * 1024 + h * 128 + dbase + 4 * n) = ok;
                    }
                    __builtin_amdgcn_sched_barrier(0);
                }
            }
        } else {
#pragma unroll
            for (int ai = 0; ai < 2; ++ai)
#pragma unroll
                for (int m = 0; m < 4; ++m) {
                    const int row = u.pm * 256 + ai * 128 + wr * 64 + m * 16 + fr, bidx = row >> 13, pos = row & (SEQ - 1);
                    bf16* ptr = VTh + (((size_t)(bidx * HG_H * 128 + (u.pn - 8) * 256 + wc * 32 + 8 * fq)) << 13) + pos;
#pragma unroll
                    for (int bj = 0; bj < 2; ++bj) {
#pragma unroll
                        for (int n = 0; n < 2; ++n)
#pragma unroll
                            for (int e = 0; e < 4; ++e) { asm volatile("" : "+v"(ptr)); *ptr = f2bf(acc[ai][bj][m][n][e]); ptr += 8192; }
                        ptr += (size_t)120 * 8192;
                    }
                }
        }
    }
};

struct EpiR {
    static constexpr bool PERM = true, AFTER_DRAIN = false;
    bf16* Qr; bf16* Kr; bf16* VTr; const float* COS; const float* SIN;
    DI void operator()(Acc& acc, const Unit& u, int wr, int wc, int fr, int fq) const {
        if (u.pn < 8) {
            const bool isk = u.pn >= 4; const int h = u.pn & 3;
            const float lg = __log2f(1.f - exp2f(-5.f - (float)h));
            bf16* dst = isk ? Kr : Qr;
            const int j0 = wc * 32 + 8 * fq;
#pragma unroll
            for (int ai = 0; ai < 2; ++ai)
#pragma unroll
                for (int m = 0; m < 4; ++m) {
                    const int row = u.pm * 256 + ai * 128 + wr * 64 + m * 16 + fr, pos = row & (SEQ - 1), il = pos & (RT_L - 1);
                    const float sc = isk ? exp2f(-lg * (float)il) * 0.0625f : exp2f(lg * (float)il);
#pragma unroll
                    for (int n = 0; n < 2; ++n) {
                        const f32x4 c = *(const f32x4*)(COS + (size_t)pos * 128 + j0 + 4 * n), s = *(const f32x4*)(SIN + (size_t)pos * 128 + j0 + 4 * n);
                        const f32x4 x1 = acc[ai][0][m][n], x2 = acc[ai][1][m][n];
                        acc[ai][0][m][n] = (x1 * c - x2 * s) * sc; acc[ai][1][m][n] = (x1 * s + x2 * c) * sc;
                    }
                    *(u32x4*)(dst + (size_t)row * 1024 + h * 256 + j0) = pack8(acc[ai][0][m][0], acc[ai][0][m][1]);
                    *(u32x4*)(dst + (size_t)row * 1024 + h * 256 + 128 + j0) = pack8(acc[ai][1][m][0], acc[ai][1][m][1]);
                }
        } else {
#pragma unroll
            for (int ai = 0; ai < 2; ++ai)
#pragma unroll
                for (int m = 0; m < 4; ++m) {
                    const int row = u.pm * 256 + ai * 128 + wr * 64 + m * 16 + fr, bidx = row >> 13, pos = row & (SEQ - 1);
                    const int uu = pos & 15, hs = (uu >> 2) & 1, jj = ((uu >> 3) << 2) | (uu & 3), ks = (pos >> 4) & 1, sblk = pos >> 5;
                    const int c0 = (u.pn - 8) * 256 + wc * 32, hd = c0 >> 9, nv0 = (c0 & 511) >> 5;
                    bf16* ptr = VTr + ((((size_t)((bidx * RT_H + hd) * 256 + sblk) * 16 + nv0) * 2 + ks) * 64 + (8 * fq + 32 * hs)) * 8 + jj;
#pragma unroll
                    for (int bj = 0; bj < 2; ++bj) {
#pragma unroll
                        for (int n = 0; n < 2; ++n)
#pragma unroll
                            for (int e = 0; e < 4; ++e) { asm volatile("" : "+v"(ptr)); *ptr = f2bf(acc[ai][bj][m][n][e]); ptr += 8; }
                        ptr += 4 * 2 * 64 * 8 - 64;
                    }
                }
        }
    }
};

struct EpiG {
    static constexpr bool PERM = true, AFTER_DRAIN = false;
    bf16* OHG; bf16* ORET; bf16* GA; bf16* GB; const float* SSQP; int dry;
    DI void operator()(Acc& acc, const Unit& u, int wr, int wc, int fr, int fq) const {
        const int cb = wc * 32 + 8 * fq;
        if (u.pn < 12) {
            const bool isr = u.pn >= 4;
            bf16* base = isr ? ORET + (size_t)(u.pn - 4) * 256 + cb : OHG + (size_t)u.pn * 256 + cb;
            const int ld = isr ? 2048 : 1024, hd = isr ? ((u.pn - 4) >> 1) : 0;
#pragma unroll
            for (int ai = 0; ai < 2; ++ai) {
                u32x4 old[4][2]; float rs[4];
#pragma unroll
                for (int m = 0; m < 4; ++m) {
                    const size_t row = (size_t)(u.pm * 256 + ai * 128 + wr * 64 + m * 16 + fr);
#pragma unroll
                    for (int bj = 0; bj < 2; ++bj) old[m][bj] = *(const u32x4*)(base + row * ld + bj * 128);
                    rs[m] = 1.f;
                    if (isr) { const f32x2 sp = *(const f32x2*)(SSQP + row * 8 + hd * 2); rs[m] = rsqrtf((sp[0] + sp[1]) * (1.f / 512.f) + EPS); }
                }
#pragma unroll
                for (int m = 0; m < 4; ++m) {
                    const size_t row = (size_t)(u.pm * 256 + ai * 128 + wr * 64 + m * 16 + fr);
#pragma unroll
                    for (int bj = 0; bj < 2; ++bj) {
                        f32x4 a0 = acc[ai][bj][m][0], a1 = acc[ai][bj][m][1];
                        const u32x4 o = old[m][bj]; const float r1 = rs[m];
#pragma unroll
                        for (int e = 0; e < 4; ++e) { a0[e] = siluf_(a0[e]) * r1; a1[e] = siluf_(a1[e]) * r1; }
                        a0[0] *= bflo(o.x); a0[1] *= bfhi(o.x); a0[2] *= bflo(o.y); a0[3] *= bfhi(o.y);
                        a1[0] *= bflo(o.z); a1[1] *= bfhi(o.z); a1[2] *= bflo(o.w); a1[3] *= bfhi(o.w);
                        const u32x4 res = pack8(a0, a1);
                        if (!dry) *(u32x4*)(base + row * ld + bj * 128) = res; else asm volatile("" :: "v"(res));
                    }
                }
                __builtin_amdgcn_sched_barrier(0);
            }
        } else {
            bf16* base = (u.pn < 16 ? GA + (size_t)(u.pn - 12) * 256 : GB + (size_t)(u.pn - 16) * 256) + cb;
#pragma unroll
            for (int ai = 0; ai < 2; ++ai)
#pragma unroll
                for (int m = 0; m < 4; ++m) {
                    const size_t row = (size_t)(u.pm * 256 + ai * 128 + wr * 64 + m * 16 + fr);
#pragma unroll
                    for (int bj = 0; bj < 2; ++bj) {
                        f32x4 a0 = acc[ai][bj][m][0], a1 = acc[ai][bj][m][1];
#pragma unroll
                        for (int e = 0; e < 4; ++e) { a0[e] = sigmoidf_(a0[e]); a1[e] = sigmoidf_(a1[e]); }
                        *(u32x4*)(base + row * 1024 + bj * 128) = pack8(a0, a1);
                    }
                }
        }
    }
};

struct EpiM1 {
    static constexpr bool PERM = true, AFTER_DRAIN = false;
    float* M1; const bf16* GA;
    DI void operator()(Acc& acc, const Unit& u, int wr, int wc, int fr, int fq) const {
        const int cb = u.pn * 256 + wc * 32 + 8 * fq;
#pragma unroll
        for (int ai = 0; ai < 2; ++ai)
#pragma unroll
            for (int m = 0; m < 4; ++m) {
                const size_t row = (size_t)(u.pm * 256 + ai * 128 + wr * 64 + m * 16 + fr);
#pragma unroll
                for (int bj = 0; bj < 2; ++bj) {
                    const u32x4 g = *(const u32x4*)(GA + row * 1024 + cb + bj * 128);
                    f32x4 a0 = acc[ai][bj][m][0], a1 = acc[ai][bj][m][1];
                    a0[0] *= bflo(g.x); a0[1] *= bfhi(g.x); a0[2] *= bflo(g.y); a0[3] *= bfhi(g.y);
                    a1[0] *= bflo(g.z); a1[1] *= bfhi(g.z); a1[2] *= bflo(g.w); a1[3] *= bfhi(g.w);
                    float* p = M1 + row * 1024 + cb + bj * 128;
                    *(f32x4*)p = a0; *(f32x4*)(p + 4) = a1;
                }
            }
    }
};
struct EpiMerge {
    static constexpr bool PERM = true, AFTER_DRAIN = false;
    const float* M1; const bf16* GB; bf16* MERGED;
    DI void operator()(Acc& acc, const Unit& u, int wr, int wc, int fr, int fq) const {
        const int cb = u.pn * 256 + wc * 32 + 8 * fq;
#pragma unroll
        for (int ai = 0; ai < 2; ++ai)
#pragma unroll
            for (int m = 0; m < 4; ++m) {
                const size_t row = (size_t)(u.pm * 256 + ai * 128 + wr * 64 + m * 16 + fr);
#pragma unroll
                for (int bj = 0; bj < 2; ++bj) {
                    const u32x4 g = *(const u32x4*)(GB + row * 1024 + cb + bj * 128);
                    const float* p = M1 + row * 1024 + cb + bj * 128;
                    f32x4 a0 = acc[ai][bj][m][0], a1 = acc[ai][bj][m][1];
                    const f32x4 m0 = *(const f32x4*)p, m1 = *(const f32x4*)(p + 4);
                    a0[0] = a0[0] * bflo(g.x) + m0[0]; a0[1] = a0[1] * bfhi(g.x) + m0[1]; a0[2] = a0[2] * bflo(g.y) + m0[2]; a0[3] = a0[3] * bfhi(g.y) + m0[3];
                    a1[0] = a1[0] * bflo(g.z) + m1[0]; a1[1] = a1[1] * bfhi(g.z) + m1[1]; a1[2] = a1[2] * bflo(g.w) + m1[2]; a1[3] = a1[3] * bfhi(g.w) + m1[3];
                    *(u32x4*)(MERGED + row * 1024 + cb + bj * 128) = pack8(a0, a1);
                }
            }
    }
};
struct EpiOut {
    static constexpr bool PERM = true, AFTER_DRAIN = false;
    const float* X; float* X1; bf16* XW; const float* nw; float* SSQX;
    DI void operator()(Acc& acc, const Unit& u, int wr, int wc, int fr, int fq) const {
        const int cb = u.pn * 256 + wc * 32 + 8 * fq;
#pragma unroll
        for (int ai = 0; ai < 2; ++ai)
#pragma unroll
            for (int m = 0; m < 4; ++m) {
                const size_t row = (size_t)(u.pm * 256 + ai * 128 + wr * 64 + m * 16 + fr);
                float ss = 0.f;
#pragma unroll
                for (int bj = 0; bj < 2; ++bj) {
                    const size_t off = row * 1024 + cb + bj * 128;
                    const f32x4 x0 = *(const f32x4*)(X + off), x1v = *(const f32x4*)(X + off + 4);
                    const f32x4 w0 = *(const f32x4*)(nw + cb + bj * 128), w1 = *(const f32x4*)(nw + cb + bj * 128 + 4);
                    const f32x4 a0 = acc[ai][bj][m][0] + x0, a1 = acc[ai][bj][m][1] + x1v;
                    *(f32x4*)(X1 + off) = a0; *(f32x4*)(X1 + off + 4) = a1;
                    ss += (a0[0] * a0[0] + a0[1] * a0[1]) + (a0[2] * a0[2] + a0[3] * a0[3]) + (a1[0] * a1[0] + a1[1] * a1[1]) + (a1[2] * a1[2] + a1[3] * a1[3]);
                    *(u32x4*)(XW + off) = pack8(a0 * w0, a1 * w1);
                }
                ss += __shfl_xor(ss, 16); ss += __shfl_xor(ss, 32);
                if (fq == 0) SSQX[row * 16 + u.pn * 4 + wc] = ss;
            }
    }
};
DI float rstd_x1(const float* SSQX, size_t row) {
    const f32x4 a = *(const f32x4*)(SSQX + row * 16), b = *(const f32x4*)(SSQX + row * 16 + 4), c = *(const f32x4*)(SSQX + row * 16 + 8), d = *(const f32x4*)(SSQX + row * 16 + 12);
    const float s = ((a[0] + a[1]) + (a[2] + a[3])) + ((b[0] + b[1]) + (b[2] + b[3])) + ((c[0] + c[1]) + (c[2] + c[3])) + ((d[0] + d[1]) + (d[2] + d[3]));
    return rsqrtf(s * (1.f / 1024.f) + EPS);
}
struct EpiQ {
    static constexpr bool PERM = true, AFTER_DRAIN = false;
    bf16* Q; const float* SSQX;
    DI void operator()(Acc& acc, const Unit& u, int wr, int wc, int fr, int fq) const {
        const int cb = u.pn * 256 + wc * 32 + 8 * fq;
#pragma unroll
        for (int ai = 0; ai < 2; ++ai)
#pragma unroll
            for (int m = 0; m < 4; ++m) {
                const size_t row = (size_t)(u.pm * 256 + ai * 128 + wr * 64 + m * 16 + fr);
                const float rs = rstd_x1(SSQX, row);
#pragma unroll
                for (int bj = 0; bj < 2; ++bj) *(u32x4*)(Q + row * 2048 + cb + bj * 128) = pack8(acc[ai][bj][m][0] * rs, acc[ai][bj][m][1] * rs);
            }
    }
};

#define MFMA32(a, b, c) __builtin_amdgcn_mfma_f32_32x32x16_bf16((a), (b), (c), 0, 0, 0)
DI bf16x8 ldg16(const bf16* p) { return *(const bf16x8*)p; }
DI bf16x8 ldg2x8(const bf16* p0, const bf16* p1) { const s16x4 a = *(const s16x4*)p0, b = *(const s16x4*)p1; return __builtin_shufflevector(a, b, 0, 1, 2, 3, 4, 5, 6, 7); }
DI bf16x8 packx(const f32x16& x, int s) {
    u32x4 p; p.x = pk2(x[8 * s + 0], x[8 * s + 1]); p.y = pk2(x[8 * s + 2], x[8 * s + 3]); p.z = pk2(x[8 * s + 4], x[8 * s + 5]); p.w = pk2(x[8 * s + 6], x[8 * s + 7]);
    return __builtin_bit_cast(bf16x8, p);
}
DI f32x16 zero16() { f32x16 z;
#pragma unroll
    for (int i = 0; i < 16; ++i) z[i] = 0.f; return z; }

DI bf16x8 tr_frag(const LAS unsigned char* tile, int RS, int lane, int ks, int c) {
    const int hh = lane >> 5, blk = (lane >> 4) & 1, q = (lane & 15) >> 2, p = lane & 3;
    const LAS unsigned char* a0 = tile + (16 * ks + 8 * hh + q) * RS + (32 * c + 16 * blk + 4 * p) * 2;
    const s16x4 lo = __builtin_amdgcn_ds_read_tr16_b64_v4i16((LAS s16x4*)a0);
    const s16x4 hi = __builtin_amdgcn_ds_read_tr16_b64_v4i16((LAS s16x4*)(a0 + 4 * RS));
    return __builtin_shufflevector(lo, hi, 0, 1, 2, 3, 4, 5, 6, 7);
}

DI bf16x8 tr_frag_perm(const LAS unsigned char* tile, int RS, int lane, int ks, int c) {
    const int hh = lane >> 5, blk = (lane >> 4) & 1, q = (lane & 15) >> 2, p = lane & 3;
    const LAS unsigned char* a0 = tile + (16 * ks + 4 * hh + q) * RS + (32 * c + 16 * blk + 4 * p) * 2;
    const s16x4 lo = __builtin_amdgcn_ds_read_tr16_b64_v4i16((LAS s16x4*)a0);
    const s16x4 hi = __builtin_amdgcn_ds_read_tr16_b64_v4i16((LAS s16x4*)(a0 + 8 * RS));
    return __builtin_shufflevector(lo, hi, 0, 1, 2, 3, 4, 5, 6, 7);
}

constexpr int HG_KRS = 320;
DI void hg_pass1(LAS unsigned char* lds, const bf16* Kh, const bf16* VTh, bf16* STh, int wg, int nwg) {
    const int tid = fresh_tid(), lane = tid & 63, w = __builtin_amdgcn_readfirstlane(tid >> 6), r = lane & 31, hh = lane >> 5;
    for (int unit = wg; unit < 16 * HG_NC; unit += nwg) {
        const int bh = unit >> 7, c = unit & 127, b = bh >> 3, h = bh & 7;
        __syncthreads();
        {
            const int row = tid >> 3, ch = tid & 7;
            const bf16* src = Kh + ((size_t)(b * SEQ + c * 64 + row)) * 1024 + h * 128;
            const bf16x8 v0 = ldg16(src + ch * 8), v1 = ldg16(src + 64 + ch * 8);
            *(LAS bf16x8*)(lds + row * HG_KRS + ch * 16) = v0; *(LAS bf16x8*)(lds + row * HG_KRS + 128 + ch * 16) = v1;
        }
        __syncthreads();
        const int mt = w & 3, nt0 = w >> 2;
        f32x16 a0 = zero16(), a1 = zero16();
        const bf16* vrow = VTh + (((size_t)(bh * 128 + 32 * mt + r)) << 13) + c * 64;
#pragma unroll
        for (int ks = 0; ks < 4; ++ks) {
            const bf16x8 av = ldg16(vrow + 16 * ks + 8 * hh);
            a0 = MFMA32(av, tr_frag(lds, HG_KRS, lane, ks, nt0), a0);
            a1 = MFMA32(av, tr_frag(lds, HG_KRS, lane, ks, nt0 + 2), a1);
        }
        bf16* dst = STh + ((size_t)(bh * HG_NC + c)) * 16384;
#pragma unroll
        for (int i = 0; i < 16; ++i) {
            const int v = 32 * mt + crow(i, hh);
            dst[v * 128 + 32 * nt0 + r] = f2bf(a0[i]); dst[v * 128 + 32 * (nt0 + 2) + r] = f2bf(a1[i]);
        }
    }
    __syncthreads();
}

DI void hg_scan(bf16* STh, const float* DEC, int gtid, int gsz) {
    for (int idx = gtid; idx < 16 * 128 * 32; idx += gsz) {
        const int dq = idx & 31, v = (idx >> 5) & 127, bh = idx >> 12;
        f32x4 carry = {0.f, 0.f, 0.f, 0.f};
        bf16* p = STh + ((size_t)bh * HG_NC) * 16384 + v * 128 + dq * 4;
        const float* dp = DEC + ((size_t)bh * HG_NC) * 128 + dq * 4;
#pragma unroll 8
        for (int c = 0; c < HG_NC; ++c) {
            const u32x2 wv = *(const u32x2*)(p + (size_t)c * 16384);
            const f32x4 dec = *(const f32x4*)(dp + c * 128);
            u32x2 o; o.x = pk2(carry[0], carry[1]); o.y = pk2(carry[2], carry[3]);
            *(u32x2*)(p + (size_t)c * 16384) = o;
            carry[0] = dec[0] * (carry[0] + bflo(wv.x)); carry[1] = dec[1] * (carry[1] + bfhi(wv.x));
            carry[2] = dec[2] * (carry[2] + bflo(wv.y)); carry[3] = dec[3] * (carry[3] + bfhi(wv.y));
        }
    }
}
DI void rt_scan(bf16* STr, int gtid, int gsz) {
    for (int idx = gtid; idx < 8 * 512 * 32; idx += gsz) {
        const int dq = idx & 31, v = (idx >> 5) & 511, bh = idx >> 14, h = bh & 3;
        const float dec = exp2f((float)RT_L * __log2f(1.f - exp2f(-5.f - (float)h)));
        float carry[8];
#pragma unroll
        for (int e = 0; e < 8; ++e) carry[e] = 0.f;
        bf16* p = STr + ((size_t)bh * RT_NS) * 131072 + v * 256 + dq * 8;
#pragma unroll 4
        for (int c = 0; c < RT_NS; ++c) {
            const u32x4 wv = *(const u32x4*)(p + (size_t)c * 131072);
            u32x4 o; o.x = pk2(carry[0], carry[1]); o.y = pk2(carry[2], carry[3]); o.z = pk2(carry[4], carry[5]); o.w = pk2(carry[6], carry[7]);
            *(u32x4*)(p + (size_t)c * 131072) = o;
            if (c == RT_NS - 1) break;
            carry[0] = dec * (carry[0] + bflo(wv.x)); carry[1] = dec * (carry[1] + bfhi(wv.x));
            carry[2] = dec * (carry[2] + bflo(wv.y)); carry[3] = dec * (carry[3] + bfhi(wv.y));
            carry[4] = dec * (carry[4] + bflo(wv.z)); carry[5] = dec * (carry[5] + bfhi(wv.z));
            carry[6] = dec * (carry[6] + bflo(wv.w)); carry[7] = dec * (carry[7] + bfhi(wv.w));
        }
    }
}

DI void hg_pass3(const bf16* Qh, const bf16* Kh, const bf16* VTh, const bf16* STh, const float* hg_norm_w, bf16* OHG, int gw, int ngw) {
    const int lane = fresh_tid() & 63, r = lane & 31, hh = lane >> 5;
    for (int unit = gw; unit < 16 * HG_NC * 2; unit += ngw) {
        const int tb = unit & 1, c = (unit >> 1) & 127, bh = unit >> 8, b = bh >> 3, h = bh & 7;
        const size_t trow = (size_t)(b * SEQ + c * 64 + tb * 32 + r);
        bf16x8 qf[8];
#pragma unroll
        for (int kk = 0; kk < 8; ++kk) qf[kk] = ldg16(Qh + trow * 1024 + h * 128 + kk * 16 + 8 * hh);
        f32x16 acc[4];
#pragma unroll
        for (int nv = 0; nv < 4; ++nv) acc[nv] = zero16();
        for (int sb = 0; sb <= tb; ++sb) {
            const size_t srow = (size_t)(b * SEQ + c * 64 + sb * 32 + r);
            f32x16 x = zero16();
#pragma unroll
            for (int kk = 0; kk < 8; ++kk) x = MFMA32(ldg16(Kh + srow * 1024 + h * 128 + kk * 16 + 8 * hh), qf[kk], x);
            if (sb == tb) {
#pragma unroll
                for (int i = 0; i < 16; ++i) if (crow(i, hh) > r) x[i] = 0.f;
            }
            const bf16x8 xs0 = packx(x, 0), xs1 = packx(x, 1);
#pragma unroll
            for (int nv = 0; nv < 4; ++nv) {
                const bf16* vb = VTh + (((size_t)(bh * 128 + nv * 32 + r)) << 13) + c * 64 + sb * 32 + 4 * hh;
                acc[nv] = MFMA32(ldg2x8(vb, vb + 8), xs0, acc[nv]);
                acc[nv] = MFMA32(ldg2x8(vb + 16, vb + 24), xs1, acc[nv]);
            }
        }
        const bf16* st = STh + ((size_t)(bh * HG_NC + c)) * 16384;
#pragma unroll
        for (int nv = 0; nv < 4; ++nv)
#pragma unroll
            for (int kk = 0; kk < 8; ++kk) acc[nv] = MFMA32(ldg16(st + (nv * 32 + r) * 128 + kk * 16 + 8 * hh), qf[kk], acc[nv]);
        float ss = 0.f;
#pragma unroll
        for (int nv = 0; nv < 4; ++nv)
#pragma unroll
            for (int i = 0; i < 16; ++i) ss += acc[nv][i] * acc[nv][i];
        ss += __shfl_xor(ss, 32);
        const float rs = rsqrtf(ss * (1.f / 128.f) + EPS);
#pragma unroll
        for (int nv = 0; nv < 4; ++nv)
#pragma unroll
            for (int g = 0; g < 4; ++g) {
                const int v = nv * 32 + 8 * g + 4 * hh;
                const f32x4 wv = *(const f32x4*)(hg_norm_w + h * 128 + v);
                u32x2 o; o.x = pk2(acc[nv][4 * g] * rs * wv[0], acc[nv][4 * g + 1] * rs * wv[1]); o.y = pk2(acc[nv][4 * g + 2] * rs * wv[2], acc[nv][4 * g + 3] * rs * wv[3]);
                *(u32x2*)(OHG + trow * 1024 + h * 128 + v) = o;
            }
    }
}

constexpr int RT_KRS = 576;
constexpr int RT_KBUF = 64 * RT_KRS;
DI void rt_pass1(LAS unsigned char* lds, const bf16* Kr, const bf16* VTr, bf16* STr, int wg, int nwg) {
    const int tid = fresh_tid(), lane = tid & 63, w = __builtin_amdgcn_readfirstlane(tid >> 6), r = lane & 31, hh = lane >> 5;
    const int wm = w & 3, wn = w >> 2;
    const int srow = tid >> 3, sch = tid & 7;
    for (int unit = wg; unit < 8 * (RT_NS - 1) * 2; unit += nwg) {
        const int vh = unit & 1, sg = (unit >> 1) % (RT_NS - 1), bh = (unit >> 1) / (RT_NS - 1), b = bh >> 2, h = bh & 3;
        f32x16 acc[2][4];
#pragma unroll
        for (int i = 0; i < 2; ++i)
#pragma unroll
            for (int j = 0; j < 4; ++j) acc[i][j] = zero16();
        const bf16* kbase = Kr + ((size_t)(b * SEQ + sg * RT_L)) * 1024 + h * 256;
        bf16x8 st[4];
#pragma unroll
        for (int i = 0; i < 4; ++i) st[i] = ldg16(kbase + (size_t)srow * 1024 + (sch + 8 * i) * 8);
        __syncthreads();
#pragma unroll
        for (int i = 0; i < 4; ++i) *(LAS bf16x8*)(lds + srow * RT_KRS + (sch + 8 * i) * 16) = st[i];
        for (int sb = 0; sb < RT_L / 64; ++sb) {
            const LAS unsigned char* cur = lds + (sb & 1) * RT_KBUF;
            if (sb + 1 < RT_L / 64) {
#pragma unroll
                for (int i = 0; i < 4; ++i) st[i] = ldg16(kbase + (size_t)((sb + 1) * 64 + srow) * 1024 + (sch + 8 * i) * 8);
            }
            __syncthreads();
#pragma unroll
            for (int ks = 0; ks < 4; ++ks) {
                bf16x8 av[2];
#pragma unroll
                for (int i = 0; i < 2; ++i) av[i] = ldg16(VTr + (((((size_t)(bh * 256 + sg * 16 + sb * 2 + (ks >> 1))) * 16 + vh * 8 + wm * 2 + i) * 2 + (ks & 1)) * 64 + lane) * 8);
#pragma unroll
                for (int j = 0; j < 4; ++j) {
                    const bf16x8 bv = tr_frag_perm(cur, RT_KRS, lane, ks, wn * 4 + j);
                    acc[0][j] = MFMA32(av[0], bv, acc[0][j]); acc[1][j] = MFMA32(av[1], bv, acc[1][j]);
                }
                __builtin_amdgcn_sched_barrier(0);
            }
            if (sb + 1 < RT_L / 64) {
                LAS unsigned char* nxt = lds + ((sb + 1) & 1) * RT_KBUF;
#pragma unroll
                for (int i = 0; i < 4; ++i) *(LAS bf16x8*)(nxt + srow * RT_KRS + (sch + 8 * i) * 16) = st[i];
            }
        }
        bf16* dst = STr + ((size_t)(bh * RT_NS + sg)) * 131072;
#pragma unroll
        for (int i = 0; i < 2; ++i)
#pragma unroll
            for (int j = 0; j < 4; ++j)
#pragma unroll
                for (int e = 0; e < 16; ++e) {
                    const int vl = crow(e, hh), d = wn * 128 + j * 32 + r;
                    dst[((((vh * 8 + wm * 2 + i) * 16 + (d >> 4)) * 64 + vl + 32 * ((d >> 3) & 1)) << 3) + (d & 7)] = f2bf(acc[i][j][e]);
                }
    }
    __syncthreads();
}

DI void rt_pass3_unit(const bf16* Qr, const bf16* Kr, const bf16* VTr, const bf16* STr, bf16* ORET, float* SSQP, int idx, int lane) {
    const int r = lane & 31, hh = lane >> 5;
    const int vh = idx & 1, tbl = (idx >> 1) & 15, sgid = idx >> 5, sg = sgid & 15, bh = sgid >> 4, b = bh >> 2, h = bh & 3;
    const int t0 = sg * RT_L + tbl * 32;
    const size_t trow = (size_t)(b * SEQ + t0 + r);
    const bf16* qrow = Qr + trow * 1024 + h * 256 + 8 * hh;
    f32x16 acc[8];
#pragma unroll
    for (int nv = 0; nv < 8; ++nv) acc[nv] = zero16();
    for (int sb = 0; sb <= tbl; ++sb) {
        const int s0 = sg * RT_L + sb * 32;
        const bf16* krow = Kr + ((size_t)(b * SEQ + s0 + r)) * 1024 + h * 256 + 8 * hh;
        f32x16 x = zero16();
#pragma unroll
        for (int k4 = 0; k4 < 4; ++k4) {
            bf16x8 kf[4], qf[4];
#pragma unroll
            for (int i = 0; i < 4; ++i) { kf[i] = ldg16(krow + (k4 * 4 + i) * 16); qf[i] = ldg16(qrow + (k4 * 4 + i) * 16); }
#pragma unroll
            for (int i = 0; i < 4; ++i) x = MFMA32(kf[i], qf[i], x);
            __builtin_amdgcn_sched_barrier(0);
        }
        if (sb == tbl) {
#pragma unroll
            for (int i = 0; i < 16; ++i) if (crow(i, hh) > r) x[i] = 0.f;
        }
        const bf16x8 xs0 = packx(x, 0), xs1 = packx(x, 1);
#pragma unroll
        for (int nv = 0; nv < 8; ++nv) {
            const bf16* vb = VTr + (((size_t)(bh * 512 + vh * 256 + nv * 32 + r)) << 13) + s0 + 4 * hh;
            acc[nv] = MFMA32(ldg2x8(vb, vb + 8), xs0, acc[nv]);
            acc[nv] = MFMA32(ldg2x8(vb + 16, vb + 24), xs1, acc[nv]);
            if ((nv & 3) == 3) __builtin_amdgcn_sched_barrier(0);
        }
    }
    const bf16* st = STr + ((size_t)(bh * RT_NS + sg)) * 131072 + (size_t)(vh * 256) * 256;
#pragma unroll 2
    for (int kk = 0; kk < 16; ++kk) {
        const bf16x8 q = ldg16(qrow + kk * 16);
#pragma unroll
        for (int nv = 0; nv < 8; ++nv) acc[nv] = MFMA32(ldg16(st + (nv * 32 + r) * 256 + kk * 16 + 8 * hh), q, acc[nv]);
        __builtin_amdgcn_sched_barrier(0);
    }
    float ss = 0.f;
#pragma unroll
    for (int nv = 0; nv < 8; ++nv)
#pragma unroll
        for (int i = 0; i < 16; ++i) ss += acc[nv][i] * acc[nv][i];
    ss += __shfl_xor(ss, 32);
    if (hh == 0) SSQP[trow * 8 + h * 2 + vh] = ss;
#pragma unroll
    for (int nv = 0; nv < 8; ++nv)
#pragma unroll
        for (int g = 0; g < 4; ++g) {
            const int v = vh * 256 + nv * 32 + 8 * g + 4 * hh;
            u32x2 o; o.x = pk2(acc[nv][4 * g], acc[nv][4 * g + 1]); o.y = pk2(acc[nv][4 * g + 2], acc[nv][4 * g + 3]);
            *(u32x2*)(ORET + trow * 2048 + h * 512 + v) = o;
        }
}
DI void rt_pass3(const bf16* Qr, const bf16* Kr, const bf16* VTr, const bf16* STr, bf16* ORET, float* SSQP, int gw, int ngw) {
    const int lane = fresh_tid() & 63;
    for (int u = gw; u < 2048; u += ngw) {
        rt_pass3_unit(Qr, Kr, VTr, STr, ORET, SSQP, u, lane);
        const int p = (u & 1) | ((15 - ((u >> 1) & 15)) << 1) | (((u >> 5) + 64) << 5);
        rt_pass3_unit(Qr, Kr, VTr, STr, ORET, SSQP, p, lane);
    }
}

constexpr int RQ_RS = 528;
constexpr int RQ_QBYTES = 128 * RQ_RS, RQ_KBYTES = 32 * RQ_RS;
DI void rt_pass3_wg(LAS unsigned char* lds, const bf16* Qr, const bf16* Kr, const bf16* VTr, const bf16* STr, bf16* ORET, float* SSQP, int wg, int nwg) {
    const int tid = fresh_tid(), lane = tid & 63, w = __builtin_amdgcn_readfirstlane(tid >> 6), r = lane & 31, hh = lane >> 5;
    const int tsub = w & 3, vh = w >> 2;
    LAS unsigned char* Qs = lds;
    LAS unsigned char* Ks = lds + RQ_QBYTES;
    for (int pairidx = wg; pairidx < 256; pairidx += nwg) {
#pragma unroll 1
        for (int half = 0; half < 2; ++half) {
            const int sgid = pairidx >> 1, bh = sgid >> 4, sg = sgid & 15, b = bh >> 2, h = bh & 3;
            const int qq = half ? 3 - (pairidx & 1) : (pairidx & 1);
            const int pos0 = sg * RT_L + qq * 128, nsb = 4 * qq + 4, mysb = 4 * qq + tsub;
            const bf16* qsrc = Qr + ((size_t)(b * SEQ + pos0)) * 1024 + h * 256;
            const bf16* ksrc = Kr + ((size_t)(b * SEQ + sg * RT_L)) * 1024 + h * 256;
            unsigned stoff = (unsigned)((tid >> 5) * 1024 + (tid & 31) * 8);
            unsigned stlds = (unsigned)((tid >> 5) * RQ_RS + (tid & 31) * 16);
            asm volatile("" : "+v"(stoff), "+v"(stlds));
            __syncthreads();
#pragma unroll
            for (int i = 0; i < 8; ++i) *(LAS bf16x8*)(Qs + stlds + i * 16 * RQ_RS) = ldg16(qsrc + i * 16 * 1024 + stoff);
            bf16x8 kst[2];
#pragma unroll
            for (int i = 0; i < 2; ++i) *(LAS bf16x8*)(Ks + stlds + i * 16 * RQ_RS) = ldg16(ksrc + i * 16 * 1024 + stoff);
            f32x16 acc[8];
#pragma unroll
            for (int nv = 0; nv < 8; ++nv) acc[nv] = zero16();
            __syncthreads();
            const LAS unsigned char* qfr = Qs + (tsub * 32 + r) * RQ_RS + 16 * hh;
            {
                const bf16* st = STr + ((size_t)(bh * RT_NS + sg)) * 131072 + (size_t)(vh * 8) * 16 * 512;
                unsigned so = (unsigned)(lane * 8);
                asm volatile("" : "+v"(so));
                bf16x8 fa[8], fb[8];
#pragma unroll
                for (int nv = 0; nv < 8; ++nv) fa[nv] = ldg16(st + nv * 16 * 512 + so);
#pragma unroll 1
                for (int k2 = 0; k2 < 8; ++k2) {
#pragma unroll
                    for (int nv = 0; nv < 8; ++nv) fb[nv] = ldg16(st + nv * 16 * 512 + (2 * k2 + 1) * 512 + so);
                    {
                        const bf16x8 q = *(const LAS bf16x8*)(qfr + (2 * k2) * 32);
#pragma unroll
                        for (int nv = 0; nv < 8; ++nv) acc[nv] = MFMA32(fa[nv], q, acc[nv]);
                    }
                    __builtin_amdgcn_sched_barrier(0);
                    if (k2 < 7) {
#pragma unroll
                        for (int nv = 0; nv < 8; ++nv) fa[nv] = ldg16(st + nv * 16 * 512 + (2 * k2 + 2) * 512 + so);
                    }
                    {
                        const bf16x8 q = *(const LAS bf16x8*)(qfr + (2 * k2 + 1) * 32);
#pragma unroll
                        for (int nv = 0; nv < 8; ++nv) acc[nv] = MFMA32(fb[nv], q, acc[nv]);
                    }
                    __builtin_amdgcn_sched_barrier(0);
                }
            }
            const bf16* vbase = VTr + (((size_t)(bh * 256 + sg * 16)) * 16 + vh * 8) * 1024;
            unsigned vo = (unsigned)(lane * 8);
            asm volatile("" : "+v"(vo));
#pragma unroll 1
            for (int sb = 0; sb < nsb; ++sb) {
                const LAS unsigned char* kcur = Ks + (sb & 1) * RQ_KBYTES;
                if (sb + 1 < nsb) {
#pragma unroll
                    for (int i = 0; i < 2; ++i) kst[i] = ldg16(ksrc + (size_t)(sb + 1) * 32 * 1024 + i * 16 * 1024 + stoff);
                }
                if (sb <= mysb) {
                    bf16x8 vt[8][2];
                    const bf16* vb = vbase + (size_t)sb * 16 * 1024;
#pragma unroll
                    for (int nv = 0; nv < 8; ++nv) { vt[nv][0] = ldg16(vb + nv * 1024 + vo); vt[nv][1] = ldg16(vb + nv * 1024 + 512 + vo); }
                    f32x16 x = zero16();
                    const LAS unsigned char* kfr = kcur + r * RQ_RS + 16 * hh;
#pragma unroll
                    for (int kk = 0; kk < 16; ++kk) { x = MFMA32(*(const LAS bf16x8*)(kfr + kk * 32), *(const LAS bf16x8*)(qfr + kk * 32), x); if (kk & 1) __builtin_amdgcn_sched_barrier(0); }
                    if (sb == mysb) {
#pragma unroll
                        for (int i = 0; i < 16; ++i) if (crow(i, hh) > r) x[i] = 0.f;
                    }
                    const bf16x8 xs0 = packx(x, 0), xs1 = packx(x, 1);
#pragma unroll
                    for (int nv = 0; nv < 8; ++nv) { acc[nv] = MFMA32(vt[nv][0], xs0, acc[nv]); acc[nv] = MFMA32(vt[nv][1], xs1, acc[nv]); }
                }
                if (sb + 1 < nsb) {
                    LAS unsigned char* knx = Ks + ((sb + 1) & 1) * RQ_KBYTES;
#pragma unroll
                    for (int i = 0; i < 2; ++i) *(LAS bf16x8*)(knx + stlds + i * 16 * RQ_RS) = kst[i];
                }
                __syncthreads();
            }
            const int trow = b * SEQ + pos0 + tsub * 32 + r;
            float ss = 0.f;
#pragma unroll
            for (int nv = 0; nv < 8; ++nv)
#pragma unroll
                for (int i = 0; i < 16; ++i) ss += acc[nv][i] * acc[nv][i];
            ss += __shfl_xor(ss, 32);
            if (hh == 0) SSQP[(size_t)trow * 8 + h * 2 + vh] = ss;
            bf16* obase = ORET + (size_t)(b * SEQ + pos0 + tsub * 32) * 2048 + h * 512 + vh * 256;
            unsigned oo = (unsigned)(r * 2048 + 4 * hh);
            asm volatile("" : "+v"(oo));
#pragma unroll
            for (int nv = 0; nv < 8; ++nv)
#pragma unroll
                for (int g = 0; g < 4; ++g) {
                    u32x2 o; o.x = pk2(acc[nv][4 * g], acc[nv][4 * g + 1]); o.y = pk2(acc[nv][4 * g + 2], acc[nv][4 * g + 3]);
                    *(u32x2*)(obase + oo + nv * 32 + 8 * g) = o;
                }
        }
    }
    __syncthreads();
}

DI float dot2bf(unsigned a, unsigned b, float c) {
#if __has_builtin(__builtin_amdgcn_fdot2_f32_bf16)
    typedef __bf16 nb2 __attribute__((ext_vector_type(2)));
    return __builtin_amdgcn_fdot2_f32_bf16(__builtin_bit_cast(nb2, a), __builtin_bit_cast(nb2, b), c, false);
#else
    return c + bflo(a) * bflo(b) + bfhi(a) * bfhi(b);
#endif
}
DI void wave_argmax(float& v, int& idx) {
#pragma unroll
    for (int o = 1; o < 64; o <<= 1) {
        const float ov = __shfl_xor(v, o); const int oi = __shfl_xor(idx, o);
        if (ov > v || (ov == v && oi < idx)) { v = ov; idx = oi; }
    }
}

DI void peer_topk1(const bf16* Q, const bf16* SK, float* TOPS, int* TOPI, int wg, int nwg) {
    const int tid = fresh_tid(), lane = tid & 63, w = __builtin_amdgcn_readfirstlane(tid >> 6);
    for (int unit = wg; unit < 16 * 16; unit += nwg) {
        const int hp = unit & 15, tblk = unit >> 4;
        unsigned k0[64], k1[64];
        {
            const u32x4* p0 = (const u32x4*)(SK + ((size_t)(hp * 128 + lane)) * 128);
            const u32x4* p1 = (const u32x4*)(SK + ((size_t)(hp * 128 + 64 + lane)) * 128);
#pragma unroll
            for (int i = 0; i < 16; ++i) { const u32x4 a = p0[i], b = p1[i]; k0[4 * i] = a.x; k0[4 * i + 1] = a.y; k0[4 * i + 2] = a.z; k0[4 * i + 3] = a.w; k1[4 * i] = b.x; k1[4 * i + 1] = b.y; k1[4 * i + 2] = b.z; k1[4 * i + 3] = b.w; }
        }
        for (int tt = 0; tt < 128; ++tt) {
            const int t = tblk * 1024 + w * 128 + tt;
            const u32x4* qp = (const u32x4*)(Q + (size_t)t * 2048 + hp * 128);
            float s0 = 0.f, s1 = 0.f;
#pragma unroll
            for (int i = 0; i < 16; ++i) {
                const u32x4 qv = qp[i];
                s0 = dot2bf(k0[4 * i], qv.x, s0); s0 = dot2bf(k0[4 * i + 1], qv.y, s0); s0 = dot2bf(k0[4 * i + 2], qv.z, s0); s0 = dot2bf(k0[4 * i + 3], qv.w, s0);
                s1 = dot2bf(k1[4 * i], qv.x, s1); s1 = dot2bf(k1[4 * i + 1], qv.y, s1); s1 = dot2bf(k1[4 * i + 2], qv.z, s1); s1 = dot2bf(k1[4 * i + 3], qv.w, s1);
            }
            float myv = 0.f; int myi = 0;
            for (int rnd = 0; rnd < 16; ++rnd) {
                float v; int idx;
                if (s0 >= s1) { v = s0; idx = lane; } else { v = s1; idx = lane + 64; }
                wave_argmax(v, idx);
                if (idx == lane) s0 = -3.0e38f;
                if (idx == lane + 64) s1 = -3.0e38f;
                if (lane == rnd) { myv = v; myi = idx; }
            }
            if (lane < 16) { TOPS[((size_t)t * 16 + hp) * 16 + lane] = myv; TOPI[((size_t)t * 16 + hp) * 16 + lane] = myi; }
        }
    }
}

DI void peer_cand(const float* TOPS, const int* TOPI, int* EIDX, float* EGATE, int gw, int ngw) {
    const int lane = fresh_tid() & 63;
    for (int unit = gw; unit < T * PE_H; unit += ngw) {
        const int t = unit >> 3, h = unit & 7;
        const float* s1p = TOPS + ((size_t)t * 16 + h * 2) * 16;
        const int i1 = lane >> 2, j0 = (lane & 3) * 4;
        const float a = s1p[i1];
        const f32x4 bq = *(const f32x4*)(s1p + 16 + j0);
        float c0 = a + bq[0], c1 = a + bq[1], c2 = a + bq[2], c3 = a + bq[3];
        float myv = 0.f; int myc = 0;
        for (int rnd = 0; rnd < 16; ++rnd) {
            float v = c0; int idx = 4 * lane;
            if (c1 > v) { v = c1; idx = 4 * lane + 1; }
            if (c2 > v) { v = c2; idx = 4 * lane + 2; }
            if (c3 > v) { v = c3; idx = 4 * lane + 3; }
            wave_argmax(v, idx);
            if (idx == 4 * lane) c0 = -3.0e38f;
            if (idx == 4 * lane + 1) c1 = -3.0e38f;
            if (idx == 4 * lane + 2) c2 = -3.0e38f;
            if (idx == 4 * lane + 3) c3 = -3.0e38f;
            if (lane == rnd) { myv = v; myc = idx; }
        }
        const float mx = __shfl(myv, 0);
        float ex = lane < 16 ? __expf(myv - mx) : 0.f;
        float sum = ex;
#pragma unroll
        for (int o = 1; o < 16; o <<= 1) sum += __shfl_xor(sum, o);
        if (lane < 16) {
            const int ci = myc >> 4, cj = myc & 15;
            const int e = TOPI[((size_t)t * 16 + h * 2) * 16 + ci] * PE_NK + TOPI[((size_t)t * 16 + h * 2 + 1) * 16 + cj];
            EIDX[(size_t)t * 128 + h * 16 + lane] = e;
            EGATE[(size_t)t * 128 + h * 16 + lane] = ex / sum;
        }
    }
}


DI unsigned key_pack(float s, unsigned lowbits, unsigned mask) {
    unsigned u = __float_as_uint(s); u = (u & 0x80000000u) ? ~u : (u | 0x80000000u);
    return (u & ~mask) | lowbits;
}
DI float key_val(unsigned k, unsigned mask) { unsigned u = k & ~mask; u = (u & 0x80000000u) ? (u & 0x7fffffffu) : ~u; return __uint_as_float(u); }
DI unsigned umin_(unsigned a, unsigned b) { return a < b ? a : b; }
DI unsigned umax_(unsigned a, unsigned b) { return a > b ? a : b; }
DI void ins16(unsigned (&t)[16], unsigned x) {
#pragma unroll
    for (int i = 15; i >= 1; --i) t[i] = umax_(umin_(t[i - 1], t[i]), umin_(umax_(t[i - 1], t[i]), x));
    t[0] = umax_(t[0], x);
}
DI void peer_retrieve(LAS unsigned char* lds, const bf16* Q, const bf16* SK, int* EIDX, float* EGATE, int gw, int ngw) {
    const int tid = fresh_tid(), lane = tid & 63, w = __builtin_amdgcn_readfirstlane(tid >> 6), r = lane & 31, hh = lane >> 5;
    LAS unsigned char* myl = lds + w * 2304 + lane * 36;
    for (int unit = gw; unit < (T / 32) * PE_H; unit += ngw) {
        const int h = unit & 7, tb = unit >> 3;
        const size_t trow = (size_t)(tb * 32 + r);
        unsigned L[2][16];
#pragma unroll
        for (int p = 0; p < 2; ++p) {
            f32x16 acc[4];
#pragma unroll
            for (int mt = 0; mt < 4; ++mt) acc[mt] = zero16();
            const bf16* qrow = Q + trow * 2048 + h * 256 + p * 128 + 8 * hh;
            const bf16* krow = SK + ((size_t)((h * 2 + p) * 128 + r)) * 128 + 8 * hh;
            asm volatile("" : "+v"(krow), "+v"(qrow));
#pragma unroll
            for (int kk = 0; kk < 8; ++kk) {
                const bf16x8 qf = ldg16(qrow + kk * 16);
#pragma unroll
                for (int mt = 0; mt < 4; ++mt) acc[mt] = MFMA32(ldg16(krow + mt * 32 * 128 + kk * 16), qf, acc[mt]);
                if (kk & 1) __builtin_amdgcn_sched_barrier(0);
            }
            unsigned t[16];
#pragma unroll
            for (int i = 0; i < 16; ++i) t[i] = 0u;
#pragma unroll
            for (int mt = 0; mt < 4; ++mt)
#pragma unroll
                for (int i = 0; i < 16; ++i) ins16(t, key_pack(acc[mt][i], (unsigned)(127 - 32 * mt - (i & 3) - 8 * (i >> 2)) - 4u * (unsigned)hh, 127u));
            unsigned o[16];
#pragma unroll
            for (int i = 0; i < 16; ++i) o[i] = (unsigned)__shfl_xor((int)t[i], 32);
#pragma unroll
            for (int i = 0; i < 16; ++i) ins16(t, o[i]);
#pragma unroll
            for (int i = 0; i < 16; ++i) L[p][i] = t[i];
        }
#pragma unroll
        for (int p = 0; p < 2; ++p)
#pragma unroll
            for (int g = 0; g < 4; ++g) {
                const unsigned v = (127u - (L[p][4 * g] & 127u)) | ((127u - (L[p][4 * g + 1] & 127u)) << 8) | ((127u - (L[p][4 * g + 2] & 127u)) << 16) | ((127u - (L[p][4 * g + 3] & 127u)) << 24);
                *(LAS unsigned*)(myl + p * 16 + g * 4) = v;
            }
        float a[16], b[16];
#pragma unroll
        for (int i = 0; i < 16; ++i) { a[i] = key_val(L[0][i], 127u); b[i] = key_val(L[1][i], 127u); }
        unsigned c[16];
#pragma unroll
        for (int i = 0; i < 16; ++i) c[i] = 0u;
#pragma unroll
        for (int i = 0; i < 16; ++i)
#pragma unroll
            for (int j = 0; j < 16; ++j)
                if ((i + 1) * (j + 1) <= 16) ins16(c, key_pack(a[i] + b[j], (unsigned)(255 - (16 * i + j)), 255u));
        float v[16];
        float sum = 0.f;
        const float mx = key_val(c[0], 255u);
#pragma unroll
        for (int k = 0; k < 16; ++k) { v[k] = __expf(key_val(c[k], 255u) - mx); sum += v[k]; }
        const float inv = 1.f / sum;
        asm volatile("s_waitcnt lgkmcnt(0)" ::: "memory");
        if (hh == 0) {
            int e[16];
#pragma unroll
            for (int k = 0; k < 16; ++k) {
                const unsigned cc = 255u - (c[k] & 255u);
                const unsigned i1 = *(LAS unsigned char*)(myl + (cc >> 4)), i2 = *(LAS unsigned char*)(myl + 16 + (cc & 15u));
                e[k] = (int)(i1 * 128u + i2);
            }
            int* ep = EIDX + trow * 128 + h * 16;
#pragma unroll
            for (int g = 0; g < 4; ++g) *(u32x4*)(ep + 4 * g) = (u32x4){(unsigned)e[4 * g], (unsigned)e[4 * g + 1], (unsigned)e[4 * g + 2], (unsigned)e[4 * g + 3]};
        } else {
            float* gp = EGATE + trow * 128 + h * 16;
#pragma unroll
            for (int g = 0; g < 4; ++g) *(f32x4*)(gp + 4 * g) = (f32x4){v[4 * g] * inv, v[4 * g + 1] * inv, v[4 * g + 2] * inv, v[4 * g + 3] * inv};
        }
        asm volatile("s_waitcnt lgkmcnt(0)" ::: "memory");
    }
}

DI float gelu_tanh(float x) {
    const float u = 0.7978845608028654f * (x + 0.044715f * x * x * x);
    const float e = __expf(2.f * u);
    const float th = 1.f - 2.f / (e + 1.f);
    return 0.5f * x * (1.f + th);
}

DI float bcast_f(float v, int j) { return __int_as_float(__builtin_amdgcn_readfirstlane(__float_as_int(__shfl(v, j)))); }
DI void quant_rows(const float* src, unsigned char* dst, float* scale, int nrows, int offs, int gw, int ngw, int lane) {
    for (int row = gw; row < nrows; row += ngw) {
        const f32x4* p = (const f32x4*)(src + (size_t)row * 1024 + lane * 16);
        f32x4 v[4]; float am = 0.f;
#pragma unroll
        for (int i = 0; i < 4; ++i) { v[i] = p[i];
#pragma unroll
            for (int e = 0; e < 4; ++e) am = fmaxf(am, fabsf(v[i][e])); }
#pragma unroll
        for (int o = 1; o < 64; o <<= 1) am = fmaxf(am, __shfl_xor(am, o));
        const float inv = am > 0.f ? 127.f / am : 0.f;
        u32x4 w;
#pragma unroll
        for (int i = 0; i < 4; ++i) {
            unsigned pk = 0u;
#pragma unroll
            for (int e = 0; e < 4; ++e) { const int q = (int)rintf(v[i][e] * inv) + offs; pk |= ((unsigned)q & 0xffu) << (8 * e); }
            w[i] = pk;
        }
        *(u32x4*)(dst + ((size_t)(lane >> 3) * nrows + row) * 128 + (lane & 7) * 16) = w;
        if (lane == 0) scale[row] = am > 0.f ? am * (1.f / 127.f) : 0.f;
    }
}
DI void quant_xw(const bf16* XW, unsigned char* XQ8, float* XS, int gw, int ngw, int lane) {
    for (int t = gw; t < T; t += ngw) {
        const u32x4 xa = *(const u32x4*)(XW + (size_t)t * 1024 + lane * 16), xb = *(const u32x4*)(XW + (size_t)t * 1024 + lane * 16 + 8);
        float xf[16] = {bflo(xa.x), bfhi(xa.x), bflo(xa.y), bfhi(xa.y), bflo(xa.z), bfhi(xa.z), bflo(xa.w), bfhi(xa.w),
                        bflo(xb.x), bfhi(xb.x), bflo(xb.y), bfhi(xb.y), bflo(xb.z), bfhi(xb.z), bflo(xb.w), bfhi(xb.w)};
        float am = 0.f;
#pragma unroll
        for (int i = 0; i < 16; ++i) am = fmaxf(am, fabsf(xf[i]));
#pragma unroll
        for (int o = 1; o < 64; o <<= 1) am = fmaxf(am, __shfl_xor(am, o));
        const float inv = am > 0.f ? 127.f / am : 0.f;
        u32x4 w;
#pragma unroll
        for (int i = 0; i < 4; ++i) { unsigned pk = 0u;
#pragma unroll
            for (int e = 0; e < 4; ++e) pk |= ((unsigned)((int)rintf(xf[4 * i + e] * inv)) & 0xffu) << (8 * e);
            w[i] = pk; }
        *(u32x4*)(XQ8 + ((size_t)(lane >> 3) * T + t) * 128 + (lane & 7) * 16) = w;
        if (lane == 0) XS[t] = am * (1.f / 127.f);
    }
}
DI void peer_u(const unsigned char* EU8, const unsigned char* XQ8, const int* EIDX, int* PART, int slice, int tok0, int tokstep, int lane) {
    const int q8 = lane & ~7, i = lane & 7, pi = 8 * i + (lane >> 3);
    const unsigned char* tab = EU8 + (size_t)slice * PE_NE * 128 + i * 16;
#define PU_LOAD(dst, t_) do { const int ea_ = EIDX[(size_t)(t_) * 128 + pi], eb_ = EIDX[(size_t)(t_) * 128 + 64 + pi]; \
        _Pragma("unroll") for (int g = 0; g < 16; ++g) { const int e_ = __shfl(g < 8 ? ea_ : eb_, q8 + (g & 7)); dst[g] = *(const u32x4*)(tab + (size_t)e_ * 128); } } while (0)
    u32x4 ub[16], nb[16];
    if (tok0 < T) PU_LOAD(ub, tok0);
    for (int t = tok0; t < T; t += tokstep) {
        const u32x4 xv = *(const u32x4*)(XQ8 + ((size_t)slice * T + t) * 128 + i * 16);
        if (t + tokstep < T) PU_LOAD(nb, t + tokstep);
        int d0 = 0, d1 = 0;
#pragma unroll
        for (int g = 0; g < 16; ++g) {
            int s = __builtin_amdgcn_sdot4((int)ub[g].x, (int)xv.x, 0, false);
            s = __builtin_amdgcn_sdot4((int)ub[g].y, (int)xv.y, s, false); s = __builtin_amdgcn_sdot4((int)ub[g].z, (int)xv.z, s, false); s = __builtin_amdgcn_sdot4((int)ub[g].w, (int)xv.w, s, false);
            s += __shfl_xor(s, 1); s += __shfl_xor(s, 2); s += __shfl_xor(s, 4);
            if (g < 8) { if (i == g) d0 = s; } else { if (i == g - 8) d1 = s; }
        }
        int* pp = PART + ((size_t)slice * T + t) * 128;
        pp[lane] = d0; pp[64 + lane] = d1;
#pragma unroll
        for (int g = 0; g < 16; ++g) ub[g] = nb[g];
    }
#undef PU_LOAD
}
DI void peer_w(const int* PART, const int* EIDX, const float* EGATE, const float* SU, const float* SV, const float* XS, const float* SSQX, float* WT, size_t gtid, size_t gsz) {
    for (size_t idx = gtid; idx < (size_t)T * 64; idx += gsz) {
        const int t = (int)(idx >> 6), L = (int)(idx & 63), pi = 8 * (L & 7) + (L >> 3);
        int d0 = 0, d1 = 0;
#pragma unroll
        for (int s = 0; s < 8; ++s) { d0 += PART[((size_t)s * T + t) * 128 + L]; d1 += PART[((size_t)s * T + t) * 128 + 64 + L]; }
        const int e0 = EIDX[(size_t)t * 128 + pi], e1 = EIDX[(size_t)t * 128 + 64 + pi];
        const float sc = XS[t] * rstd_x1(SSQX, (size_t)t);
        WT[(size_t)t * 128 + L] = EGATE[(size_t)t * 128 + pi] * SV[e0] * gelu_tanh((float)d0 * (SU[e0] * sc));
        WT[(size_t)t * 128 + 64 + L] = EGATE[(size_t)t * 128 + 64 + pi] * SV[e1] * gelu_tanh((float)d1 * (SU[e1] * sc));
    }
}
DI void peer_v(const unsigned char* EV8, const int* EIDX, const float* WT, float* X1, int slice, int tok0, int tokstep, int lane) {
    const int q8 = lane & ~7, i = lane & 7, pi = 8 * i + (lane >> 3);
    const unsigned char* tab = EV8 + (size_t)slice * PE_NE * 128 + i * 16;
#define PV_LOAD(dst, t_) do { const int ea_ = EIDX[(size_t)(t_) * 128 + pi], eb_ = EIDX[(size_t)(t_) * 128 + 64 + pi]; \
        _Pragma("unroll") for (int g = 0; g < 16; ++g) { const int e_ = __shfl(g < 8 ? ea_ : eb_, q8 + (g & 7)); dst[g] = *(const u32x4*)(tab + (size_t)e_ * 128); } } while (0)
    u32x4 vb[16], nb[16];
    if (tok0 < T) PV_LOAD(vb, tok0);
    for (int t = tok0; t < T; t += tokstep) {
        const float w0 = WT[(size_t)t * 128 + lane], w1 = WT[(size_t)t * 128 + 64 + lane];
        if (t + tokstep < T) PV_LOAD(nb, t + tokstep);
        float o[16]; float wsum = 0.f;
#pragma unroll
        for (int c = 0; c < 16; ++c) o[c] = 0.f;
#pragma unroll
        for (int g = 0; g < 16; ++g) {
            const float wq = __shfl(g < 8 ? w0 : w1, q8 + (g & 7));
            wsum += wq;
#pragma unroll
            for (int k = 0; k < 4; ++k) { const unsigned b = vb[g][k];
                o[4 * k] += wq * (float)(b & 0xffu); o[4 * k + 1] += wq * (float)((b >> 8) & 0xffu); o[4 * k + 2] += wq * (float)((b >> 16) & 0xffu); o[4 * k + 3] += wq * (float)(b >> 24); }
        }
#pragma unroll
        for (int c = 0; c < 16; ++c) { o[c] += __shfl_xor(o[c], 8); o[c] += __shfl_xor(o[c], 16); o[c] += __shfl_xor(o[c], 32); }
        wsum += __shfl_xor(wsum, 8); wsum += __shfl_xor(wsum, 16); wsum += __shfl_xor(wsum, 32);
        if (lane < 8) {
            float* xp = X1 + (size_t)t * 1024 + slice * 128 + i * 16;
#pragma unroll
            for (int k = 0; k < 4; ++k) { f32x4 xv = *(const f32x4*)(xp + 4 * k);
#pragma unroll
                for (int e = 0; e < 4; ++e) xv[e] += o[4 * k + e] - 128.f * wsum;
                *(f32x4*)(xp + 4 * k) = xv; }
        }
#pragma unroll
        for (int g = 0; g < 16; ++g) vb[g] = nb[g];
    }
#undef PV_LOAD
}
DI void final_norm(const float* Y, const float* fw, float* OUT, int gw, int ngw, int lane) {
    for (int t = gw; t < T; t += ngw) {
        const f32x4* yr = (const f32x4*)(Y + (size_t)t * 1024) + lane; const f32x4* wr4 = (const f32x4*)fw + lane;
        f32x4 v[4]; float s = 0.f;
#pragma unroll
        for (int j = 0; j < 4; ++j) { v[j] = yr[64 * j]; s += (v[j][0] * v[j][0] + v[j][1] * v[j][1]) + (v[j][2] * v[j][2] + v[j][3] * v[j][3]); }
        const float rs = rsqrtf(wave_sum(s) * (1.f / 1024.f) + EPS);
        f32x4* o = (f32x4*)(OUT + (size_t)t * 1024) + lane;
#pragma unroll
        for (int j = 0; j < 4; ++j) { const f32x4 ww = wr4[64 * j]; o[64 * j] = (f32x4){v[j][0] * rs * ww[0], v[j][1] * rs * ww[1], v[j][2] * rs * ww[2], v[j][3] * rs * ww[3]}; }
    }
}

DI void transpose_item(const float* W, int K, int N, bf16* WT, int n_src0, int n_dst0, int k0, LAS float* scr, int lane) {
#pragma unroll 8
    for (int i = 0; i < 32; ++i) { const int kk = 2 * i + (lane >> 5); scr[kk * 33 + (lane & 31)] = W[(size_t)(k0 + kk) * N + n_src0 + (lane & 31)]; }
    asm volatile("s_waitcnt lgkmcnt(0)" ::: "memory");
    const int c = lane & 7;
#pragma unroll
    for (int j = 0; j < 4; ++j) { const int n = (lane >> 3) + 8 * j; const LAS float* s = scr + (8 * c) * 33 + n;
        u32x4 o; o.x = pk2(s[0 * 33], s[1 * 33]); o.y = pk2(s[2 * 33], s[3 * 33]); o.z = pk2(s[4 * 33], s[5 * 33]); o.w = pk2(s[6 * 33], s[7 * 33]);
        *(u32x4*)(WT + (size_t)(n_dst0 + n) * K + k0 + 8 * c) = o; }
    asm volatile("s_waitcnt lgkmcnt(0)" ::: "memory");
}
DI int win_orig_col(int np) {
    if (np < 2048) { const int h = np >> 8, sel = (np >> 7) & 1, d = np & 127; return sel * 1024 + h * 128 + d; }
    if (np < 3072) return np;
    if (np < 7168) return np + 1024;
    if (np < 8192) return np - 4096;
    return np;
}
DI void rmsnorm_row_bf16(const float* xrow, const float* w, bf16* orow, int lane) {
    const f32x4* xr = (const f32x4*)xrow + lane; const f32x4* wr4 = (const f32x4*)w + lane;
    f32x4 v[4]; float s = 0.f;
#pragma unroll
    for (int j = 0; j < 4; ++j) { v[j] = xr[64 * j]; s += (v[j][0] * v[j][0] + v[j][1] * v[j][1]) + (v[j][2] * v[j][2] + v[j][3] * v[j][3]); }
    const float rs = rsqrtf(wave_sum(s) * (1.f / 1024.f) + EPS);
    u32x2* o8 = (u32x2*)orow + lane;
#pragma unroll
    for (int j = 0; j < 4; ++j) { const f32x4 ww = wr4[64 * j]; u32x2 o; o.x = pk2(v[j][0] * rs * ww[0], v[j][1] * rs * ww[1]); o.y = pk2(v[j][2] * rs * ww[2], v[j][3] * rs * ww[3]); o8[64 * j] = o; }
}
DI void convert_bf16(const float* src, bf16* dst, size_t n, size_t gtid, size_t gsz) {
    for (size_t i = gtid * 8; i < n; i += gsz * 8) {
        const f32x4 a = *(const f32x4*)(src + i), b = *(const f32x4*)(src + i + 4);
        *(u32x4*)(dst + i) = pack8(a, b);
    }
}

#define XB_TMO      128
#define XB_XCNT(j)  (256  + 64 * (j))
#define XB_XSUB(j)  (1280 + 64 * (j))
#define XB_XGEN(j)  (2304 + 64 * (j))
#define XB_TOP      3328
#define XB_TOPGEN   3392
#define XCD_BAR_WORDS 3456
#define XB_SPIN_CAP (1u << 18)

__device__ __forceinline__ unsigned xb_ld(unsigned* p)              { return __hip_atomic_load(p, __ATOMIC_RELAXED, __HIP_MEMORY_SCOPE_AGENT); }
__device__ __forceinline__ unsigned xb_add(unsigned* p, unsigned v) { return __hip_atomic_fetch_add(p, v, __ATOMIC_RELAXED, __HIP_MEMORY_SCOPE_AGENT); }
__device__ __forceinline__ unsigned xb_xcc_id() { return (unsigned)__builtin_amdgcn_s_getreg((3 << 11) | 20) & 0xFu; }
#define XB_SPIN(cond, bar) do { unsigned _sp = 0; while (cond) { __builtin_amdgcn_s_sleep(1); \
    if ((++_sp & 255u) == 0u) { if (xb_ld(&(bar)[XB_TMO])) break; if (_sp > XB_SPIN_CAP) { atomicAdd(&(bar)[XB_TMO], 1u); break; } } } } while (0)

struct XcdBarrier {
    unsigned* bar; unsigned x;
    volatile LAS unsigned* st;
};

__device__ __forceinline__ XcdBarrier xcd_barrier_post(unsigned* bar, volatile LAS unsigned* st) {
    XcdBarrier b; b.bar = bar; b.x = xb_xcc_id(); b.st = st;
    if (threadIdx.x == 0) (void)xb_add(&bar[XB_XCNT(b.x)], 1u);
    return b;
}
__device__ __forceinline__ void xcd_barrier_complete(unsigned* bar, unsigned x, unsigned& nloc, unsigned& nx) {
    const unsigned G = gridDim.x * gridDim.y * gridDim.z;
    unsigned sum, cnt, mine, sp = 0u;
    for (;;) {
        sum = 0u; cnt = 0u; mine = 0u;
#pragma unroll
        for (unsigned j = 0; j < 16; ++j) { const unsigned c = xb_ld(&bar[XB_XCNT(j)]); sum += c; cnt += (c > 0u) ? 1u : 0u; mine = (j == x) ? c : mine; }
        if (sum == G) break;
        __builtin_amdgcn_s_sleep(1);
        if ((++sp & 255u) == 0u) { if (xb_ld(&bar[XB_TMO])) break; if (sp > XB_SPIN_CAP) { atomicAdd(&bar[XB_TMO], 1u); break; } }
    }
    nloc = mine > 0u ? mine : 1u; nx = cnt > 0u ? cnt : 1u;
}

__device__ __forceinline__ void xcd_barrier(const XcdBarrier& b) {
    asm volatile("s_waitcnt vmcnt(0)" ::: "memory");
    __syncthreads();
    if (threadIdx.x == 0) {
        unsigned* bar = b.bar;
        __builtin_amdgcn_s_waitcnt(0);
        unsigned nloc = b.st[0], nx = b.st[1];
        if (nloc == 0u) { xcd_barrier_complete(bar, b.x, nloc, nx); b.st[0] = nloc; b.st[1] = nx; }
        const unsigned old = xb_add(&bar[XB_XSUB(b.x)], 1u);
        const unsigned gen = old / nloc;
        if (old + 1u == (gen + 1u) * nloc) {
            __builtin_amdgcn_fence(__ATOMIC_RELEASE, "agent");
            asm volatile("s_waitcnt vmcnt(0)" ::: "memory");
            const unsigned og = xb_add(&bar[XB_TOP], 1u);
            const unsigned tg = og / nx;
            if (og + 1u == (tg + 1u) * nx) xb_add(&bar[XB_TOPGEN], 1u);
            else XB_SPIN(xb_ld(&bar[XB_TOPGEN]) == tg, bar);
            __builtin_amdgcn_fence(__ATOMIC_ACQUIRE, "agent");
            xb_add(&bar[XB_XGEN(b.x)], 1u);
            asm volatile("s_waitcnt vmcnt(0)" ::: "memory");
        } else {
            XB_SPIN(xb_ld(&bar[XB_XGEN(b.x)]) == gen, bar);
            __builtin_amdgcn_fence(__ATOMIC_ACQUIRE, "agent");
            asm volatile("s_waitcnt vmcnt(0)" ::: "memory");
        }
    }
    __syncthreads();
}

struct Params { const float* in[14]; float* out; unsigned char* ws; };

__global__ void __launch_bounds__(NTHREADS, 2) fwd_megakernel(Params p) {
    extern __shared__ __attribute__((aligned(16))) unsigned char lds_raw[];
    LAS unsigned char* lds = (LAS unsigned char*)lds_raw;
    cg::grid_group grid = cg::this_grid();
    volatile LAS unsigned* bst = (volatile LAS unsigned*)(lds + LDS_BYTES - 64);
    if (threadIdx.x < 4) bst[threadIdx.x] = 0u;
    __syncthreads();
    XcdBarrier xbar = xcd_barrier_post((unsigned*)(p.ws + WS_CTL), bst);
    if (threadIdx.x == 0) bst[4] = xb_add((unsigned*)(p.ws + WS_CTL) + 3600 + xbar.x, 1u);
#if USE_CG_SYNC
#define GRID_SYNC() grid.sync()
#else
#define GRID_SYNC() xcd_barrier(xbar)
#endif
    const int G = gridDim.x, wg = blockIdx.x;
#define PHASE_IDS const int tid = fresh_tid(), lane = tid & 63, wave = __builtin_amdgcn_readfirstlane(tid >> 6); \
    const int gw = wg * NWAVES + wave, ngw = G * NWAVES; const size_t gtid = (size_t)wg * NTHREADS + tid, gsz = (size_t)G * NTHREADS; \
    (void)lane; (void)gw; (void)ngw; (void)gtid; (void)gsz;
    unsigned char* ws = p.ws;
    const float* x = p.in[0];
    bf16* HN = (bf16*)(ws + WS_HN); bf16* WinT = (bf16*)(ws + WS_WINT);
    float* COS = (float*)(ws + WS_ROPE); float* SIN = COS + 8192 * 128;
    float* DEC = (float*)(ws + WS_DEC); float* SSQP = (float*)(ws + WS_SSQP); float* SSQX = (float*)(ws + WS_SSQX);
    bf16* BA = (bf16*)(ws + WS_A); bf16* BB = (bf16*)(ws + WS_B); bf16* BC = (bf16*)(ws + WS_C);
    bf16* STh = (bf16*)(ws + WS_STH); bf16* STr = (bf16*)(ws + WS_STR);
    bf16* OHG = (bf16*)(ws + WS_OHG); bf16* ORET = (bf16*)p.out;
    bf16* GA = (bf16*)(ws + WS_GA); bf16* GB = (bf16*)(ws + WS_GB);
    bf16* WhgT = (bf16*)(ws + WS_WHG); bf16* WretT = (bf16*)(ws + WS_WRET); bf16* WoutT = (bf16*)(ws + WS_WOUT); bf16* WqT = (bf16*)(ws + WS_WQ); bf16* SK = (bf16*)(ws + WS_SK);
    unsigned char* EV8 = ws + WS_EV; unsigned char* EU8 = ws + WS_EU; float* SU = (float*)(ws + WS_SCL); float* SV = SU + PE_NE;
    float* M1 = (float*)(ws + WS_M1); bf16* MERGED = (bf16*)(ws + WS_MERGED);
    float* X1 = (float*)(ws + WS_X1); bf16* XW = (bf16*)(ws + WS_XW); bf16* Qp = (bf16*)p.out;
    unsigned char* XQ8 = ws + WS_XQ8; float* XS = (float*)(ws + WS_XS); int* PART = (int*)(ws + WS_PART); float* WT = (float*)(ws + WS_WT);
    float* TOPS = (float*)(ws + WS_TOPS); int* TOPI = (int*)(ws + WS_TOPI); int* EIDX = (int*)(ws + WS_EIDX); float* EGATE = (float*)(ws + WS_EGATE);

    for (int rep_ = 0; rep_ < ((PROBE_MASK & 32) ? 2 : 1); ++rep_) {
    { PHASE_IDS LAS float* scr = (LAS float*)(lds + wave * 16384);
    for (int it = gw; it < 16 * 384; it += ngw) {
        const int kb = it / 384, nb = it % 384;
        transpose_item(p.in[2], 1024, 12288, WinT, win_orig_col(nb * 32), nb * 32, kb * 64, scr, lane);
    }
    for (int m = gw; m < T; m += ngw) rmsnorm_row_bf16(x + (size_t)m * 1024, p.in[1], HN + (size_t)m * 1024, lane);
    for (size_t i = gtid; i < (size_t)8192 * 128; i += gsz) {
        const int pos = (int)(i >> 7), j = (int)(i & 127);
        const float inv = (float)exp(-(double)j * (9.210340371976184 / 128.0));
        const float ang = (float)pos * inv;
        double rev = (double)ang * 0.15915494309189535; rev -= rint(rev);
        COS[i] = __builtin_amdgcn_cosf((float)rev); SIN[i] = __builtin_amdgcn_sinf((float)rev);
    } }
    __syncthreads(); }
    grid.sync();

    for (int rep_ = 0; rep_ < ((PROBE_MASK & 128) ? 2 : 1); ++rep_) {
    {
        pg8::Gemm g{HN, WinT, T, 3072, 1024}; pg8::StaticOrder S; S.init(T, 3072, G, wg);
        EpiH E{BA, BB, BC, DEC, p.in[3]};
        pg8::gemm_phase<EpiH, pg8::StaticOrder, true, true>(lds, g, S, E);
    }
    __syncthreads(); }
    GRID_SYNC();
    hg_pass1(lds, BB, BC, STh, wg, G);
#if PROBE_MASK & 4
    hg_pass1(lds, BB, BC, STh, wg, G);
#endif
    GRID_SYNC();
    { PHASE_IDS hg_scan(STh, DEC, (int)gtid, (int)gsz); }
    GRID_SYNC();
#if PROBE_MASK & 16384
    hg_pass1(lds, BB, BC, STh, wg, G);
    GRID_SYNC();
    { PHASE_IDS hg_scan(STh, DEC, (int)gtid, (int)gsz); }
    GRID_SYNC();
#endif
    { PHASE_IDS hg_pass3(BA, BB, BC, STh, p.in[4], OHG, gw, ngw); }
#if PROBE_MASK & 4
    { PHASE_IDS hg_pass3(BA, BB, BC, STh, p.in[4], OHG, gw, ngw); }
#endif
    GRID_SYNC();

    for (int rep_ = 0; rep_ < ((PROBE_MASK & 2048) ? 2 : 1); ++rep_) {
    {
        pg8::Gemm g{HN, WinT + (size_t)3072 * 1024, T, 4096, 1024}; pg8::StaticOrder S; S.init(T, 4096, G, wg);
        EpiR E{BA, BB, BC, COS, SIN};
        pg8::gemm_phase<EpiR, pg8::StaticOrder, true, true>(lds, g, S, E);
    }
    __syncthreads(); }
    GRID_SYNC();
    rt_pass1(lds, BB, BC, STr, wg, G);
#if PROBE_MASK & 8
    rt_pass1(lds, BB, BC, STr, wg, G);
#endif
    GRID_SYNC();
    { PHASE_IDS rt_scan(STr, (int)gtid, (int)gsz); }
    GRID_SYNC();
#if PROBE_MASK & 32768
    rt_pass1(lds, BB, BC, STr, wg, G);
    GRID_SYNC();
    { PHASE_IDS rt_scan(STr, (int)gtid, (int)gsz); }
    GRID_SYNC();
#endif
    rt_pass3_wg(lds, BA, BB, BC, STr, ORET, SSQP, wg, G);
#if PROBE_MASK & 1024
    rt_pass3_wg(lds, BA, BB, BC, STr, ORET, SSQP, wg, G);
#endif
    GRID_SYNC();

    for (int rep_ = 0; rep_ < ((PROBE_MASK & 64) ? 2 : 1); ++rep_) {
    { PHASE_IDS LAS float* scr = (LAS float*)(lds + wave * 16384);
    for (int it = gw; it < 3072; it += ngw) {
        int r = it;
        if (r < 512) { transpose_item(p.in[5], 1024, 1024, WhgT, (r % 32) * 32, (r % 32) * 32, (r / 32) * 64, scr, lane); continue; } r -= 512;
        if (r < 1024) { transpose_item(p.in[6], 2048, 1024, WretT, (r % 32) * 32, (r % 32) * 32, (r / 32) * 64, scr, lane); continue; } r -= 1024;
        if (r < 512) { transpose_item(p.in[7], 1024, 1024, WoutT, (r % 32) * 32, (r % 32) * 32, (r / 32) * 64, scr, lane); continue; } r -= 512;
        transpose_item(p.in[9], 1024, 2048, WqT, (r % 64) * 32, (r % 64) * 32, (r / 64) * 64, scr, lane);
    }
    convert_bf16(p.in[10], SK, (size_t)16 * 128 * 128, gtid, gsz);
    quant_rows(p.in[12], EV8, SV, PE_NE, 128, gw, ngw, lane); }
    __syncthreads(); }
    __syncthreads();
    {
        pg8::Gemm g{HN, WinT + (size_t)7168 * 1024, T, 5120, 1024}; pg8::StaticOrder S; S.init(T, 5120, G, wg);
#if PROBE_MASK & 65536
        { EpiG E0{OHG, ORET, GA, GB, SSQP, 1}; pg8::gemm_phase<EpiG, pg8::StaticOrder, true, true>(lds, g, S, E0); __syncthreads(); }
#endif
        EpiG E{OHG, ORET, GA, GB, SSQP, 0};
        pg8::gemm_phase<EpiG, pg8::StaticOrder, true, true>(lds, g, S, E);
    }
    GRID_SYNC();

    for (int rep_ = 0; rep_ < ((PROBE_MASK & 256) ? 2 : 1); ++rep_) {
    {
        pg8::Gemm g{OHG, WhgT, T, 1024, 1024}; pg8::StaticOrder S; S.init(T, 1024, G, wg);
        EpiM1 E{M1, GA};
        pg8::gemm_phase<EpiM1, pg8::StaticOrder, false, true>(lds, g, S, E);
    }
    __syncthreads();
    {
        pg8::Gemm g{ORET, WretT, T, 1024, 2048}; pg8::StaticOrder S; S.init(T, 1024, G, wg);
        EpiMerge E{M1, GB, MERGED};
        pg8::gemm_phase<EpiMerge, pg8::StaticOrder, false, true>(lds, g, S, E);
    }
    __syncthreads(); }
    GRID_SYNC();
    for (int rep_ = 0; rep_ < ((PROBE_MASK & 4096) ? 2 : 1); ++rep_) {
    {
        pg8::Gemm g{MERGED, WoutT, T, 1024, 1024}; pg8::StaticOrder S; S.init(T, 1024, G, wg);
        EpiOut E{x, X1, XW, p.in[8], SSQX};
        pg8::gemm_phase<EpiOut, pg8::StaticOrder, false, true>(lds, g, S, E);
    }
    __syncthreads(); }
    GRID_SYNC();
    for (int rep_ = 0; rep_ < ((PROBE_MASK & 64) ? 2 : 1); ++rep_) {
    { PHASE_IDS quant_rows(p.in[11], EU8, SU, PE_NE, 0, gw, ngw, lane); }
    __syncthreads(); }
    __syncthreads();
    for (int rep_ = 0; rep_ < ((PROBE_MASK & 8192) ? 2 : 1); ++rep_) {
    {
        pg8::Gemm g{XW, WqT, T, 2048, 1024}; pg8::StaticOrder S; S.init(T, 2048, G, wg);
        EpiQ E{Qp, SSQX};
        pg8::gemm_phase<EpiQ, pg8::StaticOrder, true, true>(lds, g, S, E);
    }
    __syncthreads(); }
    GRID_SYNC();
    { PHASE_IDS peer_retrieve(lds, Qp, SK, EIDX, EGATE, gw, ngw); quant_xw(XW, XQ8, XS, gw, ngw, lane); }
#if PROBE_MASK & 2
    { PHASE_IDS peer_retrieve(lds, Qp, SK, EIDX, EGATE, gw, ngw); quant_xw(XW, XQ8, XS, gw, ngw, lane); }
#endif
    GRID_SYNC();
    if (threadIdx.x == 0) {
        unsigned k = 0, n = 0, mine = 1;
        for (unsigned j = 0; j < 16; ++j) { const unsigned c = xb_ld((unsigned*)(p.ws + WS_CTL) + XB_XCNT(j)); if (c) { if (j < xbar.x) ++k; ++n; } if (j == xbar.x) mine = c ? c : 1; }
        bst[5] = k; bst[6] = n ? n : 1; bst[7] = mine;
    }
    __syncthreads();
    const int xrank = (int)bst[4], xk = (int)bst[5], xn = (int)bst[6], xloc = (int)bst[7];
    for (int rep_ = 0; rep_ < ((PROBE_MASK & 1) ? 2 : 1); ++rep_) {
    { PHASE_IDS for (int s = xk; s < 8; s += xn) peer_u(EU8, XQ8, EIDX, PART, s, xrank * NWAVES + wave, xloc * NWAVES, lane); }
    GRID_SYNC(); }
    { PHASE_IDS peer_w(PART, EIDX, EGATE, SU, SV, XS, SSQX, WT, gtid, gsz); }
    GRID_SYNC();
    { PHASE_IDS for (int s = xk; s < 8; s += xn) peer_v(EV8, EIDX, WT, X1, s, xrank * NWAVES + wave, xloc * NWAVES, lane); }
    GRID_SYNC();
    { PHASE_IDS final_norm(X1, p.in[13], p.out, gw, ngw, lane); }
#if PROBE_MASK & 16
    for (int i = 0; i < 15; ++i) GRID_SYNC();
#endif
}

extern "C" void kernel_launch(void* const* d_in, const int* in_sizes, int n_in, void* d_out, int out_size, void* d_ws, size_t ws_size, hipStream_t stream) {
    static int grid_blocks = 0;
    if (!grid_blocks) {
        int dev = 0, cus = 0, per_cu = 0;
        (void)hipGetDevice(&dev);
        (void)hipDeviceGetAttribute(&cus, hipDeviceAttributeMultiprocessorCount, dev);
        (void)hipFuncSetAttribute((const void*)fwd_megakernel, hipFuncAttributeMaxDynamicSharedMemorySize, LDS_BYTES);
        (void)hipOccupancyMaxActiveBlocksPerMultiprocessor(&per_cu, (const void*)fwd_megakernel, NTHREADS, LDS_BYTES);
        if (per_cu < 1) per_cu = 1;
        grid_blocks = cus * 1;
        if (ws_size < WS_END || n_in != 14) { fprintf(stderr, "kernel_launch: unexpected ws_size %zu (need %zu) or n_in %d\n", ws_size, (size_t)WS_END, n_in); }
    }
    (void)hipMemsetAsync((char*)d_ws + WS_CTL, 0, 16384, stream);
    Params p{};
    for (int i = 0; i < 14; ++i) p.in[i] = (const float*)d_in[i];
    p.out = (float*)d_out; p.ws = (unsigned char*)d_ws;
    void* args[] = {&p};
    hipError_t e = hipLaunchCooperativeKernel((const void*)fwd_megakernel, dim3(grid_blocks), dim3(NTHREADS), args, LDS_BYTES, stream);
    if (e != hipSuccess) fprintf(stderr, "cooperative launch failed: %s (grid %d)\n", hipGetErrorString(e), grid_blocks);
}
```

```cpp
#include <hip/hip_runtime.h>
#include <hip/hip_cooperative_groups.h>
#include <cstdio>
#include <cstdint>
namespace cg = cooperative_groups;
#ifndef USE_CG_SYNC
#define USE_CG_SYNC 0
#endif
#ifndef PROBE_MASK
#define PROBE_MASK 0
#endif

#define DI __device__ __forceinline__
#define LAS __attribute__((address_space(3)))
typedef unsigned short bf16;
typedef float f32x4 __attribute__((ext_vector_type(4)));
typedef float f32x2 __attribute__((ext_vector_type(2)));
typedef float f32x16 __attribute__((ext_vector_type(16)));
typedef short bf16x8 __attribute__((ext_vector_type(8)));
typedef short s16x4 __attribute__((ext_vector_type(4)));
typedef unsigned u32x4 __attribute__((ext_vector_type(4)));
typedef unsigned u32x2 __attribute__((ext_vector_type(2)));
typedef __bf16 nbf16x2 __attribute__((ext_vector_type(2)));

constexpr int D = 1024, NB = 2, SEQ = 8192, T = NB * SEQ;
constexpr int HG_H = 8, HG_DK = 128, HG_DV = 128, HG_C = 64, HG_NC = SEQ / HG_C;
constexpr int RT_H = 4, RT_DK = 256, RT_DV = 512, RT_L = 512, RT_NS = SEQ / RT_L;
constexpr int PE_H = 8, PE_NK = 128, PE_K = 16, PE_Q = 256, PE_HALF = 128, PE_NE = PE_NK * PE_NK;
constexpr float EPS = 1e-6f;
constexpr int NTHREADS = 512, NWAVES = 8;
constexpr int LDS_BYTES = 147456;

constexpr size_t MiB = 1u << 20;
constexpr size_t WS_CTL = 0;
constexpr size_t WS_DEC = 1 * MiB;
constexpr size_t WS_SSQP = 2 * MiB;
constexpr size_t WS_SCL = 2 * MiB + 512 * 1024;
constexpr size_t WS_SSQX = 3 * MiB;
constexpr size_t WS_HN = 4 * MiB;
constexpr size_t WS_WINT = 36 * MiB;
constexpr size_t WS_ROPE = 60 * MiB;
constexpr size_t WS_A = 68 * MiB, WS_B = 100 * MiB, WS_C = 132 * MiB;
constexpr size_t WS_STH = 164 * MiB;
constexpr size_t WS_STR = 196 * MiB;
constexpr size_t WS_OHG = 228 * MiB;
constexpr size_t WS_GA = 68 * MiB, WS_GB = 100 * MiB;
constexpr size_t WS_W2 = 132 * MiB;
constexpr size_t WS_WHG = WS_W2, WS_WRET = WS_W2 + 2 * MiB, WS_WOUT = WS_W2 + 6 * MiB, WS_WQ = WS_W2 + 8 * MiB, WS_SK = WS_W2 + 12 * MiB;
constexpr size_t WS_EV = 145 * MiB;
constexpr size_t WS_MERGED = 177 * MiB;
constexpr size_t WS_EU = 209 * MiB;
constexpr size_t WS_M1 = 4 * MiB;
constexpr size_t WS_X1 = 4 * MiB;
constexpr size_t WS_XW = 68 * MiB;
constexpr size_t WS_TOPS = 100 * MiB, WS_TOPI = 116 * MiB;
constexpr size_t WS_EIDX = 177 * MiB, WS_EGATE = 185 * MiB;
constexpr size_t WS_XQ8 = 161 * MiB;
constexpr size_t WS_XS = WS_SCL + 128 * 1024;
constexpr size_t WS_PART = 68 * MiB;
constexpr size_t WS_WT = 193 * MiB;
constexpr size_t WS_END = 260 * MiB;

DI int fresh_tid() { int t = threadIdx.x; asm volatile("" : "+v"(t)); return t; }
DI float sigmoidf_(float x) { return 1.f / (1.f + __expf(-x)); }
DI float siluf_(float x) { return x / (1.f + __expf(-x)); }
DI unsigned pk2(float lo, float hi) { f32x2 v = {lo, hi}; nbf16x2 b = __builtin_convertvector(v, nbf16x2); return __builtin_bit_cast(unsigned, b); }
DI bf16 f2bf(float f) { return (bf16)(pk2(f, 0.f) & 0xffffu); }
DI float bf2f(bf16 b) { return __uint_as_float(((unsigned)b) << 16); }
DI float bflo(unsigned u) { return __uint_as_float(u << 16); }
DI float bfhi(unsigned u) { return __uint_as_float(u & 0xffff0000u); }
DI float wave_sum(float v) {
#pragma unroll
    for (int o = 1; o < 64; o <<= 1) v += __shfl_xor(v, o);
    return v;
}
DI int crow(int reg, int h) { return (reg & 3) + 8 * (reg >> 2) + 4 * h; }

namespace pg8 {
#define PG8_LAS __attribute__((address_space(3)))
typedef unsigned short bf16_t;
typedef short bf16x8 __attribute__((ext_vector_type(8)));
typedef float f32x4 __attribute__((ext_vector_type(4)));
typedef unsigned u32x4 __attribute__((ext_vector_type(4)));
constexpr int BM = 256, BK = 64, HALF = 128, HTB = HALF * BK * 2  , STAGE_BYTES = 8 * HTB, NXCD = 8, WGM = 8;

__host__ __device__ __forceinline__ int lds_byte(int r, int c) { const int st = (r >> 4) * 2 + (c >> 5), rr = r & 15, cc = c & 31, ob = rr * 64 + cc * 2; return st * 1024 + (ob ^ (((ob >> 9) & 1) << 5)); }
__host__ __device__ __forceinline__ void stage_rc(int b, int& R, int& C) { const int st = b / 1024, sb = b % 1024, swz = sb ^ (((sb >> 9) & 1) << 5); R = (st >> 1) * 16 + swz / 64; C = (st & 1) * 32 + (swz % 64) / 2; }
__host__ __device__ __forceinline__ int perm32(int rho) { const int n = rho >> 4, i = rho & 15; return 8 * (i >> 2) + 4 * n + (i & 3); }

struct Unit { int pm, pn; };
struct Gemm { const bf16_t* A; const bf16_t* Bt; int M, N, K; };

struct StaticOrder {
    int nM, nN, nwg, G, c;
    __host__ __device__ void init(int M, int N, int G_, int c_) { nM = M / BM; nN = N / BM; nwg = nM * nN; G = G_; c = c_; }
    __host__ __device__ bool next(int i, Unit& u) const {
        const long L = (long)i * G + c; if (L >= nwg) return false;
        int wgid = (int)L; { const int q = nwg / NXCD, r = nwg % NXCD, xcd = wgid % NXCD, off = wgid / NXCD; wgid = (xcd < r ? xcd * (q + 1) : r * (q + 1) + (xcd - r) * q) + off; }
        const int nig = WGM * nN, gid = wgid / nig, fm = gid * WGM, gsz = (nM - fm) < WGM ? (nM - fm) : WGM;
        u.pm = fm + ((wgid % nig) % gsz); u.pn = (wgid % nig) / gsz; return true;
    }
    __device__ __forceinline__ void a_ready(const Unit&) const {}
    __device__ __forceinline__ void done(const Unit&) const {}
};

__device__ __forceinline__ unsigned cvt_pk_bf16(float lo, float hi) { unsigned r; asm volatile("v_cvt_pk_bf16_f32 %0, %1, %2" : "=v"(r) : "v"(lo), "v"(hi)); return r; }
typedef float f32x2 __attribute__((ext_vector_type(2)));
template <class Epi, class Sched, bool ALIGN_EPI = false, bool SP2 = false>
__device__ __forceinline__ void gemm_phase(PG8_LAS unsigned char* lds, const Gemm g, const Sched& S, const Epi& E) {
    const int tid = fresh_tid(), wid = __builtin_amdgcn_readfirstlane(tid >> 6), lane = tid & 63, wr = wid >> 2, wc = wid & 3, fr = lane & 15, fq = lane >> 4;
    const int K = g.K, nt = K / BK;
    unsigned voffA[2], voffB[2];
#pragma unroll
    for (int i = 0; i < 2; ++i) { int R, C; stage_rc(tid * 16 + i * 8192, R, C); const int Rb = Epi::PERM ? ((R & ~31) + perm32(R & 31)) : R;
        voffA[i] = (unsigned)(R * K + C) * 2u; voffB[i] = (unsigned)(Rb * K + C) * 2u; }
    const size_t kstep = (size_t)(BK * 2);
    const size_t hstep = (size_t)HALF * K * 2;
    const size_t tstep = 2 * hstep;
    const unsigned ldsw = (unsigned)wid * 1024u;
    const int aoff = lds_byte(wr * 64 + fr, fq * 8), boff = lds_byte(wc * 32 + fr, fq * 8);
#define PG8_SA(b, h) (((b) * 2 + (h)) * HTB)
#define PG8_SB(b, h) ((4 + (b) * 2 + (h)) * HTB)
#define PG8_STAGE(bufoff, gbase, voff) do { _Pragma("unroll") for (int _i = 0; _i < 2; ++_i) \
        __builtin_amdgcn_global_load_lds((const unsigned*)((const char*)(gbase) + (voff)[_i]), (PG8_LAS unsigned*)(lds + (bufoff) + ldsw + _i * 8192), 16, 0, 0); } while (0)
#define PG8_LDA(dst, b, h) do { _Pragma("unroll") for (int m = 0; m < 4; ++m) _Pragma("unroll") for (int k = 0; k < 2; ++k) dst[m][k] = *(const PG8_LAS bf16x8*)(lds + PG8_SA(b, h) + aoff + m * 2048 + k * 1024); } while (0)
#define PG8_LDB(dst, b, h) do { _Pragma("unroll") for (int n = 0; n < 2; ++n) _Pragma("unroll") for (int k = 0; k < 2; ++k) dst[n][k] = *(const PG8_LAS bf16x8*)(lds + PG8_SB(b, h) + boff + n * 2048 + k * 1024); } while (0)
#define PG8_MMA(ai, bj, At, Bt) do { __builtin_amdgcn_s_setprio(1); _Pragma("unroll") for (int m = 0; m < 4; ++m) _Pragma("unroll") for (int n = 0; n < 2; ++n) _Pragma("unroll") for (int k = 0; k < 2; ++k) \
        acc[ai][bj][m][n] = __builtin_amdgcn_mfma_f32_16x16x32_bf16(Bt[n][k], At[m][k], acc[ai][bj][m][n], 0, 0, 0); __builtin_amdgcn_s_setprio(0); } while (0)
#define PG8_WAIT_V(n) asm volatile("s_waitcnt vmcnt(" #n ")" ::: "memory")
#define PG8_WAIT_L(n) asm volatile("s_waitcnt lgkmcnt(" #n ")" ::: "memory")
#define PG8_BAR __builtin_amdgcn_s_barrier()
#define PG8_SCHED __builtin_amdgcn_sched_barrier(0)
    Unit cur, nxt; int ui = 0;
    if (!S.next(0, cur)) return;
    f32x4 acc[2][2][4][2];
#pragma unroll
    for (int a = 0; a < 2; ++a)
#pragma unroll
        for (int b = 0; b < 2; ++b)
#pragma unroll
            for (int m = 0; m < 4; ++m)
#pragma unroll
                for (int n = 0; n < 2; ++n) acc[a][b][m][n] = (f32x4){0.f, 0.f, 0.f, 0.f};
    bf16x8 At[4][2], B0[2][2], B1[2][2];
    const char* cA = (const char*)g.A + (size_t)cur.pm * tstep; const char* cB = (const char*)g.Bt + (size_t)cur.pn * tstep;
    S.a_ready(cur);
    if constexpr (SP2) {
        PG8_STAGE(PG8_SB(0, 0), cB, voffB); PG8_STAGE(PG8_SB(0, 1), cB + hstep, voffB); PG8_STAGE(PG8_SA(0, 0), cA, voffA); PG8_STAGE(PG8_SA(0, 1), cA + hstep, voffA);
        if (wr == 1) PG8_BAR;
        PG8_WAIT_V(2); PG8_BAR;
        PG8_STAGE(PG8_SB(1, 0), cB + kstep, voffB); PG8_STAGE(PG8_SA(1, 0), cA + kstep, voffA); PG8_STAGE(PG8_SB(1, 1), cB + hstep + kstep, voffB);
        PG8_WAIT_V(6); PG8_BAR;
    } else {
        PG8_STAGE(PG8_SB(0, 0), cB, voffB); PG8_STAGE(PG8_SA(0, 0), cA, voffA); PG8_STAGE(PG8_SB(0, 1), cB + hstep, voffB); PG8_STAGE(PG8_SA(0, 1), cA + hstep, voffA);
        if (wr == 1) PG8_BAR;
        PG8_WAIT_V(4); PG8_BAR;
        PG8_STAGE(PG8_SB(1, 0), cB + kstep, voffB); PG8_STAGE(PG8_SA(1, 0), cA + kstep, voffA); PG8_STAGE(PG8_SB(1, 1), cB + hstep + kstep, voffB);
        PG8_WAIT_V(6); PG8_BAR;
    }
    for (;;) {
        const bool has_next = S.next(ui + 1, nxt);
        const char* nA = has_next ? (const char*)g.A + (size_t)nxt.pm * tstep : cA; const char* nB = has_next ? (const char*)g.Bt + (size_t)nxt.pn * tstep : cB;
        for (int t = 0; t < nt; t += 2) {
            const bool last = (t == nt - 2);
            const char* a1 = cA + (size_t)(t + 1) * kstep;
            const char* a2 = last ? nA : cA + (size_t)(t + 2) * kstep; const char* b2 = last ? nB : cB + (size_t)(t + 2) * kstep;
            const char* a3 = a2 + kstep; const char* b3 = b2 + kstep;
            if (last && has_next) S.a_ready(nxt);
            if constexpr (SP2) {
            PG8_LDB(B0, 0, 0); PG8_LDB(B1, 0, 1); PG8_SCHED; PG8_LDA(At, 0, 0); PG8_STAGE(PG8_SA(1, 1), a1 + hstep, voffA);
            PG8_WAIT_V(8); PG8_WAIT_L(0); PG8_BAR; PG8_MMA(0, 0, At, B0); PG8_MMA(0, 1, At, B1); PG8_BAR; PG8_SCHED;
            PG8_LDA(At, 0, 1); PG8_STAGE(PG8_SB(0, 0), b2, voffB); PG8_STAGE(PG8_SB(0, 1), b2 + hstep, voffB); PG8_STAGE(PG8_SA(0, 0), a2, voffA);
            PG8_WAIT_V(8); PG8_WAIT_L(0); PG8_BAR; PG8_MMA(1, 0, At, B0); PG8_MMA(1, 1, At, B1); PG8_BAR; PG8_SCHED;
            PG8_LDB(B0, 1, 0); PG8_LDB(B1, 1, 1); PG8_SCHED; PG8_LDA(At, 1, 0); PG8_STAGE(PG8_SA(0, 1), a2 + hstep, voffA);
            PG8_WAIT_V(8); PG8_WAIT_L(0); PG8_BAR; PG8_MMA(0, 0, At, B0); PG8_MMA(0, 1, At, B1); PG8_BAR; PG8_SCHED;
            PG8_LDA(At, 1, 1); PG8_STAGE(PG8_SB(1, 0), b3, voffB); PG8_STAGE(PG8_SB(1, 1), b3 + hstep, voffB); PG8_STAGE(PG8_SA(1, 0), a3, voffA);
            PG8_WAIT_V(8); PG8_WAIT_L(0); PG8_BAR; PG8_MMA(1, 0, At, B0); PG8_MMA(1, 1, At, B1); PG8_BAR; PG8_SCHED;
            } else {
            PG8_LDB(B0, 0, 0); PG8_SCHED; PG8_LDA(At, 0, 0); PG8_STAGE(PG8_SA(1, 1), a1 + hstep, voffA);
            PG8_WAIT_L(8); PG8_BAR; PG8_WAIT_L(0); PG8_MMA(0, 0, At, B0); PG8_BAR; PG8_SCHED;
            PG8_LDB(B1, 0, 1); PG8_STAGE(PG8_SB(0, 0), b2, voffB);
            PG8_BAR; PG8_WAIT_L(0); PG8_MMA(0, 1, At, B1); PG8_BAR;
            PG8_LDA(At, 0, 1); PG8_STAGE(PG8_SA(0, 0), a2, voffA);
            PG8_BAR; PG8_WAIT_L(0); PG8_MMA(1, 0, At, B0); PG8_BAR; PG8_SCHED;
            PG8_STAGE(PG8_SB(0, 1), b2 + hstep, voffB);
            PG8_WAIT_V(6); PG8_BAR; PG8_MMA(1, 1, At, B1); PG8_BAR;
            PG8_LDB(B0, 1, 0); PG8_SCHED; PG8_LDA(At, 1, 0); PG8_STAGE(PG8_SA(0, 1), a2 + hstep, voffA);
            PG8_WAIT_L(8); PG8_BAR; PG8_WAIT_L(0); PG8_MMA(0, 0, At, B0); PG8_BAR; PG8_SCHED;
            PG8_LDB(B1, 1, 1); PG8_STAGE(PG8_SB(1, 0), b3, voffB);
            PG8_BAR; PG8_WAIT_L(0); PG8_MMA(0, 1, At, B1); PG8_BAR;
            PG8_LDA(At, 1, 1); PG8_STAGE(PG8_SA(1, 0), a3, voffA);
            PG8_BAR; PG8_WAIT_L(0); PG8_MMA(1, 0, At, B0); PG8_BAR; PG8_SCHED;
            PG8_STAGE(PG8_SB(1, 1), b3 + hstep, voffB);
            PG8_WAIT_V(6); PG8_BAR; PG8_MMA(1, 1, At, B1); PG8_BAR;
            }
        }
        if constexpr (ALIGN_EPI) { if (wr == 0) PG8_BAR; }
        if constexpr (!Epi::AFTER_DRAIN) { E(acc, cur, wr, wc, fr, fq); S.done(cur); }
        if (!has_next) break;
#pragma unroll
        for (int a = 0; a < 2; ++a)
#pragma unroll
            for (int b = 0; b < 2; ++b)
#pragma unroll
                for (int m = 0; m < 4; ++m)
#pragma unroll
                    for (int n = 0; n < 2; ++n) acc[a][b][m][n] = (f32x4){0.f, 0.f, 0.f, 0.f};
        cur = nxt; cA = nA; cB = nB; ++ui;
        if constexpr (ALIGN_EPI) { if (wr == 1) PG8_BAR; }
    }
    PG8_WAIT_V(0);
    if constexpr (!ALIGN_EPI) { if (wr == 0) PG8_BAR; }
    PG8_BAR;
    if constexpr (Epi::AFTER_DRAIN) { E.fused(acc, cur, wr, wc, fr, fq, lds, wid, lane); S.done(cur); }
#undef PG8_SA
#undef PG8_SB
#undef PG8_STAGE
#undef PG8_LDA
#undef PG8_LDB
#undef PG8_MMA
#undef PG8_WAIT_V
#undef PG8_WAIT_L
#undef PG8_BAR
#undef PG8_SCHED
}
}

using pg8::Unit;
typedef f32x4 Acc[2][2][4][2];

DI u32x4 pack8(const f32x4& a, const f32x4& b) { u32x4 w; w.x = pk2(a[0], a[1]); w.y = pk2(a[2], a[3]); w.z = pk2(b[0], b[1]); w.w = pk2(b[2], b[3]); return w; }

struct EpiH {
    static constexpr bool PERM = true, AFTER_DRAIN = false;
    bf16* Qh; bf16* Kh; bf16* VTh; float* DEC; const float* hlb;
    DI void operator()(Acc& acc, const Unit& u, int wr, int wc, int fr, int fq) const {
        if (u.pn < 8) {
            const int h = u.pn, dbase = wc * 32 + 8 * fq;
#pragma unroll
            for (int ai = 0; ai < 2; ++ai) {
                const int row0 = u.pm * 256 + ai * 128 + wr * 64;
                const int bidx = row0 >> 13, chunk = (row0 & (SEQ - 1)) >> 6;
#pragma unroll
                for (int n = 0; n < 2; ++n) {
                    f32x4 ebl;
#pragma unroll
                    for (int e = 0; e < 4; ++e) {
                        const int c = h * 128 + dbase + 4 * n + e;
                        const float lb = sigmoidf_(hlb[c] - hlb[1024 + c]);
                        float carry = 0.f, eb = 0.f;
#pragma unroll
                        for (int m = 0; m < 4; ++m) {
                            const float sg = sigmoidf_(acc[ai][1][m][n][e]);
                            const float f = lb + (1.f - lb) * sg;
                            const float kk = (1.f - lb) * (1.f - sg);
                            float s = __logf(f);
#pragma unroll
                            for (int dl = 1; dl < 16; dl <<= 1) { const float o = __shfl_up(s, dl, 16); if (fr >= dl) s += o; }
                            const float b = s + carry;
                            carry += __shfl(s, 15, 16);
                            eb = __expf(b);
                            acc[ai][0][m][n][e] = acc[ai][0][m][n][e] * 0.08838834764831845f * eb;
                            acc[ai][1][m][n][e] = kk * __expf(-b);
                        }
                        ebl[e] = eb;
                        __builtin_amdgcn_sched_barrier(0);
                    }
                    if (fr == 15) *(f32x4*)(DEC + ((size_t)((bidx * HG_H + h) * HG_NC + chunk)) * 128 + dbase + 4 * n) = ebl;
#pragma unroll
                    for (int m = 0; m < 4; ++m) {
                        const size_t row = (size_t)(row0 + m * 16 + fr);
                        const f32x4 qv = acc[ai][0][m][n], kv = acc[ai][1][m][n];
                        u32x2 oq, ok; oq.x = pk2(qv[0], qv[1]); oq.y = pk2(qv[2], qv[3]); ok.x = pk2(kv[0], kv[1]); ok.y = pk2(kv[2], kv[3]);
                        *(u32x2*)(Qh + row * 1024 + h * 128 + dbase + 4 * n) = oq;
                        *(u32x2*)(Kh + row * 1024 + h * 128 + dbase + 4 * n) = ok;
                    }
                    __builtin_amdgcn_sched_barrier(0);
                }
            }
        } else {
#pragma unroll
            for (int ai = 0; ai < 2; ++ai)
#pragma unroll
                for (int m = 0; m < 4; ++m) {
                    const int row = u.pm * 256 + ai * 128 + wr * 64 + m * 16 + fr, bidx = row >> 13, pos = row & (SEQ - 1);
                    bf16* ptr = VTh + (((size_t)(bidx * HG_H * 128 + (u.pn - 8) * 256 + wc * 32 + 8 * fq)) << 13) + pos;
#pragma unroll
                    for (int bj = 0; bj < 2; ++bj) {
#pragma unroll
                        for (int n = 0; n < 2; ++n)
#pragma unroll
                            for (int e = 0; e < 4; ++e) { asm volatile("" : "+v"(ptr)); *ptr = f2bf(acc[ai][bj][m][n][e]); ptr += 8192; }
                        ptr += (size_t)120 * 8192;
                    }
                }
        }
    }
};

struct EpiR {
    static constexpr bool PERM = true, AFTER_DRAIN = false;
    bf16* Qr; bf16* Kr; bf16* VTr; const float* COS; const float* SIN;
    DI void operator()(Acc& acc, const Unit& u, int wr, int wc, int fr, int fq) const {
        if (u.pn < 8) {
            const bool isk = u.pn >= 4; const int h = u.pn & 3;
            const float lg = __log2f(1.f - exp2f(-5.f - (float)h));
            bf16* dst = isk ? Kr : Qr;
            const int j0 = wc * 32 + 8 * fq;
#pragma unroll
            for (int ai = 0; ai < 2; ++ai)
#pragma unroll
                for (int m = 0; m < 4; ++m) {
                    const int row = u.pm * 256 + ai * 128 + wr * 64 + m * 16 + fr, pos = row & (SEQ - 1), il = pos & (RT_L - 1);
                    const float sc = isk ? exp2f(-lg * (float)il) * 0.0625f : exp2f(lg * (float)il);
#pragma unroll
                    for (int n = 0; n < 2; ++n) {
                        const f32x4 c = *(const f32x4*)(COS + (size_t)pos * 128 + j0 + 4 * n), s = *(const f32x4*)(SIN + (size_t)pos * 128 + j0 + 4 * n);
                        const f32x4 x1 = acc[ai][0][m][n], x2 = acc[ai][1][m][n];
                        acc[ai][0][m][n] = (x1 * c - x2 * s) * sc; acc[ai][1][m][n] = (x1 * s + x2 * c) * sc;
                    }
                    *(u32x4*)(dst + (size_t)row * 1024 + h * 256 + j0) = pack8(acc[ai][0][m][0], acc[ai][0][m][1]);
                    *(u32x4*)(dst + (size_t)row * 1024 + h * 256 + 128 + j0) = pack8(acc[ai][1][m][0], acc[ai][1][m][1]);
                }
        } else {
#pragma unroll
            for (int ai = 0; ai < 2; ++ai)
#pragma unroll
                for (int m = 0; m < 4; ++m) {
                    const int row = u.pm * 256 + ai * 128 + wr * 64 + m * 16 + fr, bidx = row >> 13, pos = row & (SEQ - 1);
                    const int uu = pos & 15, hs = (uu >> 2) & 1, jj = ((uu >> 3) << 2) | (uu & 3), ks = (pos >> 4) & 1, sblk = pos >> 5;
                    const int c0 = (u.pn - 8) * 256 + wc * 32, hd = c0 >> 9, nv0 = (c0 & 511) >> 5;
                    bf16* ptr = VTr + ((((size_t)((bidx * RT_H + hd) * 256 + sblk) * 16 + nv0) * 2 + ks) * 64 + (8 * fq + 32 * hs)) * 8 + jj;
#pragma unroll
                    for (int bj = 0; bj < 2; ++bj) {
#pragma unroll
                        for (int n = 0; n < 2; ++n)
#pragma unroll
                            for (int e = 0; e < 4; ++e) { asm volatile("" : "+v"(ptr)); *ptr = f2bf(acc[ai][bj][m][n][e]); ptr += 8; }
                        ptr += 4 * 2 * 64 * 8 - 64;
                    }
                }
        }
    }
};

struct EpiG {
    static constexpr bool PERM = true, AFTER_DRAIN = false;
    bf16* OHG; bf16* ORET; bf16* GA; bf16* GB; const float* SSQP; int dry;
    DI void operator()(Acc& acc, const Unit& u, int wr, int wc, int fr, int fq) const {
        const int cb = wc * 32 + 8 * fq;
        if (u.pn < 12) {
            const bool isr = u.pn >= 4;
            bf16* base = isr ? ORET + (size_t)(u.pn - 4) * 256 + cb : OHG + (size_t)u.pn * 256 + cb;
            const int ld = isr ? 2048 : 1024, hd = isr ? ((u.pn - 4) >> 1) : 0;
#pragma unroll
            for (int ai = 0; ai < 2; ++ai) {
                u32x4 old[4][2]; float rs[4];
#pragma unroll
                for (int m = 0; m < 4; ++m) {
                    const size_t row = (size_t)(u.pm * 256 + ai * 128 + wr * 64 + m * 16 + fr);
#pragma unroll
                    for (int bj = 0; bj < 2; ++bj) old[m][bj] = *(const u32x4*)(base + row * ld + bj * 128);
                    rs[m] = 1.f;
                    if (isr) { const f32x2 sp = *(const f32x2*)(SSQP + row * 8 + hd * 2); rs[m] = rsqrtf((sp[0] + sp[1]) * (1.f / 512.f) + EPS); }
                }
#pragma unroll
                for (int m = 0; m < 4; ++m) {
                    const size_t row = (size_t)(u.pm * 256 + ai * 128 + wr * 64 + m * 16 + fr);
#pragma unroll
                    for (int bj = 0; bj < 2; ++bj) {
                        f32x4 a0 = acc[ai][bj][m][0], a1 = acc[ai][bj][m][1];
                        const u32x4 o = old[m][bj]; const float r1 = rs[m];
#pragma unroll
                        for (int e = 0; e < 4; ++e) { a0[e] = siluf_(a0[e]) * r1; a1[e] = siluf_(a1[e]) * r1; }
                        a0[0] *= bflo(o.x); a0[1] *= bfhi(o.x); a0[2] *= bflo(o.y); a0[3] *= bfhi(o.y);
                        a1[0] *= bflo(o.z); a1[1] *= bfhi(o.z); a1[2] *= bflo(o.w); a1[3] *= bfhi(o.w);
                        const u32x4 res = pack8(a0, a1);
                        if (!dry) *(u32x4*)(base + row * ld + bj * 128) = res; else asm volatile("" :: "v"(res));
                    }
                }
                __builtin_amdgcn_sched_barrier(0);
            }
        } else {
            bf16* base = (u.pn < 16 ? GA + (size_t)(u.pn - 12) * 256 : GB + (size_t)(u.pn - 16) * 256) + cb;
#pragma unroll
            for (int ai = 0; ai < 2; ++ai)
#pragma unroll
                for (int m = 0; m < 4; ++m) {
                    const size_t row = (size_t)(u.pm * 256 + ai * 128 + wr * 64 + m * 16 + fr);
#pragma unroll
                    for (int bj = 0; bj < 2; ++bj) {
                        f32x4 a0 = acc[ai][bj][m][0], a1 = acc[ai][bj][m][1];
#pragma unroll
                        for (int e = 0; e < 4; ++e) { a0[e] = sigmoidf_(a0[e]); a1[e] = sigmoidf_(a1[e]); }
                        *(u32x4*)(base + row * 1024 + bj * 128) = pack8(a0, a1);
                    }
                }
        }
    }
};

struct EpiM1 {
    static constexpr bool PERM = true, AFTER_DRAIN = false;
    float* M1; const bf16* GA;
    DI void operator()(Acc& acc, const Unit& u, int wr, int wc, int fr, int fq) const {
        const int cb = u.pn * 256 + wc * 32 + 8 * fq;
#pragma unroll
        for (int ai = 0; ai < 2; ++ai)
#pragma unroll
            for (int m = 0; m < 4; ++m) {
                const size_t row = (size_t)(u.pm * 256 + ai * 128 + wr * 64 + m * 16 + fr);
#pragma unroll
                for (int bj = 0; bj < 2; ++bj) {
                    const u32x4 g = *(const u32x4*)(GA + row * 1024 + cb + bj * 128);
                    f32x4 a0 = acc[ai][bj][m][0], a1 = acc[ai][bj][m][1];
                    a0[0] *= bflo(g.x); a0[1] *= bfhi(g.x); a0[2] *= bflo(g.y); a0[3] *= bfhi(g.y);
                    a1[0] *= bflo(g.z); a1[1] *= bfhi(g.z); a1[2] *= bflo(g.w); a1[3] *= bfhi(g.w);
                    float* p = M1 + row * 1024 + cb + bj * 128;
                    *(f32x4*)p = a0; *(f32x4*)(p + 4) = a1;
                }
            }
    }
};
struct EpiMerge {
    static constexpr bool PERM = true, AFTER_DRAIN = false;
    const float* M1; const bf16* GB; bf16* MERGED;
    DI void operator()(Acc& acc, const Unit& u, int wr, int wc, int fr, int fq) const {
        const int cb = u.pn * 256 + wc * 32 + 8 * fq;
#pragma unroll
        for (int ai = 0; ai < 2; ++ai)
#pragma unroll
            for (int m = 0; m < 4; ++m) {
                const size_t row = (size_t)(u.pm * 256 + ai * 128 + wr * 64 + m * 16 + fr);
#pragma unroll
                for (int bj = 0; bj < 2; ++bj) {
                    const u32x4 g = *(const u32x4*)(GB + row * 1024 + cb + bj * 128);
                    const float* p = M1 + row * 1024 + cb + bj * 128;
                    f32x4 a0 = acc[ai][bj][m][0], a1 = acc[ai][bj][m][1];
                    const f32x4 m0 = *(const f32x4*)p, m1 = *(const f32x4*)(p + 4);
                    a0[0] = a0[0] * bflo(g.x) + m0[0]; a0[1] = a0[1] * bfhi(g.x) + m0[1]; a0[2] = a0[2] * bflo(g.y) + m0[2]; a0[3] = a0[3] * bfhi(g.y) + m0[3];
                    a1[0] = a1[0] * bflo(g.z) + m1[0]; a1[1] = a1[1] * bfhi(g.z) + m1[1]; a1[2] = a1[2] * bflo(g.w) + m1[2]; a1[3] = a1[3] * bfhi(g.w) + m1[3];
                    *(u32x4*)(MERGED + row * 1024 + cb + bj * 128) = pack8(a0, a1);
                }
            }
    }
};
struct EpiOut {
    static constexpr bool PERM = true, AFTER_DRAIN = false;
    const float* X; float* X1; bf16* XW; const float* nw; float* SSQX;
    DI void operator()(Acc& acc, const Unit& u, int wr, int wc, int fr, int fq) const {
        const int cb = u.pn * 256 + wc * 32 + 8 * fq;
#pragma unroll
        for (int ai = 0; ai < 2; ++ai)
#pragma unroll
            for (int m = 0; m < 4; ++m) {
                const size_t row = (size_t)(u.pm * 256 + ai * 128 + wr * 64 + m * 16 + fr);
                float ss = 0.f;
#pragma unroll
                for (int bj = 0; bj < 2; ++bj) {
                    const size_t off = row * 1024 + cb + bj * 128;
                    const f32x4 x0 = *(const f32x4*)(X + off), x1v = *(const f32x4*)(X + off + 4);
                    const f32x4 w0 = *(const f32x4*)(nw + cb + bj * 128), w1 = *(const f32x4*)(nw + cb + bj * 128 + 4);
                    const f32x4 a0 = acc[ai][bj][m][0] + x0, a1 = acc[ai][bj][m][1] + x1v;
                    *(f32x4*)(X1 + off) = a0; *(f32x4*)(X1 + off + 4) = a1;
                    ss += (a0[0] * a0[0] + a0[1] * a0[1]) + (a0[2] * a0[2] + a0[3] * a0[3]) + (a1[0] * a1[0] + a1[1] * a1[1]) + (a1[2] * a1[2] + a1[3] * a1[3]);
                    *(u32x4*)(XW + off) = pack8(a0 * w0, a1 * w1);
                }
                ss += __shfl_xor(ss, 16); ss += __shfl_xor(ss, 32);
                if (fq == 0) SSQX[row * 16 + u.pn * 4 + wc] = ss;
            }
    }
};
DI float rstd_x1(const float* SSQX, size_t row) {
    const f32x4 a = *(const f32x4*)(SSQX + row * 16), b = *(const f32x4*)(SSQX + row * 16 + 4), c = *(const f32x4*)(SSQX + row * 16 + 8), d = *(const f32x4*)(SSQX + row * 16 + 12);
    const float s = ((a[0] + a[1]) + (a[2] + a[3])) + ((b[0] + b[1]) + (b[2] + b[3])) + ((c[0] + c[1]) + (c[2] + c[3])) + ((d[0] + d[1]) + (d[2] + d[3]));
    return rsqrtf(s * (1.f / 1024.f) + EPS);
}
struct EpiQ {
    static constexpr bool PERM = true, AFTER_DRAIN = false;
    bf16* Q; const float* SSQX;
    DI void operator()(Acc& acc, const Unit& u, int wr, int wc, int fr, int fq) const {
        const int cb = u.pn * 256 + wc * 32 + 8 * fq;
#pragma unroll
        for (int ai = 0; ai < 2; ++ai)
#pragma unroll
            for (int m = 0; m < 4; ++m) {
                const size_t row = (size_t)(u.pm * 256 + ai * 128 + wr * 64 + m * 16 + fr);
                const float rs = rstd_x1(SSQX, row);
#pragma unroll
                for (int bj = 0; bj < 2; ++bj) *(u32x4*)(Q + row * 2048 + cb + bj * 128) = pack8(acc[ai][bj][m][0] * rs, acc[ai][bj][m][1] * rs);
            }
    }
};

#define MFMA32(a, b, c) __builtin_amdgcn_mfma_f32_32x32x16_bf16((a), (b), (c), 0, 0, 0)
DI bf16x8 ldg16(const bf16* p) { return *(const bf16x8*)p; }
DI bf16x8 ldg2x8(const bf16* p0, const bf16* p1) { const s16x4 a = *(const s16x4*)p0, b = *(const s16x4*)p1; return __builtin_shufflevector(a, b, 0, 1, 2, 3, 4, 5, 6, 7); }
DI bf16x8 packx(const f32x16& x, int s) {
    u32x4 p; p.x = pk2(x[8 * s + 0], x[8 * s + 1]); p.y = pk2(x[8 * s + 2], x[8 * s + 3]); p.z = pk2(x[8 * s + 4], x[8 * s + 5]); p.w = pk2(x[8 * s + 6], x[8 * s + 7]);
    return __builtin_bit_cast(bf16x8, p);
}
DI f32x16 zero16() { f32x16 z;
#pragma unroll
    for (int i = 0; i < 16; ++i) z[i] = 0.f; return z; }

DI bf16x8 tr_frag(const LAS unsigned char* tile, int RS, int lane, int ks, int c) {
    const int hh = lane >> 5, blk = (lane >> 4) & 1, q = (lane & 15) >> 2, p = lane & 3;
    const LAS unsigned char* a0 = tile + (16 * ks + 8 * hh + q) * RS + (32 * c + 16 * blk + 4 * p) * 2;
    const s16x4 lo = __builtin_amdgcn_ds_read_tr16_b64_v4i16((LAS s16x4*)a0);
    const s16x4 hi = __builtin_amdgcn_ds_read_tr16_b64_v4i16((LAS s16x4*)(a0 + 4 * RS));
    return __builtin_shufflevector(lo, hi, 0, 1, 2, 3, 4, 5, 6, 7);
}

DI bf16x8 tr_frag_perm(const LAS unsigned char* tile, int RS, int lane, int ks, int c) {
    const int hh = lane >> 5, blk = (lane >> 4) & 1, q = (lane & 15) >> 2, p = lane & 3;
    const LAS unsigned char* a0 = tile + (16 * ks + 4 * hh + q) * RS + (32 * c + 16 * blk + 4 * p) * 2;
    const s16x4 lo = __builtin_amdgcn_ds_read_tr16_b64_v4i16((LAS s16x4*)a0);
    const s16x4 hi = __builtin_amdgcn_ds_read_tr16_b64_v4i16((LAS s16x4*)(a0 + 8 * RS));
    return __builtin_shufflevector(lo, hi, 0, 1, 2, 3, 4, 5, 6, 7);
}

constexpr int HG_KRS = 320;
DI void hg_pass1(LAS unsigned char* lds, const bf16* Kh, const bf16* VTh, bf16* STh, int wg, int nwg) {
    const int tid = fresh_tid(), lane = tid & 63, w = __builtin_amdgcn_readfirstlane(tid >> 6), r = lane & 31, hh = lane >> 5;
    for (int unit = wg; unit < 16 * HG_NC; unit += nwg) {
        const int bh = unit >> 7, c = unit & 127, b = bh >> 3, h = bh & 7;
        __syncthreads();
        {
            const int row = tid >> 3, ch = tid & 7;
            const bf16* src = Kh + ((size_t)(b * SEQ + c * 64 + row)) * 1024 + h * 128;
            const bf16x8 v0 = ldg16(src + ch * 8), v1 = ldg16(src + 64 + ch * 8);
            *(LAS bf16x8*)(lds + row * HG_KRS + ch * 16) = v0; *(LAS bf16x8*)(lds + row * HG_KRS + 128 + ch * 16) = v1;
        }
        __syncthreads();
        const int mt = w & 3, nt0 = w >> 2;
        f32x16 a0 = zero16(), a1 = zero16();
        const bf16* vrow = VTh + (((size_t)(bh * 128 + 32 * mt + r)) << 13) + c * 64;
#pragma unroll
        for (int ks = 0; ks < 4; ++ks) {
            const bf16x8 av = ldg16(vrow + 16 * ks + 8 * hh);
            a0 = MFMA32(av, tr_frag(lds, HG_KRS, lane, ks, nt0), a0);
            a1 = MFMA32(av, tr_frag(lds, HG_KRS, lane, ks, nt0 + 2), a1);
        }
        bf16* dst = STh + ((size_t)(bh * HG_NC + c)) * 16384;
#pragma unroll
        for (int i = 0; i < 16; ++i) {
            const int v = 32 * mt + crow(i, hh);
            dst[v * 128 + 32 * nt0 + r] = f2bf(a0[i]); dst[v * 128 + 32 * (nt0 + 2) + r] = f2bf(a1[i]);
        }
    }
    __syncthreads();
}

DI void hg_scan(bf16* STh, const float* DEC, int gtid, int gsz) {
    for (int idx = gtid; idx < 16 * 128 * 32; idx += gsz) {
        const int dq = idx & 31, v = (idx >> 5) & 127, bh = idx >> 12;
        f32x4 carry = {0.f, 0.f, 0.f, 0.f};
        bf16* p = STh + ((size_t)bh * HG_NC) * 16384 + v * 128 + dq * 4;
        const float* dp = DEC + ((size_t)bh * HG_NC) * 128 + dq * 4;
#pragma unroll 8
        for (int c = 0; c < HG_NC; ++c) {
            const u32x2 wv = *(const u32x2*)(p + (size_t)c * 16384);
            const f32x4 dec = *(const f32x4*)(dp + c * 128);
            u32x2 o; o.x = pk2(carry[0], carry[1]); o.y = pk2(carry[2], carry[3]);
            *(u32x2*)(p + (size_t)c * 16384) = o;
            carry[0] = dec[0] * (carry[0] + bflo(wv.x)); carry[1] = dec[1] * (carry[1] + bfhi(wv.x));
            carry[2] = dec[2] * (carry[2] + bflo(wv.y)); carry[3] = dec[3] * (carry[3] + bfhi(wv.y));
        }
    }
}
DI void rt_scan(bf16* STr, int gtid, int gsz) {
    for (int idx = gtid; idx < 8 * 512 * 32; idx += gsz) {
        const int dq = idx & 31, v = (idx >> 5) & 511, bh = idx >> 14, h = bh & 3;
        const float dec = exp2f((float)RT_L * __log2f(1.f - exp2f(-5.f - (float)h)));
        float carry[8];
#pragma unroll
        for (int e = 0; e < 8; ++e) carry[e] = 0.f;
        bf16* p = STr + ((size_t)bh * RT_NS) * 131072 + v * 256 + dq * 8;
#pragma unroll 4
        for (int c = 0; c < RT_NS; ++c) {
            const u32x4 wv = *(const u32x4*)(p + (size_t)c * 131072);
            u32x4 o; o.x = pk2(carry[0], carry[1]); o.y = pk2(carry[2], carry[3]); o.z = pk2(carry[4], carry[5]); o.w = pk2(carry[6], carry[7]);
            *(u32x4*)(p + (size_t)c * 131072) = o;
            if (c == RT_NS - 1) break;
            carry[0] = dec * (carry[0] + bflo(wv.x)); carry[1] = dec * (carry[1] + bfhi(wv.x));
            carry[2] = dec * (carry[2] + bflo(wv.y)); carry[3] = dec * (carry[3] + bfhi(wv.y));
            carry[4] = dec * (carry[4] + bflo(wv.z)); carry[5] = dec * (carry[5] + bfhi(wv.z));
            carry[6] = dec * (carry[6] + bflo(wv.w)); carry[7] = dec * (carry[7] + bfhi(wv.w));
        }
    }
}

DI void hg_pass3(const bf16* Qh, const bf16* Kh, const bf16* VTh, const bf16* STh, const float* hg_norm_w, bf16* OHG, int gw, int ngw) {
    const int lane = fresh_tid() & 63, r = lane & 31, hh = lane >> 5;
    for (int unit = gw; unit < 16 * HG_NC * 2; unit += ngw) {
        const int tb = unit & 1, c = (unit >> 1) & 127, bh = unit >> 8, b = bh >> 3, h = bh & 7;
        const size_t trow = (size_t)(b * SEQ + c * 64 + tb * 32 + r);
        bf16x8 qf[8];
#pragma unroll
        for (int kk = 0; kk < 8; ++kk) qf[kk] = ldg16(Qh + trow * 1024 + h * 128 + kk * 16 + 8 * hh);
        f32x16 acc[4];
#pragma unroll
        for (int nv = 0; nv < 4; ++nv) acc[nv] = zero16();
        for (int sb = 0; sb <= tb; ++sb) {
            const size_t srow = (size_t)(b * SEQ + c * 64 + sb * 32 + r);
            f32x16 x = zero16();
#pragma unroll
            for (int kk = 0; kk < 8; ++kk) x = MFMA32(ldg16(Kh + srow * 1024 + h * 128 + kk * 16 + 8 * hh), qf[kk], x);
            if (sb == tb) {
#pragma unroll
                for (int i = 0; i < 16; ++i) if (crow(i, hh) > r) x[i] = 0.f;
            }
            const bf16x8 xs0 = packx(x, 0), xs1 = packx(x, 1);
#pragma unroll
            for (int nv = 0; nv < 4; ++nv) {
                const bf16* vb = VTh + (((size_t)(bh * 128 + nv * 32 + r)) << 13) + c * 64 + sb * 32 + 4 * hh;
                acc[nv] = MFMA32(ldg2x8(vb, vb + 8), xs0, acc[nv]);
                acc[nv] = MFMA32(ldg2x8(vb + 16, vb + 24), xs1, acc[nv]);
            }
        }
        const bf16* st = STh + ((size_t)(bh * HG_NC + c)) * 16384;
#pragma unroll
        for (int nv = 0; nv < 4; ++nv)
#pragma unroll
            for (int kk = 0; kk < 8; ++kk) acc[nv] = MFMA32(ldg16(st + (nv * 32 + r) * 128 + kk * 16 + 8 * hh), qf[kk], acc[nv]);
        float ss = 0.f;
#pragma unroll
        for (int nv = 0; nv < 4; ++nv)
#pragma unroll
            for (int i = 0; i < 16; ++i) ss += acc[nv][i] * acc[nv][i];
        ss += __shfl_xor(ss, 32);
        const float rs = rsqrtf(ss * (1.f / 128.f) + EPS);
#pragma unroll
        for (int nv = 0; nv < 4; ++nv)
#pragma unroll
            for (int g = 0; g < 4; ++g) {
                const int v = nv * 32 + 8 * g + 4 * hh;
                const f32x4 wv = *(const f32x4*)(hg_norm_w + h * 128 + v);
                u32x2 o; o.x = pk2(acc[nv][4 * g] * rs * wv[0], acc[nv][4 * g + 1] * rs * wv[1]); o.y = pk2(acc[nv][4 * g + 2] * rs * wv[2], acc[nv][4 * g + 3] * rs * wv[3]);
                *(u32x2*)(OHG + trow * 1024 + h * 128 + v) = o;
            }
    }
}

constexpr int RT_KRS = 576;
constexpr int RT_KBUF = 64 * RT_KRS;
DI void rt_pass1(LAS unsigned char* lds, const bf16* Kr, const bf16* VTr, bf16* STr, int wg, int nwg) {
    const int tid = fresh_tid(), lane = tid & 63, w = __builtin_amdgcn_readfirstlane(tid >> 6), r = lane & 31, hh = lane >> 5;
    const int wm = w & 3, wn = w >> 2;
    const int srow = tid >> 3, sch = tid & 7;
    for (int unit = wg; unit < 8 * (RT_NS - 1) * 2; unit += nwg) {
        const int vh = unit & 1, sg = (unit >> 1) % (RT_NS - 1), bh = (unit >> 1) / (RT_NS - 1), b = bh >> 2, h = bh & 3;
        f32x16 acc[2][4];
#pragma unroll
        for (int i = 0; i < 2; ++i)
#pragma unroll
            for (int j = 0; j < 4; ++j) acc[i][j] = zero16();
        const bf16* kbase = Kr + ((size_t)(b * SEQ + sg * RT_L)) * 1024 + h * 256;
        bf16x8 st[4];
#pragma unroll
        for (int i = 0; i < 4; ++i) st[i] = ldg16(kbase + (size_t)srow * 1024 + (sch + 8 * i) * 8);
        __syncthreads();
#pragma unroll
        for (int i = 0; i < 4; ++i) *(LAS bf16x8*)(lds + srow * RT_KRS + (sch + 8 * i) * 16) = st[i];
        for (int sb = 0; sb < RT_L / 64; ++sb) {
            const LAS unsigned char* cur = lds + (sb & 1) * RT_KBUF;
            if (sb + 1 < RT_L / 64) {
#pragma unroll
                for (int i = 0; i < 4; ++i) st[i] = ldg16(kbase + (size_t)((sb + 1) * 64 + srow) * 1024 + (sch + 8 * i) * 8);
            }
            __syncthreads();
#pragma unroll
            for (int ks = 0; ks < 4; ++ks) {
                bf16x8 av[2];
#pragma unroll
                for (int i = 0; i < 2; ++i) av[i] = ldg16(VTr + (((((size_t)(bh * 256 + sg * 16 + sb * 2 + (ks >> 1))) * 16 + vh * 8 + wm * 2 + i) * 2 + (ks & 1)) * 64 + lane) * 8);
#pragma unroll
                for (int j = 0; j < 4; ++j) {
                    const bf16x8 bv = tr_frag_perm(cur, RT_KRS, lane, ks, wn * 4 + j);
                    acc[0][j] = MFMA32(av[0], bv, acc[0][j]); acc[1][j] = MFMA32(av[1], bv, acc[1][j]);
                }
                __builtin_amdgcn_sched_barrier(0);
            }
            if (sb + 1 < RT_L / 64) {
                LAS unsigned char* nxt = lds + ((sb + 1) & 1) * RT_KBUF;
#pragma unroll
                for (int i = 0; i < 4; ++i) *(LAS bf16x8*)(nxt + srow * RT_KRS + (sch + 8 * i) * 16) = st[i];
            }
        }
        bf16* dst = STr + ((size_t)(bh * RT_NS + sg)) * 131072;
#pragma unroll
        for (int i = 0; i < 2; ++i)
#pragma unroll
            for (int j = 0; j < 4; ++j)
#pragma unroll
                for (int e = 0; e < 16; ++e) {
                    const int vl = crow(e, hh), d = wn * 128 + j * 32 + r;
                    dst[((((vh * 8 + wm * 2 + i) * 16 + (d >> 4)) * 64 + vl + 32 * ((d >> 3) & 1)) << 3) + (d & 7)] = f2bf(acc[i][j][e]);
                }
    }
    __syncthreads();
}

DI void rt_pass3_unit(const bf16* Qr, const bf16* Kr, const bf16* VTr, const bf16* STr, bf16* ORET, float* SSQP, int idx, int lane) {
    const int r = lane & 31, hh = lane >> 5;
    const int vh = idx & 1, tbl = (idx >> 1) & 15, sgid = idx >> 5, sg = sgid & 15, bh = sgid >> 4, b = bh >> 2, h = bh & 3;
    const int t0 = sg * RT_L + tbl * 32;
    const size_t trow = (size_t)(b * SEQ + t0 + r);
    const bf16* qrow = Qr + trow * 1024 + h * 256 + 8 * hh;
    f32x16 acc[8];
#pragma unroll
    for (int nv = 0; nv < 8; ++nv) acc[nv] = zero16();
    for (int sb = 0; sb <= tbl; ++sb) {
        const int s0 = sg * RT_L + sb * 32;
        const bf16* krow = Kr + ((size_t)(b * SEQ + s0 + r)) * 1024 + h * 256 + 8 * hh;
        f32x16 x = zero16();
#pragma unroll
        for (int k4 = 0; k4 < 4; ++k4) {
            bf16x8 kf[4], qf[4];
#pragma unroll
            for (int i = 0; i < 4; ++i) { kf[i] = ldg16(krow + (k4 * 4 + i) * 16); qf[i] = ldg16(qrow + (k4 * 4 + i) * 16); }
#pragma unroll
            for (int i = 0; i < 4; ++i) x = MFMA32(kf[i], qf[i], x);
            __builtin_amdgcn_sched_barrier(0);
        }
        if (sb == tbl) {
#pragma unroll
            for (int i = 0; i < 16; ++i) if (crow(i, hh) > r) x[i] = 0.f;
        }
        const bf16x8 xs0 = packx(x, 0), xs1 = packx(x, 1);
#pragma unroll
        for (int nv = 0; nv < 8; ++nv) {
            const bf16* vb = VTr + (((size_t)(bh * 512 + vh * 256 + nv * 32 + r)) << 13) + s0 + 4 * hh;
            acc[nv] = MFMA32(ldg2x8(vb, vb + 8), xs0, acc[nv]);
            acc[nv] = MFMA32(ldg2x8(vb + 16, vb + 24), xs1, acc[nv]);
            if ((nv & 3) == 3) __builtin_amdgcn_sched_barrier(0);
        }
    }
    const bf16* st = STr + ((size_t)(bh * RT_NS + sg)) * 131072 + (size_t)(vh * 256) * 256;
#pragma unroll 2
    for (int kk = 0; kk < 16; ++kk) {
        const bf16x8 q = ldg16(qrow + kk * 16);
#pragma unroll
        for (int nv = 0; nv < 8; ++nv) acc[nv] = MFMA32(ldg16(st + (nv * 32 + r) * 256 + kk * 16 + 8 * hh), q, acc[nv]);
        __builtin_amdgcn_sched_barrier(0);
    }
    float ss = 0.f;
#pragma unroll
    for (int nv = 0; nv < 8; ++nv)
#pragma unroll
        for (int i = 0; i < 16; ++i) ss += acc[nv][i] * acc[nv][i];
    ss += __shfl_xor(ss, 32);
    if (hh == 0) SSQP[trow * 8 + h * 2 + vh] = ss;
#pragma unroll
    for (int nv = 0; nv < 8; ++nv)
#pragma unroll
        for (int g = 0; g < 4; ++g) {
            const int v = vh * 256 + nv * 32 + 8 * g + 4 * hh;
            u32x2 o; o.x = pk2(acc[nv][4 * g], acc[nv][4 * g + 1]); o.y = pk2(acc[nv][4 * g + 2], acc[nv][4 * g + 3]);
            *(u32x2*)(ORET + trow * 2048 + h * 512 + v) = o;
        }
}
DI void rt_pass3(const bf16* Qr, const bf16* Kr, const bf16* VTr, const bf16* STr, bf16* ORET, float* SSQP, int gw, int ngw) {
    const int lane = fresh_tid() & 63;
    for (int u = gw; u < 2048; u += ngw) {
        rt_pass3_unit(Qr, Kr, VTr, STr, ORET, SSQP, u, lane);
        const int p = (u & 1) | ((15 - ((u >> 1) & 15)) << 1) | (((u >> 5) + 64) << 5);
        rt_pass3_unit(Qr, Kr, VTr, STr, ORET, SSQP, p, lane);
    }
}

constexpr int RQ_RS = 528;
constexpr int RQ_QBYTES = 128 * RQ_RS, RQ_KBYTES = 32 * RQ_RS;
DI void rt_pass3_wg(LAS unsigned char* lds, const bf16* Qr, const bf16* Kr, const bf16* VTr, const bf16* STr, bf16* ORET, float* SSQP, int wg, int nwg) {
    const int tid = fresh_tid(), lane = tid & 63, w = __builtin_amdgcn_readfirstlane(tid >> 6), r = lane & 31, hh = lane >> 5;
    const int tsub = w & 3, vh = w >> 2;
    LAS unsigned char* Qs = lds;
    LAS unsigned char* Ks = lds + RQ_QBYTES;
    for (int pairidx = wg; pairidx < 256; pairidx += nwg) {
#pragma unroll 1
        for (int half = 0; half < 2; ++half) {
            const int sgid = pairidx >> 1, bh = sgid >> 4, sg = sgid & 15, b = bh >> 2, h = bh & 3;
            const int qq = half ? 3 - (pairidx & 1) : (pairidx & 1);
            const int pos0 = sg * RT_L + qq * 128, nsb = 4 * qq + 4, mysb = 4 * qq + tsub;
            const bf16* qsrc = Qr + ((size_t)(b * SEQ + pos0)) * 1024 + h * 256;
            const bf16* ksrc = Kr + ((size_t)(b * SEQ + sg * RT_L)) * 1024 + h * 256;
            unsigned stoff = (unsigned)((tid >> 5) * 1024 + (tid & 31) * 8);
            unsigned stlds = (unsigned)((tid >> 5) * RQ_RS + (tid & 31) * 16);
            asm volatile("" : "+v"(stoff), "+v"(stlds));
            __syncthreads();
#pragma unroll
            for (int i = 0; i < 8; ++i) *(LAS bf16x8*)(Qs + stlds + i * 16 * RQ_RS) = ldg16(qsrc + i * 16 * 1024 + stoff);
            bf16x8 kst[2];
#pragma unroll
            for (int i = 0; i < 2; ++i) *(LAS bf16x8*)(Ks + stlds + i * 16 * RQ_RS) = ldg16(ksrc + i * 16 * 1024 + stoff);
            f32x16 acc[8];
#pragma unroll
            for (int nv = 0; nv < 8; ++nv) acc[nv] = zero16();
            __syncthreads();
            const LAS unsigned char* qfr = Qs + (tsub * 32 + r) * RQ_RS + 16 * hh;
            {
                const bf16* st = STr + ((size_t)(bh * RT_NS + sg)) * 131072 + (size_t)(vh * 8) * 16 * 512;
                unsigned so = (unsigned)(lane * 8);
                asm volatile("" : "+v"(so));
                bf16x8 fa[8], fb[8];
#pragma unroll
                for (int nv = 0; nv < 8; ++nv) fa[nv] = ldg16(st + nv * 16 * 512 + so);
#pragma unroll 1
                for (int k2 = 0; k2 < 8; ++k2) {
#pragma unroll
                    for (int nv = 0; nv < 8; ++nv) fb[nv] = ldg16(st + nv * 16 * 512 + (2 * k2 + 1) * 512 + so);
                    {
                        const bf16x8 q = *(const LAS bf16x8*)(qfr + (2 * k2) * 32);
#pragma unroll
                        for (int nv = 0; nv < 8; ++nv) acc[nv] = MFMA32(fa[nv], q, acc[nv]);
                    }
                    __builtin_amdgcn_sched_barrier(0);
                    if (k2 < 7) {
#pragma unroll
                        for (int nv = 0; nv < 8; ++nv) fa[nv] = ldg16(st + nv * 16 * 512 + (2 * k2 + 2) * 512 + so);
                    }
                    {
                        const bf16x8 q = *(const LAS bf16x8*)(qfr + (2 * k2 + 1) * 32);
#pragma unroll
                        for (int nv = 0; nv < 8; ++nv) acc[nv] = MFMA32(fb[nv], q, acc[nv]);
                    }
                    __builtin_amdgcn_sched_barrier(0);
                }
            }
            const bf16* vbase = VTr + (((size_t)(bh * 256 + sg * 16)) * 16 + vh * 8) * 1024;
            unsigned vo = (unsigned)(lane * 8);
            asm volatile("" : "+v"(vo));
#pragma unroll 1
            for (int sb = 0; sb < nsb; ++sb) {
                const LAS unsigned char* kcur = Ks + (sb & 1) * RQ_KBYTES;
                if (sb + 1 < nsb) {
#pragma unroll
                    for (int i = 0; i < 2; ++i) kst[i] = ldg16(ksrc + (size_t)(sb + 1) * 32 * 1024 + i * 16 * 1024 + stoff);
                }
                if (sb <= mysb) {
                    bf16x8 vt[8][2];
                    const bf16* vb = vbase + (size_t)sb * 16 * 1024;
#pragma unroll
                    for (int nv = 0; nv < 8; ++nv) { vt[nv][0] = ldg16(vb + nv * 1024 + vo); vt[nv][1] = ldg16(vb + nv * 1024 + 512 + vo); }
                    f32x16 x = zero16();
                    const LAS unsigned char* kfr = kcur + r * RQ_RS + 16 * hh;
#pragma unroll
                    for (int kk = 0; kk < 16; ++kk) { x = MFMA32(*(const LAS bf16x8*)(kfr + kk * 32), *(const LAS bf16x8*)(qfr + kk * 32), x); if (kk & 1) __builtin_amdgcn_sched_barrier(0); }
                    if (sb == mysb) {
#pragma unroll
                        for (int i = 0; i < 16; ++i) if (crow(i, hh) > r) x[i] = 0.f;
                    }
                    const bf16x8 xs0 = packx(x, 0), xs1 = packx(x, 1);
#pragma unroll
                    for (int nv = 0; nv < 8; ++nv) { acc[nv] = MFMA32(vt[nv][0], xs0, acc[nv]); acc[nv] = MFMA32(vt[nv][1], xs1, acc[nv]); }
                }
                if (sb + 1 < nsb) {
                    LAS unsigned char* knx = Ks + ((sb + 1) & 1) * RQ_KBYTES;
#pragma unroll
                    for (int i = 0; i < 2; ++i) *(LAS bf16x8*)(knx + stlds + i * 16 * RQ_RS) = kst[i];
                }
                __syncthreads();
            }
            const int trow = b * SEQ + pos0 + tsub * 32 + r;
            float ss = 0.f;
#pragma unroll
            for (int nv = 0; nv < 8; ++nv)
#pragma unroll
                for (int i = 0; i < 16; ++i) ss += acc[nv][i] * acc[nv][i];
            ss += __shfl_xor(ss, 32);
            if (hh == 0) SSQP[(size_t)trow * 8 + h * 2 + vh] = ss;
            bf16* obase = ORET + (size_t)(b * SEQ + pos0 + tsub * 32) * 2048 + h * 512 + vh * 256;
            unsigned oo = (unsigned)(r * 2048 + 4 * hh);
            asm volatile("" : "+v"(oo));
#pragma unroll
            for (int nv = 0; nv < 8; ++nv)
#pragma unroll
                for (int g = 0; g < 4; ++g) {
                    u32x2 o; o.x = pk2(acc[nv][4 * g], acc[nv][4 * g + 1]); o.y = pk2(acc[nv][4 * g + 2], acc[nv][4 * g + 3]);
                    *(u32x2*)(obase + oo + nv * 32 + 8 * g) = o;
                }
        }
    }
    __syncthreads();
}

DI float dot2bf(unsigned a, unsigned b, float c) {
#if __has_builtin(__builtin_amdgcn_fdot2_f32_bf16)
    typedef __bf16 nb2 __attribute__((ext_vector_type(2)));
    return __builtin_amdgcn_fdot2_f32_bf16(__builtin_bit_cast(nb2, a), __builtin_bit_cast(nb2, b), c, false);
#else
    return c + bflo(a) * bflo(b) + bfhi(a) * bfhi(b);
#endif
}
DI void wave_argmax(float& v, int& idx) {
#pragma unroll
    for (int o = 1; o < 64; o <<= 1) {
        const float ov = __shfl_xor(v, o); const int oi = __shfl_xor(idx, o);
        if (ov > v || (ov == v && oi < idx)) { v = ov; idx = oi; }
    }
}

DI void peer_topk1(const bf16* Q, const bf16* SK, float* TOPS, int* TOPI, int wg, int nwg) {
    const int tid = fresh_tid(), lane = tid & 63, w = __builtin_amdgcn_readfirstlane(tid >> 6);
    for (int unit = wg; unit < 16 * 16; unit += nwg) {
        const int hp = unit & 15, tblk = unit >> 4;
        unsigned k0[64], k1[64];
        {
            const u32x4* p0 = (const u32x4*)(SK + ((size_t)(hp * 128 + lane)) * 128);
            const u32x4* p1 = (const u32x4*)(SK + ((size_t)(hp * 128 + 64 + lane)) * 128);
#pragma unroll
            for (int i = 0; i < 16; ++i) { const u32x4 a = p0[i], b = p1[i]; k0[4 * i] = a.x; k0[4 * i + 1] = a.y; k0[4 * i + 2] = a.z; k0[4 * i + 3] = a.w; k1[4 * i] = b.x; k1[4 * i + 1] = b.y; k1[4 * i + 2] = b.z; k1[4 * i + 3] = b.w; }
        }
        for (int tt = 0; tt < 128; ++tt) {
            const int t = tblk * 1024 + w * 128 + tt;
            const u32x4* qp = (const u32x4*)(Q + (size_t)t * 2048 + hp * 128);
            float s0 = 0.f, s1 = 0.f;
#pragma unroll
            for (int i = 0; i < 16; ++i) {
                const u32x4 qv = qp[i];
                s0 = dot2bf(k0[4 * i], qv.x, s0); s0 = dot2bf(k0[4 * i + 1], qv.y, s0); s0 = dot2bf(k0[4 * i + 2], qv.z, s0); s0 = dot2bf(k0[4 * i + 3], qv.w, s0);
                s1 = dot2bf(k1[4 * i], qv.x, s1); s1 = dot2bf(k1[4 * i + 1], qv.y, s1); s1 = dot2bf(k1[4 * i + 2], qv.z, s1); s1 = dot2bf(k1[4 * i + 3], qv.w, s1);
            }
            float myv = 0.f; int myi = 0;
            for (int rnd = 0; rnd < 16; ++rnd) {
                float v; int idx;
                if (s0 >= s1) { v = s0; idx = lane; } else { v = s1; idx = lane + 64; }
                wave_argmax(v, idx);
                if (idx == lane) s0 = -3.0e38f;
                if (idx == lane + 64) s1 = -3.0e38f;
                if (lane == rnd) { myv = v; myi = idx; }
            }
            if (lane < 16) { TOPS[((size_t)t * 16 + hp) * 16 + lane] = myv; TOPI[((size_t)t * 16 + hp) * 16 + lane] = myi; }
        }
    }
}

DI void peer_cand(const float* TOPS, const int* TOPI, int* EIDX, float* EGATE, int gw, int ngw) {
    const int lane = fresh_tid() & 63;
    for (int unit = gw; unit < T * PE_H; unit += ngw) {
        const int t = unit >> 3, h = unit & 7;
        const float* s1p = TOPS + ((size_t)t * 16 + h * 2) * 16;
        const int i1 = lane >> 2, j0 = (lane & 3) * 4;
        const float a = s1p[i1];
        const f32x4 bq = *(const f32x4*)(s1p + 16 + j0);
        float c0 = a + bq[0], c1 = a + bq[1], c2 = a + bq[2], c3 = a + bq[3];
        float myv = 0.f; int myc = 0;
        for (int rnd = 0; rnd < 16; ++rnd) {
            float v = c0; int idx = 4 * lane;
            if (c1 > v) { v = c1; idx = 4 * lane + 1; }
            if (c2 > v) { v = c2; idx = 4 * lane + 2; }
            if (c3 > v) { v = c3; idx = 4 * lane + 3; }
            wave_argmax(v, idx);
            if (idx == 4 * lane) c0 = -3.0e38f;
            if (idx == 4 * lane + 1) c1 = -3.0e38f;
            if (idx == 4 * lane + 2) c2 = -3.0e38f;
            if (idx == 4 * lane + 3) c3 = -3.0e38f;
            if (lane == rnd) { myv = v; myc = idx; }
        }
        const float mx = __shfl(myv, 0);
        float ex = lane < 16 ? __expf(myv - mx) : 0.f;
        float sum = ex;
#pragma unroll
        for (int o = 1; o < 16; o <<= 1) sum += __shfl_xor(sum, o);
        if (lane < 16) {
            const int ci = myc >> 4, cj = myc & 15;
            const int e = TOPI[((size_t)t * 16 + h * 2) * 16 + ci] * PE_NK + TOPI[((size_t)t * 16 + h * 2 + 1) * 16 + cj];
            EIDX[(size_t)t * 128 + h * 16 + lane] = e;
            EGATE[(size_t)t * 128 + h * 16 + lane] = ex / sum;
        }
    }
}


DI unsigned key_pack(float s, unsigned lowbits, unsigned mask) {
    unsigned u = __float_as_uint(s); u = (u & 0x80000000u) ? ~u : (u | 0x80000000u);
    return (u & ~mask) | lowbits;
}
DI float key_val(unsigned k, unsigned mask) { unsigned u = k & ~mask; u = (u & 0x80000000u) ? (u & 0x7fffffffu) : ~u; return __uint_as_float(u); }
DI unsigned umin_(unsigned a, unsigned b) { return a < b ? a : b; }
DI unsigned umax_(unsigned a, unsigned b) { return a > b ? a : b; }
DI void ins16(unsigned (&t)[16], unsigned x) {
#pragma unroll
    for (int i = 15; i >= 1; --i) t[i] = umax_(umin_(t[i - 1], t[i]), umin_(umax_(t[i - 1], t[i]), x));
    t[0] = umax_(t[0], x);
}
DI void peer_retrieve(LAS unsigned char* lds, const bf16* Q, const bf16* SK, int* EIDX, float* EGATE, int gw, int ngw) {
    const int tid = fresh_tid(), lane = tid & 63, w = __builtin_amdgcn_readfirstlane(tid >> 6), r = lane & 31, hh = lane >> 5;
    LAS unsigned char* myl = lds + w * 2304 + lane * 36;
    for (int unit = gw; unit < (T / 32) * PE_H; unit += ngw) {
        const int h = unit & 7, tb = unit >> 3;
        const size_t trow = (size_t)(tb * 32 + r);
        unsigned L[2][16];
#pragma unroll
        for (int p = 0; p < 2; ++p) {
            f32x16 acc[4];
#pragma unroll
            for (int mt = 0; mt < 4; ++mt) acc[mt] = zero16();
            const bf16* qrow = Q + trow * 2048 + h * 256 + p * 128 + 8 * hh;
            const bf16* krow = SK + ((size_t)((h * 2 + p) * 128 + r)) * 128 + 8 * hh;
            asm volatile("" : "+v"(krow), "+v"(qrow));
#pragma unroll
            for (int kk = 0; kk < 8; ++kk) {
                const bf16x8 qf = ldg16(qrow + kk * 16);
#pragma unroll
                for (int mt = 0; mt < 4; ++mt) acc[mt] = MFMA32(ldg16(krow + mt * 32 * 128 + kk * 16), qf, acc[mt]);
                if (kk & 1) __builtin_amdgcn_sched_barrier(0);
            }
            unsigned t[16];
#pragma unroll
            for (int i = 0; i < 16; ++i) t[i] = 0u;
#pragma unroll
            for (int mt = 0; mt < 4; ++mt)
#pragma unroll
                for (int i = 0; i < 16; ++i) ins16(t, key_pack(acc[mt][i], (unsigned)(127 - 32 * mt - (i & 3) - 8 * (i >> 2)) - 4u * (unsigned)hh, 127u));
            unsigned o[16];
#pragma unroll
            for (int i = 0; i < 16; ++i) o[i] = (unsigned)__shfl_xor((int)t[i], 32);
#pragma unroll
            for (int i = 0; i < 16; ++i) ins16(t, o[i]);
#pragma unroll
            for (int i = 0; i < 16; ++i) L[p][i] = t[i];
        }
#pragma unroll
        for (int p = 0; p < 2; ++p)
#pragma unroll
            for (int g = 0; g < 4; ++g) {
                const unsigned v = (127u - (L[p][4 * g] & 127u)) | ((127u - (L[p][4 * g + 1] & 127u)) << 8) | ((127u - (L[p][4 * g + 2] & 127u)) << 16) | ((127u - (L[p][4 * g + 3] & 127u)) << 24);
                *(LAS unsigned*)(myl + p * 16 + g * 4) = v;
            }
        float a[16], b[16];
#pragma unroll
        for (int i = 0; i < 16; ++i) { a[i] = key_val(L[0][i], 127u); b[i] = key_val(L[1][i], 127u); }
        unsigned c[16];
#pragma unroll
        for (int i = 0; i < 16; ++i) c[i] = 0u;
#pragma unroll
        for (int i = 0; i < 16; ++i)
#pragma unroll
            for (int j = 0; j < 16; ++j)
                if ((i + 1) * (j + 1) <= 16) ins16(c, key_pack(a[i] + b[j], (unsigned)(255 - (16 * i + j)), 255u));
        float v[16];
        float sum = 0.f;
        const float mx = key_val(c[0], 255u);
#pragma unroll
        for (int k = 0; k < 16; ++k) { v[k] = __expf(key_val(c[k], 255u) - mx); sum += v[k]; }
        const float inv = 1.f / sum;
        asm volatile("s_waitcnt lgkmcnt(0)" ::: "memory");
        if (hh == 0) {
            int e[16];
#pragma unroll
            for (int k = 0; k < 16; ++k) {
                const unsigned cc = 255u - (c[k] & 255u);
                const unsigned i1 = *(LAS unsigned char*)(myl + (cc >> 4)), i2 = *(LAS unsigned char*)(myl + 16 + (cc & 15u));
                e[k] = (int)(i1 * 128u + i2);
            }
            int* ep = EIDX + trow * 128 + h * 16;
#pragma unroll
            for (int g = 0; g < 4; ++g) *(u32x4*)(ep + 4 * g) = (u32x4){(unsigned)e[4 * g], (unsigned)e[4 * g + 1], (unsigned)e[4 * g + 2], (unsigned)e[4 * g + 3]};
        } else {
            float* gp = EGATE + trow * 128 + h * 16;
#pragma unroll
            for (int g = 0; g < 4; ++g) *(f32x4*)(gp + 4 * g) = (f32x4){v[4 * g] * inv, v[4 * g + 1] * inv, v[4 * g + 2] * inv, v[4 * g + 3] * inv};
        }
        asm volatile("s_waitcnt lgkmcnt(0)" ::: "memory");
    }
}

DI float gelu_tanh(float x) {
    const float u = 0.7978845608028654f * (x + 0.044715f * x * x * x);
    const float e = __expf(2.f * u);
    const float th = 1.f - 2.f / (e + 1.f);
    return 0.5f * x * (1.f + th);
}

DI float bcast_f(float v, int j) { return __int_as_float(__builtin_amdgcn_readfirstlane(__float_as_int(__shfl(v, j)))); }
DI void quant_rows(const float* src, unsigned char* dst, float* scale, int nrows, int offs, int gw, int ngw, int lane) {
    for (int row = gw; row < nrows; row += ngw) {
        const f32x4* p = (const f32x4*)(src + (size_t)row * 1024 + lane * 16);
        f32x4 v[4]; float am = 0.f;
#pragma unroll
        for (int i = 0; i < 4; ++i) { v[i] = p[i];
#pragma unroll
            for (int e = 0; e < 4; ++e) am = fmaxf(am, fabsf(v[i][e])); }
#pragma unroll
        for (int o = 1; o < 64; o <<= 1) am = fmaxf(am, __shfl_xor(am, o));
        const float inv = am > 0.f ? 127.f / am : 0.f;
        u32x4 w;
#pragma unroll
        for (int i = 0; i < 4; ++i) {
            unsigned pk = 0u;
#pragma unroll
            for (int e = 0; e < 4; ++e) { const int q = (int)rintf(v[i][e] * inv) + offs; pk |= ((unsigned)q & 0xffu) << (8 * e); }
            w[i] = pk;
        }
        *(u32x4*)(dst + ((size_t)(lane >> 3) * nrows + row) * 128 + (lane & 7) * 16) = w;
        if (lane == 0) scale[row] = am > 0.f ? am * (1.f / 127.f) : 0.f;
    }
}
DI void quant_xw(const bf16* XW, unsigned char* XQ8, float* XS, int gw, int ngw, int lane) {
    for (int t = gw; t < T; t += ngw) {
        const u32x4 xa = *(const u32x4*)(XW + (size_t)t * 1024 + lane * 16), xb = *(const u32x4*)(XW + (size_t)t * 1024 + lane * 16 + 8);
        float xf[16] = {bflo(xa.x), bfhi(xa.x), bflo(xa.y), bfhi(xa.y), bflo(xa.z), bfhi(xa.z), bflo(xa.w), bfhi(xa.w),
                        bflo(xb.x), bfhi(xb.x), bflo(xb.y), bfhi(xb.y), bflo(xb.z), bfhi(xb.z), bflo(xb.w), bfhi(xb.w)};
        float am = 0.f;
#pragma unroll
        for (int i = 0; i < 16; ++i) am = fmaxf(am, fabsf(xf[i]));
#pragma unroll
        for (int o = 1; o < 64; o <<= 1) am = fmaxf(am, __shfl_xor(am, o));
        const float inv = am > 0.f ? 127.f / am : 0.f;
        u32x4 w;
#pragma unroll
        for (int i = 0; i < 4; ++i) { unsigned pk = 0u;
#pragma unroll
            for (int e = 0; e < 4; ++e) pk |= ((unsigned)((int)rintf(xf[4 * i + e] * inv)) & 0xffu) << (8 * e);
            w[i] = pk; }
        *(u32x4*)(XQ8 + ((size_t)(lane >> 3) * T + t) * 128 + (lane & 7) * 16) = w;
        if (lane == 0) XS[t] = am * (1.f / 127.f);
    }
}
DI int dpp_xor1(int v) { return __builtin_amdgcn_update_dpp(0, v, 0xB1, 0xF, 0xF, false); }
DI int dpp_xor2(int v) { return __builtin_amdgcn_update_dpp(0, v, 0x4E, 0xF, 0xF, false); }
DI int dpp_hmir(int v) { return __builtin_amdgcn_update_dpp(0, v, 0x141, 0xF, 0xF, false); }
DI void peer_u(const unsigned char* EU8, const unsigned char* XQ8, const int* EIDX, int* PART, int slice, int tok0, int tokstep, int lane) {
    const int q = lane >> 3, i = lane & 7;
    const unsigned char* tab = EU8 + (size_t)slice * PE_NE * 128 + i * 16;
#define PU_LOAD(dst, t_) do { const u32x4* ep_ = (const u32x4*)(EIDX + (size_t)(t_) * 128 + 16 * q); const u32x4 e0_ = ep_[0], e1_ = ep_[1], e2_ = ep_[2], e3_ = ep_[3]; \
        const unsigned ee_[16] = {e0_.x, e0_.y, e0_.z, e0_.w, e1_.x, e1_.y, e1_.z, e1_.w, e2_.x, e2_.y, e2_.z, e2_.w, e3_.x, e3_.y, e3_.z, e3_.w}; \
        _Pragma("unroll") for (int g = 0; g < 16; ++g) dst[g] = *(const u32x4*)(tab + (size_t)ee_[g] * 128); } while (0)
    u32x4 ub[16], nb[16];
    if (tok0 < T) PU_LOAD(ub, tok0);
    for (int t = tok0; t < T; t += tokstep) {
        const u32x4 xv = *(const u32x4*)(XQ8 + ((size_t)slice * T + t) * 128 + i * 16);
        if (t + tokstep < T) PU_LOAD(nb, t + tokstep);
        int d0 = 0, d1 = 0;
#pragma unroll
        for (int g = 0; g < 16; ++g) {
            int s = __builtin_amdgcn_sdot4((int)ub[g].x, (int)xv.x, 0, false);
            s = __builtin_amdgcn_sdot4((int)ub[g].y, (int)xv.y, s, false); s = __builtin_amdgcn_sdot4((int)ub[g].z, (int)xv.z, s, false); s = __builtin_amdgcn_sdot4((int)ub[g].w, (int)xv.w, s, false);
            s += dpp_xor1(s); s += dpp_xor2(s); s += dpp_hmir(s);
            if (g < 8) { if (i == g) d0 = s; } else { if (i == g - 8) d1 = s; }
        }
        int* pp = PART + ((size_t)slice * T + t) * 128 + 16 * q + i;
        pp[0] = d0; pp[8] = d1;
#pragma unroll
        for (int g = 0; g < 16; ++g) ub[g] = nb[g];
    }
#undef PU_LOAD
}
DI void peer_w(const int* PART, const int* EIDX, const float* EGATE, const float* SU, const float* SV, const float* XS, const float* SSQX, float* WT, size_t gtid, size_t gsz) {
    for (size_t idx = gtid; idx < (size_t)T * 128; idx += gsz) {
        const int t = (int)(idx >> 7);
        int dsum = 0;
#pragma unroll
        for (int s = 0; s < 8; ++s) dsum += PART[(size_t)s * T * 128 + idx];
        const int e = EIDX[idx];
        const float sc = XS[t] * rstd_x1(SSQX, (size_t)t);
        WT[idx] = EGATE[idx] * SV[e] * gelu_tanh((float)dsum * (SU[e] * sc));
    }
}
DI void peer_v(const unsigned char* EV8, const int* EIDX, const float* WT, float* X1, int slice, int tok0, int tokstep, int lane) {
    const int q = lane >> 3, i = lane & 7;
    const unsigned char* tab = EV8 + (size_t)slice * PE_NE * 128 + i * 16;
#define PV_LOAD(dst, t_) do { const u32x4* ep_ = (const u32x4*)(EIDX + (size_t)(t_) * 128 + 16 * q); const u32x4 e0_ = ep_[0], e1_ = ep_[1], e2_ = ep_[2], e3_ = ep_[3]; \
        const unsigned ee_[16] = {e0_.x, e0_.y, e0_.z, e0_.w, e1_.x, e1_.y, e1_.z, e1_.w, e2_.x, e2_.y, e2_.z, e2_.w, e3_.x, e3_.y, e3_.z, e3_.w}; \
        _Pragma("unroll") for (int g = 0; g < 16; ++g) dst[g] = *(const u32x4*)(tab + (size_t)ee_[g] * 128); } while (0)
    u32x4 vb[16], nb[16];
    if (tok0 < T) PV_LOAD(vb, tok0);
    for (int t = tok0; t < T; t += tokstep) {
        const f32x4* wp = (const f32x4*)(WT + (size_t)t * 128 + 16 * q);
        const f32x4 w0 = wp[0], w1 = wp[1], w2 = wp[2], w3 = wp[3];
        const float ww[16] = {w0[0], w0[1], w0[2], w0[3], w1[0], w1[1], w1[2], w1[3], w2[0], w2[1], w2[2], w2[3], w3[0], w3[1], w3[2], w3[3]};
        if (t + tokstep < T) PV_LOAD(nb, t + tokstep);
        float o[16]; float wsum = 0.f;
#pragma unroll
        for (int c = 0; c < 16; ++c) o[c] = 0.f;
#pragma unroll
        for (int g = 0; g < 16; ++g) {
            const float wq = ww[g];
            wsum += wq;
#pragma unroll
            for (int k = 0; k < 4; ++k) { const unsigned b = vb[g][k];
                o[4 * k] += wq * (float)(b & 0xffu); o[4 * k + 1] += wq * (float)((b >> 8) & 0xffu); o[4 * k + 2] += wq * (float)((b >> 16) & 0xffu); o[4 * k + 3] += wq * (float)(b >> 24); }
        }
        float r8[8], r4[4], r2[2];
#pragma unroll
        for (int c = 0; c < 8; ++c) { const float mine = (q & 4) ? o[c + 8] : o[c], theirs = (q & 4) ? o[c] : o[c + 8]; r8[c] = mine + __shfl_xor(theirs, 32); }
#pragma unroll
        for (int c = 0; c < 4; ++c) { const float mine = (q & 2) ? r8[c + 4] : r8[c], theirs = (q & 2) ? r8[c] : r8[c + 4]; r4[c] = mine + __shfl_xor(theirs, 16); }
#pragma unroll
        for (int c = 0; c < 2; ++c) { const float mine = (q & 1) ? r4[c + 2] : r4[c], theirs = (q & 1) ? r4[c] : r4[c + 2]; r2[c] = mine + __shfl_xor(theirs, 8); }
        wsum += __shfl_xor(wsum, 8); wsum += __shfl_xor(wsum, 16); wsum += __shfl_xor(wsum, 32);
        float* xp = X1 + (size_t)t * 1024 + slice * 128 + i * 16 + 2 * q;
        f32x2 xv = *(const f32x2*)xp;
        xv[0] += r2[0] - 128.f * wsum; xv[1] += r2[1] - 128.f * wsum;
        *(f32x2*)xp = xv;
#pragma unroll
        for (int g = 0; g < 16; ++g) vb[g] = nb[g];
    }
#undef PV_LOAD
}
DI void final_norm(const float* Y, const float* fw, float* OUT, int gw, int ngw, int lane) {
    for (int t = gw; t < T; t += ngw) {
        const f32x4* yr = (const f32x4*)(Y + (size_t)t * 1024) + lane; const f32x4* wr4 = (const f32x4*)fw + lane;
        f32x4 v[4]; float s = 0.f;
#pragma unroll
        for (int j = 0; j < 4; ++j) { v[j] = yr[64 * j]; s += (v[j][0] * v[j][0] + v[j][1] * v[j][1]) + (v[j][2] * v[j][2] + v[j][3] * v[j][3]); }
        const float rs = rsqrtf(wave_sum(s) * (1.f / 1024.f) + EPS);
        f32x4* o = (f32x4*)(OUT + (size_t)t * 1024) + lane;
#pragma unroll
        for (int j = 0; j < 4; ++j) { const f32x4 ww = wr4[64 * j]; o[64 * j] = (f32x4){v[j][0] * rs * ww[0], v[j][1] * rs * ww[1], v[j][2] * rs * ww[2], v[j][3] * rs * ww[3]}; }
    }
}

DI void transpose_item(const float* W, int K, int N, bf16* WT, int n_src0, int n_dst0, int k0, LAS float* scr, int lane) {
#pragma unroll 8
    for (int i = 0; i < 32; ++i) { const int kk = 2 * i + (lane >> 5); scr[kk * 33 + (lane & 31)] = W[(size_t)(k0 + kk) * N + n_src0 + (lane & 31)]; }
    asm volatile("s_waitcnt lgkmcnt(0)" ::: "memory");
    const int c = lane & 7;
#pragma unroll
    for (int j = 0; j < 4; ++j) { const int n = (lane >> 3) + 8 * j; const LAS float* s = scr + (8 * c) * 33 + n;
        u32x4 o; o.x = pk2(s[0 * 33], s[1 * 33]); o.y = pk2(s[2 * 33], s[3 * 33]); o.z = pk2(s[4 * 33], s[5 * 33]); o.w = pk2(s[6 * 33], s[7 * 33]);
        *(u32x4*)(WT + (size_t)(n_dst0 + n) * K + k0 + 8 * c) = o; }
    asm volatile("s_waitcnt lgkmcnt(0)" ::: "memory");
}
DI int win_orig_col(int np) {
    if (np < 2048) { const int h = np >> 8, sel = (np >> 7) & 1, d = np & 127; return sel * 1024 + h * 128 + d; }
    if (np < 3072) return np;
    if (np < 7168) return np + 1024;
    if (np < 8192) return np - 4096;
    return np;
}
DI void rmsnorm_row_bf16(const float* xrow, const float* w, bf16* orow, int lane) {
    const f32x4* xr = (const f32x4*)xrow + lane; const f32x4* wr4 = (const f32x4*)w + lane;
    f32x4 v[4]; float s = 0.f;
#pragma unroll
    for (int j = 0; j < 4; ++j) { v[j] = xr[64 * j]; s += (v[j][0] * v[j][0] + v[j][1] * v[j][1]) + (v[j][2] * v[j][2] + v[j][3] * v[j][3]); }
    const float rs = rsqrtf(wave_sum(s) * (1.f / 1024.f) + EPS);
    u32x2* o8 = (u32x2*)orow + lane;
#pragma unroll
    for (int j = 0; j < 4; ++j) { const f32x4 ww = wr4[64 * j]; u32x2 o; o.x = pk2(v[j][0] * rs * ww[0], v[j][1] * rs * ww[1]); o.y = pk2(v[j][2] * rs * ww[2], v[j][3] * rs * ww[3]); o8[64 * j] = o; }
}
DI void convert_bf16(const float* src, bf16* dst, size_t n, size_t gtid, size_t gsz) {
    for (size_t i = gtid * 8; i < n; i += gsz * 8) {
        const f32x4 a = *(const f32x4*)(src + i), b = *(const f32x4*)(src + i + 4);
        *(u32x4*)(dst + i) = pack8(a, b);
    }
}

#define XB_TMO      128
#define XB_XCNT(j)  (256  + 64 * (j))
#define XB_XSUB(j)  (1280 + 64 * (j))
#define XB_XGEN(j)  (2304 + 64 * (j))
#define XB_TOP      3328
#define XB_TOPGEN   3392
#define XCD_BAR_WORDS 3456
#define XB_SPIN_CAP (1u << 18)

__device__ __forceinline__ unsigned xb_ld(unsigned* p)              { return __hip_atomic_load(p, __ATOMIC_RELAXED, __HIP_MEMORY_SCOPE_AGENT); }
__device__ __forceinline__ unsigned xb_add(unsigned* p, unsigned v) { return __hip_atomic_fetch_add(p, v, __ATOMIC_RELAXED, __HIP_MEMORY_SCOPE_AGENT); }
__device__ __forceinline__ unsigned xb_xcc_id() { return (unsigned)__builtin_amdgcn_s_getreg((3 << 11) | 20) & 0xFu; }
#define XB_SPIN(cond, bar) do { unsigned _sp = 0; while (cond) { __builtin_amdgcn_s_sleep(1); \
    if ((++_sp & 255u) == 0u) { if (xb_ld(&(bar)[XB_TMO])) break; if (_sp > XB_SPIN_CAP) { atomicAdd(&(bar)[XB_TMO], 1u); break; } } } } while (0)

struct XcdBarrier {
    unsigned* bar; unsigned x;
    volatile LAS unsigned* st;
};

__device__ __forceinline__ XcdBarrier xcd_barrier_post(unsigned* bar, volatile LAS unsigned* st) {
    XcdBarrier b; b.bar = bar; b.x = xb_xcc_id(); b.st = st;
    if (threadIdx.x == 0) (void)xb_add(&bar[XB_XCNT(b.x)], 1u);
    return b;
}
__device__ __forceinline__ void xcd_barrier_complete(unsigned* bar, unsigned x, unsigned& nloc, unsigned& nx) {
    const unsigned G = gridDim.x * gridDim.y * gridDim.z;
    unsigned sum, cnt, mine, sp = 0u;
    for (;;) {
        sum = 0u; cnt = 0u; mine = 0u;
#pragma unroll
        for (unsigned j = 0; j < 16; ++j) { const unsigned c = xb_ld(&bar[XB_XCNT(j)]); sum += c; cnt += (c > 0u) ? 1u : 0u; mine = (j == x) ? c : mine; }
        if (sum == G) break;
        __builtin_amdgcn_s_sleep(1);
        if ((++sp & 255u) == 0u) { if (xb_ld(&bar[XB_TMO])) break; if (sp > XB_SPIN_CAP) { atomicAdd(&bar[XB_TMO], 1u); break; } }
    }
    nloc = mine > 0u ? mine : 1u; nx = cnt > 0u ? cnt : 1u;
}

__device__ __forceinline__ void xcd_barrier(const XcdBarrier& b) {
    asm volatile("s_waitcnt vmcnt(0)" ::: "memory");
    __syncthreads();
    if (threadIdx.x == 0) {
        unsigned* bar = b.bar;
        __builtin_amdgcn_s_waitcnt(0);
        unsigned nloc = b.st[0], nx = b.st[1];
        if (nloc == 0u) { xcd_barrier_complete(bar, b.x, nloc, nx); b.st[0] = nloc; b.st[1] = nx; }
        const unsigned old = xb_add(&bar[XB_XSUB(b.x)], 1u);
        const unsigned gen = old / nloc;
        if (old + 1u == (gen + 1u) * nloc) {
            __builtin_amdgcn_fence(__ATOMIC_RELEASE, "agent");
            asm volatile("s_waitcnt vmcnt(0)" ::: "memory");
            const unsigned og = xb_add(&bar[XB_TOP], 1u);
            const unsigned tg = og / nx;
            if (og + 1u == (tg + 1u) * nx) xb_add(&bar[XB_TOPGEN], 1u);
            else XB_SPIN(xb_ld(&bar[XB_TOPGEN]) == tg, bar);
            __builtin_amdgcn_fence(__ATOMIC_ACQUIRE, "agent");
            xb_add(&bar[XB_XGEN(b.x)], 1u);
            asm volatile("s_waitcnt vmcnt(0)" ::: "memory");
        } else {
            XB_SPIN(xb_ld(&bar[XB_XGEN(b.x)]) == gen, bar);
            __builtin_amdgcn_fence(__ATOMIC_ACQUIRE, "agent");
            asm volatile("s_waitcnt vmcnt(0)" ::: "memory");
        }
    }
    __syncthreads();
}

struct Params { const float* in[14]; float* out; unsigned char* ws; };

__global__ void __launch_bounds__(NTHREADS, 2) fwd_megakernel(Params p) {
    extern __shared__ __attribute__((aligned(16))) unsigned char lds_raw[];
    LAS unsigned char* lds = (LAS unsigned char*)lds_raw;
    cg::grid_group grid = cg::this_grid();
    volatile LAS unsigned* bst = (volatile LAS unsigned*)(lds + LDS_BYTES - 64);
    if (threadIdx.x < 4) bst[threadIdx.x] = 0u;
    __syncthreads();
    XcdBarrier xbar = xcd_barrier_post((unsigned*)(p.ws + WS_CTL), bst);
    if (threadIdx.x == 0) bst[4] = xb_add((unsigned*)(p.ws + WS_CTL) + 3600 + xbar.x, 1u);
#if USE_CG_SYNC
#define GRID_SYNC() grid.sync()
#else
#define GRID_SYNC() xcd_barrier(xbar)
#endif
    const int G = gridDim.x, wg = blockIdx.x;
#define PHASE_IDS const int tid = fresh_tid(), lane = tid & 63, wave = __builtin_amdgcn_readfirstlane(tid >> 6); \
    const int gw = wg * NWAVES + wave, ngw = G * NWAVES; const size_t gtid = (size_t)wg * NTHREADS + tid, gsz = (size_t)G * NTHREADS; \
    (void)lane; (void)gw; (void)ngw; (void)gtid; (void)gsz;
    unsigned char* ws = p.ws;
    const float* x = p.in[0];
    bf16* HN = (bf16*)(ws + WS_HN); bf16* WinT = (bf16*)(ws + WS_WINT);
    float* COS = (float*)(ws + WS_ROPE); float* SIN = COS + 8192 * 128;
    float* DEC = (float*)(ws + WS_DEC); float* SSQP = (float*)(ws + WS_SSQP); float* SSQX = (float*)(ws + WS_SSQX);
    bf16* BA = (bf16*)(ws + WS_A); bf16* BB = (bf16*)(ws + WS_B); bf16* BC = (bf16*)(ws + WS_C);
    bf16* STh = (bf16*)(ws + WS_STH); bf16* STr = (bf16*)(ws + WS_STR);
    bf16* OHG = (bf16*)(ws + WS_OHG); bf16* ORET = (bf16*)p.out;
    bf16* GA = (bf16*)(ws + WS_GA); bf16* GB = (bf16*)(ws + WS_GB);
    bf16* WhgT = (bf16*)(ws + WS_WHG); bf16* WretT = (bf16*)(ws + WS_WRET); bf16* WoutT = (bf16*)(ws + WS_WOUT); bf16* WqT = (bf16*)(ws + WS_WQ); bf16* SK = (bf16*)(ws + WS_SK);
    unsigned char* EV8 = ws + WS_EV; unsigned char* EU8 = ws + WS_EU; float* SU = (float*)(ws + WS_SCL); float* SV = SU + PE_NE;
    float* M1 = (float*)(ws + WS_M1); bf16* MERGED = (bf16*)(ws + WS_MERGED);
    float* X1 = (float*)(ws + WS_X1); bf16* XW = (bf16*)(ws + WS_XW); bf16* Qp = (bf16*)p.out;
    unsigned char* XQ8 = ws + WS_XQ8; float* XS = (float*)(ws + WS_XS); int* PART = (int*)(ws + WS_PART); float* WT = (float*)(ws + WS_WT);
    float* TOPS = (float*)(ws + WS_TOPS); int* TOPI = (int*)(ws + WS_TOPI); int* EIDX = (int*)(ws + WS_EIDX); float* EGATE = (float*)(ws + WS_EGATE);

    for (int rep_ = 0; rep_ < ((PROBE_MASK & 32) ? 2 : 1); ++rep_) {
    { PHASE_IDS LAS float* scr = (LAS float*)(lds + wave * 16384);
    for (int it = gw; it < 16 * 384; it += ngw) {
        const int kb = it / 384, nb = it % 384;
        transpose_item(p.in[2], 1024, 12288, WinT, win_orig_col(nb * 32), nb * 32, kb * 64, scr, lane);
    }
    for (int m = gw; m < T; m += ngw) rmsnorm_row_bf16(x + (size_t)m * 1024, p.in[1], HN + (size_t)m * 1024, lane);
    for (size_t i = gtid; i < (size_t)8192 * 128; i += gsz) {
        const int pos = (int)(i >> 7), j = (int)(i & 127);
        const float inv = (float)exp(-(double)j * (9.210340371976184 / 128.0));
        const float ang = (float)pos * inv;
        double rev = (double)ang * 0.15915494309189535; rev -= rint(rev);
        COS[i] = __builtin_amdgcn_cosf((float)rev); SIN[i] = __builtin_amdgcn_sinf((float)rev);
    } }
    __syncthreads(); }
    grid.sync();

    for (int rep_ = 0; rep_ < ((PROBE_MASK & 128) ? 2 : 1); ++rep_) {
    {
        pg8::Gemm g{HN, WinT, T, 3072, 1024}; pg8::StaticOrder S; S.init(T, 3072, G, wg);
        EpiH E{BA, BB, BC, DEC, p.in[3]};
        pg8::gemm_phase<EpiH, pg8::StaticOrder, true, true>(lds, g, S, E);
    }
    __syncthreads(); }
    GRID_SYNC();
    hg_pass1(lds, BB, BC, STh, wg, G);
#if PROBE_MASK & 4
    hg_pass1(lds, BB, BC, STh, wg, G);
#endif
    GRID_SYNC();
    { PHASE_IDS hg_scan(STh, DEC, (int)gtid, (int)gsz); }
    GRID_SYNC();
#if PROBE_MASK & 16384
    hg_pass1(lds, BB, BC, STh, wg, G);
    GRID_SYNC();
    { PHASE_IDS hg_scan(STh, DEC, (int)gtid, (int)gsz); }
    GRID_SYNC();
#endif
    { PHASE_IDS hg_pass3(BA, BB, BC, STh, p.in[4], OHG, gw, ngw); }
#if PROBE_MASK & 4
    { PHASE_IDS hg_pass3(BA, BB, BC, STh, p.in[4], OHG, gw, ngw); }
#endif
    GRID_SYNC();

    for (int rep_ = 0; rep_ < ((PROBE_MASK & 2048) ? 2 : 1); ++rep_) {
    {
        pg8::Gemm g{HN, WinT + (size_t)3072 * 1024, T, 4096, 1024}; pg8::StaticOrder S; S.init(T, 4096, G, wg);
        EpiR E{BA, BB, BC, COS, SIN};
        pg8::gemm_phase<EpiR, pg8::StaticOrder, true, true>(lds, g, S, E);
    }
    __syncthreads(); }
    GRID_SYNC();
    rt_pass1(lds, BB, BC, STr, wg, G);
#if PROBE_MASK & 8
    rt_pass1(lds, BB, BC, STr, wg, G);
#endif
    GRID_SYNC();
    { PHASE_IDS rt_scan(STr, (int)gtid, (int)gsz); }
    GRID_SYNC();
#if PROBE_MASK & 32768
    rt_pass1(lds, BB, BC, STr, wg, G);
    GRID_SYNC();
    { PHASE_IDS rt_scan(STr, (int)gtid, (int)gsz); }
    GRID_SYNC();
#endif
    rt_pass3_wg(lds, BA, BB, BC, STr, ORET, SSQP, wg, G);
#if PROBE_MASK & 1024
    rt_pass3_wg(lds, BA, BB, BC, STr, ORET, SSQP, wg, G);
#endif
    GRID_SYNC();

    for (int rep_ = 0; rep_ < ((PROBE_MASK & 64) ? 2 : 1); ++rep_) {
    { PHASE_IDS LAS float* scr = (LAS float*)(lds + wave * 16384);
    for (int it = gw; it < 3072; it += ngw) {
        int r = it;
        if (r < 512) { transpose_item(p.in[5], 1024, 1024, WhgT, (r % 32) * 32, (r % 32) * 32, (r / 32) * 64, scr, lane); continue; } r -= 512;
        if (r < 1024) { transpose_item(p.in[6], 2048, 1024, WretT, (r % 32) * 32, (r % 32) * 32, (r / 32) * 64, scr, lane); continue; } r -= 1024;
        if (r < 512) { transpose_item(p.in[7], 1024, 1024, WoutT, (r % 32) * 32, (r % 32) * 32, (r / 32) * 64, scr, lane); continue; } r -= 512;
        transpose_item(p.in[9], 1024, 2048, WqT, (r % 64) * 32, (r % 64) * 32, (r / 64) * 64, scr, lane);
    }
    convert_bf16(p.in[10], SK, (size_t)16 * 128 * 128, gtid, gsz);
    quant_rows(p.in[12], EV8, SV, PE_NE, 128, gw, ngw, lane); }
    __syncthreads(); }
    __syncthreads();
    {
        pg8::Gemm g{HN, WinT + (size_t)7168 * 1024, T, 5120, 1024}; pg8::StaticOrder S; S.init(T, 5120, G, wg);
#if PROBE_MASK & 65536
        { EpiG E0{OHG, ORET, GA, GB, SSQP, 1}; pg8::gemm_phase<EpiG, pg8::StaticOrder, true, true>(lds, g, S, E0); __syncthreads(); }
#endif
        EpiG E{OHG, ORET, GA, GB, SSQP, 0};
        pg8::gemm_phase<EpiG, pg8::StaticOrder, true, true>(lds, g, S, E);
    }
    GRID_SYNC();

    for (int rep_ = 0; rep_ < ((PROBE_MASK & 256) ? 2 : 1); ++rep_) {
    {
        pg8::Gemm g{OHG, WhgT, T, 1024, 1024}; pg8::StaticOrder S; S.init(T, 1024, G, wg);
        EpiM1 E{M1, GA};
        pg8::gemm_phase<EpiM1, pg8::StaticOrder, false, true>(lds, g, S, E);
    }
    __syncthreads();
    {
        pg8::Gemm g{ORET, WretT, T, 1024, 2048}; pg8::StaticOrder S; S.init(T, 1024, G, wg);
        EpiMerge E{M1, GB, MERGED};
        pg8::gemm_phase<EpiMerge, pg8::StaticOrder, false, true>(lds, g, S, E);
    }
    __syncthreads(); }
    GRID_SYNC();
    for (int rep_ = 0; rep_ < ((PROBE_MASK & 4096) ? 2 : 1); ++rep_) {
    {
        pg8::Gemm g{MERGED, WoutT, T, 1024, 1024}; pg8::StaticOrder S; S.init(T, 1024, G, wg);
        EpiOut E{x, X1, XW, p.in[8], SSQX};
        pg8::gemm_phase<EpiOut, pg8::StaticOrder, false, true>(lds, g, S, E);
    }
    __syncthreads(); }
    GRID_SYNC();
    for (int rep_ = 0; rep_ < ((PROBE_MASK & 64) ? 2 : 1); ++rep_) {
    { PHASE_IDS quant_rows(p.in[11], EU8, SU, PE_NE, 0, gw, ngw, lane); }
    __syncthreads(); }
    __syncthreads();
    for (int rep_ = 0; rep_ < ((PROBE_MASK & 8192) ? 2 : 1); ++rep_) {
    {
        pg8::Gemm g{XW, WqT, T, 2048, 1024}; pg8::StaticOrder S; S.init(T, 2048, G, wg);
        EpiQ E{Qp, SSQX};
        pg8::gemm_phase<EpiQ, pg8::StaticOrder, true, true>(lds, g, S, E);
    }
    __syncthreads(); }
    GRID_SYNC();
    { PHASE_IDS peer_retrieve(lds, Qp, SK, EIDX, EGATE, gw, ngw); quant_xw(XW, XQ8, XS, gw, ngw, lane); }
#if PROBE_MASK & 2
    { PHASE_IDS peer_retrieve(lds, Qp, SK, EIDX, EGATE, gw, ngw); quant_xw(XW, XQ8, XS, gw, ngw, lane); }
#endif
    GRID_SYNC();
    if (threadIdx.x == 0) {
        unsigned k = 0, n = 0, mine = 1;
        for (unsigned j = 0; j < 16; ++j) { const unsigned c = xb_ld((unsigned*)(p.ws + WS_CTL) + XB_XCNT(j)); if (c) { if (j < xbar.x) ++k; ++n; } if (j == xbar.x) mine = c ? c : 1; }
        bst[5] = k; bst[6] = n ? n : 1; bst[7] = mine;
    }
    __syncthreads();
    const int xrank = (int)bst[4], xk = (int)bst[5], xn = (int)bst[6], xloc = (int)bst[7];
    for (int rep_ = 0; rep_ < ((PROBE_MASK & 1) ? 2 : 1); ++rep_) {
    { PHASE_IDS for (int s = xk; s < 8; s += xn) peer_u(EU8, XQ8, EIDX, PART, s, xrank * NWAVES + wave, xloc * NWAVES, lane); }
    GRID_SYNC(); }
    { PHASE_IDS peer_w(PART, EIDX, EGATE, SU, SV, XS, SSQX, WT, gtid, gsz); }
    GRID_SYNC();
    { PHASE_IDS for (int s = xk; s < 8; s += xn) peer_v(EV8, EIDX, WT, X1, s, xrank * NWAVES + wave, xloc * NWAVES, lane); }
    GRID_SYNC();
    { PHASE_IDS final_norm(X1, p.in[13], p.out, gw, ngw, lane); }
#if PROBE_MASK & 16
    for (int i = 0; i < 15; ++i) GRID_SYNC();
#endif
}

extern "C" void kernel_launch(void* const* d_in, const int* in_sizes, int n_in, void* d_out, int out_size, void* d_ws, size_t ws_size, hipStream_t stream) {
    static int grid_blocks = 0;
    if (!grid_blocks) {
        int dev = 0, cus = 0, per_cu = 0;
        (void)hipGetDevice(&dev);
        (void)hipDeviceGetAttribute(&cus, hipDeviceAttributeMultiprocessorCount, dev);
        (void)hipFuncSetAttribute((const void*)fwd_megakernel, hipFuncAttributeMaxDynamicSharedMemorySize, LDS_BYTES);
        (void)hipOccupancyMaxActiveBlocksPerMultiprocessor(&per_cu, (const void*)fwd_megakernel, NTHREADS, LDS_BYTES);
        if (per_cu < 1) per_cu = 1;
        grid_blocks = cus * 1;
        if (ws_size < WS_END || n_in != 14) { fprintf(stderr, "kernel_launch: unexpected ws_size %zu (need %zu) or n_in %d\n", ws_size, (size_t)WS_END, n_in); }
    }
    (void)hipMemsetAsync((char*)d_ws + WS_CTL, 0, 16384, stream);
    Params p{};
    for (int i = 0; i < 14; ++i) p.in[i] = (const float*)d_in[i];
    p.out = (float*)d_out; p.ws = (unsigned char*)d_ws;
    void* args[] = {&p};
    hipError_t e = hipLaunchCooperativeKernel((const void*)fwd_megakernel, dim3(grid_blocks), dim3(NTHREADS), args, LDS_BYTES, stream);
    if (e != hipSuccess) fprintf(stderr, "cooperative launch failed: %s (grid %d)\n", hipGetErrorString(e), grid_blocks);
}
```

```cpp
#include <hip/hip_runtime.h>
#include <hip/hip_cooperative_groups.h>
#include <cstdio>
#include <cstdint>
namespace cg = cooperative_groups;
#ifndef USE_CG_SYNC
#define USE_CG_SYNC 0
#endif
#ifndef PROBE_MASK
#define PROBE_MASK 0
#endif

#define DI __device__ __forceinline__
#define LAS __attribute__((address_space(3)))
typedef unsigned short bf16;
typedef float f32x4 __attribute__((ext_vector_type(4)));
typedef float f32x2 __attribute__((ext_vector_type(2)));
typedef float f32x16 __attribute__((ext_vector_type(16)));
typedef short bf16x8 __attribute__((ext_vector_type(8)));
typedef short s16x4 __attribute__((ext_vector_type(4)));
typedef unsigned u32x4 __attribute__((ext_vector_type(4)));
typedef unsigned u32x2 __attribute__((ext_vector_type(2)));
typedef __bf16 nbf16x2 __attribute__((ext_vector_type(2)));

constexpr int D = 1024, NB = 2, SEQ = 8192, T = NB * SEQ;
constexpr int HG_H = 8, HG_DK = 128, HG_DV = 128, HG_C = 64, HG_NC = SEQ / HG_C;
constexpr int RT_H = 4, RT_DK = 256, RT_DV = 512, RT_L = 512, RT_NS = SEQ / RT_L;
constexpr int PE_H = 8, PE_NK = 128, PE_K = 16, PE_Q = 256, PE_HALF = 128, PE_NE = PE_NK * PE_NK;
constexpr float EPS = 1e-6f;
constexpr int NTHREADS = 512, NWAVES = 8;
constexpr int LDS_BYTES = 147456;

constexpr size_t MiB = 1u << 20;
constexpr size_t WS_CTL = 0;
constexpr size_t WS_DEC = 1 * MiB;
constexpr size_t WS_SSQP = 2 * MiB;
constexpr size_t WS_SCL = 2 * MiB + 512 * 1024;
constexpr size_t WS_SSQX = 3 * MiB;
constexpr size_t WS_HN = 4 * MiB;
constexpr size_t WS_WINT = 36 * MiB;
constexpr size_t WS_ROPE = 60 * MiB;
constexpr size_t WS_A = 68 * MiB, WS_B = 100 * MiB, WS_C = 132 * MiB;
constexpr size_t WS_STH = 164 * MiB;
constexpr size_t WS_STR = 196 * MiB;
constexpr size_t WS_OHG = 228 * MiB;
constexpr size_t WS_GA = 68 * MiB, WS_GB = 100 * MiB;
constexpr size_t WS_W2 = 132 * MiB;
constexpr size_t WS_WHG = WS_W2, WS_WRET = WS_W2 + 2 * MiB, WS_WOUT = WS_W2 + 6 * MiB, WS_WQ = WS_W2 + 8 * MiB, WS_SK = WS_W2 + 12 * MiB;
constexpr size_t WS_EV = 145 * MiB;
constexpr size_t WS_MERGED = 177 * MiB;
constexpr size_t WS_EU = 209 * MiB;
constexpr size_t WS_M1 = 4 * MiB;
constexpr size_t WS_X1 = 4 * MiB;
constexpr size_t WS_XW = 68 * MiB;
constexpr size_t WS_TOPS = 100 * MiB, WS_TOPI = 116 * MiB;
constexpr size_t WS_EIDX = 177 * MiB, WS_EGATE = 185 * MiB;
constexpr size_t WS_SA = WS_SCL + 192 * 1024;
constexpr size_t WS_SB = WS_SCL + 256 * 1024;
constexpr size_t CTL_AMAX = 65536;
constexpr size_t CTL_BYTES = 131072;
constexpr size_t WS_XQ8 = 161 * MiB;
constexpr size_t WS_XS = WS_SCL + 128 * 1024;
constexpr size_t WS_PART = 68 * MiB;
constexpr size_t WS_WT = 193 * MiB;
constexpr size_t WS_END = 260 * MiB;

DI int fresh_tid() { int t = threadIdx.x; asm volatile("" : "+v"(t)); return t; }
DI float sigmoidf_(float x) { return 1.f / (1.f + __expf(-x)); }
DI float siluf_(float x) { return x / (1.f + __expf(-x)); }
DI unsigned pk2(float lo, float hi) { f32x2 v = {lo, hi}; nbf16x2 b = __builtin_convertvector(v, nbf16x2); return __builtin_bit_cast(unsigned, b); }
DI bf16 f2bf(float f) { return (bf16)(pk2(f, 0.f) & 0xffffu); }
DI float bf2f(bf16 b) { return __uint_as_float(((unsigned)b) << 16); }
DI float bflo(unsigned u) { return __uint_as_float(u << 16); }
DI float bfhi(unsigned u) { return __uint_as_float(u & 0xffff0000u); }
DI float wave_sum(float v) {
#pragma unroll
    for (int o = 1; o < 64; o <<= 1) v += __shfl_xor(v, o);
    return v;
}
DI int crow(int reg, int h) { return (reg & 3) + 8 * (reg >> 2) + 4 * h; }

namespace pg8 {
#define PG8_LAS __attribute__((address_space(3)))
typedef unsigned short bf16_t;
typedef short bf16x8 __attribute__((ext_vector_type(8)));
typedef float f32x4 __attribute__((ext_vector_type(4)));
typedef unsigned u32x4 __attribute__((ext_vector_type(4)));
constexpr int BM = 256, BK = 64, HALF = 128, HTB = HALF * BK * 2  , STAGE_BYTES = 8 * HTB, NXCD = 8, WGM = 8;

__host__ __device__ __forceinline__ int lds_byte(int r, int c) { const int st = (r >> 4) * 2 + (c >> 5), rr = r & 15, cc = c & 31, ob = rr * 64 + cc * 2; return st * 1024 + (ob ^ (((ob >> 9) & 1) << 5)); }
__host__ __device__ __forceinline__ void stage_rc(int b, int& R, int& C) { const int st = b / 1024, sb = b % 1024, swz = sb ^ (((sb >> 9) & 1) << 5); R = (st >> 1) * 16 + swz / 64; C = (st & 1) * 32 + (swz % 64) / 2; }
__host__ __device__ __forceinline__ int perm32(int rho) { const int n = rho >> 4, i = rho & 15; return 8 * (i >> 2) + 4 * n + (i & 3); }

struct Unit { int pm, pn; };
struct Gemm { const bf16_t* A; const bf16_t* Bt; int M, N, K; };

struct StaticOrder {
    int nM, nN, nwg, G, c;
    __host__ __device__ void init(int M, int N, int G_, int c_) { nM = M / BM; nN = N / BM; nwg = nM * nN; G = G_; c = c_; }
    __host__ __device__ bool next(int i, Unit& u) const {
        const long L = (long)i * G + c; if (L >= nwg) return false;
        int wgid = (int)L; { const int q = nwg / NXCD, r = nwg % NXCD, xcd = wgid % NXCD, off = wgid / NXCD; wgid = (xcd < r ? xcd * (q + 1) : r * (q + 1) + (xcd - r) * q) + off; }
        const int nig = WGM * nN, gid = wgid / nig, fm = gid * WGM, gsz = (nM - fm) < WGM ? (nM - fm) : WGM;
        u.pm = fm + ((wgid % nig) % gsz); u.pn = (wgid % nig) / gsz; return true;
    }
    __device__ __forceinline__ void a_ready(const Unit&) const {}
    __device__ __forceinline__ void done(const Unit&) const {}
};

__device__ __forceinline__ unsigned cvt_pk_bf16(float lo, float hi) { unsigned r; asm volatile("v_cvt_pk_bf16_f32 %0, %1, %2" : "=v"(r) : "v"(lo), "v"(hi)); return r; }
typedef float f32x2 __attribute__((ext_vector_type(2)));
typedef int i32x4 __attribute__((ext_vector_type(4)));
template <bool I8> __device__ __forceinline__ f32x4 mma16(const bf16x8& b, const bf16x8& a, const f32x4& c) {
    if constexpr (I8) return __builtin_bit_cast(f32x4, __builtin_amdgcn_mfma_i32_16x16x64_i8(__builtin_bit_cast(i32x4, b), __builtin_bit_cast(i32x4, a), __builtin_bit_cast(i32x4, c), 0, 0, 0));
    else return __builtin_amdgcn_mfma_f32_16x16x32_bf16(b, a, c, 0, 0, 0);
}
template <class Epi, class Sched, bool ALIGN_EPI = false, bool SP2 = false, bool I8 = false>
__device__ __forceinline__ void gemm_phase(PG8_LAS unsigned char* lds, const Gemm g, const Sched& S, const Epi& E) {
    const int tid = fresh_tid(), wid = __builtin_amdgcn_readfirstlane(tid >> 6), lane = tid & 63, wr = wid >> 2, wc = wid & 3, fr = lane & 15, fq = lane >> 4;
    const int K = g.K, nt = K / BK;
    unsigned voffA[2], voffB[2];
#pragma unroll
    for (int i = 0; i < 2; ++i) { int R, C; stage_rc(tid * 16 + i * 8192, R, C); const int Rb = Epi::PERM ? ((R & ~31) + perm32(R & 31)) : R;
        voffA[i] = (unsigned)(R * K + C) * 2u; voffB[i] = (unsigned)(Rb * K + C) * 2u; }
    const size_t kstep = (size_t)(BK * 2);
    const size_t hstep = (size_t)HALF * K * 2;
    const size_t tstep = 2 * hstep;
    const unsigned ldsw = (unsigned)wid * 1024u;
    const int aoff = lds_byte(wr * 64 + fr, fq * 8), boff = lds_byte(wc * 32 + fr, fq * 8);
#define PG8_SA(b, h) (((b) * 2 + (h)) * HTB)
#define PG8_SB(b, h) ((4 + (b) * 2 + (h)) * HTB)
#define PG8_STAGE(bufoff, gbase, voff) do { _Pragma("unroll") for (int _i = 0; _i < 2; ++_i) \
        __builtin_amdgcn_global_load_lds((const unsigned*)((const char*)(gbase) + (voff)[_i]), (PG8_LAS unsigned*)(lds + (bufoff) + ldsw + _i * 8192), 16, 0, 0); } while (0)
#define PG8_LDA(dst, b, h) do { _Pragma("unroll") for (int m = 0; m < 4; ++m) _Pragma("unroll") for (int k = 0; k < 2; ++k) dst[m][k] = *(const PG8_LAS bf16x8*)(lds + PG8_SA(b, h) + aoff + m * 2048 + k * 1024); } while (0)
#define PG8_LDB(dst, b, h) do { _Pragma("unroll") for (int n = 0; n < 2; ++n) _Pragma("unroll") for (int k = 0; k < 2; ++k) dst[n][k] = *(const PG8_LAS bf16x8*)(lds + PG8_SB(b, h) + boff + n * 2048 + k * 1024); } while (0)
#define PG8_MMA(ai, bj, At, Bt) do { __builtin_amdgcn_s_setprio(1); _Pragma("unroll") for (int m = 0; m < 4; ++m) _Pragma("unroll") for (int n = 0; n < 2; ++n) _Pragma("unroll") for (int k = 0; k < 2; ++k) \
        acc[ai][bj][m][n] = mma16<I8>(Bt[n][k], At[m][k], acc[ai][bj][m][n]); __builtin_amdgcn_s_setprio(0); } while (0)
#define PG8_WAIT_V(n) asm volatile("s_waitcnt vmcnt(" #n ")" ::: "memory")
#define PG8_WAIT_L(n) asm volatile("s_waitcnt lgkmcnt(" #n ")" ::: "memory")
#define PG8_BAR __builtin_amdgcn_s_barrier()
#define PG8_SCHED __builtin_amdgcn_sched_barrier(0)
    Unit cur, nxt; int ui = 0;
    if (!S.next(0, cur)) return;
    f32x4 acc[2][2][4][2];
#pragma unroll
    for (int a = 0; a < 2; ++a)
#pragma unroll
        for (int b = 0; b < 2; ++b)
#pragma unroll
            for (int m = 0; m < 4; ++m)
#pragma unroll
                for (int n = 0; n < 2; ++n) acc[a][b][m][n] = (f32x4){0.f, 0.f, 0.f, 0.f};
    bf16x8 At[4][2], B0[2][2], B1[2][2];
    const char* cA = (const char*)g.A + (size_t)cur.pm * tstep; const char* cB = (const char*)g.Bt + (size_t)cur.pn * tstep;
    S.a_ready(cur);
    if constexpr (SP2) {
        PG8_STAGE(PG8_SB(0, 0), cB, voffB); PG8_STAGE(PG8_SB(0, 1), cB + hstep, voffB); PG8_STAGE(PG8_SA(0, 0), cA, voffA); PG8_STAGE(PG8_SA(0, 1), cA + hstep, voffA);
        if (wr == 1) PG8_BAR;
        PG8_WAIT_V(2); PG8_BAR;
        PG8_STAGE(PG8_SB(1, 0), cB + kstep, voffB); PG8_STAGE(PG8_SA(1, 0), cA + kstep, voffA); PG8_STAGE(PG8_SB(1, 1), cB + hstep + kstep, voffB);
        PG8_WAIT_V(6); PG8_BAR;
    } else {
        PG8_STAGE(PG8_SB(0, 0), cB, voffB); PG8_STAGE(PG8_SA(0, 0), cA, voffA); PG8_STAGE(PG8_SB(0, 1), cB + hstep, voffB); PG8_STAGE(PG8_SA(0, 1), cA + hstep, voffA);
        if (wr == 1) PG8_BAR;
        PG8_WAIT_V(4); PG8_BAR;
        PG8_STAGE(PG8_SB(1, 0), cB + kstep, voffB); PG8_STAGE(PG8_SA(1, 0), cA + kstep, voffA); PG8_STAGE(PG8_SB(1, 1), cB + hstep + kstep, voffB);
        PG8_WAIT_V(6); PG8_BAR;
    }
    for (;;) {
        const bool has_next = S.next(ui + 1, nxt);
        const char* nA = has_next ? (const char*)g.A + (size_t)nxt.pm * tstep : cA; const char* nB = has_next ? (const char*)g.Bt + (size_t)nxt.pn * tstep : cB;
        for (int t = 0; t < nt; t += 2) {
            const bool last = (t == nt - 2);
            const char* a1 = cA + (size_t)(t + 1) * kstep;
            const char* a2 = last ? nA : cA + (size_t)(t + 2) * kstep; const char* b2 = last ? nB : cB + (size_t)(t + 2) * kstep;
            const char* a3 = a2 + kstep; const char* b3 = b2 + kstep;
            if (last && has_next) S.a_ready(nxt);
            if constexpr (SP2) {
            PG8_LDB(B0, 0, 0); PG8_LDB(B1, 0, 1); PG8_SCHED; PG8_LDA(At, 0, 0); PG8_STAGE(PG8_SA(1, 1), a1 + hstep, voffA);
            PG8_WAIT_V(8); PG8_WAIT_L(0); PG8_BAR; PG8_MMA(0, 0, At, B0); PG8_MMA(0, 1, At, B1); PG8_BAR; PG8_SCHED;
            PG8_LDA(At, 0, 1); PG8_STAGE(PG8_SB(0, 0), b2, voffB); PG8_STAGE(PG8_SB(0, 1), b2 + hstep, voffB); PG8_STAGE(PG8_SA(0, 0), a2, voffA);
            PG8_WAIT_V(8); PG8_WAIT_L(0); PG8_BAR; PG8_MMA(1, 0, At, B0); PG8_MMA(1, 1, At, B1); PG8_BAR; PG8_SCHED;
            PG8_LDB(B0, 1, 0); PG8_LDB(B1, 1, 1); PG8_SCHED; PG8_LDA(At, 1, 0); PG8_STAGE(PG8_SA(0, 1), a2 + hstep, voffA);
            PG8_WAIT_V(8); PG8_WAIT_L(0); PG8_BAR; PG8_MMA(0, 0, At, B0); PG8_MMA(0, 1, At, B1); PG8_BAR; PG8_SCHED;
            PG8_LDA(At, 1, 1); PG8_STAGE(PG8_SB(1, 0), b3, voffB); PG8_STAGE(PG8_SB(1, 1), b3 + hstep, voffB); PG8_STAGE(PG8_SA(1, 0), a3, voffA);
            PG8_WAIT_V(8); PG8_WAIT_L(0); PG8_BAR; PG8_MMA(1, 0, At, B0); PG8_MMA(1, 1, At, B1); PG8_BAR; PG8_SCHED;
            } else {
            PG8_LDB(B0, 0, 0); PG8_SCHED; PG8_LDA(At, 0, 0); PG8_STAGE(PG8_SA(1, 1), a1 + hstep, voffA);
            PG8_WAIT_L(8); PG8_BAR; PG8_WAIT_L(0); PG8_MMA(0, 0, At, B0); PG8_BAR; PG8_SCHED;
            PG8_LDB(B1, 0, 1); PG8_STAGE(PG8_SB(0, 0), b2, voffB);
            PG8_BAR; PG8_WAIT_L(0); PG8_MMA(0, 1, At, B1); PG8_BAR;
            PG8_LDA(At, 0, 1); PG8_STAGE(PG8_SA(0, 0), a2, voffA);
            PG8_BAR; PG8_WAIT_L(0); PG8_MMA(1, 0, At, B0); PG8_BAR; PG8_SCHED;
            PG8_STAGE(PG8_SB(0, 1), b2 + hstep, voffB);
            PG8_WAIT_V(6); PG8_BAR; PG8_MMA(1, 1, At, B1); PG8_BAR;
            PG8_LDB(B0, 1, 0); PG8_SCHED; PG8_LDA(At, 1, 0); PG8_STAGE(PG8_SA(0, 1), a2 + hstep, voffA);
            PG8_WAIT_L(8); PG8_BAR; PG8_WAIT_L(0); PG8_MMA(0, 0, At, B0); PG8_BAR; PG8_SCHED;
            PG8_LDB(B1, 1, 1); PG8_STAGE(PG8_SB(1, 0), b3, voffB);
            PG8_BAR; PG8_WAIT_L(0); PG8_MMA(0, 1, At, B1); PG8_BAR;
            PG8_LDA(At, 1, 1); PG8_STAGE(PG8_SA(1, 0), a3, voffA);
            PG8_BAR; PG8_WAIT_L(0); PG8_MMA(1, 0, At, B0); PG8_BAR; PG8_SCHED;
            PG8_STAGE(PG8_SB(1, 1), b3 + hstep, voffB);
            PG8_WAIT_V(6); PG8_BAR; PG8_MMA(1, 1, At, B1); PG8_BAR;
            }
        }
        if constexpr (ALIGN_EPI) { if (wr == 0) PG8_BAR; }
        if constexpr (!Epi::AFTER_DRAIN) { E(acc, cur, wr, wc, fr, fq); S.done(cur); }
        if (!has_next) break;
#pragma unroll
        for (int a = 0; a < 2; ++a)
#pragma unroll
            for (int b = 0; b < 2; ++b)
#pragma unroll
                for (int m = 0; m < 4; ++m)
#pragma unroll
                    for (int n = 0; n < 2; ++n) acc[a][b][m][n] = (f32x4){0.f, 0.f, 0.f, 0.f};
        cur = nxt; cA = nA; cB = nB; ++ui;
        if constexpr (ALIGN_EPI) { if (wr == 1) PG8_BAR; }
    }
    PG8_WAIT_V(0);
    if constexpr (!ALIGN_EPI) { if (wr == 0) PG8_BAR; }
    PG8_BAR;
    if constexpr (Epi::AFTER_DRAIN) { E.fused(acc, cur, wr, wc, fr, fq, lds, wid, lane); S.done(cur); }
#undef PG8_SA
#undef PG8_SB
#undef PG8_STAGE
#undef PG8_LDA
#undef PG8_LDB
#undef PG8_MMA
#undef PG8_WAIT_V
#undef PG8_WAIT_L
#undef PG8_BAR
#undef PG8_SCHED
}
}

using pg8::Unit;
typedef f32x4 Acc[2][2][4][2];

DI u32x4 pack8(const f32x4& a, const f32x4& b) { u32x4 w; w.x = pk2(a[0], a[1]); w.y = pk2(a[2], a[3]); w.z = pk2(b[0], b[1]); w.w = pk2(b[2], b[3]); return w; }

DI void dequant_acc(Acc& acc, const Unit& u, int wr, int wc, int fr, int fq, const float* SA, const float* SB) {
    f32x4 sb[2][2];
#pragma unroll
    for (int bj = 0; bj < 2; ++bj)
#pragma unroll
        for (int n = 0; n < 2; ++n) sb[bj][n] = *(const f32x4*)(SB + u.pn * 256 + bj * 128 + wc * 32 + 8 * fq + 4 * n);
#pragma unroll
    for (int ai = 0; ai < 2; ++ai)
#pragma unroll
        for (int m = 0; m < 4; ++m) {
            const float sa = SA[u.pm * 256 + ai * 128 + wr * 64 + m * 16 + fr];
#pragma unroll
            for (int bj = 0; bj < 2; ++bj)
#pragma unroll
                for (int n = 0; n < 2; ++n)
#pragma unroll
                    for (int e = 0; e < 4; ++e) acc[ai][bj][m][n][e] = (float)__float_as_int(acc[ai][bj][m][n][e]) * sa * sb[bj][n][e];
        }
}

template <int CTRL, bool ZERO> DI float dppf(float v) { return __int_as_float(__builtin_amdgcn_update_dpp(0, __float_as_int(v), CTRL, 0xF, 0xF, ZERO)); }

struct EpiH {
    static constexpr bool PERM = true, AFTER_DRAIN = false;
    bf16* Qh; bf16* Kh; bf16* VTh; float* DEC; const float* hlb; bf16* OHG; const float* SA; const float* SB;
    DI void operator()(Acc& acc, const Unit& u, int wr, int wc, int fr, int fq) const {
        dequant_acc(acc, u, wr, wc, fr, fq, SA, SB);
        if (u.pn < 8) {
            const int h = u.pn, dbase = wc * 32 + 8 * fq;
#pragma unroll
            for (int ai = 0; ai < 2; ++ai) {
                const int row0 = u.pm * 256 + ai * 128 + wr * 64;
                const int bidx = row0 >> 13, chunk = (row0 & (SEQ - 1)) >> 6;
#pragma unroll
                for (int n = 0; n < 2; ++n) {
                    const f32x4 h0 = *(const f32x4*)(hlb + h * 128 + dbase + 4 * n), h1 = *(const f32x4*)(hlb + 1024 + h * 128 + dbase + 4 * n);
                    f32x4 ebl;
#pragma unroll
                    for (int e = 0; e < 4; ++e) {
                        const float lb = sigmoidf_(h0[e] - h1[e]);
                        float g[4], kk[4], tot[4];
#pragma unroll
                        for (int m = 0; m < 4; ++m) {
                            const float sg = sigmoidf_(acc[ai][1][m][n][e]);
                            kk[m] = (1.f - lb) * (1.f - sg);
                            const float lf = __logf(lb + (1.f - lb) * sg);
                            float s = lf;
                            s += dppf<0x111, true>(s); s += dppf<0x112, true>(s); s += dppf<0x114, true>(s); s += dppf<0x118, true>(s);
                            float t = lf;
                            t += dppf<0xB1, false>(t); t += dppf<0x4E, false>(t); t += dppf<0x141, false>(t); t += dppf<0x140, false>(t);
                            g[m] = s; tot[m] = t;
                        }
                        float carry = 0.f, eb = 0.f;
#pragma unroll
                        for (int m = 0; m < 4; ++m) {
                            const float bb = g[m] + carry; carry += tot[m];
                            eb = __expf(bb);
                            acc[ai][0][m][n][e] = acc[ai][0][m][n][e] * 0.08838834764831845f * eb;
                            acc[ai][1][m][n][e] = kk[m] * __expf(-bb);
                        }
                        ebl[e] = eb;
                    }
                    if (fr == 15) *(f32x4*)(DEC + ((size_t)((bidx * HG_H + h) * HG_NC + chunk)) * 128 + dbase + 4 * n) = ebl;
#pragma unroll
                    for (int m = 0; m < 4; ++m) {
                        const size_t row = (size_t)(row0 + m * 16 + fr);
                        const f32x4 qv = acc[ai][0][m][n], kv = acc[ai][1][m][n];
                        u32x2 oq, ok; oq.x = pk2(qv[0], qv[1]); oq.y = pk2(qv[2], qv[3]); ok.x = pk2(kv[0], kv[1]); ok.y = pk2(kv[2], kv[3]);
                        *(u32x2*)(Qh + row * 1024 + h * 128 + dbase + 4 * n) = oq;
                        *(u32x2*)(Kh + row * 1024 + h * 128 + dbase + 4 * n) = ok;
                    }
                    __builtin_amdgcn_sched_barrier(0);
                }
            }
        } else if (u.pn >= 12) {
            const int cb = (u.pn - 12) * 256 + wc * 32 + 8 * fq;
#pragma unroll
            for (int ai = 0; ai < 2; ++ai)
#pragma unroll
                for (int m = 0; m < 4; ++m) {
                    const size_t row = (size_t)(u.pm * 256 + ai * 128 + wr * 64 + m * 16 + fr);
#pragma unroll
                    for (int bj = 0; bj < 2; ++bj) {
                        f32x4 a0 = acc[ai][bj][m][0], a1 = acc[ai][bj][m][1];
#pragma unroll
                        for (int e = 0; e < 4; ++e) { a0[e] = siluf_(a0[e]); a1[e] = siluf_(a1[e]); }
                        *(u32x4*)(OHG + row * 1024 + cb + bj * 128) = pack8(a0, a1);
                    }
                }
        } else {
#pragma unroll
            for (int ai = 0; ai < 2; ++ai)
#pragma unroll
                for (int m = 0; m < 4; ++m) {
                    const int row = u.pm * 256 + ai * 128 + wr * 64 + m * 16 + fr, bidx = row >> 13, pos = row & (SEQ - 1);
                    bf16* ptr = VTh + (((size_t)(bidx * HG_H * 128 + (u.pn - 8) * 256 + wc * 32 + 8 * fq)) << 13) + pos;
#pragma unroll
                    for (int bj = 0; bj < 2; ++bj) {
#pragma unroll
                        for (int n = 0; n < 2; ++n)
#pragma unroll
                            for (int e = 0; e < 4; ++e) { asm volatile("" : "+v"(ptr)); *ptr = f2bf(acc[ai][bj][m][n][e]); ptr += 8192; }
                        ptr += (size_t)120 * 8192;
                    }
                }
        }
    }
};

struct EpiR {
    static constexpr bool PERM = true, AFTER_DRAIN = false;
    bf16* Qr; bf16* Kr; bf16* VTr; const float* COS; const float* SIN; bf16* ORET; const float* SA; const float* SB;
    DI void operator()(Acc& acc, const Unit& u, int wr, int wc, int fr, int fq) const {
        dequant_acc(acc, u, wr, wc, fr, fq, SA, SB);
        if (u.pn < 8) {
            const bool isk = u.pn >= 4; const int h = u.pn & 3;
            const float lg = __log2f(1.f - exp2f(-5.f - (float)h));
            bf16* dst = isk ? Kr : Qr;
            const int j0 = wc * 32 + 8 * fq;
#pragma unroll
            for (int ai = 0; ai < 2; ++ai)
#pragma unroll
                for (int m = 0; m < 4; ++m) {
                    const int row = u.pm * 256 + ai * 128 + wr * 64 + m * 16 + fr, pos = row & (SEQ - 1), il = pos & (RT_L - 1);
                    const float sc = isk ? exp2f(-lg * (float)il) * 0.0625f : exp2f(lg * (float)il);
#pragma unroll
                    for (int n = 0; n < 2; ++n) {
                        const f32x4 c = *(const f32x4*)(COS + (size_t)pos * 128 + j0 + 4 * n), s = *(const f32x4*)(SIN + (size_t)pos * 128 + j0 + 4 * n);
                        const f32x4 x1 = acc[ai][0][m][n], x2 = acc[ai][1][m][n];
                        acc[ai][0][m][n] = (x1 * c - x2 * s) * sc; acc[ai][1][m][n] = (x1 * s + x2 * c) * sc;
                    }
                    *(u32x4*)(dst + (size_t)row * 1024 + h * 256 + j0) = pack8(acc[ai][0][m][0], acc[ai][0][m][1]);
                    *(u32x4*)(dst + (size_t)row * 1024 + h * 256 + 128 + j0) = pack8(acc[ai][1][m][0], acc[ai][1][m][1]);
                }
        } else if (u.pn >= 16) {
            const int cb = (u.pn - 16) * 256 + wc * 32 + 8 * fq;
#pragma unroll
            for (int ai = 0; ai < 2; ++ai)
#pragma unroll
                for (int m = 0; m < 4; ++m) {
                    const size_t row = (size_t)(u.pm * 256 + ai * 128 + wr * 64 + m * 16 + fr);
#pragma unroll
                    for (int bj = 0; bj < 2; ++bj) {
                        f32x4 a0 = acc[ai][bj][m][0], a1 = acc[ai][bj][m][1];
#pragma unroll
                        for (int e = 0; e < 4; ++e) { a0[e] = siluf_(a0[e]); a1[e] = siluf_(a1[e]); }
                        *(u32x4*)(ORET + row * 2048 + cb + bj * 128) = pack8(a0, a1);
                    }
                }
        } else {
#pragma unroll
            for (int ai = 0; ai < 2; ++ai)
#pragma unroll
                for (int m = 0; m < 4; ++m) {
                    const int row = u.pm * 256 + ai * 128 + wr * 64 + m * 16 + fr, bidx = row >> 13, pos = row & (SEQ - 1);
                    const int uu = pos & 15, hs = (uu >> 2) & 1, jj = ((uu >> 3) << 2) | (uu & 3), ks = (pos >> 4) & 1, sblk = pos >> 5;
                    const int c0 = (u.pn - 8) * 256 + wc * 32, hd = c0 >> 9, nv0 = (c0 & 511) >> 5;
                    bf16* ptr = VTr + ((((size_t)((bidx * RT_H + hd) * 256 + sblk) * 16 + nv0) * 2 + ks) * 64 + (8 * fq + 32 * hs)) * 8 + jj;
#pragma unroll
                    for (int bj = 0; bj < 2; ++bj) {
#pragma unroll
                        for (int n = 0; n < 2; ++n)
#pragma unroll
                            for (int e = 0; e < 4; ++e) { asm volatile("" : "+v"(ptr)); *ptr = f2bf(acc[ai][bj][m][n][e]); ptr += 8; }
                        ptr += 4 * 2 * 64 * 8 - 64;
                    }
                }
        }
    }
};

struct EpiG {
    static constexpr bool PERM = true, AFTER_DRAIN = false;
    bf16* GA; bf16* GB; const float* SA; const float* SB;
    DI void operator()(Acc& acc, const Unit& u, int wr, int wc, int fr, int fq) const {
        dequant_acc(acc, u, wr, wc, fr, fq, SA, SB);
        const int cb = wc * 32 + 8 * fq;
        bf16* base = (u.pn < 4 ? GA + (size_t)u.pn * 256 : GB + (size_t)(u.pn - 4) * 256) + cb;
#pragma unroll
        for (int ai = 0; ai < 2; ++ai)
#pragma unroll
            for (int m = 0; m < 4; ++m) {
                const size_t row = (size_t)(u.pm * 256 + ai * 128 + wr * 64 + m * 16 + fr);
#pragma unroll
                for (int bj = 0; bj < 2; ++bj) {
                    f32x4 a0 = acc[ai][bj][m][0], a1 = acc[ai][bj][m][1];
#pragma unroll
                    for (int e = 0; e < 4; ++e) { a0[e] = sigmoidf_(a0[e]); a1[e] = sigmoidf_(a1[e]); }
                    *(u32x4*)(base + row * 1024 + bj * 128) = pack8(a0, a1);
                }
            }
    }
};

struct EpiM1 {
    static constexpr bool PERM = true, AFTER_DRAIN = false;
    float* M1; const bf16* GA;
    DI void operator()(Acc& acc, const Unit& u, int wr, int wc, int fr, int fq) const {
        const int cb = u.pn * 256 + wc * 32 + 8 * fq;
#pragma unroll
        for (int ai = 0; ai < 2; ++ai)
#pragma unroll
            for (int m = 0; m < 4; ++m) {
                const size_t row = (size_t)(u.pm * 256 + ai * 128 + wr * 64 + m * 16 + fr);
#pragma unroll
                for (int bj = 0; bj < 2; ++bj) {
                    const u32x4 g = *(const u32x4*)(GA + row * 1024 + cb + bj * 128);
                    f32x4 a0 = acc[ai][bj][m][0], a1 = acc[ai][bj][m][1];
                    a0[0] *= bflo(g.x); a0[1] *= bfhi(g.x); a0[2] *= bflo(g.y); a0[3] *= bfhi(g.y);
                    a1[0] *= bflo(g.z); a1[1] *= bfhi(g.z); a1[2] *= bflo(g.w); a1[3] *= bfhi(g.w);
                    float* p = M1 + row * 1024 + cb + bj * 128;
                    *(f32x4*)p = a0; *(f32x4*)(p + 4) = a1;
                }
            }
    }
};
struct EpiMerge {
    static constexpr bool PERM = true, AFTER_DRAIN = false;
    const float* M1; const bf16* GB; bf16* MERGED;
    DI void operator()(Acc& acc, const Unit& u, int wr, int wc, int fr, int fq) const {
        const int cb = u.pn * 256 + wc * 32 + 8 * fq;
#pragma unroll
        for (int ai = 0; ai < 2; ++ai)
#pragma unroll
            for (int m = 0; m < 4; ++m) {
                const size_t row = (size_t)(u.pm * 256 + ai * 128 + wr * 64 + m * 16 + fr);
#pragma unroll
                for (int bj = 0; bj < 2; ++bj) {
                    const u32x4 g = *(const u32x4*)(GB + row * 1024 + cb + bj * 128);
                    const float* p = M1 + row * 1024 + cb + bj * 128;
                    f32x4 a0 = acc[ai][bj][m][0], a1 = acc[ai][bj][m][1];
                    const f32x4 m0 = *(const f32x4*)p, m1 = *(const f32x4*)(p + 4);
                    a0[0] = a0[0] * bflo(g.x) + m0[0]; a0[1] = a0[1] * bfhi(g.x) + m0[1]; a0[2] = a0[2] * bflo(g.y) + m0[2]; a0[3] = a0[3] * bfhi(g.y) + m0[3];
                    a1[0] = a1[0] * bflo(g.z) + m1[0]; a1[1] = a1[1] * bfhi(g.z) + m1[1]; a1[2] = a1[2] * bflo(g.w) + m1[2]; a1[3] = a1[3] * bfhi(g.w) + m1[3];
                    *(u32x4*)(MERGED + row * 1024 + cb + bj * 128) = pack8(a0, a1);
                }
            }
    }
};
struct EpiOut {
    static constexpr bool PERM = true, AFTER_DRAIN = false;
    const float* X; float* X1; bf16* XW; const float* nw; float* SSQX;
    DI void operator()(Acc& acc, const Unit& u, int wr, int wc, int fr, int fq) const {
        const int cb = u.pn * 256 + wc * 32 + 8 * fq;
#pragma unroll
        for (int ai = 0; ai < 2; ++ai)
#pragma unroll
            for (int m = 0; m < 4; ++m) {
                const size_t row = (size_t)(u.pm * 256 + ai * 128 + wr * 64 + m * 16 + fr);
                float ss = 0.f;
#pragma unroll
                for (int bj = 0; bj < 2; ++bj) {
                    const size_t off = row * 1024 + cb + bj * 128;
                    const f32x4 x0 = *(const f32x4*)(X + off), x1v = *(const f32x4*)(X + off + 4);
                    const f32x4 w0 = *(const f32x4*)(nw + cb + bj * 128), w1 = *(const f32x4*)(nw + cb + bj * 128 + 4);
                    const f32x4 a0 = acc[ai][bj][m][0] + x0, a1 = acc[ai][bj][m][1] + x1v;
                    *(f32x4*)(X1 + off) = a0; *(f32x4*)(X1 + off + 4) = a1;
                    ss += (a0[0] * a0[0] + a0[1] * a0[1]) + (a0[2] * a0[2] + a0[3] * a0[3]) + (a1[0] * a1[0] + a1[1] * a1[1]) + (a1[2] * a1[2] + a1[3] * a1[3]);
                    *(u32x4*)(XW + off) = pack8(a0 * w0, a1 * w1);
                }
                ss += __shfl_xor(ss, 16); ss += __shfl_xor(ss, 32);
                if (fq == 0) SSQX[row * 16 + u.pn * 4 + wc] = ss;
            }
    }
};
DI float rstd_x1(const float* SSQX, size_t row) {
    const f32x4 a = *(const f32x4*)(SSQX + row * 16), b = *(const f32x4*)(SSQX + row * 16 + 4), c = *(const f32x4*)(SSQX + row * 16 + 8), d = *(const f32x4*)(SSQX + row * 16 + 12);
    const float s = ((a[0] + a[1]) + (a[2] + a[3])) + ((b[0] + b[1]) + (b[2] + b[3])) + ((c[0] + c[1]) + (c[2] + c[3])) + ((d[0] + d[1]) + (d[2] + d[3]));
    return rsqrtf(s * (1.f / 1024.f) + EPS);
}
struct EpiQ {
    static constexpr bool PERM = true, AFTER_DRAIN = false;
    bf16* Q; const float* SSQX;
    DI void operator()(Acc& acc, const Unit& u, int wr, int wc, int fr, int fq) const {
        const int cb = u.pn * 256 + wc * 32 + 8 * fq;
#pragma unroll
        for (int ai = 0; ai < 2; ++ai)
#pragma unroll
            for (int m = 0; m < 4; ++m) {
                const size_t row = (size_t)(u.pm * 256 + ai * 128 + wr * 64 + m * 16 + fr);
                const float rs = rstd_x1(SSQX, row);
#pragma unroll
                for (int bj = 0; bj < 2; ++bj) *(u32x4*)(Q + row * 2048 + cb + bj * 128) = pack8(acc[ai][bj][m][0] * rs, acc[ai][bj][m][1] * rs);
            }
    }
};

#define MFMA32(a, b, c) __builtin_amdgcn_mfma_f32_32x32x16_bf16((a), (b), (c), 0, 0, 0)
DI bf16x8 ldg16(const bf16* p) { return *(const bf16x8*)p; }
DI bf16x8 ldg2x8(const bf16* p0, const bf16* p1) { const s16x4 a = *(const s16x4*)p0, b = *(const s16x4*)p1; return __builtin_shufflevector(a, b, 0, 1, 2, 3, 4, 5, 6, 7); }
DI bf16x8 packx(const f32x16& x, int s) {
    u32x4 p; p.x = pk2(x[8 * s + 0], x[8 * s + 1]); p.y = pk2(x[8 * s + 2], x[8 * s + 3]); p.z = pk2(x[8 * s + 4], x[8 * s + 5]); p.w = pk2(x[8 * s + 6], x[8 * s + 7]);
    return __builtin_bit_cast(bf16x8, p);
}
DI f32x16 zero16() { f32x16 z;
#pragma unroll
    for (int i = 0; i < 16; ++i) z[i] = 0.f; return z; }

DI bf16x8 tr_frag(const LAS unsigned char* tile, int RS, int lane, int ks, int c) {
    const int hh = lane >> 5, blk = (lane >> 4) & 1, q = (lane & 15) >> 2, p = lane & 3;
    const LAS unsigned char* a0 = tile + (16 * ks + 8 * hh + q) * RS + (32 * c + 16 * blk + 4 * p) * 2;
    const s16x4 lo = __builtin_amdgcn_ds_read_tr16_b64_v4i16((LAS s16x4*)a0);
    const s16x4 hi = __builtin_amdgcn_ds_read_tr16_b64_v4i16((LAS s16x4*)(a0 + 4 * RS));
    return __builtin_shufflevector(lo, hi, 0, 1, 2, 3, 4, 5, 6, 7);
}

DI bf16x8 tr_frag_perm(const LAS unsigned char* tile, int RS, int lane, int ks, int c) {
    const int hh = lane >> 5, blk = (lane >> 4) & 1, q = (lane & 15) >> 2, p = lane & 3;
    const LAS unsigned char* a0 = tile + (16 * ks + 4 * hh + q) * RS + (32 * c + 16 * blk + 4 * p) * 2;
    const s16x4 lo = __builtin_amdgcn_ds_read_tr16_b64_v4i16((LAS s16x4*)a0);
    const s16x4 hi = __builtin_amdgcn_ds_read_tr16_b64_v4i16((LAS s16x4*)(a0 + 8 * RS));
    return __builtin_shufflevector(lo, hi, 0, 1, 2, 3, 4, 5, 6, 7);
}

constexpr int HG_KRS = 320;
DI void hg_pass1(LAS unsigned char* lds, const bf16* Kh, const bf16* VTh, bf16* STh, int wg, int nwg) {
    const int tid = fresh_tid(), lane = tid & 63, w = __builtin_amdgcn_readfirstlane(tid >> 6), r = lane & 31, hh = lane >> 5;
    for (int unit = wg; unit < 16 * HG_NC; unit += nwg) {
        const int bh = unit >> 7, c = unit & 127, b = bh >> 3, h = bh & 7;
        __syncthreads();
        {
            const int row = tid >> 3, ch = tid & 7;
            const bf16* src = Kh + ((size_t)(b * SEQ + c * 64 + row)) * 1024 + h * 128;
            const bf16x8 v0 = ldg16(src + ch * 8), v1 = ldg16(src + 64 + ch * 8);
            *(LAS bf16x8*)(lds + row * HG_KRS + ch * 16) = v0; *(LAS bf16x8*)(lds + row * HG_KRS + 128 + ch * 16) = v1;
        }
        __syncthreads();
        const int mt = w & 3, nt0 = w >> 2;
        f32x16 a0 = zero16(), a1 = zero16();
        const bf16* vrow = VTh + (((size_t)(bh * 128 + 32 * mt + r)) << 13) + c * 64;
#pragma unroll
        for (int ks = 0; ks < 4; ++ks) {
            const bf16x8 av = ldg16(vrow + 16 * ks + 8 * hh);
            a0 = MFMA32(av, tr_frag(lds, HG_KRS, lane, ks, nt0), a0);
            a1 = MFMA32(av, tr_frag(lds, HG_KRS, lane, ks, nt0 + 2), a1);
        }
        bf16* dst = STh + ((size_t)(bh * HG_NC + c)) * 16384;
#pragma unroll
        for (int i = 0; i < 16; ++i) {
            const int v = 32 * mt + crow(i, hh);
            dst[v * 128 + 32 * nt0 + r] = f2bf(a0[i]); dst[v * 128 + 32 * (nt0 + 2) + r] = f2bf(a1[i]);
        }
    }
    __syncthreads();
}

DI void hg_scan(bf16* STh, const float* DEC, int gtid, int gsz) {
    for (int idx = gtid; idx < 16 * 128 * 32; idx += gsz) {
        const int dq = idx & 31, v = (idx >> 5) & 127, bh = idx >> 12;
        f32x4 carry = {0.f, 0.f, 0.f, 0.f};
        bf16* p = STh + ((size_t)bh * HG_NC) * 16384 + v * 128 + dq * 4;
        const float* dp = DEC + ((size_t)bh * HG_NC) * 128 + dq * 4;
#pragma unroll 8
        for (int c = 0; c < HG_NC; ++c) {
            const u32x2 wv = *(const u32x2*)(p + (size_t)c * 16384);
            const f32x4 dec = *(const f32x4*)(dp + c * 128);
            u32x2 o; o.x = pk2(carry[0], carry[1]); o.y = pk2(carry[2], carry[3]);
            *(u32x2*)(p + (size_t)c * 16384) = o;
            carry[0] = dec[0] * (carry[0] + bflo(wv.x)); carry[1] = dec[1] * (carry[1] + bfhi(wv.x));
            carry[2] = dec[2] * (carry[2] + bflo(wv.y)); carry[3] = dec[3] * (carry[3] + bfhi(wv.y));
        }
    }
}
DI void rt_scan(bf16* STr, int gtid, int gsz) {
    for (int idx = gtid; idx < 8 * 512 * 32; idx += gsz) {
        const int dq = idx & 31, v = (idx >> 5) & 511, bh = idx >> 14, h = bh & 3;
        const float dec = exp2f((float)RT_L * __log2f(1.f - exp2f(-5.f - (float)h)));
        float carry[8];
#pragma unroll
        for (int e = 0; e < 8; ++e) carry[e] = 0.f;
        bf16* p = STr + ((size_t)bh * RT_NS) * 131072 + v * 256 + dq * 8;
#pragma unroll 4
        for (int c = 0; c < RT_NS; ++c) {
            const u32x4 wv = *(const u32x4*)(p + (size_t)c * 131072);
            u32x4 o; o.x = pk2(carry[0], carry[1]); o.y = pk2(carry[2], carry[3]); o.z = pk2(carry[4], carry[5]); o.w = pk2(carry[6], carry[7]);
            *(u32x4*)(p + (size_t)c * 131072) = o;
            if (c == RT_NS - 1) break;
            carry[0] = dec * (carry[0] + bflo(wv.x)); carry[1] = dec * (carry[1] + bfhi(wv.x));
            carry[2] = dec * (carry[2] + bflo(wv.y)); carry[3] = dec * (carry[3] + bfhi(wv.y));
            carry[4] = dec * (carry[4] + bflo(wv.z)); carry[5] = dec * (carry[5] + bfhi(wv.z));
            carry[6] = dec * (carry[6] + bflo(wv.w)); carry[7] = dec * (carry[7] + bfhi(wv.w));
        }
    }
}

DI void hg_pass3(LAS unsigned char* lds, const bf16* Qh, const bf16* Kh, const bf16* VTh, const bf16* STh, const float* hg_norm_w, bf16* OHG, int gw, int ngw, int dry) {
    const int tid_ = fresh_tid(), lane = tid_ & 63, r = lane & 31, hh = lane >> 5;
    LAS unsigned char* ot = lds + __builtin_amdgcn_readfirstlane(tid_ >> 6) * 8704;
    for (int unit = gw; unit < 16 * HG_NC * 2; unit += ngw) {
        const int tb = unit & 1, c = (unit >> 1) & 127, bh = unit >> 8, b = bh >> 3, h = bh & 7;
        const size_t trow = (size_t)(b * SEQ + c * 64 + tb * 32 + r);
        bf16x8 qf[8];
#pragma unroll
        for (int kk = 0; kk < 8; ++kk) qf[kk] = ldg16(Qh + trow * 1024 + h * 128 + kk * 16 + 8 * hh);
        f32x16 acc[4];
#pragma unroll
        for (int nv = 0; nv < 4; ++nv) acc[nv] = zero16();
        for (int sb = 0; sb <= tb; ++sb) {
            const size_t srow = (size_t)(b * SEQ + c * 64 + sb * 32 + r);
            f32x16 x = zero16();
#pragma unroll
            for (int kk = 0; kk < 8; ++kk) x = MFMA32(ldg16(Kh + srow * 1024 + h * 128 + kk * 16 + 8 * hh), qf[kk], x);
            if (sb == tb) {
#pragma unroll
                for (int i = 0; i < 16; ++i) if (crow(i, hh) > r) x[i] = 0.f;
            }
            const bf16x8 xs0 = packx(x, 0), xs1 = packx(x, 1);
#pragma unroll
            for (int nv = 0; nv < 4; ++nv) {
                const bf16* vb = VTh + (((size_t)(bh * 128 + nv * 32 + r)) << 13) + c * 64 + sb * 32 + 4 * hh;
                acc[nv] = MFMA32(ldg2x8(vb, vb + 8), xs0, acc[nv]);
                acc[nv] = MFMA32(ldg2x8(vb + 16, vb + 24), xs1, acc[nv]);
            }
        }
        const bf16* st = STh + ((size_t)(bh * HG_NC + c)) * 16384;
#pragma unroll
        for (int nv = 0; nv < 4; ++nv)
#pragma unroll
            for (int kk = 0; kk < 8; ++kk) acc[nv] = MFMA32(ldg16(st + (nv * 32 + r) * 128 + kk * 16 + 8 * hh), qf[kk], acc[nv]);
        float ss = 0.f;
#pragma unroll
        for (int nv = 0; nv < 4; ++nv)
#pragma unroll
            for (int i = 0; i < 16; ++i) ss += acc[nv][i] * acc[nv][i];
        ss += __shfl_xor(ss, 32);
        const float rs = rsqrtf(ss * (1.f / 128.f) + EPS);
#pragma unroll
        for (int nv = 0; nv < 4; ++nv)
#pragma unroll
            for (int g = 0; g < 4; ++g) {
                const int v = nv * 32 + 8 * g + 4 * hh;
                const f32x4 wv = *(const f32x4*)(hg_norm_w + h * 128 + v);
                u32x2 o; o.x = pk2(acc[nv][4 * g] * rs * wv[0], acc[nv][4 * g + 1] * rs * wv[1]); o.y = pk2(acc[nv][4 * g + 2] * rs * wv[2], acc[nv][4 * g + 3] * rs * wv[3]);
                *(LAS u32x2*)(ot + r * 272 + v * 2) = o;
            }
        bf16* orow = OHG + ((size_t)(b * SEQ + c * 64 + tb * 32)) * 1024 + h * 128;
#pragma unroll
        for (int k = 0; k < 8; ++k) {
            const int row = 4 * k + (lane >> 4), ch = lane & 15;
            const u32x4 val = *(const LAS u32x4*)(ot + row * 272 + ch * 16);
            bf16* gp = orow + (size_t)row * 1024 + ch * 8;
            const u32x4 gt = *(const u32x4*)gp;
            u32x4 o;
            o.x = pk2(bflo(val.x) * bflo(gt.x), bfhi(val.x) * bfhi(gt.x)); o.y = pk2(bflo(val.y) * bflo(gt.y), bfhi(val.y) * bfhi(gt.y));
            o.z = pk2(bflo(val.z) * bflo(gt.z), bfhi(val.z) * bfhi(gt.z)); o.w = pk2(bflo(val.w) * bflo(gt.w), bfhi(val.w) * bfhi(gt.w));
            if (!dry) *(u32x4*)gp = o; else asm volatile("" :: "v"(o));
        }
    }
}

constexpr int RT_KRS = 576;
constexpr int RT_KBUF = 64 * RT_KRS;
DI void rt_pass1(LAS unsigned char* lds, const bf16* Kr, const bf16* VTr, bf16* STr, int wg, int nwg) {
    const int tid = fresh_tid(), lane = tid & 63, w = __builtin_amdgcn_readfirstlane(tid >> 6), r = lane & 31, hh = lane >> 5;
    const int wm = w & 3, wn = w >> 2;
    const int srow = tid >> 3, sch = tid & 7;
    for (int unit = wg; unit < 8 * (RT_NS - 1) * 2; unit += nwg) {
        const int vh = unit & 1, sg = (unit >> 1) % (RT_NS - 1), bh = (unit >> 1) / (RT_NS - 1), b = bh >> 2, h = bh & 3;
        f32x16 acc[2][4];
#pragma unroll
        for (int i = 0; i < 2; ++i)
#pragma unroll
            for (int j = 0; j < 4; ++j) acc[i][j] = zero16();
        const bf16* kbase = Kr + ((size_t)(b * SEQ + sg * RT_L)) * 1024 + h * 256;
        bf16x8 st[4];
#pragma unroll
        for (int i = 0; i < 4; ++i) st[i] = ldg16(kbase + (size_t)srow * 1024 + (sch + 8 * i) * 8);
        __syncthreads();
#pragma unroll
        for (int i = 0; i < 4; ++i) *(LAS bf16x8*)(lds + srow * RT_KRS + (sch + 8 * i) * 16) = st[i];
        for (int sb = 0; sb < RT_L / 64; ++sb) {
            const LAS unsigned char* cur = lds + (sb & 1) * RT_KBUF;
            if (sb + 1 < RT_L / 64) {
#pragma unroll
                for (int i = 0; i < 4; ++i) st[i] = ldg16(kbase + (size_t)((sb + 1) * 64 + srow) * 1024 + (sch + 8 * i) * 8);
            }
            __syncthreads();
#pragma unroll
            for (int ks = 0; ks < 4; ++ks) {
                bf16x8 av[2];
#pragma unroll
                for (int i = 0; i < 2; ++i) av[i] = ldg16(VTr + (((((size_t)(bh * 256 + sg * 16 + sb * 2 + (ks >> 1))) * 16 + vh * 8 + wm * 2 + i) * 2 + (ks & 1)) * 64 + lane) * 8);
#pragma unroll
                for (int j = 0; j < 4; ++j) {
                    const bf16x8 bv = tr_frag_perm(cur, RT_KRS, lane, ks, wn * 4 + j);
                    acc[0][j] = MFMA32(av[0], bv, acc[0][j]); acc[1][j] = MFMA32(av[1], bv, acc[1][j]);
                }
                __builtin_amdgcn_sched_barrier(0);
            }
            if (sb + 1 < RT_L / 64) {
                LAS unsigned char* nxt = lds + ((sb + 1) & 1) * RT_KBUF;
#pragma unroll
                for (int i = 0; i < 4; ++i) *(LAS bf16x8*)(nxt + srow * RT_KRS + (sch + 8 * i) * 16) = st[i];
            }
        }
        bf16* dst = STr + ((size_t)(bh * RT_NS + sg)) * 131072;
#pragma unroll
        for (int i = 0; i < 2; ++i)
#pragma unroll
            for (int j = 0; j < 4; ++j)
#pragma unroll
                for (int e = 0; e < 16; ++e) {
                    const int vl = crow(e, hh), d = wn * 128 + j * 32 + r;
                    dst[((((vh * 8 + wm * 2 + i) * 16 + (d >> 4)) * 64 + vl + 32 * ((d >> 3) & 1)) << 3) + (d & 7)] = f2bf(acc[i][j][e]);
                }
    }
    __syncthreads();
}

DI void rt_pass3_unit(const bf16* Qr, const bf16* Kr, const bf16* VTr, const bf16* STr, bf16* ORET, float* SSQP, int idx, int lane) {
    const int r = lane & 31, hh = lane >> 5;
    const int vh = idx & 1, tbl = (idx >> 1) & 15, sgid = idx >> 5, sg = sgid & 15, bh = sgid >> 4, b = bh >> 2, h = bh & 3;
    const int t0 = sg * RT_L + tbl * 32;
    const size_t trow = (size_t)(b * SEQ + t0 + r);
    const bf16* qrow = Qr + trow * 1024 + h * 256 + 8 * hh;
    f32x16 acc[8];
#pragma unroll
    for (int nv = 0; nv < 8; ++nv) acc[nv] = zero16();
    for (int sb = 0; sb <= tbl; ++sb) {
        const int s0 = sg * RT_L + sb * 32;
        const bf16* krow = Kr + ((size_t)(b * SEQ + s0 + r)) * 1024 + h * 256 + 8 * hh;
        f32x16 x = zero16();
#pragma unroll
        for (int k4 = 0; k4 < 4; ++k4) {
            bf16x8 kf[4], qf[4];
#pragma unroll
            for (int i = 0; i < 4; ++i) { kf[i] = ldg16(krow + (k4 * 4 + i) * 16); qf[i] = ldg16(qrow + (k4 * 4 + i) * 16); }
#pragma unroll
            for (int i = 0; i < 4; ++i) x = MFMA32(kf[i], qf[i], x);
            __builtin_amdgcn_sched_barrier(0);
        }
        if (sb == tbl) {
#pragma unroll
            for (int i = 0; i < 16; ++i) if (crow(i, hh) > r) x[i] = 0.f;
        }
        const bf16x8 xs0 = packx(x, 0), xs1 = packx(x, 1);
#pragma unroll
        for (int nv = 0; nv < 8; ++nv) {
            const bf16* vb = VTr + (((size_t)(bh * 512 + vh * 256 + nv * 32 + r)) << 13) + s0 + 4 * hh;
            acc[nv] = MFMA32(ldg2x8(vb, vb + 8), xs0, acc[nv]);
            acc[nv] = MFMA32(ldg2x8(vb + 16, vb + 24), xs1, acc[nv]);
            if ((nv & 3) == 3) __builtin_amdgcn_sched_barrier(0);
        }
    }
    const bf16* st = STr + ((size_t)(bh * RT_NS + sg)) * 131072 + (size_t)(vh * 256) * 256;
#pragma unroll 2
    for (int kk = 0; kk < 16; ++kk) {
        const bf16x8 q = ldg16(qrow + kk * 16);
#pragma unroll
        for (int nv = 0; nv < 8; ++nv) acc[nv] = MFMA32(ldg16(st + (nv * 32 + r) * 256 + kk * 16 + 8 * hh), q, acc[nv]);
        __builtin_amdgcn_sched_barrier(0);
    }
    float ss = 0.f;
#pragma unroll
    for (int nv = 0; nv < 8; ++nv)
#pragma unroll
        for (int i = 0; i < 16; ++i) ss += acc[nv][i] * acc[nv][i];
    ss += __shfl_xor(ss, 32);
    if (hh == 0) SSQP[trow * 8 + h * 2 + vh] = ss;
#pragma unroll
    for (int nv = 0; nv < 8; ++nv)
#pragma unroll
        for (int g = 0; g < 4; ++g) {
            const int v = vh * 256 + nv * 32 + 8 * g + 4 * hh;
            u32x2 o; o.x = pk2(acc[nv][4 * g], acc[nv][4 * g + 1]); o.y = pk2(acc[nv][4 * g + 2], acc[nv][4 * g + 3]);
            *(u32x2*)(ORET + trow * 2048 + h * 512 + v) = o;
        }
}
DI void rt_pass3(const bf16* Qr, const bf16* Kr, const bf16* VTr, const bf16* STr, bf16* ORET, float* SSQP, int gw, int ngw) {
    const int lane = fresh_tid() & 63;
    for (int u = gw; u < 2048; u += ngw) {
        rt_pass3_unit(Qr, Kr, VTr, STr, ORET, SSQP, u, lane);
        const int p = (u & 1) | ((15 - ((u >> 1) & 15)) << 1) | (((u >> 5) + 64) << 5);
        rt_pass3_unit(Qr, Kr, VTr, STr, ORET, SSQP, p, lane);
    }
}

constexpr int RQ_RS = 528;
constexpr int RQ_QBYTES = 128 * RQ_RS, RQ_KBYTES = 32 * RQ_RS;
DI void rt_pass3_wg(LAS unsigned char* lds, const bf16* Qr, const bf16* Kr, const bf16* VTr, const bf16* STr, bf16* ORET, float* SSQP, int wg, int nwg, int dry) {
    const int tid = fresh_tid(), lane = tid & 63, w = __builtin_amdgcn_readfirstlane(tid >> 6), r = lane & 31, hh = lane >> 5;
    const int tsub = w & 3, vh = w >> 2;
    LAS unsigned char* Qs = lds;
    LAS unsigned char* Ks = lds + RQ_QBYTES;
    for (int pairidx = wg; pairidx < 256; pairidx += nwg) {
#pragma unroll 1
        for (int half = 0; half < 2; ++half) {
            const int sgid = pairidx >> 1, bh = sgid >> 4, sg = sgid & 15, b = bh >> 2, h = bh & 3;
            const int qq = half ? 3 - (pairidx & 1) : (pairidx & 1);
            const int pos0 = sg * RT_L + qq * 128, nsb = 4 * qq + 4, mysb = 4 * qq + tsub;
            const bf16* qsrc = Qr + ((size_t)(b * SEQ + pos0)) * 1024 + h * 256;
            const bf16* ksrc = Kr + ((size_t)(b * SEQ + sg * RT_L)) * 1024 + h * 256;
            unsigned stoff = (unsigned)((tid >> 5) * 1024 + (tid & 31) * 8);
            unsigned stlds = (unsigned)((tid >> 5) * RQ_RS + (tid & 31) * 16);
            asm volatile("" : "+v"(stoff), "+v"(stlds));
            __syncthreads();
#pragma unroll
            for (int i = 0; i < 8; ++i) *(LAS bf16x8*)(Qs + stlds + i * 16 * RQ_RS) = ldg16(qsrc + i * 16 * 1024 + stoff);
            bf16x8 kst[2];
#pragma unroll
            for (int i = 0; i < 2; ++i) *(LAS bf16x8*)(Ks + stlds + i * 16 * RQ_RS) = ldg16(ksrc + i * 16 * 1024 + stoff);
            f32x16 acc[8];
#pragma unroll
            for (int nv = 0; nv < 8; ++nv) acc[nv] = zero16();
            __syncthreads();
            const LAS unsigned char* qfr = Qs + (tsub * 32 + r) * RQ_RS + 16 * hh;
            {
                const bf16* st = STr + ((size_t)(bh * RT_NS + sg)) * 131072 + (size_t)(vh * 8) * 16 * 512;
                unsigned so = (unsigned)(lane * 8);
                asm volatile("" : "+v"(so));
                bf16x8 fa[8], fb[8];
#pragma unroll
                for (int nv = 0; nv < 8; ++nv) fa[nv] = ldg16(st + nv * 16 * 512 + so);
#pragma unroll 1
                for (int k2 = 0; k2 < 8; ++k2) {
#pragma unroll
                    for (int nv = 0; nv < 8; ++nv) fb[nv] = ldg16(st + nv * 16 * 512 + (2 * k2 + 1) * 512 + so);
                    {
                        const bf16x8 q = *(const LAS bf16x8*)(qfr + (2 * k2) * 32);
#pragma unroll
                        for (int nv = 0; nv < 8; ++nv) acc[nv] = MFMA32(fa[nv], q, acc[nv]);
                    }
                    __builtin_amdgcn_sched_barrier(0);
                    if (k2 < 7) {
#pragma unroll
                        for (int nv = 0; nv < 8; ++nv) fa[nv] = ldg16(st + nv * 16 * 512 + (2 * k2 + 2) * 512 + so);
                    }
                    {
                        const bf16x8 q = *(const LAS bf16x8*)(qfr + (2 * k2 + 1) * 32);
#pragma unroll
                        for (int nv = 0; nv < 8; ++nv) acc[nv] = MFMA32(fb[nv], q, acc[nv]);
                    }
                    __builtin_amdgcn_sched_barrier(0);
                }
            }
            const bf16* vbase = VTr + (((size_t)(bh * 256 + sg * 16)) * 16 + vh * 8) * 1024;
            unsigned vo = (unsigned)(lane * 8);
            asm volatile("" : "+v"(vo));
#pragma unroll 1
            for (int sb = 0; sb < nsb; ++sb) {
                const LAS unsigned char* kcur = Ks + (sb & 1) * RQ_KBYTES;
                if (sb + 1 < nsb) {
#pragma unroll
                    for (int i = 0; i < 2; ++i) kst[i] = ldg16(ksrc + (size_t)(sb + 1) * 32 * 1024 + i * 16 * 1024 + stoff);
                }
                if (sb <= mysb) {
                    bf16x8 vt[8][2];
                    const bf16* vb = vbase + (size_t)sb * 16 * 1024;
#pragma unroll
                    for (int nv = 0; nv < 8; ++nv) { vt[nv][0] = ldg16(vb + nv * 1024 + vo); vt[nv][1] = ldg16(vb + nv * 1024 + 512 + vo); }
                    f32x16 x = zero16();
                    const LAS unsigned char* kfr = kcur + r * RQ_RS + 16 * hh;
#pragma unroll
                    for (int kk = 0; kk < 16; ++kk) { x = MFMA32(*(const LAS bf16x8*)(kfr + kk * 32), *(const LAS bf16x8*)(qfr + kk * 32), x); if (kk & 1) __builtin_amdgcn_sched_barrier(0); }
                    if (sb == mysb) {
#pragma unroll
                        for (int i = 0; i < 16; ++i) if (crow(i, hh) > r) x[i] = 0.f;
                    }
                    const bf16x8 xs0 = packx(x, 0), xs1 = packx(x, 1);
#pragma unroll
                    for (int nv = 0; nv < 8; ++nv) { acc[nv] = MFMA32(vt[nv][0], xs0, acc[nv]); acc[nv] = MFMA32(vt[nv][1], xs1, acc[nv]); }
                }
                if (sb + 1 < nsb) {
                    LAS unsigned char* knx = Ks + ((sb + 1) & 1) * RQ_KBYTES;
#pragma unroll
                    for (int i = 0; i < 2; ++i) *(LAS bf16x8*)(knx + stlds + i * 16 * RQ_RS) = kst[i];
                }
                __syncthreads();
            }
            float ss = 0.f;
#pragma unroll
            for (int nv = 0; nv < 8; ++nv)
#pragma unroll
                for (int i = 0; i < 16; ++i) ss += acc[nv][i] * acc[nv][i];
            ss += __shfl_xor(ss, 32);
            LAS float* sx = (LAS float*)(lds + 8 * 16896);
            if (hh == 0) sx[vh * 128 + tsub * 32 + r] = ss;
            __syncthreads();
            const float rs = rsqrtf((sx[tsub * 32 + r] + sx[128 + tsub * 32 + r]) * (1.f / 512.f) + EPS);
            LAS unsigned char* ot = lds + w * 16896;
#pragma unroll
            for (int nv = 0; nv < 8; ++nv)
#pragma unroll
                for (int g = 0; g < 4; ++g) {
                    u32x2 o; o.x = pk2(acc[nv][4 * g] * rs, acc[nv][4 * g + 1] * rs); o.y = pk2(acc[nv][4 * g + 2] * rs, acc[nv][4 * g + 3] * rs);
                    *(LAS u32x2*)(ot + r * 528 + (nv * 32 + 8 * g + 4 * hh) * 2) = o;
                }
            bf16* orow = ORET + (size_t)(b * SEQ + pos0 + tsub * 32) * 2048 + h * 512 + vh * 256;
#pragma unroll 4
            for (int k = 0; k < 16; ++k) {
                const int row = 2 * k + (lane >> 5), ch = lane & 31;
                const u32x4 val = *(const LAS u32x4*)(ot + row * 528 + ch * 16);
                bf16* gp = orow + (size_t)row * 2048 + ch * 8;
                const u32x4 gt = *(const u32x4*)gp;
                u32x4 o;
                o.x = pk2(bflo(val.x) * bflo(gt.x), bfhi(val.x) * bfhi(gt.x)); o.y = pk2(bflo(val.y) * bflo(gt.y), bfhi(val.y) * bfhi(gt.y));
                o.z = pk2(bflo(val.z) * bflo(gt.z), bfhi(val.z) * bfhi(gt.z)); o.w = pk2(bflo(val.w) * bflo(gt.w), bfhi(val.w) * bfhi(gt.w));
                if (!dry) *(u32x4*)gp = o; else asm volatile("" :: "v"(o));
            }
        }
    }
    __syncthreads();
}

DI float dot2bf(unsigned a, unsigned b, float c) {
#if __has_builtin(__builtin_amdgcn_fdot2_f32_bf16)
    typedef __bf16 nb2 __attribute__((ext_vector_type(2)));
    return __builtin_amdgcn_fdot2_f32_bf16(__builtin_bit_cast(nb2, a), __builtin_bit_cast(nb2, b), c, false);
#else
    return c + bflo(a) * bflo(b) + bfhi(a) * bfhi(b);
#endif
}
DI void wave_argmax(float& v, int& idx) {
#pragma unroll
    for (int o = 1; o < 64; o <<= 1) {
        const float ov = __shfl_xor(v, o); const int oi = __shfl_xor(idx, o);
        if (ov > v || (ov == v && oi < idx)) { v = ov; idx = oi; }
    }
}

DI void peer_topk1(const bf16* Q, const bf16* SK, float* TOPS, int* TOPI, int wg, int nwg) {
    const int tid = fresh_tid(), lane = tid & 63, w = __builtin_amdgcn_readfirstlane(tid >> 6);
    for (int unit = wg; unit < 16 * 16; unit += nwg) {
        const int hp = unit & 15, tblk = unit >> 4;
        unsigned k0[64], k1[64];
        {
            const u32x4* p0 = (const u32x4*)(SK + ((size_t)(hp * 128 + lane)) * 128);
            const u32x4* p1 = (const u32x4*)(SK + ((size_t)(hp * 128 + 64 + lane)) * 128);
#pragma unroll
            for (int i = 0; i < 16; ++i) { const u32x4 a = p0[i], b = p1[i]; k0[4 * i] = a.x; k0[4 * i + 1] = a.y; k0[4 * i + 2] = a.z; k0[4 * i + 3] = a.w; k1[4 * i] = b.x; k1[4 * i + 1] = b.y; k1[4 * i + 2] = b.z; k1[4 * i + 3] = b.w; }
        }
        for (int tt = 0; tt < 128; ++tt) {
            const int t = tblk * 1024 + w * 128 + tt;
            const u32x4* qp = (const u32x4*)(Q + (size_t)t * 2048 + hp * 128);
            float s0 = 0.f, s1 = 0.f;
#pragma unroll
            for (int i = 0; i < 16; ++i) {
                const u32x4 qv = qp[i];
                s0 = dot2bf(k0[4 * i], qv.x, s0); s0 = dot2bf(k0[4 * i + 1], qv.y, s0); s0 = dot2bf(k0[4 * i + 2], qv.z, s0); s0 = dot2bf(k0[4 * i + 3], qv.w, s0);
                s1 = dot2bf(k1[4 * i], qv.x, s1); s1 = dot2bf(k1[4 * i + 1], qv.y, s1); s1 = dot2bf(k1[4 * i + 2], qv.z, s1); s1 = dot2bf(k1[4 * i + 3], qv.w, s1);
            }
            float myv = 0.f; int myi = 0;
            for (int rnd = 0; rnd < 16; ++rnd) {
                float v; int idx;
                if (s0 >= s1) { v = s0; idx = lane; } else { v = s1; idx = lane + 64; }
                wave_argmax(v, idx);
                if (idx == lane) s0 = -3.0e38f;
                if (idx == lane + 64) s1 = -3.0e38f;
                if (lane == rnd) { myv = v; myi = idx; }
            }
            if (lane < 16) { TOPS[((size_t)t * 16 + hp) * 16 + lane] = myv; TOPI[((size_t)t * 16 + hp) * 16 + lane] = myi; }
        }
    }
}

DI void peer_cand(const float* TOPS, const int* TOPI, int* EIDX, float* EGATE, int gw, int ngw) {
    const int lane = fresh_tid() & 63;
    for (int unit = gw; unit < T * PE_H; unit += ngw) {
        const int t = unit >> 3, h = unit & 7;
        const float* s1p = TOPS + ((size_t)t * 16 + h * 2) * 16;
        const int i1 = lane >> 2, j0 = (lane & 3) * 4;
        const float a = s1p[i1];
        const f32x4 bq = *(const f32x4*)(s1p + 16 + j0);
        float c0 = a + bq[0], c1 = a + bq[1], c2 = a + bq[2], c3 = a + bq[3];
        float myv = 0.f; int myc = 0;
        for (int rnd = 0; rnd < 16; ++rnd) {
            float v = c0; int idx = 4 * lane;
            if (c1 > v) { v = c1; idx = 4 * lane + 1; }
            if (c2 > v) { v = c2; idx = 4 * lane + 2; }
            if (c3 > v) { v = c3; idx = 4 * lane + 3; }
            wave_argmax(v, idx);
            if (idx == 4 * lane) c0 = -3.0e38f;
            if (idx == 4 * lane + 1) c1 = -3.0e38f;
            if (idx == 4 * lane + 2) c2 = -3.0e38f;
            if (idx == 4 * lane + 3) c3 = -3.0e38f;
            if (lane == rnd) { myv = v; myc = idx; }
        }
        const float mx = __shfl(myv, 0);
        float ex = lane < 16 ? __expf(myv - mx) : 0.f;
        float sum = ex;
#pragma unroll
        for (int o = 1; o < 16; o <<= 1) sum += __shfl_xor(sum, o);
        if (lane < 16) {
            const int ci = myc >> 4, cj = myc & 15;
            const int e = TOPI[((size_t)t * 16 + h * 2) * 16 + ci] * PE_NK + TOPI[((size_t)t * 16 + h * 2 + 1) * 16 + cj];
            EIDX[(size_t)t * 128 + h * 16 + lane] = e;
            EGATE[(size_t)t * 128 + h * 16 + lane] = ex / sum;
        }
    }
}


DI unsigned key_pack(float s, unsigned lowbits, unsigned mask) {
    unsigned u = __float_as_uint(s); u = (u & 0x80000000u) ? ~u : (u | 0x80000000u);
    return (u & ~mask) | lowbits;
}
DI float key_val(unsigned k, unsigned mask) { unsigned u = k & ~mask; u = (u & 0x80000000u) ? (u & 0x7fffffffu) : ~u; return __uint_as_float(u); }
DI unsigned umin_(unsigned a, unsigned b) { return a < b ? a : b; }
DI unsigned umax_(unsigned a, unsigned b) { return a > b ? a : b; }
DI void ins16(unsigned (&t)[16], unsigned x) {
#pragma unroll
    for (int i = 15; i >= 1; --i) t[i] = umax_(umin_(t[i - 1], t[i]), umin_(umax_(t[i - 1], t[i]), x));
    t[0] = umax_(t[0], x);
}
DI void peer_retrieve(LAS unsigned char* lds, const bf16* Q, const bf16* SK, int* EIDX, float* EGATE, int gw, int ngw) {
    const int tid = fresh_tid(), lane = tid & 63, w = __builtin_amdgcn_readfirstlane(tid >> 6), r = lane & 31, hh = lane >> 5;
    LAS unsigned char* myl = lds + w * 2304 + lane * 36;
    for (int unit = gw; unit < (T / 32) * PE_H; unit += ngw) {
        const int h = unit & 7, tb = unit >> 3;
        const size_t trow = (size_t)(tb * 32 + r);
        unsigned L[2][16];
#pragma unroll
        for (int p = 0; p < 2; ++p) {
            f32x16 acc[4];
#pragma unroll
            for (int mt = 0; mt < 4; ++mt) acc[mt] = zero16();
            const bf16* qrow = Q + trow * 2048 + h * 256 + p * 128 + 8 * hh;
            const bf16* krow = SK + ((size_t)((h * 2 + p) * 128 + r)) * 128 + 8 * hh;
            asm volatile("" : "+v"(krow), "+v"(qrow));
#pragma unroll
            for (int kk = 0; kk < 8; ++kk) {
                const bf16x8 qf = ldg16(qrow + kk * 16);
#pragma unroll
                for (int mt = 0; mt < 4; ++mt) acc[mt] = MFMA32(ldg16(krow + mt * 32 * 128 + kk * 16), qf, acc[mt]);
                if (kk & 1) __builtin_amdgcn_sched_barrier(0);
            }
            unsigned t[16];
#pragma unroll
            for (int i = 0; i < 16; ++i) t[i] = 0u;
#pragma unroll
            for (int mt = 0; mt < 4; ++mt)
#pragma unroll
                for (int i = 0; i < 16; ++i) ins16(t, key_pack(acc[mt][i], (unsigned)(127 - 32 * mt - (i & 3) - 8 * (i >> 2)) - 4u * (unsigned)hh, 127u));
            unsigned o[16];
#pragma unroll
            for (int i = 0; i < 16; ++i) o[i] = (unsigned)__shfl_xor((int)t[i], 32);
#pragma unroll
            for (int i = 0; i < 16; ++i) ins16(t, o[i]);
#pragma unroll
            for (int i = 0; i < 16; ++i) L[p][i] = t[i];
        }
#pragma unroll
        for (int p = 0; p < 2; ++p)
#pragma unroll
            for (int g = 0; g < 4; ++g) {
                const unsigned v = (127u - (L[p][4 * g] & 127u)) | ((127u - (L[p][4 * g + 1] & 127u)) << 8) | ((127u - (L[p][4 * g + 2] & 127u)) << 16) | ((127u - (L[p][4 * g + 3] & 127u)) << 24);
                *(LAS unsigned*)(myl + p * 16 + g * 4) = v;
            }
        float a[16], b[16];
#pragma unroll
        for (int i = 0; i < 16; ++i) { a[i] = key_val(L[0][i], 127u); b[i] = key_val(L[1][i], 127u); }
        unsigned c[16];
#pragma unroll
        for (int i = 0; i < 16; ++i) c[i] = 0u;
#pragma unroll
        for (int i = 0; i < 16; ++i)
#pragma unroll
            for (int j = 0; j < 16; ++j)
                if ((i + 1) * (j + 1) <= 16) ins16(c, key_pack(a[i] + b[j], (unsigned)(255 - (16 * i + j)), 255u));
        float v[16];
        float sum = 0.f;
        const float mx = key_val(c[0], 255u);
#pragma unroll
        for (int k = 0; k < 16; ++k) { v[k] = __expf(key_val(c[k], 255u) - mx); sum += v[k]; }
        const float inv = 1.f / sum;
        asm volatile("s_waitcnt lgkmcnt(0)" ::: "memory");
        if (hh == 0) {
            int e[16];
#pragma unroll
            for (int k = 0; k < 16; ++k) {
                const unsigned cc = 255u - (c[k] & 255u);
                const unsigned i1 = *(LAS unsigned char*)(myl + (cc >> 4)), i2 = *(LAS unsigned char*)(myl + 16 + (cc & 15u));
                e[k] = (int)(i1 * 128u + i2);
            }
            int* ep = EIDX + trow * 128 + h * 16;
#pragma unroll
            for (int g = 0; g < 4; ++g) *(u32x4*)(ep + 4 * g) = (u32x4){(unsigned)e[4 * g], (unsigned)e[4 * g + 1], (unsigned)e[4 * g + 2], (unsigned)e[4 * g + 3]};
        } else {
            float* gp = EGATE + trow * 128 + h * 16;
#pragma unroll
            for (int g = 0; g < 4; ++g) *(f32x4*)(gp + 4 * g) = (f32x4){v[4 * g] * inv, v[4 * g + 1] * inv, v[4 * g + 2] * inv, v[4 * g + 3] * inv};
        }
        asm volatile("s_waitcnt lgkmcnt(0)" ::: "memory");
    }
}

DI float gelu_tanh(float x) {
    const float u = 0.7978845608028654f * (x + 0.044715f * x * x * x);
    const float e = __expf(2.f * u);
    const float th = 1.f - 2.f / (e + 1.f);
    return 0.5f * x * (1.f + th);
}

DI float bcast_f(float v, int j) { return __int_as_float(__builtin_amdgcn_readfirstlane(__float_as_int(__shfl(v, j)))); }
DI void quant_rows(const float* src, unsigned char* dst, float* scale, int nrows, int offs, int gw, int ngw, int lane) {
    for (int row = gw; row < nrows; row += ngw) {
        const f32x4* p = (const f32x4*)(src + (size_t)row * 1024 + lane * 16);
        f32x4 v[4]; float am = 0.f;
#pragma unroll
        for (int i = 0; i < 4; ++i) { v[i] = p[i];
#pragma unroll
            for (int e = 0; e < 4; ++e) am = fmaxf(am, fabsf(v[i][e])); }
#pragma unroll
        for (int o = 1; o < 64; o <<= 1) am = fmaxf(am, __shfl_xor(am, o));
        const float inv = am > 0.f ? 127.f / am : 0.f;
        u32x4 w;
#pragma unroll
        for (int i = 0; i < 4; ++i) {
            unsigned pk = 0u;
#pragma unroll
            for (int e = 0; e < 4; ++e) { const int q = (int)rintf(v[i][e] * inv) + offs; pk |= ((unsigned)q & 0xffu) << (8 * e); }
            w[i] = pk;
        }
        *(u32x4*)(dst + ((size_t)(lane >> 3) * nrows + row) * 128 + (lane & 7) * 16) = w;
        if (lane == 0) scale[row] = am > 0.f ? am * (1.f / 127.f) : 0.f;
    }
}
DI void quant_xw(const bf16* XW, unsigned char* XQ8, float* XS, int gw, int ngw, int lane) {
    for (int t = gw; t < T; t += ngw) {
        const u32x4 xa = *(const u32x4*)(XW + (size_t)t * 1024 + lane * 16), xb = *(const u32x4*)(XW + (size_t)t * 1024 + lane * 16 + 8);
        float xf[16] = {bflo(xa.x), bfhi(xa.x), bflo(xa.y), bfhi(xa.y), bflo(xa.z), bfhi(xa.z), bflo(xa.w), bfhi(xa.w),
                        bflo(xb.x), bfhi(xb.x), bflo(xb.y), bfhi(xb.y), bflo(xb.z), bfhi(xb.z), bflo(xb.w), bfhi(xb.w)};
        float am = 0.f;
#pragma unroll
        for (int i = 0; i < 16; ++i) am = fmaxf(am, fabsf(xf[i]));
#pragma unroll
        for (int o = 1; o < 64; o <<= 1) am = fmaxf(am, __shfl_xor(am, o));
        const float inv = am > 0.f ? 127.f / am : 0.f;
        u32x4 w;
#pragma unroll
        for (int i = 0; i < 4; ++i) { unsigned pk = 0u;
#pragma unroll
            for (int e = 0; e < 4; ++e) pk |= ((unsigned)((int)rintf(xf[4 * i + e] * inv)) & 0xffu) << (8 * e);
            w[i] = pk; }
        *(u32x4*)(XQ8 + ((size_t)(lane >> 3) * T + t) * 128 + (lane & 7) * 16) = w;
        if (lane == 0) XS[t] = am * (1.f / 127.f);
    }
}
DI int dpp_xor1(int v) { return __builtin_amdgcn_update_dpp(0, v, 0xB1, 0xF, 0xF, false); }
DI int dpp_xor2(int v) { return __builtin_amdgcn_update_dpp(0, v, 0x4E, 0xF, 0xF, false); }
DI int dpp_hmir(int v) { return __builtin_amdgcn_update_dpp(0, v, 0x141, 0xF, 0xF, false); }
DI void peer_u(const unsigned char* EU8, const unsigned char* XQ8, const int* EIDX, int* PART, int slice, int tok0, int tokstep, int lane) {
    const int q = lane >> 3, i = lane & 7;
    const unsigned char* tab = EU8 + (size_t)slice * PE_NE * 128 + i * 16;
#define PU_LOAD(dst, t_) do { const u32x4* ep_ = (const u32x4*)(EIDX + (size_t)(t_) * 128 + 16 * q); const u32x4 e0_ = ep_[0], e1_ = ep_[1], e2_ = ep_[2], e3_ = ep_[3]; \
        const unsigned ee_[16] = {e0_.x, e0_.y, e0_.z, e0_.w, e1_.x, e1_.y, e1_.z, e1_.w, e2_.x, e2_.y, e2_.z, e2_.w, e3_.x, e3_.y, e3_.z, e3_.w}; \
        _Pragma("unroll") for (int g = 0; g < 16; ++g) dst[g] = *(const u32x4*)(tab + (size_t)ee_[g] * 128); } while (0)
    u32x4 ub[16], nb[16];
    if (tok0 < T) PU_LOAD(ub, tok0);
    for (int t = tok0; t < T; t += tokstep) {
        const u32x4 xv = *(const u32x4*)(XQ8 + ((size_t)slice * T + t) * 128 + i * 16);
        if (t + tokstep < T) PU_LOAD(nb, t + tokstep);
        int d0 = 0, d1 = 0;
#pragma unroll
        for (int g = 0; g < 16; ++g) {
            int s = __builtin_amdgcn_sdot4((int)ub[g].x, (int)xv.x, 0, false);
            s = __builtin_amdgcn_sdot4((int)ub[g].y, (int)xv.y, s, false); s = __builtin_amdgcn_sdot4((int)ub[g].z, (int)xv.z, s, false); s = __builtin_amdgcn_sdot4((int)ub[g].w, (int)xv.w, s, false);
            s += dpp_xor1(s); s += dpp_xor2(s); s += dpp_hmir(s);
            if (g < 8) { if (i == g) d0 = s; } else { if (i == g - 8) d1 = s; }
        }
        int* pp = PART + ((size_t)slice * T + t) * 128 + 16 * q + i;
        pp[0] = d0; pp[8] = d1;
#pragma unroll
        for (int g = 0; g < 16; ++g) ub[g] = nb[g];
    }
#undef PU_LOAD
}
DI void peer_w(const int* PART, const int* EIDX, const float* EGATE, const float* SU, const float* SV, const float* XS, const float* SSQX, float* WT, size_t gtid, size_t gsz) {
    for (size_t idx = gtid; idx < (size_t)T * 128; idx += gsz) {
        const int t = (int)(idx >> 7);
        int dsum = 0;
#pragma unroll
        for (int s = 0; s < 8; ++s) dsum += PART[(size_t)s * T * 128 + idx];
        const int e = EIDX[idx];
        const float sc = XS[t] * rstd_x1(SSQX, (size_t)t);
        WT[idx] = EGATE[idx] * SV[e] * gelu_tanh((float)dsum * (SU[e] * sc));
    }
}
DI unsigned perm_(unsigned s0, unsigned s1, unsigned sel) { return __builtin_amdgcn_perm(s0, s1, sel); }
DI void peer_v(const unsigned char* EV8, const int* EIDX, const float* WT, float* X1, int slice, int tok0, int tokstep, int lane, int dry) {
    const int q = lane >> 3, i = lane & 7;
    const unsigned char* tab = EV8 + (size_t)slice * PE_NE * 128 + i * 16;
#define PV_LOAD(dst, t_) do { const u32x4* ep_ = (const u32x4*)(EIDX + (size_t)(t_) * 128 + 16 * q); const u32x4 e0_ = ep_[0], e1_ = ep_[1], e2_ = ep_[2], e3_ = ep_[3]; \
        const unsigned ee_[16] = {e0_.x, e0_.y, e0_.z, e0_.w, e1_.x, e1_.y, e1_.z, e1_.w, e2_.x, e2_.y, e2_.z, e2_.w, e3_.x, e3_.y, e3_.z, e3_.w}; \
        _Pragma("unroll") for (int g = 0; g < 16; ++g) dst[g] = *(const u32x4*)(tab + (size_t)ee_[g] * 128); } while (0)
    u32x4 vb[16], nb[16];
    if (tok0 < T) PV_LOAD(vb, tok0);
    for (int t = tok0; t < T; t += tokstep) {
        const f32x4* wp = (const f32x4*)(WT + (size_t)t * 128 + 16 * q);
        const f32x4 w0 = wp[0], w1 = wp[1], w2 = wp[2], w3 = wp[3];
        if (t + tokstep < T) PV_LOAD(nb, t + tokstep);
        const float ww[16] = {w0[0], w0[1], w0[2], w0[3], w1[0], w1[1], w1[2], w1[3], w2[0], w2[1], w2[2], w2[3], w3[0], w3[1], w3[2], w3[3]};
        float am = 0.f;
#pragma unroll
        for (int g = 0; g < 16; ++g) am = fmaxf(am, fabsf(ww[g]));
        am = fmaxf(am, __shfl_xor(am, 8)); am = fmaxf(am, __shfl_xor(am, 16)); am = fmaxf(am, __shfl_xor(am, 32));
        const float inv = am > 0.f ? 127.f / am : 0.f, wsc = am * (1.f / 127.f);
        int wq[4];
#pragma unroll
        for (int m = 0; m < 4; ++m) { unsigned pk = 0u;
#pragma unroll
            for (int e = 0; e < 4; ++e) pk |= ((unsigned)((int)rintf(ww[4 * m + e] * inv)) & 0xffu) << (8 * e);
            wq[m] = (int)pk; }
        int o[16];
#pragma unroll
        for (int c = 0; c < 16; ++c) o[c] = 0;
#pragma unroll
        for (int m = 0; m < 4; ++m) {
#pragma unroll
            for (int k = 0; k < 4; ++k) {
                const unsigned a = vb[4 * m][k], b = vb[4 * m + 1][k], c = vb[4 * m + 2][k], dd = vb[4 * m + 3][k];
                const unsigned ablo = perm_(b, a, 0x05010400u), abhi = perm_(b, a, 0x07030602u), cdlo = perm_(dd, c, 0x05010400u), cdhi = perm_(dd, c, 0x07030602u);
                o[4 * k + 0] = __builtin_amdgcn_sdot4((int)perm_(cdlo, ablo, 0x05040100u), wq[m], o[4 * k + 0], false);
                o[4 * k + 1] = __builtin_amdgcn_sdot4((int)perm_(cdlo, ablo, 0x07060302u), wq[m], o[4 * k + 1], false);
                o[4 * k + 2] = __builtin_amdgcn_sdot4((int)perm_(cdhi, abhi, 0x05040100u), wq[m], o[4 * k + 2], false);
                o[4 * k + 3] = __builtin_amdgcn_sdot4((int)perm_(cdhi, abhi, 0x07060302u), wq[m], o[4 * k + 3], false);
            }
        }
        int r8[8], r4[4], r2[2];
#pragma unroll
        for (int c = 0; c < 8; ++c) { const int mine = (q & 4) ? o[c + 8] : o[c], theirs = (q & 4) ? o[c] : o[c + 8]; r8[c] = mine + __shfl_xor(theirs, 32); }
#pragma unroll
        for (int c = 0; c < 4; ++c) { const int mine = (q & 2) ? r8[c + 4] : r8[c], theirs = (q & 2) ? r8[c] : r8[c + 4]; r4[c] = mine + __shfl_xor(theirs, 16); }
#pragma unroll
        for (int c = 0; c < 2; ++c) { const int mine = (q & 1) ? r4[c + 2] : r4[c], theirs = (q & 1) ? r4[c] : r4[c + 2]; r2[c] = mine + __shfl_xor(theirs, 8); }
        float* xp = X1 + (size_t)t * 1024 + slice * 128 + i * 16 + 2 * q;
        f32x2 xv = *(const f32x2*)xp;
        xv[0] += (float)r2[0] * wsc; xv[1] += (float)r2[1] * wsc;
        if (!dry) *(f32x2*)xp = xv; else asm volatile("" :: "v"(xv));
#pragma unroll
        for (int g = 0; g < 16; ++g) vb[g] = nb[g];
    }
#undef PV_LOAD
}
DI void final_norm(const float* Y, const float* fw, float* OUT, int gw, int ngw, int lane) {
    for (int t = gw; t < T; t += ngw) {
        const f32x4* yr = (const f32x4*)(Y + (size_t)t * 1024) + lane; const f32x4* wr4 = (const f32x4*)fw + lane;
        f32x4 v[4]; float s = 0.f;
#pragma unroll
        for (int j = 0; j < 4; ++j) { v[j] = yr[64 * j]; s += (v[j][0] * v[j][0] + v[j][1] * v[j][1]) + (v[j][2] * v[j][2] + v[j][3] * v[j][3]); }
        const float rs = rsqrtf(wave_sum(s) * (1.f / 1024.f) + EPS);
        f32x4* o = (f32x4*)(OUT + (size_t)t * 1024) + lane;
#pragma unroll
        for (int j = 0; j < 4; ++j) { const f32x4 ww = wr4[64 * j]; o[64 * j] = (f32x4){v[j][0] * rs * ww[0], v[j][1] * rs * ww[1], v[j][2] * rs * ww[2], v[j][3] * rs * ww[3]}; }
    }
}

DI void transpose_item(const float* W, int K, int N, bf16* WT, int n_src0, int n_dst0, int k0, LAS float* scr, int lane) {
#pragma unroll 8
    for (int i = 0; i < 32; ++i) { const int kk = 2 * i + (lane >> 5); scr[kk * 33 + (lane & 31)] = W[(size_t)(k0 + kk) * N + n_src0 + (lane & 31)]; }
    asm volatile("s_waitcnt lgkmcnt(0)" ::: "memory");
    const int c = lane & 7;
#pragma unroll
    for (int j = 0; j < 4; ++j) { const int n = (lane >> 3) + 8 * j; const LAS float* s = scr + (8 * c) * 33 + n;
        u32x4 o; o.x = pk2(s[0 * 33], s[1 * 33]); o.y = pk2(s[2 * 33], s[3 * 33]); o.z = pk2(s[4 * 33], s[5 * 33]); o.w = pk2(s[6 * 33], s[7 * 33]);
        *(u32x4*)(WT + (size_t)(n_dst0 + n) * K + k0 + 8 * c) = o; }
    asm volatile("s_waitcnt lgkmcnt(0)" ::: "memory");
}
DI int win_orig_col(int np) {
    if (np < 2048) { const int h = np >> 8, sel = (np >> 7) & 1, d = np & 127; return sel * 1024 + h * 128 + d; }
    return np;
}
DI void rmsnorm_row_bf16(const float* xrow, const float* w, bf16* orow, int lane) {
    const f32x4* xr = (const f32x4*)xrow + lane; const f32x4* wr4 = (const f32x4*)w + lane;
    f32x4 v[4]; float s = 0.f;
#pragma unroll
    for (int j = 0; j < 4; ++j) { v[j] = xr[64 * j]; s += (v[j][0] * v[j][0] + v[j][1] * v[j][1]) + (v[j][2] * v[j][2] + v[j][3] * v[j][3]); }
    const float rs = rsqrtf(wave_sum(s) * (1.f / 1024.f) + EPS);
    u32x2* o8 = (u32x2*)orow + lane;
#pragma unroll
    for (int j = 0; j < 4; ++j) { const f32x4 ww = wr4[64 * j]; u32x2 o; o.x = pk2(v[j][0] * rs * ww[0], v[j][1] * rs * ww[1]); o.y = pk2(v[j][2] * rs * ww[2], v[j][3] * rs * ww[3]); o8[64 * j] = o; }
}
DI void transpose_item_q8(const float* W, int N, unsigned char* WT8, const unsigned* amaxu, float* SB, int n_src0, int n_dst0, int k0, bool first_kb, LAS float* scr, int lane) {
#pragma unroll 8
    for (int i = 0; i < 32; ++i) { const int kk = 2 * i + (lane >> 5); scr[kk * 33 + (lane & 31)] = W[(size_t)(k0 + kk) * N + n_src0 + (lane & 31)]; }
    asm volatile("s_waitcnt lgkmcnt(0)" ::: "memory");
    const int c = lane & 3;
#pragma unroll
    for (int j = 0; j < 2; ++j) {
        const int n = (lane >> 2) + 16 * j;
        const float am = __uint_as_float(amaxu[n_src0 + n]), inv = am > 0.f ? 127.f / am : 0.f;
        const LAS float* s = scr + (16 * c) * 33 + n;
        u32x4 o;
#pragma unroll
        for (int g = 0; g < 4; ++g) { unsigned pk = 0u;
#pragma unroll
            for (int e2 = 0; e2 < 4; ++e2) pk |= ((unsigned)((int)rintf(s[(4 * g + e2) * 33] * inv)) & 0xffu) << (8 * e2);
            o[g] = pk; }
        *(u32x4*)(WT8 + (size_t)(n_dst0 + n) * 1024 + k0 + 16 * c) = o;
        if (first_kb && c == 0) SB[n_dst0 + n] = am * (1.f / 127.f);
    }
    asm volatile("s_waitcnt lgkmcnt(0)" ::: "memory");
}
DI void rmsnorm_row_q8(const float* xrow, const float* w, unsigned char* orow, float* sa, int lane) {
    const f32x4* xr = (const f32x4*)xrow + lane; const f32x4* wr4 = (const f32x4*)w + lane;
    f32x4 v[4]; float s = 0.f;
#pragma unroll
    for (int j = 0; j < 4; ++j) { v[j] = xr[64 * j]; s += (v[j][0] * v[j][0] + v[j][1] * v[j][1]) + (v[j][2] * v[j][2] + v[j][3] * v[j][3]); }
    const float rs = rsqrtf(wave_sum(s) * (1.f / 1024.f) + EPS);
    float am = 0.f;
#pragma unroll
    for (int j = 0; j < 4; ++j) { const f32x4 ww = wr4[64 * j];
#pragma unroll
        for (int e2 = 0; e2 < 4; ++e2) { v[j][e2] = v[j][e2] * rs * ww[e2]; am = fmaxf(am, fabsf(v[j][e2])); } }
#pragma unroll
    for (int o = 1; o < 64; o <<= 1) am = fmaxf(am, __shfl_xor(am, o));
    const float inv = am > 0.f ? 127.f / am : 0.f;
    unsigned* o4 = (unsigned*)orow + lane;
#pragma unroll
    for (int j = 0; j < 4; ++j) { unsigned pk = 0u;
#pragma unroll
        for (int e2 = 0; e2 < 4; ++e2) pk |= ((unsigned)((int)rintf(v[j][e2] * inv)) & 0xffu) << (8 * e2);
        o4[64 * j] = pk; }
    if (lane == 0) *sa = am * (1.f / 127.f);
}
DI void convert_bf16(const float* src, bf16* dst, size_t n, size_t gtid, size_t gsz) {
    for (size_t i = gtid * 8; i < n; i += gsz * 8) {
        const f32x4 a = *(const f32x4*)(src + i), b = *(const f32x4*)(src + i + 4);
        *(u32x4*)(dst + i) = pack8(a, b);
    }
}

#define XB_TMO      128
#define XB_XCNT(j)  (256  + 64 * (j))
#define XB_XSUB(j)  (1280 + 64 * (j))
#define XB_XGEN(j)  (2304 + 64 * (j))
#define XB_TOP      3328
#define XB_TOPGEN   3392
#define XCD_BAR_WORDS 3456
#define XB_SPIN_CAP (1u << 18)

__device__ __forceinline__ unsigned xb_ld(unsigned* p)              { return __hip_atomic_load(p, __ATOMIC_RELAXED, __HIP_MEMORY_SCOPE_AGENT); }
__device__ __forceinline__ unsigned xb_add(unsigned* p, unsigned v) { return __hip_atomic_fetch_add(p, v, __ATOMIC_RELAXED, __HIP_MEMORY_SCOPE_AGENT); }
__device__ __forceinline__ unsigned xb_xcc_id() { return (unsigned)__builtin_amdgcn_s_getreg((3 << 11) | 20) & 0xFu; }
#define XB_SPIN(cond, bar) do { unsigned _sp = 0; while (cond) { __builtin_amdgcn_s_sleep(1); \
    if ((++_sp & 255u) == 0u) { if (xb_ld(&(bar)[XB_TMO])) break; if (_sp > XB_SPIN_CAP) { atomicAdd(&(bar)[XB_TMO], 1u); break; } } } } while (0)

struct XcdBarrier {
    unsigned* bar; unsigned x;
    volatile LAS unsigned* st;
};

__device__ __forceinline__ XcdBarrier xcd_barrier_post(unsigned* bar, volatile LAS unsigned* st) {
    XcdBarrier b; b.bar = bar; b.x = xb_xcc_id(); b.st = st;
    if (threadIdx.x == 0) (void)xb_add(&bar[XB_XCNT(b.x)], 1u);
    return b;
}
__device__ __forceinline__ void xcd_barrier_complete(unsigned* bar, unsigned x, unsigned& nloc, unsigned& nx) {
    const unsigned G = gridDim.x * gridDim.y * gridDim.z;
    unsigned sum, cnt, mine, sp = 0u;
    for (;;) {
        sum = 0u; cnt = 0u; mine = 0u;
#pragma unroll
        for (unsigned j = 0; j < 16; ++j) { const unsigned c = xb_ld(&bar[XB_XCNT(j)]); sum += c; cnt += (c > 0u) ? 1u : 0u; mine = (j == x) ? c : mine; }
        if (sum == G) break;
        __builtin_amdgcn_s_sleep(1);
        if ((++sp & 255u) == 0u) { if (xb_ld(&bar[XB_TMO])) break; if (sp > XB_SPIN_CAP) { atomicAdd(&bar[XB_TMO], 1u); break; } }
    }
    nloc = mine > 0u ? mine : 1u; nx = cnt > 0u ? cnt : 1u;
}

__device__ __forceinline__ void xcd_barrier(const XcdBarrier& b) {
    asm volatile("s_waitcnt vmcnt(0)" ::: "memory");
    __syncthreads();
    if (threadIdx.x == 0) {
        unsigned* bar = b.bar;
        __builtin_amdgcn_s_waitcnt(0);
        unsigned nloc = b.st[0], nx = b.st[1];
        if (nloc == 0u) { xcd_barrier_complete(bar, b.x, nloc, nx); b.st[0] = nloc; b.st[1] = nx; }
        const unsigned old = xb_add(&bar[XB_XSUB(b.x)], 1u);
        const unsigned gen = old / nloc;
        if (old + 1u == (gen + 1u) * nloc) {
            __builtin_amdgcn_fence(__ATOMIC_RELEASE, "agent");
            asm volatile("s_waitcnt vmcnt(0)" ::: "memory");
            const unsigned og = xb_add(&bar[XB_TOP], 1u);
            const unsigned tg = og / nx;
            if (og + 1u == (tg + 1u) * nx) xb_add(&bar[XB_TOPGEN], 1u);
            else XB_SPIN(xb_ld(&bar[XB_TOPGEN]) == tg, bar);
            __builtin_amdgcn_fence(__ATOMIC_ACQUIRE, "agent");
            xb_add(&bar[XB_XGEN(b.x)], 1u);
            asm volatile("s_waitcnt vmcnt(0)" ::: "memory");
        } else {
            XB_SPIN(xb_ld(&bar[XB_XGEN(b.x)]) == gen, bar);
            __builtin_amdgcn_fence(__ATOMIC_ACQUIRE, "agent");
            asm volatile("s_waitcnt vmcnt(0)" ::: "memory");
        }
    }
    __syncthreads();
}

struct Params { const float* in[14]; float* out; unsigned char* ws; };

__global__ void __launch_bounds__(NTHREADS, 2) fwd_megakernel(Params p) {
    extern __shared__ __attribute__((aligned(16))) unsigned char lds_raw[];
    LAS unsigned char* lds = (LAS unsigned char*)lds_raw;
    cg::grid_group grid = cg::this_grid();
    volatile LAS unsigned* bst = (volatile LAS unsigned*)(lds + LDS_BYTES - 64);
    if (threadIdx.x < 4) bst[threadIdx.x] = 0u;
    __syncthreads();
    XcdBarrier xbar = xcd_barrier_post((unsigned*)(p.ws + WS_CTL), bst);
    if (threadIdx.x == 0) bst[4] = xb_add((unsigned*)(p.ws + WS_CTL) + 3600 + xbar.x, 1u);
#if USE_CG_SYNC
#define GRID_SYNC() grid.sync()
#else
#define GRID_SYNC() xcd_barrier(xbar)
#endif
    const int G = gridDim.x, wg = blockIdx.x;
#define PHASE_IDS const int tid = fresh_tid(), lane = tid & 63, wave = __builtin_amdgcn_readfirstlane(tid >> 6); \
    const int gw = wg * NWAVES + wave, ngw = G * NWAVES; const size_t gtid = (size_t)wg * NTHREADS + tid, gsz = (size_t)G * NTHREADS; \
    (void)lane; (void)gw; (void)ngw; (void)gtid; (void)gsz;
    unsigned char* ws = p.ws;
    const float* x = p.in[0];
    unsigned char* HN8 = ws + WS_HN; unsigned char* WinT8 = ws + WS_WINT; float* SA = (float*)(ws + WS_SA); float* SB = (float*)(ws + WS_SB);
    unsigned* AMAXU = (unsigned*)(ws + WS_CTL + CTL_AMAX);
    float* COS = (float*)(ws + WS_ROPE); float* SIN = COS + 8192 * 128;
    float* DEC = (float*)(ws + WS_DEC); float* SSQP = (float*)(ws + WS_SSQP); float* SSQX = (float*)(ws + WS_SSQX);
    bf16* BA = (bf16*)(ws + WS_A); bf16* BB = (bf16*)(ws + WS_B); bf16* BC = (bf16*)(ws + WS_C);
    bf16* STh = (bf16*)(ws + WS_STH); bf16* STr = (bf16*)(ws + WS_STR);
    bf16* OHG = (bf16*)(ws + WS_OHG); bf16* ORET = (bf16*)p.out;
    bf16* GA = (bf16*)(ws + WS_GA); bf16* GB = (bf16*)(ws + WS_GB);
    bf16* WhgT = (bf16*)(ws + WS_WHG); bf16* WretT = (bf16*)(ws + WS_WRET); bf16* WoutT = (bf16*)(ws + WS_WOUT); bf16* WqT = (bf16*)(ws + WS_WQ); bf16* SK = (bf16*)(ws + WS_SK);
    unsigned char* EV8 = ws + WS_EV; unsigned char* EU8 = ws + WS_EU; float* SU = (float*)(ws + WS_SCL); float* SV = SU + PE_NE;
    float* M1 = (float*)(ws + WS_M1); bf16* MERGED = (bf16*)(ws + WS_MERGED);
    float* X1 = (float*)(ws + WS_X1); bf16* XW = (bf16*)(ws + WS_XW); bf16* Qp = (bf16*)p.out;
    unsigned char* XQ8 = ws + WS_XQ8; float* XS = (float*)(ws + WS_XS); int* PART = (int*)(ws + WS_PART); float* WT = (float*)(ws + WS_WT);
    float* TOPS = (float*)(ws + WS_TOPS); int* TOPI = (int*)(ws + WS_TOPI); int* EIDX = (int*)(ws + WS_EIDX); float* EGATE = (float*)(ws + WS_EGATE);

    for (int rep_ = 0; rep_ < ((PROBE_MASK & 32) ? 2 : 1); ++rep_) {
    { PHASE_IDS
    for (size_t it = gtid; it < (size_t)16 * 12288; it += gsz) {
        const int kb = (int)(it / 12288), col = (int)(it % 12288);
        const float* wp = p.in[2] + (size_t)(kb * 64) * 12288 + col;
        float am = 0.f;
#pragma unroll 16
        for (int k = 0; k < 64; ++k) am = fmaxf(am, fabsf(wp[(size_t)k * 12288]));
        atomicMax(AMAXU + col, __float_as_uint(am));
    }
    for (int m = gw; m < T; m += ngw) rmsnorm_row_q8(x + (size_t)m * 1024, p.in[1], HN8 + (size_t)m * 1024, SA + m, lane);
    for (size_t i = gtid; i < (size_t)8192 * 128; i += gsz) {
        const int pos = (int)(i >> 7), j = (int)(i & 127);
        const float inv = (float)exp(-(double)j * (9.210340371976184 / 128.0));
        const float ang = (float)pos * inv;
        double rev = (double)ang * 0.15915494309189535; rev -= rint(rev);
        COS[i] = __builtin_amdgcn_cosf((float)rev); SIN[i] = __builtin_amdgcn_sinf((float)rev);
    } }
    __syncthreads(); }
    grid.sync();
    { PHASE_IDS LAS float* scr = (LAS float*)(lds + wave * 16384);
    for (int it = gw; it < 16 * 384; it += ngw) {
        const int kb = it / 384, nb = it % 384;
        transpose_item_q8(p.in[2], 12288, WinT8, AMAXU, SB, win_orig_col(nb * 32), nb * 32, kb * 64, kb == 0, scr, lane);
    } }
    GRID_SYNC();

    for (int rep_ = 0; rep_ < ((PROBE_MASK & 128) ? 2 : 1); ++rep_) {
    {
        pg8::Gemm g{(const bf16*)HN8, (const bf16*)WinT8, T, 4096, 512}; pg8::StaticOrder S; S.init(T, 4096, G, wg);
        EpiH E{BA, BB, BC, DEC, p.in[3], OHG, SA, SB};
        pg8::gemm_phase<EpiH, pg8::StaticOrder, true, true, true>(lds, g, S, E);
    }
    __syncthreads(); }
    GRID_SYNC();
    hg_pass1(lds, BB, BC, STh, wg, G);
#if PROBE_MASK & 4
    hg_pass1(lds, BB, BC, STh, wg, G);
#endif
    GRID_SYNC();
    { PHASE_IDS hg_scan(STh, DEC, (int)gtid, (int)gsz); }
    GRID_SYNC();
#if PROBE_MASK & 16384
    hg_pass1(lds, BB, BC, STh, wg, G);
    GRID_SYNC();
    { PHASE_IDS hg_scan(STh, DEC, (int)gtid, (int)gsz); }
    GRID_SYNC();
#endif
#if PROBE_MASK & 4
    { PHASE_IDS hg_pass3(lds, BA, BB, BC, STh, p.in[4], OHG, gw, ngw, 1); }
#endif
    { PHASE_IDS hg_pass3(lds, BA, BB, BC, STh, p.in[4], OHG, gw, ngw, 0); }
    GRID_SYNC();

    for (int rep_ = 0; rep_ < ((PROBE_MASK & 2048) ? 2 : 1); ++rep_) {
    {
        pg8::Gemm g{(const bf16*)HN8, (const bf16*)(WinT8 + (size_t)4096 * 1024), T, 6144, 512}; pg8::StaticOrder S; S.init(T, 6144, G, wg);
        EpiR E{BA, BB, BC, COS, SIN, ORET, SA, SB + 4096};
        pg8::gemm_phase<EpiR, pg8::StaticOrder, true, true, true>(lds, g, S, E);
    }
    __syncthreads(); }
    GRID_SYNC();
    rt_pass1(lds, BB, BC, STr, wg, G);
#if PROBE_MASK & 8
    rt_pass1(lds, BB, BC, STr, wg, G);
#endif
    GRID_SYNC();
    { PHASE_IDS rt_scan(STr, (int)gtid, (int)gsz); }
    GRID_SYNC();
#if PROBE_MASK & 32768
    rt_pass1(lds, BB, BC, STr, wg, G);
    GRID_SYNC();
    { PHASE_IDS rt_scan(STr, (int)gtid, (int)gsz); }
    GRID_SYNC();
#endif
#if PROBE_MASK & 1024
    rt_pass3_wg(lds, BA, BB, BC, STr, ORET, SSQP, wg, G, 1);
#endif
    rt_pass3_wg(lds, BA, BB, BC, STr, ORET, SSQP, wg, G, 0);
    GRID_SYNC();

    for (int rep_ = 0; rep_ < ((PROBE_MASK & 64) ? 2 : 1); ++rep_) {
    { PHASE_IDS LAS float* scr = (LAS float*)(lds + wave * 16384);
    for (int it = gw; it < 3072; it += ngw) {
        int r = it;
        if (r < 512) { transpose_item(p.in[5], 1024, 1024, WhgT, (r % 32) * 32, (r % 32) * 32, (r / 32) * 64, scr, lane); continue; } r -= 512;
        if (r < 1024) { transpose_item(p.in[6], 2048, 1024, WretT, (r % 32) * 32, (r % 32) * 32, (r / 32) * 64, scr, lane); continue; } r -= 1024;
        if (r < 512) { transpose_item(p.in[7], 1024, 1024, WoutT, (r % 32) * 32, (r % 32) * 32, (r / 32) * 64, scr, lane); continue; } r -= 512;
        transpose_item(p.in[9], 1024, 2048, WqT, (r % 64) * 32, (r % 64) * 32, (r / 64) * 64, scr, lane);
    }
    convert_bf16(p.in[10], SK, (size_t)16 * 128 * 128, gtid, gsz);
    quant_rows(p.in[12], EV8, SV, PE_NE, 0, gw, ngw, lane); }
    __syncthreads(); }
    __syncthreads();
    for (int rep_ = 0; rep_ < ((PROBE_MASK & 65536) ? 2 : 1); ++rep_) {
    {
        pg8::Gemm g{(const bf16*)HN8, (const bf16*)(WinT8 + (size_t)10240 * 1024), T, 2048, 512}; pg8::StaticOrder S; S.init(T, 2048, G, wg);
        EpiG E{GA, GB, SA, SB + 10240};
        pg8::gemm_phase<EpiG, pg8::StaticOrder, true, true, true>(lds, g, S, E);
    }
    __syncthreads(); }
    GRID_SYNC();

    for (int rep_ = 0; rep_ < ((PROBE_MASK & 256) ? 2 : 1); ++rep_) {
    {
        pg8::Gemm g{OHG, WhgT, T, 1024, 1024}; pg8::StaticOrder S; S.init(T, 1024, G, wg);
        EpiM1 E{M1, GA};
        pg8::gemm_phase<EpiM1, pg8::StaticOrder, false, true>(lds, g, S, E);
    }
    __syncthreads();
    {
        pg8::Gemm g{ORET, WretT, T, 1024, 2048}; pg8::StaticOrder S; S.init(T, 1024, G, wg);
        EpiMerge E{M1, GB, MERGED};
        pg8::gemm_phase<EpiMerge, pg8::StaticOrder, false, true>(lds, g, S, E);
    }
    __syncthreads(); }
    GRID_SYNC();
    for (int rep_ = 0; rep_ < ((PROBE_MASK & 4096) ? 2 : 1); ++rep_) {
    {
        pg8::Gemm g{MERGED, WoutT, T, 1024, 1024}; pg8::StaticOrder S; S.init(T, 1024, G, wg);
        EpiOut E{x, X1, XW, p.in[8], SSQX};
        pg8::gemm_phase<EpiOut, pg8::StaticOrder, false, true>(lds, g, S, E);
    }
    __syncthreads(); }
    GRID_SYNC();
    for (int rep_ = 0; rep_ < ((PROBE_MASK & 64) ? 2 : 1); ++rep_) {
    { PHASE_IDS quant_rows(p.in[11], EU8, SU, PE_NE, 0, gw, ngw, lane); }
    __syncthreads(); }
    __syncthreads();
    for (int rep_ = 0; rep_ < ((PROBE_MASK & 8192) ? 2 : 1); ++rep_) {
    {
        pg8::Gemm g{XW, WqT, T, 2048, 1024}; pg8::StaticOrder S; S.init(T, 2048, G, wg);
        EpiQ E{Qp, SSQX};
        pg8::gemm_phase<EpiQ, pg8::StaticOrder, true, true>(lds, g, S, E);
    }
    __syncthreads(); }
    GRID_SYNC();
    { PHASE_IDS peer_retrieve(lds, Qp, SK, EIDX, EGATE, gw, ngw); quant_xw(XW, XQ8, XS, gw, ngw, lane); }
#if PROBE_MASK & 2
    { PHASE_IDS peer_retrieve(lds, Qp, SK, EIDX, EGATE, gw, ngw); quant_xw(XW, XQ8, XS, gw, ngw, lane); }
#endif
    GRID_SYNC();
    if (threadIdx.x == 0) {
        unsigned k = 0, n = 0, mine = 1;
        for (unsigned j = 0; j < 16; ++j) { const unsigned c = xb_ld((unsigned*)(p.ws + WS_CTL) + XB_XCNT(j)); if (c) { if (j < xbar.x) ++k; ++n; } if (j == xbar.x) mine = c ? c : 1; }
        bst[5] = k; bst[6] = n ? n : 1; bst[7] = mine;
    }
    __syncthreads();
    const int xrank = (int)bst[4], xk = (int)bst[5], xn = (int)bst[6], xloc = (int)bst[7];
    for (int rep_ = 0; rep_ < ((PROBE_MASK & 1) ? 2 : 1); ++rep_) {
    { PHASE_IDS for (int s = xk; s < 8; s += xn) peer_u(EU8, XQ8, EIDX, PART, s, xrank * NWAVES + wave, xloc * NWAVES, lane); }
    GRID_SYNC(); }
    { PHASE_IDS peer_w(PART, EIDX, EGATE, SU, SV, XS, SSQX, WT, gtid, gsz); }
    GRID_SYNC();
#if PROBE_MASK & 131072
    { PHASE_IDS for (int s = xk; s < 8; s += xn) peer_v(EV8, EIDX, WT, X1, s, xrank * NWAVES + wave, xloc * NWAVES, lane, 1); }
    GRID_SYNC();
#endif
    { PHASE_IDS for (int s = xk; s < 8; s += xn) peer_v(EV8, EIDX, WT, X1, s, xrank * NWAVES + wave, xloc * NWAVES, lane, 0); }
    GRID_SYNC();
    { PHASE_IDS final_norm(X1, p.in[13], p.out, gw, ngw, lane); }
#if PROBE_MASK & 16
    for (int i = 0; i < 15; ++i) GRID_SYNC();
#endif
}

extern "C" void kernel_launch(void* const* d_in, const int* in_sizes, int n_in, void* d_out, int out_size, void* d_ws, size_t ws_size, hipStream_t stream) {
    static int grid_blocks = 0;
    if (!grid_blocks) {
        int dev = 0, cus = 0, per_cu = 0;
        (void)hipGetDevice(&dev);
        (void)hipDeviceGetAttribute(&cus, hipDeviceAttributeMultiprocessorCount, dev);
        (void)hipFuncSetAttribute((const void*)fwd_megakernel, hipFuncAttributeMaxDynamicSharedMemorySize, LDS_BYTES);
        (void)hipOccupancyMaxActiveBlocksPerMultiprocessor(&per_cu, (const void*)fwd_megakernel, NTHREADS, LDS_BYTES);
        if (per_cu < 1) per_cu = 1;
        grid_blocks = cus * 1;
        if (ws_size < WS_END || n_in != 14) { fprintf(stderr, "kernel_launch: unexpected ws_size %zu (need %zu) or n_in %d\n", ws_size, (size_t)WS_END, n_in); }
    }
    (void)hipMemsetAsync((char*)d_ws + WS_CTL, 0, CTL_BYTES, stream);
    Params p{};
    for (int i = 0; i < 14; ++i) p.in[i] = (const float*)d_in[i];
    p.out = (float*)d_out; p.ws = (unsigned char*)d_ws;
    void* args[] = {&p};
    hipError_t e = hipLaunchCooperativeKernel((const void*)fwd_megakernel, dim3(grid_blocks), dim3(NTHREADS), args, LDS_BYTES, stream);
    if (e != hipSuccess) fprintf(stderr, "cooperative launch failed: %s (grid %d)\n", hipGetErrorString(e), grid_blocks);
}
```

```cpp
#include <hip/hip_runtime.h>
#include <hip/hip_cooperative_groups.h>
#include <cstdio>
#include <cstdint>
namespace cg = cooperative_groups;
#ifndef USE_CG_SYNC
#define USE_CG_SYNC 0
#endif
#ifndef PROBE_MASK
#define PROBE_MASK 0
#endif

#define DI __device__ __forceinline__
#define LAS __attribute__((address_space(3)))
typedef unsigned short bf16;
typedef float f32x4 __attribute__((ext_vector_type(4)));
typedef float f32x2 __attribute__((ext_vector_type(2)));
typedef float f32x16 __attribute__((ext_vector_type(16)));
typedef short bf16x8 __attribute__((ext_vector_type(8)));
typedef short s16x4 __attribute__((ext_vector_type(4)));
typedef unsigned u32x4 __attribute__((ext_vector_type(4)));
typedef unsigned u32x2 __attribute__((ext_vector_type(2)));
typedef __bf16 nbf16x2 __attribute__((ext_vector_type(2)));

constexpr int D = 1024, NB = 2, SEQ = 8192, T = NB * SEQ;
constexpr int HG_H = 8, HG_DK = 128, HG_DV = 128, HG_C = 64, HG_NC = SEQ / HG_C;
constexpr int RT_H = 4, RT_DK = 256, RT_DV = 512, RT_L = 512, RT_NS = SEQ / RT_L;
constexpr int PE_H = 8, PE_NK = 128, PE_K = 16, PE_Q = 256, PE_HALF = 128, PE_NE = PE_NK * PE_NK;
constexpr float EPS = 1e-6f;
constexpr int NTHREADS = 512, NWAVES = 8;
constexpr int LDS_BYTES = 147456;

constexpr size_t MiB = 1u << 20;
constexpr size_t WS_CTL = 0;
constexpr size_t WS_DEC = 1 * MiB;
constexpr size_t WS_SSQP = 2 * MiB;
constexpr size_t WS_SCL = 2 * MiB + 512 * 1024;
constexpr size_t WS_SSQX = 3 * MiB;
constexpr size_t WS_HN = 4 * MiB;
constexpr size_t WS_WINT = 36 * MiB;
constexpr size_t WS_ROPE = 60 * MiB;
constexpr size_t WS_A = 68 * MiB, WS_B = 100 * MiB, WS_C = 132 * MiB;
constexpr size_t WS_STH = 164 * MiB;
constexpr size_t WS_STR = 196 * MiB;
constexpr size_t WS_OHG = 228 * MiB;
constexpr size_t WS_GA = 68 * MiB, WS_GB = 100 * MiB;
constexpr size_t WS_W2 = 132 * MiB;
constexpr size_t WS_WHG = WS_W2, WS_WRET = WS_W2 + 2 * MiB, WS_WOUT = WS_W2 + 6 * MiB, WS_WQ = WS_W2 + 8 * MiB, WS_SK = WS_W2 + 12 * MiB;
constexpr size_t WS_EV = 145 * MiB;
constexpr size_t WS_MERGED = 177 * MiB;
constexpr size_t WS_EU = 209 * MiB;
constexpr size_t WS_M1 = 4 * MiB;
constexpr size_t WS_X1 = 4 * MiB;
constexpr size_t WS_XW = 68 * MiB;
constexpr size_t WS_TOPS = 100 * MiB, WS_TOPI = 116 * MiB;
constexpr size_t WS_EIDX = 177 * MiB, WS_EGATE = 185 * MiB;
constexpr size_t WS_SA = WS_SCL + 192 * 1024;
constexpr size_t WS_SB = WS_SCL + 256 * 1024;
constexpr size_t CTL_AMAX = 65536;
constexpr size_t CTL_BYTES = 131072;
constexpr size_t WS_XQ8 = 161 * MiB;
constexpr size_t WS_XS = WS_SCL + 128 * 1024;
constexpr size_t WS_PART = 68 * MiB;
constexpr size_t WS_WT = 193 * MiB;
constexpr size_t WS_END = 260 * MiB;

DI int fresh_tid() { int t = threadIdx.x; asm volatile("" : "+v"(t)); return t; }
DI float sigmoidf_(float x) { return 1.f / (1.f + __expf(-x)); }
DI float siluf_(float x) { return x / (1.f + __expf(-x)); }
DI unsigned pk2(float lo, float hi) { f32x2 v = {lo, hi}; nbf16x2 b = __builtin_convertvector(v, nbf16x2); return __builtin_bit_cast(unsigned, b); }
DI bf16 f2bf(float f) { return (bf16)(pk2(f, 0.f) & 0xffffu); }
DI float bf2f(bf16 b) { return __uint_as_float(((unsigned)b) << 16); }
DI float bflo(unsigned u) { return __uint_as_float(u << 16); }
DI float bfhi(unsigned u) { return __uint_as_float(u & 0xffff0000u); }
DI float wave_sum(float v) {
#pragma unroll
    for (int o = 1; o < 64; o <<= 1) v += __shfl_xor(v, o);
    return v;
}
DI int crow(int reg, int h) { return (reg & 3) + 8 * (reg >> 2) + 4 * h; }

namespace pg8 {
#define PG8_LAS __attribute__((address_space(3)))
typedef unsigned short bf16_t;
typedef short bf16x8 __attribute__((ext_vector_type(8)));
typedef float f32x4 __attribute__((ext_vector_type(4)));
typedef unsigned u32x4 __attribute__((ext_vector_type(4)));
constexpr int BM = 256, BK = 64, HALF = 128, HTB = HALF * BK * 2  , STAGE_BYTES = 8 * HTB, NXCD = 8, WGM = 8;

__host__ __device__ __forceinline__ int lds_byte(int r, int c) { const int st = (r >> 4) * 2 + (c >> 5), rr = r & 15, cc = c & 31, ob = rr * 64 + cc * 2; return st * 1024 + (ob ^ (((ob >> 9) & 1) << 5)); }
__host__ __device__ __forceinline__ void stage_rc(int b, int& R, int& C) { const int st = b / 1024, sb = b % 1024, swz = sb ^ (((sb >> 9) & 1) << 5); R = (st >> 1) * 16 + swz / 64; C = (st & 1) * 32 + (swz % 64) / 2; }
__host__ __device__ __forceinline__ int perm32(int rho) { const int n = rho >> 4, i = rho & 15; return 8 * (i >> 2) + 4 * n + (i & 3); }

struct Unit { int pm, pn; };
struct Gemm { const bf16_t* A; const bf16_t* Bt; int M, N, K; };

struct StaticOrder {
    int nM, nN, nwg, G, c;
    __host__ __device__ void init(int M, int N, int G_, int c_) { nM = M / BM; nN = N / BM; nwg = nM * nN; G = G_; c = c_; }
    __host__ __device__ bool next(int i, Unit& u) const {
        const long L = (long)i * G + c; if (L >= nwg) return false;
        int wgid = (int)L; { const int q = nwg / NXCD, r = nwg % NXCD, xcd = wgid % NXCD, off = wgid / NXCD; wgid = (xcd < r ? xcd * (q + 1) : r * (q + 1) + (xcd - r) * q) + off; }
        const int nig = WGM * nN, gid = wgid / nig, fm = gid * WGM, gsz = (nM - fm) < WGM ? (nM - fm) : WGM;
        u.pm = fm + ((wgid % nig) % gsz); u.pn = (wgid % nig) / gsz; return true;
    }
    __device__ __forceinline__ void a_ready(const Unit&) const {}
    __device__ __forceinline__ void done(const Unit&) const {}
};

__device__ __forceinline__ unsigned cvt_pk_bf16(float lo, float hi) { unsigned r; asm volatile("v_cvt_pk_bf16_f32 %0, %1, %2" : "=v"(r) : "v"(lo), "v"(hi)); return r; }
typedef float f32x2 __attribute__((ext_vector_type(2)));
typedef int i32x4 __attribute__((ext_vector_type(4)));
template <bool I8> __device__ __forceinline__ f32x4 mma16(const bf16x8& b, const bf16x8& a, const f32x4& c) {
    if constexpr (I8) return __builtin_bit_cast(f32x4, __builtin_amdgcn_mfma_i32_16x16x64_i8(__builtin_bit_cast(i32x4, b), __builtin_bit_cast(i32x4, a), __builtin_bit_cast(i32x4, c), 0, 0, 0));
    else return __builtin_amdgcn_mfma_f32_16x16x32_bf16(b, a, c, 0, 0, 0);
}
template <class Epi, class Sched, bool ALIGN_EPI = false, bool SP2 = false, bool I8 = false>
__device__ __forceinline__ void gemm_phase(PG8_LAS unsigned char* lds, const Gemm g, const Sched& S, const Epi& E) {
    const int tid = fresh_tid(), wid = __builtin_amdgcn_readfirstlane(tid >> 6), lane = tid & 63, wr = wid >> 2, wc = wid & 3, fr = lane & 15, fq = lane >> 4;
    const int K = g.K, nt = K / BK;
    unsigned voffA[2], voffB[2];
#pragma unroll
    for (int i = 0; i < 2; ++i) { int R, C; stage_rc(tid * 16 + i * 8192, R, C); const int Rb = Epi::PERM ? ((R & ~31) + perm32(R & 31)) : R;
        voffA[i] = (unsigned)(R * K + C) * 2u; voffB[i] = (unsigned)(Rb * K + C) * 2u; }
    const size_t kstep = (size_t)(BK * 2);
    const size_t hstep = (size_t)HALF * K * 2;
    const size_t tstep = 2 * hstep;
    const unsigned ldsw = (unsigned)wid * 1024u;
    const int aoff = lds_byte(wr * 64 + fr, fq * 8), boff = lds_byte(wc * 32 + fr, fq * 8);
#define PG8_SA(b, h) (((b) * 2 + (h)) * HTB)
#define PG8_SB(b, h) ((4 + (b) * 2 + (h)) * HTB)
#define PG8_STAGE(bufoff, gbase, voff) do { _Pragma("unroll") for (int _i = 0; _i < 2; ++_i) \
        __builtin_amdgcn_global_load_lds((const unsigned*)((const char*)(gbase) + (voff)[_i]), (PG8_LAS unsigned*)(lds + (bufoff) + ldsw + _i * 8192), 16, 0, 0); } while (0)
#define PG8_LDA(dst, b, h) do { _Pragma("unroll") for (int m = 0; m < 4; ++m) _Pragma("unroll") for (int k = 0; k < 2; ++k) dst[m][k] = *(const PG8_LAS bf16x8*)(lds + PG8_SA(b, h) + aoff + m * 2048 + k * 1024); } while (0)
#define PG8_LDB(dst, b, h) do { _Pragma("unroll") for (int n = 0; n < 2; ++n) _Pragma("unroll") for (int k = 0; k < 2; ++k) dst[n][k] = *(const PG8_LAS bf16x8*)(lds + PG8_SB(b, h) + boff + n * 2048 + k * 1024); } while (0)
#define PG8_MMA(ai, bj, At, Bt) do { __builtin_amdgcn_s_setprio(1); _Pragma("unroll") for (int m = 0; m < 4; ++m) _Pragma("unroll") for (int n = 0; n < 2; ++n) _Pragma("unroll") for (int k = 0; k < 2; ++k) \
        acc[ai][bj][m][n] = mma16<I8>(Bt[n][k], At[m][k], acc[ai][bj][m][n]); __builtin_amdgcn_s_setprio(0); } while (0)
#define PG8_WAIT_V(n) asm volatile("s_waitcnt vmcnt(" #n ")" ::: "memory")
#define PG8_WAIT_L(n) asm volatile("s_waitcnt lgkmcnt(" #n ")" ::: "memory")
#define PG8_BAR __builtin_amdgcn_s_barrier()
#define PG8_SCHED __builtin_amdgcn_sched_barrier(0)
    Unit cur, nxt; int ui = 0;
    if (!S.next(0, cur)) return;
    f32x4 acc[2][2][4][2];
#pragma unroll
    for (int a = 0; a < 2; ++a)
#pragma unroll
        for (int b = 0; b < 2; ++b)
#pragma unroll
            for (int m = 0; m < 4; ++m)
#pragma unroll
                for (int n = 0; n < 2; ++n) acc[a][b][m][n] = (f32x4){0.f, 0.f, 0.f, 0.f};
    bf16x8 At[4][2], B0[2][2], B1[2][2];
    const char* cA = (const char*)g.A + (size_t)cur.pm * tstep; const char* cB = (const char*)g.Bt + (size_t)cur.pn * tstep;
    S.a_ready(cur);
    if constexpr (SP2) {
        PG8_STAGE(PG8_SB(0, 0), cB, voffB); PG8_STAGE(PG8_SB(0, 1), cB + hstep, voffB); PG8_STAGE(PG8_SA(0, 0), cA, voffA); PG8_STAGE(PG8_SA(0, 1), cA + hstep, voffA);
        if (wr == 1) PG8_BAR;
        PG8_WAIT_V(2); PG8_BAR;
        PG8_STAGE(PG8_SB(1, 0), cB + kstep, voffB); PG8_STAGE(PG8_SA(1, 0), cA + kstep, voffA); PG8_STAGE(PG8_SB(1, 1), cB + hstep + kstep, voffB);
        PG8_WAIT_V(6); PG8_BAR;
    } else {
        PG8_STAGE(PG8_SB(0, 0), cB, voffB); PG8_STAGE(PG8_SA(0, 0), cA, voffA); PG8_STAGE(PG8_SB(0, 1), cB + hstep, voffB); PG8_STAGE(PG8_SA(0, 1), cA + hstep, voffA);
        if (wr == 1) PG8_BAR;
        PG8_WAIT_V(4); PG8_BAR;
        PG8_STAGE(PG8_SB(1, 0), cB + kstep, voffB); PG8_STAGE(PG8_SA(1, 0), cA + kstep, voffA); PG8_STAGE(PG8_SB(1, 1), cB + hstep + kstep, voffB);
        PG8_WAIT_V(6); PG8_BAR;
    }
    for (;;) {
        const bool has_next = S.next(ui + 1, nxt);
        const char* nA = has_next ? (const char*)g.A + (size_t)nxt.pm * tstep : cA; const char* nB = has_next ? (const char*)g.Bt + (size_t)nxt.pn * tstep : cB;
        for (int t = 0; t < nt; t += 2) {
            const bool last = (t == nt - 2);
            const char* a1 = cA + (size_t)(t + 1) * kstep;
            const char* a2 = last ? nA : cA + (size_t)(t + 2) * kstep; const char* b2 = last ? nB : cB + (size_t)(t + 2) * kstep;
            const char* a3 = a2 + kstep; const char* b3 = b2 + kstep;
            if (last && has_next) S.a_ready(nxt);
            if constexpr (SP2) {
            PG8_LDB(B0, 0, 0); PG8_LDB(B1, 0, 1); PG8_SCHED; PG8_LDA(At, 0, 0); PG8_STAGE(PG8_SA(1, 1), a1 + hstep, voffA);
            PG8_WAIT_V(8); PG8_WAIT_L(0); PG8_BAR; PG8_MMA(0, 0, At, B0); PG8_MMA(0, 1, At, B1); PG8_BAR; PG8_SCHED;
            PG8_LDA(At, 0, 1); PG8_STAGE(PG8_SB(0, 0), b2, voffB); PG8_STAGE(PG8_SB(0, 1), b2 + hstep, voffB); PG8_STAGE(PG8_SA(0, 0), a2, voffA);
            PG8_WAIT_V(8); PG8_WAIT_L(0); PG8_BAR; PG8_MMA(1, 0, At, B0); PG8_MMA(1, 1, At, B1); PG8_BAR; PG8_SCHED;
            PG8_LDB(B0, 1, 0); PG8_LDB(B1, 1, 1); PG8_SCHED; PG8_LDA(At, 1, 0); PG8_STAGE(PG8_SA(0, 1), a2 + hstep, voffA);
            PG8_WAIT_V(8); PG8_WAIT_L(0); PG8_BAR; PG8_MMA(0, 0, At, B0); PG8_MMA(0, 1, At, B1); PG8_BAR; PG8_SCHED;
            PG8_LDA(At, 1, 1); PG8_STAGE(PG8_SB(1, 0), b3, voffB); PG8_STAGE(PG8_SB(1, 1), b3 + hstep, voffB); PG8_STAGE(PG8_SA(1, 0), a3, voffA);
            PG8_WAIT_V(8); PG8_WAIT_L(0); PG8_BAR; PG8_MMA(1, 0, At, B0); PG8_MMA(1, 1, At, B1); PG8_BAR; PG8_SCHED;
            } else {
            PG8_LDB(B0, 0, 0); PG8_SCHED; PG8_LDA(At, 0, 0); PG8_STAGE(PG8_SA(1, 1), a1 + hstep, voffA);
            PG8_WAIT_L(8); PG8_BAR; PG8_WAIT_L(0); PG8_MMA(0, 0, At, B0); PG8_BAR; PG8_SCHED;
            PG8_LDB(B1, 0, 1); PG8_STAGE(PG8_SB(0, 0), b2, voffB);
            PG8_BAR; PG8_WAIT_L(0); PG8_MMA(0, 1, At, B1); PG8_BAR;
            PG8_LDA(At, 0, 1); PG8_STAGE(PG8_SA(0, 0), a2, voffA);
            PG8_BAR; PG8_WAIT_L(0); PG8_MMA(1, 0, At, B0); PG8_BAR; PG8_SCHED;
            PG8_STAGE(PG8_SB(0, 1), b2 + hstep, voffB);
            PG8_WAIT_V(6); PG8_BAR; PG8_MMA(1, 1, At, B1); PG8_BAR;
            PG8_LDB(B0, 1, 0); PG8_SCHED; PG8_LDA(At, 1, 0); PG8_STAGE(PG8_SA(0, 1), a2 + hstep, voffA);
            PG8_WAIT_L(8); PG8_BAR; PG8_WAIT_L(0); PG8_MMA(0, 0, At, B0); PG8_BAR; PG8_SCHED;
            PG8_LDB(B1, 1, 1); PG8_STAGE(PG8_SB(1, 0), b3, voffB);
            PG8_BAR; PG8_WAIT_L(0); PG8_MMA(0, 1, At, B1); PG8_BAR;
            PG8_LDA(At, 1, 1); PG8_STAGE(PG8_SA(1, 0), a3, voffA);
            PG8_BAR; PG8_WAIT_L(0); PG8_MMA(1, 0, At, B0); PG8_BAR; PG8_SCHED;
            PG8_STAGE(PG8_SB(1, 1), b3 + hstep, voffB);
            PG8_WAIT_V(6); PG8_BAR; PG8_MMA(1, 1, At, B1); PG8_BAR;
            }
        }
        if constexpr (ALIGN_EPI) { if (wr == 0) PG8_BAR; }
        if constexpr (!Epi::AFTER_DRAIN) { E(acc, cur, wr, wc, fr, fq); S.done(cur); }
        if (!has_next) break;
#pragma unroll
        for (int a = 0; a < 2; ++a)
#pragma unroll
            for (int b = 0; b < 2; ++b)
#pragma unroll
                for (int m = 0; m < 4; ++m)
#pragma unroll
                    for (int n = 0; n < 2; ++n) acc[a][b][m][n] = (f32x4){0.f, 0.f, 0.f, 0.f};
        cur = nxt; cA = nA; cB = nB; ++ui;
        if constexpr (ALIGN_EPI) { if (wr == 1) PG8_BAR; }
    }
    PG8_WAIT_V(0);
    if constexpr (!ALIGN_EPI) { if (wr == 0) PG8_BAR; }
    PG8_BAR;
    if constexpr (Epi::AFTER_DRAIN) { E.fused(acc, cur, wr, wc, fr, fq, lds, wid, lane); S.done(cur); }
#undef PG8_SA
#undef PG8_SB
#undef PG8_STAGE
#undef PG8_LDA
#undef PG8_LDB
#undef PG8_MMA
#undef PG8_WAIT_V
#undef PG8_WAIT_L
#undef PG8_BAR
#undef PG8_SCHED
}
}

using pg8::Unit;
typedef f32x4 Acc[2][2][4][2];

DI u32x4 pack8(const f32x4& a, const f32x4& b) { u32x4 w; w.x = pk2(a[0], a[1]); w.y = pk2(a[2], a[3]); w.z = pk2(b[0], b[1]); w.w = pk2(b[2], b[3]); return w; }

DI void dequant_acc(Acc& acc, const Unit& u, int wr, int wc, int fr, int fq, const float* SA, const float* SB) {
    f32x4 sb[2][2];
#pragma unroll
    for (int bj = 0; bj < 2; ++bj)
#pragma unroll
        for (int n = 0; n < 2; ++n) sb[bj][n] = *(const f32x4*)(SB + u.pn * 256 + bj * 128 + wc * 32 + 8 * fq + 4 * n);
#pragma unroll
    for (int ai = 0; ai < 2; ++ai)
#pragma unroll
        for (int m = 0; m < 4; ++m) {
            const float sa = SA[u.pm * 256 + ai * 128 + wr * 64 + m * 16 + fr];
#pragma unroll
            for (int bj = 0; bj < 2; ++bj)
#pragma unroll
                for (int n = 0; n < 2; ++n)
#pragma unroll
                    for (int e = 0; e < 4; ++e) acc[ai][bj][m][n][e] = (float)__float_as_int(acc[ai][bj][m][n][e]) * sa * sb[bj][n][e];
        }
}

template <int CTRL, bool ZERO> DI float dppf(float v) { return __int_as_float(__builtin_amdgcn_update_dpp(0, __float_as_int(v), CTRL, 0xF, 0xF, ZERO)); }

struct EpiH {
    static constexpr bool PERM = true, AFTER_DRAIN = false;
    bf16* Qh; bf16* Kh; bf16* VTh; float* DEC; const float* hlb; bf16* OHG; const float* SA; const float* SB;
    DI void operator()(Acc& acc, const Unit& u, int wr, int wc, int fr, int fq) const {
        dequant_acc(acc, u, wr, wc, fr, fq, SA, SB);
        if (u.pn < 8) {
            const int h = u.pn, dbase = wc * 32 + 8 * fq;
#pragma unroll
            for (int ai = 0; ai < 2; ++ai) {
                const int row0 = u.pm * 256 + ai * 128 + wr * 64;
                const int bidx = row0 >> 13, chunk = (row0 & (SEQ - 1)) >> 6;
#pragma unroll
                for (int n = 0; n < 2; ++n) {
                    const f32x4 h0 = *(const f32x4*)(hlb + h * 128 + dbase + 4 * n), h1 = *(const f32x4*)(hlb + 1024 + h * 128 + dbase + 4 * n);
                    f32x4 ebl;
#pragma unroll
                    for (int e = 0; e < 4; ++e) {
                        const float lb = sigmoidf_(h0[e] - h1[e]);
                        float g[4], kk[4], tot[4];
#pragma unroll
                        for (int m = 0; m < 4; ++m) {
                            const float sg = sigmoidf_(acc[ai][1][m][n][e]);
                            kk[m] = (1.f - lb) * (1.f - sg);
                            const float lf = __logf(lb + (1.f - lb) * sg);
                            float s = lf;
                            s += dppf<0x111, true>(s); s += dppf<0x112, true>(s); s += dppf<0x114, true>(s); s += dppf<0x118, true>(s);
                            float t = lf;
                            t += dppf<0xB1, false>(t); t += dppf<0x4E, false>(t); t += dppf<0x141, false>(t); t += dppf<0x140, false>(t);
                            g[m] = s; tot[m] = t;
                        }
                        float carry = 0.f, eb = 0.f;
#pragma unroll
                        for (int m = 0; m < 4; ++m) {
                            const float bb = g[m] + carry; carry += tot[m];
                            eb = __expf(bb);
                            acc[ai][0][m][n][e] = acc[ai][0][m][n][e] * 0.08838834764831845f * eb;
                            acc[ai][1][m][n][e] = kk[m] * __expf(-bb);
                        }
                        ebl[e] = eb;
                    }
                    if (fr == 15) *(f32x4*)(DEC + ((size_t)((bidx * HG_H + h) * HG_NC + chunk)) * 128 + dbase + 4 * n) = ebl;
#pragma unroll
                    for (int m = 0; m < 4; ++m) {
                        const size_t row = (size_t)(row0 + m * 16 + fr);
                        const f32x4 qv = acc[ai][0][m][n], kv = acc[ai][1][m][n];
                        u32x2 oq, ok; oq.x = pk2(qv[0], qv[1]); oq.y = pk2(qv[2], qv[3]); ok.x = pk2(kv[0], kv[1]); ok.y = pk2(kv[2], kv[3]);
                        *(u32x2*)(Qh + row * 1024 + h * 128 + dbase + 4 * n) = oq;
                        *(u32x2*)(Kh + row * 1024 + h * 128 + dbase + 4 * n) = ok;
                    }
                    __builtin_amdgcn_sched_barrier(0);
                }
            }
        } else if (u.pn >= 12) {
            const int cb = (u.pn - 12) * 256 + wc * 32 + 8 * fq;
#pragma unroll
            for (int ai = 0; ai < 2; ++ai)
#pragma unroll
                for (int m = 0; m < 4; ++m) {
                    const size_t row = (size_t)(u.pm * 256 + ai * 128 + wr * 64 + m * 16 + fr);
#pragma unroll
                    for (int bj = 0; bj < 2; ++bj) {
                        f32x4 a0 = acc[ai][bj][m][0], a1 = acc[ai][bj][m][1];
#pragma unroll
                        for (int e = 0; e < 4; ++e) { a0[e] = siluf_(a0[e]); a1[e] = siluf_(a1[e]); }
                        *(u32x4*)(OHG + row * 1024 + cb + bj * 128) = pack8(a0, a1);
                    }
                }
        } else {
#pragma unroll
            for (int ai = 0; ai < 2; ++ai)
#pragma unroll
                for (int m = 0; m < 4; ++m) {
                    const int row = u.pm * 256 + ai * 128 + wr * 64 + m * 16 + fr, bidx = row >> 13, pos = row & (SEQ - 1);
                    bf16* ptr = VTh + (((size_t)(bidx * HG_H * 128 + (u.pn - 8) * 256 + wc * 32 + 8 * fq)) << 13) + pos;
#pragma unroll
                    for (int bj = 0; bj < 2; ++bj) {
#pragma unroll
                        for (int n = 0; n < 2; ++n)
#pragma unroll
                            for (int e = 0; e < 4; ++e) { asm volatile("" : "+v"(ptr)); *ptr = f2bf(acc[ai][bj][m][n][e]); ptr += 8192; }
                        ptr += (size_t)120 * 8192;
                    }
                }
        }
    }
};

struct EpiR {
    static constexpr bool PERM = true, AFTER_DRAIN = false;
    bf16* Qr; bf16* Kr; bf16* VTr; const float* COS; const float* SIN; bf16* ORET; const float* SA; const float* SB;
    DI void operator()(Acc& acc, const Unit& u, int wr, int wc, int fr, int fq) const {
        dequant_acc(acc, u, wr, wc, fr, fq, SA, SB);
        if (u.pn < 8) {
            const bool isk = u.pn >= 4; const int h = u.pn & 3;
            const float lg = __log2f(1.f - exp2f(-5.f - (float)h));
            bf16* dst = isk ? Kr : Qr;
            const int j0 = wc * 32 + 8 * fq;
#pragma unroll
            for (int ai = 0; ai < 2; ++ai)
#pragma unroll
                for (int m = 0; m < 4; ++m) {
                    const int row = u.pm * 256 + ai * 128 + wr * 64 + m * 16 + fr, pos = row & (SEQ - 1), il = pos & (RT_L - 1);
                    const float sc = isk ? exp2f(-lg * (float)il) * 0.0625f : exp2f(lg * (float)il);
#pragma unroll
                    for (int n = 0; n < 2; ++n) {
                        const f32x4 c = *(const f32x4*)(COS + (size_t)pos * 128 + j0 + 4 * n), s = *(const f32x4*)(SIN + (size_t)pos * 128 + j0 + 4 * n);
                        const f32x4 x1 = acc[ai][0][m][n], x2 = acc[ai][1][m][n];
                        acc[ai][0][m][n] = (x1 * c - x2 * s) * sc; acc[ai][1][m][n] = (x1 * s + x2 * c) * sc;
                    }
                    *(u32x4*)(dst + (size_t)row * 1024 + h * 256 + j0) = pack8(acc[ai][0][m][0], acc[ai][0][m][1]);
                    *(u32x4*)(dst + (size_t)row * 1024 + h * 256 + 128 + j0) = pack8(acc[ai][1][m][0], acc[ai][1][m][1]);
                }
        } else if (u.pn >= 16) {
            const int cb = (u.pn - 16) * 256 + wc * 32 + 8 * fq;
#pragma unroll
            for (int ai = 0; ai < 2; ++ai)
#pragma unroll
                for (int m = 0; m < 4; ++m) {
                    const size_t row = (size_t)(u.pm * 256 + ai * 128 + wr * 64 + m * 16 + fr);
#pragma unroll
                    for (int bj = 0; bj < 2; ++bj) {
                        f32x4 a0 = acc[ai][bj][m][0], a1 = acc[ai][bj][m][1];
#pragma unroll
                        for (int e = 0; e < 4; ++e) { a0[e] = siluf_(a0[e]); a1[e] = siluf_(a1[e]); }
                        *(u32x4*)(ORET + row * 2048 + cb + bj * 128) = pack8(a0, a1);
                    }
                }
        } else {
#pragma unroll
            for (int ai = 0; ai < 2; ++ai)
#pragma unroll
                for (int m = 0; m < 4; ++m) {
                    const int row = u.pm * 256 + ai * 128 + wr * 64 + m * 16 + fr, bidx = row >> 13, pos = row & (SEQ - 1);
                    const int uu = pos & 15, hs = (uu >> 2) & 1, jj = ((uu >> 3) << 2) | (uu & 3), ks = (pos >> 4) & 1, sblk = pos >> 5;
                    const int c0 = (u.pn - 8) * 256 + wc * 32, hd = c0 >> 9, nv0 = (c0 & 511) >> 5;
                    bf16* ptr = VTr + ((((size_t)((bidx * RT_H + hd) * 256 + sblk) * 16 + nv0) * 2 + ks) * 64 + (8 * fq + 32 * hs)) * 8 + jj;
#pragma unroll
                    for (int bj = 0; bj < 2; ++bj) {
#pragma unroll
                        for (int n = 0; n < 2; ++n)
#pragma unroll
                            for (int e = 0; e < 4; ++e) { asm volatile("" : "+v"(ptr)); *ptr = f2bf(acc[ai][bj][m][n][e]); ptr += 8; }
                        ptr += 4 * 2 * 64 * 8 - 64;
                    }
                }
        }
    }
};

struct EpiG {
    static constexpr bool PERM = true, AFTER_DRAIN = false;
    bf16* GA; bf16* GB; const float* SA; const float* SB;
    DI void operator()(Acc& acc, const Unit& u, int wr, int wc, int fr, int fq) const {
        dequant_acc(acc, u, wr, wc, fr, fq, SA, SB);
        const int cb = wc * 32 + 8 * fq;
        bf16* base = (u.pn < 4 ? GA + (size_t)u.pn * 256 : GB + (size_t)(u.pn - 4) * 256) + cb;
#pragma unroll
        for (int ai = 0; ai < 2; ++ai)
#pragma unroll
            for (int m = 0; m < 4; ++m) {
                const size_t row = (size_t)(u.pm * 256 + ai * 128 + wr * 64 + m * 16 + fr);
#pragma unroll
                for (int bj = 0; bj < 2; ++bj) {
                    f32x4 a0 = acc[ai][bj][m][0], a1 = acc[ai][bj][m][1];
#pragma unroll
                    for (int e = 0; e < 4; ++e) { a0[e] = sigmoidf_(a0[e]); a1[e] = sigmoidf_(a1[e]); }
                    *(u32x4*)(base + row * 1024 + bj * 128) = pack8(a0, a1);
                }
            }
    }
};

struct EpiM1 {
    static constexpr bool PERM = true, AFTER_DRAIN = false;
    bf16* MERGED; const bf16* GA;
    DI void operator()(Acc& acc, const Unit& u, int wr, int wc, int fr, int fq) const {
        const int cb = u.pn * 256 + wc * 32 + 8 * fq;
#pragma unroll
        for (int ai = 0; ai < 2; ++ai)
#pragma unroll
            for (int m = 0; m < 4; ++m) {
                const size_t row = (size_t)(u.pm * 256 + ai * 128 + wr * 64 + m * 16 + fr);
#pragma unroll
                for (int bj = 0; bj < 2; ++bj) {
                    const u32x4 g = *(const u32x4*)(GA + row * 1024 + cb + bj * 128);
                    f32x4 a0 = acc[ai][bj][m][0], a1 = acc[ai][bj][m][1];
                    a0[0] *= bflo(g.x); a0[1] *= bfhi(g.x); a0[2] *= bflo(g.y); a0[3] *= bfhi(g.y);
                    a1[0] *= bflo(g.z); a1[1] *= bfhi(g.z); a1[2] *= bflo(g.w); a1[3] *= bfhi(g.w);
                    *(u32x4*)(MERGED + row * 1024 + cb + bj * 128) = pack8(a0, a1);
                }
            }
    }
};
struct EpiMerge {
    static constexpr bool PERM = true, AFTER_DRAIN = false;
    const bf16* GB; bf16* MERGED;
    DI void operator()(Acc& acc, const Unit& u, int wr, int wc, int fr, int fq) const {
        const int cb = u.pn * 256 + wc * 32 + 8 * fq;
#pragma unroll
        for (int ai = 0; ai < 2; ++ai)
#pragma unroll
            for (int m = 0; m < 4; ++m) {
                const size_t row = (size_t)(u.pm * 256 + ai * 128 + wr * 64 + m * 16 + fr);
#pragma unroll
                for (int bj = 0; bj < 2; ++bj) {
                    const u32x4 g = *(const u32x4*)(GB + row * 1024 + cb + bj * 128);
                    const u32x4 mo = *(const u32x4*)(MERGED + row * 1024 + cb + bj * 128);
                    f32x4 a0 = acc[ai][bj][m][0], a1 = acc[ai][bj][m][1];
                    a0[0] = a0[0] * bflo(g.x) + bflo(mo.x); a0[1] = a0[1] * bfhi(g.x) + bfhi(mo.x); a0[2] = a0[2] * bflo(g.y) + bflo(mo.y); a0[3] = a0[3] * bfhi(g.y) + bfhi(mo.y);
                    a1[0] = a1[0] * bflo(g.z) + bflo(mo.z); a1[1] = a1[1] * bfhi(g.z) + bfhi(mo.z); a1[2] = a1[2] * bflo(g.w) + bflo(mo.w); a1[3] = a1[3] * bfhi(g.w) + bfhi(mo.w);
                    *(u32x4*)(MERGED + row * 1024 + cb + bj * 128) = pack8(a0, a1);
                }
            }
    }
};
struct EpiOut {
    static constexpr bool PERM = true, AFTER_DRAIN = false;
    const float* X; float* X1; bf16* XW; const float* nw; float* SSQX;
    DI void operator()(Acc& acc, const Unit& u, int wr, int wc, int fr, int fq) const {
        const int cb = u.pn * 256 + wc * 32 + 8 * fq;
#pragma unroll
        for (int ai = 0; ai < 2; ++ai)
#pragma unroll
            for (int m = 0; m < 4; ++m) {
                const size_t row = (size_t)(u.pm * 256 + ai * 128 + wr * 64 + m * 16 + fr);
                float ss = 0.f;
#pragma unroll
                for (int bj = 0; bj < 2; ++bj) {
                    const size_t off = row * 1024 + cb + bj * 128;
                    const f32x4 x0 = *(const f32x4*)(X + off), x1v = *(const f32x4*)(X + off + 4);
                    const f32x4 w0 = *(const f32x4*)(nw + cb + bj * 128), w1 = *(const f32x4*)(nw + cb + bj * 128 + 4);
                    const f32x4 a0 = acc[ai][bj][m][0] + x0, a1 = acc[ai][bj][m][1] + x1v;
                    *(f32x4*)(X1 + off) = a0; *(f32x4*)(X1 + off + 4) = a1;
                    ss += (a0[0] * a0[0] + a0[1] * a0[1]) + (a0[2] * a0[2] + a0[3] * a0[3]) + (a1[0] * a1[0] + a1[1] * a1[1]) + (a1[2] * a1[2] + a1[3] * a1[3]);
                    *(u32x4*)(XW + off) = pack8(a0 * w0, a1 * w1);
                }
                ss += __shfl_xor(ss, 16); ss += __shfl_xor(ss, 32);
                if (fq == 0) SSQX[row * 16 + u.pn * 4 + wc] = ss;
            }
    }
};
DI float rstd_x1(const float* SSQX, size_t row) {
    const f32x4 a = *(const f32x4*)(SSQX + row * 16), b = *(const f32x4*)(SSQX + row * 16 + 4), c = *(const f32x4*)(SSQX + row * 16 + 8), d = *(const f32x4*)(SSQX + row * 16 + 12);
    const float s = ((a[0] + a[1]) + (a[2] + a[3])) + ((b[0] + b[1]) + (b[2] + b[3])) + ((c[0] + c[1]) + (c[2] + c[3])) + ((d[0] + d[1]) + (d[2] + d[3]));
    return rsqrtf(s * (1.f / 1024.f) + EPS);
}
struct EpiQ {
    static constexpr bool PERM = true, AFTER_DRAIN = false;
    bf16* Q; const float* SSQX;
    DI void operator()(Acc& acc, const Unit& u, int wr, int wc, int fr, int fq) const {
        const int cb = u.pn * 256 + wc * 32 + 8 * fq;
#pragma unroll
        for (int ai = 0; ai < 2; ++ai)
#pragma unroll
            for (int m = 0; m < 4; ++m) {
                const size_t row = (size_t)(u.pm * 256 + ai * 128 + wr * 64 + m * 16 + fr);
                const float rs = rstd_x1(SSQX, row);
#pragma unroll
                for (int bj = 0; bj < 2; ++bj) *(u32x4*)(Q + row * 2048 + cb + bj * 128) = pack8(acc[ai][bj][m][0] * rs, acc[ai][bj][m][1] * rs);
            }
    }
};

#define MFMA32(a, b, c) __builtin_amdgcn_mfma_f32_32x32x16_bf16((a), (b), (c), 0, 0, 0)
DI bf16x8 ldg16(const bf16* p) { return *(const bf16x8*)p; }
DI bf16x8 ldg2x8(const bf16* p0, const bf16* p1) { const s16x4 a = *(const s16x4*)p0, b = *(const s16x4*)p1; return __builtin_shufflevector(a, b, 0, 1, 2, 3, 4, 5, 6, 7); }
DI bf16x8 packx(const f32x16& x, int s) {
    u32x4 p; p.x = pk2(x[8 * s + 0], x[8 * s + 1]); p.y = pk2(x[8 * s + 2], x[8 * s + 3]); p.z = pk2(x[8 * s + 4], x[8 * s + 5]); p.w = pk2(x[8 * s + 6], x[8 * s + 7]);
    return __builtin_bit_cast(bf16x8, p);
}
DI f32x16 zero16() { f32x16 z;
#pragma unroll
    for (int i = 0; i < 16; ++i) z[i] = 0.f; return z; }

DI bf16x8 tr_frag(const LAS unsigned char* tile, int RS, int lane, int ks, int c) {
    const int hh = lane >> 5, blk = (lane >> 4) & 1, q = (lane & 15) >> 2, p = lane & 3;
    const LAS unsigned char* a0 = tile + (16 * ks + 8 * hh + q) * RS + (32 * c + 16 * blk + 4 * p) * 2;
    const s16x4 lo = __builtin_amdgcn_ds_read_tr16_b64_v4i16((LAS s16x4*)a0);
    const s16x4 hi = __builtin_amdgcn_ds_read_tr16_b64_v4i16((LAS s16x4*)(a0 + 4 * RS));
    return __builtin_shufflevector(lo, hi, 0, 1, 2, 3, 4, 5, 6, 7);
}

DI bf16x8 tr_frag_perm(const LAS unsigned char* tile, int RS, int lane, int ks, int c) {
    const int hh = lane >> 5, blk = (lane >> 4) & 1, q = (lane & 15) >> 2, p = lane & 3;
    const LAS unsigned char* a0 = tile + (16 * ks + 4 * hh + q) * RS + (32 * c + 16 * blk + 4 * p) * 2;
    const s16x4 lo = __builtin_amdgcn_ds_read_tr16_b64_v4i16((LAS s16x4*)a0);
    const s16x4 hi = __builtin_amdgcn_ds_read_tr16_b64_v4i16((LAS s16x4*)(a0 + 8 * RS));
    return __builtin_shufflevector(lo, hi, 0, 1, 2, 3, 4, 5, 6, 7);
}

constexpr int HG_KRS = 320;
DI void hg_pass1(LAS unsigned char* lds, const bf16* Kh, const bf16* VTh, bf16* STh, int wg, int nwg) {
    const int tid = fresh_tid(), lane = tid & 63, w = __builtin_amdgcn_readfirstlane(tid >> 6), r = lane & 31, hh = lane >> 5;
    for (int unit = wg; unit < 16 * HG_NC; unit += nwg) {
        const int bh = unit >> 7, c = unit & 127, b = bh >> 3, h = bh & 7;
        __syncthreads();
        {
            const int row = tid >> 3, ch = tid & 7;
            const bf16* src = Kh + ((size_t)(b * SEQ + c * 64 + row)) * 1024 + h * 128;
            const bf16x8 v0 = ldg16(src + ch * 8), v1 = ldg16(src + 64 + ch * 8);
            *(LAS bf16x8*)(lds + row * HG_KRS + ch * 16) = v0; *(LAS bf16x8*)(lds + row * HG_KRS + 128 + ch * 16) = v1;
        }
        __syncthreads();
        const int mt = w & 3, nt0 = w >> 2;
        f32x16 a0 = zero16(), a1 = zero16();
        const bf16* vrow = VTh + (((size_t)(bh * 128 + 32 * mt + r)) << 13) + c * 64;
#pragma unroll
        for (int ks = 0; ks < 4; ++ks) {
            const bf16x8 av = ldg16(vrow + 16 * ks + 8 * hh);
            a0 = MFMA32(av, tr_frag(lds, HG_KRS, lane, ks, nt0), a0);
            a1 = MFMA32(av, tr_frag(lds, HG_KRS, lane, ks, nt0 + 2), a1);
        }
        bf16* dst = STh + ((size_t)(bh * HG_NC + c)) * 16384;
#pragma unroll
        for (int i = 0; i < 16; ++i) {
            const int v = 32 * mt + crow(i, hh);
            dst[v * 128 + 32 * nt0 + r] = f2bf(a0[i]); dst[v * 128 + 32 * (nt0 + 2) + r] = f2bf(a1[i]);
        }
    }
    __syncthreads();
}

DI void hg_scan(bf16* STh, const float* DEC, int gtid, int gsz) {
    for (int idx = gtid; idx < 16 * 128 * 32; idx += gsz) {
        const int dq = idx & 31, v = (idx >> 5) & 127, bh = idx >> 12;
        f32x4 carry = {0.f, 0.f, 0.f, 0.f};
        bf16* p = STh + ((size_t)bh * HG_NC) * 16384 + v * 128 + dq * 4;
        const float* dp = DEC + ((size_t)bh * HG_NC) * 128 + dq * 4;
#pragma unroll 8
        for (int c = 0; c < HG_NC; ++c) {
            const u32x2 wv = *(const u32x2*)(p + (size_t)c * 16384);
            const f32x4 dec = *(const f32x4*)(dp + c * 128);
            u32x2 o; o.x = pk2(carry[0], carry[1]); o.y = pk2(carry[2], carry[3]);
            *(u32x2*)(p + (size_t)c * 16384) = o;
            carry[0] = dec[0] * (carry[0] + bflo(wv.x)); carry[1] = dec[1] * (carry[1] + bfhi(wv.x));
            carry[2] = dec[2] * (carry[2] + bflo(wv.y)); carry[3] = dec[3] * (carry[3] + bfhi(wv.y));
        }
    }
}
DI void rt_scan(bf16* STr, int gtid, int gsz) {
    for (int idx = gtid; idx < 8 * 512 * 32; idx += gsz) {
        const int dq = idx & 31, v = (idx >> 5) & 511, bh = idx >> 14, h = bh & 3;
        const float dec = exp2f((float)RT_L * __log2f(1.f - exp2f(-5.f - (float)h)));
        float carry[8];
#pragma unroll
        for (int e = 0; e < 8; ++e) carry[e] = 0.f;
        bf16* p = STr + ((size_t)bh * RT_NS) * 131072 + v * 256 + dq * 8;
#pragma unroll 4
        for (int c = 0; c < RT_NS; ++c) {
            const u32x4 wv = *(const u32x4*)(p + (size_t)c * 131072);
            u32x4 o; o.x = pk2(carry[0], carry[1]); o.y = pk2(carry[2], carry[3]); o.z = pk2(carry[4], carry[5]); o.w = pk2(carry[6], carry[7]);
            *(u32x4*)(p + (size_t)c * 131072) = o;
            if (c == RT_NS - 1) break;
            carry[0] = dec * (carry[0] + bflo(wv.x)); carry[1] = dec * (carry[1] + bfhi(wv.x));
            carry[2] = dec * (carry[2] + bflo(wv.y)); carry[3] = dec * (carry[3] + bfhi(wv.y));
            carry[4] = dec * (carry[4] + bflo(wv.z)); carry[5] = dec * (carry[5] + bfhi(wv.z));
            carry[6] = dec * (carry[6] + bflo(wv.w)); carry[7] = dec * (carry[7] + bfhi(wv.w));
        }
    }
}

DI void hg_pass3(LAS unsigned char* lds, const bf16* Qh, const bf16* Kh, const bf16* VTh, const bf16* STh, const float* hg_norm_w, bf16* OHG, int gw, int ngw, int dry) {
    const int tid_ = fresh_tid(), lane = tid_ & 63, r = lane & 31, hh = lane >> 5;
    LAS unsigned char* ot = lds + __builtin_amdgcn_readfirstlane(tid_ >> 6) * 8704;
    for (int unit = gw; unit < 16 * HG_NC * 2; unit += ngw) {
        const int tb = unit & 1, c = (unit >> 1) & 127, bh = unit >> 8, b = bh >> 3, h = bh & 7;
        const size_t trow = (size_t)(b * SEQ + c * 64 + tb * 32 + r);
        bf16x8 qf[8];
#pragma unroll
        for (int kk = 0; kk < 8; ++kk) qf[kk] = ldg16(Qh + trow * 1024 + h * 128 + kk * 16 + 8 * hh);
        f32x16 acc[4];
#pragma unroll
        for (int nv = 0; nv < 4; ++nv) acc[nv] = zero16();
        for (int sb = 0; sb <= tb; ++sb) {
            const size_t srow = (size_t)(b * SEQ + c * 64 + sb * 32 + r);
            f32x16 x = zero16();
#pragma unroll
            for (int kk = 0; kk < 8; ++kk) x = MFMA32(ldg16(Kh + srow * 1024 + h * 128 + kk * 16 + 8 * hh), qf[kk], x);
            if (sb == tb) {
#pragma unroll
                for (int i = 0; i < 16; ++i) if (crow(i, hh) > r) x[i] = 0.f;
            }
            const bf16x8 xs0 = packx(x, 0), xs1 = packx(x, 1);
#pragma unroll
            for (int nv = 0; nv < 4; ++nv) {
                const bf16* vb = VTh + (((size_t)(bh * 128 + nv * 32 + r)) << 13) + c * 64 + sb * 32 + 4 * hh;
                acc[nv] = MFMA32(ldg2x8(vb, vb + 8), xs0, acc[nv]);
                acc[nv] = MFMA32(ldg2x8(vb + 16, vb + 24), xs1, acc[nv]);
            }
        }
        const bf16* st = STh + ((size_t)(bh * HG_NC + c)) * 16384;
#pragma unroll
        for (int nv = 0; nv < 4; ++nv)
#pragma unroll
            for (int kk = 0; kk < 8; ++kk) acc[nv] = MFMA32(ldg16(st + (nv * 32 + r) * 128 + kk * 16 + 8 * hh), qf[kk], acc[nv]);
        float ss = 0.f;
#pragma unroll
        for (int nv = 0; nv < 4; ++nv)
#pragma unroll
            for (int i = 0; i < 16; ++i) ss += acc[nv][i] * acc[nv][i];
        ss += __shfl_xor(ss, 32);
        const float rs = rsqrtf(ss * (1.f / 128.f) + EPS);
#pragma unroll
        for (int nv = 0; nv < 4; ++nv)
#pragma unroll
            for (int g = 0; g < 4; ++g) {
                const int v = nv * 32 + 8 * g + 4 * hh;
                const f32x4 wv = *(const f32x4*)(hg_norm_w + h * 128 + v);
                u32x2 o; o.x = pk2(acc[nv][4 * g] * rs * wv[0], acc[nv][4 * g + 1] * rs * wv[1]); o.y = pk2(acc[nv][4 * g + 2] * rs * wv[2], acc[nv][4 * g + 3] * rs * wv[3]);
                *(LAS u32x2*)(ot + r * 272 + v * 2) = o;
            }
        bf16* orow = OHG + ((size_t)(b * SEQ + c * 64 + tb * 32)) * 1024 + h * 128;
#pragma unroll
        for (int k = 0; k < 8; ++k) {
            const int row = 4 * k + (lane >> 4), ch = lane & 15;
            const u32x4 val = *(const LAS u32x4*)(ot + row * 272 + ch * 16);
            bf16* gp = orow + (size_t)row * 1024 + ch * 8;
            const u32x4 gt = *(const u32x4*)gp;
            u32x4 o;
            o.x = pk2(bflo(val.x) * bflo(gt.x), bfhi(val.x) * bfhi(gt.x)); o.y = pk2(bflo(val.y) * bflo(gt.y), bfhi(val.y) * bfhi(gt.y));
            o.z = pk2(bflo(val.z) * bflo(gt.z), bfhi(val.z) * bfhi(gt.z)); o.w = pk2(bflo(val.w) * bflo(gt.w), bfhi(val.w) * bfhi(gt.w));
            if (!dry) *(u32x4*)gp = o; else asm volatile("" :: "v"(o));
        }
    }
}

constexpr int RT_KRS = 576;
constexpr int RT_KBUF = 64 * RT_KRS;
DI void rt_pass1(LAS unsigned char* lds, const bf16* Kr, const bf16* VTr, bf16* STr, int wg, int nwg) {
    const int tid = fresh_tid(), lane = tid & 63, w = __builtin_amdgcn_readfirstlane(tid >> 6), r = lane & 31, hh = lane >> 5;
    const int wm = w & 3, wn = w >> 2;
    const int srow = tid >> 3, sch = tid & 7;
    for (int unit = wg; unit < 8 * (RT_NS - 1) * 2; unit += nwg) {
        const int vh = unit & 1, sg = (unit >> 1) % (RT_NS - 1), bh = (unit >> 1) / (RT_NS - 1), b = bh >> 2, h = bh & 3;
        f32x16 acc[2][4];
#pragma unroll
        for (int i = 0; i < 2; ++i)
#pragma unroll
            for (int j = 0; j < 4; ++j) acc[i][j] = zero16();
        const bf16* kbase = Kr + ((size_t)(b * SEQ + sg * RT_L)) * 1024 + h * 256;
        bf16x8 st[4];
#pragma unroll
        for (int i = 0; i < 4; ++i) st[i] = ldg16(kbase + (size_t)srow * 1024 + (sch + 8 * i) * 8);
        __syncthreads();
#pragma unroll
        for (int i = 0; i < 4; ++i) *(LAS bf16x8*)(lds + srow * RT_KRS + (sch + 8 * i) * 16) = st[i];
        for (int sb = 0; sb < RT_L / 64; ++sb) {
            const LAS unsigned char* cur = lds + (sb & 1) * RT_KBUF;
            if (sb + 1 < RT_L / 64) {
#pragma unroll
                for (int i = 0; i < 4; ++i) st[i] = ldg16(kbase + (size_t)((sb + 1) * 64 + srow) * 1024 + (sch + 8 * i) * 8);
            }
            __syncthreads();
#pragma unroll
            for (int ks = 0; ks < 4; ++ks) {
                bf16x8 av[2];
#pragma unroll
                for (int i = 0; i < 2; ++i) av[i] = ldg16(VTr + (((((size_t)(bh * 256 + sg * 16 + sb * 2 + (ks >> 1))) * 16 + vh * 8 + wm * 2 + i) * 2 + (ks & 1)) * 64 + lane) * 8);
#pragma unroll
                for (int j = 0; j < 4; ++j) {
                    const bf16x8 bv = tr_frag_perm(cur, RT_KRS, lane, ks, wn * 4 + j);
                    acc[0][j] = MFMA32(av[0], bv, acc[0][j]); acc[1][j] = MFMA32(av[1], bv, acc[1][j]);
                }
                __builtin_amdgcn_sched_barrier(0);
            }
            if (sb + 1 < RT_L / 64) {
                LAS unsigned char* nxt = lds + ((sb + 1) & 1) * RT_KBUF;
#pragma unroll
                for (int i = 0; i < 4; ++i) *(LAS bf16x8*)(nxt + srow * RT_KRS + (sch + 8 * i) * 16) = st[i];
            }
        }
        bf16* dst = STr + ((size_t)(bh * RT_NS + sg)) * 131072;
#pragma unroll
        for (int i = 0; i < 2; ++i)
#pragma unroll
            for (int j = 0; j < 4; ++j)
#pragma unroll
                for (int e = 0; e < 16; ++e) {
                    const int vl = crow(e, hh), d = wn * 128 + j * 32 + r;
                    dst[((((vh * 8 + wm * 2 + i) * 16 + (d >> 4)) * 64 + vl + 32 * ((d >> 3) & 1)) << 3) + (d & 7)] = f2bf(acc[i][j][e]);
                }
    }
    __syncthreads();
}

DI void rt_pass3_unit(const bf16* Qr, const bf16* Kr, const bf16* VTr, const bf16* STr, bf16* ORET, float* SSQP, int idx, int lane) {
    const int r = lane & 31, hh = lane >> 5;
    const int vh = idx & 1, tbl = (idx >> 1) & 15, sgid = idx >> 5, sg = sgid & 15, bh = sgid >> 4, b = bh >> 2, h = bh & 3;
    const int t0 = sg * RT_L + tbl * 32;
    const size_t trow = (size_t)(b * SEQ + t0 + r);
    const bf16* qrow = Qr + trow * 1024 + h * 256 + 8 * hh;
    f32x16 acc[8];
#pragma unroll
    for (int nv = 0; nv < 8; ++nv) acc[nv] = zero16();
    for (int sb = 0; sb <= tbl; ++sb) {
        const int s0 = sg * RT_L + sb * 32;
        const bf16* krow = Kr + ((size_t)(b * SEQ + s0 + r)) * 1024 + h * 256 + 8 * hh;
        f32x16 x = zero16();
#pragma unroll
        for (int k4 = 0; k4 < 4; ++k4) {
            bf16x8 kf[4], qf[4];
#pragma unroll
            for (int i = 0; i < 4; ++i) { kf[i] = ldg16(krow + (k4 * 4 + i) * 16); qf[i] = ldg16(qrow + (k4 * 4 + i) * 16); }
#pragma unroll
            for (int i = 0; i < 4; ++i) x = MFMA32(kf[i], qf[i], x);
            __builtin_amdgcn_sched_barrier(0);
        }
        if (sb == tbl) {
#pragma unroll
            for (int i = 0; i < 16; ++i) if (crow(i, hh) > r) x[i] = 0.f;
        }
        const bf16x8 xs0 = packx(x, 0), xs1 = packx(x, 1);
#pragma unroll
        for (int nv = 0; nv < 8; ++nv) {
            const bf16* vb = VTr + (((size_t)(bh * 512 + vh * 256 + nv * 32 + r)) << 13) + s0 + 4 * hh;
            acc[nv] = MFMA32(ldg2x8(vb, vb + 8), xs0, acc[nv]);
            acc[nv] = MFMA32(ldg2x8(vb + 16, vb + 24), xs1, acc[nv]);
            if ((nv & 3) == 3) __builtin_amdgcn_sched_barrier(0);
        }
    }
    const bf16* st = STr + ((size_t)(bh * RT_NS + sg)) * 131072 + (size_t)(vh * 256) * 256;
#pragma unroll 2
    for (int kk = 0; kk < 16; ++kk) {
        const bf16x8 q = ldg16(qrow + kk * 16);
#pragma unroll
        for (int nv = 0; nv < 8; ++nv) acc[nv] = MFMA32(ldg16(st + (nv * 32 + r) * 256 + kk * 16 + 8 * hh), q, acc[nv]);
        __builtin_amdgcn_sched_barrier(0);
    }
    float ss = 0.f;
#pragma unroll
    for (int nv = 0; nv < 8; ++nv)
#pragma unroll
        for (int i = 0; i < 16; ++i) ss += acc[nv][i] * acc[nv][i];
    ss += __shfl_xor(ss, 32);
    if (hh == 0) SSQP[trow * 8 + h * 2 + vh] = ss;
#pragma unroll
    for (int nv = 0; nv < 8; ++nv)
#pragma unroll
        for (int g = 0; g < 4; ++g) {
            const int v = vh * 256 + nv * 32 + 8 * g + 4 * hh;
            u32x2 o; o.x = pk2(acc[nv][4 * g], acc[nv][4 * g + 1]); o.y = pk2(acc[nv][4 * g + 2], acc[nv][4 * g + 3]);
            *(u32x2*)(ORET + trow * 2048 + h * 512 + v) = o;
        }
}
DI void rt_pass3(const bf16* Qr, const bf16* Kr, const bf16* VTr, const bf16* STr, bf16* ORET, float* SSQP, int gw, int ngw) {
    const int lane = fresh_tid() & 63;
    for (int u = gw; u < 2048; u += ngw) {
        rt_pass3_unit(Qr, Kr, VTr, STr, ORET, SSQP, u, lane);
        const int p = (u & 1) | ((15 - ((u >> 1) & 15)) << 1) | (((u >> 5) + 64) << 5);
        rt_pass3_unit(Qr, Kr, VTr, STr, ORET, SSQP, p, lane);
    }
}

constexpr int RQ_RS = 528;
constexpr int RQ_QBYTES = 128 * RQ_RS, RQ_KBYTES = 32 * RQ_RS;
DI void rt_pass3_wg(LAS unsigned char* lds, const bf16* Qr, const bf16* Kr, const bf16* VTr, const bf16* STr, bf16* ORET, float* SSQP, int wg, int nwg, int dry) {
    const int tid = fresh_tid(), lane = tid & 63, w = __builtin_amdgcn_readfirstlane(tid >> 6), r = lane & 31, hh = lane >> 5;
    const int tsub = w & 3, vh = w >> 2;
    LAS unsigned char* Qs = lds;
    LAS unsigned char* Ks = lds + RQ_QBYTES;
    for (int pairidx = wg; pairidx < 256; pairidx += nwg) {
#pragma unroll 1
        for (int half = 0; half < 2; ++half) {
            const int sgid = pairidx >> 1, bh = sgid >> 4, sg = sgid & 15, b = bh >> 2, h = bh & 3;
            const int qq = half ? 3 - (pairidx & 1) : (pairidx & 1);
            const int pos0 = sg * RT_L + qq * 128, nsb = 4 * qq + 4, mysb = 4 * qq + tsub;
            const bf16* qsrc = Qr + ((size_t)(b * SEQ + pos0)) * 1024 + h * 256;
            const bf16* ksrc = Kr + ((size_t)(b * SEQ + sg * RT_L)) * 1024 + h * 256;
            unsigned stoff = (unsigned)((tid >> 5) * 1024 + (tid & 31) * 8);
            unsigned stlds = (unsigned)((tid >> 5) * RQ_RS + (tid & 31) * 16);
            asm volatile("" : "+v"(stoff), "+v"(stlds));
            __syncthreads();
#pragma unroll
            for (int i = 0; i < 8; ++i) *(LAS bf16x8*)(Qs + stlds + i * 16 * RQ_RS) = ldg16(qsrc + i * 16 * 1024 + stoff);
            bf16x8 kst[2];
#pragma unroll
            for (int i = 0; i < 2; ++i) *(LAS bf16x8*)(Ks + stlds + i * 16 * RQ_RS) = ldg16(ksrc + i * 16 * 1024 + stoff);
            f32x16 acc[8];
#pragma unroll
            for (int nv = 0; nv < 8; ++nv) acc[nv] = zero16();
            __syncthreads();
            const LAS unsigned char* qfr = Qs + (tsub * 32 + r) * RQ_RS + 16 * hh;
            {
                const bf16* st = STr + ((size_t)(bh * RT_NS + sg)) * 131072 + (size_t)(vh * 8) * 16 * 512;
                unsigned so = (unsigned)(lane * 8);
                asm volatile("" : "+v"(so));
                bf16x8 fa[8], fb[8];
#pragma unroll
                for (int nv = 0; nv < 8; ++nv) fa[nv] = ldg16(st + nv * 16 * 512 + so);
#pragma unroll 1
                for (int k2 = 0; k2 < 8; ++k2) {
#pragma unroll
                    for (int nv = 0; nv < 8; ++nv) fb[nv] = ldg16(st + nv * 16 * 512 + (2 * k2 + 1) * 512 + so);
                    {
                        const bf16x8 q = *(const LAS bf16x8*)(qfr + (2 * k2) * 32);
#pragma unroll
                        for (int nv = 0; nv < 8; ++nv) acc[nv] = MFMA32(fa[nv], q, acc[nv]);
                    }
                    __builtin_amdgcn_sched_barrier(0);
                    if (k2 < 7) {
#pragma unroll
                        for (int nv = 0; nv < 8; ++nv) fa[nv] = ldg16(st + nv * 16 * 512 + (2 * k2 + 2) * 512 + so);
                    }
                    {
                        const bf16x8 q = *(const LAS bf16x8*)(qfr + (2 * k2 + 1) * 32);
#pragma unroll
                        for (int nv = 0; nv < 8; ++nv) acc[nv] = MFMA32(fb[nv], q, acc[nv]);
                    }
                    __builtin_amdgcn_sched_barrier(0);
                }
            }
            const bf16* vbase = VTr + (((size_t)(bh * 256 + sg * 16)) * 16 + vh * 8) * 1024;
            unsigned vo = (unsigned)(lane * 8);
            asm volatile("" : "+v"(vo));
#pragma unroll 1
            for (int sb = 0; sb < nsb; ++sb) {
                const LAS unsigned char* kcur = Ks + (sb & 1) * RQ_KBYTES;
                if (sb + 1 < nsb) {
#pragma unroll
                    for (int i = 0; i < 2; ++i) kst[i] = ldg16(ksrc + (size_t)(sb + 1) * 32 * 1024 + i * 16 * 1024 + stoff);
                }
                if (sb <= mysb) {
                    bf16x8 vt[8][2];
                    const bf16* vb = vbase + (size_t)sb * 16 * 1024;
#pragma unroll
                    for (int nv = 0; nv < 8; ++nv) { vt[nv][0] = ldg16(vb + nv * 1024 + vo); vt[nv][1] = ldg16(vb + nv * 1024 + 512 + vo); }
                    f32x16 x = zero16();
                    const LAS unsigned char* kfr = kcur + r * RQ_RS + 16 * hh;
#pragma unroll
                    for (int kk = 0; kk < 16; ++kk) { x = MFMA32(*(const LAS bf16x8*)(kfr + kk * 32), *(const LAS bf16x8*)(qfr + kk * 32), x); if (kk & 1) __builtin_amdgcn_sched_barrier(0); }
                    if (sb == mysb) {
#pragma unroll
                        for (int i = 0; i < 16; ++i) if (crow(i, hh) > r) x[i] = 0.f;
                    }
                    const bf16x8 xs0 = packx(x, 0), xs1 = packx(x, 1);
#pragma unroll
                    for (int nv = 0; nv < 8; ++nv) { acc[nv] = MFMA32(vt[nv][0], xs0, acc[nv]); acc[nv] = MFMA32(vt[nv][1], xs1, acc[nv]); }
                }
                if (sb + 1 < nsb) {
                    LAS unsigned char* knx = Ks + ((sb + 1) & 1) * RQ_KBYTES;
#pragma unroll
                    for (int i = 0; i < 2; ++i) *(LAS bf16x8*)(knx + stlds + i * 16 * RQ_RS) = kst[i];
                }
                __syncthreads();
            }
            float ss = 0.f;
#pragma unroll
            for (int nv = 0; nv < 8; ++nv)
#pragma unroll
                for (int i = 0; i < 16; ++i) ss += acc[nv][i] * acc[nv][i];
            ss += __shfl_xor(ss, 32);
            LAS float* sx = (LAS float*)(lds + 8 * 16896);
            if (hh == 0) sx[vh * 128 + tsub * 32 + r] = ss;
            __syncthreads();
            const float rs = rsqrtf((sx[tsub * 32 + r] + sx[128 + tsub * 32 + r]) * (1.f / 512.f) + EPS);
            LAS unsigned char* ot = lds + w * 16896;
#pragma unroll
            for (int nv = 0; nv < 8; ++nv)
#pragma unroll
                for (int g = 0; g < 4; ++g) {
                    u32x2 o; o.x = pk2(acc[nv][4 * g] * rs, acc[nv][4 * g + 1] * rs); o.y = pk2(acc[nv][4 * g + 2] * rs, acc[nv][4 * g + 3] * rs);
                    *(LAS u32x2*)(ot + r * 528 + (nv * 32 + 8 * g + 4 * hh) * 2) = o;
                }
            bf16* orow = ORET + (size_t)(b * SEQ + pos0 + tsub * 32) * 2048 + h * 512 + vh * 256;
#pragma unroll 4
            for (int k = 0; k < 16; ++k) {
                const int row = 2 * k + (lane >> 5), ch = lane & 31;
                const u32x4 val = *(const LAS u32x4*)(ot + row * 528 + ch * 16);
                bf16* gp = orow + (size_t)row * 2048 + ch * 8;
                const u32x4 gt = *(const u32x4*)gp;
                u32x4 o;
                o.x = pk2(bflo(val.x) * bflo(gt.x), bfhi(val.x) * bfhi(gt.x)); o.y = pk2(bflo(val.y) * bflo(gt.y), bfhi(val.y) * bfhi(gt.y));
                o.z = pk2(bflo(val.z) * bflo(gt.z), bfhi(val.z) * bfhi(gt.z)); o.w = pk2(bflo(val.w) * bflo(gt.w), bfhi(val.w) * bfhi(gt.w));
                if (!dry) *(u32x4*)gp = o; else asm volatile("" :: "v"(o));
            }
        }
    }
    __syncthreads();
}

DI float dot2bf(unsigned a, unsigned b, float c) {
#if __has_builtin(__builtin_amdgcn_fdot2_f32_bf16)
    typedef __bf16 nb2 __attribute__((ext_vector_type(2)));
    return __builtin_amdgcn_fdot2_f32_bf16(__builtin_bit_cast(nb2, a), __builtin_bit_cast(nb2, b), c, false);
#else
    return c + bflo(a) * bflo(b) + bfhi(a) * bfhi(b);
#endif
}
DI void wave_argmax(float& v, int& idx) {
#pragma unroll
    for (int o = 1; o < 64; o <<= 1) {
        const float ov = __shfl_xor(v, o); const int oi = __shfl_xor(idx, o);
        if (ov > v || (ov == v && oi < idx)) { v = ov; idx = oi; }
    }
}

DI void peer_topk1(const bf16* Q, const bf16* SK, float* TOPS, int* TOPI, int wg, int nwg) {
    const int tid = fresh_tid(), lane = tid & 63, w = __builtin_amdgcn_readfirstlane(tid >> 6);
    for (int unit = wg; unit < 16 * 16; unit += nwg) {
        const int hp = unit & 15, tblk = unit >> 4;
        unsigned k0[64], k1[64];
        {
            const u32x4* p0 = (const u32x4*)(SK + ((size_t)(hp * 128 + lane)) * 128);
            const u32x4* p1 = (const u32x4*)(SK + ((size_t)(hp * 128 + 64 + lane)) * 128);
#pragma unroll
            for (int i = 0; i < 16; ++i) { const u32x4 a = p0[i], b = p1[i]; k0[4 * i] = a.x; k0[4 * i + 1] = a.y; k0[4 * i + 2] = a.z; k0[4 * i + 3] = a.w; k1[4 * i] = b.x; k1[4 * i + 1] = b.y; k1[4 * i + 2] = b.z; k1[4 * i + 3] = b.w; }
        }
        for (int tt = 0; tt < 128; ++tt) {
            const int t = tblk * 1024 + w * 128 + tt;
            const u32x4* qp = (const u32x4*)(Q + (size_t)t * 2048 + hp * 128);
            float s0 = 0.f, s1 = 0.f;
#pragma unroll
            for (int i = 0; i < 16; ++i) {
                const u32x4 qv = qp[i];
                s0 = dot2bf(k0[4 * i], qv.x, s0); s0 = dot2bf(k0[4 * i + 1], qv.y, s0); s0 = dot2bf(k0[4 * i + 2], qv.z, s0); s0 = dot2bf(k0[4 * i + 3], qv.w, s0);
                s1 = dot2bf(k1[4 * i], qv.x, s1); s1 = dot2bf(k1[4 * i + 1], qv.y, s1); s1 = dot2bf(k1[4 * i + 2], qv.z, s1); s1 = dot2bf(k1[4 * i + 3], qv.w, s1);
            }
            float myv = 0.f; int myi = 0;
            for (int rnd = 0; rnd < 16; ++rnd) {
                float v; int idx;
                if (s0 >= s1) { v = s0; idx = lane; } else { v = s1; idx = lane + 64; }
                wave_argmax(v, idx);
                if (idx == lane) s0 = -3.0e38f;
                if (idx == lane + 64) s1 = -3.0e38f;
                if (lane == rnd) { myv = v; myi = idx; }
            }
            if (lane < 16) { TOPS[((size_t)t * 16 + hp) * 16 + lane] = myv; TOPI[((size_t)t * 16 + hp) * 16 + lane] = myi; }
        }
    }
}

DI void peer_cand(const float* TOPS, const int* TOPI, int* EIDX, float* EGATE, int gw, int ngw) {
    const int lane = fresh_tid() & 63;
    for (int unit = gw; unit < T * PE_H; unit += ngw) {
        const int t = unit >> 3, h = unit & 7;
        const float* s1p = TOPS + ((size_t)t * 16 + h * 2) * 16;
        const int i1 = lane >> 2, j0 = (lane & 3) * 4;
        const float a = s1p[i1];
        const f32x4 bq = *(const f32x4*)(s1p + 16 + j0);
        float c0 = a + bq[0], c1 = a + bq[1], c2 = a + bq[2], c3 = a + bq[3];
        float myv = 0.f; int myc = 0;
        for (int rnd = 0; rnd < 16; ++rnd) {
            float v = c0; int idx = 4 * lane;
            if (c1 > v) { v = c1; idx = 4 * lane + 1; }
            if (c2 > v) { v = c2; idx = 4 * lane + 2; }
            if (c3 > v) { v = c3; idx = 4 * lane + 3; }
            wave_argmax(v, idx);
            if (idx == 4 * lane) c0 = -3.0e38f;
            if (idx == 4 * lane + 1) c1 = -3.0e38f;
            if (idx == 4 * lane + 2) c2 = -3.0e38f;
            if (idx == 4 * lane + 3) c3 = -3.0e38f;
            if (lane == rnd) { myv = v; myc = idx; }
        }
        const float mx = __shfl(myv, 0);
        float ex = lane < 16 ? __expf(myv - mx) : 0.f;
        float sum = ex;
#pragma unroll
        for (int o = 1; o < 16; o <<= 1) sum += __shfl_xor(sum, o);
        if (lane < 16) {
            const int ci = myc >> 4, cj = myc & 15;
            const int e = TOPI[((size_t)t * 16 + h * 2) * 16 + ci] * PE_NK + TOPI[((size_t)t * 16 + h * 2 + 1) * 16 + cj];
            EIDX[(size_t)t * 128 + h * 16 + lane] = e;
            EGATE[(size_t)t * 128 + h * 16 + lane] = ex / sum;
        }
    }
}


DI unsigned key_pack(float s, unsigned lowbits, unsigned mask) {
    unsigned u = __float_as_uint(s); u = (u & 0x80000000u) ? ~u : (u | 0x80000000u);
    return (u & ~mask) | lowbits;
}
DI float key_val(unsigned k, unsigned mask) { unsigned u = k & ~mask; u = (u & 0x80000000u) ? (u & 0x7fffffffu) : ~u; return __uint_as_float(u); }
DI unsigned umin_(unsigned a, unsigned b) { return a < b ? a : b; }
DI unsigned umax_(unsigned a, unsigned b) { return a > b ? a : b; }
DI void ins16(unsigned (&t)[16], unsigned x) {
#pragma unroll
    for (int i = 15; i >= 1; --i) t[i] = umax_(umin_(t[i - 1], t[i]), umin_(umax_(t[i - 1], t[i]), x));
    t[0] = umax_(t[0], x);
}
constexpr int PR_KOFF = 20480, PR_KRS = 272;
DI void peer_retrieve(LAS unsigned char* lds, const bf16* Q, const bf16* SK, int* EIDX, float* EGATE, int wg, int nwg) {
    const int tid = fresh_tid(), lane = tid & 63, w = __builtin_amdgcn_readfirstlane(tid >> 6), r = lane & 31, hh = lane >> 5;
    LAS unsigned char* myl = lds + w * 2304 + lane * 36;
    LAS unsigned char* ks = lds + PR_KOFF;
    int staged_h = -1;
    for (int unit = 2 * wg; unit < 512; unit += (unit & 1) ? 2 * nwg - 1 : 1) {
        const int h = unit >> 6, tb = (unit & 63) * 8 + w;
        if (h != staged_h) {
            __syncthreads();
#pragma unroll
            for (int i = 0; i < 8; ++i) { const int cidx = tid + 512 * i, row = cidx >> 4, ch = cidx & 15;
                *(LAS bf16x8*)(ks + row * PR_KRS + ch * 16) = ldg16(SK + ((size_t)(h * 256 + row)) * 128 + ch * 8); }
            __syncthreads();
            staged_h = h;
        }
        const size_t trow = (size_t)(tb * 32 + r);
        bf16x8 qf[2][8];
        {
            const bf16* qrow = Q + trow * 2048 + h * 256 + 8 * hh;
#pragma unroll
            for (int p = 0; p < 2; ++p)
#pragma unroll
                for (int kk = 0; kk < 8; ++kk) qf[p][kk] = ldg16(qrow + p * 128 + kk * 16);
        }
        unsigned L[2][16];
#pragma unroll
        for (int p = 0; p < 2; ++p) {
            f32x16 acc[4];
#pragma unroll
            for (int mt = 0; mt < 4; ++mt) acc[mt] = zero16();
            const LAS unsigned char* kfr = ks + (p * 128 + r) * PR_KRS + 16 * hh;
#pragma unroll
            for (int kk = 0; kk < 8; ++kk) {
#pragma unroll
                for (int mt = 0; mt < 4; ++mt) acc[mt] = MFMA32(*(const LAS bf16x8*)(kfr + mt * 32 * PR_KRS + kk * 32), qf[p][kk], acc[mt]);
                if (kk & 1) __builtin_amdgcn_sched_barrier(0);
            }
            unsigned t[16];
#pragma unroll
            for (int i = 0; i < 16; ++i) t[i] = 0u;
#pragma unroll
            for (int mt = 0; mt < 4; ++mt)
#pragma unroll
                for (int i = 0; i < 16; ++i) ins16(t, key_pack(acc[mt][i], (unsigned)(127 - 32 * mt - (i & 3) - 8 * (i >> 2)) - 4u * (unsigned)hh, 127u));
            unsigned o[16];
#pragma unroll
            for (int i = 0; i < 16; ++i) o[i] = (unsigned)__shfl_xor((int)t[i], 32);
#pragma unroll
            for (int i = 0; i < 16; ++i) ins16(t, o[i]);
#pragma unroll
            for (int i = 0; i < 16; ++i) L[p][i] = t[i];
        }
#pragma unroll
        for (int p = 0; p < 2; ++p)
#pragma unroll
            for (int g = 0; g < 4; ++g) {
                const unsigned v = (127u - (L[p][4 * g] & 127u)) | ((127u - (L[p][4 * g + 1] & 127u)) << 8) | ((127u - (L[p][4 * g + 2] & 127u)) << 16) | ((127u - (L[p][4 * g + 3] & 127u)) << 24);
                *(LAS unsigned*)(myl + p * 16 + g * 4) = v;
            }
        float a[16], b[16];
#pragma unroll
        for (int i = 0; i < 16; ++i) { a[i] = key_val(L[0][i], 127u); b[i] = key_val(L[1][i], 127u); }
        unsigned c[16];
#pragma unroll
        for (int i = 0; i < 16; ++i) c[i] = 0u;
#pragma unroll
        for (int i = 0; i < 16; ++i)
#pragma unroll
            for (int j = 0; j < 16; ++j)
                if ((i + 1) * (j + 1) <= 16) ins16(c, key_pack(a[i] + b[j], (unsigned)(255 - (16 * i + j)), 255u));
        float v[16];
        float sum = 0.f;
        const float mx = key_val(c[0], 255u);
#pragma unroll
        for (int k = 0; k < 16; ++k) { v[k] = __expf(key_val(c[k], 255u) - mx); sum += v[k]; }
        const float inv = 1.f / sum;
        asm volatile("s_waitcnt lgkmcnt(0)" ::: "memory");
        if (hh == 0) {
            int e[16];
#pragma unroll
            for (int k = 0; k < 16; ++k) {
                const unsigned cc = 255u - (c[k] & 255u);
                const unsigned i1 = *(LAS unsigned char*)(myl + (cc >> 4)), i2 = *(LAS unsigned char*)(myl + 16 + (cc & 15u));
                e[k] = (int)(i1 * 128u + i2);
            }
            int* ep = EIDX + trow * 128 + h * 16;
#pragma unroll
            for (int g = 0; g < 4; ++g) *(u32x4*)(ep + 4 * g) = (u32x4){(unsigned)e[4 * g], (unsigned)e[4 * g + 1], (unsigned)e[4 * g + 2], (unsigned)e[4 * g + 3]};
        } else {
            float* gp = EGATE + trow * 128 + h * 16;
#pragma unroll
            for (int g = 0; g < 4; ++g) *(f32x4*)(gp + 4 * g) = (f32x4){v[4 * g] * inv, v[4 * g + 1] * inv, v[4 * g + 2] * inv, v[4 * g + 3] * inv};
        }
        asm volatile("s_waitcnt lgkmcnt(0)" ::: "memory");
    }
}

DI float gelu_tanh(float x) {
    const float u = 0.7978845608028654f * (x + 0.044715f * x * x * x);
    const float e = __expf(2.f * u);
    const float th = 1.f - 2.f / (e + 1.f);
    return 0.5f * x * (1.f + th);
}

DI float bcast_f(float v, int j) { return __int_as_float(__builtin_amdgcn_readfirstlane(__float_as_int(__shfl(v, j)))); }
DI void quant_rows(const float* __restrict__ src, unsigned char* __restrict__ dst, float* __restrict__ scale, int nrows, int offs, int gw, int ngw, int lane) {
    for (int row0 = gw; row0 < nrows; row0 += 2 * ngw) {
        const int rowb = row0 + ngw, row1 = rowb < nrows ? rowb : row0;
        f32x4 v[2][4];
#pragma unroll
        for (int rr = 0; rr < 2; ++rr) { const f32x4* p = (const f32x4*)(src + (size_t)(rr ? row1 : row0) * 1024 + lane * 16);
#pragma unroll
            for (int i = 0; i < 4; ++i) v[rr][i] = p[i]; }
#pragma unroll
        for (int rr = 0; rr < 2; ++rr) {
            const int row = rr ? row1 : row0;
            float am = 0.f;
#pragma unroll
            for (int i = 0; i < 4; ++i)
#pragma unroll
                for (int e = 0; e < 4; ++e) am = fmaxf(am, fabsf(v[rr][i][e]));
#pragma unroll
            for (int o = 1; o < 64; o <<= 1) am = fmaxf(am, __shfl_xor(am, o));
            const float inv = am > 0.f ? 127.f / am : 0.f;
            u32x4 w;
#pragma unroll
            for (int i = 0; i < 4; ++i) {
                unsigned pk = 0u;
#pragma unroll
                for (int e = 0; e < 4; ++e) { const int q = (int)rintf(v[rr][i][e] * inv) + offs; pk |= ((unsigned)q & 0xffu) << (8 * e); }
                w[i] = pk;
            }
            if (rr == 0 || rowb < nrows) {
                *(u32x4*)(dst + ((size_t)(lane >> 3) * nrows + row) * 128 + (lane & 7) * 16) = w;
                if (lane == 0) scale[row] = am > 0.f ? am * (1.f / 127.f) : 0.f;
            }
        }
    }
}
DI void quant_xw(const bf16* XW, unsigned char* XQ8, float* XS, int gw, int ngw, int lane) {
    for (int t = gw; t < T; t += ngw) {
        const u32x4 xa = *(const u32x4*)(XW + (size_t)t * 1024 + lane * 16), xb = *(const u32x4*)(XW + (size_t)t * 1024 + lane * 16 + 8);
        float xf[16] = {bflo(xa.x), bfhi(xa.x), bflo(xa.y), bfhi(xa.y), bflo(xa.z), bfhi(xa.z), bflo(xa.w), bfhi(xa.w),
                        bflo(xb.x), bfhi(xb.x), bflo(xb.y), bfhi(xb.y), bflo(xb.z), bfhi(xb.z), bflo(xb.w), bfhi(xb.w)};
        float am = 0.f;
#pragma unroll
        for (int i = 0; i < 16; ++i) am = fmaxf(am, fabsf(xf[i]));
#pragma unroll
        for (int o = 1; o < 64; o <<= 1) am = fmaxf(am, __shfl_xor(am, o));
        const float inv = am > 0.f ? 127.f / am : 0.f;
        u32x4 w;
#pragma unroll
        for (int i = 0; i < 4; ++i) { unsigned pk = 0u;
#pragma unroll
            for (int e = 0; e < 4; ++e) pk |= ((unsigned)((int)rintf(xf[4 * i + e] * inv)) & 0xffu) << (8 * e);
            w[i] = pk; }
        *(u32x4*)(XQ8 + ((size_t)(lane >> 3) * T + t) * 128 + (lane & 7) * 16) = w;
        if (lane == 0) XS[t] = am * (1.f / 127.f);
    }
}
DI int dpp_xor1(int v) { return __builtin_amdgcn_update_dpp(0, v, 0xB1, 0xF, 0xF, false); }
DI int dpp_xor2(int v) { return __builtin_amdgcn_update_dpp(0, v, 0x4E, 0xF, 0xF, false); }
DI int dpp_hmir(int v) { return __builtin_amdgcn_update_dpp(0, v, 0x141, 0xF, 0xF, false); }
DI void peer_u(const unsigned char* EU8, const unsigned char* XQ8, const int* EIDX, int* PART, int slice, int tok0, int tokstep, int lane) {
    const int q = lane >> 3, i = lane & 7;
    const unsigned char* tab = EU8 + (size_t)slice * PE_NE * 128 + i * 16;
#define PU_LOAD(dst, t_) do { const u32x4* ep_ = (const u32x4*)(EIDX + (size_t)(t_) * 128 + 16 * q); const u32x4 e0_ = ep_[0], e1_ = ep_[1], e2_ = ep_[2], e3_ = ep_[3]; \
        const unsigned ee_[16] = {e0_.x, e0_.y, e0_.z, e0_.w, e1_.x, e1_.y, e1_.z, e1_.w, e2_.x, e2_.y, e2_.z, e2_.w, e3_.x, e3_.y, e3_.z, e3_.w}; \
        _Pragma("unroll") for (int g = 0; g < 16; ++g) dst[g] = *(const u32x4*)(tab + (size_t)ee_[g] * 128); } while (0)
    u32x4 ub[16], nb[16];
    if (tok0 < T) PU_LOAD(ub, tok0);
    for (int t = tok0; t < T; t += tokstep) {
        const u32x4 xv = *(const u32x4*)(XQ8 + ((size_t)slice * T + t) * 128 + i * 16);
        if (t + tokstep < T) PU_LOAD(nb, t + tokstep);
        int d0 = 0, d1 = 0;
#pragma unroll
        for (int g = 0; g < 16; ++g) {
            int s = __builtin_amdgcn_sdot4((int)ub[g].x, (int)xv.x, 0, false);
            s = __builtin_amdgcn_sdot4((int)ub[g].y, (int)xv.y, s, false); s = __builtin_amdgcn_sdot4((int)ub[g].z, (int)xv.z, s, false); s = __builtin_amdgcn_sdot4((int)ub[g].w, (int)xv.w, s, false);
            s += dpp_xor1(s); s += dpp_xor2(s); s += dpp_hmir(s);
            if (g < 8) { if (i == g) d0 = s; } else { if (i == g - 8) d1 = s; }
        }
        int* pp = PART + ((size_t)slice * T + t) * 128 + 16 * q + i;
        pp[0] = d0; pp[8] = d1;
#pragma unroll
        for (int g = 0; g < 16; ++g) ub[g] = nb[g];
    }
#undef PU_LOAD
}
DI void peer_w(const int* PART, const int* EIDX, const float* EGATE, const float* SU, const float* SV, const float* XS, const float* SSQX, float* WT, size_t gtid, size_t gsz) {
    for (size_t idx = gtid; idx < (size_t)T * 128; idx += gsz) {
        const int t = (int)(idx >> 7);
        int dsum = 0;
#pragma unroll
        for (int s = 0; s < 8; ++s) dsum += PART[(size_t)s * T * 128 + idx];
        const int e = EIDX[idx];
        const float sc = XS[t] * rstd_x1(SSQX, (size_t)t);
        WT[idx] = EGATE[idx] * SV[e] * gelu_tanh((float)dsum * (SU[e] * sc));
    }
}
DI unsigned perm_(unsigned s0, unsigned s1, unsigned sel) { return __builtin_amdgcn_perm(s0, s1, sel); }
DI void peer_v(const unsigned char* EV8, const int* EIDX, const float* WT, float* X1, int slice, int tok0, int tokstep, int lane, int dry) {
    const int q = lane >> 3, i = lane & 7;
    const unsigned char* tab = EV8 + (size_t)slice * PE_NE * 128 + i * 16;
#define PV_LOAD(dst, t_) do { const u32x4* ep_ = (const u32x4*)(EIDX + (size_t)(t_) * 128 + 16 * q); const u32x4 e0_ = ep_[0], e1_ = ep_[1], e2_ = ep_[2], e3_ = ep_[3]; \
        const unsigned ee_[16] = {e0_.x, e0_.y, e0_.z, e0_.w, e1_.x, e1_.y, e1_.z, e1_.w, e2_.x, e2_.y, e2_.z, e2_.w, e3_.x, e3_.y, e3_.z, e3_.w}; \
        _Pragma("unroll") for (int g = 0; g < 16; ++g) dst[g] = *(const u32x4*)(tab + (size_t)ee_[g] * 128); } while (0)
    u32x4 vb[16], nb[16];
    if (tok0 < T) PV_LOAD(vb, tok0);
    for (int t = tok0; t < T; t += tokstep) {
        const f32x4* wp = (const f32x4*)(WT + (size_t)t * 128 + 16 * q);
        const f32x4 w0 = wp[0], w1 = wp[1], w2 = wp[2], w3 = wp[3];
        if (t + tokstep < T) PV_LOAD(nb, t + tokstep);
        const float ww[16] = {w0[0], w0[1], w0[2], w0[3], w1[0], w1[1], w1[2], w1[3], w2[0], w2[1], w2[2], w2[3], w3[0], w3[1], w3[2], w3[3]};
        float am = 0.f;
#pragma unroll
        for (int g = 0; g < 16; ++g) am = fmaxf(am, fabsf(ww[g]));
        am = fmaxf(am, __shfl_xor(am, 8)); am = fmaxf(am, __shfl_xor(am, 16)); am = fmaxf(am, __shfl_xor(am, 32));
        const float inv = am > 0.f ? 127.f / am : 0.f, wsc = am * (1.f / 127.f);
        int wq[4];
#pragma unroll
        for (int m = 0; m < 4; ++m) { unsigned pk = 0u;
#pragma unroll
            for (int e = 0; e < 4; ++e) pk |= ((unsigned)((int)rintf(ww[4 * m + e] * inv)) & 0xffu) << (8 * e);
            wq[m] = (int)pk; }
        int o[16];
#pragma unroll
        for (int c = 0; c < 16; ++c) o[c] = 0;
#pragma unroll
        for (int m = 0; m < 4; ++m) {
#pragma unroll
            for (int k = 0; k < 4; ++k) {
                const unsigned a = vb[4 * m][k], b = vb[4 * m + 1][k], c = vb[4 * m + 2][k], dd = vb[4 * m + 3][k];
                const unsigned ablo = perm_(b, a, 0x05010400u), abhi = perm_(b, a, 0x07030602u), cdlo = perm_(dd, c, 0x05010400u), cdhi = perm_(dd, c, 0x07030602u);
                o[4 * k + 0] = __builtin_amdgcn_sdot4((int)perm_(cdlo, ablo, 0x05040100u), wq[m], o[4 * k + 0], false);
                o[4 * k + 1] = __builtin_amdgcn_sdot4((int)perm_(cdlo, ablo, 0x07060302u), wq[m], o[4 * k + 1], false);
                o[4 * k + 2] = __builtin_amdgcn_sdot4((int)perm_(cdhi, abhi, 0x05040100u), wq[m], o[4 * k + 2], false);
                o[4 * k + 3] = __builtin_amdgcn_sdot4((int)perm_(cdhi, abhi, 0x07060302u), wq[m], o[4 * k + 3], false);
            }
        }
        int r8[8], r4[4], r2[2];
#pragma unroll
        for (int c = 0; c < 8; ++c) { const int mine = (q & 4) ? o[c + 8] : o[c], theirs = (q & 4) ? o[c] : o[c + 8]; r8[c] = mine + __shfl_xor(theirs, 32); }
#pragma unroll
        for (int c = 0; c < 4; ++c) { const int mine = (q & 2) ? r8[c + 4] : r8[c], theirs = (q & 2) ? r8[c] : r8[c + 4]; r4[c] = mine + __shfl_xor(theirs, 16); }
#pragma unroll
        for (int c = 0; c < 2; ++c) { const int mine = (q & 1) ? r4[c + 2] : r4[c], theirs = (q & 1) ? r4[c] : r4[c + 2]; r2[c] = mine + __shfl_xor(theirs, 8); }
        float* xp = X1 + (size_t)t * 1024 + slice * 128 + i * 16 + 2 * q;
        f32x2 xv = *(const f32x2*)xp;
        xv[0] += (float)r2[0] * wsc; xv[1] += (float)r2[1] * wsc;
        if (!dry) *(f32x2*)xp = xv; else asm volatile("" :: "v"(xv));
#pragma unroll
        for (int g = 0; g < 16; ++g) vb[g] = nb[g];
    }
#undef PV_LOAD
}
DI void final_norm(const float* __restrict__ Y, const float* __restrict__ fw, float* __restrict__ OUT, int gw, int ngw, int lane) {
    for (int t0 = gw; t0 < T; t0 += 2 * ngw) {
        const int tb = t0 + ngw, t1 = tb < T ? tb : t0;
        f32x4 v[2][4];
#pragma unroll
        for (int rr = 0; rr < 2; ++rr) { const f32x4* yr = (const f32x4*)(Y + (size_t)(rr ? t1 : t0) * 1024) + lane;
#pragma unroll
            for (int j = 0; j < 4; ++j) v[rr][j] = yr[64 * j]; }
#pragma unroll
        for (int rr = 0; rr < 2; ++rr) {
            float s = 0.f;
#pragma unroll
            for (int j = 0; j < 4; ++j) s += (v[rr][j][0] * v[rr][j][0] + v[rr][j][1] * v[rr][j][1]) + (v[rr][j][2] * v[rr][j][2] + v[rr][j][3] * v[rr][j][3]);
            const float rs = rsqrtf(wave_sum(s) * (1.f / 1024.f) + EPS);
            if (rr == 0 || tb < T) {
                f32x4* o = (f32x4*)(OUT + (size_t)(rr ? t1 : t0) * 1024) + lane; const f32x4* wr4 = (const f32x4*)fw + lane;
#pragma unroll
                for (int j = 0; j < 4; ++j) { const f32x4 ww = wr4[64 * j]; o[64 * j] = (f32x4){v[rr][j][0] * rs * ww[0], v[rr][j][1] * rs * ww[1], v[rr][j][2] * rs * ww[2], v[rr][j][3] * rs * ww[3]}; }
            }
        }
    }
}

DI void transpose_item(const float* W, int K, int N, bf16* WT, int n_src0, int n_dst0, int k0, LAS float* scr, int lane) {
#pragma unroll 8
    for (int i = 0; i < 32; ++i) { const int kk = 2 * i + (lane >> 5); scr[kk * 33 + (lane & 31)] = W[(size_t)(k0 + kk) * N + n_src0 + (lane & 31)]; }
    asm volatile("s_waitcnt lgkmcnt(0)" ::: "memory");
    const int c = lane & 7;
#pragma unroll
    for (int j = 0; j < 4; ++j) { const int n = (lane >> 3) + 8 * j; const LAS float* s = scr + (8 * c) * 33 + n;
        u32x4 o; o.x = pk2(s[0 * 33], s[1 * 33]); o.y = pk2(s[2 * 33], s[3 * 33]); o.z = pk2(s[4 * 33], s[5 * 33]); o.w = pk2(s[6 * 33], s[7 * 33]);
        *(u32x4*)(WT + (size_t)(n_dst0 + n) * K + k0 + 8 * c) = o; }
    asm volatile("s_waitcnt lgkmcnt(0)" ::: "memory");
}
DI int win_orig_col(int np) {
    if (np < 2048) { const int h = np >> 8, sel = (np >> 7) & 1, d = np & 127; return sel * 1024 + h * 128 + d; }
    return np;
}
DI void rmsnorm_row_bf16(const float* xrow, const float* w, bf16* orow, int lane) {
    const f32x4* xr = (const f32x4*)xrow + lane; const f32x4* wr4 = (const f32x4*)w + lane;
    f32x4 v[4]; float s = 0.f;
#pragma unroll
    for (int j = 0; j < 4; ++j) { v[j] = xr[64 * j]; s += (v[j][0] * v[j][0] + v[j][1] * v[j][1]) + (v[j][2] * v[j][2] + v[j][3] * v[j][3]); }
    const float rs = rsqrtf(wave_sum(s) * (1.f / 1024.f) + EPS);
    u32x2* o8 = (u32x2*)orow + lane;
#pragma unroll
    for (int j = 0; j < 4; ++j) { const f32x4 ww = wr4[64 * j]; u32x2 o; o.x = pk2(v[j][0] * rs * ww[0], v[j][1] * rs * ww[1]); o.y = pk2(v[j][2] * rs * ww[2], v[j][3] * rs * ww[3]); o8[64 * j] = o; }
}
DI void transpose_item_q8(const float* W, int N, unsigned char* WT8, const unsigned* amaxu, float* SB, int n_src0, int n_dst0, int k0, bool first_kb, LAS float* scr, int lane) {
#pragma unroll 8
    for (int i = 0; i < 32; ++i) { const int kk = 2 * i + (lane >> 5); scr[kk * 33 + (lane & 31)] = W[(size_t)(k0 + kk) * N + n_src0 + (lane & 31)]; }
    asm volatile("s_waitcnt lgkmcnt(0)" ::: "memory");
    const int c = lane & 3;
#pragma unroll
    for (int j = 0; j < 2; ++j) {
        const int n = (lane >> 2) + 16 * j;
        const float am = __uint_as_float(amaxu[n_src0 + n]), inv = am > 0.f ? 127.f / am : 0.f;
        const LAS float* s = scr + (16 * c) * 33 + n;
        u32x4 o;
#pragma unroll
        for (int g = 0; g < 4; ++g) { unsigned pk = 0u;
#pragma unroll
            for (int e2 = 0; e2 < 4; ++e2) pk |= ((unsigned)((int)rintf(s[(4 * g + e2) * 33] * inv)) & 0xffu) << (8 * e2);
            o[g] = pk; }
        *(u32x4*)(WT8 + (size_t)(n_dst0 + n) * 1024 + k0 + 16 * c) = o;
        if (first_kb && c == 0) SB[n_dst0 + n] = am * (1.f / 127.f);
    }
    asm volatile("s_waitcnt lgkmcnt(0)" ::: "memory");
}
DI void rmsnorm_rows_q8(const float* __restrict__ x, const float* __restrict__ w, unsigned char* __restrict__ HN8, float* __restrict__ SA, int gw, int ngw, int lane) {
    for (int m0 = gw; m0 < T; m0 += 2 * ngw) {
        const int mb = m0 + ngw, m1 = mb < T ? mb : m0;
        f32x4 v[2][4];
#pragma unroll
        for (int rr = 0; rr < 2; ++rr) { const f32x4* xr = (const f32x4*)(x + (size_t)(rr ? m1 : m0) * 1024) + lane;
#pragma unroll
            for (int j = 0; j < 4; ++j) v[rr][j] = xr[64 * j]; }
        const f32x4* wr4 = (const f32x4*)w + lane;
#pragma unroll
        for (int rr = 0; rr < 2; ++rr) {
            float s = 0.f;
#pragma unroll
            for (int j = 0; j < 4; ++j) s += (v[rr][j][0] * v[rr][j][0] + v[rr][j][1] * v[rr][j][1]) + (v[rr][j][2] * v[rr][j][2] + v[rr][j][3] * v[rr][j][3]);
            const float rs = rsqrtf(wave_sum(s) * (1.f / 1024.f) + EPS);
            float am = 0.f;
#pragma unroll
            for (int j = 0; j < 4; ++j) { const f32x4 ww = wr4[64 * j];
#pragma unroll
                for (int e2 = 0; e2 < 4; ++e2) { v[rr][j][e2] = v[rr][j][e2] * rs * ww[e2]; am = fmaxf(am, fabsf(v[rr][j][e2])); } }
#pragma unroll
            for (int o = 1; o < 64; o <<= 1) am = fmaxf(am, __shfl_xor(am, o));
            const float inv = am > 0.f ? 127.f / am : 0.f;
            if (rr == 0 || mb < T) {
                const int m = rr ? m1 : m0;
                unsigned* o4 = (unsigned*)(HN8 + (size_t)m * 1024) + lane;
#pragma unroll
                for (int j = 0; j < 4; ++j) { unsigned pk = 0u;
#pragma unroll
                    for (int e2 = 0; e2 < 4; ++e2) pk |= ((unsigned)((int)rintf(v[rr][j][e2] * inv)) & 0xffu) << (8 * e2);
                    o4[64 * j] = pk; }
                if (lane == 0) SA[m] = am * (1.f / 127.f);
            }
        }
    }
}
DI void convert_bf16(const float* src, bf16* dst, size_t n, size_t gtid, size_t gsz) {
    for (size_t i = gtid * 8; i < n; i += gsz * 8) {
        const f32x4 a = *(const f32x4*)(src + i), b = *(const f32x4*)(src + i + 4);
        *(u32x4*)(dst + i) = pack8(a, b);
    }
}

#define XB_TMO      128
#define XB_XCNT(j)  (256  + 64 * (j))
#define XB_XSUB(j)  (1280 + 64 * (j))
#define XB_XGEN(j)  (2304 + 64 * (j))
#define XB_TOP      3328
#define XB_TOPGEN   3392
#define XCD_BAR_WORDS 3456
#define XB_SPIN_CAP (1u << 18)

__device__ __forceinline__ unsigned xb_ld(unsigned* p)              { return __hip_atomic_load(p, __ATOMIC_RELAXED, __HIP_MEMORY_SCOPE_AGENT); }
__device__ __forceinline__ unsigned xb_add(unsigned* p, unsigned v) { return __hip_atomic_fetch_add(p, v, __ATOMIC_RELAXED, __HIP_MEMORY_SCOPE_AGENT); }
__device__ __forceinline__ unsigned xb_xcc_id() { return (unsigned)__builtin_amdgcn_s_getreg((3 << 11) | 20) & 0xFu; }
#define XB_SPIN(cond, bar) do { unsigned _sp = 0; while (cond) { __builtin_amdgcn_s_sleep(1); \
    if ((++_sp & 255u) == 0u) { if (xb_ld(&(bar)[XB_TMO])) break; if (_sp > XB_SPIN_CAP) { atomicAdd(&(bar)[XB_TMO], 1u); break; } } } } while (0)

struct XcdBarrier {
    unsigned* bar; unsigned x;
    volatile LAS unsigned* st;
};

__device__ __forceinline__ XcdBarrier xcd_barrier_post(unsigned* bar, volatile LAS unsigned* st) {
    XcdBarrier b; b.bar = bar; b.x = xb_xcc_id(); b.st = st;
    if (threadIdx.x == 0) (void)xb_add(&bar[XB_XCNT(b.x)], 1u);
    return b;
}
__device__ __forceinline__ void xcd_barrier_complete(unsigned* bar, unsigned x, unsigned& nloc, unsigned& nx) {
    const unsigned G = gridDim.x * gridDim.y * gridDim.z;
    unsigned sum, cnt, mine, sp = 0u;
    for (;;) {
        sum = 0u; cnt = 0u; mine = 0u;
#pragma unroll
        for (unsigned j = 0; j < 16; ++j) { const unsigned c = xb_ld(&bar[XB_XCNT(j)]); sum += c; cnt += (c > 0u) ? 1u : 0u; mine = (j == x) ? c : mine; }
        if (sum == G) break;
        __builtin_amdgcn_s_sleep(1);
        if ((++sp & 255u) == 0u) { if (xb_ld(&bar[XB_TMO])) break; if (sp > XB_SPIN_CAP) { atomicAdd(&bar[XB_TMO], 1u); break; } }
    }
    nloc = mine > 0u ? mine : 1u; nx = cnt > 0u ? cnt : 1u;
}

__device__ __forceinline__ void xcd_barrier(const XcdBarrier& b) {
    asm volatile("s_waitcnt vmcnt(0)" ::: "memory");
    __syncthreads();
    if (threadIdx.x == 0) {
        unsigned* bar = b.bar;
        __builtin_amdgcn_s_waitcnt(0);
        unsigned nloc = b.st[0], nx = b.st[1];
        if (nloc == 0u) { xcd_barrier_complete(bar, b.x, nloc, nx); b.st[0] = nloc; b.st[1] = nx; }
        const unsigned old = xb_add(&bar[XB_XSUB(b.x)], 1u);
        const unsigned gen = old / nloc;
        if (old + 1u == (gen + 1u) * nloc) {
            __builtin_amdgcn_fence(__ATOMIC_RELEASE, "agent");
            asm volatile("s_waitcnt vmcnt(0)" ::: "memory");
            const unsigned og = xb_add(&bar[XB_TOP], 1u);
            const unsigned tg = og / nx;
            if (og + 1u == (tg + 1u) * nx) xb_add(&bar[XB_TOPGEN], 1u);
            else XB_SPIN(xb_ld(&bar[XB_TOPGEN]) == tg, bar);
            __builtin_amdgcn_fence(__ATOMIC_ACQUIRE, "agent");
            xb_add(&bar[XB_XGEN(b.x)], 1u);
            asm volatile("s_waitcnt vmcnt(0)" ::: "memory");
        } else {
            XB_SPIN(xb_ld(&bar[XB_XGEN(b.x)]) == gen, bar);
            __builtin_amdgcn_fence(__ATOMIC_ACQUIRE, "agent");
            asm volatile("s_waitcnt vmcnt(0)" ::: "memory");
        }
    }
    __syncthreads();
}

struct Params { const float* in[14]; float* out; unsigned char* ws; };

__global__ void __launch_bounds__(NTHREADS, 2) fwd_megakernel(Params p) {
    extern __shared__ __attribute__((aligned(16))) unsigned char lds_raw[];
    LAS unsigned char* lds = (LAS unsigned char*)lds_raw;
    cg::grid_group grid = cg::this_grid();
    volatile LAS unsigned* bst = (volatile LAS unsigned*)(lds + LDS_BYTES - 64);
    if (threadIdx.x < 4) bst[threadIdx.x] = 0u;
    __syncthreads();
    XcdBarrier xbar = xcd_barrier_post((unsigned*)(p.ws + WS_CTL), bst);
    if (threadIdx.x == 0) bst[4] = xb_add((unsigned*)(p.ws + WS_CTL) + 3600 + xbar.x, 1u);
#if USE_CG_SYNC
#define GRID_SYNC() grid.sync()
#else
#define GRID_SYNC() xcd_barrier(xbar)
#endif
    const int G = gridDim.x, wg = blockIdx.x;
#define PHASE_IDS const int tid = fresh_tid(), lane = tid & 63, wave = __builtin_amdgcn_readfirstlane(tid >> 6); \
    const int gw = wg * NWAVES + wave, ngw = G * NWAVES; const size_t gtid = (size_t)wg * NTHREADS + tid, gsz = (size_t)G * NTHREADS; \
    (void)lane; (void)gw; (void)ngw; (void)gtid; (void)gsz;
    unsigned char* ws = p.ws;
    const float* x = p.in[0];
    unsigned char* HN8 = ws + WS_HN; unsigned char* WinT8 = ws + WS_WINT; float* SA = (float*)(ws + WS_SA); float* SB = (float*)(ws + WS_SB);
    unsigned* AMAXU = (unsigned*)(ws + WS_CTL + CTL_AMAX);
    float* COS = (float*)(ws + WS_ROPE); float* SIN = COS + 8192 * 128;
    float* DEC = (float*)(ws + WS_DEC); float* SSQP = (float*)(ws + WS_SSQP); float* SSQX = (float*)(ws + WS_SSQX);
    bf16* BA = (bf16*)(ws + WS_A); bf16* BB = (bf16*)(ws + WS_B); bf16* BC = (bf16*)(ws + WS_C);
    bf16* STh = (bf16*)(ws + WS_STH); bf16* STr = (bf16*)(ws + WS_STR);
    bf16* OHG = (bf16*)(ws + WS_OHG); bf16* ORET = (bf16*)p.out;
    bf16* GA = (bf16*)(ws + WS_GA); bf16* GB = (bf16*)(ws + WS_GB);
    bf16* WhgT = (bf16*)(ws + WS_WHG); bf16* WretT = (bf16*)(ws + WS_WRET); bf16* WoutT = (bf16*)(ws + WS_WOUT); bf16* WqT = (bf16*)(ws + WS_WQ); bf16* SK = (bf16*)(ws + WS_SK);
    unsigned char* EV8 = ws + WS_EV; unsigned char* EU8 = ws + WS_EU; float* SU = (float*)(ws + WS_SCL); float* SV = SU + PE_NE;
    float* M1 = (float*)(ws + WS_M1); bf16* MERGED = (bf16*)(ws + WS_MERGED);
    float* X1 = (float*)(ws + WS_X1); bf16* XW = (bf16*)(ws + WS_XW); bf16* Qp = (bf16*)p.out;
    unsigned char* XQ8 = ws + WS_XQ8; float* XS = (float*)(ws + WS_XS); int* PART = (int*)(ws + WS_PART); float* WT = (float*)(ws + WS_WT);
    float* TOPS = (float*)(ws + WS_TOPS); int* TOPI = (int*)(ws + WS_TOPI); int* EIDX = (int*)(ws + WS_EIDX); float* EGATE = (float*)(ws + WS_EGATE);

    for (int rep_ = 0; rep_ < ((PROBE_MASK & 32) ? 2 : 1); ++rep_) {
    { PHASE_IDS
    for (size_t it = gtid; it < (size_t)16 * 12288; it += gsz) {
        const int kb = (int)(it / 12288), col = (int)(it % 12288);
        const float* wp = p.in[2] + (size_t)(kb * 64) * 12288 + col;
        float am = 0.f;
#pragma unroll 16
        for (int k = 0; k < 64; ++k) am = fmaxf(am, fabsf(wp[(size_t)k * 12288]));
        atomicMax(AMAXU + col, __float_as_uint(am));
    }
    rmsnorm_rows_q8(x, p.in[1], HN8, SA, gw, ngw, lane);
#ifdef DBG_ZERO_VT
    for (size_t i = gtid; i < (size_t)32 * 1024 * 1024 / 16; i += gsz) ((u32x4*)BC)[i] = (u32x4){0u, 0u, 0u, 0u};
#endif
    for (size_t i = gtid; i < (size_t)8192 * 128; i += gsz) {
        const int pos = (int)(i >> 7), j = (int)(i & 127);
        const float inv = (float)exp(-(double)j * (9.210340371976184 / 128.0));
        const float ang = (float)pos * inv;
        double rev = (double)ang * 0.15915494309189535; rev -= rint(rev);
        COS[i] = __builtin_amdgcn_cosf((float)rev); SIN[i] = __builtin_amdgcn_sinf((float)rev);
    } }
    __syncthreads(); }
    grid.sync();
    { PHASE_IDS LAS float* scr = (LAS float*)(lds + wave * 16384);
    for (int it = gw; it < 16 * 384; it += ngw) {
        const int kb = it / 384, nb = it % 384;
        transpose_item_q8(p.in[2], 12288, WinT8, AMAXU, SB, win_orig_col(nb * 32), nb * 32, kb * 64, kb == 0, scr, lane);
    } }
    GRID_SYNC();

    for (int rep_ = 0; rep_ < ((PROBE_MASK & 128) ? 2 : 1); ++rep_) {
    {
        pg8::Gemm g{(const bf16*)HN8, (const bf16*)WinT8, T, 4096, 512}; pg8::StaticOrder S; S.init(T, 4096, G, wg);
        EpiH E{BA, BB, BC, DEC, p.in[3], OHG, SA, SB};
        pg8::gemm_phase<EpiH, pg8::StaticOrder, true, true, true>(lds, g, S, E);
    }
    __syncthreads(); }
    GRID_SYNC();
    hg_pass1(lds, BB, BC, STh, wg, G);
#if PROBE_MASK & 4
    hg_pass1(lds, BB, BC, STh, wg, G);
#endif
    GRID_SYNC();
    { PHASE_IDS hg_scan(STh, DEC, (int)gtid, (int)gsz); }
    GRID_SYNC();
#if PROBE_MASK & 16384
    hg_pass1(lds, BB, BC, STh, wg, G);
    GRID_SYNC();
    { PHASE_IDS hg_scan(STh, DEC, (int)gtid, (int)gsz); }
    GRID_SYNC();
#endif
#if PROBE_MASK & 4
    { PHASE_IDS hg_pass3(lds, BA, BB, BC, STh, p.in[4], OHG, gw, ngw, 1); }
#endif
    { PHASE_IDS hg_pass3(lds, BA, BB, BC, STh, p.in[4], OHG, gw, ngw, 0); }
    GRID_SYNC();

    for (int rep_ = 0; rep_ < ((PROBE_MASK & 2048) ? 2 : 1); ++rep_) {
    {
        pg8::Gemm g{(const bf16*)HN8, (const bf16*)(WinT8 + (size_t)4096 * 1024), T, 6144, 512}; pg8::StaticOrder S; S.init(T, 6144, G, wg);
        EpiR E{BA, BB, BC, COS, SIN, ORET, SA, SB + 4096};
        pg8::gemm_phase<EpiR, pg8::StaticOrder, true, true, true>(lds, g, S, E);
    }
    __syncthreads(); }
    GRID_SYNC();
    rt_pass1(lds, BB, BC, STr, wg, G);
#if PROBE_MASK & 8
    rt_pass1(lds, BB, BC, STr, wg, G);
#endif
    GRID_SYNC();
    { PHASE_IDS rt_scan(STr, (int)gtid, (int)gsz); }
    GRID_SYNC();
#if PROBE_MASK & 32768
    rt_pass1(lds, BB, BC, STr, wg, G);
    GRID_SYNC();
    { PHASE_IDS rt_scan(STr, (int)gtid, (int)gsz); }
    GRID_SYNC();
#endif
#if PROBE_MASK & 1024
    rt_pass3_wg(lds, BA, BB, BC, STr, ORET, SSQP, wg, G, 1);
#endif
    rt_pass3_wg(lds, BA, BB, BC, STr, ORET, SSQP, wg, G, 0);
    GRID_SYNC();

    for (int rep_ = 0; rep_ < ((PROBE_MASK & 64) ? 2 : 1); ++rep_) {
    { PHASE_IDS LAS float* scr = (LAS float*)(lds + wave * 16384);
    for (int it = gw; it < 3072; it += ngw) {
        int r = it;
        if (r < 512) { transpose_item(p.in[5], 1024, 1024, WhgT, (r % 32) * 32, (r % 32) * 32, (r / 32) * 64, scr, lane); continue; } r -= 512;
        if (r < 1024) { transpose_item(p.in[6], 2048, 1024, WretT, (r % 32) * 32, (r % 32) * 32, (r / 32) * 64, scr, lane); continue; } r -= 1024;
        if (r < 512) { transpose_item(p.in[7], 1024, 1024, WoutT, (r % 32) * 32, (r % 32) * 32, (r / 32) * 64, scr, lane); continue; } r -= 512;
        transpose_item(p.in[9], 1024, 2048, WqT, (r % 64) * 32, (r % 64) * 32, (r / 64) * 64, scr, lane);
    }
    convert_bf16(p.in[10], SK, (size_t)16 * 128 * 128, gtid, gsz);
    quant_rows(p.in[12], EV8, SV, PE_NE, 0, gw, ngw, lane); }
    __syncthreads(); }
    __syncthreads();
    for (int rep_ = 0; rep_ < ((PROBE_MASK & 65536) ? 2 : 1); ++rep_) {
    {
        pg8::Gemm g{(const bf16*)HN8, (const bf16*)(WinT8 + (size_t)10240 * 1024), T, 2048, 512}; pg8::StaticOrder S; S.init(T, 2048, G, wg);
        EpiG E{GA, GB, SA, SB + 10240};
        pg8::gemm_phase<EpiG, pg8::StaticOrder, true, true, true>(lds, g, S, E);
    }
    __syncthreads(); }
    GRID_SYNC();

    for (int rep_ = 0; rep_ < ((PROBE_MASK & 256) ? 2 : 1); ++rep_) {
    {
        pg8::Gemm g{OHG, WhgT, T, 1024, 1024}; pg8::StaticOrder S; S.init(T, 1024, G, wg);
        EpiM1 E{MERGED, GA};
        pg8::gemm_phase<EpiM1, pg8::StaticOrder, false, true>(lds, g, S, E);
    }
    __syncthreads();
    {
        pg8::Gemm g{ORET, WretT, T, 1024, 2048}; pg8::StaticOrder S; S.init(T, 1024, G, wg);
        EpiMerge E{GB, MERGED};
        pg8::gemm_phase<EpiMerge, pg8::StaticOrder, false, true>(lds, g, S, E);
    }
    __syncthreads(); }
    GRID_SYNC();
    for (int rep_ = 0; rep_ < ((PROBE_MASK & 4096) ? 2 : 1); ++rep_) {
    {
        pg8::Gemm g{MERGED, WoutT, T, 1024, 1024}; pg8::StaticOrder S; S.init(T, 1024, G, wg);
        EpiOut E{x, X1, XW, p.in[8], SSQX};
        pg8::gemm_phase<EpiOut, pg8::StaticOrder, false, true>(lds, g, S, E);
    }
    __syncthreads(); }
    GRID_SYNC();
    for (int rep_ = 0; rep_ < ((PROBE_MASK & 64) ? 2 : 1); ++rep_) {
    { PHASE_IDS quant_rows(p.in[11], EU8, SU, PE_NE, 0, gw, ngw, lane); }
    __syncthreads(); }
    __syncthreads();
    for (int rep_ = 0; rep_ < ((PROBE_MASK & 8192) ? 2 : 1); ++rep_) {
    {
        pg8::Gemm g{XW, WqT, T, 2048, 1024}; pg8::StaticOrder S; S.init(T, 2048, G, wg);
        EpiQ E{Qp, SSQX};
        pg8::gemm_phase<EpiQ, pg8::StaticOrder, true, true>(lds, g, S, E);
    }
    __syncthreads(); }
    GRID_SYNC();
    { PHASE_IDS peer_retrieve(lds, Qp, SK, EIDX, EGATE, wg, G); quant_xw(XW, XQ8, XS, gw, ngw, lane); }
#if PROBE_MASK & 2
    { PHASE_IDS peer_retrieve(lds, Qp, SK, EIDX, EGATE, wg, G); quant_xw(XW, XQ8, XS, gw, ngw, lane); }
#endif
    GRID_SYNC();
    if (threadIdx.x == 0) {
        unsigned k = 0, n = 0, mine = 1;
        for (unsigned j = 0; j < 16; ++j) { const unsigned c = xb_ld((unsigned*)(p.ws + WS_CTL) + XB_XCNT(j)); if (c) { if (j < xbar.x) ++k; ++n; } if (j == xbar.x) mine = c ? c : 1; }
        bst[5] = k; bst[6] = n ? n : 1; bst[7] = mine;
    }
    __syncthreads();
    const int xrank = (int)bst[4], xk = (int)bst[5], xn = (int)bst[6], xloc = (int)bst[7];
    for (int rep_ = 0; rep_ < ((PROBE_MASK & 1) ? 2 : 1); ++rep_) {
    { PHASE_IDS for (int s = xk; s < 8; s += xn) peer_u(EU8, XQ8, EIDX, PART, s, xrank * NWAVES + wave, xloc * NWAVES, lane); }
    GRID_SYNC(); }
    { PHASE_IDS peer_w(PART, EIDX, EGATE, SU, SV, XS, SSQX, WT, gtid, gsz); }
    GRID_SYNC();
#if PROBE_MASK & 131072
    { PHASE_IDS for (int s = xk; s < 8; s += xn) peer_v(EV8, EIDX, WT, X1, s, xrank * NWAVES + wave, xloc * NWAVES, lane, 1); }
    GRID_SYNC();
#endif
    { PHASE_IDS for (int s = xk; s < 8; s += xn) peer_v(EV8, EIDX, WT, X1, s, xrank * NWAVES + wave, xloc * NWAVES, lane, 0); }
    GRID_SYNC();
    { PHASE_IDS final_norm(X1, p.in[13], p.out, gw, ngw, lane); }
#if PROBE_MASK & 16
    for (int i = 0; i < 15; ++i) GRID_SYNC();
#endif
}

extern "C" void kernel_launch(void* const* d_in, const int* in_sizes, int n_in, void* d_out, int out_size, void* d_ws, size_t ws_size, hipStream_t stream) {
    static int grid_blocks = 0;
    if (!grid_blocks) {
        int dev = 0, cus = 0, per_cu = 0;
        (void)hipGetDevice(&dev);
        (void)hipDeviceGetAttribute(&cus, hipDeviceAttributeMultiprocessorCount, dev);
        (void)hipFuncSetAttribute((const void*)fwd_megakernel, hipFuncAttributeMaxDynamicSharedMemorySize, LDS_BYTES);
        (void)hipOccupancyMaxActiveBlocksPerMultiprocessor(&per_cu, (const void*)fwd_megakernel, NTHREADS, LDS_BYTES);
        if (per_cu < 1) per_cu = 1;
        grid_blocks = cus * 1;
        if (ws_size < WS_END || n_in != 14) { fprintf(stderr, "kernel_launch: unexpected ws_size %zu (need %zu) or n_in %d\n", ws_size, (size_t)WS_END, n_in); }
    }
    (void)hipMemsetAsync((char*)d_ws + WS_CTL, 0, CTL_BYTES, stream);
    Params p{};
    for (int i = 0; i < 14; ++i) p.in[i] = (const float*)d_in[i];
    p.out = (float*)d_out; p.ws = (unsigned char*)d_ws;
    void* args[] = {&p};
    hipError_t e = hipLaunchCooperativeKernel((const void*)fwd_megakernel, dim3(grid_blocks), dim3(NTHREADS), args, LDS_BYTES, stream);
    if (e != hipSuccess) fprintf(stderr, "cooperative launch failed: %s (grid %d)\n", hipGetErrorString(e), grid_blocks);
}
```

```cpp
#include <hip/hip_runtime.h>
#include <hip/hip_cooperative_groups.h>
#include <cstdio>
#include <cstdint>
namespace cg = cooperative_groups;
#ifndef USE_CG_SYNC
#define USE_CG_SYNC 0
#endif
#ifndef USE_WT_STORES
#define USE_WT_STORES 0
#endif
#ifndef PROBE_MASK
#define PROBE_MASK 0
#endif

#define DI __device__ __forceinline__
#define LAS __attribute__((address_space(3)))
typedef unsigned short bf16;
typedef float f32x4 __attribute__((ext_vector_type(4)));
typedef float f32x2 __attribute__((ext_vector_type(2)));
typedef float f32x16 __attribute__((ext_vector_type(16)));
typedef short bf16x8 __attribute__((ext_vector_type(8)));
typedef short s16x4 __attribute__((ext_vector_type(4)));
typedef unsigned u32x4 __attribute__((ext_vector_type(4)));
typedef unsigned u32x2 __attribute__((ext_vector_type(2)));
typedef __bf16 nbf16x2 __attribute__((ext_vector_type(2)));

constexpr int D = 1024, NB = 2, SEQ = 8192, T = NB * SEQ;
constexpr int HG_H = 8, HG_DK = 128, HG_DV = 128, HG_C = 64, HG_NC = SEQ / HG_C;
constexpr int RT_H = 4, RT_DK = 256, RT_DV = 512, RT_L = 512, RT_NS = SEQ / RT_L;
constexpr int PE_H = 8, PE_NK = 128, PE_K = 16, PE_Q = 256, PE_HALF = 128, PE_NE = PE_NK * PE_NK;
constexpr float EPS = 1e-6f;
constexpr int NTHREADS = 512, NWAVES = 8;
constexpr int LDS_BYTES = 147456;

constexpr size_t MiB = 1u << 20;
constexpr size_t WS_CTL = 0;
constexpr size_t WS_DEC = 1 * MiB;
constexpr size_t WS_SSQP = 2 * MiB;
constexpr size_t WS_SCL = 2 * MiB + 512 * 1024;
constexpr size_t WS_SSQX = 3 * MiB;
constexpr size_t WS_HN = 4 * MiB;
constexpr size_t WS_WINT = 36 * MiB;
constexpr size_t WS_ROPE = 60 * MiB;
constexpr size_t WS_A = 68 * MiB, WS_B = 100 * MiB, WS_C = 132 * MiB;
constexpr size_t WS_STH = 164 * MiB;
constexpr size_t WS_STR = 196 * MiB;
constexpr size_t WS_OHG = 228 * MiB;
constexpr size_t WS_GA = 68 * MiB, WS_GB = 100 * MiB;
constexpr size_t WS_W2 = 132 * MiB;
constexpr size_t WS_WHG = WS_W2, WS_WRET = WS_W2 + 2 * MiB, WS_WOUT = WS_W2 + 6 * MiB, WS_WQ = WS_W2 + 8 * MiB, WS_SK = WS_W2 + 12 * MiB;
constexpr size_t WS_EV = 145 * MiB;
constexpr size_t WS_MERGED = 177 * MiB;
constexpr size_t WS_EU = 209 * MiB;
constexpr size_t WS_M1 = 4 * MiB;
constexpr size_t WS_X1 = 4 * MiB;
constexpr size_t WS_XW = 68 * MiB;
constexpr size_t WS_TOPS = 100 * MiB, WS_TOPI = 116 * MiB;
constexpr size_t WS_EIDX = 177 * MiB, WS_EGATE = 185 * MiB;
constexpr size_t WS_SA = WS_SCL + 192 * 1024;
constexpr size_t WS_SB = WS_SCL + 256 * 1024;
constexpr size_t CTL_AMAX = 65536;
constexpr size_t CTL_BYTES = 131072;
constexpr size_t WS_XQ8 = 161 * MiB;
constexpr size_t WS_XS = WS_SCL + 128 * 1024;
constexpr size_t WS_PART = 68 * MiB;
constexpr size_t WS_WT = 193 * MiB;
constexpr size_t WS_END = 260 * MiB;

DI int fresh_tid() { int t = threadIdx.x; asm volatile("" : "+v"(t)); return t; }
DI float sigmoidf_(float x) { return 1.f / (1.f + __expf(-x)); }
DI float siluf_(float x) { return x / (1.f + __expf(-x)); }
DI unsigned pk2(float lo, float hi) { f32x2 v = {lo, hi}; nbf16x2 b = __builtin_convertvector(v, nbf16x2); return __builtin_bit_cast(unsigned, b); }
DI bf16 f2bf(float f) { return (bf16)(pk2(f, 0.f) & 0xffffu); }
DI float bf2f(bf16 b) { return __uint_as_float(((unsigned)b) << 16); }
DI float bflo(unsigned u) { return __uint_as_float(u << 16); }
DI float bfhi(unsigned u) { return __uint_as_float(u & 0xffff0000u); }
DI float wave_sum(float v) {
#pragma unroll
    for (int o = 1; o < 64; o <<= 1) v += __shfl_xor(v, o);
    return v;
}
DI int crow(int reg, int h) { return (reg & 3) + 8 * (reg >> 2) + 4 * h; }

namespace pg8 {
#define PG8_LAS __attribute__((address_space(3)))
typedef unsigned short bf16_t;
typedef short bf16x8 __attribute__((ext_vector_type(8)));
typedef float f32x4 __attribute__((ext_vector_type(4)));
typedef unsigned u32x4 __attribute__((ext_vector_type(4)));
constexpr int BM = 256, BK = 64, HALF = 128, HTB = HALF * BK * 2  , STAGE_BYTES = 8 * HTB, NXCD = 8, WGM = 8;

__host__ __device__ __forceinline__ int lds_byte(int r, int c) { const int st = (r >> 4) * 2 + (c >> 5), rr = r & 15, cc = c & 31, ob = rr * 64 + cc * 2; return st * 1024 + (ob ^ (((ob >> 9) & 1) << 5)); }
__host__ __device__ __forceinline__ void stage_rc(int b, int& R, int& C) { const int st = b / 1024, sb = b % 1024, swz = sb ^ (((sb >> 9) & 1) << 5); R = (st >> 1) * 16 + swz / 64; C = (st & 1) * 32 + (swz % 64) / 2; }
__host__ __device__ __forceinline__ int perm32(int rho) { const int n = rho >> 4, i = rho & 15; return 8 * (i >> 2) + 4 * n + (i & 3); }

struct Unit { int pm, pn; };
struct Gemm { const bf16_t* A; const bf16_t* Bt; int M, N, K; };

struct StaticOrder {
    int nM, nN, nwg, G, c;
    __host__ __device__ void init(int M, int N, int G_, int c_) { nM = M / BM; nN = N / BM; nwg = nM * nN; G = G_; c = c_; }
    __host__ __device__ bool next(int i, Unit& u) const {
        const long L = (long)i * G + c; if (L >= nwg) return false;
        int wgid = (int)L; { const int q = nwg / NXCD, r = nwg % NXCD, xcd = wgid % NXCD, off = wgid / NXCD; wgid = (xcd < r ? xcd * (q + 1) : r * (q + 1) + (xcd - r) * q) + off; }
        const int nig = WGM * nN, gid = wgid / nig, fm = gid * WGM, gsz = (nM - fm) < WGM ? (nM - fm) : WGM;
        u.pm = fm + ((wgid % nig) % gsz); u.pn = (wgid % nig) / gsz; return true;
    }
    __device__ __forceinline__ void a_ready(const Unit&) const {}
    __device__ __forceinline__ void done(const Unit&) const {}
};

__device__ __forceinline__ unsigned cvt_pk_bf16(float lo, float hi) { unsigned r; asm volatile("v_cvt_pk_bf16_f32 %0, %1, %2" : "=v"(r) : "v"(lo), "v"(hi)); return r; }
typedef float f32x2 __attribute__((ext_vector_type(2)));
typedef int i32x4 __attribute__((ext_vector_type(4)));
template <bool I8> __device__ __forceinline__ f32x4 mma16(const bf16x8& b, const bf16x8& a, const f32x4& c) {
    if constexpr (I8) return __builtin_bit_cast(f32x4, __builtin_amdgcn_mfma_i32_16x16x64_i8(__builtin_bit_cast(i32x4, b), __builtin_bit_cast(i32x4, a), __builtin_bit_cast(i32x4, c), 0, 0, 0));
    else return __builtin_amdgcn_mfma_f32_16x16x32_bf16(b, a, c, 0, 0, 0);
}
template <class Epi, class Sched, bool ALIGN_EPI = false, bool SP2 = false, bool I8 = false>
__device__ __forceinline__ void gemm_phase(PG8_LAS unsigned char* lds, const Gemm g, const Sched& S, const Epi& E) {
    const int tid = fresh_tid(), wid = __builtin_amdgcn_readfirstlane(tid >> 6), lane = tid & 63, wr = wid >> 2, wc = wid & 3, fr = lane & 15, fq = lane >> 4;
    const int K = g.K, nt = K / BK;
    unsigned voffA[2], voffB[2];
#pragma unroll
    for (int i = 0; i < 2; ++i) { int R, C; stage_rc(tid * 16 + i * 8192, R, C); const int Rb = Epi::PERM ? ((R & ~31) + perm32(R & 31)) : R;
        voffA[i] = (unsigned)(R * K + C) * 2u; voffB[i] = (unsigned)(Rb * K + C) * 2u; }
    const size_t kstep = (size_t)(BK * 2);
    const size_t hstep = (size_t)HALF * K * 2;
    const size_t tstep = 2 * hstep;
    const unsigned ldsw = (unsigned)wid * 1024u;
    const int aoff = lds_byte(wr * 64 + fr, fq * 8), boff = lds_byte(wc * 32 + fr, fq * 8);
#define PG8_SA(b, h) (((b) * 2 + (h)) * HTB)
#define PG8_SB(b, h) ((4 + (b) * 2 + (h)) * HTB)
#define PG8_STAGE(bufoff, gbase, voff) do { _Pragma("unroll") for (int _i = 0; _i < 2; ++_i) \
        __builtin_amdgcn_global_load_lds((const unsigned*)((const char*)(gbase) + (voff)[_i]), (PG8_LAS unsigned*)(lds + (bufoff) + ldsw + _i * 8192), 16, 0, 0); } while (0)
#define PG8_LDA(dst, b, h) do { _Pragma("unroll") for (int m = 0; m < 4; ++m) _Pragma("unroll") for (int k = 0; k < 2; ++k) dst[m][k] = *(const PG8_LAS bf16x8*)(lds + PG8_SA(b, h) + aoff + m * 2048 + k * 1024); } while (0)
#define PG8_LDB(dst, b, h) do { _Pragma("unroll") for (int n = 0; n < 2; ++n) _Pragma("unroll") for (int k = 0; k < 2; ++k) dst[n][k] = *(const PG8_LAS bf16x8*)(lds + PG8_SB(b, h) + boff + n * 2048 + k * 1024); } while (0)
#define PG8_MMA(ai, bj, At, Bt) do { __builtin_amdgcn_s_setprio(1); _Pragma("unroll") for (int m = 0; m < 4; ++m) _Pragma("unroll") for (int n = 0; n < 2; ++n) _Pragma("unroll") for (int k = 0; k < 2; ++k) \
        acc[ai][bj][m][n] = mma16<I8>(Bt[n][k], At[m][k], acc[ai][bj][m][n]); __builtin_amdgcn_s_setprio(0); } while (0)
#define PG8_WAIT_V(n) asm volatile("s_waitcnt vmcnt(" #n ")" ::: "memory")
#define PG8_WAIT_L(n) asm volatile("s_waitcnt lgkmcnt(" #n ")" ::: "memory")
#define PG8_BAR __builtin_amdgcn_s_barrier()
#define PG8_SCHED __builtin_amdgcn_sched_barrier(0)
    Unit cur, nxt; int ui = 0;
    if (!S.next(0, cur)) return;
    f32x4 acc[2][2][4][2];
#pragma unroll
    for (int a = 0; a < 2; ++a)
#pragma unroll
        for (int b = 0; b < 2; ++b)
#pragma unroll
            for (int m = 0; m < 4; ++m)
#pragma unroll
                for (int n = 0; n < 2; ++n) acc[a][b][m][n] = (f32x4){0.f, 0.f, 0.f, 0.f};
    bf16x8 At[4][2], B0[2][2], B1[2][2];
    const char* cA = (const char*)g.A + (size_t)cur.pm * tstep; const char* cB = (const char*)g.Bt + (size_t)cur.pn * tstep;
    S.a_ready(cur);
    if constexpr (SP2) {
        PG8_STAGE(PG8_SB(0, 0), cB, voffB); PG8_STAGE(PG8_SB(0, 1), cB + hstep, voffB); PG8_STAGE(PG8_SA(0, 0), cA, voffA); PG8_STAGE(PG8_SA(0, 1), cA + hstep, voffA);
        if (wr == 1) PG8_BAR;
        PG8_WAIT_V(2); PG8_BAR;
        PG8_STAGE(PG8_SB(1, 0), cB + kstep, voffB); PG8_STAGE(PG8_SA(1, 0), cA + kstep, voffA); PG8_STAGE(PG8_SB(1, 1), cB + hstep + kstep, voffB);
        PG8_WAIT_V(6); PG8_BAR;
    } else {
        PG8_STAGE(PG8_SB(0, 0), cB, voffB); PG8_STAGE(PG8_SA(0, 0), cA, voffA); PG8_STAGE(PG8_SB(0, 1), cB + hstep, voffB); PG8_STAGE(PG8_SA(0, 1), cA + hstep, voffA);
        if (wr == 1) PG8_BAR;
        PG8_WAIT_V(4); PG8_BAR;
        PG8_STAGE(PG8_SB(1, 0), cB + kstep, voffB); PG8_STAGE(PG8_SA(1, 0), cA + kstep, voffA); PG8_STAGE(PG8_SB(1, 1), cB + hstep + kstep, voffB);
        PG8_WAIT_V(6); PG8_BAR;
    }
    for (;;) {
        const bool has_next = S.next(ui + 1, nxt);
        const char* nA = has_next ? (const char*)g.A + (size_t)nxt.pm * tstep : cA; const char* nB = has_next ? (const char*)g.Bt + (size_t)nxt.pn * tstep : cB;
        for (int t = 0; t < nt; t += 2) {
            const bool last = (t == nt - 2);
            const char* a1 = cA + (size_t)(t + 1) * kstep;
            const char* a2 = last ? nA : cA + (size_t)(t + 2) * kstep; const char* b2 = last ? nB : cB + (size_t)(t + 2) * kstep;
            const char* a3 = a2 + kstep; const char* b3 = b2 + kstep;
            if (last && has_next) S.a_ready(nxt);
            if constexpr (SP2) {
            PG8_LDB(B0, 0, 0); PG8_LDB(B1, 0, 1); PG8_SCHED; PG8_LDA(At, 0, 0); PG8_STAGE(PG8_SA(1, 1), a1 + hstep, voffA);
            PG8_WAIT_V(8); PG8_WAIT_L(0); PG8_BAR; PG8_MMA(0, 0, At, B0); PG8_MMA(0, 1, At, B1); PG8_BAR; PG8_SCHED;
            PG8_LDA(At, 0, 1); PG8_STAGE(PG8_SB(0, 0), b2, voffB); PG8_STAGE(PG8_SB(0, 1), b2 + hstep, voffB); PG8_STAGE(PG8_SA(0, 0), a2, voffA);
            PG8_WAIT_V(8); PG8_WAIT_L(0); PG8_BAR; PG8_MMA(1, 0, At, B0); PG8_MMA(1, 1, At, B1); PG8_BAR; PG8_SCHED;
            PG8_LDB(B0, 1, 0); PG8_LDB(B1, 1, 1); PG8_SCHED; PG8_LDA(At, 1, 0); PG8_STAGE(PG8_SA(0, 1), a2 + hstep, voffA);
            PG8_WAIT_V(8); PG8_WAIT_L(0); PG8_BAR; PG8_MMA(0, 0, At, B0); PG8_MMA(0, 1, At, B1); PG8_BAR; PG8_SCHED;
            PG8_LDA(At, 1, 1); PG8_STAGE(PG8_SB(1, 0), b3, voffB); PG8_STAGE(PG8_SB(1, 1), b3 + hstep, voffB); PG8_STAGE(PG8_SA(1, 0), a3, voffA);
            PG8_WAIT_V(8); PG8_WAIT_L(0); PG8_BAR; PG8_MMA(1, 0, At, B0); PG8_MMA(1, 1, At, B1); PG8_BAR; PG8_SCHED;
            } else {
            PG8_LDB(B0, 0, 0); PG8_SCHED; PG8_LDA(At, 0, 0); PG8_STAGE(PG8_SA(1, 1), a1 + hstep, voffA);
            PG8_WAIT_L(8); PG8_BAR; PG8_WAIT_L(0); PG8_MMA(0, 0, At, B0); PG8_BAR; PG8_SCHED;
            PG8_LDB(B1, 0, 1); PG8_STAGE(PG8_SB(0, 0), b2, voffB);
            PG8_BAR; PG8_WAIT_L(0); PG8_MMA(0, 1, At, B1); PG8_BAR;
            PG8_LDA(At, 0, 1); PG8_STAGE(PG8_SA(0, 0), a2, voffA);
            PG8_BAR; PG8_WAIT_L(0); PG8_MMA(1, 0, At, B0); PG8_BAR; PG8_SCHED;
            PG8_STAGE(PG8_SB(0, 1), b2 + hstep, voffB);
            PG8_WAIT_V(6); PG8_BAR; PG8_MMA(1, 1, At, B1); PG8_BAR;
            PG8_LDB(B0, 1, 0); PG8_SCHED; PG8_LDA(At, 1, 0); PG8_STAGE(PG8_SA(0, 1), a2 + hstep, voffA);
            PG8_WAIT_L(8); PG8_BAR; PG8_WAIT_L(0); PG8_MMA(0, 0, At, B0); PG8_BAR; PG8_SCHED;
            PG8_LDB(B1, 1, 1); PG8_STAGE(PG8_SB(1, 0), b3, voffB);
            PG8_BAR; PG8_WAIT_L(0); PG8_MMA(0, 1, At, B1); PG8_BAR;
            PG8_LDA(At, 1, 1); PG8_STAGE(PG8_SA(1, 0), a3, voffA);
            PG8_BAR; PG8_WAIT_L(0); PG8_MMA(1, 0, At, B0); PG8_BAR; PG8_SCHED;
            PG8_STAGE(PG8_SB(1, 1), b3 + hstep, voffB);
            PG8_WAIT_V(6); PG8_BAR; PG8_MMA(1, 1, At, B1); PG8_BAR;
            }
        }
        if constexpr (ALIGN_EPI) { if (wr == 0) PG8_BAR; }
        if constexpr (!Epi::AFTER_DRAIN) { E(acc, cur, wr, wc, fr, fq); S.done(cur); }
        if (!has_next) break;
#pragma unroll
        for (int a = 0; a < 2; ++a)
#pragma unroll
            for (int b = 0; b < 2; ++b)
#pragma unroll
                for (int m = 0; m < 4; ++m)
#pragma unroll
                    for (int n = 0; n < 2; ++n) acc[a][b][m][n] = (f32x4){0.f, 0.f, 0.f, 0.f};
        cur = nxt; cA = nA; cB = nB; ++ui;
        if constexpr (ALIGN_EPI) { if (wr == 1) PG8_BAR; }
    }
    PG8_WAIT_V(0);
    if constexpr (!ALIGN_EPI) { if (wr == 0) PG8_BAR; }
    PG8_BAR;
    if constexpr (Epi::AFTER_DRAIN) { E.fused(acc, cur, wr, wc, fr, fq, lds, wid, lane); S.done(cur); }
#undef PG8_SA
#undef PG8_SB
#undef PG8_STAGE
#undef PG8_LDA
#undef PG8_LDB
#undef PG8_MMA
#undef PG8_WAIT_V
#undef PG8_WAIT_L
#undef PG8_BAR
#undef PG8_SCHED
}
}

using pg8::Unit;
typedef f32x4 Acc[2][2][4][2];

DI u32x4 pack8(const f32x4& a, const f32x4& b) { u32x4 w; w.x = pk2(a[0], a[1]); w.y = pk2(a[2], a[3]); w.z = pk2(b[0], b[1]); w.w = pk2(b[2], b[3]); return w; }

DI void st16_wt(void* p, const u32x4& v) {
#if USE_WT_STORES
    asm volatile("global_store_dwordx4 %0, %1, off sc1\n\ts_nop 1" :: "v"(p), "v"(v) : "memory");
#else
    *(u32x4*)p = v;
#endif
}
DI void dequant_acc(Acc& acc, const Unit& u, int wr, int wc, int fr, int fq, const float* SA, const float* SB) {
    f32x4 sb[2][2];
#pragma unroll
    for (int bj = 0; bj < 2; ++bj)
#pragma unroll
        for (int n = 0; n < 2; ++n) sb[bj][n] = *(const f32x4*)(SB + u.pn * 256 + bj * 128 + wc * 32 + 8 * fq + 4 * n);
#pragma unroll
    for (int ai = 0; ai < 2; ++ai)
#pragma unroll
        for (int m = 0; m < 4; ++m) {
            const float sa = SA[u.pm * 256 + ai * 128 + wr * 64 + m * 16 + fr];
#pragma unroll
            for (int bj = 0; bj < 2; ++bj)
#pragma unroll
                for (int n = 0; n < 2; ++n)
#pragma unroll
                    for (int e = 0; e < 4; ++e) acc[ai][bj][m][n][e] = (float)__float_as_int(acc[ai][bj][m][n][e]) * sa * sb[bj][n][e];
        }
}

template <int CTRL, bool ZERO> DI float dppf(float v) { return __int_as_float(__builtin_amdgcn_update_dpp(0, __float_as_int(v), CTRL, 0xF, 0xF, ZERO)); }

struct EpiH {
    static constexpr bool PERM = true, AFTER_DRAIN = false;
    bf16* Qh; bf16* Kh; bf16* VTh; float* DEC; const float* hlb; bf16* OHG; const float* SA; const float* SB;
    DI void operator()(Acc& acc, const Unit& u, int wr, int wc, int fr, int fq) const {
        dequant_acc(acc, u, wr, wc, fr, fq, SA, SB);
        if (u.pn < 8) {
            const int h = u.pn, dbase = wc * 32 + 8 * fq;
#pragma unroll
            for (int ai = 0; ai < 2; ++ai) {
                const int row0 = u.pm * 256 + ai * 128 + wr * 64;
                const int bidx = row0 >> 13, chunk = (row0 & (SEQ - 1)) >> 6;
#pragma unroll
                for (int n = 0; n < 2; ++n) {
                    const f32x4 h0 = *(const f32x4*)(hlb + h * 128 + dbase + 4 * n), h1 = *(const f32x4*)(hlb + 1024 + h * 128 + dbase + 4 * n);
                    f32x4 ebl;
#pragma unroll
                    for (int e = 0; e < 4; ++e) {
                        const float lb = sigmoidf_(h0[e] - h1[e]);
                        float g[4], kk[4], tot[4];
#pragma unroll
                        for (int m = 0; m < 4; ++m) {
                            const float sg = sigmoidf_(acc[ai][1][m][n][e]);
                            kk[m] = (1.f - lb) * (1.f - sg);
                            const float lf = __logf(lb + (1.f - lb) * sg);
                            float s = lf;
                            s += dppf<0x111, true>(s); s += dppf<0x112, true>(s); s += dppf<0x114, true>(s); s += dppf<0x118, true>(s);
                            float t = lf;
                            t += dppf<0xB1, false>(t); t += dppf<0x4E, false>(t); t += dppf<0x141, false>(t); t += dppf<0x140, false>(t);
                            g[m] = s; tot[m] = t;
                        }
                        float carry = 0.f, eb = 0.f;
#pragma unroll
                        for (int m = 0; m < 4; ++m) {
                            const float bb = g[m] + carry; carry += tot[m];
                            eb = __expf(bb);
                            acc[ai][0][m][n][e] = acc[ai][0][m][n][e] * 0.08838834764831845f * eb;
                            acc[ai][1][m][n][e] = kk[m] * __expf(-bb);
                        }
                        ebl[e] = eb;
                    }
                    if (fr == 15) *(f32x4*)(DEC + ((size_t)((bidx * HG_H + h) * HG_NC + chunk)) * 128 + dbase + 4 * n) = ebl;
#pragma unroll
                    for (int m = 0; m < 4; ++m) {
                        const size_t row = (size_t)(row0 + m * 16 + fr);
                        const f32x4 qv = acc[ai][0][m][n], kv = acc[ai][1][m][n];
                        u32x2 oq, ok; oq.x = pk2(qv[0], qv[1]); oq.y = pk2(qv[2], qv[3]); ok.x = pk2(kv[0], kv[1]); ok.y = pk2(kv[2], kv[3]);
                        *(u32x2*)(Qh + row * 1024 + h * 128 + dbase + 4 * n) = oq;
                        *(u32x2*)(Kh + row * 1024 + h * 128 + dbase + 4 * n) = ok;
                    }
                    __builtin_amdgcn_sched_barrier(0);
                }
            }
        } else if (u.pn >= 12) {
            const int cb = (u.pn - 12) * 256 + wc * 32 + 8 * fq;
#pragma unroll
            for (int ai = 0; ai < 2; ++ai)
#pragma unroll
                for (int m = 0; m < 4; ++m) {
                    const size_t row = (size_t)(u.pm * 256 + ai * 128 + wr * 64 + m * 16 + fr);
#pragma unroll
                    for (int bj = 0; bj < 2; ++bj) {
                        f32x4 a0 = acc[ai][bj][m][0], a1 = acc[ai][bj][m][1];
#pragma unroll
                        for (int e = 0; e < 4; ++e) { a0[e] = siluf_(a0[e]); a1[e] = siluf_(a1[e]); }
                        st16_wt(OHG + row * 1024 + cb + bj * 128, pack8(a0, a1));
                    }
                }
        } else {
#pragma unroll
            for (int ai = 0; ai < 2; ++ai)
#pragma unroll
                for (int m = 0; m < 4; ++m) {
                    const int row = u.pm * 256 + ai * 128 + wr * 64 + m * 16 + fr, bidx = row >> 13, pos = row & (SEQ - 1);
                    bf16* ptr = VTh + (((size_t)(bidx * HG_H * 128 + (u.pn - 8) * 256 + wc * 32 + 8 * fq)) << 13) + pos;
#pragma unroll
                    for (int bj = 0; bj < 2; ++bj) {
#pragma unroll
                        for (int n = 0; n < 2; ++n)
#pragma unroll
                            for (int e = 0; e < 4; ++e) { asm volatile("" : "+v"(ptr)); *ptr = f2bf(acc[ai][bj][m][n][e]); ptr += 8192; }
                        ptr += (size_t)120 * 8192;
                    }
                }
        }
    }
};

struct EpiR {
    static constexpr bool PERM = true, AFTER_DRAIN = false;
    bf16* Qr; bf16* Kr; bf16* VTr; const float* COS; const float* SIN; bf16* ORET; const float* SA; const float* SB;
    DI void operator()(Acc& acc, const Unit& u, int wr, int wc, int fr, int fq) const {
        dequant_acc(acc, u, wr, wc, fr, fq, SA, SB);
        if (u.pn < 8) {
            const bool isk = u.pn >= 4; const int h = u.pn & 3;
            const float lg = __log2f(1.f - exp2f(-5.f - (float)h));
            bf16* dst = isk ? Kr : Qr;
            const int j0 = wc * 32 + 8 * fq;
            f32x4 cj[2];
#pragma unroll
            for (int n = 0; n < 2; ++n)
#pragma unroll
                for (int e = 0; e < 4; ++e) cj[n][e] = exp2f(-(float)(j0 + 4 * n + e) * 0.10381025296523008f) * 0.15915494309189535f;
#pragma unroll
            for (int ai = 0; ai < 2; ++ai)
#pragma unroll
                for (int m = 0; m < 4; ++m) {
                    const int row = u.pm * 256 + ai * 128 + wr * 64 + m * 16 + fr, pos = row & (SEQ - 1), il = pos & (RT_L - 1);
                    const float sc = isk ? exp2f(-lg * (float)il) * 0.0625f : exp2f(lg * (float)il);
                    const float fpos = (float)pos;
#pragma unroll
                    for (int n = 0; n < 2; ++n) {
                        f32x4 c, s;
#pragma unroll
                        for (int e = 0; e < 4; ++e) { const float rev = __builtin_amdgcn_fractf(fpos * cj[n][e]); c[e] = __builtin_amdgcn_cosf(rev); s[e] = __builtin_amdgcn_sinf(rev); }
                        const f32x4 x1 = acc[ai][0][m][n], x2 = acc[ai][1][m][n];
                        acc[ai][0][m][n] = (x1 * c - x2 * s) * sc; acc[ai][1][m][n] = (x1 * s + x2 * c) * sc;
                    }
                    st16_wt(dst + (size_t)row * 1024 + h * 256 + j0, pack8(acc[ai][0][m][0], acc[ai][0][m][1]));
                    st16_wt(dst + (size_t)row * 1024 + h * 256 + 128 + j0, pack8(acc[ai][1][m][0], acc[ai][1][m][1]));
                }
        } else if (u.pn >= 16) {
            const int cb = (u.pn - 16) * 256 + wc * 32 + 8 * fq;
#pragma unroll
            for (int ai = 0; ai < 2; ++ai)
#pragma unroll
                for (int m = 0; m < 4; ++m) {
                    const size_t row = (size_t)(u.pm * 256 + ai * 128 + wr * 64 + m * 16 + fr);
#pragma unroll
                    for (int bj = 0; bj < 2; ++bj) {
                        f32x4 a0 = acc[ai][bj][m][0], a1 = acc[ai][bj][m][1];
#pragma unroll
                        for (int e = 0; e < 4; ++e) { a0[e] = siluf_(a0[e]); a1[e] = siluf_(a1[e]); }
                        st16_wt(ORET + row * 2048 + cb + bj * 128, pack8(a0, a1));
                    }
                }
        } else {
#pragma unroll
            for (int ai = 0; ai < 2; ++ai)
#pragma unroll
                for (int m = 0; m < 4; ++m) {
                    const int row = u.pm * 256 + ai * 128 + wr * 64 + m * 16 + fr, bidx = row >> 13, pos = row & (SEQ - 1);
                    const int uu = pos & 15, hs = (uu >> 2) & 1, jj = ((uu >> 3) << 2) | (uu & 3), ks = (pos >> 4) & 1, sblk = pos >> 5;
                    const int c0 = (u.pn - 8) * 256 + wc * 32, hd = c0 >> 9, nv0 = (c0 & 511) >> 5;
                    bf16* ptr = VTr + ((((size_t)((bidx * RT_H + hd) * 256 + sblk) * 16 + nv0) * 2 + ks) * 64 + (8 * fq + 32 * hs)) * 8 + jj;
#pragma unroll
                    for (int bj = 0; bj < 2; ++bj) {
#pragma unroll
                        for (int n = 0; n < 2; ++n)
#pragma unroll
                            for (int e = 0; e < 4; ++e) { asm volatile("" : "+v"(ptr)); *ptr = f2bf(acc[ai][bj][m][n][e]); ptr += 8; }
                        ptr += 4 * 2 * 64 * 8 - 64;
                    }
                }
        }
    }
};

struct EpiG {
    static constexpr bool PERM = true, AFTER_DRAIN = false;
    bf16* GA; bf16* GB; const float* SA; const float* SB;
    DI void operator()(Acc& acc, const Unit& u, int wr, int wc, int fr, int fq) const {
        dequant_acc(acc, u, wr, wc, fr, fq, SA, SB);
        const int cb = wc * 32 + 8 * fq;
        bf16* base = (u.pn < 4 ? GA + (size_t)u.pn * 256 : GB + (size_t)(u.pn - 4) * 256) + cb;
#pragma unroll
        for (int ai = 0; ai < 2; ++ai)
#pragma unroll
            for (int m = 0; m < 4; ++m) {
                const size_t row = (size_t)(u.pm * 256 + ai * 128 + wr * 64 + m * 16 + fr);
#pragma unroll
                for (int bj = 0; bj < 2; ++bj) {
                    f32x4 a0 = acc[ai][bj][m][0], a1 = acc[ai][bj][m][1];
#pragma unroll
                    for (int e = 0; e < 4; ++e) { a0[e] = sigmoidf_(a0[e]); a1[e] = sigmoidf_(a1[e]); }
                    st16_wt(base + row * 1024 + bj * 128, pack8(a0, a1));
                }
            }
    }
};

struct EpiM1 {
    static constexpr bool PERM = true, AFTER_DRAIN = false;
    bf16* MERGED; const bf16* GA;
    DI void operator()(Acc& acc, const Unit& u, int wr, int wc, int fr, int fq) const {
        const int cb = u.pn * 256 + wc * 32 + 8 * fq;
#pragma unroll
        for (int ai = 0; ai < 2; ++ai)
#pragma unroll
            for (int m = 0; m < 4; ++m) {
                const size_t row = (size_t)(u.pm * 256 + ai * 128 + wr * 64 + m * 16 + fr);
#pragma unroll
                for (int bj = 0; bj < 2; ++bj) {
                    const u32x4 g = *(const u32x4*)(GA + row * 1024 + cb + bj * 128);
                    f32x4 a0 = acc[ai][bj][m][0], a1 = acc[ai][bj][m][1];
                    a0[0] *= bflo(g.x); a0[1] *= bfhi(g.x); a0[2] *= bflo(g.y); a0[3] *= bfhi(g.y);
                    a1[0] *= bflo(g.z); a1[1] *= bfhi(g.z); a1[2] *= bflo(g.w); a1[3] *= bfhi(g.w);
                    st16_wt(MERGED + row * 1024 + cb + bj * 128, pack8(a0, a1));
                }
            }
    }
};
struct EpiMerge {
    static constexpr bool PERM = true, AFTER_DRAIN = false;
    const bf16* GB; bf16* MERGED;
    DI void operator()(Acc& acc, const Unit& u, int wr, int wc, int fr, int fq) const {
        const int cb = u.pn * 256 + wc * 32 + 8 * fq;
#pragma unroll
        for (int ai = 0; ai < 2; ++ai)
#pragma unroll
            for (int m = 0; m < 4; ++m) {
                const size_t row = (size_t)(u.pm * 256 + ai * 128 + wr * 64 + m * 16 + fr);
#pragma unroll
                for (int bj = 0; bj < 2; ++bj) {
                    const u32x4 g = *(const u32x4*)(GB + row * 1024 + cb + bj * 128);
                    const u32x4 mo = *(const u32x4*)(MERGED + row * 1024 + cb + bj * 128);
                    f32x4 a0 = acc[ai][bj][m][0], a1 = acc[ai][bj][m][1];
                    a0[0] = a0[0] * bflo(g.x) + bflo(mo.x); a0[1] = a0[1] * bfhi(g.x) + bfhi(mo.x); a0[2] = a0[2] * bflo(g.y) + bflo(mo.y); a0[3] = a0[3] * bfhi(g.y) + bfhi(mo.y);
                    a1[0] = a1[0] * bflo(g.z) + bflo(mo.z); a1[1] = a1[1] * bfhi(g.z) + bfhi(mo.z); a1[2] = a1[2] * bflo(g.w) + bflo(mo.w); a1[3] = a1[3] * bfhi(g.w) + bfhi(mo.w);
                    st16_wt(MERGED + row * 1024 + cb + bj * 128, pack8(a0, a1));
                }
            }
    }
};
struct EpiOut {
    static constexpr bool PERM = true, AFTER_DRAIN = false;
    const float* X; float* X1; bf16* XW; const float* nw; float* SSQX;
    DI void operator()(Acc& acc, const Unit& u, int wr, int wc, int fr, int fq) const {
        const int cb = u.pn * 256 + wc * 32 + 8 * fq;
#pragma unroll
        for (int ai = 0; ai < 2; ++ai)
#pragma unroll
            for (int m = 0; m < 4; ++m) {
                const size_t row = (size_t)(u.pm * 256 + ai * 128 + wr * 64 + m * 16 + fr);
                float ss = 0.f;
#pragma unroll
                for (int bj = 0; bj < 2; ++bj) {
                    const size_t off = row * 1024 + cb + bj * 128;
                    const f32x4 x0 = *(const f32x4*)(X + off), x1v = *(const f32x4*)(X + off + 4);
                    const f32x4 w0 = *(const f32x4*)(nw + cb + bj * 128), w1 = *(const f32x4*)(nw + cb + bj * 128 + 4);
                    const f32x4 a0 = acc[ai][bj][m][0] + x0, a1 = acc[ai][bj][m][1] + x1v;
                    *(f32x4*)(X1 + off) = a0; *(f32x4*)(X1 + off + 4) = a1;
                    ss += (a0[0] * a0[0] + a0[1] * a0[1]) + (a0[2] * a0[2] + a0[3] * a0[3]) + (a1[0] * a1[0] + a1[1] * a1[1]) + (a1[2] * a1[2] + a1[3] * a1[3]);
                    st16_wt(XW + off, pack8(a0 * w0, a1 * w1));
                }
                ss += __shfl_xor(ss, 16); ss += __shfl_xor(ss, 32);
                if (fq == 0) SSQX[row * 16 + u.pn * 4 + wc] = ss;
            }
    }
};
DI float rstd_x1(const float* SSQX, size_t row) {
    const f32x4 a = *(const f32x4*)(SSQX + row * 16), b = *(const f32x4*)(SSQX + row * 16 + 4), c = *(const f32x4*)(SSQX + row * 16 + 8), d = *(const f32x4*)(SSQX + row * 16 + 12);
    const float s = ((a[0] + a[1]) + (a[2] + a[3])) + ((b[0] + b[1]) + (b[2] + b[3])) + ((c[0] + c[1]) + (c[2] + c[3])) + ((d[0] + d[1]) + (d[2] + d[3]));
    return rsqrtf(s * (1.f / 1024.f) + EPS);
}
struct EpiQ {
    static constexpr bool PERM = true, AFTER_DRAIN = false;
    bf16* Q; const float* SSQX;
    DI void operator()(Acc& acc, const Unit& u, int wr, int wc, int fr, int fq) const {
        const int cb = u.pn * 256 + wc * 32 + 8 * fq;
#pragma unroll
        for (int ai = 0; ai < 2; ++ai)
#pragma unroll
            for (int m = 0; m < 4; ++m) {
                const size_t row = (size_t)(u.pm * 256 + ai * 128 + wr * 64 + m * 16 + fr);
                const float rs = rstd_x1(SSQX, row);
#pragma unroll
                for (int bj = 0; bj < 2; ++bj) st16_wt(Q + row * 2048 + cb + bj * 128, pack8(acc[ai][bj][m][0] * rs, acc[ai][bj][m][1] * rs));
            }
    }
};

#define MFMA32(a, b, c) __builtin_amdgcn_mfma_f32_32x32x16_bf16((a), (b), (c), 0, 0, 0)
DI bf16x8 ldg16(const bf16* p) { return *(const bf16x8*)p; }
DI bf16x8 ldg2x8(const bf16* p0, const bf16* p1) { const s16x4 a = *(const s16x4*)p0, b = *(const s16x4*)p1; return __builtin_shufflevector(a, b, 0, 1, 2, 3, 4, 5, 6, 7); }
DI bf16x8 packx(const f32x16& x, int s) {
    u32x4 p; p.x = pk2(x[8 * s + 0], x[8 * s + 1]); p.y = pk2(x[8 * s + 2], x[8 * s + 3]); p.z = pk2(x[8 * s + 4], x[8 * s + 5]); p.w = pk2(x[8 * s + 6], x[8 * s + 7]);
    return __builtin_bit_cast(bf16x8, p);
}
DI f32x16 zero16() { f32x16 z;
#pragma unroll
    for (int i = 0; i < 16; ++i) z[i] = 0.f; return z; }

DI bf16x8 tr_frag(const LAS unsigned char* tile, int RS, int lane, int ks, int c) {
    const int hh = lane >> 5, blk = (lane >> 4) & 1, q = (lane & 15) >> 2, p = lane & 3;
    const LAS unsigned char* a0 = tile + (16 * ks + 8 * hh + q) * RS + (32 * c + 16 * blk + 4 * p) * 2;
    const s16x4 lo = __builtin_amdgcn_ds_read_tr16_b64_v4i16((LAS s16x4*)a0);
    const s16x4 hi = __builtin_amdgcn_ds_read_tr16_b64_v4i16((LAS s16x4*)(a0 + 4 * RS));
    return __builtin_shufflevector(lo, hi, 0, 1, 2, 3, 4, 5, 6, 7);
}

DI bf16x8 tr_frag_perm(const LAS unsigned char* tile, int RS, int lane, int ks, int c) {
    const int hh = lane >> 5, blk = (lane >> 4) & 1, q = (lane & 15) >> 2, p = lane & 3;
    const LAS unsigned char* a0 = tile + (16 * ks + 4 * hh + q) * RS + (32 * c + 16 * blk + 4 * p) * 2;
    const s16x4 lo = __builtin_amdgcn_ds_read_tr16_b64_v4i16((LAS s16x4*)a0);
    const s16x4 hi = __builtin_amdgcn_ds_read_tr16_b64_v4i16((LAS s16x4*)(a0 + 8 * RS));
    return __builtin_shufflevector(lo, hi, 0, 1, 2, 3, 4, 5, 6, 7);
}

constexpr int HG_KRS = 320;
DI void hg_pass1(LAS unsigned char* lds, const bf16* Kh, const bf16* VTh, bf16* STh, int wg, int nwg) {
    const int tid = fresh_tid(), lane = tid & 63, w = __builtin_amdgcn_readfirstlane(tid >> 6), r = lane & 31, hh = lane >> 5;
    for (int unit = wg; unit < 16 * HG_NC; unit += nwg) {
        const int bh = unit >> 7, c = unit & 127, b = bh >> 3, h = bh & 7;
        __syncthreads();
        {
            const int row = tid >> 3, ch = tid & 7;
            const bf16* src = Kh + ((size_t)(b * SEQ + c * 64 + row)) * 1024 + h * 128;
            const bf16x8 v0 = ldg16(src + ch * 8), v1 = ldg16(src + 64 + ch * 8);
            *(LAS bf16x8*)(lds + row * HG_KRS + ch * 16) = v0; *(LAS bf16x8*)(lds + row * HG_KRS + 128 + ch * 16) = v1;
        }
        __syncthreads();
        const int mt = w & 3, nt0 = w >> 2;
        f32x16 a0 = zero16(), a1 = zero16();
        const bf16* vrow = VTh + (((size_t)(bh * 128 + 32 * mt + r)) << 13) + c * 64;
#pragma unroll
        for (int ks = 0; ks < 4; ++ks) {
            const bf16x8 av = ldg16(vrow + 16 * ks + 8 * hh);
            a0 = MFMA32(av, tr_frag(lds, HG_KRS, lane, ks, nt0), a0);
            a1 = MFMA32(av, tr_frag(lds, HG_KRS, lane, ks, nt0 + 2), a1);
        }
        bf16* dst = STh + ((size_t)(bh * HG_NC + c)) * 16384;
#pragma unroll
        for (int i = 0; i < 16; ++i) {
            const int v = 32 * mt + crow(i, hh);
            dst[v * 128 + 32 * nt0 + r] = f2bf(a0[i]); dst[v * 128 + 32 * (nt0 + 2) + r] = f2bf(a1[i]);
        }
    }
    __syncthreads();
}

DI void hg_scan(bf16* STh, const float* DEC, int gtid, int gsz) {
    for (int idx = gtid; idx < 16 * 128 * 32; idx += gsz) {
        const int dq = idx & 31, v = (idx >> 5) & 127, bh = idx >> 12;
        f32x4 carry = {0.f, 0.f, 0.f, 0.f};
        bf16* p = STh + ((size_t)bh * HG_NC) * 16384 + v * 128 + dq * 4;
        const float* dp = DEC + ((size_t)bh * HG_NC) * 128 + dq * 4;
#pragma unroll 8
        for (int c = 0; c < HG_NC; ++c) {
            const u32x2 wv = *(const u32x2*)(p + (size_t)c * 16384);
            const f32x4 dec = *(const f32x4*)(dp + c * 128);
            u32x2 o; o.x = pk2(carry[0], carry[1]); o.y = pk2(carry[2], carry[3]);
            *(u32x2*)(p + (size_t)c * 16384) = o;
            carry[0] = dec[0] * (carry[0] + bflo(wv.x)); carry[1] = dec[1] * (carry[1] + bfhi(wv.x));
            carry[2] = dec[2] * (carry[2] + bflo(wv.y)); carry[3] = dec[3] * (carry[3] + bfhi(wv.y));
        }
    }
}
DI void rt_scan(bf16* STr, int gtid, int gsz) {
    for (int idx = gtid; idx < 8 * 512 * 32; idx += gsz) {
        const int dq = idx & 31, v = (idx >> 5) & 511, bh = idx >> 14, h = bh & 3;
        const float dec = exp2f((float)RT_L * __log2f(1.f - exp2f(-5.f - (float)h)));
        float carry[8];
#pragma unroll
        for (int e = 0; e < 8; ++e) carry[e] = 0.f;
        bf16* p = STr + ((size_t)bh * RT_NS) * 131072 + v * 256 + dq * 8;
#pragma unroll 4
        for (int c = 0; c < RT_NS; ++c) {
            const u32x4 wv = *(const u32x4*)(p + (size_t)c * 131072);
            u32x4 o; o.x = pk2(carry[0], carry[1]); o.y = pk2(carry[2], carry[3]); o.z = pk2(carry[4], carry[5]); o.w = pk2(carry[6], carry[7]);
            *(u32x4*)(p + (size_t)c * 131072) = o;
            if (c == RT_NS - 1) break;
            carry[0] = dec * (carry[0] + bflo(wv.x)); carry[1] = dec * (carry[1] + bfhi(wv.x));
            carry[2] = dec * (carry[2] + bflo(wv.y)); carry[3] = dec * (carry[3] + bfhi(wv.y));
            carry[4] = dec * (carry[4] + bflo(wv.z)); carry[5] = dec * (carry[5] + bfhi(wv.z));
            carry[6] = dec * (carry[6] + bflo(wv.w)); carry[7] = dec * (carry[7] + bfhi(wv.w));
        }
    }
}

DI void hg_pass3(LAS unsigned char* lds, const bf16* Qh, const bf16* Kh, const bf16* VTh, const bf16* STh, const float* hg_norm_w, bf16* OHG, int gw, int ngw, int dry) {
    const int tid_ = fresh_tid(), lane = tid_ & 63, r = lane & 31, hh = lane >> 5;
    LAS unsigned char* ot = lds + __builtin_amdgcn_readfirstlane(tid_ >> 6) * 8704;
    for (int unit = gw; unit < 16 * HG_NC * 2; unit += ngw) {
        const int tb = unit & 1, c = (unit >> 1) & 127, bh = unit >> 8, b = bh >> 3, h = bh & 7;
        const size_t trow = (size_t)(b * SEQ + c * 64 + tb * 32 + r);
        bf16x8 qf[8];
#pragma unroll
        for (int kk = 0; kk < 8; ++kk) qf[kk] = ldg16(Qh + trow * 1024 + h * 128 + kk * 16 + 8 * hh);
        f32x16 acc[4];
#pragma unroll
        for (int nv = 0; nv < 4; ++nv) acc[nv] = zero16();
        for (int sb = 0; sb <= tb; ++sb) {
            const size_t srow = (size_t)(b * SEQ + c * 64 + sb * 32 + r);
            f32x16 x = zero16();
#pragma unroll
            for (int kk = 0; kk < 8; ++kk) x = MFMA32(ldg16(Kh + srow * 1024 + h * 128 + kk * 16 + 8 * hh), qf[kk], x);
            if (sb == tb) {
#pragma unroll
                for (int i = 0; i < 16; ++i) if (crow(i, hh) > r) x[i] = 0.f;
            }
            const bf16x8 xs0 = packx(x, 0), xs1 = packx(x, 1);
#pragma unroll
            for (int nv = 0; nv < 4; ++nv) {
                const bf16* vb = VTh + (((size_t)(bh * 128 + nv * 32 + r)) << 13) + c * 64 + sb * 32 + 4 * hh;
                acc[nv] = MFMA32(ldg2x8(vb, vb + 8), xs0, acc[nv]);
                acc[nv] = MFMA32(ldg2x8(vb + 16, vb + 24), xs1, acc[nv]);
            }
        }
        const bf16* st = STh + ((size_t)(bh * HG_NC + c)) * 16384;
#pragma unroll
        for (int nv = 0; nv < 4; ++nv)
#pragma unroll
            for (int kk = 0; kk < 8; ++kk) acc[nv] = MFMA32(ldg16(st + (nv * 32 + r) * 128 + kk * 16 + 8 * hh), qf[kk], acc[nv]);
        float ss = 0.f;
#pragma unroll
        for (int nv = 0; nv < 4; ++nv)
#pragma unroll
            for (int i = 0; i < 16; ++i) ss += acc[nv][i] * acc[nv][i];
        ss += __shfl_xor(ss, 32);
        const float rs = rsqrtf(ss * (1.f / 128.f) + EPS);
#pragma unroll
        for (int nv = 0; nv < 4; ++nv)
#pragma unroll
            for (int g = 0; g < 4; ++g) {
                const int v = nv * 32 + 8 * g + 4 * hh;
                const f32x4 wv = *(const f32x4*)(hg_norm_w + h * 128 + v);
                u32x2 o; o.x = pk2(acc[nv][4 * g] * rs * wv[0], acc[nv][4 * g + 1] * rs * wv[1]); o.y = pk2(acc[nv][4 * g + 2] * rs * wv[2], acc[nv][4 * g + 3] * rs * wv[3]);
                *(LAS u32x2*)(ot + r * 272 + v * 2) = o;
            }
        bf16* orow = OHG + ((size_t)(b * SEQ + c * 64 + tb * 32)) * 1024 + h * 128;
#pragma unroll
        for (int k = 0; k < 8; ++k) {
            const int row = 4 * k + (lane >> 4), ch = lane & 15;
            const u32x4 val = *(const LAS u32x4*)(ot + row * 272 + ch * 16);
            bf16* gp = orow + (size_t)row * 1024 + ch * 8;
            const u32x4 gt = *(const u32x4*)gp;
            u32x4 o;
            o.x = pk2(bflo(val.x) * bflo(gt.x), bfhi(val.x) * bfhi(gt.x)); o.y = pk2(bflo(val.y) * bflo(gt.y), bfhi(val.y) * bfhi(gt.y));
            o.z = pk2(bflo(val.z) * bflo(gt.z), bfhi(val.z) * bfhi(gt.z)); o.w = pk2(bflo(val.w) * bflo(gt.w), bfhi(val.w) * bfhi(gt.w));
            if (!dry) *(u32x4*)gp = o; else asm volatile("" :: "v"(o));
        }
    }
}

constexpr int RT_KRS = 576;
constexpr int RT_KBUF = 64 * RT_KRS;
DI void rt_pass1(LAS unsigned char* lds, const bf16* Kr, const bf16* VTr, bf16* STr, int wg, int nwg) {
    const int tid = fresh_tid(), lane = tid & 63, w = __builtin_amdgcn_readfirstlane(tid >> 6), r = lane & 31, hh = lane >> 5;
    const int wm = w & 3, wn = w >> 2;
    const int srow = tid >> 3, sch = tid & 7;
    for (int unit = wg; unit < 8 * (RT_NS - 1) * 2; unit += nwg) {
        const int vh = unit & 1, sg = (unit >> 1) % (RT_NS - 1), bh = (unit >> 1) / (RT_NS - 1), b = bh >> 2, h = bh & 3;
        f32x16 acc[2][4];
#pragma unroll
        for (int i = 0; i < 2; ++i)
#pragma unroll
            for (int j = 0; j < 4; ++j) acc[i][j] = zero16();
        const bf16* kbase = Kr + ((size_t)(b * SEQ + sg * RT_L)) * 1024 + h * 256;
        bf16x8 st[4];
#pragma unroll
        for (int i = 0; i < 4; ++i) st[i] = ldg16(kbase + (size_t)srow * 1024 + (sch + 8 * i) * 8);
        __syncthreads();
#pragma unroll
        for (int i = 0; i < 4; ++i) *(LAS bf16x8*)(lds + srow * RT_KRS + (sch + 8 * i) * 16) = st[i];
        for (int sb = 0; sb < RT_L / 64; ++sb) {
            const LAS unsigned char* cur = lds + (sb & 1) * RT_KBUF;
            if (sb + 1 < RT_L / 64) {
#pragma unroll
                for (int i = 0; i < 4; ++i) st[i] = ldg16(kbase + (size_t)((sb + 1) * 64 + srow) * 1024 + (sch + 8 * i) * 8);
            }
            __syncthreads();
#pragma unroll
            for (int ks = 0; ks < 4; ++ks) {
                bf16x8 av[2];
#pragma unroll
                for (int i = 0; i < 2; ++i) av[i] = ldg16(VTr + (((((size_t)(bh * 256 + sg * 16 + sb * 2 + (ks >> 1))) * 16 + vh * 8 + wm * 2 + i) * 2 + (ks & 1)) * 64 + lane) * 8);
#pragma unroll
                for (int j = 0; j < 4; ++j) {
                    const bf16x8 bv = tr_frag_perm(cur, RT_KRS, lane, ks, wn * 4 + j);
                    acc[0][j] = MFMA32(av[0], bv, acc[0][j]); acc[1][j] = MFMA32(av[1], bv, acc[1][j]);
                }
                __builtin_amdgcn_sched_barrier(0);
            }
            if (sb + 1 < RT_L / 64) {
                LAS unsigned char* nxt = lds + ((sb + 1) & 1) * RT_KBUF;
#pragma unroll
                for (int i = 0; i < 4; ++i) *(LAS bf16x8*)(nxt + srow * RT_KRS + (sch + 8 * i) * 16) = st[i];
            }
        }
        bf16* dst = STr + ((size_t)(bh * RT_NS + sg)) * 131072;
#pragma unroll
        for (int i = 0; i < 2; ++i)
#pragma unroll
            for (int j = 0; j < 4; ++j)
#pragma unroll
                for (int e = 0; e < 16; ++e) {
                    const int vl = crow(e, hh), d = wn * 128 + j * 32 + r;
                    dst[((((vh * 8 + wm * 2 + i) * 16 + (d >> 4)) * 64 + vl + 32 * ((d >> 3) & 1)) << 3) + (d & 7)] = f2bf(acc[i][j][e]);
                }
    }
    __syncthreads();
}

DI void rt_pass3_unit(const bf16* Qr, const bf16* Kr, const bf16* VTr, const bf16* STr, bf16* ORET, float* SSQP, int idx, int lane) {
    const int r = lane & 31, hh = lane >> 5;
    const int vh = idx & 1, tbl = (idx >> 1) & 15, sgid = idx >> 5, sg = sgid & 15, bh = sgid >> 4, b = bh >> 2, h = bh & 3;
    const int t0 = sg * RT_L + tbl * 32;
    const size_t trow = (size_t)(b * SEQ + t0 + r);
    const bf16* qrow = Qr + trow * 1024 + h * 256 + 8 * hh;
    f32x16 acc[8];
#pragma unroll
    for (int nv = 0; nv < 8; ++nv) acc[nv] = zero16();
    for (int sb = 0; sb <= tbl; ++sb) {
        const int s0 = sg * RT_L + sb * 32;
        const bf16* krow = Kr + ((size_t)(b * SEQ + s0 + r)) * 1024 + h * 256 + 8 * hh;
        f32x16 x = zero16();
#pragma unroll
        for (int k4 = 0; k4 < 4; ++k4) {
            bf16x8 kf[4], qf[4];
#pragma unroll
            for (int i = 0; i < 4; ++i) { kf[i] = ldg16(krow + (k4 * 4 + i) * 16); qf[i] = ldg16(qrow + (k4 * 4 + i) * 16); }
#pragma unroll
            for (int i = 0; i < 4; ++i) x = MFMA32(kf[i], qf[i], x);
            __builtin_amdgcn_sched_barrier(0);
        }
        if (sb == tbl) {
#pragma unroll
            for (int i = 0; i < 16; ++i) if (crow(i, hh) > r) x[i] = 0.f;
        }
        const bf16x8 xs0 = packx(x, 0), xs1 = packx(x, 1);
#pragma unroll
        for (int nv = 0; nv < 8; ++nv) {
            const bf16* vb = VTr + (((size_t)(bh * 512 + vh * 256 + nv * 32 + r)) << 13) + s0 + 4 * hh;
            acc[nv] = MFMA32(ldg2x8(vb, vb + 8), xs0, acc[nv]);
            acc[nv] = MFMA32(ldg2x8(vb + 16, vb + 24), xs1, acc[nv]);
            if ((nv & 3) == 3) __builtin_amdgcn_sched_barrier(0);
        }
    }
    const bf16* st = STr + ((size_t)(bh * RT_NS + sg)) * 131072 + (size_t)(vh * 256) * 256;
#pragma unroll 2
    for (int kk = 0; kk < 16; ++kk) {
        const bf16x8 q = ldg16(qrow + kk * 16);
#pragma unroll
        for (int nv = 0; nv < 8; ++nv) acc[nv] = MFMA32(ldg16(st + (nv * 32 + r) * 256 + kk * 16 + 8 * hh), q, acc[nv]);
        __builtin_amdgcn_sched_barrier(0);
    }
    float ss = 0.f;
#pragma unroll
    for (int nv = 0; nv < 8; ++nv)
#pragma unroll
        for (int i = 0; i < 16; ++i) ss += acc[nv][i] * acc[nv][i];
    ss += __shfl_xor(ss, 32);
    if (hh == 0) SSQP[trow * 8 + h * 2 + vh] = ss;
#pragma unroll
    for (int nv = 0; nv < 8; ++nv)
#pragma unroll
        for (int g = 0; g < 4; ++g) {
            const int v = vh * 256 + nv * 32 + 8 * g + 4 * hh;
            u32x2 o; o.x = pk2(acc[nv][4 * g], acc[nv][4 * g + 1]); o.y = pk2(acc[nv][4 * g + 2], acc[nv][4 * g + 3]);
            *(u32x2*)(ORET + trow * 2048 + h * 512 + v) = o;
        }
}
DI void rt_pass3(const bf16* Qr, const bf16* Kr, const bf16* VTr, const bf16* STr, bf16* ORET, float* SSQP, int gw, int ngw) {
    const int lane = fresh_tid() & 63;
    for (int u = gw; u < 2048; u += ngw) {
        rt_pass3_unit(Qr, Kr, VTr, STr, ORET, SSQP, u, lane);
        const int p = (u & 1) | ((15 - ((u >> 1) & 15)) << 1) | (((u >> 5) + 64) << 5);
        rt_pass3_unit(Qr, Kr, VTr, STr, ORET, SSQP, p, lane);
    }
}

constexpr int RQ_RS = 528;
constexpr int RQ_QBYTES = 128 * RQ_RS, RQ_KBYTES = 32 * RQ_RS;
DI void rt_pass3_wg(LAS unsigned char* lds, const bf16* Qr, const bf16* Kr, const bf16* VTr, const bf16* STr, bf16* ORET, float* SSQP, int wg, int nwg, int dry) {
    const int tid = fresh_tid(), lane = tid & 63, w = __builtin_amdgcn_readfirstlane(tid >> 6), r = lane & 31, hh = lane >> 5;
    const int tsub = w & 3, vh = w >> 2;
    LAS unsigned char* Qs = lds;
    LAS unsigned char* Ks = lds + RQ_QBYTES;
    for (int pairidx = wg; pairidx < 256; pairidx += nwg) {
#pragma unroll 1
        for (int half = 0; half < 2; ++half) {
            const int sgid = pairidx >> 1, bh = sgid >> 4, sg = sgid & 15, b = bh >> 2, h = bh & 3;
            const int qq = half ? 3 - (pairidx & 1) : (pairidx & 1);
            const int pos0 = sg * RT_L + qq * 128, nsb = 4 * qq + 4, mysb = 4 * qq + tsub;
            const bf16* qsrc = Qr + ((size_t)(b * SEQ + pos0)) * 1024 + h * 256;
            const bf16* ksrc = Kr + ((size_t)(b * SEQ + sg * RT_L)) * 1024 + h * 256;
            unsigned stoff = (unsigned)((tid >> 5) * 1024 + (tid & 31) * 8);
            unsigned stlds = (unsigned)((tid >> 5) * RQ_RS + (tid & 31) * 16);
            asm volatile("" : "+v"(stoff), "+v"(stlds));
            __syncthreads();
#pragma unroll
            for (int i = 0; i < 8; ++i) *(LAS bf16x8*)(Qs + stlds + i * 16 * RQ_RS) = ldg16(qsrc + i * 16 * 1024 + stoff);
            bf16x8 kst[2];
#pragma unroll
            for (int i = 0; i < 2; ++i) *(LAS bf16x8*)(Ks + stlds + i * 16 * RQ_RS) = ldg16(ksrc + i * 16 * 1024 + stoff);
            f32x16 acc[8];
#pragma unroll
            for (int nv = 0; nv < 8; ++nv) acc[nv] = zero16();
            __syncthreads();
            const LAS unsigned char* qfr = Qs + (tsub * 32 + r) * RQ_RS + 16 * hh;
            {
                const bf16* st = STr + ((size_t)(bh * RT_NS + sg)) * 131072 + (size_t)(vh * 8) * 16 * 512;
                unsigned so = (unsigned)(lane * 8);
                asm volatile("" : "+v"(so));
                bf16x8 fa[8], fb[8];
#pragma unroll
                for (int nv = 0; nv < 8; ++nv) fa[nv] = ldg16(st + nv * 16 * 512 + so);
#pragma unroll 1
                for (int k2 = 0; k2 < 8; ++k2) {
#pragma unroll
                    for (int nv = 0; nv < 8; ++nv) fb[nv] = ldg16(st + nv * 16 * 512 + (2 * k2 + 1) * 512 + so);
                    {
                        const bf16x8 q = *(const LAS bf16x8*)(qfr + (2 * k2) * 32);
#pragma unroll
                        for (int nv = 0; nv < 8; ++nv) acc[nv] = MFMA32(fa[nv], q, acc[nv]);
                    }
                    __builtin_amdgcn_sched_barrier(0);
                    if (k2 < 7) {
#pragma unroll
                        for (int nv = 0; nv < 8; ++nv) fa[nv] = ldg16(st + nv * 16 * 512 + (2 * k2 + 2) * 512 + so);
                    }
                    {
                        const bf16x8 q = *(const LAS bf16x8*)(qfr + (2 * k2 + 1) * 32);
#pragma unroll
                        for (int nv = 0; nv < 8; ++nv) acc[nv] = MFMA32(fb[nv], q, acc[nv]);
                    }
                    __builtin_amdgcn_sched_barrier(0);
                }
            }
            const bf16* vbase = VTr + (((size_t)(bh * 256 + sg * 16)) * 16 + vh * 8) * 1024;
            unsigned vo = (unsigned)(lane * 8);
            asm volatile("" : "+v"(vo));
#pragma unroll 1
            for (int sb = 0; sb < nsb; ++sb) {
                const LAS unsigned char* kcur = Ks + (sb & 1) * RQ_KBYTES;
                if (sb + 1 < nsb) {
#pragma unroll
                    for (int i = 0; i < 2; ++i) kst[i] = ldg16(ksrc + (size_t)(sb + 1) * 32 * 1024 + i * 16 * 1024 + stoff);
                }
                if (sb <= mysb) {
                    bf16x8 vt[8][2];
                    const bf16* vb = vbase + (size_t)sb * 16 * 1024;
#pragma unroll
                    for (int nv = 0; nv < 8; ++nv) { vt[nv][0] = ldg16(vb + nv * 1024 + vo); vt[nv][1] = ldg16(vb + nv * 1024 + 512 + vo); }
                    f32x16 x = zero16();
                    const LAS unsigned char* kfr = kcur + r * RQ_RS + 16 * hh;
#pragma unroll
                    for (int kk = 0; kk < 16; ++kk) { x = MFMA32(*(const LAS bf16x8*)(kfr + kk * 32), *(const LAS bf16x8*)(qfr + kk * 32), x); if (kk & 1) __builtin_amdgcn_sched_barrier(0); }
                    if (sb == mysb) {
#pragma unroll
                        for (int i = 0; i < 16; ++i) if (crow(i, hh) > r) x[i] = 0.f;
                    }
                    const bf16x8 xs0 = packx(x, 0), xs1 = packx(x, 1);
#pragma unroll
                    for (int nv = 0; nv < 8; ++nv) { acc[nv] = MFMA32(vt[nv][0], xs0, acc[nv]); acc[nv] = MFMA32(vt[nv][1], xs1, acc[nv]); }
                }
                if (sb + 1 < nsb) {
                    LAS unsigned char* knx = Ks + ((sb + 1) & 1) * RQ_KBYTES;
#pragma unroll
                    for (int i = 0; i < 2; ++i) *(LAS bf16x8*)(knx + stlds + i * 16 * RQ_RS) = kst[i];
                }
                __syncthreads();
            }
            float ss = 0.f;
#pragma unroll
            for (int nv = 0; nv < 8; ++nv)
#pragma unroll
                for (int i = 0; i < 16; ++i) ss += acc[nv][i] * acc[nv][i];
            ss += __shfl_xor(ss, 32);
            LAS float* sx = (LAS float*)(lds + 8 * 16896);
            if (hh == 0) sx[vh * 128 + tsub * 32 + r] = ss;
            __syncthreads();
            const float rs = rsqrtf((sx[tsub * 32 + r] + sx[128 + tsub * 32 + r]) * (1.f / 512.f) + EPS);
            LAS unsigned char* ot = lds + w * 16896;
#pragma unroll
            for (int nv = 0; nv < 8; ++nv)
#pragma unroll
                for (int g = 0; g < 4; ++g) {
                    u32x2 o; o.x = pk2(acc[nv][4 * g] * rs, acc[nv][4 * g + 1] * rs); o.y = pk2(acc[nv][4 * g + 2] * rs, acc[nv][4 * g + 3] * rs);
                    *(LAS u32x2*)(ot + r * 528 + (nv * 32 + 8 * g + 4 * hh) * 2) = o;
                }
            bf16* orow = ORET + (size_t)(b * SEQ + pos0 + tsub * 32) * 2048 + h * 512 + vh * 256;
#pragma unroll 4
            for (int k = 0; k < 16; ++k) {
                const int row = 2 * k + (lane >> 5), ch = lane & 31;
                const u32x4 val = *(const LAS u32x4*)(ot + row * 528 + ch * 16);
                bf16* gp = orow + (size_t)row * 2048 + ch * 8;
                const u32x4 gt = *(const u32x4*)gp;
                u32x4 o;
                o.x = pk2(bflo(val.x) * bflo(gt.x), bfhi(val.x) * bfhi(gt.x)); o.y = pk2(bflo(val.y) * bflo(gt.y), bfhi(val.y) * bfhi(gt.y));
                o.z = pk2(bflo(val.z) * bflo(gt.z), bfhi(val.z) * bfhi(gt.z)); o.w = pk2(bflo(val.w) * bflo(gt.w), bfhi(val.w) * bfhi(gt.w));
                if (!dry) *(u32x4*)gp = o; else asm volatile("" :: "v"(o));
            }
        }
    }
    __syncthreads();
}

DI float dot2bf(unsigned a, unsigned b, float c) {
#if __has_builtin(__builtin_amdgcn_fdot2_f32_bf16)
    typedef __bf16 nb2 __attribute__((ext_vector_type(2)));
    return __builtin_amdgcn_fdot2_f32_bf16(__builtin_bit_cast(nb2, a), __builtin_bit_cast(nb2, b), c, false);
#else
    return c + bflo(a) * bflo(b) + bfhi(a) * bfhi(b);
#endif
}
DI void wave_argmax(float& v, int& idx) {
#pragma unroll
    for (int o = 1; o < 64; o <<= 1) {
        const float ov = __shfl_xor(v, o); const int oi = __shfl_xor(idx, o);
        if (ov > v || (ov == v && oi < idx)) { v = ov; idx = oi; }
    }
}

DI void peer_topk1(const bf16* Q, const bf16* SK, float* TOPS, int* TOPI, int wg, int nwg) {
    const int tid = fresh_tid(), lane = tid & 63, w = __builtin_amdgcn_readfirstlane(tid >> 6);
    for (int unit = wg; unit < 16 * 16; unit += nwg) {
        const int hp = unit & 15, tblk = unit >> 4;
        unsigned k0[64], k1[64];
        {
            const u32x4* p0 = (const u32x4*)(SK + ((size_t)(hp * 128 + lane)) * 128);
            const u32x4* p1 = (const u32x4*)(SK + ((size_t)(hp * 128 + 64 + lane)) * 128);
#pragma unroll
            for (int i = 0; i < 16; ++i) { const u32x4 a = p0[i], b = p1[i]; k0[4 * i] = a.x; k0[4 * i + 1] = a.y; k0[4 * i + 2] = a.z; k0[4 * i + 3] = a.w; k1[4 * i] = b.x; k1[4 * i + 1] = b.y; k1[4 * i + 2] = b.z; k1[4 * i + 3] = b.w; }
        }
        for (int tt = 0; tt < 128; ++tt) {
            const int t = tblk * 1024 + w * 128 + tt;
            const u32x4* qp = (const u32x4*)(Q + (size_t)t * 2048 + hp * 128);
            float s0 = 0.f, s1 = 0.f;
#pragma unroll
            for (int i = 0; i < 16; ++i) {
                const u32x4 qv = qp[i];
                s0 = dot2bf(k0[4 * i], qv.x, s0); s0 = dot2bf(k0[4 * i + 1], qv.y, s0); s0 = dot2bf(k0[4 * i + 2], qv.z, s0); s0 = dot2bf(k0[4 * i + 3], qv.w, s0);
                s1 = dot2bf(k1[4 * i], qv.x, s1); s1 = dot2bf(k1[4 * i + 1], qv.y, s1); s1 = dot2bf(k1[4 * i + 2], qv.z, s1); s1 = dot2bf(k1[4 * i + 3], qv.w, s1);
            }
            float myv = 0.f; int myi = 0;
            for (int rnd = 0; rnd < 16; ++rnd) {
                float v; int idx;
                if (s0 >= s1) { v = s0; idx = lane; } else { v = s1; idx = lane + 64; }
                wave_argmax(v, idx);
                if (idx == lane) s0 = -3.0e38f;
                if (idx == lane + 64) s1 = -3.0e38f;
                if (lane == rnd) { myv = v; myi = idx; }
            }
            if (lane < 16) { TOPS[((size_t)t * 16 + hp) * 16 + lane] = myv; TOPI[((size_t)t * 16 + hp) * 16 + lane] = myi; }
        }
    }
}

DI void peer_cand(const float* TOPS, const int* TOPI, int* EIDX, float* EGATE, int gw, int ngw) {
    const int lane = fresh_tid() & 63;
    for (int unit = gw; unit < T * PE_H; unit += ngw) {
        const int t = unit >> 3, h = unit & 7;
        const float* s1p = TOPS + ((size_t)t * 16 + h * 2) * 16;
        const int i1 = lane >> 2, j0 = (lane & 3) * 4;
        const float a = s1p[i1];
        const f32x4 bq = *(const f32x4*)(s1p + 16 + j0);
        float c0 = a + bq[0], c1 = a + bq[1], c2 = a + bq[2], c3 = a + bq[3];
        float myv = 0.f; int myc = 0;
        for (int rnd = 0; rnd < 16; ++rnd) {
            float v = c0; int idx = 4 * lane;
            if (c1 > v) { v = c1; idx = 4 * lane + 1; }
            if (c2 > v) { v = c2; idx = 4 * lane + 2; }
            if (c3 > v) { v = c3; idx = 4 * lane + 3; }
            wave_argmax(v, idx);
            if (idx == 4 * lane) c0 = -3.0e38f;
            if (idx == 4 * lane + 1) c1 = -3.0e38f;
            if (idx == 4 * lane + 2) c2 = -3.0e38f;
            if (idx == 4 * lane + 3) c3 = -3.0e38f;
            if (lane == rnd) { myv = v; myc = idx; }
        }
        const float mx = __shfl(myv, 0);
        float ex = lane < 16 ? __expf(myv - mx) : 0.f;
        float sum = ex;
#pragma unroll
        for (int o = 1; o < 16; o <<= 1) sum += __shfl_xor(sum, o);
        if (lane < 16) {
            const int ci = myc >> 4, cj = myc & 15;
            const int e = TOPI[((size_t)t * 16 + h * 2) * 16 + ci] * PE_NK + TOPI[((size_t)t * 16 + h * 2 + 1) * 16 + cj];
            EIDX[(size_t)t * 128 + h * 16 + lane] = e;
            EGATE[(size_t)t * 128 + h * 16 + lane] = ex / sum;
        }
    }
}


DI unsigned key_pack(float s, unsigned lowbits, unsigned mask) {
    unsigned u = __float_as_uint(s); u = (u & 0x80000000u) ? ~u : (u | 0x80000000u);
    return (u & ~mask) | lowbits;
}
DI float key_val(unsigned k, unsigned mask) { unsigned u = k & ~mask; u = (u & 0x80000000u) ? (u & 0x7fffffffu) : ~u; return __uint_as_float(u); }
DI unsigned umin_(unsigned a, unsigned b) { return a < b ? a : b; }
DI unsigned umax_(unsigned a, unsigned b) { return a > b ? a : b; }
DI void ins16(unsigned (&t)[16], unsigned x) {
#pragma unroll
    for (int i = 15; i >= 1; --i) t[i] = umax_(umin_(t[i - 1], t[i]), umin_(umax_(t[i - 1], t[i]), x));
    t[0] = umax_(t[0], x);
}
constexpr int PR_KOFF = 20480, PR_KRS = 272;
DI void peer_retrieve(LAS unsigned char* lds, const bf16* Q, const bf16* SK, int* EIDX, float* EGATE, int wg, int nwg) {
    const int tid = fresh_tid(), lane = tid & 63, w = __builtin_amdgcn_readfirstlane(tid >> 6), r = lane & 31, hh = lane >> 5;
    LAS unsigned char* myl = lds + w * 2304 + lane * 36;
    LAS unsigned char* ks = lds + PR_KOFF;
    int staged_h = -1;
    for (int unit = 2 * wg; unit < 512; unit += (unit & 1) ? 2 * nwg - 1 : 1) {
        const int h = unit >> 6, tb = (unit & 63) * 8 + w;
        if (h != staged_h) {
            __syncthreads();
#pragma unroll
            for (int i = 0; i < 8; ++i) { const int cidx = tid + 512 * i, row = cidx >> 4, ch = cidx & 15;
                *(LAS bf16x8*)(ks + row * PR_KRS + ch * 16) = ldg16(SK + ((size_t)(h * 256 + row)) * 128 + ch * 8); }
            __syncthreads();
            staged_h = h;
        }
        const size_t trow = (size_t)(tb * 32 + r);
        bf16x8 qf[2][8];
        {
            const bf16* qrow = Q + trow * 2048 + h * 256 + 8 * hh;
#pragma unroll
            for (int p = 0; p < 2; ++p)
#pragma unroll
                for (int kk = 0; kk < 8; ++kk) qf[p][kk] = ldg16(qrow + p * 128 + kk * 16);
        }
        unsigned L[2][16];
#pragma unroll
        for (int p = 0; p < 2; ++p) {
            f32x16 acc[4];
#pragma unroll
            for (int mt = 0; mt < 4; ++mt) acc[mt] = zero16();
            const LAS unsigned char* kfr = ks + (p * 128 + r) * PR_KRS + 16 * hh;
#pragma unroll
            for (int kk = 0; kk < 8; ++kk) {
#pragma unroll
                for (int mt = 0; mt < 4; ++mt) acc[mt] = MFMA32(*(const LAS bf16x8*)(kfr + mt * 32 * PR_KRS + kk * 32), qf[p][kk], acc[mt]);
                if (kk & 1) __builtin_amdgcn_sched_barrier(0);
            }
            unsigned t[16];
#pragma unroll
            for (int i = 0; i < 16; ++i) t[i] = 0u;
#pragma unroll
            for (int mt = 0; mt < 4; ++mt)
#pragma unroll
                for (int i = 0; i < 16; ++i) ins16(t, key_pack(acc[mt][i], (unsigned)(127 - 32 * mt - (i & 3) - 8 * (i >> 2)) - 4u * (unsigned)hh, 127u));
            unsigned o[16];
#pragma unroll
            for (int i = 0; i < 16; ++i) o[i] = (unsigned)__shfl_xor((int)t[i], 32);
#pragma unroll
            for (int i = 0; i < 16; ++i) ins16(t, o[i]);
#pragma unroll
            for (int i = 0; i < 16; ++i) L[p][i] = t[i];
        }
#pragma unroll
        for (int p = 0; p < 2; ++p)
#pragma unroll
            for (int g = 0; g < 4; ++g) {
                const unsigned v = (127u - (L[p][4 * g] & 127u)) | ((127u - (L[p][4 * g + 1] & 127u)) << 8) | ((127u - (L[p][4 * g + 2] & 127u)) << 16) | ((127u - (L[p][4 * g + 3] & 127u)) << 24);
                *(LAS unsigned*)(myl + p * 16 + g * 4) = v;
            }
        float a[16], b[16];
#pragma unroll
        for (int i = 0; i < 16; ++i) { a[i] = key_val(L[0][i], 127u); b[i] = key_val(L[1][i], 127u); }
        unsigned c[16];
#pragma unroll
        for (int i = 0; i < 16; ++i) c[i] = 0u;
#pragma unroll
        for (int i = 0; i < 16; ++i)
#pragma unroll
            for (int j = 0; j < 16; ++j)
                if ((i + 1) * (j + 1) <= 16) ins16(c, key_pack(a[i] + b[j], (unsigned)(255 - (16 * i + j)), 255u));
        float v[16];
        float sum = 0.f;
        const float mx = key_val(c[0], 255u);
#pragma unroll
        for (int k = 0; k < 16; ++k) { v[k] = __expf(key_val(c[k], 255u) - mx); sum += v[k]; }
        const float inv = 1.f / sum;
        asm volatile("s_waitcnt lgkmcnt(0)" ::: "memory");
        if (hh == 0) {
            int e[16];
#pragma unroll
            for (int k = 0; k < 16; ++k) {
                const unsigned cc = 255u - (c[k] & 255u);
                const unsigned i1 = *(LAS unsigned char*)(myl + (cc >> 4)), i2 = *(LAS unsigned char*)(myl + 16 + (cc & 15u));
                e[k] = (int)(i1 * 128u + i2);
            }
            int* ep = EIDX + trow * 128 + h * 16;
#pragma unroll
            for (int g = 0; g < 4; ++g) *(u32x4*)(ep + 4 * g) = (u32x4){(unsigned)e[4 * g], (unsigned)e[4 * g + 1], (unsigned)e[4 * g + 2], (unsigned)e[4 * g + 3]};
        } else {
            float* gp = EGATE + trow * 128 + h * 16;
#pragma unroll
            for (int g = 0; g < 4; ++g) *(f32x4*)(gp + 4 * g) = (f32x4){v[4 * g] * inv, v[4 * g + 1] * inv, v[4 * g + 2] * inv, v[4 * g + 3] * inv};
        }
        asm volatile("s_waitcnt lgkmcnt(0)" ::: "memory");
    }
}

DI float gelu_tanh(float x) {
    const float u = 0.7978845608028654f * (x + 0.044715f * x * x * x);
    const float e = __expf(2.f * u);
    const float th = 1.f - 2.f / (e + 1.f);
    return 0.5f * x * (1.f + th);
}

DI float bcast_f(float v, int j) { return __int_as_float(__builtin_amdgcn_readfirstlane(__float_as_int(__shfl(v, j)))); }
DI void quant_rows(const float* __restrict__ src, unsigned char* __restrict__ dst, float* __restrict__ scale, int nrows, int offs, int gw, int ngw, int lane) {
    for (int row0 = gw; row0 < nrows; row0 += 2 * ngw) {
        const int rowb = row0 + ngw, row1 = rowb < nrows ? rowb : row0;
        f32x4 v[2][4];
#pragma unroll
        for (int rr = 0; rr < 2; ++rr) { const f32x4* p = (const f32x4*)(src + (size_t)(rr ? row1 : row0) * 1024 + lane * 16);
#pragma unroll
            for (int i = 0; i < 4; ++i) v[rr][i] = p[i]; }
#pragma unroll
        for (int rr = 0; rr < 2; ++rr) {
            const int row = rr ? row1 : row0;
            float am = 0.f;
#pragma unroll
            for (int i = 0; i < 4; ++i)
#pragma unroll
                for (int e = 0; e < 4; ++e) am = fmaxf(am, fabsf(v[rr][i][e]));
#pragma unroll
            for (int o = 1; o < 64; o <<= 1) am = fmaxf(am, __shfl_xor(am, o));
            const float inv = am > 0.f ? 127.f / am : 0.f;
            u32x4 w;
#pragma unroll
            for (int i = 0; i < 4; ++i) {
                unsigned pk = 0u;
#pragma unroll
                for (int e = 0; e < 4; ++e) { const int q = (int)rintf(v[rr][i][e] * inv) + offs; pk |= ((unsigned)q & 0xffu) << (8 * e); }
                w[i] = pk;
            }
            if (rr == 0 || rowb < nrows) {
                *(u32x4*)(dst + ((size_t)(lane >> 3) * nrows + row) * 128 + (lane & 7) * 16) = w;
                if (lane == 0) scale[row] = am > 0.f ? am * (1.f / 127.f) : 0.f;
            }
        }
    }
}
DI void quant_xw(const bf16* XW, unsigned char* XQ8, float* XS, int gw, int ngw, int lane) {
    for (int t = gw; t < T; t += ngw) {
        const u32x4 xa = *(const u32x4*)(XW + (size_t)t * 1024 + lane * 16), xb = *(const u32x4*)(XW + (size_t)t * 1024 + lane * 16 + 8);
        float xf[16] = {bflo(xa.x), bfhi(xa.x), bflo(xa.y), bfhi(xa.y), bflo(xa.z), bfhi(xa.z), bflo(xa.w), bfhi(xa.w),
                        bflo(xb.x), bfhi(xb.x), bflo(xb.y), bfhi(xb.y), bflo(xb.z), bfhi(xb.z), bflo(xb.w), bfhi(xb.w)};
        float am = 0.f;
#pragma unroll
        for (int i = 0; i < 16; ++i) am = fmaxf(am, fabsf(xf[i]));
#pragma unroll
        for (int o = 1; o < 64; o <<= 1) am = fmaxf(am, __shfl_xor(am, o));
        const float inv = am > 0.f ? 127.f / am : 0.f;
        u32x4 w;
#pragma unroll
        for (int i = 0; i < 4; ++i) { unsigned pk = 0u;
#pragma unroll
            for (int e = 0; e < 4; ++e) pk |= ((unsigned)((int)rintf(xf[4 * i + e] * inv)) & 0xffu) << (8 * e);
            w[i] = pk; }
        *(u32x4*)(XQ8 + ((size_t)(lane >> 3) * T + t) * 128 + (lane & 7) * 16) = w;
        if (lane == 0) XS[t] = am * (1.f / 127.f);
    }
}
DI int dpp_xor1(int v) { return __builtin_amdgcn_update_dpp(0, v, 0xB1, 0xF, 0xF, false); }
DI int dpp_xor2(int v) { return __builtin_amdgcn_update_dpp(0, v, 0x4E, 0xF, 0xF, false); }
DI int dpp_hmir(int v) { return __builtin_amdgcn_update_dpp(0, v, 0x141, 0xF, 0xF, false); }
DI void peer_u(const unsigned char* EU8, const unsigned char* XQ8, const int* EIDX, int* PART, int slice, int tok0, int tokstep, int lane) {
    const int q = lane >> 3, i = lane & 7;
    const unsigned char* tab = EU8 + (size_t)slice * PE_NE * 128 + i * 16;
#define PU_LOAD(dst, t_) do { const u32x4* ep_ = (const u32x4*)(EIDX + (size_t)(t_) * 128 + 16 * q); const u32x4 e0_ = ep_[0], e1_ = ep_[1], e2_ = ep_[2], e3_ = ep_[3]; \
        const unsigned ee_[16] = {e0_.x, e0_.y, e0_.z, e0_.w, e1_.x, e1_.y, e1_.z, e1_.w, e2_.x, e2_.y, e2_.z, e2_.w, e3_.x, e3_.y, e3_.z, e3_.w}; \
        _Pragma("unroll") for (int g = 0; g < 16; ++g) dst[g] = *(const u32x4*)(tab + (size_t)ee_[g] * 128); } while (0)
    u32x4 ub[16], nb[16];
    if (tok0 < T) PU_LOAD(ub, tok0);
    for (int t = tok0; t < T; t += tokstep) {
        const u32x4 xv = *(const u32x4*)(XQ8 + ((size_t)slice * T + t) * 128 + i * 16);
        if (t + tokstep < T) PU_LOAD(nb, t + tokstep);
        int d0 = 0, d1 = 0;
#pragma unroll
        for (int g = 0; g < 16; ++g) {
            int s = __builtin_amdgcn_sdot4((int)ub[g].x, (int)xv.x, 0, false);
            s = __builtin_amdgcn_sdot4((int)ub[g].y, (int)xv.y, s, false); s = __builtin_amdgcn_sdot4((int)ub[g].z, (int)xv.z, s, false); s = __builtin_amdgcn_sdot4((int)ub[g].w, (int)xv.w, s, false);
            s += dpp_xor1(s); s += dpp_xor2(s); s += dpp_hmir(s);
            if (g < 8) { if (i == g) d0 = s; } else { if (i == g - 8) d1 = s; }
        }
        int* pp = PART + ((size_t)slice * T + t) * 128 + 16 * q + i;
        pp[0] = d0; pp[8] = d1;
#pragma unroll
        for (int g = 0; g < 16; ++g) ub[g] = nb[g];
    }
#undef PU_LOAD
}
DI void peer_w(const int* PART, const int* EIDX, const float* EGATE, const float* SU, const float* SV, const float* XS, const float* SSQX, unsigned char* WQ8, float* WSC, int gw, int ngw, int lane) {
    for (int t = gw; t < T; t += ngw) {
        const size_t base = (size_t)t * 128 + 2 * lane;
        int d0 = 0, d1 = 0;
#pragma unroll
        for (int s = 0; s < 8; ++s) { const u32x2 pv = *(const u32x2*)(PART + (size_t)s * T * 128 + base); d0 += (int)pv.x; d1 += (int)pv.y; }
        const u32x2 ev = *(const u32x2*)(EIDX + base); const f32x2 gv = *(const f32x2*)(EGATE + base);
        const float sc = XS[t] * rstd_x1(SSQX, (size_t)t);
        const float w0 = gv[0] * SV[ev.x] * gelu_tanh((float)d0 * (SU[ev.x] * sc)), w1 = gv[1] * SV[ev.y] * gelu_tanh((float)d1 * (SU[ev.y] * sc));
        float am = fmaxf(fabsf(w0), fabsf(w1));
#pragma unroll
        for (int o = 1; o < 64; o <<= 1) am = fmaxf(am, __shfl_xor(am, o));
        const float inv = am > 0.f ? 127.f / am : 0.f;
        const unsigned q0 = (unsigned)((int)rintf(w0 * inv)) & 0xffu, q1 = (unsigned)((int)rintf(w1 * inv)) & 0xffu;
        *(unsigned short*)(WQ8 + base) = (unsigned short)(q0 | (q1 << 8));
        if (lane == 0) WSC[t] = am * (1.f / 127.f);
    }
}
DI unsigned perm_(unsigned s0, unsigned s1, unsigned sel) { return __builtin_amdgcn_perm(s0, s1, sel); }
DI void peer_v(const unsigned char* EV8, const int* EIDX, const unsigned char* WQ8, const float* WSC, float* X1, int slice, int tok0, int tokstep, int lane, int dry) {
    const int q = lane >> 3, i = lane & 7;
    const unsigned char* tab = EV8 + (size_t)slice * PE_NE * 128 + i * 16;
#define PV_LOAD(dst, t_) do { const u32x4* ep_ = (const u32x4*)(EIDX + (size_t)(t_) * 128 + 16 * q); const u32x4 e0_ = ep_[0], e1_ = ep_[1], e2_ = ep_[2], e3_ = ep_[3]; \
        const unsigned ee_[16] = {e0_.x, e0_.y, e0_.z, e0_.w, e1_.x, e1_.y, e1_.z, e1_.w, e2_.x, e2_.y, e2_.z, e2_.w, e3_.x, e3_.y, e3_.z, e3_.w}; \
        _Pragma("unroll") for (int g = 0; g < 16; ++g) dst[g] = *(const u32x4*)(tab + (size_t)ee_[g] * 128); } while (0)
    u32x4 vb[16], nb[16];
    if (tok0 < T) PV_LOAD(vb, tok0);
    for (int t = tok0; t < T; t += tokstep) {
        const u32x4 wqv = *(const u32x4*)(WQ8 + (size_t)t * 128 + 16 * q);
        const float wsc = WSC[t];
        if (t + tokstep < T) PV_LOAD(nb, t + tokstep);
        const int wq[4] = {(int)wqv.x, (int)wqv.y, (int)wqv.z, (int)wqv.w};
        int o[16];
#pragma unroll
        for (int c = 0; c < 16; ++c) o[c] = 0;
#pragma unroll
        for (int m = 0; m < 4; ++m) {
#pragma unroll
            for (int k = 0; k < 4; ++k) {
                const unsigned a = vb[4 * m][k], b = vb[4 * m + 1][k], c = vb[4 * m + 2][k], dd = vb[4 * m + 3][k];
                const unsigned ablo = perm_(b, a, 0x05010400u), abhi = perm_(b, a, 0x07030602u), cdlo = perm_(dd, c, 0x05010400u), cdhi = perm_(dd, c, 0x07030602u);
                o[4 * k + 0] = __builtin_amdgcn_sdot4((int)perm_(cdlo, ablo, 0x05040100u), wq[m], o[4 * k + 0], false);
                o[4 * k + 1] = __builtin_amdgcn_sdot4((int)perm_(cdlo, ablo, 0x07060302u), wq[m], o[4 * k + 1], false);
                o[4 * k + 2] = __builtin_amdgcn_sdot4((int)perm_(cdhi, abhi, 0x05040100u), wq[m], o[4 * k + 2], false);
                o[4 * k + 3] = __builtin_amdgcn_sdot4((int)perm_(cdhi, abhi, 0x07060302u), wq[m], o[4 * k + 3], false);
            }
        }
        int r8[8], r4[4], r2[2];
#pragma unroll
        for (int c = 0; c < 8; ++c) { const int mine = (q & 4) ? o[c + 8] : o[c], theirs = (q & 4) ? o[c] : o[c + 8]; r8[c] = mine + __shfl_xor(theirs, 32); }
#pragma unroll
        for (int c = 0; c < 4; ++c) { const int mine = (q & 2) ? r8[c + 4] : r8[c], theirs = (q & 2) ? r8[c] : r8[c + 4]; r4[c] = mine + __shfl_xor(theirs, 16); }
#pragma unroll
        for (int c = 0; c < 2; ++c) { const int mine = (q & 1) ? r4[c + 2] : r4[c], theirs = (q & 1) ? r4[c] : r4[c + 2]; r2[c] = mine + __shfl_xor(theirs, 8); }
        float* xp = X1 + (size_t)t * 1024 + slice * 128 + i * 16 + 2 * q;
        f32x2 xv = *(const f32x2*)xp;
        xv[0] += (float)r2[0] * wsc; xv[1] += (float)r2[1] * wsc;
        if (!dry) *(f32x2*)xp = xv; else asm volatile("" :: "v"(xv));
#pragma unroll
        for (int g = 0; g < 16; ++g) vb[g] = nb[g];
    }
#undef PV_LOAD
}
DI void final_norm(const float* __restrict__ Y, const float* __restrict__ fw, float* __restrict__ OUT, int gw, int ngw, int lane) {
    for (int t0 = gw; t0 < T; t0 += 2 * ngw) {
        const int tb = t0 + ngw, t1 = tb < T ? tb : t0;
        f32x4 v[2][4];
#pragma unroll
        for (int rr = 0; rr < 2; ++rr) { const f32x4* yr = (const f32x4*)(Y + (size_t)(rr ? t1 : t0) * 1024) + lane;
#pragma unroll
            for (int j = 0; j < 4; ++j) v[rr][j] = yr[64 * j]; }
#pragma unroll
        for (int rr = 0; rr < 2; ++rr) {
            float s = 0.f;
#pragma unroll
            for (int j = 0; j < 4; ++j) s += (v[rr][j][0] * v[rr][j][0] + v[rr][j][1] * v[rr][j][1]) + (v[rr][j][2] * v[rr][j][2] + v[rr][j][3] * v[rr][j][3]);
            const float rs = rsqrtf(wave_sum(s) * (1.f / 1024.f) + EPS);
            if (rr == 0 || tb < T) {
                f32x4* o = (f32x4*)(OUT + (size_t)(rr ? t1 : t0) * 1024) + lane; const f32x4* wr4 = (const f32x4*)fw + lane;
#pragma unroll
                for (int j = 0; j < 4; ++j) { const f32x4 ww = wr4[64 * j]; o[64 * j] = (f32x4){v[rr][j][0] * rs * ww[0], v[rr][j][1] * rs * ww[1], v[rr][j][2] * rs * ww[2], v[rr][j][3] * rs * ww[3]}; }
            }
        }
    }
}

DI void transpose_item(const float* W, int K, int N, bf16* WT, int n_src0, int n_dst0, int k0, LAS float* scr, int lane) {
#pragma unroll 8
    for (int i = 0; i < 32; ++i) { const int kk = 2 * i + (lane >> 5); scr[kk * 33 + (lane & 31)] = W[(size_t)(k0 + kk) * N + n_src0 + (lane & 31)]; }
    asm volatile("s_waitcnt lgkmcnt(0)" ::: "memory");
    const int c = lane & 7;
#pragma unroll
    for (int j = 0; j < 4; ++j) { const int n = (lane >> 3) + 8 * j; const LAS float* s = scr + (8 * c) * 33 + n;
        u32x4 o; o.x = pk2(s[0 * 33], s[1 * 33]); o.y = pk2(s[2 * 33], s[3 * 33]); o.z = pk2(s[4 * 33], s[5 * 33]); o.w = pk2(s[6 * 33], s[7 * 33]);
        *(u32x4*)(WT + (size_t)(n_dst0 + n) * K + k0 + 8 * c) = o; }
    asm volatile("s_waitcnt lgkmcnt(0)" ::: "memory");
}
DI int win_orig_col(int np) {
    if (np < 2048) { const int h = np >> 8, sel = (np >> 7) & 1, d = np & 127; return sel * 1024 + h * 128 + d; }
    return np;
}
DI void rmsnorm_row_bf16(const float* xrow, const float* w, bf16* orow, int lane) {
    const f32x4* xr = (const f32x4*)xrow + lane; const f32x4* wr4 = (const f32x4*)w + lane;
    f32x4 v[4]; float s = 0.f;
#pragma unroll
    for (int j = 0; j < 4; ++j) { v[j] = xr[64 * j]; s += (v[j][0] * v[j][0] + v[j][1] * v[j][1]) + (v[j][2] * v[j][2] + v[j][3] * v[j][3]); }
    const float rs = rsqrtf(wave_sum(s) * (1.f / 1024.f) + EPS);
    u32x2* o8 = (u32x2*)orow + lane;
#pragma unroll
    for (int j = 0; j < 4; ++j) { const f32x4 ww = wr4[64 * j]; u32x2 o; o.x = pk2(v[j][0] * rs * ww[0], v[j][1] * rs * ww[1]); o.y = pk2(v[j][2] * rs * ww[2], v[j][3] * rs * ww[3]); o8[64 * j] = o; }
}
DI void transpose_item_q8(const float* W, int N, unsigned char* WT8, const unsigned* amaxu, float* SB, int n_src0, int n_dst0, int k0, bool first_kb, LAS float* scr, int lane) {
#pragma unroll 8
    for (int i = 0; i < 32; ++i) { const int kk = 2 * i + (lane >> 5); scr[kk * 33 + (lane & 31)] = W[(size_t)(k0 + kk) * N + n_src0 + (lane & 31)]; }
    asm volatile("s_waitcnt lgkmcnt(0)" ::: "memory");
    const int c = lane & 3;
#pragma unroll
    for (int j = 0; j < 2; ++j) {
        const int n = (lane >> 2) + 16 * j;
        const float am = __uint_as_float(amaxu[n_src0 + n]), inv = am > 0.f ? 127.f / am : 0.f;
        const LAS float* s = scr + (16 * c) * 33 + n;
        u32x4 o;
#pragma unroll
        for (int g = 0; g < 4; ++g) { unsigned pk = 0u;
#pragma unroll
            for (int e2 = 0; e2 < 4; ++e2) pk |= ((unsigned)((int)rintf(s[(4 * g + e2) * 33] * inv)) & 0xffu) << (8 * e2);
            o[g] = pk; }
        *(u32x4*)(WT8 + (size_t)(n_dst0 + n) * 1024 + k0 + 16 * c) = o;
        if (first_kb && c == 0) SB[n_dst0 + n] = am * (1.f / 127.f);
    }
    asm volatile("s_waitcnt lgkmcnt(0)" ::: "memory");
}
DI void rmsnorm_rows_q8(const float* __restrict__ x, const float* __restrict__ w, unsigned char* __restrict__ HN8, float* __restrict__ SA, int gw, int ngw, int lane) {
    for (int m0 = gw; m0 < T; m0 += 2 * ngw) {
        const int mb = m0 + ngw, m1 = mb < T ? mb : m0;
        f32x4 v[2][4];
#pragma unroll
        for (int rr = 0; rr < 2; ++rr) { const f32x4* xr = (const f32x4*)(x + (size_t)(rr ? m1 : m0) * 1024) + lane;
#pragma unroll
            for (int j = 0; j < 4; ++j) v[rr][j] = xr[64 * j]; }
        const f32x4* wr4 = (const f32x4*)w + lane;
#pragma unroll
        for (int rr = 0; rr < 2; ++rr) {
            float s = 0.f;
#pragma unroll
            for (int j = 0; j < 4; ++j) s += (v[rr][j][0] * v[rr][j][0] + v[rr][j][1] * v[rr][j][1]) + (v[rr][j][2] * v[rr][j][2] + v[rr][j][3] * v[rr][j][3]);
            const float rs = rsqrtf(wave_sum(s) * (1.f / 1024.f) + EPS);
            float am = 0.f;
#pragma unroll
            for (int j = 0; j < 4; ++j) { const f32x4 ww = wr4[64 * j];
#pragma unroll
                for (int e2 = 0; e2 < 4; ++e2) { v[rr][j][e2] = v[rr][j][e2] * rs * ww[e2]; am = fmaxf(am, fabsf(v[rr][j][e2])); } }
#pragma unroll
            for (int o = 1; o < 64; o <<= 1) am = fmaxf(am, __shfl_xor(am, o));
            const float inv = am > 0.f ? 127.f / am : 0.f;
            if (rr == 0 || mb < T) {
                const int m = rr ? m1 : m0;
                unsigned* o4 = (unsigned*)(HN8 + (size_t)m * 1024) + lane;
#pragma unroll
                for (int j = 0; j < 4; ++j) { unsigned pk = 0u;
#pragma unroll
                    for (int e2 = 0; e2 < 4; ++e2) pk |= ((unsigned)((int)rintf(v[rr][j][e2] * inv)) & 0xffu) << (8 * e2);
                    o4[64 * j] = pk; }
                if (lane == 0) SA[m] = am * (1.f / 127.f);
            }
        }
    }
}
DI void convert_bf16(const float* src, bf16* dst, size_t n, size_t gtid, size_t gsz) {
    for (size_t i = gtid * 8; i < n; i += gsz * 8) {
        const f32x4 a = *(const f32x4*)(src + i), b = *(const f32x4*)(src + i + 4);
        *(u32x4*)(dst + i) = pack8(a, b);
    }
}

#define XB_TMO      128
#define XB_XCNT(j)  (256  + 64 * (j))
#define XB_XSUB(j)  (1280 + 64 * (j))
#define XB_XGEN(j)  (2304 + 64 * (j))
#define XB_TOP      3328
#define XB_TOPGEN   3392
#define XCD_BAR_WORDS 3456
#define XB_SPIN_CAP (1u << 18)

__device__ __forceinline__ unsigned xb_ld(unsigned* p)              { return __hip_atomic_load(p, __ATOMIC_RELAXED, __HIP_MEMORY_SCOPE_AGENT); }
__device__ __forceinline__ unsigned xb_add(unsigned* p, unsigned v) { return __hip_atomic_fetch_add(p, v, __ATOMIC_RELAXED, __HIP_MEMORY_SCOPE_AGENT); }
__device__ __forceinline__ unsigned xb_xcc_id() { return (unsigned)__builtin_amdgcn_s_getreg((3 << 11) | 20) & 0xFu; }
#define XB_SPIN(cond, bar) do { unsigned _sp = 0; while (cond) { __builtin_amdgcn_s_sleep(1); \
    if ((++_sp & 255u) == 0u) { if (xb_ld(&(bar)[XB_TMO])) break; if (_sp > XB_SPIN_CAP) { atomicAdd(&(bar)[XB_TMO], 1u); break; } } } } while (0)

struct XcdBarrier {
    unsigned* bar; unsigned x;
    volatile LAS unsigned* st;
};

__device__ __forceinline__ XcdBarrier xcd_barrier_post(unsigned* bar, volatile LAS unsigned* st) {
    XcdBarrier b; b.bar = bar; b.x = xb_xcc_id(); b.st = st;
    if (threadIdx.x == 0) (void)xb_add(&bar[XB_XCNT(b.x)], 1u);
    return b;
}
__device__ __forceinline__ void xcd_barrier_complete(unsigned* bar, unsigned x, unsigned& nloc, unsigned& nx) {
    const unsigned G = gridDim.x * gridDim.y * gridDim.z;
    unsigned sum, cnt, mine, sp = 0u;
    for (;;) {
        sum = 0u; cnt = 0u; mine = 0u;
#pragma unroll
        for (unsigned j = 0; j < 16; ++j) { const unsigned c = xb_ld(&bar[XB_XCNT(j)]); sum += c; cnt += (c > 0u) ? 1u : 0u; mine = (j == x) ? c : mine; }
        if (sum == G) break;
        __builtin_amdgcn_s_sleep(1);
        if ((++sp & 255u) == 0u) { if (xb_ld(&bar[XB_TMO])) break; if (sp > XB_SPIN_CAP) { atomicAdd(&bar[XB_TMO], 1u); break; } }
    }
    nloc = mine > 0u ? mine : 1u; nx = cnt > 0u ? cnt : 1u;
}

__device__ __forceinline__ void xcd_barrier(const XcdBarrier& b) {
    asm volatile("s_waitcnt vmcnt(0)" ::: "memory");
    __syncthreads();
    if (threadIdx.x == 0) {
        unsigned* bar = b.bar;
        __builtin_amdgcn_s_waitcnt(0);
        unsigned nloc = b.st[0], nx = b.st[1];
        if (nloc == 0u) { xcd_barrier_complete(bar, b.x, nloc, nx); b.st[0] = nloc; b.st[1] = nx; }
        const unsigned old = xb_add(&bar[XB_XSUB(b.x)], 1u);
        const unsigned gen = old / nloc;
        if (old + 1u == (gen + 1u) * nloc) {
            __builtin_amdgcn_fence(__ATOMIC_RELEASE, "agent");
            asm volatile("s_waitcnt vmcnt(0)" ::: "memory");
            const unsigned og = xb_add(&bar[XB_TOP], 1u);
            const unsigned tg = og / nx;
            if (og + 1u == (tg + 1u) * nx) xb_add(&bar[XB_TOPGEN], 1u);
            else XB_SPIN(xb_ld(&bar[XB_TOPGEN]) == tg, bar);
            __builtin_amdgcn_fence(__ATOMIC_ACQUIRE, "agent");
            xb_add(&bar[XB_XGEN(b.x)], 1u);
            asm volatile("s_waitcnt vmcnt(0)" ::: "memory");
        } else {
            XB_SPIN(xb_ld(&bar[XB_XGEN(b.x)]) == gen, bar);
            __builtin_amdgcn_fence(__ATOMIC_ACQUIRE, "agent");
            asm volatile("s_waitcnt vmcnt(0)" ::: "memory");
        }
    }
    __syncthreads();
}

struct Params { const float* in[14]; float* out; unsigned char* ws; };

__global__ void __launch_bounds__(NTHREADS, 2) fwd_megakernel(Params p) {
    extern __shared__ __attribute__((aligned(16))) unsigned char lds_raw[];
    LAS unsigned char* lds = (LAS unsigned char*)lds_raw;
    cg::grid_group grid = cg::this_grid();
    volatile LAS unsigned* bst = (volatile LAS unsigned*)(lds + LDS_BYTES - 64);
    if (threadIdx.x < 4) bst[threadIdx.x] = 0u;
    __syncthreads();
    XcdBarrier xbar = xcd_barrier_post((unsigned*)(p.ws + WS_CTL), bst);
    if (threadIdx.x == 0) bst[4] = xb_add((unsigned*)(p.ws + WS_CTL) + 3600 + xbar.x, 1u);
#if USE_CG_SYNC
#define GRID_SYNC() grid.sync()
#else
#define GRID_SYNC() xcd_barrier(xbar)
#endif
    const int G = gridDim.x, wg = blockIdx.x;
#define PHASE_IDS const int tid = fresh_tid(), lane = tid & 63, wave = __builtin_amdgcn_readfirstlane(tid >> 6); \
    const int gw = wg * NWAVES + wave, ngw = G * NWAVES; const size_t gtid = (size_t)wg * NTHREADS + tid, gsz = (size_t)G * NTHREADS; \
    (void)lane; (void)gw; (void)ngw; (void)gtid; (void)gsz;
    unsigned char* ws = p.ws;
    const float* x = p.in[0];
    unsigned char* HN8 = ws + WS_HN; unsigned char* WinT8 = ws + WS_WINT; float* SA = (float*)(ws + WS_SA); float* SB = (float*)(ws + WS_SB);
    unsigned* AMAXU = (unsigned*)(ws + WS_CTL + CTL_AMAX);
    float* COS = (float*)(ws + WS_ROPE); float* SIN = COS + 8192 * 128;
    float* DEC = (float*)(ws + WS_DEC); float* SSQP = (float*)(ws + WS_SSQP); float* SSQX = (float*)(ws + WS_SSQX);
    bf16* BA = (bf16*)(ws + WS_A); bf16* BB = (bf16*)(ws + WS_B); bf16* BC = (bf16*)(ws + WS_C);
    bf16* STh = (bf16*)(ws + WS_STH); bf16* STr = (bf16*)(ws + WS_STR);
    bf16* OHG = (bf16*)(ws + WS_OHG); bf16* ORET = (bf16*)p.out;
    bf16* GA = (bf16*)(ws + WS_GA); bf16* GB = (bf16*)(ws + WS_GB);
    bf16* WhgT = (bf16*)(ws + WS_WHG); bf16* WretT = (bf16*)(ws + WS_WRET); bf16* WoutT = (bf16*)(ws + WS_WOUT); bf16* WqT = (bf16*)(ws + WS_WQ); bf16* SK = (bf16*)(ws + WS_SK);
    unsigned char* EV8 = ws + WS_EV; unsigned char* EU8 = ws + WS_EU; float* SU = (float*)(ws + WS_SCL); float* SV = SU + PE_NE;
    float* M1 = (float*)(ws + WS_M1); bf16* MERGED = (bf16*)(ws + WS_MERGED);
    float* X1 = (float*)(ws + WS_X1); bf16* XW = (bf16*)(ws + WS_XW); bf16* Qp = (bf16*)p.out;
    unsigned char* XQ8 = ws + WS_XQ8; float* XS = (float*)(ws + WS_XS); int* PART = (int*)(ws + WS_PART); unsigned char* WQ8 = ws + WS_WT; float* WSC = (float*)(ws + WS_WT + 4 * MiB);
    float* TOPS = (float*)(ws + WS_TOPS); int* TOPI = (int*)(ws + WS_TOPI); int* EIDX = (int*)(ws + WS_EIDX); float* EGATE = (float*)(ws + WS_EGATE);

    for (int rep_ = 0; rep_ < ((PROBE_MASK & 32) ? 2 : 1); ++rep_) {
    { PHASE_IDS
    for (size_t it = gtid; it < (size_t)16 * 12288; it += gsz) {
        const int kb = (int)(it / 12288), col = (int)(it % 12288);
        const float* wp = p.in[2] + (size_t)(kb * 64) * 12288 + col;
        float am = 0.f;
#pragma unroll 16
        for (int k = 0; k < 64; ++k) am = fmaxf(am, fabsf(wp[(size_t)k * 12288]));
        atomicMax(AMAXU + col, __float_as_uint(am));
    }
    rmsnorm_rows_q8(x, p.in[1], HN8, SA, gw, ngw, lane);
#ifdef DBG_ZERO_VT
    for (size_t i = gtid; i < (size_t)32 * 1024 * 1024 / 16; i += gsz) ((u32x4*)BC)[i] = (u32x4){0u, 0u, 0u, 0u};
#endif
}
    __syncthreads(); }
    grid.sync();
    { PHASE_IDS LAS float* scr = (LAS float*)(lds + wave * 16384);
    for (int it = gw; it < 16 * 384; it += ngw) {
        const int kb = it / 384, nb = it % 384;
        transpose_item_q8(p.in[2], 12288, WinT8, AMAXU, SB, win_orig_col(nb * 32), nb * 32, kb * 64, kb == 0, scr, lane);
    } }
    GRID_SYNC();

    for (int rep_ = 0; rep_ < ((PROBE_MASK & 128) ? 2 : 1); ++rep_) {
    {
        pg8::Gemm g{(const bf16*)HN8, (const bf16*)WinT8, T, 4096, 512}; pg8::StaticOrder S; S.init(T, 4096, G, wg);
        EpiH E{BA, BB, BC, DEC, p.in[3], OHG, SA, SB};
        pg8::gemm_phase<EpiH, pg8::StaticOrder, true, true, true>(lds, g, S, E);
    }
    __syncthreads(); }
    GRID_SYNC();
    hg_pass1(lds, BB, BC, STh, wg, G);
#if PROBE_MASK & 4
    hg_pass1(lds, BB, BC, STh, wg, G);
#endif
    GRID_SYNC();
    { PHASE_IDS hg_scan(STh, DEC, (int)gtid, (int)gsz); }
    GRID_SYNC();
#if PROBE_MASK & 16384
    hg_pass1(lds, BB, BC, STh, wg, G);
    GRID_SYNC();
    { PHASE_IDS hg_scan(STh, DEC, (int)gtid, (int)gsz); }
    GRID_SYNC();
#endif
#if PROBE_MASK & 4
    { PHASE_IDS hg_pass3(lds, BA, BB, BC, STh, p.in[4], OHG, gw, ngw, 1); }
#endif
    { PHASE_IDS hg_pass3(lds, BA, BB, BC, STh, p.in[4], OHG, gw, ngw, 0); }
    GRID_SYNC();

    for (int rep_ = 0; rep_ < ((PROBE_MASK & 2048) ? 2 : 1); ++rep_) {
    {
        pg8::Gemm g{(const bf16*)HN8, (const bf16*)(WinT8 + (size_t)4096 * 1024), T, 6144, 512}; pg8::StaticOrder S; S.init(T, 6144, G, wg);
        EpiR E{BA, BB, BC, COS, SIN, ORET, SA, SB + 4096};
        pg8::gemm_phase<EpiR, pg8::StaticOrder, true, true, true>(lds, g, S, E);
    }
    __syncthreads(); }
    GRID_SYNC();
    rt_pass1(lds, BB, BC, STr, wg, G);
#if PROBE_MASK & 8
    rt_pass1(lds, BB, BC, STr, wg, G);
#endif
    GRID_SYNC();
    { PHASE_IDS rt_scan(STr, (int)gtid, (int)gsz); }
    GRID_SYNC();
#if PROBE_MASK & 32768
    rt_pass1(lds, BB, BC, STr, wg, G);
    GRID_SYNC();
    { PHASE_IDS rt_scan(STr, (int)gtid, (int)gsz); }
    GRID_SYNC();
#endif
#if PROBE_MASK & 1024
    rt_pass3_wg(lds, BA, BB, BC, STr, ORET, SSQP, wg, G, 1);
#endif
    rt_pass3_wg(lds, BA, BB, BC, STr, ORET, SSQP, wg, G, 0);
    GRID_SYNC();

    for (int rep_ = 0; rep_ < ((PROBE_MASK & 64) ? 2 : 1); ++rep_) {
    { PHASE_IDS LAS float* scr = (LAS float*)(lds + wave * 16384);
    for (int it = gw; it < 3072; it += ngw) {
        int r = it;
        if (r < 512) { transpose_item(p.in[5], 1024, 1024, WhgT, (r % 32) * 32, (r % 32) * 32, (r / 32) * 64, scr, lane); continue; } r -= 512;
        if (r < 1024) { transpose_item(p.in[6], 2048, 1024, WretT, (r % 32) * 32, (r % 32) * 32, (r / 32) * 64, scr, lane); continue; } r -= 1024;
        if (r < 512) { transpose_item(p.in[7], 1024, 1024, WoutT, (r % 32) * 32, (r % 32) * 32, (r / 32) * 64, scr, lane); continue; } r -= 512;
        transpose_item(p.in[9], 1024, 2048, WqT, (r % 64) * 32, (r % 64) * 32, (r / 64) * 64, scr, lane);
    }
    convert_bf16(p.in[10], SK, (size_t)16 * 128 * 128, gtid, gsz);
    quant_rows(p.in[12], EV8, SV, PE_NE, 0, gw, ngw, lane); }
    __syncthreads(); }
    __syncthreads();
    for (int rep_ = 0; rep_ < ((PROBE_MASK & 65536) ? 2 : 1); ++rep_) {
    {
        pg8::Gemm g{(const bf16*)HN8, (const bf16*)(WinT8 + (size_t)10240 * 1024), T, 2048, 512}; pg8::StaticOrder S; S.init(T, 2048, G, wg);
        EpiG E{GA, GB, SA, SB + 10240};
        pg8::gemm_phase<EpiG, pg8::StaticOrder, true, true, true>(lds, g, S, E);
    }
    __syncthreads(); }
    GRID_SYNC();

    for (int rep_ = 0; rep_ < ((PROBE_MASK & 256) ? 2 : 1); ++rep_) {
    {
        pg8::Gemm g{OHG, WhgT, T, 1024, 1024}; pg8::StaticOrder S; S.init(T, 1024, G, wg);
        EpiM1 E{MERGED, GA};
        pg8::gemm_phase<EpiM1, pg8::StaticOrder, false, true>(lds, g, S, E);
    }
    __syncthreads();
    {
        pg8::Gemm g{ORET, WretT, T, 1024, 2048}; pg8::StaticOrder S; S.init(T, 1024, G, wg);
        EpiMerge E{GB, MERGED};
        pg8::gemm_phase<EpiMerge, pg8::StaticOrder, false, true>(lds, g, S, E);
    }
    __syncthreads(); }
    GRID_SYNC();
    for (int rep_ = 0; rep_ < ((PROBE_MASK & 4096) ? 2 : 1); ++rep_) {
    {
        pg8::Gemm g{MERGED, WoutT, T, 1024, 1024}; pg8::StaticOrder S; S.init(T, 1024, G, wg);
        EpiOut E{x, X1, XW, p.in[8], SSQX};
        pg8::gemm_phase<EpiOut, pg8::StaticOrder, false, true>(lds, g, S, E);
    }
    __syncthreads(); }
    GRID_SYNC();
    for (int rep_ = 0; rep_ < ((PROBE_MASK & 64) ? 2 : 1); ++rep_) {
    { PHASE_IDS quant_rows(p.in[11], EU8, SU, PE_NE, 0, gw, ngw, lane); }
    __syncthreads(); }
    __syncthreads();
    for (int rep_ = 0; rep_ < ((PROBE_MASK & 8192) ? 2 : 1); ++rep_) {
    {
        pg8::Gemm g{XW, WqT, T, 2048, 1024}; pg8::StaticOrder S; S.init(T, 2048, G, wg);
        EpiQ E{Qp, SSQX};
        pg8::gemm_phase<EpiQ, pg8::StaticOrder, true, true>(lds, g, S, E);
    }
    __syncthreads(); }
    GRID_SYNC();
    { PHASE_IDS peer_retrieve(lds, Qp, SK, EIDX, EGATE, wg, G); quant_xw(XW, XQ8, XS, gw, ngw, lane); }
#if PROBE_MASK & 2
    { PHASE_IDS peer_retrieve(lds, Qp, SK, EIDX, EGATE, wg, G); quant_xw(XW, XQ8, XS, gw, ngw, lane); }
#endif
    GRID_SYNC();
    if (threadIdx.x == 0) {
        unsigned k = 0, n = 0, mine = 1;
        for (unsigned j = 0; j < 16; ++j) { const unsigned c = xb_ld((unsigned*)(p.ws + WS_CTL) + XB_XCNT(j)); if (c) { if (j < xbar.x) ++k; ++n; } if (j == xbar.x) mine = c ? c : 1; }
        bst[5] = k; bst[6] = n ? n : 1; bst[7] = mine;
    }
    __syncthreads();
    const int xrank = (int)bst[4], xk = (int)bst[5], xn = (int)bst[6], xloc = (int)bst[7];
    for (int rep_ = 0; rep_ < ((PROBE_MASK & 1) ? 2 : 1); ++rep_) {
    { PHASE_IDS for (int s = xk; s < 8; s += xn) peer_u(EU8, XQ8, EIDX, PART, s, xrank * NWAVES + wave, xloc * NWAVES, lane); }
    GRID_SYNC(); }
    { PHASE_IDS peer_w(PART, EIDX, EGATE, SU, SV, XS, SSQX, WQ8, WSC, gw, ngw, lane); }
    GRID_SYNC();
#if PROBE_MASK & 131072
    { PHASE_IDS for (int s = xk; s < 8; s += xn) peer_v(EV8, EIDX, WQ8, WSC, X1, s, xrank * NWAVES + wave, xloc * NWAVES, lane, 1); }
    GRID_SYNC();
#endif
    { PHASE_IDS for (int s = xk; s < 8; s += xn) peer_v(EV8, EIDX, WQ8, WSC, X1, s, xrank * NWAVES + wave, xloc * NWAVES, lane, 0); }
    GRID_SYNC();
    { PHASE_IDS final_norm(X1, p.in[13], p.out, gw, ngw, lane); }
#if PROBE_MASK & 16
    for (int i = 0; i < 15; ++i) GRID_SYNC();
#endif
}

extern "C" void kernel_launch(void* const* d_in, const int* in_sizes, int n_in, void* d_out, int out_size, void* d_ws, size_t ws_size, hipStream_t stream) {
    static int grid_blocks = 0;
    if (!grid_blocks) {
        int dev = 0, cus = 0, per_cu = 0;
        (void)hipGetDevice(&dev);
        (void)hipDeviceGetAttribute(&cus, hipDeviceAttributeMultiprocessorCount, dev);
        (void)hipFuncSetAttribute((const void*)fwd_megakernel, hipFuncAttributeMaxDynamicSharedMemorySize, LDS_BYTES);
        (void)hipOccupancyMaxActiveBlocksPerMultiprocessor(&per_cu, (const void*)fwd_megakernel, NTHREADS, LDS_BYTES);
        if (per_cu < 1) per_cu = 1;
        grid_blocks = cus * 1;
        if (ws_size < WS_END || n_in != 14) { fprintf(stderr, "kernel_launch: unexpected ws_size %zu (need %zu) or n_in %d\n", ws_size, (size_t)WS_END, n_in); }
    }
    (void)hipMemsetAsync((char*)d_ws + WS_CTL, 0, CTL_BYTES, stream);
    Params p{};
    for (int i = 0; i < 14; ++i) p.in[i] = (const float*)d_in[i];
    p.out = (float*)d_out; p.ws = (unsigned char*)d_ws;
    void* args[] = {&p};
    hipError_t e = hipLaunchCooperativeKernel((const void*)fwd_megakernel, dim3(grid_blocks), dim3(NTHREADS), args, LDS_BYTES, stream);
    if (e != hipSuccess) fprintf(stderr, "cooperative launch failed: %s (grid %d)\n", hipGetErrorString(e), grid_blocks);
}
```

```cpp
#include <hip/hip_runtime.h>
#include <hip/hip_cooperative_groups.h>
#include <cstdio>
#include <cstdint>
namespace cg = cooperative_groups;
#ifndef USE_CG_SYNC
#define USE_CG_SYNC 0
#endif
#ifndef USE_WT_STORES
#define USE_WT_STORES 0
#endif
#ifndef PROBE_MASK
#define PROBE_MASK 0
#endif

#define DI __device__ __forceinline__
#define LAS __attribute__((address_space(3)))
typedef unsigned short bf16;
typedef float f32x4 __attribute__((ext_vector_type(4)));
typedef float f32x2 __attribute__((ext_vector_type(2)));
typedef float f32x16 __attribute__((ext_vector_type(16)));
typedef short bf16x8 __attribute__((ext_vector_type(8)));
typedef short s16x4 __attribute__((ext_vector_type(4)));
typedef unsigned u32x4 __attribute__((ext_vector_type(4)));
typedef unsigned u32x2 __attribute__((ext_vector_type(2)));
typedef __bf16 nbf16x2 __attribute__((ext_vector_type(2)));

constexpr int D = 1024, NB = 2, SEQ = 8192, T = NB * SEQ;
constexpr int HG_H = 8, HG_DK = 128, HG_DV = 128, HG_C = 64, HG_NC = SEQ / HG_C;
constexpr int RT_H = 4, RT_DK = 256, RT_DV = 512, RT_L = 512, RT_NS = SEQ / RT_L;
constexpr int PE_H = 8, PE_NK = 128, PE_K = 16, PE_Q = 256, PE_HALF = 128, PE_NE = PE_NK * PE_NK;
constexpr float EPS = 1e-6f;
constexpr int NTHREADS = 512, NWAVES = 8;
constexpr int LDS_BYTES = 147456;

constexpr size_t MiB = 1u << 20;
constexpr size_t WS_CTL = 0;
constexpr size_t WS_DEC = 1 * MiB;
constexpr size_t WS_SSQP = 2 * MiB;
constexpr size_t WS_SCL = 2 * MiB + 512 * 1024;
constexpr size_t WS_SSQX = 3 * MiB;
constexpr size_t WS_HN = 4 * MiB;
constexpr size_t WS_WINT = 36 * MiB;
constexpr size_t WS_ROPE = 60 * MiB;
constexpr size_t WS_A = 68 * MiB, WS_B = 100 * MiB, WS_C = 132 * MiB;
constexpr size_t WS_STH = 164 * MiB;
constexpr size_t WS_STR = 196 * MiB;
constexpr size_t WS_OHG = 228 * MiB;
constexpr size_t WS_GA = 68 * MiB, WS_GB = 100 * MiB;
constexpr size_t WS_W2 = 132 * MiB;
constexpr size_t WS_WHG = WS_W2, WS_WRET = WS_W2 + 2 * MiB, WS_WOUT = WS_W2 + 6 * MiB, WS_WQ = WS_W2 + 8 * MiB, WS_SK = WS_W2 + 12 * MiB;
constexpr size_t WS_EV = 145 * MiB;
constexpr size_t WS_MERGED = 177 * MiB;
constexpr size_t WS_EU = 209 * MiB;
constexpr size_t WS_M1 = 4 * MiB;
constexpr size_t WS_X1 = 4 * MiB;
constexpr size_t WS_XW = 68 * MiB;
constexpr size_t WS_TOPS = 100 * MiB, WS_TOPI = 116 * MiB;
constexpr size_t WS_EIDX = 177 * MiB, WS_EGATE = 185 * MiB;
constexpr size_t WS_SA = WS_SCL + 192 * 1024;
constexpr size_t WS_SB = WS_SCL + 256 * 1024;
constexpr size_t CTL_AMAX = 65536;
constexpr size_t CTL_BYTES = 131072;
constexpr size_t WS_XQ8 = 161 * MiB;
constexpr size_t WS_XS = WS_SCL + 128 * 1024;
constexpr size_t WS_PART = 68 * MiB;
constexpr size_t WS_WT = 193 * MiB;
constexpr size_t WS_END = 260 * MiB;

DI int fresh_tid() { int t = threadIdx.x; asm volatile("" : "+v"(t)); return t; }
DI float sigmoidf_(float x) { return 1.f / (1.f + __expf(-x)); }
DI float siluf_(float x) { return x / (1.f + __expf(-x)); }
DI unsigned pk2(float lo, float hi) { f32x2 v = {lo, hi}; nbf16x2 b = __builtin_convertvector(v, nbf16x2); return __builtin_bit_cast(unsigned, b); }
DI bf16 f2bf(float f) { return (bf16)(pk2(f, 0.f) & 0xffffu); }
DI float bf2f(bf16 b) { return __uint_as_float(((unsigned)b) << 16); }
DI float bflo(unsigned u) { return __uint_as_float(u << 16); }
DI float bfhi(unsigned u) { return __uint_as_float(u & 0xffff0000u); }
DI float wave_sum(float v) {
#pragma unroll
    for (int o = 1; o < 64; o <<= 1) v += __shfl_xor(v, o);
    return v;
}
DI int crow(int reg, int h) { return (reg & 3) + 8 * (reg >> 2) + 4 * h; }

namespace pg8 {
#define PG8_LAS __attribute__((address_space(3)))
typedef unsigned short bf16_t;
typedef short bf16x8 __attribute__((ext_vector_type(8)));
typedef float f32x4 __attribute__((ext_vector_type(4)));
typedef unsigned u32x4 __attribute__((ext_vector_type(4)));
constexpr int BM = 256, BK = 64, HALF = 128, HTB = HALF * BK * 2  , STAGE_BYTES = 8 * HTB, NXCD = 8, WGM = 8;

__host__ __device__ __forceinline__ int lds_byte(int r, int c) { const int st = (r >> 4) * 2 + (c >> 5), rr = r & 15, cc = c & 31, ob = rr * 64 + cc * 2; return st * 1024 + (ob ^ (((ob >> 9) & 1) << 5)); }
__host__ __device__ __forceinline__ void stage_rc(int b, int& R, int& C) { const int st = b / 1024, sb = b % 1024, swz = sb ^ (((sb >> 9) & 1) << 5); R = (st >> 1) * 16 + swz / 64; C = (st & 1) * 32 + (swz % 64) / 2; }
__host__ __device__ __forceinline__ int perm32(int rho) { const int n = rho >> 4, i = rho & 15; return 8 * (i >> 2) + 4 * n + (i & 3); }

struct Unit { int pm, pn; };
struct Gemm { const bf16_t* A; const bf16_t* Bt; int M, N, K; };

struct StaticOrder {
    int nM, nN, nwg, G, c;
    __host__ __device__ void init(int M, int N, int G_, int c_) { nM = M / BM; nN = N / BM; nwg = nM * nN; G = G_; c = c_; }
    __host__ __device__ bool next(int i, Unit& u) const {
        const long L = (long)i * G + c; if (L >= nwg) return false;
        int wgid = (int)L; { const int q = nwg / NXCD, r = nwg % NXCD, xcd = wgid % NXCD, off = wgid / NXCD; wgid = (xcd < r ? xcd * (q + 1) : r * (q + 1) + (xcd - r) * q) + off; }
        const int nig = WGM * nN, gid = wgid / nig, fm = gid * WGM, gsz = (nM - fm) < WGM ? (nM - fm) : WGM;
        u.pm = fm + ((wgid % nig) % gsz); u.pn = (wgid % nig) / gsz; return true;
    }
    __device__ __forceinline__ void a_ready(const Unit&) const {}
    __device__ __forceinline__ void done(const Unit&) const {}
};

__device__ __forceinline__ unsigned cvt_pk_bf16(float lo, float hi) { unsigned r; asm volatile("v_cvt_pk_bf16_f32 %0, %1, %2" : "=v"(r) : "v"(lo), "v"(hi)); return r; }
typedef float f32x2 __attribute__((ext_vector_type(2)));
typedef int i32x4 __attribute__((ext_vector_type(4)));
template <bool I8> __device__ __forceinline__ f32x4 mma16(const bf16x8& b, const bf16x8& a, const f32x4& c) {
    if constexpr (I8) return __builtin_bit_cast(f32x4, __builtin_amdgcn_mfma_i32_16x16x64_i8(__builtin_bit_cast(i32x4, b), __builtin_bit_cast(i32x4, a), __builtin_bit_cast(i32x4, c), 0, 0, 0));
    else return __builtin_amdgcn_mfma_f32_16x16x32_bf16(b, a, c, 0, 0, 0);
}
template <class Epi, class Sched, bool ALIGN_EPI = false, bool SP2 = false, bool I8 = false>
__device__ __forceinline__ void gemm_phase(PG8_LAS unsigned char* lds, const Gemm g, const Sched& S, const Epi& E) {
    const int tid = fresh_tid(), wid = __builtin_amdgcn_readfirstlane(tid >> 6), lane = tid & 63, wr = wid >> 2, wc = wid & 3, fr = lane & 15, fq = lane >> 4;
    const int K = g.K, nt = K / BK;
    unsigned voffA[2], voffB[2];
#pragma unroll
    for (int i = 0; i < 2; ++i) { int R, C; stage_rc(tid * 16 + i * 8192, R, C); const int Rb = Epi::PERM ? ((R & ~31) + perm32(R & 31)) : R;
        voffA[i] = (unsigned)(R * K + C) * 2u; voffB[i] = (unsigned)(Rb * K + C) * 2u; }
    const size_t kstep = (size_t)(BK * 2);
    const size_t hstep = (size_t)HALF * K * 2;
    const size_t tstep = 2 * hstep;
    const unsigned ldsw = (unsigned)wid * 1024u;
    const int aoff = lds_byte(wr * 64 + fr, fq * 8), boff = lds_byte(wc * 32 + fr, fq * 8);
#define PG8_SA(b, h) (((b) * 2 + (h)) * HTB)
#define PG8_SB(b, h) ((4 + (b) * 2 + (h)) * HTB)
#define PG8_STAGE(bufoff, gbase, voff) do { _Pragma("unroll") for (int _i = 0; _i < 2; ++_i) \
        __builtin_amdgcn_global_load_lds((const unsigned*)((const char*)(gbase) + (voff)[_i]), (PG8_LAS unsigned*)(lds + (bufoff) + ldsw + _i * 8192), 16, 0, 0); } while (0)
#define PG8_LDA(dst, b, h) do { _Pragma("unroll") for (int m = 0; m < 4; ++m) _Pragma("unroll") for (int k = 0; k < 2; ++k) dst[m][k] = *(const PG8_LAS bf16x8*)(lds + PG8_SA(b, h) + aoff + m * 2048 + k * 1024); } while (0)
#define PG8_LDB(dst, b, h) do { _Pragma("unroll") for (int n = 0; n < 2; ++n) _Pragma("unroll") for (int k = 0; k < 2; ++k) dst[n][k] = *(const PG8_LAS bf16x8*)(lds + PG8_SB(b, h) + boff + n * 2048 + k * 1024); } while (0)
#define PG8_MMA(ai, bj, At, Bt) do { __builtin_amdgcn_s_setprio(1); _Pragma("unroll") for (int m = 0; m < 4; ++m) _Pragma("unroll") for (int n = 0; n < 2; ++n) _Pragma("unroll") for (int k = 0; k < 2; ++k) \
        acc[ai][bj][m][n] = mma16<I8>(Bt[n][k], At[m][k], acc[ai][bj][m][n]); __builtin_amdgcn_s_setprio(0); } while (0)
#define PG8_WAIT_V(n) asm volatile("s_waitcnt vmcnt(" #n ")" ::: "memory")
#define PG8_WAIT_L(n) asm volatile("s_waitcnt lgkmcnt(" #n ")" ::: "memory")
#define PG8_BAR __builtin_amdgcn_s_barrier()
#define PG8_SCHED __builtin_amdgcn_sched_barrier(0)
    Unit cur, nxt; int ui = 0;
    if (!S.next(0, cur)) return;
    f32x4 acc[2][2][4][2];
#pragma unroll
    for (int a = 0; a < 2; ++a)
#pragma unroll
        for (int b = 0; b < 2; ++b)
#pragma unroll
            for (int m = 0; m < 4; ++m)
#pragma unroll
                for (int n = 0; n < 2; ++n) acc[a][b][m][n] = (f32x4){0.f, 0.f, 0.f, 0.f};
    bf16x8 At[4][2], B0[2][2], B1[2][2];
    const char* cA = (const char*)g.A + (size_t)cur.pm * tstep; const char* cB = (const char*)g.Bt + (size_t)cur.pn * tstep;
    S.a_ready(cur);
    if constexpr (SP2) {
        PG8_STAGE(PG8_SB(0, 0), cB, voffB); PG8_STAGE(PG8_SB(0, 1), cB + hstep, voffB); PG8_STAGE(PG8_SA(0, 0), cA, voffA); PG8_STAGE(PG8_SA(0, 1), cA + hstep, voffA);
        if (wr == 1) PG8_BAR;
        PG8_WAIT_V(2); PG8_BAR;
        PG8_STAGE(PG8_SB(1, 0), cB + kstep, voffB); PG8_STAGE(PG8_SA(1, 0), cA + kstep, voffA); PG8_STAGE(PG8_SB(1, 1), cB + hstep + kstep, voffB);
        PG8_WAIT_V(6); PG8_BAR;
    } else {
        PG8_STAGE(PG8_SB(0, 0), cB, voffB); PG8_STAGE(PG8_SA(0, 0), cA, voffA); PG8_STAGE(PG8_SB(0, 1), cB + hstep, voffB); PG8_STAGE(PG8_SA(0, 1), cA + hstep, voffA);
        if (wr == 1) PG8_BAR;
        PG8_WAIT_V(4); PG8_BAR;
        PG8_STAGE(PG8_SB(1, 0), cB + kstep, voffB); PG8_STAGE(PG8_SA(1, 0), cA + kstep, voffA); PG8_STAGE(PG8_SB(1, 1), cB + hstep + kstep, voffB);
        PG8_WAIT_V(6); PG8_BAR;
    }
    for (;;) {
        const bool has_next = S.next(ui + 1, nxt);
        const char* nA = has_next ? (const char*)g.A + (size_t)nxt.pm * tstep : cA; const char* nB = has_next ? (const char*)g.Bt + (size_t)nxt.pn * tstep : cB;
        for (int t = 0; t < nt; t += 2) {
            const bool last = (t == nt - 2);
            const char* a1 = cA + (size_t)(t + 1) * kstep;
            const char* a2 = last ? nA : cA + (size_t)(t + 2) * kstep; const char* b2 = last ? nB : cB + (size_t)(t + 2) * kstep;
            const char* a3 = a2 + kstep; const char* b3 = b2 + kstep;
            if (last && has_next) S.a_ready(nxt);
            if constexpr (SP2) {
            PG8_LDB(B0, 0, 0); PG8_LDB(B1, 0, 1); PG8_SCHED; PG8_LDA(At, 0, 0); PG8_STAGE(PG8_SA(1, 1), a1 + hstep, voffA);
            PG8_WAIT_V(8); PG8_WAIT_L(0); PG8_BAR; PG8_MMA(0, 0, At, B0); PG8_MMA(0, 1, At, B1); PG8_BAR; PG8_SCHED;
            PG8_LDA(At, 0, 1); PG8_STAGE(PG8_SB(0, 0), b2, voffB); PG8_STAGE(PG8_SB(0, 1), b2 + hstep, voffB); PG8_STAGE(PG8_SA(0, 0), a2, voffA);
            PG8_WAIT_V(8); PG8_WAIT_L(0); PG8_BAR; PG8_MMA(1, 0, At, B0); PG8_MMA(1, 1, At, B1); PG8_BAR; PG8_SCHED;
            PG8_LDB(B0, 1, 0); PG8_LDB(B1, 1, 1); PG8_SCHED; PG8_LDA(At, 1, 0); PG8_STAGE(PG8_SA(0, 1), a2 + hstep, voffA);
            PG8_WAIT_V(8); PG8_WAIT_L(0); PG8_BAR; PG8_MMA(0, 0, At, B0); PG8_MMA(0, 1, At, B1); PG8_BAR; PG8_SCHED;
            PG8_LDA(At, 1, 1); PG8_STAGE(PG8_SB(1, 0), b3, voffB); PG8_STAGE(PG8_SB(1, 1), b3 + hstep, voffB); PG8_STAGE(PG8_SA(1, 0), a3, voffA);
            PG8_WAIT_V(8); PG8_WAIT_L(0); PG8_BAR; PG8_MMA(1, 0, At, B0); PG8_MMA(1, 1, At, B1); PG8_BAR; PG8_SCHED;
            } else {
            PG8_LDB(B0, 0, 0); PG8_SCHED; PG8_LDA(At, 0, 0); PG8_STAGE(PG8_SA(1, 1), a1 + hstep, voffA);
            PG8_WAIT_L(8); PG8_BAR; PG8_WAIT_L(0); PG8_MMA(0, 0, At, B0); PG8_BAR; PG8_SCHED;
            PG8_LDB(B1, 0, 1); PG8_STAGE(PG8_SB(0, 0), b2, voffB);
            PG8_BAR; PG8_WAIT_L(0); PG8_MMA(0, 1, At, B1); PG8_BAR;
            PG8_LDA(At, 0, 1); PG8_STAGE(PG8_SA(0, 0), a2, voffA);
            PG8_BAR; PG8_WAIT_L(0); PG8_MMA(1, 0, At, B0); PG8_BAR; PG8_SCHED;
            PG8_STAGE(PG8_SB(0, 1), b2 + hstep, voffB);
            PG8_WAIT_V(6); PG8_BAR; PG8_MMA(1, 1, At, B1); PG8_BAR;
            PG8_LDB(B0, 1, 0); PG8_SCHED; PG8_LDA(At, 1, 0); PG8_STAGE(PG8_SA(0, 1), a2 + hstep, voffA);
            PG8_WAIT_L(8); PG8_BAR; PG8_WAIT_L(0); PG8_MMA(0, 0, At, B0); PG8_BAR; PG8_SCHED;
            PG8_LDB(B1, 1, 1); PG8_STAGE(PG8_SB(1, 0), b3, voffB);
            PG8_BAR; PG8_WAIT_L(0); PG8_MMA(0, 1, At, B1); PG8_BAR;
            PG8_LDA(At, 1, 1); PG8_STAGE(PG8_SA(1, 0), a3, voffA);
            PG8_BAR; PG8_WAIT_L(0); PG8_MMA(1, 0, At, B0); PG8_BAR; PG8_SCHED;
            PG8_STAGE(PG8_SB(1, 1), b3 + hstep, voffB);
            PG8_WAIT_V(6); PG8_BAR; PG8_MMA(1, 1, At, B1); PG8_BAR;
            }
        }
        if constexpr (ALIGN_EPI) { if (wr == 0) PG8_BAR; }
        if constexpr (!Epi::AFTER_DRAIN) { E(acc, cur, wr, wc, fr, fq); S.done(cur); }
        if (!has_next) break;
#pragma unroll
        for (int a = 0; a < 2; ++a)
#pragma unroll
            for (int b = 0; b < 2; ++b)
#pragma unroll
                for (int m = 0; m < 4; ++m)
#pragma unroll
                    for (int n = 0; n < 2; ++n) acc[a][b][m][n] = (f32x4){0.f, 0.f, 0.f, 0.f};
        cur = nxt; cA = nA; cB = nB; ++ui;
        if constexpr (ALIGN_EPI) { if (wr == 1) PG8_BAR; }
    }
    PG8_WAIT_V(0);
    if constexpr (!ALIGN_EPI) { if (wr == 0) PG8_BAR; }
    PG8_BAR;
    if constexpr (Epi::AFTER_DRAIN) { E.fused(acc, cur, wr, wc, fr, fq, lds, wid, lane); S.done(cur); }
#undef PG8_SA
#undef PG8_SB
#undef PG8_STAGE
#undef PG8_LDA
#undef PG8_LDB
#undef PG8_MMA
#undef PG8_WAIT_V
#undef PG8_WAIT_L
#undef PG8_BAR
#undef PG8_SCHED
}
}

using pg8::Unit;
typedef f32x4 Acc[2][2][4][2];

DI u32x4 pack8(const f32x4& a, const f32x4& b) { u32x4 w; w.x = pk2(a[0], a[1]); w.y = pk2(a[2], a[3]); w.z = pk2(b[0], b[1]); w.w = pk2(b[2], b[3]); return w; }

DI void st16_wt(void* p, const u32x4& v) {
#if USE_WT_STORES
    asm volatile("global_store_dwordx4 %0, %1, off sc1\n\ts_nop 1" :: "v"(p), "v"(v) : "memory");
#else
    *(u32x4*)p = v;
#endif
}
DI void dequant_acc(Acc& acc, const Unit& u, int wr, int wc, int fr, int fq, const float* SA, const float* SB) {
    f32x4 sb[2][2];
#pragma unroll
    for (int bj = 0; bj < 2; ++bj)
#pragma unroll
        for (int n = 0; n < 2; ++n) sb[bj][n] = *(const f32x4*)(SB + u.pn * 256 + bj * 128 + wc * 32 + 8 * fq + 4 * n);
#pragma unroll
    for (int ai = 0; ai < 2; ++ai)
#pragma unroll
        for (int m = 0; m < 4; ++m) {
            const float sa = SA[u.pm * 256 + ai * 128 + wr * 64 + m * 16 + fr];
#pragma unroll
            for (int bj = 0; bj < 2; ++bj)
#pragma unroll
                for (int n = 0; n < 2; ++n)
#pragma unroll
                    for (int e = 0; e < 4; ++e) acc[ai][bj][m][n][e] = (float)__float_as_int(acc[ai][bj][m][n][e]) * sa * sb[bj][n][e];
        }
}

template <int CTRL, bool ZERO> DI float dppf(float v) { return __int_as_float(__builtin_amdgcn_update_dpp(0, __float_as_int(v), CTRL, 0xF, 0xF, ZERO)); }

struct EpiH {
    static constexpr bool PERM = true, AFTER_DRAIN = false;
    bf16* Qh; bf16* Kh; bf16* VTh; float* DEC; const float* hlb; bf16* OHG; const float* SA; const float* SB;
    DI void operator()(Acc& acc, const Unit& u, int wr, int wc, int fr, int fq) const {
        dequant_acc(acc, u, wr, wc, fr, fq, SA, SB);
        if (u.pn < 8) {
            const int h = u.pn, dbase = wc * 32 + 8 * fq;
#pragma unroll
            for (int ai = 0; ai < 2; ++ai) {
                const int row0 = u.pm * 256 + ai * 128 + wr * 64;
                const int bidx = row0 >> 13, chunk = (row0 & (SEQ - 1)) >> 6;
#pragma unroll
                for (int n = 0; n < 2; ++n) {
                    const f32x4 h0 = *(const f32x4*)(hlb + h * 128 + dbase + 4 * n), h1 = *(const f32x4*)(hlb + 1024 + h * 128 + dbase + 4 * n);
                    f32x4 ebl;
#pragma unroll
                    for (int e = 0; e < 4; ++e) {
                        const float lb = sigmoidf_(h0[e] - h1[e]);
                        float g[4], kk[4], tot[4];
#pragma unroll
                        for (int m = 0; m < 4; ++m) {
                            const float sg = sigmoidf_(acc[ai][1][m][n][e]);
                            kk[m] = (1.f - lb) * (1.f - sg);
                            const float lf = __logf(lb + (1.f - lb) * sg);
                            float s = lf;
                            s += dppf<0x111, true>(s); s += dppf<0x112, true>(s); s += dppf<0x114, true>(s); s += dppf<0x118, true>(s);
                            float t = lf;
                            t += dppf<0xB1, false>(t); t += dppf<0x4E, false>(t); t += dppf<0x141, false>(t); t += dppf<0x140, false>(t);
                            g[m] = s; tot[m] = t;
                        }
                        float carry = 0.f, eb = 0.f;
#pragma unroll
                        for (int m = 0; m < 4; ++m) {
                            const float bb = g[m] + carry; carry += tot[m];
                            eb = __expf(bb);
                            acc[ai][0][m][n][e] = acc[ai][0][m][n][e] * 0.08838834764831845f * eb;
                            acc[ai][1][m][n][e] = kk[m] * __expf(-bb);
                        }
                        ebl[e] = eb;
                    }
                    if (fr == 15) *(f32x4*)(DEC + ((size_t)((bidx * HG_H + h) * HG_NC + chunk)) * 128 + dbase + 4 * n) = ebl;
#pragma unroll
                    for (int m = 0; m < 4; ++m) {
                        const size_t row = (size_t)(row0 + m * 16 + fr);
                        const f32x4 qv = acc[ai][0][m][n], kv = acc[ai][1][m][n];
                        u32x2 oq, ok; oq.x = pk2(qv[0], qv[1]); oq.y = pk2(qv[2], qv[3]); ok.x = pk2(kv[0], kv[1]); ok.y = pk2(kv[2], kv[3]);
                        *(u32x2*)(Qh + row * 1024 + h * 128 + dbase + 4 * n) = oq;
                        *(u32x2*)(Kh + row * 1024 + h * 128 + dbase + 4 * n) = ok;
                    }
                    __builtin_amdgcn_sched_barrier(0);
                }
            }
        } else if (u.pn >= 12) {
            const int cb = (u.pn - 12) * 256 + wc * 32 + 8 * fq;
#pragma unroll
            for (int ai = 0; ai < 2; ++ai)
#pragma unroll
                for (int m = 0; m < 4; ++m) {
                    const size_t row = (size_t)(u.pm * 256 + ai * 128 + wr * 64 + m * 16 + fr);
#pragma unroll
                    for (int bj = 0; bj < 2; ++bj) {
                        f32x4 a0 = acc[ai][bj][m][0], a1 = acc[ai][bj][m][1];
#pragma unroll
                        for (int e = 0; e < 4; ++e) { a0[e] = siluf_(a0[e]); a1[e] = siluf_(a1[e]); }
                        st16_wt(OHG + row * 1024 + cb + bj * 128, pack8(a0, a1));
                    }
                }
        } else {
#pragma unroll
            for (int ai = 0; ai < 2; ++ai)
#pragma unroll
                for (int m = 0; m < 4; ++m) {
                    const int row = u.pm * 256 + ai * 128 + wr * 64 + m * 16 + fr, bidx = row >> 13, pos = row & (SEQ - 1);
                    bf16* ptr = VTh + (((size_t)(bidx * HG_H * 128 + (u.pn - 8) * 256 + wc * 32 + 8 * fq)) << 13) + pos;
#pragma unroll
                    for (int bj = 0; bj < 2; ++bj) {
#pragma unroll
                        for (int n = 0; n < 2; ++n)
#pragma unroll
                            for (int e = 0; e < 4; ++e) { asm volatile("" : "+v"(ptr)); *ptr = f2bf(acc[ai][bj][m][n][e]); ptr += 8192; }
                        ptr += (size_t)120 * 8192;
                    }
                }
        }
    }
};

struct EpiR {
    static constexpr bool PERM = true, AFTER_DRAIN = false;
    bf16* Qr; bf16* Kr; bf16* VTr; const float* COS; const float* SIN; bf16* ORET; const float* SA; const float* SB;
    DI void operator()(Acc& acc, const Unit& u, int wr, int wc, int fr, int fq) const {
        dequant_acc(acc, u, wr, wc, fr, fq, SA, SB);
        if (u.pn < 8) {
            const bool isk = u.pn >= 4; const int h = u.pn & 3;
            const float lg = __log2f(1.f - exp2f(-5.f - (float)h));
            bf16* dst = isk ? Kr : Qr;
            const int j0 = wc * 32 + 8 * fq;
            f32x4 cj[2];
#pragma unroll
            for (int n = 0; n < 2; ++n)
#pragma unroll
                for (int e = 0; e < 4; ++e) cj[n][e] = exp2f(-(float)(j0 + 4 * n + e) * 0.10381025296523008f) * 0.15915494309189535f;
#pragma unroll
            for (int ai = 0; ai < 2; ++ai)
#pragma unroll
                for (int m = 0; m < 4; ++m) {
                    const int row = u.pm * 256 + ai * 128 + wr * 64 + m * 16 + fr, pos = row & (SEQ - 1), il = pos & (RT_L - 1);
                    const float sc = isk ? exp2f(-lg * (float)il) * 0.0625f : exp2f(lg * (float)il);
                    const float fpos = (float)pos;
#pragma unroll
                    for (int n = 0; n < 2; ++n) {
                        f32x4 c, s;
#pragma unroll
                        for (int e = 0; e < 4; ++e) { const float rev = __builtin_amdgcn_fractf(fpos * cj[n][e]); c[e] = __builtin_amdgcn_cosf(rev); s[e] = __builtin_amdgcn_sinf(rev); }
                        const f32x4 x1 = acc[ai][0][m][n], x2 = acc[ai][1][m][n];
                        acc[ai][0][m][n] = (x1 * c - x2 * s) * sc; acc[ai][1][m][n] = (x1 * s + x2 * c) * sc;
                    }
                    st16_wt(dst + (size_t)row * 1024 + h * 256 + j0, pack8(acc[ai][0][m][0], acc[ai][0][m][1]));
                    st16_wt(dst + (size_t)row * 1024 + h * 256 + 128 + j0, pack8(acc[ai][1][m][0], acc[ai][1][m][1]));
                }
        } else if (u.pn >= 16) {
            const int cb = (u.pn - 16) * 256 + wc * 32 + 8 * fq;
#pragma unroll
            for (int ai = 0; ai < 2; ++ai)
#pragma unroll
                for (int m = 0; m < 4; ++m) {
                    const size_t row = (size_t)(u.pm * 256 + ai * 128 + wr * 64 + m * 16 + fr);
#pragma unroll
                    for (int bj = 0; bj < 2; ++bj) {
                        f32x4 a0 = acc[ai][bj][m][0], a1 = acc[ai][bj][m][1];
#pragma unroll
                        for (int e = 0; e < 4; ++e) { a0[e] = siluf_(a0[e]); a1[e] = siluf_(a1[e]); }
                        st16_wt(ORET + row * 2048 + cb + bj * 128, pack8(a0, a1));
                    }
                }
        } else {
#pragma unroll
            for (int ai = 0; ai < 2; ++ai)
#pragma unroll
                for (int m = 0; m < 4; ++m) {
                    const int row = u.pm * 256 + ai * 128 + wr * 64 + m * 16 + fr, bidx = row >> 13, pos = row & (SEQ - 1);
                    const int uu = pos & 15, hs = (uu >> 2) & 1, jj = ((uu >> 3) << 2) | (uu & 3), ks = (pos >> 4) & 1, sblk = pos >> 5;
                    const int c0 = (u.pn - 8) * 256 + wc * 32, hd = c0 >> 9, nv0 = (c0 & 511) >> 5;
                    bf16* ptr = VTr + ((((size_t)((bidx * RT_H + hd) * 256 + sblk) * 16 + nv0) * 2 + ks) * 64 + (8 * fq + 32 * hs)) * 8 + jj;
#pragma unroll
                    for (int bj = 0; bj < 2; ++bj) {
#pragma unroll
                        for (int n = 0; n < 2; ++n)
#pragma unroll
                            for (int e = 0; e < 4; ++e) { asm volatile("" : "+v"(ptr)); *ptr = f2bf(acc[ai][bj][m][n][e]); ptr += 8; }
                        ptr += 4 * 2 * 64 * 8 - 64;
                    }
                }
        }
    }
};

struct EpiG {
    static constexpr bool PERM = true, AFTER_DRAIN = false;
    bf16* GA; bf16* GB; const float* SA; const float* SB;
    DI void operator()(Acc& acc, const Unit& u, int wr, int wc, int fr, int fq) const {
        dequant_acc(acc, u, wr, wc, fr, fq, SA, SB);
        const int cb = wc * 32 + 8 * fq;
        bf16* base = (u.pn < 4 ? GA + (size_t)u.pn * 256 : GB + (size_t)(u.pn - 4) * 256) + cb;
#pragma unroll
        for (int ai = 0; ai < 2; ++ai)
#pragma unroll
            for (int m = 0; m < 4; ++m) {
                const size_t row = (size_t)(u.pm * 256 + ai * 128 + wr * 64 + m * 16 + fr);
#pragma unroll
                for (int bj = 0; bj < 2; ++bj) {
                    f32x4 a0 = acc[ai][bj][m][0], a1 = acc[ai][bj][m][1];
#pragma unroll
                    for (int e = 0; e < 4; ++e) { a0[e] = sigmoidf_(a0[e]); a1[e] = sigmoidf_(a1[e]); }
                    st16_wt(base + row * 1024 + bj * 128, pack8(a0, a1));
                }
            }
    }
};

struct EpiM1 {
    static constexpr bool PERM = true, AFTER_DRAIN = false;
    bf16* MERGED; const bf16* GA;
    DI void operator()(Acc& acc, const Unit& u, int wr, int wc, int fr, int fq) const {
        const int cb = u.pn * 256 + wc * 32 + 8 * fq;
#pragma unroll
        for (int ai = 0; ai < 2; ++ai)
#pragma unroll
            for (int m = 0; m < 4; ++m) {
                const size_t row = (size_t)(u.pm * 256 + ai * 128 + wr * 64 + m * 16 + fr);
#pragma unroll
                for (int bj = 0; bj < 2; ++bj) {
                    const u32x4 g = *(const u32x4*)(GA + row * 1024 + cb + bj * 128);
                    f32x4 a0 = acc[ai][bj][m][0], a1 = acc[ai][bj][m][1];
                    a0[0] *= bflo(g.x); a0[1] *= bfhi(g.x); a0[2] *= bflo(g.y); a0[3] *= bfhi(g.y);
                    a1[0] *= bflo(g.z); a1[1] *= bfhi(g.z); a1[2] *= bflo(g.w); a1[3] *= bfhi(g.w);
                    st16_wt(MERGED + row * 1024 + cb + bj * 128, pack8(a0, a1));
                }
            }
    }
};
struct EpiMerge {
    static constexpr bool PERM = true, AFTER_DRAIN = false;
    const bf16* GB; bf16* MERGED;
    DI void operator()(Acc& acc, const Unit& u, int wr, int wc, int fr, int fq) const {
        const int cb = u.pn * 256 + wc * 32 + 8 * fq;
#pragma unroll
        for (int ai = 0; ai < 2; ++ai)
#pragma unroll
            for (int m = 0; m < 4; ++m) {
                const size_t row = (size_t)(u.pm * 256 + ai * 128 + wr * 64 + m * 16 + fr);
#pragma unroll
                for (int bj = 0; bj < 2; ++bj) {
                    const u32x4 g = *(const u32x4*)(GB + row * 1024 + cb + bj * 128);
                    const u32x4 mo = *(const u32x4*)(MERGED + row * 1024 + cb + bj * 128);
                    f32x4 a0 = acc[ai][bj][m][0], a1 = acc[ai][bj][m][1];
                    a0[0] = a0[0] * bflo(g.x) + bflo(mo.x); a0[1] = a0[1] * bfhi(g.x) + bfhi(mo.x); a0[2] = a0[2] * bflo(g.y) + bflo(mo.y); a0[3] = a0[3] * bfhi(g.y) + bfhi(mo.y);
                    a1[0] = a1[0] * bflo(g.z) + bflo(mo.z); a1[1] = a1[1] * bfhi(g.z) + bfhi(mo.z); a1[2] = a1[2] * bflo(g.w) + bflo(mo.w); a1[3] = a1[3] * bfhi(g.w) + bfhi(mo.w);
                    st16_wt(MERGED + row * 1024 + cb + bj * 128, pack8(a0, a1));
                }
            }
    }
};
struct EpiOut {
    static constexpr bool PERM = true, AFTER_DRAIN = false;
    const float* X; float* X1; bf16* XW; const float* nw; float* SSQX;
    DI void operator()(Acc& acc, const Unit& u, int wr, int wc, int fr, int fq) const {
        const int cb = u.pn * 256 + wc * 32 + 8 * fq;
#pragma unroll
        for (int ai = 0; ai < 2; ++ai)
#pragma unroll
            for (int m = 0; m < 4; ++m) {
                const size_t row = (size_t)(u.pm * 256 + ai * 128 + wr * 64 + m * 16 + fr);
                float ss = 0.f;
#pragma unroll
                for (int bj = 0; bj < 2; ++bj) {
                    const size_t off = row * 1024 + cb + bj * 128;
                    const f32x4 x0 = *(const f32x4*)(X + off), x1v = *(const f32x4*)(X + off + 4);
                    const f32x4 w0 = *(const f32x4*)(nw + cb + bj * 128), w1 = *(const f32x4*)(nw + cb + bj * 128 + 4);
                    const f32x4 a0 = acc[ai][bj][m][0] + x0, a1 = acc[ai][bj][m][1] + x1v;
                    *(f32x4*)(X1 + off) = a0; *(f32x4*)(X1 + off + 4) = a1;
                    ss += (a0[0] * a0[0] + a0[1] * a0[1]) + (a0[2] * a0[2] + a0[3] * a0[3]) + (a1[0] * a1[0] + a1[1] * a1[1]) + (a1[2] * a1[2] + a1[3] * a1[3]);
                    st16_wt(XW + off, pack8(a0 * w0, a1 * w1));
                }
                ss += __shfl_xor(ss, 16); ss += __shfl_xor(ss, 32);
                if (fq == 0) SSQX[row * 16 + u.pn * 4 + wc] = ss;
            }
    }
};
DI float rstd_x1(const float* SSQX, size_t row) {
    const f32x4 a = *(const f32x4*)(SSQX + row * 16), b = *(const f32x4*)(SSQX + row * 16 + 4), c = *(const f32x4*)(SSQX + row * 16 + 8), d = *(const f32x4*)(SSQX + row * 16 + 12);
    const float s = ((a[0] + a[1]) + (a[2] + a[3])) + ((b[0] + b[1]) + (b[2] + b[3])) + ((c[0] + c[1]) + (c[2] + c[3])) + ((d[0] + d[1]) + (d[2] + d[3]));
    return rsqrtf(s * (1.f / 1024.f) + EPS);
}
struct EpiQ {
    static constexpr bool PERM = true, AFTER_DRAIN = false;
    bf16* Q; const float* SSQX;
    DI void operator()(Acc& acc, const Unit& u, int wr, int wc, int fr, int fq) const {
        const int cb = u.pn * 256 + wc * 32 + 8 * fq;
#pragma unroll
        for (int ai = 0; ai < 2; ++ai)
#pragma unroll
            for (int m = 0; m < 4; ++m) {
                const size_t row = (size_t)(u.pm * 256 + ai * 128 + wr * 64 + m * 16 + fr);
                const float rs = rstd_x1(SSQX, row);
#pragma unroll
                for (int bj = 0; bj < 2; ++bj) st16_wt(Q + row * 2048 + cb + bj * 128, pack8(acc[ai][bj][m][0] * rs, acc[ai][bj][m][1] * rs));
            }
    }
};

#define MFMA32(a, b, c) __builtin_amdgcn_mfma_f32_32x32x16_bf16((a), (b), (c), 0, 0, 0)
DI bf16x8 ldg16(const bf16* p) { return *(const bf16x8*)p; }
DI bf16x8 ldg2x8(const bf16* p0, const bf16* p1) { const s16x4 a = *(const s16x4*)p0, b = *(const s16x4*)p1; return __builtin_shufflevector(a, b, 0, 1, 2, 3, 4, 5, 6, 7); }
DI bf16x8 packx(const f32x16& x, int s) {
    u32x4 p; p.x = pk2(x[8 * s + 0], x[8 * s + 1]); p.y = pk2(x[8 * s + 2], x[8 * s + 3]); p.z = pk2(x[8 * s + 4], x[8 * s + 5]); p.w = pk2(x[8 * s + 6], x[8 * s + 7]);
    return __builtin_bit_cast(bf16x8, p);
}
DI f32x16 zero16() { f32x16 z;
#pragma unroll
    for (int i = 0; i < 16; ++i) z[i] = 0.f; return z; }

DI bf16x8 tr_frag(const LAS unsigned char* tile, int RS, int lane, int ks, int c) {
    const int hh = lane >> 5, blk = (lane >> 4) & 1, q = (lane & 15) >> 2, p = lane & 3;
    const LAS unsigned char* a0 = tile + (16 * ks + 8 * hh + q) * RS + (32 * c + 16 * blk + 4 * p) * 2;
    const s16x4 lo = __builtin_amdgcn_ds_read_tr16_b64_v4i16((LAS s16x4*)a0);
    const s16x4 hi = __builtin_amdgcn_ds_read_tr16_b64_v4i16((LAS s16x4*)(a0 + 4 * RS));
    return __builtin_shufflevector(lo, hi, 0, 1, 2, 3, 4, 5, 6, 7);
}

DI bf16x8 tr_frag_perm(const LAS unsigned char* tile, int RS, int lane, int ks, int c) {
    const int hh = lane >> 5, blk = (lane >> 4) & 1, q = (lane & 15) >> 2, p = lane & 3;
    const LAS unsigned char* a0 = tile + (16 * ks + 4 * hh + q) * RS + (32 * c + 16 * blk + 4 * p) * 2;
    const s16x4 lo = __builtin_amdgcn_ds_read_tr16_b64_v4i16((LAS s16x4*)a0);
    const s16x4 hi = __builtin_amdgcn_ds_read_tr16_b64_v4i16((LAS s16x4*)(a0 + 8 * RS));
    return __builtin_shufflevector(lo, hi, 0, 1, 2, 3, 4, 5, 6, 7);
}

constexpr int HG_KRS = 320;
DI void hg_pass1(LAS unsigned char* lds, const bf16* Kh, const bf16* VTh, bf16* STh, int wg, int nwg) {
    const int tid = fresh_tid(), lane = tid & 63, w = __builtin_amdgcn_readfirstlane(tid >> 6), r = lane & 31, hh = lane >> 5;
    for (int unit = wg; unit < 16 * HG_NC; unit += nwg) {
        const int bh = unit >> 7, c = unit & 127, b = bh >> 3, h = bh & 7;
        __syncthreads();
        {
            const int row = tid >> 3, ch = tid & 7;
            const bf16* src = Kh + ((size_t)(b * SEQ + c * 64 + row)) * 1024 + h * 128;
            const bf16x8 v0 = ldg16(src + ch * 8), v1 = ldg16(src + 64 + ch * 8);
            *(LAS bf16x8*)(lds + row * HG_KRS + ch * 16) = v0; *(LAS bf16x8*)(lds + row * HG_KRS + 128 + ch * 16) = v1;
        }
        __syncthreads();
        const int mt = w & 3, nt0 = w >> 2;
        f32x16 a0 = zero16(), a1 = zero16();
        const bf16* vrow = VTh + (((size_t)(bh * 128 + 32 * mt + r)) << 13) + c * 64;
#pragma unroll
        for (int ks = 0; ks < 4; ++ks) {
            const bf16x8 av = ldg16(vrow + 16 * ks + 8 * hh);
            a0 = MFMA32(av, tr_frag(lds, HG_KRS, lane, ks, nt0), a0);
            a1 = MFMA32(av, tr_frag(lds, HG_KRS, lane, ks, nt0 + 2), a1);
        }
        bf16* dst = STh + ((size_t)(bh * HG_NC + c)) * 16384;
#pragma unroll
        for (int i = 0; i < 16; ++i) {
            const int v = 32 * mt + crow(i, hh);
            dst[v * 128 + 32 * nt0 + r] = f2bf(a0[i]); dst[v * 128 + 32 * (nt0 + 2) + r] = f2bf(a1[i]);
        }
    }
    __syncthreads();
}

DI void hg_scan(bf16* STh, const float* DEC, int gtid, int gsz) {
    for (int idx = gtid; idx < 16 * 128 * 32; idx += gsz) {
        const int dq = idx & 31, v = (idx >> 5) & 127, bh = idx >> 12;
        f32x4 carry = {0.f, 0.f, 0.f, 0.f};
        bf16* p = STh + ((size_t)bh * HG_NC) * 16384 + v * 128 + dq * 4;
        const float* dp = DEC + ((size_t)bh * HG_NC) * 128 + dq * 4;
#pragma unroll 8
        for (int c = 0; c < HG_NC; ++c) {
            const u32x2 wv = *(const u32x2*)(p + (size_t)c * 16384);
            const f32x4 dec = *(const f32x4*)(dp + c * 128);
            u32x2 o; o.x = pk2(carry[0], carry[1]); o.y = pk2(carry[2], carry[3]);
            *(u32x2*)(p + (size_t)c * 16384) = o;
            carry[0] = dec[0] * (carry[0] + bflo(wv.x)); carry[1] = dec[1] * (carry[1] + bfhi(wv.x));
            carry[2] = dec[2] * (carry[2] + bflo(wv.y)); carry[3] = dec[3] * (carry[3] + bfhi(wv.y));
        }
    }
}
DI void rt_scan(bf16* STr, int gtid, int gsz) {
    for (int idx = gtid; idx < 8 * 512 * 32; idx += gsz) {
        const int dq = idx & 31, v = (idx >> 5) & 511, bh = idx >> 14, h = bh & 3;
        const float dec = exp2f((float)RT_L * __log2f(1.f - exp2f(-5.f - (float)h)));
        float carry[8];
#pragma unroll
        for (int e = 0; e < 8; ++e) carry[e] = 0.f;
        bf16* p = STr + ((size_t)bh * RT_NS) * 131072 + v * 256 + dq * 8;
#pragma unroll 4
        for (int c = 0; c < RT_NS; ++c) {
            const u32x4 wv = *(const u32x4*)(p + (size_t)c * 131072);
            u32x4 o; o.x = pk2(carry[0], carry[1]); o.y = pk2(carry[2], carry[3]); o.z = pk2(carry[4], carry[5]); o.w = pk2(carry[6], carry[7]);
            *(u32x4*)(p + (size_t)c * 131072) = o;
            if (c == RT_NS - 1) break;
            carry[0] = dec * (carry[0] + bflo(wv.x)); carry[1] = dec * (carry[1] + bfhi(wv.x));
            carry[2] = dec * (carry[2] + bflo(wv.y)); carry[3] = dec * (carry[3] + bfhi(wv.y));
            carry[4] = dec * (carry[4] + bflo(wv.z)); carry[5] = dec * (carry[5] + bfhi(wv.z));
            carry[6] = dec * (carry[6] + bflo(wv.w)); carry[7] = dec * (carry[7] + bfhi(wv.w));
        }
    }
}

DI void hg_pass3(LAS unsigned char* lds, const bf16* Qh, const bf16* Kh, const bf16* VTh, const bf16* STh, const float* hg_norm_w, bf16* OHG, int gw, int ngw, int dry) {
    const int tid_ = fresh_tid(), lane = tid_ & 63, r = lane & 31, hh = lane >> 5;
    LAS unsigned char* ot = lds + __builtin_amdgcn_readfirstlane(tid_ >> 6) * 8704;
    for (int unit = gw; unit < 16 * HG_NC * 2; unit += ngw) {
        const int tb = unit & 1, c = (unit >> 1) & 127, bh = unit >> 8, b = bh >> 3, h = bh & 7;
        const size_t trow = (size_t)(b * SEQ + c * 64 + tb * 32 + r);
        bf16x8 qf[8];
#pragma unroll
        for (int kk = 0; kk < 8; ++kk) qf[kk] = ldg16(Qh + trow * 1024 + h * 128 + kk * 16 + 8 * hh);
        f32x16 acc[4];
#pragma unroll
        for (int nv = 0; nv < 4; ++nv) acc[nv] = zero16();
        for (int sb = 0; sb <= tb; ++sb) {
            const size_t srow = (size_t)(b * SEQ + c * 64 + sb * 32 + r);
            f32x16 x = zero16();
#pragma unroll
            for (int kk = 0; kk < 8; ++kk) x = MFMA32(ldg16(Kh + srow * 1024 + h * 128 + kk * 16 + 8 * hh), qf[kk], x);
            if (sb == tb) {
#pragma unroll
                for (int i = 0; i < 16; ++i) if (crow(i, hh) > r) x[i] = 0.f;
            }
            const bf16x8 xs0 = packx(x, 0), xs1 = packx(x, 1);
#pragma unroll
            for (int nv = 0; nv < 4; ++nv) {
                const bf16* vb = VTh + (((size_t)(bh * 128 + nv * 32 + r)) << 13) + c * 64 + sb * 32 + 4 * hh;
                acc[nv] = MFMA32(ldg2x8(vb, vb + 8), xs0, acc[nv]);
                acc[nv] = MFMA32(ldg2x8(vb + 16, vb + 24), xs1, acc[nv]);
            }
        }
        const bf16* st = STh + ((size_t)(bh * HG_NC + c)) * 16384;
#pragma unroll
        for (int nv = 0; nv < 4; ++nv)
#pragma unroll
            for (int kk = 0; kk < 8; ++kk) acc[nv] = MFMA32(ldg16(st + (nv * 32 + r) * 128 + kk * 16 + 8 * hh), qf[kk], acc[nv]);
        float ss = 0.f;
#pragma unroll
        for (int nv = 0; nv < 4; ++nv)
#pragma unroll
            for (int i = 0; i < 16; ++i) ss += acc[nv][i] * acc[nv][i];
        ss += __shfl_xor(ss, 32);
        const float rs = rsqrtf(ss * (1.f / 128.f) + EPS);
#pragma unroll
        for (int nv = 0; nv < 4; ++nv)
#pragma unroll
            for (int g = 0; g < 4; ++g) {
                const int v = nv * 32 + 8 * g + 4 * hh;
                const f32x4 wv = *(const f32x4*)(hg_norm_w + h * 128 + v);
                u32x2 o; o.x = pk2(acc[nv][4 * g] * rs * wv[0], acc[nv][4 * g + 1] * rs * wv[1]); o.y = pk2(acc[nv][4 * g + 2] * rs * wv[2], acc[nv][4 * g + 3] * rs * wv[3]);
                *(LAS u32x2*)(ot + r * 272 + v * 2) = o;
            }
        bf16* orow = OHG + ((size_t)(b * SEQ + c * 64 + tb * 32)) * 1024 + h * 128;
#pragma unroll
        for (int k = 0; k < 8; ++k) {
            const int row = 4 * k + (lane >> 4), ch = lane & 15;
            const u32x4 val = *(const LAS u32x4*)(ot + row * 272 + ch * 16);
            bf16* gp = orow + (size_t)row * 1024 + ch * 8;
            const u32x4 gt = *(const u32x4*)gp;
            u32x4 o;
            o.x = pk2(bflo(val.x) * bflo(gt.x), bfhi(val.x) * bfhi(gt.x)); o.y = pk2(bflo(val.y) * bflo(gt.y), bfhi(val.y) * bfhi(gt.y));
            o.z = pk2(bflo(val.z) * bflo(gt.z), bfhi(val.z) * bfhi(gt.z)); o.w = pk2(bflo(val.w) * bflo(gt.w), bfhi(val.w) * bfhi(gt.w));
            if (!dry) *(u32x4*)gp = o; else asm volatile("" :: "v"(o));
        }
    }
}

constexpr int RT_KRS = 576;
constexpr int RT_KBUF = 64 * RT_KRS;
DI void rt_pass1(LAS unsigned char* lds, const bf16* Kr, const bf16* VTr, bf16* STr, int wg, int nwg) {
    const int tid = fresh_tid(), lane = tid & 63, w = __builtin_amdgcn_readfirstlane(tid >> 6), r = lane & 31, hh = lane >> 5;
    const int wm = w & 3, wn = w >> 2;
    const int srow = tid >> 3, sch = tid & 7;
    for (int unit = wg; unit < 8 * (RT_NS - 1) * 2; unit += nwg) {
        const int vh = unit & 1, sg = (unit >> 1) % (RT_NS - 1), bh = (unit >> 1) / (RT_NS - 1), b = bh >> 2, h = bh & 3;
        f32x16 acc[2][4];
#pragma unroll
        for (int i = 0; i < 2; ++i)
#pragma unroll
            for (int j = 0; j < 4; ++j) acc[i][j] = zero16();
        const bf16* kbase = Kr + ((size_t)(b * SEQ + sg * RT_L)) * 1024 + h * 256;
        bf16x8 st[4];
#pragma unroll
        for (int i = 0; i < 4; ++i) st[i] = ldg16(kbase + (size_t)srow * 1024 + (sch + 8 * i) * 8);
        __syncthreads();
#pragma unroll
        for (int i = 0; i < 4; ++i) *(LAS bf16x8*)(lds + srow * RT_KRS + (sch + 8 * i) * 16) = st[i];
        for (int sb = 0; sb < RT_L / 64; ++sb) {
            const LAS unsigned char* cur = lds + (sb & 1) * RT_KBUF;
            if (sb + 1 < RT_L / 64) {
#pragma unroll
                for (int i = 0; i < 4; ++i) st[i] = ldg16(kbase + (size_t)((sb + 1) * 64 + srow) * 1024 + (sch + 8 * i) * 8);
            }
            __syncthreads();
#pragma unroll
            for (int ks = 0; ks < 4; ++ks) {
                bf16x8 av[2];
#pragma unroll
                for (int i = 0; i < 2; ++i) av[i] = ldg16(VTr + (((((size_t)(bh * 256 + sg * 16 + sb * 2 + (ks >> 1))) * 16 + vh * 8 + wm * 2 + i) * 2 + (ks & 1)) * 64 + lane) * 8);
#pragma unroll
                for (int j = 0; j < 4; ++j) {
                    const bf16x8 bv = tr_frag_perm(cur, RT_KRS, lane, ks, wn * 4 + j);
                    acc[0][j] = MFMA32(av[0], bv, acc[0][j]); acc[1][j] = MFMA32(av[1], bv, acc[1][j]);
                }
                __builtin_amdgcn_sched_barrier(0);
            }
            if (sb + 1 < RT_L / 64) {
                LAS unsigned char* nxt = lds + ((sb + 1) & 1) * RT_KBUF;
#pragma unroll
                for (int i = 0; i < 4; ++i) *(LAS bf16x8*)(nxt + srow * RT_KRS + (sch + 8 * i) * 16) = st[i];
            }
        }
        bf16* dst = STr + ((size_t)(bh * RT_NS + sg)) * 131072;
#pragma unroll
        for (int i = 0; i < 2; ++i)
#pragma unroll
            for (int j = 0; j < 4; ++j)
#pragma unroll
                for (int e = 0; e < 16; ++e) {
                    const int vl = crow(e, hh), d = wn * 128 + j * 32 + r;
                    dst[((((vh * 8 + wm * 2 + i) * 16 + (d >> 4)) * 64 + vl + 32 * ((d >> 3) & 1)) << 3) + (d & 7)] = f2bf(acc[i][j][e]);
                }
    }
    __syncthreads();
}

constexpr int RQ_RS = 528;
constexpr int RQ_QBYTES = 128 * RQ_RS, RQ_KBYTES = 32 * RQ_RS;
DI void rt_pass3_wg(LAS unsigned char* lds, const bf16* Qr, const bf16* Kr, const bf16* VTr, const bf16* STr, bf16* ORET, float* SSQP, int wg, int nwg, int dry) {
    const int tid = fresh_tid(), lane = tid & 63, w = __builtin_amdgcn_readfirstlane(tid >> 6), r = lane & 31, hh = lane >> 5;
    const int tsub = w & 3, vh = w >> 2;
    LAS unsigned char* Qs = lds;
    LAS unsigned char* Ks = lds + RQ_QBYTES;
    for (int pairidx = wg; pairidx < 256; pairidx += nwg) {
#pragma unroll 1
        for (int half = 0; half < 2; ++half) {
            const int sgid = pairidx >> 1, bh = sgid >> 4, sg = sgid & 15, b = bh >> 2, h = bh & 3;
            const int qq = half ? 3 - (pairidx & 1) : (pairidx & 1);
            const int pos0 = sg * RT_L + qq * 128, nsb = 4 * qq + 4, mysb = 4 * qq + tsub;
            const bf16* qsrc = Qr + ((size_t)(b * SEQ + pos0)) * 1024 + h * 256;
            const bf16* ksrc = Kr + ((size_t)(b * SEQ + sg * RT_L)) * 1024 + h * 256;
            unsigned stoff = (unsigned)((tid >> 5) * 1024 + (tid & 31) * 8);
            unsigned stlds = (unsigned)((tid >> 5) * RQ_RS + (tid & 31) * 16);
            asm volatile("" : "+v"(stoff), "+v"(stlds));
            __syncthreads();
#pragma unroll
            for (int i = 0; i < 8; ++i) *(LAS bf16x8*)(Qs + stlds + i * 16 * RQ_RS) = ldg16(qsrc + i * 16 * 1024 + stoff);
            bf16x8 kst[2];
#pragma unroll
            for (int i = 0; i < 2; ++i) *(LAS bf16x8*)(Ks + stlds + i * 16 * RQ_RS) = ldg16(ksrc + i * 16 * 1024 + stoff);
            f32x16 acc[8];
#pragma unroll
            for (int nv = 0; nv < 8; ++nv) acc[nv] = zero16();
            __syncthreads();
            const LAS unsigned char* qfr = Qs + (tsub * 32 + r) * RQ_RS + 16 * hh;
            {
                const bf16* st = STr + ((size_t)(bh * RT_NS + sg)) * 131072 + (size_t)(vh * 8) * 16 * 512;
                unsigned so = (unsigned)(lane * 8);
                asm volatile("" : "+v"(so));
                bf16x8 fa[8], fb[8];
#pragma unroll
                for (int nv = 0; nv < 8; ++nv) fa[nv] = ldg16(st + nv * 16 * 512 + so);
#pragma unroll 1
                for (int k2 = 0; k2 < 8; ++k2) {
#pragma unroll
                    for (int nv = 0; nv < 8; ++nv) fb[nv] = ldg16(st + nv * 16 * 512 + (2 * k2 + 1) * 512 + so);
                    {
                        const bf16x8 q = *(const LAS bf16x8*)(qfr + (2 * k2) * 32);
#pragma unroll
                        for (int nv = 0; nv < 8; ++nv) acc[nv] = MFMA32(fa[nv], q, acc[nv]);
                    }
                    __builtin_amdgcn_sched_barrier(0);
                    if (k2 < 7) {
#pragma unroll
                        for (int nv = 0; nv < 8; ++nv) fa[nv] = ldg16(st + nv * 16 * 512 + (2 * k2 + 2) * 512 + so);
                    }
                    {
                        const bf16x8 q = *(const LAS bf16x8*)(qfr + (2 * k2 + 1) * 32);
#pragma unroll
                        for (int nv = 0; nv < 8; ++nv) acc[nv] = MFMA32(fb[nv], q, acc[nv]);
                    }
                    __builtin_amdgcn_sched_barrier(0);
                }
            }
            const bf16* vbase = VTr + (((size_t)(bh * 256 + sg * 16)) * 16 + vh * 8) * 1024;
            unsigned vo = (unsigned)(lane * 8);
            asm volatile("" : "+v"(vo));
#pragma unroll 1
            for (int sb = 0; sb < nsb; ++sb) {
                const LAS unsigned char* kcur = Ks + (sb & 1) * RQ_KBYTES;
                if (sb + 1 < nsb) {
#pragma unroll
                    for (int i = 0; i < 2; ++i) kst[i] = ldg16(ksrc + (size_t)(sb + 1) * 32 * 1024 + i * 16 * 1024 + stoff);
                }
                if (sb <= mysb) {
                    bf16x8 vt[8][2];
                    const bf16* vb = vbase + (size_t)sb * 16 * 1024;
#pragma unroll
                    for (int nv = 0; nv < 8; ++nv) { vt[nv][0] = ldg16(vb + nv * 1024 + vo); vt[nv][1] = ldg16(vb + nv * 1024 + 512 + vo); }
                    f32x16 x = zero16();
                    const LAS unsigned char* kfr = kcur + r * RQ_RS + 16 * hh;
#pragma unroll
                    for (int kk = 0; kk < 16; ++kk) { x = MFMA32(*(const LAS bf16x8*)(kfr + kk * 32), *(const LAS bf16x8*)(qfr + kk * 32), x); if (kk & 1) __builtin_amdgcn_sched_barrier(0); }
                    if (sb == mysb) {
#pragma unroll
                        for (int i = 0; i < 16; ++i) if (crow(i, hh) > r) x[i] = 0.f;
                    }
                    const bf16x8 xs0 = packx(x, 0), xs1 = packx(x, 1);
#pragma unroll
                    for (int nv = 0; nv < 8; ++nv) { acc[nv] = MFMA32(vt[nv][0], xs0, acc[nv]); acc[nv] = MFMA32(vt[nv][1], xs1, acc[nv]); }
                }
                if (sb + 1 < nsb) {
                    LAS unsigned char* knx = Ks + ((sb + 1) & 1) * RQ_KBYTES;
#pragma unroll
                    for (int i = 0; i < 2; ++i) *(LAS bf16x8*)(knx + stlds + i * 16 * RQ_RS) = kst[i];
                }
                __syncthreads();
            }
            float ss = 0.f;
#pragma unroll
            for (int nv = 0; nv < 8; ++nv)
#pragma unroll
                for (int i = 0; i < 16; ++i) ss += acc[nv][i] * acc[nv][i];
            ss += __shfl_xor(ss, 32);
            LAS float* sx = (LAS float*)(lds + 8 * 16896);
            if (hh == 0) sx[vh * 128 + tsub * 32 + r] = ss;
            __syncthreads();
            const float rs = rsqrtf((sx[tsub * 32 + r] + sx[128 + tsub * 32 + r]) * (1.f / 512.f) + EPS);
            LAS unsigned char* ot = lds + w * 16896;
#pragma unroll
            for (int nv = 0; nv < 8; ++nv)
#pragma unroll
                for (int g = 0; g < 4; ++g) {
                    u32x2 o; o.x = pk2(acc[nv][4 * g] * rs, acc[nv][4 * g + 1] * rs); o.y = pk2(acc[nv][4 * g + 2] * rs, acc[nv][4 * g + 3] * rs);
                    *(LAS u32x2*)(ot + r * 528 + (nv * 32 + 8 * g + 4 * hh) * 2) = o;
                }
            bf16* orow = ORET + (size_t)(b * SEQ + pos0 + tsub * 32) * 2048 + h * 512 + vh * 256;
#pragma unroll 4
            for (int k = 0; k < 16; ++k) {
                const int row = 2 * k + (lane >> 5), ch = lane & 31;
                const u32x4 val = *(const LAS u32x4*)(ot + row * 528 + ch * 16);
                bf16* gp = orow + (size_t)row * 2048 + ch * 8;
                const u32x4 gt = *(const u32x4*)gp;
                u32x4 o;
                o.x = pk2(bflo(val.x) * bflo(gt.x), bfhi(val.x) * bfhi(gt.x)); o.y = pk2(bflo(val.y) * bflo(gt.y), bfhi(val.y) * bfhi(gt.y));
                o.z = pk2(bflo(val.z) * bflo(gt.z), bfhi(val.z) * bfhi(gt.z)); o.w = pk2(bflo(val.w) * bflo(gt.w), bfhi(val.w) * bfhi(gt.w));
                if (!dry) *(u32x4*)gp = o; else asm volatile("" :: "v"(o));
            }
        }
    }
    __syncthreads();
}

DI float dot2bf(unsigned a, unsigned b, float c) {
#if __has_builtin(__builtin_amdgcn_fdot2_f32_bf16)
    typedef __bf16 nb2 __attribute__((ext_vector_type(2)));
    return __builtin_amdgcn_fdot2_f32_bf16(__builtin_bit_cast(nb2, a), __builtin_bit_cast(nb2, b), c, false);
#else
    return c + bflo(a) * bflo(b) + bfhi(a) * bfhi(b);
#endif
}
DI unsigned key_pack(float s, unsigned lowbits, unsigned mask) {
    unsigned u = __float_as_uint(s); u = (u & 0x80000000u) ? ~u : (u | 0x80000000u);
    return (u & ~mask) | lowbits;
}
DI float key_val(unsigned k, unsigned mask) { unsigned u = k & ~mask; u = (u & 0x80000000u) ? (u & 0x7fffffffu) : ~u; return __uint_as_float(u); }
DI unsigned umin_(unsigned a, unsigned b) { return a < b ? a : b; }
DI unsigned umax_(unsigned a, unsigned b) { return a > b ? a : b; }
DI void ins16(unsigned (&t)[16], unsigned x) {
#pragma unroll
    for (int i = 15; i >= 1; --i) t[i] = umax_(umin_(t[i - 1], t[i]), umin_(umax_(t[i - 1], t[i]), x));
    t[0] = umax_(t[0], x);
}
constexpr int PR_KOFF = 20480, PR_KRS = 272;
DI void peer_retrieve(LAS unsigned char* lds, const bf16* Q, const bf16* SK, int* EIDX, float* EGATE, int wg, int nwg) {
    const int tid = fresh_tid(), lane = tid & 63, w = __builtin_amdgcn_readfirstlane(tid >> 6), r = lane & 31, hh = lane >> 5;
    LAS unsigned char* myl = lds + w * 2304 + lane * 36;
    LAS unsigned char* ks = lds + PR_KOFF;
    int staged_h = -1;
    for (int unit = 2 * wg; unit < 512; unit += (unit & 1) ? 2 * nwg - 1 : 1) {
        const int h = unit >> 6, tb = (unit & 63) * 8 + w;
        if (h != staged_h) {
            __syncthreads();
#pragma unroll
            for (int i = 0; i < 8; ++i) { const int cidx = tid + 512 * i, row = cidx >> 4, ch = cidx & 15;
                *(LAS bf16x8*)(ks + row * PR_KRS + ch * 16) = ldg16(SK + ((size_t)(h * 256 + row)) * 128 + ch * 8); }
            __syncthreads();
            staged_h = h;
        }
        const size_t trow = (size_t)(tb * 32 + r);
        bf16x8 qf[2][8];
        {
            const bf16* qrow = Q + trow * 2048 + h * 256 + 8 * hh;
#pragma unroll
            for (int p = 0; p < 2; ++p)
#pragma unroll
                for (int kk = 0; kk < 8; ++kk) qf[p][kk] = ldg16(qrow + p * 128 + kk * 16);
        }
        unsigned L[2][16];
#pragma unroll
        for (int p = 0; p < 2; ++p) {
            f32x16 acc[4];
#pragma unroll
            for (int mt = 0; mt < 4; ++mt) acc[mt] = zero16();
            const LAS unsigned char* kfr = ks + (p * 128 + r) * PR_KRS + 16 * hh;
#pragma unroll
            for (int kk = 0; kk < 8; ++kk) {
#pragma unroll
                for (int mt = 0; mt < 4; ++mt) acc[mt] = MFMA32(*(const LAS bf16x8*)(kfr + mt * 32 * PR_KRS + kk * 32), qf[p][kk], acc[mt]);
                if (kk & 1) __builtin_amdgcn_sched_barrier(0);
            }
            unsigned t[16];
#pragma unroll
            for (int i = 0; i < 16; ++i) t[i] = 0u;
#pragma unroll
            for (int mt = 0; mt < 4; ++mt)
#pragma unroll
                for (int i = 0; i < 16; ++i) ins16(t, key_pack(acc[mt][i], (unsigned)(127 - 32 * mt - (i & 3) - 8 * (i >> 2)) - 4u * (unsigned)hh, 127u));
            unsigned o[16];
#pragma unroll
            for (int i = 0; i < 16; ++i) o[i] = (unsigned)__shfl_xor((int)t[i], 32);
#pragma unroll
            for (int i = 0; i < 16; ++i) ins16(t, o[i]);
#pragma unroll
            for (int i = 0; i < 16; ++i) L[p][i] = t[i];
        }
#pragma unroll
        for (int p = 0; p < 2; ++p)
#pragma unroll
            for (int g = 0; g < 4; ++g) {
                const unsigned v = (127u - (L[p][4 * g] & 127u)) | ((127u - (L[p][4 * g + 1] & 127u)) << 8) | ((127u - (L[p][4 * g + 2] & 127u)) << 16) | ((127u - (L[p][4 * g + 3] & 127u)) << 24);
                *(LAS unsigned*)(myl + p * 16 + g * 4) = v;
            }
        float a[16], b[16];
#pragma unroll
        for (int i = 0; i < 16; ++i) { a[i] = key_val(L[0][i], 127u); b[i] = key_val(L[1][i], 127u); }
        unsigned c[16];
#pragma unroll
        for (int i = 0; i < 16; ++i) c[i] = 0u;
#pragma unroll
        for (int i = 0; i < 16; ++i)
#pragma unroll
            for (int j = 0; j < 16; ++j)
                if ((i + 1) * (j + 1) <= 16) ins16(c, key_pack(a[i] + b[j], (unsigned)(255 - (16 * i + j)), 255u));
        float v[16];
        float sum = 0.f;
        const float mx = key_val(c[0], 255u);
#pragma unroll
        for (int k = 0; k < 16; ++k) { v[k] = __expf(key_val(c[k], 255u) - mx); sum += v[k]; }
        const float inv = 1.f / sum;
        asm volatile("s_waitcnt lgkmcnt(0)" ::: "memory");
        if (hh == 0) {
            int e[16];
#pragma unroll
            for (int k = 0; k < 16; ++k) {
                const unsigned cc = 255u - (c[k] & 255u);
                const unsigned i1 = *(LAS unsigned char*)(myl + (cc >> 4)), i2 = *(LAS unsigned char*)(myl + 16 + (cc & 15u));
                e[k] = (int)(i1 * 128u + i2);
            }
            int* ep = EIDX + trow * 128 + h * 16;
#pragma unroll
            for (int g = 0; g < 4; ++g) *(u32x4*)(ep + 4 * g) = (u32x4){(unsigned)e[4 * g], (unsigned)e[4 * g + 1], (unsigned)e[4 * g + 2], (unsigned)e[4 * g + 3]};
        } else {
            float* gp = EGATE + trow * 128 + h * 16;
#pragma unroll
            for (int g = 0; g < 4; ++g) *(f32x4*)(gp + 4 * g) = (f32x4){v[4 * g] * inv, v[4 * g + 1] * inv, v[4 * g + 2] * inv, v[4 * g + 3] * inv};
        }
        asm volatile("s_waitcnt lgkmcnt(0)" ::: "memory");
    }
}

DI float gelu_tanh(float x) {
    const float u = 0.7978845608028654f * (x + 0.044715f * x * x * x);
    const float e = __expf(2.f * u);
    const float th = 1.f - 2.f / (e + 1.f);
    return 0.5f * x * (1.f + th);
}

DI float bcast_f(float v, int j) { return __int_as_float(__builtin_amdgcn_readfirstlane(__float_as_int(__shfl(v, j)))); }
DI void quant_rows(const float* __restrict__ src, unsigned char* __restrict__ dst, float* __restrict__ scale, int nrows, int offs, int gw, int ngw, int lane) {
    for (int row0 = gw; row0 < nrows; row0 += 2 * ngw) {
        const int rowb = row0 + ngw, row1 = rowb < nrows ? rowb : row0;
        f32x4 v[2][4];
#pragma unroll
        for (int rr = 0; rr < 2; ++rr) { const f32x4* p = (const f32x4*)(src + (size_t)(rr ? row1 : row0) * 1024 + lane * 16);
#pragma unroll
            for (int i = 0; i < 4; ++i) v[rr][i] = p[i]; }
#pragma unroll
        for (int rr = 0; rr < 2; ++rr) {
            const int row = rr ? row1 : row0;
            float am = 0.f;
#pragma unroll
            for (int i = 0; i < 4; ++i)
#pragma unroll
                for (int e = 0; e < 4; ++e) am = fmaxf(am, fabsf(v[rr][i][e]));
#pragma unroll
            for (int o = 1; o < 64; o <<= 1) am = fmaxf(am, __shfl_xor(am, o));
            const float inv = am > 0.f ? 127.f / am : 0.f;
            u32x4 w;
#pragma unroll
            for (int i = 0; i < 4; ++i) {
                unsigned pk = 0u;
#pragma unroll
                for (int e = 0; e < 4; ++e) { const int q = (int)rintf(v[rr][i][e] * inv) + offs; pk |= ((unsigned)q & 0xffu) << (8 * e); }
                w[i] = pk;
            }
            if (rr == 0 || rowb < nrows) {
                *(u32x4*)(dst + ((size_t)(lane >> 3) * nrows + row) * 128 + (lane & 7) * 16) = w;
                if (lane == 0) scale[row] = am > 0.f ? am * (1.f / 127.f) : 0.f;
            }
        }
    }
}
DI void quant_xw(const bf16* XW, unsigned char* XQ8, float* XS, int gw, int ngw, int lane) {
    for (int t = gw; t < T; t += ngw) {
        const u32x4 xa = *(const u32x4*)(XW + (size_t)t * 1024 + lane * 16), xb = *(const u32x4*)(XW + (size_t)t * 1024 + lane * 16 + 8);
        float xf[16] = {bflo(xa.x), bfhi(xa.x), bflo(xa.y), bfhi(xa.y), bflo(xa.z), bfhi(xa.z), bflo(xa.w), bfhi(xa.w),
                        bflo(xb.x), bfhi(xb.x), bflo(xb.y), bfhi(xb.y), bflo(xb.z), bfhi(xb.z), bflo(xb.w), bfhi(xb.w)};
        float am = 0.f;
#pragma unroll
        for (int i = 0; i < 16; ++i) am = fmaxf(am, fabsf(xf[i]));
#pragma unroll
        for (int o = 1; o < 64; o <<= 1) am = fmaxf(am, __shfl_xor(am, o));
        const float inv = am > 0.f ? 127.f / am : 0.f;
        u32x4 w;
#pragma unroll
        for (int i = 0; i < 4; ++i) { unsigned pk = 0u;
#pragma unroll
            for (int e = 0; e < 4; ++e) pk |= ((unsigned)((int)rintf(xf[4 * i + e] * inv)) & 0xffu) << (8 * e);
            w[i] = pk; }
        *(u32x4*)(XQ8 + ((size_t)(lane >> 3) * T + t) * 128 + (lane & 7) * 16) = w;
        if (lane == 0) XS[t] = am * (1.f / 127.f);
    }
}
DI int dpp_xor1(int v) { return __builtin_amdgcn_update_dpp(0, v, 0xB1, 0xF, 0xF, false); }
DI int dpp_xor2(int v) { return __builtin_amdgcn_update_dpp(0, v, 0x4E, 0xF, 0xF, false); }
DI int dpp_hmir(int v) { return __builtin_amdgcn_update_dpp(0, v, 0x141, 0xF, 0xF, false); }
DI void peer_u(const unsigned char* EU8, const unsigned char* XQ8, const int* EIDX, int* PART, int slice, int tok0, int tokstep, int lane) {
    const int q = lane >> 3, i = lane & 7;
    const unsigned char* tab = EU8 + (size_t)slice * PE_NE * 128 + i * 16;
#define PU_LOAD(dst, t_) do { const u32x4* ep_ = (const u32x4*)(EIDX + (size_t)(t_) * 128 + 16 * q); const u32x4 e0_ = ep_[0], e1_ = ep_[1], e2_ = ep_[2], e3_ = ep_[3]; \
        const unsigned ee_[16] = {e0_.x, e0_.y, e0_.z, e0_.w, e1_.x, e1_.y, e1_.z, e1_.w, e2_.x, e2_.y, e2_.z, e2_.w, e3_.x, e3_.y, e3_.z, e3_.w}; \
        _Pragma("unroll") for (int g = 0; g < 16; ++g) dst[g] = *(const u32x4*)(tab + (size_t)ee_[g] * 128); } while (0)
    u32x4 ub[16], nb[16];
    if (tok0 < T) PU_LOAD(ub, tok0);
    for (int t = tok0; t < T; t += tokstep) {
        const u32x4 xv = *(const u32x4*)(XQ8 + ((size_t)slice * T + t) * 128 + i * 16);
        if (t + tokstep < T) PU_LOAD(nb, t + tokstep);
        int d0 = 0, d1 = 0;
#pragma unroll
        for (int g = 0; g < 16; ++g) {
            int s = __builtin_amdgcn_sdot4((int)ub[g].x, (int)xv.x, 0, false);
            s = __builtin_amdgcn_sdot4((int)ub[g].y, (int)xv.y, s, false); s = __builtin_amdgcn_sdot4((int)ub[g].z, (int)xv.z, s, false); s = __builtin_amdgcn_sdot4((int)ub[g].w, (int)xv.w, s, false);
            s += dpp_xor1(s); s += dpp_xor2(s); s += dpp_hmir(s);
            if (g < 8) { if (i == g) d0 = s; } else { if (i == g - 8) d1 = s; }
        }
        int* pp = PART + ((size_t)slice * T + t) * 128 + 16 * q + i;
        pp[0] = d0; pp[8] = d1;
#pragma unroll
        for (int g = 0; g < 16; ++g) ub[g] = nb[g];
    }
#undef PU_LOAD
}
DI void peer_w(const int* PART, const int* EIDX, const float* EGATE, const float* SU, const float* SV, const float* XS, const float* SSQX, unsigned char* WQ8, float* WSC, int gw, int ngw, int lane) {
    for (int t = gw; t < T; t += ngw) {
        const size_t base = (size_t)t * 128 + 2 * lane;
        int d0 = 0, d1 = 0;
#pragma unroll
        for (int s = 0; s < 8; ++s) { const u32x2 pv = *(const u32x2*)(PART + (size_t)s * T * 128 + base); d0 += (int)pv.x; d1 += (int)pv.y; }
        const u32x2 ev = *(const u32x2*)(EIDX + base); const f32x2 gv = *(const f32x2*)(EGATE + base);
        const float sc = XS[t] * rstd_x1(SSQX, (size_t)t);
        const float w0 = gv[0] * SV[ev.x] * gelu_tanh((float)d0 * (SU[ev.x] * sc)), w1 = gv[1] * SV[ev.y] * gelu_tanh((float)d1 * (SU[ev.y] * sc));
        float am = fmaxf(fabsf(w0), fabsf(w1));
#pragma unroll
        for (int o = 1; o < 64; o <<= 1) am = fmaxf(am, __shfl_xor(am, o));
        const float inv = am > 0.f ? 127.f / am : 0.f;
        const unsigned q0 = (unsigned)((int)rintf(w0 * inv)) & 0xffu, q1 = (unsigned)((int)rintf(w1 * inv)) & 0xffu;
        *(unsigned short*)(WQ8 + base) = (unsigned short)(q0 | (q1 << 8));
        if (lane == 0) WSC[t] = am * (1.f / 127.f);
    }
}
DI unsigned perm_(unsigned s0, unsigned s1, unsigned sel) { return __builtin_amdgcn_perm(s0, s1, sel); }
DI void peer_v(const unsigned char* EV8, const int* EIDX, const unsigned char* WQ8, const float* WSC, float* X1, int slice, int tok0, int tokstep, int lane, int dry) {
    const int q = lane >> 3, i = lane & 7;
    const unsigned char* tab = EV8 + (size_t)slice * PE_NE * 128 + i * 16;
#define PV_LOAD(dst, t_) do { const u32x4* ep_ = (const u32x4*)(EIDX + (size_t)(t_) * 128 + 16 * q); const u32x4 e0_ = ep_[0], e1_ = ep_[1], e2_ = ep_[2], e3_ = ep_[3]; \
        const unsigned ee_[16] = {e0_.x, e0_.y, e0_.z, e0_.w, e1_.x, e1_.y, e1_.z, e1_.w, e2_.x, e2_.y, e2_.z, e2_.w, e3_.x, e3_.y, e3_.z, e3_.w}; \
        _Pragma("unroll") for (int g = 0; g < 16; ++g) dst[g] = *(const u32x4*)(tab + (size_t)ee_[g] * 128); } while (0)
    u32x4 vb[16], nb[16];
    if (tok0 < T) PV_LOAD(vb, tok0);
    for (int t = tok0; t < T; t += tokstep) {
        const u32x4 wqv = *(const u32x4*)(WQ8 + (size_t)t * 128 + 16 * q);
        const float wsc = WSC[t];
        if (t + tokstep < T) PV_LOAD(nb, t + tokstep);
        const int wq[4] = {(int)wqv.x, (int)wqv.y, (int)wqv.z, (int)wqv.w};
        int o[16];
#pragma unroll
        for (int c = 0; c < 16; ++c) o[c] = 0;
#pragma unroll
        for (int m = 0; m < 4; ++m) {
#pragma unroll
            for (int k = 0; k < 4; ++k) {
                const unsigned a = vb[4 * m][k], b = vb[4 * m + 1][k], c = vb[4 * m + 2][k], dd = vb[4 * m + 3][k];
                const unsigned ablo = perm_(b, a, 0x05010400u), abhi = perm_(b, a, 0x07030602u), cdlo = perm_(dd, c, 0x05010400u), cdhi = perm_(dd, c, 0x07030602u);
                o[4 * k + 0] = __builtin_amdgcn_sdot4((int)perm_(cdlo, ablo, 0x05040100u), wq[m], o[4 * k + 0], false);
                o[4 * k + 1] = __builtin_amdgcn_sdot4((int)perm_(cdlo, ablo, 0x07060302u), wq[m], o[4 * k + 1], false);
                o[4 * k + 2] = __builtin_amdgcn_sdot4((int)perm_(cdhi, abhi, 0x05040100u), wq[m], o[4 * k + 2], false);
                o[4 * k + 3] = __builtin_amdgcn_sdot4((int)perm_(cdhi, abhi, 0x07060302u), wq[m], o[4 * k + 3], false);
            }
        }
        int r8[8], r4[4], r2[2];
#pragma unroll
        for (int c = 0; c < 8; ++c) { const int mine = (q & 4) ? o[c + 8] : o[c], theirs = (q & 4) ? o[c] : o[c + 8]; r8[c] = mine + __shfl_xor(theirs, 32); }
#pragma unroll
        for (int c = 0; c < 4; ++c) { const int mine = (q & 2) ? r8[c + 4] : r8[c], theirs = (q & 2) ? r8[c] : r8[c + 4]; r4[c] = mine + __shfl_xor(theirs, 16); }
#pragma unroll
        for (int c = 0; c < 2; ++c) { const int mine = (q & 1) ? r4[c + 2] : r4[c], theirs = (q & 1) ? r4[c] : r4[c + 2]; r2[c] = mine + __shfl_xor(theirs, 8); }
        float* xp = X1 + (size_t)t * 1024 + slice * 128 + i * 16 + 2 * q;
        f32x2 xv = *(const f32x2*)xp;
        xv[0] += (float)r2[0] * wsc; xv[1] += (float)r2[1] * wsc;
        if (!dry) *(f32x2*)xp = xv; else asm volatile("" :: "v"(xv));
#pragma unroll
        for (int g = 0; g < 16; ++g) vb[g] = nb[g];
    }
#undef PV_LOAD
}
DI void final_norm(const float* __restrict__ Y, const float* __restrict__ fw, float* __restrict__ OUT, int gw, int ngw, int lane) {
    for (int t0 = gw; t0 < T; t0 += 2 * ngw) {
        const int tb = t0 + ngw, t1 = tb < T ? tb : t0;
        f32x4 v[2][4];
#pragma unroll
        for (int rr = 0; rr < 2; ++rr) { const f32x4* yr = (const f32x4*)(Y + (size_t)(rr ? t1 : t0) * 1024) + lane;
#pragma unroll
            for (int j = 0; j < 4; ++j) v[rr][j] = yr[64 * j]; }
#pragma unroll
        for (int rr = 0; rr < 2; ++rr) {
            float s = 0.f;
#pragma unroll
            for (int j = 0; j < 4; ++j) s += (v[rr][j][0] * v[rr][j][0] + v[rr][j][1] * v[rr][j][1]) + (v[rr][j][2] * v[rr][j][2] + v[rr][j][3] * v[rr][j][3]);
            const float rs = rsqrtf(wave_sum(s) * (1.f / 1024.f) + EPS);
            if (rr == 0 || tb < T) {
                f32x4* o = (f32x4*)(OUT + (size_t)(rr ? t1 : t0) * 1024) + lane; const f32x4* wr4 = (const f32x4*)fw + lane;
#pragma unroll
                for (int j = 0; j < 4; ++j) { const f32x4 ww = wr4[64 * j]; o[64 * j] = (f32x4){v[rr][j][0] * rs * ww[0], v[rr][j][1] * rs * ww[1], v[rr][j][2] * rs * ww[2], v[rr][j][3] * rs * ww[3]}; }
            }
        }
    }
}

DI void transpose_item(const float* W, int K, int N, bf16* WT, int n_src0, int n_dst0, int k0, LAS float* scr, int lane) {
#pragma unroll 16
    for (int i = 0; i < 32; ++i) { const int kk = 2 * i + (lane >> 5); scr[kk * 33 + (lane & 31)] = W[(size_t)(k0 + kk) * N + n_src0 + (lane & 31)]; }
    asm volatile("s_waitcnt lgkmcnt(0)" ::: "memory");
    const int c = lane & 7;
#pragma unroll
    for (int j = 0; j < 4; ++j) { const int n = (lane >> 3) + 8 * j; const LAS float* s = scr + (8 * c) * 33 + n;
        u32x4 o; o.x = pk2(s[0 * 33], s[1 * 33]); o.y = pk2(s[2 * 33], s[3 * 33]); o.z = pk2(s[4 * 33], s[5 * 33]); o.w = pk2(s[6 * 33], s[7 * 33]);
        *(u32x4*)(WT + (size_t)(n_dst0 + n) * K + k0 + 8 * c) = o; }
    asm volatile("s_waitcnt lgkmcnt(0)" ::: "memory");
}
DI int win_orig_col(int np) {
    if (np < 2048) { const int h = np >> 8, sel = (np >> 7) & 1, d = np & 127; return sel * 1024 + h * 128 + d; }
    return np;
}
DI void rmsnorm_row_bf16(const float* xrow, const float* w, bf16* orow, int lane) {
    const f32x4* xr = (const f32x4*)xrow + lane; const f32x4* wr4 = (const f32x4*)w + lane;
    f32x4 v[4]; float s = 0.f;
#pragma unroll
    for (int j = 0; j < 4; ++j) { v[j] = xr[64 * j]; s += (v[j][0] * v[j][0] + v[j][1] * v[j][1]) + (v[j][2] * v[j][2] + v[j][3] * v[j][3]); }
    const float rs = rsqrtf(wave_sum(s) * (1.f / 1024.f) + EPS);
    u32x2* o8 = (u32x2*)orow + lane;
#pragma unroll
    for (int j = 0; j < 4; ++j) { const f32x4 ww = wr4[64 * j]; u32x2 o; o.x = pk2(v[j][0] * rs * ww[0], v[j][1] * rs * ww[1]); o.y = pk2(v[j][2] * rs * ww[2], v[j][3] * rs * ww[3]); o8[64 * j] = o; }
}
DI void transpose_item_q8(const float* W, int N, unsigned char* WT8, const LAS float* cmax, int n_src0, int n_dst0, int k0, LAS float* scr, int lane) {
#pragma unroll 16
    for (int i = 0; i < 32; ++i) { const int kk = 2 * i + (lane >> 5); scr[kk * 33 + (lane & 31)] = W[(size_t)(k0 + kk) * N + n_src0 + (lane & 31)]; }
    asm volatile("s_waitcnt lgkmcnt(0)" ::: "memory");
    const int c = lane & 3;
#pragma unroll
    for (int j = 0; j < 2; ++j) {
        const int n = (lane >> 2) + 16 * j;
        const float am = cmax[n], inv = am > 0.f ? 127.f / am : 0.f;
        const LAS float* s = scr + (16 * c) * 33 + n;
        u32x4 o;
#pragma unroll
        for (int g = 0; g < 4; ++g) { unsigned pk = 0u;
#pragma unroll
            for (int e2 = 0; e2 < 4; ++e2) pk |= ((unsigned)((int)rintf(s[(4 * g + e2) * 33] * inv)) & 0xffu) << (8 * e2);
            o[g] = pk; }
        *(u32x4*)(WT8 + (size_t)(n_dst0 + n) * 1024 + k0 + 16 * c) = o;
    }
    asm volatile("s_waitcnt lgkmcnt(0)" ::: "memory");
}
DI void rmsnorm_rows_q8(const float* __restrict__ x, const float* __restrict__ w, unsigned char* __restrict__ HN8, float* __restrict__ SA, int gw, int ngw, int lane) {
    for (int m0 = gw; m0 < T; m0 += 2 * ngw) {
        const int mb = m0 + ngw, m1 = mb < T ? mb : m0;
        f32x4 v[2][4];
#pragma unroll
        for (int rr = 0; rr < 2; ++rr) { const f32x4* xr = (const f32x4*)(x + (size_t)(rr ? m1 : m0) * 1024) + lane;
#pragma unroll
            for (int j = 0; j < 4; ++j) v[rr][j] = xr[64 * j]; }
        const f32x4* wr4 = (const f32x4*)w + lane;
#pragma unroll
        for (int rr = 0; rr < 2; ++rr) {
            float s = 0.f;
#pragma unroll
            for (int j = 0; j < 4; ++j) s += (v[rr][j][0] * v[rr][j][0] + v[rr][j][1] * v[rr][j][1]) + (v[rr][j][2] * v[rr][j][2] + v[rr][j][3] * v[rr][j][3]);
            const float rs = rsqrtf(wave_sum(s) * (1.f / 1024.f) + EPS);
            float am = 0.f;
#pragma unroll
            for (int j = 0; j < 4; ++j) { const f32x4 ww = wr4[64 * j];
#pragma unroll
                for (int e2 = 0; e2 < 4; ++e2) { v[rr][j][e2] = v[rr][j][e2] * rs * ww[e2]; am = fmaxf(am, fabsf(v[rr][j][e2])); } }
#pragma unroll
            for (int o = 1; o < 64; o <<= 1) am = fmaxf(am, __shfl_xor(am, o));
            const float inv = am > 0.f ? 127.f / am : 0.f;
            if (rr == 0 || mb < T) {
                const int m = rr ? m1 : m0;
                unsigned* o4 = (unsigned*)(HN8 + (size_t)m * 1024) + lane;
#pragma unroll
                for (int j = 0; j < 4; ++j) { unsigned pk = 0u;
#pragma unroll
                    for (int e2 = 0; e2 < 4; ++e2) pk |= ((unsigned)((int)rintf(v[rr][j][e2] * inv)) & 0xffu) << (8 * e2);
                    o4[64 * j] = pk; }
                if (lane == 0) SA[m] = am * (1.f / 127.f);
            }
        }
    }
}
DI void convert_bf16(const float* src, bf16* dst, size_t n, size_t gtid, size_t gsz) {
    for (size_t i = gtid * 8; i < n; i += gsz * 8) {
        const f32x4 a = *(const f32x4*)(src + i), b = *(const f32x4*)(src + i + 4);
        *(u32x4*)(dst + i) = pack8(a, b);
    }
}

#define XB_TMO      128
#define XB_XCNT(j)  (256  + 64 * (j))
#define XB_XSUB(j)  (1280 + 64 * (j))
#define XB_XGEN(j)  (2304 + 64 * (j))
#define XB_TOP      3328
#define XB_TOPGEN   3392
#define XCD_BAR_WORDS 3456
#define XB_SPIN_CAP (1u << 18)

__device__ __forceinline__ unsigned xb_ld(unsigned* p)              { return __hip_atomic_load(p, __ATOMIC_RELAXED, __HIP_MEMORY_SCOPE_AGENT); }
__device__ __forceinline__ unsigned xb_add(unsigned* p, unsigned v) { return __hip_atomic_fetch_add(p, v, __ATOMIC_RELAXED, __HIP_MEMORY_SCOPE_AGENT); }
__device__ __forceinline__ unsigned xb_xcc_id() { return (unsigned)__builtin_amdgcn_s_getreg((3 << 11) | 20) & 0xFu; }
#define XB_SPIN(cond, bar) do { unsigned _sp = 0; while (cond) { __builtin_amdgcn_s_sleep(1); \
    if ((++_sp & 255u) == 0u) { if (xb_ld(&(bar)[XB_TMO])) break; if (_sp > XB_SPIN_CAP) { atomicAdd(&(bar)[XB_TMO], 1u); break; } } } } while (0)

struct XcdBarrier {
    unsigned* bar; unsigned x;
    volatile LAS unsigned* st;
};

__device__ __forceinline__ XcdBarrier xcd_barrier_post(unsigned* bar, volatile LAS unsigned* st) {
    XcdBarrier b; b.bar = bar; b.x = xb_xcc_id(); b.st = st;
    if (threadIdx.x == 0) (void)xb_add(&bar[XB_XCNT(b.x)], 1u);
    return b;
}
__device__ __forceinline__ void xcd_barrier_complete(unsigned* bar, unsigned x, unsigned& nloc, unsigned& nx) {
    const unsigned G = gridDim.x * gridDim.y * gridDim.z;
    unsigned sum, cnt, mine, sp = 0u;
    for (;;) {
        sum = 0u; cnt = 0u; mine = 0u;
#pragma unroll
        for (unsigned j = 0; j < 16; ++j) { const unsigned c = xb_ld(&bar[XB_XCNT(j)]); sum += c; cnt += (c > 0u) ? 1u : 0u; mine = (j == x) ? c : mine; }
        if (sum == G) break;
        __builtin_amdgcn_s_sleep(1);
        if ((++sp & 255u) == 0u) { if (xb_ld(&bar[XB_TMO])) break; if (sp > XB_SPIN_CAP) { atomicAdd(&bar[XB_TMO], 1u); break; } }
    }
    nloc = mine > 0u ? mine : 1u; nx = cnt > 0u ? cnt : 1u;
}

__device__ __forceinline__ void xcd_barrier(const XcdBarrier& b) {
    asm volatile("s_waitcnt vmcnt(0)" ::: "memory");
    __syncthreads();
    if (threadIdx.x == 0) {
        unsigned* bar = b.bar;
        __builtin_amdgcn_s_waitcnt(0);
        unsigned nloc = b.st[0], nx = b.st[1];
        if (nloc == 0u) { xcd_barrier_complete(bar, b.x, nloc, nx); b.st[0] = nloc; b.st[1] = nx; }
        const unsigned old = xb_add(&bar[XB_XSUB(b.x)], 1u);
        const unsigned gen = old / nloc;
        if (old + 1u == (gen + 1u) * nloc) {
            __builtin_amdgcn_fence(__ATOMIC_RELEASE, "agent");
            asm volatile("s_waitcnt vmcnt(0)" ::: "memory");
            const unsigned og = xb_add(&bar[XB_TOP], 1u);
            const unsigned tg = og / nx;
            if (og + 1u == (tg + 1u) * nx) xb_add(&bar[XB_TOPGEN], 1u);
            else XB_SPIN(xb_ld(&bar[XB_TOPGEN]) == tg, bar);
            __builtin_amdgcn_fence(__ATOMIC_ACQUIRE, "agent");
            xb_add(&bar[XB_XGEN(b.x)], 1u);
            asm volatile("s_waitcnt vmcnt(0)" ::: "memory");
        } else {
            XB_SPIN(xb_ld(&bar[XB_XGEN(b.x)]) == gen, bar);
            __builtin_amdgcn_fence(__ATOMIC_ACQUIRE, "agent");
            asm volatile("s_waitcnt vmcnt(0)" ::: "memory");
        }
    }
    __syncthreads();
}

struct Params { const float* in[14]; float* out; unsigned char* ws; };

__global__ void __launch_bounds__(NTHREADS, 2) fwd_megakernel(Params p) {
    extern __shared__ __attribute__((aligned(16))) unsigned char lds_raw[];
    LAS unsigned char* lds = (LAS unsigned char*)lds_raw;
    cg::grid_group grid = cg::this_grid();
    volatile LAS unsigned* bst = (volatile LAS unsigned*)(lds + LDS_BYTES - 64);
    if (threadIdx.x < 4) bst[threadIdx.x] = 0u;
    __syncthreads();
    XcdBarrier xbar = xcd_barrier_post((unsigned*)(p.ws + WS_CTL), bst);
    if (threadIdx.x == 0) bst[4] = xb_add((unsigned*)(p.ws + WS_CTL) + 3600 + xbar.x, 1u);
#if USE_CG_SYNC
#define GRID_SYNC() grid.sync()
#else
#define GRID_SYNC() xcd_barrier(xbar)
#endif
    const int G = gridDim.x, wg = blockIdx.x;
#define PHASE_IDS const int tid = fresh_tid(), lane = tid & 63, wave = __builtin_amdgcn_readfirstlane(tid >> 6); \
    const int gw = wg * NWAVES + wave, ngw = G * NWAVES; const size_t gtid = (size_t)wg * NTHREADS + tid, gsz = (size_t)G * NTHREADS; \
    (void)lane; (void)gw; (void)ngw; (void)gtid; (void)gsz;
    unsigned char* ws = p.ws;
    const float* x = p.in[0];
    unsigned char* HN8 = ws + WS_HN; unsigned char* WinT8 = ws + WS_WINT; float* SA = (float*)(ws + WS_SA); float* SB = (float*)(ws + WS_SB);

    float* COS = (float*)(ws + WS_ROPE); float* SIN = COS + 8192 * 128;
    float* DEC = (float*)(ws + WS_DEC); float* SSQP = (float*)(ws + WS_SSQP); float* SSQX = (float*)(ws + WS_SSQX);
    bf16* BA = (bf16*)(ws + WS_A); bf16* BB = (bf16*)(ws + WS_B); bf16* BC = (bf16*)(ws + WS_C);
    bf16* STh = (bf16*)(ws + WS_STH); bf16* STr = (bf16*)(ws + WS_STR);
    bf16* OHG = (bf16*)(ws + WS_OHG); bf16* ORET = (bf16*)p.out;
    bf16* GA = (bf16*)(ws + WS_GA); bf16* GB = (bf16*)(ws + WS_GB);
    bf16* WhgT = (bf16*)(ws + WS_WHG); bf16* WretT = (bf16*)(ws + WS_WRET); bf16* WoutT = (bf16*)(ws + WS_WOUT); bf16* WqT = (bf16*)(ws + WS_WQ); bf16* SK = (bf16*)(ws + WS_SK);
    unsigned char* EV8 = ws + WS_EV; unsigned char* EU8 = ws + WS_EU; float* SU = (float*)(ws + WS_SCL); float* SV = SU + PE_NE;
    float* M1 = (float*)(ws + WS_M1); bf16* MERGED = (bf16*)(ws + WS_MERGED);
    float* X1 = (float*)(ws + WS_X1); bf16* XW = (bf16*)(ws + WS_XW); bf16* Qp = (bf16*)p.out;
    unsigned char* XQ8 = ws + WS_XQ8; float* XS = (float*)(ws + WS_XS); int* PART = (int*)(ws + WS_PART); unsigned char* WQ8 = ws + WS_WT; float* WSC = (float*)(ws + WS_WT + 4 * MiB);
    int* EIDX = (int*)(ws + WS_EIDX); float* EGATE = (float*)(ws + WS_EGATE);

    for (int rep_ = 0; rep_ < ((PROBE_MASK & 32) ? 2 : 1); ++rep_) {
    { PHASE_IDS LAS float* scr = (LAS float*)(lds + wave * 16384);
    LAS float* amx = (LAS float*)(lds + 131072); LAS float* cm = amx + 512;
    for (int strip = wg; strip < 192; strip += G) {
        const int nd0 = strip * 64, ns0 = win_orig_col(nd0);
        const float* wp = p.in[2] + (size_t)(wave * 128) * 12288 + ns0 + lane;
        float am = 0.f;
#pragma unroll 16
        for (int k = 0; k < 128; ++k) am = fmaxf(am, fabsf(wp[(size_t)k * 12288]));
        amx[wave * 64 + lane] = am;
        __syncthreads();
        if (tid < 64) { float m8 = 0.f;
#pragma unroll
            for (int w8 = 0; w8 < 8; ++w8) m8 = fmaxf(m8, amx[w8 * 64 + tid]);
            cm[tid] = m8; SB[nd0 + tid] = m8 * (1.f / 127.f); }
        __syncthreads();
#pragma unroll 1
        for (int q4 = 0; q4 < 4; ++q4) {
            const int kb = 2 * wave + (q4 >> 1), hf = q4 & 1;
            transpose_item_q8(p.in[2], 12288, WinT8, cm + hf * 32, ns0 + hf * 32, nd0 + hf * 32, kb * 64, scr, lane);
        }
        __syncthreads();
    }
    rmsnorm_rows_q8(x, p.in[1], HN8, SA, gw, ngw, lane);
    }
    __syncthreads(); }
    grid.sync();

    for (int rep_ = 0; rep_ < ((PROBE_MASK & 128) ? 2 : 1); ++rep_) {
    {
        pg8::Gemm g{(const bf16*)HN8, (const bf16*)WinT8, T, 4096, 512}; pg8::StaticOrder S; S.init(T, 4096, G, wg);
        EpiH E{BA, BB, BC, DEC, p.in[3], OHG, SA, SB};
        pg8::gemm_phase<EpiH, pg8::StaticOrder, true, true, true>(lds, g, S, E);
    }
    __syncthreads(); }
    GRID_SYNC();
    hg_pass1(lds, BB, BC, STh, wg, G);
#if PROBE_MASK & 4
    hg_pass1(lds, BB, BC, STh, wg, G);
#endif
    GRID_SYNC();
    { PHASE_IDS hg_scan(STh, DEC, (int)gtid, (int)gsz); }
    GRID_SYNC();
#if PROBE_MASK & 16384
    hg_pass1(lds, BB, BC, STh, wg, G);
    GRID_SYNC();
    { PHASE_IDS hg_scan(STh, DEC, (int)gtid, (int)gsz); }
    GRID_SYNC();
#endif
#if PROBE_MASK & 4
    { PHASE_IDS hg_pass3(lds, BA, BB, BC, STh, p.in[4], OHG, gw, ngw, 1); }
#endif
    { PHASE_IDS hg_pass3(lds, BA, BB, BC, STh, p.in[4], OHG, gw, ngw, 0); }
    GRID_SYNC();

    for (int rep_ = 0; rep_ < ((PROBE_MASK & 2048) ? 2 : 1); ++rep_) {
    {
        pg8::Gemm g{(const bf16*)HN8, (const bf16*)(WinT8 + (size_t)4096 * 1024), T, 6144, 512}; pg8::StaticOrder S; S.init(T, 6144, G, wg);
        EpiR E{BA, BB, BC, COS, SIN, ORET, SA, SB + 4096};
        pg8::gemm_phase<EpiR, pg8::StaticOrder, true, true, true>(lds, g, S, E);
    }
    __syncthreads(); }
    GRID_SYNC();
    rt_pass1(lds, BB, BC, STr, wg, G);
#if PROBE_MASK & 8
    rt_pass1(lds, BB, BC, STr, wg, G);
#endif
    GRID_SYNC();
    { PHASE_IDS rt_scan(STr, (int)gtid, (int)gsz); }
    GRID_SYNC();
#if PROBE_MASK & 32768
    rt_pass1(lds, BB, BC, STr, wg, G);
    GRID_SYNC();
    { PHASE_IDS rt_scan(STr, (int)gtid, (int)gsz); }
    GRID_SYNC();
#endif
#if PROBE_MASK & 1024
    rt_pass3_wg(lds, BA, BB, BC, STr, ORET, SSQP, wg, G, 1);
#endif
    rt_pass3_wg(lds, BA, BB, BC, STr, ORET, SSQP, wg, G, 0);
    GRID_SYNC();

    for (int rep_ = 0; rep_ < ((PROBE_MASK & 64) ? 2 : 1); ++rep_) {
    { PHASE_IDS LAS float* scr = (LAS float*)(lds + wave * 16384);
    for (int it = gw; it < 3072; it += ngw) {
        int r = it;
        if (r < 512) { transpose_item(p.in[5], 1024, 1024, WhgT, (r % 32) * 32, (r % 32) * 32, (r / 32) * 64, scr, lane); continue; } r -= 512;
        if (r < 1024) { transpose_item(p.in[6], 2048, 1024, WretT, (r % 32) * 32, (r % 32) * 32, (r / 32) * 64, scr, lane); continue; } r -= 1024;
        if (r < 512) { transpose_item(p.in[7], 1024, 1024, WoutT, (r % 32) * 32, (r % 32) * 32, (r / 32) * 64, scr, lane); continue; } r -= 512;
        transpose_item(p.in[9], 1024, 2048, WqT, (r % 64) * 32, (r % 64) * 32, (r / 64) * 64, scr, lane);
    }
    convert_bf16(p.in[10], SK, (size_t)16 * 128 * 128, gtid, gsz);
    quant_rows(p.in[12], EV8, SV, PE_NE, 0, gw, ngw, lane); }
    __syncthreads(); }
    __syncthreads();
    for (int rep_ = 0; rep_ < ((PROBE_MASK & 65536) ? 2 : 1); ++rep_) {
    {
        pg8::Gemm g{(const bf16*)HN8, (const bf16*)(WinT8 + (size_t)10240 * 1024), T, 2048, 512}; pg8::StaticOrder S; S.init(T, 2048, G, wg);
        EpiG E{GA, GB, SA, SB + 10240};
        pg8::gemm_phase<EpiG, pg8::StaticOrder, true, true, true>(lds, g, S, E);
    }
    __syncthreads(); }
    GRID_SYNC();

    for (int rep_ = 0; rep_ < ((PROBE_MASK & 256) ? 2 : 1); ++rep_) {
    for (int rep2_ = 0; rep2_ < ((PROBE_MASK & 262144) ? 2 : 1); ++rep2_) {
    {
        pg8::Gemm g{OHG, WhgT, T, 1024, 1024}; pg8::StaticOrder S; S.init(T, 1024, G, wg);
        EpiM1 E{MERGED, GA};
        pg8::gemm_phase<EpiM1, pg8::StaticOrder, false, true>(lds, g, S, E);
    }
    __syncthreads(); }
    __syncthreads();
    {
        pg8::Gemm g{ORET, WretT, T, 1024, 2048}; pg8::StaticOrder S; S.init(T, 1024, G, wg);
        EpiMerge E{GB, MERGED};
        pg8::gemm_phase<EpiMerge, pg8::StaticOrder, false, true>(lds, g, S, E);
    }
    __syncthreads(); }
    GRID_SYNC();
    for (int rep_ = 0; rep_ < ((PROBE_MASK & 4096) ? 2 : 1); ++rep_) {
    {
        pg8::Gemm g{MERGED, WoutT, T, 1024, 1024}; pg8::StaticOrder S; S.init(T, 1024, G, wg);
        EpiOut E{x, X1, XW, p.in[8], SSQX};
        pg8::gemm_phase<EpiOut, pg8::StaticOrder, false, true>(lds, g, S, E);
    }
    __syncthreads(); }
    GRID_SYNC();
    for (int rep_ = 0; rep_ < ((PROBE_MASK & 64) ? 2 : 1); ++rep_) {
    { PHASE_IDS quant_rows(p.in[11], EU8, SU, PE_NE, 0, gw, ngw, lane); }
    __syncthreads(); }
    __syncthreads();
    for (int rep_ = 0; rep_ < ((PROBE_MASK & 8192) ? 2 : 1); ++rep_) {
    {
        pg8::Gemm g{XW, WqT, T, 2048, 1024}; pg8::StaticOrder S; S.init(T, 2048, G, wg);
        EpiQ E{Qp, SSQX};
        pg8::gemm_phase<EpiQ, pg8::StaticOrder, true, true>(lds, g, S, E);
    }
    __syncthreads(); }
    GRID_SYNC();
    { PHASE_IDS peer_retrieve(lds, Qp, SK, EIDX, EGATE, wg, G); quant_xw(XW, XQ8, XS, gw, ngw, lane); }
#if PROBE_MASK & 2
    { PHASE_IDS peer_retrieve(lds, Qp, SK, EIDX, EGATE, wg, G); quant_xw(XW, XQ8, XS, gw, ngw, lane); }
#endif
    GRID_SYNC();
    if (threadIdx.x == 0) {
        unsigned k = 0, n = 0, mine = 1;
        for (unsigned j = 0; j < 16; ++j) { const unsigned c = xb_ld((unsigned*)(p.ws + WS_CTL) + XB_XCNT(j)); if (c) { if (j < xbar.x) ++k; ++n; } if (j == xbar.x) mine = c ? c : 1; }
        bst[5] = k; bst[6] = n ? n : 1; bst[7] = mine;
    }
    __syncthreads();
    const int xrank = (int)bst[4], xk = (int)bst[5], xn = (int)bst[6], xloc = (int)bst[7];
    for (int rep_ = 0; rep_ < ((PROBE_MASK & 1) ? 2 : 1); ++rep_) {
    { PHASE_IDS for (int s = xk; s < 8; s += xn) peer_u(EU8, XQ8, EIDX, PART, s, xrank * NWAVES + wave, xloc * NWAVES, lane); }
    GRID_SYNC(); }
    { PHASE_IDS peer_w(PART, EIDX, EGATE, SU, SV, XS, SSQX, WQ8, WSC, gw, ngw, lane); }
    GRID_SYNC();
#if PROBE_MASK & 131072
    { PHASE_IDS for (int s = xk; s < 8; s += xn) peer_v(EV8, EIDX, WQ8, WSC, X1, s, xrank * NWAVES + wave, xloc * NWAVES, lane, 1); }
    GRID_SYNC();
#endif
    { PHASE_IDS for (int s = xk; s < 8; s += xn) peer_v(EV8, EIDX, WQ8, WSC, X1, s, xrank * NWAVES + wave, xloc * NWAVES, lane, 0); }
    GRID_SYNC();
    { PHASE_IDS final_norm(X1, p.in[13], p.out, gw, ngw, lane); }
#if PROBE_MASK & 16
    for (int i = 0; i < 15; ++i) GRID_SYNC();
#endif
}

extern "C" void kernel_launch(void* const* d_in, const int* in_sizes, int n_in, void* d_out, int out_size, void* d_ws, size_t ws_size, hipStream_t stream) {
    static int grid_blocks = 0;
    if (!grid_blocks) {
        int dev = 0, cus = 0, per_cu = 0;
        (void)hipGetDevice(&dev);
        (void)hipDeviceGetAttribute(&cus, hipDeviceAttributeMultiprocessorCount, dev);
        (void)hipFuncSetAttribute((const void*)fwd_megakernel, hipFuncAttributeMaxDynamicSharedMemorySize, LDS_BYTES);
        (void)hipOccupancyMaxActiveBlocksPerMultiprocessor(&per_cu, (const void*)fwd_megakernel, NTHREADS, LDS_BYTES);
        if (per_cu < 1) per_cu = 1;
        grid_blocks = cus * 1;
        if (ws_size < WS_END || n_in != 14) { fprintf(stderr, "kernel_launch: unexpected ws_size %zu (need %zu) or n_in %d\n", ws_size, (size_t)WS_END, n_in); }
    }
    (void)hipMemsetAsync((char*)d_ws + WS_CTL, 0, 32768, stream);
    Params p{};
    for (int i = 0; i < 14; ++i) p.in[i] = (const float*)d_in[i];
    p.out = (float*)d_out; p.ws = (unsigned char*)d_ws;
    void* args[] = {&p};
    hipError_t e = hipLaunchCooperativeKernel((const void*)fwd_megakernel, dim3(grid_blocks), dim3(NTHREADS), args, LDS_BYTES, stream);
    if (e != hipSuccess) fprintf(stderr, "cooperative launch failed: %s (grid %d)\n", hipGetErrorString(e), grid_blocks);
}
```

```cpp
#include <hip/hip_runtime.h>
#include <hip/hip_cooperative_groups.h>
#include <cstdio>
#include <cstdint>
namespace cg = cooperative_groups;
#ifndef USE_CG_SYNC
#define USE_CG_SYNC 0
#endif
#ifndef USE_WT_STORES
#define USE_WT_STORES 0
#endif
#ifndef STAMP_K
#define STAMP_K -1
#endif
#ifndef PROBE_MASK
#define PROBE_MASK 0
#endif

#define DI __device__ __forceinline__
#define LAS __attribute__((address_space(3)))
typedef unsigned short bf16;
typedef float f32x4 __attribute__((ext_vector_type(4)));
typedef float f32x2 __attribute__((ext_vector_type(2)));
typedef float f32x16 __attribute__((ext_vector_type(16)));
typedef short bf16x8 __attribute__((ext_vector_type(8)));
typedef short s16x4 __attribute__((ext_vector_type(4)));
typedef unsigned u32x4 __attribute__((ext_vector_type(4)));
typedef unsigned u32x2 __attribute__((ext_vector_type(2)));
typedef __bf16 nbf16x2 __attribute__((ext_vector_type(2)));

constexpr int D = 1024, NB = 2, SEQ = 8192, T = NB * SEQ;
constexpr int HG_H = 8, HG_DK = 128, HG_DV = 128, HG_C = 64, HG_NC = SEQ / HG_C;
constexpr int RT_H = 4, RT_DK = 256, RT_DV = 512, RT_L = 512, RT_NS = SEQ / RT_L;
constexpr int PE_H = 8, PE_NK = 128, PE_K = 16, PE_Q = 256, PE_HALF = 128, PE_NE = PE_NK * PE_NK;
constexpr float EPS = 1e-6f;
constexpr int NTHREADS = 512, NWAVES = 8;
constexpr int LDS_BYTES = 147456;

constexpr size_t MiB = 1u << 20;
constexpr size_t WS_CTL = 0;
constexpr size_t WS_DEC = 1 * MiB;
constexpr size_t WS_SSQP = 2 * MiB;
constexpr size_t WS_SCL = 2 * MiB + 512 * 1024;
constexpr size_t WS_SSQX = 3 * MiB;
constexpr size_t WS_HN = 4 * MiB;
constexpr size_t WS_WINT = 36 * MiB;
constexpr size_t WS_ROPE = 60 * MiB;
constexpr size_t WS_A = 68 * MiB, WS_B = 100 * MiB, WS_C = 132 * MiB;
constexpr size_t WS_STH = 164 * MiB;
constexpr size_t WS_STR = 196 * MiB;
constexpr size_t WS_OHG = 228 * MiB;
constexpr size_t WS_GA = 68 * MiB, WS_GB = 100 * MiB;
constexpr size_t WS_W2 = 132 * MiB;
constexpr size_t WS_WHG = WS_W2, WS_WRET = WS_W2 + 2 * MiB, WS_WOUT = WS_W2 + 6 * MiB, WS_WQ = WS_W2 + 8 * MiB, WS_SK = WS_W2 + 12 * MiB;
constexpr size_t WS_EV = 145 * MiB;
constexpr size_t WS_MERGED = 177 * MiB;
constexpr size_t WS_EU = 209 * MiB;
constexpr size_t WS_M1 = 4 * MiB;
constexpr size_t WS_X1 = 4 * MiB;
constexpr size_t WS_XW = 68 * MiB;
constexpr size_t WS_TOPS = 100 * MiB, WS_TOPI = 116 * MiB;
constexpr size_t WS_EIDX = 177 * MiB, WS_EGATE = 185 * MiB;
constexpr size_t WS_SA = WS_SCL + 192 * 1024;
constexpr size_t WS_SB = WS_SCL + 256 * 1024;
constexpr size_t CTL_AMAX = 65536;
constexpr size_t CTL_BYTES = 131072;
constexpr size_t WS_XQ8 = 161 * MiB;
constexpr size_t WS_XS = WS_SCL + 128 * 1024;
constexpr size_t WS_PART = 68 * MiB;
constexpr size_t WS_WT = 193 * MiB;
constexpr size_t WS_END = 260 * MiB;

DI int fresh_tid() { int t = threadIdx.x; asm volatile("" : "+v"(t)); return t; }
DI float sigmoidf_(float x) { return 1.f / (1.f + __expf(-x)); }
DI float siluf_(float x) { return x / (1.f + __expf(-x)); }
DI unsigned pk2(float lo, float hi) { f32x2 v = {lo, hi}; nbf16x2 b = __builtin_convertvector(v, nbf16x2); return __builtin_bit_cast(unsigned, b); }
DI bf16 f2bf(float f) { return (bf16)(pk2(f, 0.f) & 0xffffu); }
DI float bf2f(bf16 b) { return __uint_as_float(((unsigned)b) << 16); }
DI float bflo(unsigned u) { return __uint_as_float(u << 16); }
DI float bfhi(unsigned u) { return __uint_as_float(u & 0xffff0000u); }
DI float wave_sum(float v) {
#pragma unroll
    for (int o = 1; o < 64; o <<= 1) v += __shfl_xor(v, o);
    return v;
}
DI int crow(int reg, int h) { return (reg & 3) + 8 * (reg >> 2) + 4 * h; }

namespace pg8 {
#define PG8_LAS __attribute__((address_space(3)))
typedef unsigned short bf16_t;
typedef short bf16x8 __attribute__((ext_vector_type(8)));
typedef float f32x4 __attribute__((ext_vector_type(4)));
typedef unsigned u32x4 __attribute__((ext_vector_type(4)));
constexpr int BM = 256, BK = 64, HALF = 128, HTB = HALF * BK * 2  , STAGE_BYTES = 8 * HTB, NXCD = 8, WGM = 8;

__host__ __device__ __forceinline__ int lds_byte(int r, int c) { const int st = (r >> 4) * 2 + (c >> 5), rr = r & 15, cc = c & 31, ob = rr * 64 + cc * 2; return st * 1024 + (ob ^ (((ob >> 9) & 1) << 5)); }
__host__ __device__ __forceinline__ void stage_rc(int b, int& R, int& C) { const int st = b / 1024, sb = b % 1024, swz = sb ^ (((sb >> 9) & 1) << 5); R = (st >> 1) * 16 + swz / 64; C = (st & 1) * 32 + (swz % 64) / 2; }
__host__ __device__ __forceinline__ int perm32(int rho) { const int n = rho >> 4, i = rho & 15; return 8 * (i >> 2) + 4 * n + (i & 3); }

struct Unit { int pm, pn; };
struct Gemm { const bf16_t* A; const bf16_t* Bt; int M, N, K; };

struct StaticOrder {
    int nM, nN, nwg, G, c;
    __host__ __device__ void init(int M, int N, int G_, int c_) { nM = M / BM; nN = N / BM; nwg = nM * nN; G = G_; c = c_; }
    __host__ __device__ bool next(int i, Unit& u) const {
        const long L = (long)i * G + c; if (L >= nwg) return false;
        int wgid = (int)L; { const int q = nwg / NXCD, r = nwg % NXCD, xcd = wgid % NXCD, off = wgid / NXCD; wgid = (xcd < r ? xcd * (q + 1) : r * (q + 1) + (xcd - r) * q) + off; }
        const int nig = WGM * nN, gid = wgid / nig, fm = gid * WGM, gsz = (nM - fm) < WGM ? (nM - fm) : WGM;
        u.pm = fm + ((wgid % nig) % gsz); u.pn = (wgid % nig) / gsz; return true;
    }
    __device__ __forceinline__ void a_ready(const Unit&) const {}
    __device__ __forceinline__ void done(const Unit&) const {}
};

__device__ __forceinline__ unsigned cvt_pk_bf16(float lo, float hi) { unsigned r; asm volatile("v_cvt_pk_bf16_f32 %0, %1, %2" : "=v"(r) : "v"(lo), "v"(hi)); return r; }
typedef float f32x2 __attribute__((ext_vector_type(2)));
typedef int i32x4 __attribute__((ext_vector_type(4)));
template <bool I8> __device__ __forceinline__ f32x4 mma16(const bf16x8& b, const bf16x8& a, const f32x4& c) {
    if constexpr (I8) return __builtin_bit_cast(f32x4, __builtin_amdgcn_mfma_i32_16x16x64_i8(__builtin_bit_cast(i32x4, b), __builtin_bit_cast(i32x4, a), __builtin_bit_cast(i32x4, c), 0, 0, 0));
    else return __builtin_amdgcn_mfma_f32_16x16x32_bf16(b, a, c, 0, 0, 0);
}
template <class Epi, class Sched, bool ALIGN_EPI = false, bool SP2 = false, bool I8 = false>
__device__ __forceinline__ void gemm_phase(PG8_LAS unsigned char* lds, const Gemm g, const Sched& S, const Epi& E) {
    const int tid = fresh_tid(), wid = __builtin_amdgcn_readfirstlane(tid >> 6), lane = tid & 63, wr = wid >> 2, wc = wid & 3, fr = lane & 15, fq = lane >> 4;
    const int K = g.K, nt = K / BK;
    unsigned voffA[2], voffB[2];
#pragma unroll
    for (int i = 0; i < 2; ++i) { int R, C; stage_rc(tid * 16 + i * 8192, R, C); const int Rb = Epi::PERM ? ((R & ~31) + perm32(R & 31)) : R;
        voffA[i] = (unsigned)(R * K + C) * 2u; voffB[i] = (unsigned)(Rb * K + C) * 2u; }
    const size_t kstep = (size_t)(BK * 2);
    const size_t hstep = (size_t)HALF * K * 2;
    const size_t tstep = 2 * hstep;
    const unsigned ldsw = (unsigned)wid * 1024u;
    const int aoff = lds_byte(wr * 64 + fr, fq * 8), boff = lds_byte(wc * 32 + fr, fq * 8);
#define PG8_SA(b, h) (((b) * 2 + (h)) * HTB)
#define PG8_SB(b, h) ((4 + (b) * 2 + (h)) * HTB)
#define PG8_STAGE(bufoff, gbase, voff) do { _Pragma("unroll") for (int _i = 0; _i < 2; ++_i) \
        __builtin_amdgcn_global_load_lds((const unsigned*)((const char*)(gbase) + (voff)[_i]), (PG8_LAS unsigned*)(lds + (bufoff) + ldsw + _i * 8192), 16, 0, 0); } while (0)
#define PG8_LDA(dst, b, h) do { _Pragma("unroll") for (int m = 0; m < 4; ++m) _Pragma("unroll") for (int k = 0; k < 2; ++k) dst[m][k] = *(const PG8_LAS bf16x8*)(lds + PG8_SA(b, h) + aoff + m * 2048 + k * 1024); } while (0)
#define PG8_LDB(dst, b, h) do { _Pragma("unroll") for (int n = 0; n < 2; ++n) _Pragma("unroll") for (int k = 0; k < 2; ++k) dst[n][k] = *(const PG8_LAS bf16x8*)(lds + PG8_SB(b, h) + boff + n * 2048 + k * 1024); } while (0)
#define PG8_MMA(ai, bj, At, Bt) do { __builtin_amdgcn_s_setprio(1); _Pragma("unroll") for (int m = 0; m < 4; ++m) _Pragma("unroll") for (int n = 0; n < 2; ++n) _Pragma("unroll") for (int k = 0; k < 2; ++k) \
        acc[ai][bj][m][n] = mma16<I8>(Bt[n][k], At[m][k], acc[ai][bj][m][n]); __builtin_amdgcn_s_setprio(0); } while (0)
#define PG8_WAIT_V(n) asm volatile("s_waitcnt vmcnt(" #n ")" ::: "memory")
#define PG8_WAIT_L(n) asm volatile("s_waitcnt lgkmcnt(" #n ")" ::: "memory")
#define PG8_BAR __builtin_amdgcn_s_barrier()
#define PG8_SCHED __builtin_amdgcn_sched_barrier(0)
    Unit cur, nxt; int ui = 0;
    if (!S.next(0, cur)) return;
    f32x4 acc[2][2][4][2];
#pragma unroll
    for (int a = 0; a < 2; ++a)
#pragma unroll
        for (int b = 0; b < 2; ++b)
#pragma unroll
            for (int m = 0; m < 4; ++m)
#pragma unroll
                for (int n = 0; n < 2; ++n) acc[a][b][m][n] = (f32x4){0.f, 0.f, 0.f, 0.f};
    bf16x8 At[4][2], B0[2][2], B1[2][2];
    const char* cA = (const char*)g.A + (size_t)cur.pm * tstep; const char* cB = (const char*)g.Bt + (size_t)cur.pn * tstep;
    S.a_ready(cur);
    if constexpr (SP2) {
        PG8_STAGE(PG8_SB(0, 0), cB, voffB); PG8_STAGE(PG8_SB(0, 1), cB + hstep, voffB); PG8_STAGE(PG8_SA(0, 0), cA, voffA); PG8_STAGE(PG8_SA(0, 1), cA + hstep, voffA);
        if (wr == 1) PG8_BAR;
        PG8_WAIT_V(2); PG8_BAR;
        PG8_STAGE(PG8_SB(1, 0), cB + kstep, voffB); PG8_STAGE(PG8_SA(1, 0), cA + kstep, voffA); PG8_STAGE(PG8_SB(1, 1), cB + hstep + kstep, voffB);
        PG8_WAIT_V(6); PG8_BAR;
    } else {
        PG8_STAGE(PG8_SB(0, 0), cB, voffB); PG8_STAGE(PG8_SA(0, 0), cA, voffA); PG8_STAGE(PG8_SB(0, 1), cB + hstep, voffB); PG8_STAGE(PG8_SA(0, 1), cA + hstep, voffA);
        if (wr == 1) PG8_BAR;
        PG8_WAIT_V(4); PG8_BAR;
        PG8_STAGE(PG8_SB(1, 0), cB + kstep, voffB); PG8_STAGE(PG8_SA(1, 0), cA + kstep, voffA); PG8_STAGE(PG8_SB(1, 1), cB + hstep + kstep, voffB);
        PG8_WAIT_V(6); PG8_BAR;
    }
    for (;;) {
        const bool has_next = S.next(ui + 1, nxt);
        const char* nA = has_next ? (const char*)g.A + (size_t)nxt.pm * tstep : cA; const char* nB = has_next ? (const char*)g.Bt + (size_t)nxt.pn * tstep : cB;
        for (int t = 0; t < nt; t += 2) {
            const bool last = (t == nt - 2);
            const char* a1 = cA + (size_t)(t + 1) * kstep;
            const char* a2 = last ? nA : cA + (size_t)(t + 2) * kstep; const char* b2 = last ? nB : cB + (size_t)(t + 2) * kstep;
            const char* a3 = a2 + kstep; const char* b3 = b2 + kstep;
            if (last && has_next) S.a_ready(nxt);
            if constexpr (SP2) {
            PG8_LDB(B0, 0, 0); PG8_LDB(B1, 0, 1); PG8_SCHED; PG8_LDA(At, 0, 0); PG8_STAGE(PG8_SA(1, 1), a1 + hstep, voffA);
            PG8_WAIT_V(8); PG8_WAIT_L(0); PG8_BAR; PG8_MMA(0, 0, At, B0); PG8_MMA(0, 1, At, B1); PG8_BAR; PG8_SCHED;
            PG8_LDA(At, 0, 1); PG8_STAGE(PG8_SB(0, 0), b2, voffB); PG8_STAGE(PG8_SB(0, 1), b2 + hstep, voffB); PG8_STAGE(PG8_SA(0, 0), a2, voffA);
            PG8_WAIT_V(8); PG8_WAIT_L(0); PG8_BAR; PG8_MMA(1, 0, At, B0); PG8_MMA(1, 1, At, B1); PG8_BAR; PG8_SCHED;
            PG8_LDB(B0, 1, 0); PG8_LDB(B1, 1, 1); PG8_SCHED; PG8_LDA(At, 1, 0); PG8_STAGE(PG8_SA(0, 1), a2 + hstep, voffA);
            PG8_WAIT_V(8); PG8_WAIT_L(0); PG8_BAR; PG8_MMA(0, 0, At, B0); PG8_MMA(0, 1, At, B1); PG8_BAR; PG8_SCHED;
            PG8_LDA(At, 1, 1); PG8_STAGE(PG8_SB(1, 0), b3, voffB); PG8_STAGE(PG8_SB(1, 1), b3 + hstep, voffB); PG8_STAGE(PG8_SA(1, 0), a3, voffA);
            PG8_WAIT_V(8); PG8_WAIT_L(0); PG8_BAR; PG8_MMA(1, 0, At, B0); PG8_MMA(1, 1, At, B1); PG8_BAR; PG8_SCHED;
            } else {
            PG8_LDB(B0, 0, 0); PG8_SCHED; PG8_LDA(At, 0, 0); PG8_STAGE(PG8_SA(1, 1), a1 + hstep, voffA);
            PG8_WAIT_L(8); PG8_BAR; PG8_WAIT_L(0); PG8_MMA(0, 0, At, B0); PG8_BAR; PG8_SCHED;
            PG8_LDB(B1, 0, 1); PG8_STAGE(PG8_SB(0, 0), b2, voffB);
            PG8_BAR; PG8_WAIT_L(0); PG8_MMA(0, 1, At, B1); PG8_BAR;
            PG8_LDA(At, 0, 1); PG8_STAGE(PG8_SA(0, 0), a2, voffA);
            PG8_BAR; PG8_WAIT_L(0); PG8_MMA(1, 0, At, B0); PG8_BAR; PG8_SCHED;
            PG8_STAGE(PG8_SB(0, 1), b2 + hstep, voffB);
            PG8_WAIT_V(6); PG8_BAR; PG8_MMA(1, 1, At, B1); PG8_BAR;
            PG8_LDB(B0, 1, 0); PG8_SCHED; PG8_LDA(At, 1, 0); PG8_STAGE(PG8_SA(0, 1), a2 + hstep, voffA);
            PG8_WAIT_L(8); PG8_BAR; PG8_WAIT_L(0); PG8_MMA(0, 0, At, B0); PG8_BAR; PG8_SCHED;
            PG8_LDB(B1, 1, 1); PG8_STAGE(PG8_SB(1, 0), b3, voffB);
            PG8_BAR; PG8_WAIT_L(0); PG8_MMA(0, 1, At, B1); PG8_BAR;
            PG8_LDA(At, 1, 1); PG8_STAGE(PG8_SA(1, 0), a3, voffA);
            PG8_BAR; PG8_WAIT_L(0); PG8_MMA(1, 0, At, B0); PG8_BAR; PG8_SCHED;
            PG8_STAGE(PG8_SB(1, 1), b3 + hstep, voffB);
            PG8_WAIT_V(6); PG8_BAR; PG8_MMA(1, 1, At, B1); PG8_BAR;
            }
        }
        if constexpr (ALIGN_EPI) { if (wr == 0) PG8_BAR; }
        if constexpr (!Epi::AFTER_DRAIN) { E(acc, cur, wr, wc, fr, fq); S.done(cur); }
        if (!has_next) break;
#pragma unroll
        for (int a = 0; a < 2; ++a)
#pragma unroll
            for (int b = 0; b < 2; ++b)
#pragma unroll
                for (int m = 0; m < 4; ++m)
#pragma unroll
                    for (int n = 0; n < 2; ++n) acc[a][b][m][n] = (f32x4){0.f, 0.f, 0.f, 0.f};
        cur = nxt; cA = nA; cB = nB; ++ui;
        if constexpr (ALIGN_EPI) { if (wr == 1) PG8_BAR; }
    }
    PG8_WAIT_V(0);
    if constexpr (!ALIGN_EPI) { if (wr == 0) PG8_BAR; }
    PG8_BAR;
    if constexpr (Epi::AFTER_DRAIN) { E.fused(acc, cur, wr, wc, fr, fq, lds, wid, lane); S.done(cur); }
#undef PG8_SA
#undef PG8_SB
#undef PG8_STAGE
#undef PG8_LDA
#undef PG8_LDB
#undef PG8_MMA
#undef PG8_WAIT_V
#undef PG8_WAIT_L
#undef PG8_BAR
#undef PG8_SCHED
}
}

using pg8::Unit;
typedef f32x4 Acc[2][2][4][2];

DI u32x4 pack8(const f32x4& a, const f32x4& b) { u32x4 w; w.x = pk2(a[0], a[1]); w.y = pk2(a[2], a[3]); w.z = pk2(b[0], b[1]); w.w = pk2(b[2], b[3]); return w; }

DI void st16_wt(void* p, const u32x4& v) {
#if USE_WT_STORES
    asm volatile("global_store_dwordx4 %0, %1, off sc1\n\ts_nop 1" :: "v"(p), "v"(v) : "memory");
#else
    *(u32x4*)p = v;
#endif
}
DI void dequant_acc(Acc& acc, const Unit& u, int wr, int wc, int fr, int fq, const float* SA, const float* SB) {
    f32x4 sb[2][2];
#pragma unroll
    for (int bj = 0; bj < 2; ++bj)
#pragma unroll
        for (int n = 0; n < 2; ++n) sb[bj][n] = *(const f32x4*)(SB + u.pn * 256 + bj * 128 + wc * 32 + 8 * fq + 4 * n);
#pragma unroll
    for (int ai = 0; ai < 2; ++ai)
#pragma unroll
        for (int m = 0; m < 4; ++m) {
            const float sa = SA[u.pm * 256 + ai * 128 + wr * 64 + m * 16 + fr];
#pragma unroll
            for (int bj = 0; bj < 2; ++bj)
#pragma unroll
                for (int n = 0; n < 2; ++n)
#pragma unroll
                    for (int e = 0; e < 4; ++e) acc[ai][bj][m][n][e] = (float)__float_as_int(acc[ai][bj][m][n][e]) * sa * sb[bj][n][e];
        }
}

template <int CTRL, bool ZERO> DI float dppf(float v) { return __int_as_float(__builtin_amdgcn_update_dpp(0, __float_as_int(v), CTRL, 0xF, 0xF, ZERO)); }

struct EpiH {
    static constexpr bool PERM = true, AFTER_DRAIN = false;
    bf16* Qh; bf16* Kh; bf16* VTh; float* DEC; const float* hlb; bf16* OHG; const float* SA; const float* SB;
    DI void operator()(Acc& acc, const Unit& u, int wr, int wc, int fr, int fq) const {
        dequant_acc(acc, u, wr, wc, fr, fq, SA, SB);
        if (u.pn < 8) {
            const int h = u.pn, dbase = wc * 32 + 8 * fq;
#pragma unroll
            for (int ai = 0; ai < 2; ++ai) {
                const int row0 = u.pm * 256 + ai * 128 + wr * 64;
                const int bidx = row0 >> 13, chunk = (row0 & (SEQ - 1)) >> 6;
#pragma unroll
                for (int n = 0; n < 2; ++n) {
                    const f32x4 h0 = *(const f32x4*)(hlb + h * 128 + dbase + 4 * n), h1 = *(const f32x4*)(hlb + 1024 + h * 128 + dbase + 4 * n);
                    f32x4 ebl;
#pragma unroll
                    for (int e = 0; e < 4; ++e) {
                        const float lb = sigmoidf_(h0[e] - h1[e]);
                        float g[4], kk[4], tot[4];
#pragma unroll
                        for (int m = 0; m < 4; ++m) {
                            const float sg = sigmoidf_(acc[ai][1][m][n][e]);
                            kk[m] = (1.f - lb) * (1.f - sg);
                            const float lf = __logf(lb + (1.f - lb) * sg);
                            float s = lf;
                            s += dppf<0x111, true>(s); s += dppf<0x112, true>(s); s += dppf<0x114, true>(s); s += dppf<0x118, true>(s);
                            float t = lf;
                            t += dppf<0xB1, false>(t); t += dppf<0x4E, false>(t); t += dppf<0x141, false>(t); t += dppf<0x140, false>(t);
                            g[m] = s; tot[m] = t;
                        }
                        float carry = 0.f, eb = 0.f;
#pragma unroll
                        for (int m = 0; m < 4; ++m) {
                            const float bb = g[m] + carry; carry += tot[m];
                            eb = __expf(bb);
                            acc[ai][0][m][n][e] = acc[ai][0][m][n][e] * 0.08838834764831845f * eb;
                            acc[ai][1][m][n][e] = kk[m] * __expf(-bb);
                        }
                        ebl[e] = eb;
                    }
                    if (fr == 15) *(f32x4*)(DEC + ((size_t)((bidx * HG_H + h) * HG_NC + chunk)) * 128 + dbase + 4 * n) = ebl;
#pragma unroll
                    for (int m = 0; m < 4; ++m) {
                        const size_t row = (size_t)(row0 + m * 16 + fr);
                        const f32x4 qv = acc[ai][0][m][n], kv = acc[ai][1][m][n];
                        u32x2 oq, ok; oq.x = pk2(qv[0], qv[1]); oq.y = pk2(qv[2], qv[3]); ok.x = pk2(kv[0], kv[1]); ok.y = pk2(kv[2], kv[3]);
                        *(u32x2*)(Qh + row * 1024 + h * 128 + dbase + 4 * n) = oq;
                        *(u32x2*)(Kh + row * 1024 + h * 128 + dbase + 4 * n) = ok;
                    }
                    __builtin_amdgcn_sched_barrier(0);
                }
            }
        } else if (u.pn >= 12) {
            const int cb = (u.pn - 12) * 256 + wc * 32 + 8 * fq;
#pragma unroll
            for (int ai = 0; ai < 2; ++ai)
#pragma unroll
                for (int m = 0; m < 4; ++m) {
                    const size_t row = (size_t)(u.pm * 256 + ai * 128 + wr * 64 + m * 16 + fr);
#pragma unroll
                    for (int bj = 0; bj < 2; ++bj) {
                        f32x4 a0 = acc[ai][bj][m][0], a1 = acc[ai][bj][m][1];
#pragma unroll
                        for (int e = 0; e < 4; ++e) { a0[e] = siluf_(a0[e]); a1[e] = siluf_(a1[e]); }
                        st16_wt(OHG + row * 1024 + cb + bj * 128, pack8(a0, a1));
                    }
                }
        } else {
#pragma unroll
            for (int ai = 0; ai < 2; ++ai)
#pragma unroll
                for (int m = 0; m < 4; ++m) {
                    const int row = u.pm * 256 + ai * 128 + wr * 64 + m * 16 + fr, bidx = row >> 13, pos = row & (SEQ - 1);
                    bf16* ptr = VTh + (((size_t)(bidx * HG_H * 128 + (u.pn - 8) * 256 + wc * 32 + 8 * fq)) << 13) + pos;
#pragma unroll
                    for (int bj = 0; bj < 2; ++bj) {
#pragma unroll
                        for (int n = 0; n < 2; ++n)
#pragma unroll
                            for (int e = 0; e < 4; ++e) { asm volatile("" : "+v"(ptr)); *ptr = f2bf(acc[ai][bj][m][n][e]); ptr += 8192; }
                        ptr += (size_t)120 * 8192;
                    }
                }
        }
    }
};

struct EpiR {
    static constexpr bool PERM = true, AFTER_DRAIN = false;
    bf16* Qr; bf16* Kr; bf16* VTr; const float* COS; const float* SIN; bf16* ORET; const float* SA; const float* SB;
    DI void operator()(Acc& acc, const Unit& u, int wr, int wc, int fr, int fq) const {
        dequant_acc(acc, u, wr, wc, fr, fq, SA, SB);
        if (u.pn < 8) {
            const bool isk = u.pn >= 4; const int h = u.pn & 3;
            const float lg = __log2f(1.f - exp2f(-5.f - (float)h));
            bf16* dst = isk ? Kr : Qr;
            const int j0 = wc * 32 + 8 * fq;
            f32x4 cj[2];
#pragma unroll
            for (int n = 0; n < 2; ++n)
#pragma unroll
                for (int e = 0; e < 4; ++e) cj[n][e] = exp2f(-(float)(j0 + 4 * n + e) * 0.10381025296523008f) * 0.15915494309189535f;
#pragma unroll
            for (int ai = 0; ai < 2; ++ai)
#pragma unroll
                for (int m = 0; m < 4; ++m) {
                    const int row = u.pm * 256 + ai * 128 + wr * 64 + m * 16 + fr, pos = row & (SEQ - 1), il = pos & (RT_L - 1);
                    const float sc = isk ? exp2f(-lg * (float)il) * 0.0625f : exp2f(lg * (float)il);
                    const float fpos = (float)pos;
#pragma unroll
                    for (int n = 0; n < 2; ++n) {
                        f32x4 c, s;
#pragma unroll
                        for (int e = 0; e < 4; ++e) { const float rev = __builtin_amdgcn_fractf(fpos * cj[n][e]); c[e] = __builtin_amdgcn_cosf(rev); s[e] = __builtin_amdgcn_sinf(rev); }
                        const f32x4 x1 = acc[ai][0][m][n], x2 = acc[ai][1][m][n];
                        acc[ai][0][m][n] = (x1 * c - x2 * s) * sc; acc[ai][1][m][n] = (x1 * s + x2 * c) * sc;
                    }
                    st16_wt(dst + (size_t)row * 1024 + h * 256 + j0, pack8(acc[ai][0][m][0], acc[ai][0][m][1]));
                    st16_wt(dst + (size_t)row * 1024 + h * 256 + 128 + j0, pack8(acc[ai][1][m][0], acc[ai][1][m][1]));
                }
        } else if (u.pn >= 16) {
            const int cb = (u.pn - 16) * 256 + wc * 32 + 8 * fq;
#pragma unroll
            for (int ai = 0; ai < 2; ++ai)
#pragma unroll
                for (int m = 0; m < 4; ++m) {
                    const size_t row = (size_t)(u.pm * 256 + ai * 128 + wr * 64 + m * 16 + fr);
#pragma unroll
                    for (int bj = 0; bj < 2; ++bj) {
                        f32x4 a0 = acc[ai][bj][m][0], a1 = acc[ai][bj][m][1];
#pragma unroll
                        for (int e = 0; e < 4; ++e) { a0[e] = siluf_(a0[e]); a1[e] = siluf_(a1[e]); }
                        st16_wt(ORET + row * 2048 + cb + bj * 128, pack8(a0, a1));
                    }
                }
        } else {
#pragma unroll
            for (int ai = 0; ai < 2; ++ai)
#pragma unroll
                for (int m = 0; m < 4; ++m) {
                    const int row = u.pm * 256 + ai * 128 + wr * 64 + m * 16 + fr, bidx = row >> 13, pos = row & (SEQ - 1);
                    const int uu = pos & 15, hs = (uu >> 2) & 1, jj = ((uu >> 3) << 2) | (uu & 3), ks = (pos >> 4) & 1, sblk = pos >> 5;
                    const int c0 = (u.pn - 8) * 256 + wc * 32, hd = c0 >> 9, nv0 = (c0 & 511) >> 5;
                    bf16* ptr = VTr + ((((size_t)((bidx * RT_H + hd) * 256 + sblk) * 16 + nv0) * 2 + ks) * 64 + (8 * fq + 32 * hs)) * 8 + jj;
#pragma unroll
                    for (int bj = 0; bj < 2; ++bj) {
#pragma unroll
                        for (int n = 0; n < 2; ++n)
#pragma unroll
                            for (int e = 0; e < 4; ++e) { asm volatile("" : "+v"(ptr)); *ptr = f2bf(acc[ai][bj][m][n][e]); ptr += 8; }
                        ptr += 4 * 2 * 64 * 8 - 64;
                    }
                }
        }
    }
};

struct EpiG {
    static constexpr bool PERM = true, AFTER_DRAIN = false;
    bf16* GA; bf16* GB; const float* SA; const float* SB;
    DI void operator()(Acc& acc, const Unit& u, int wr, int wc, int fr, int fq) const {
        dequant_acc(acc, u, wr, wc, fr, fq, SA, SB);
        const int cb = wc * 32 + 8 * fq;
        bf16* base = (u.pn < 4 ? GA + (size_t)u.pn * 256 : GB + (size_t)(u.pn - 4) * 256) + cb;
#pragma unroll
        for (int ai = 0; ai < 2; ++ai)
#pragma unroll
            for (int m = 0; m < 4; ++m) {
                const size_t row = (size_t)(u.pm * 256 + ai * 128 + wr * 64 + m * 16 + fr);
#pragma unroll
                for (int bj = 0; bj < 2; ++bj) {
                    f32x4 a0 = acc[ai][bj][m][0], a1 = acc[ai][bj][m][1];
#pragma unroll
                    for (int e = 0; e < 4; ++e) { a0[e] = sigmoidf_(a0[e]); a1[e] = sigmoidf_(a1[e]); }
                    st16_wt(base + row * 1024 + bj * 128, pack8(a0, a1));
                }
            }
    }
};

struct EpiM1 {
    static constexpr bool PERM = true, AFTER_DRAIN = false;
    bf16* MERGED; const bf16* GA;
    DI void operator()(Acc& acc, const Unit& u, int wr, int wc, int fr, int fq) const {
        const int cb = u.pn * 256 + wc * 32 + 8 * fq;
#pragma unroll
        for (int ai = 0; ai < 2; ++ai)
#pragma unroll
            for (int m = 0; m < 4; ++m) {
                const size_t row = (size_t)(u.pm * 256 + ai * 128 + wr * 64 + m * 16 + fr);
#pragma unroll
                for (int bj = 0; bj < 2; ++bj) {
                    const u32x4 g = *(const u32x4*)(GA + row * 1024 + cb + bj * 128);
                    f32x4 a0 = acc[ai][bj][m][0], a1 = acc[ai][bj][m][1];
                    a0[0] *= bflo(g.x); a0[1] *= bfhi(g.x); a0[2] *= bflo(g.y); a0[3] *= bfhi(g.y);
                    a1[0] *= bflo(g.z); a1[1] *= bfhi(g.z); a1[2] *= bflo(g.w); a1[3] *= bfhi(g.w);
                    st16_wt(MERGED + row * 1024 + cb + bj * 128, pack8(a0, a1));
                }
            }
    }
};
struct EpiMerge {
    static constexpr bool PERM = true, AFTER_DRAIN = false;
    const bf16* GB; bf16* MERGED;
    DI void operator()(Acc& acc, const Unit& u, int wr, int wc, int fr, int fq) const {
        const int cb = u.pn * 256 + wc * 32 + 8 * fq;
#pragma unroll
        for (int ai = 0; ai < 2; ++ai)
#pragma unroll
            for (int m = 0; m < 4; ++m) {
                const size_t row = (size_t)(u.pm * 256 + ai * 128 + wr * 64 + m * 16 + fr);
#pragma unroll
                for (int bj = 0; bj < 2; ++bj) {
                    const u32x4 g = *(const u32x4*)(GB + row * 1024 + cb + bj * 128);
                    const u32x4 mo = *(const u32x4*)(MERGED + row * 1024 + cb + bj * 128);
                    f32x4 a0 = acc[ai][bj][m][0], a1 = acc[ai][bj][m][1];
                    a0[0] = a0[0] * bflo(g.x) + bflo(mo.x); a0[1] = a0[1] * bfhi(g.x) + bfhi(mo.x); a0[2] = a0[2] * bflo(g.y) + bflo(mo.y); a0[3] = a0[3] * bfhi(g.y) + bfhi(mo.y);
                    a1[0] = a1[0] * bflo(g.z) + bflo(mo.z); a1[1] = a1[1] * bfhi(g.z) + bfhi(mo.z); a1[2] = a1[2] * bflo(g.w) + bflo(mo.w); a1[3] = a1[3] * bfhi(g.w) + bfhi(mo.w);
                    st16_wt(MERGED + row * 1024 + cb + bj * 128, pack8(a0, a1));
                }
            }
    }
};
struct EpiOut {
    static constexpr bool PERM = true, AFTER_DRAIN = false;
    const float* X; float* X1; bf16* XW; const float* nw; float* SSQX;
    DI void operator()(Acc& acc, const Unit& u, int wr, int wc, int fr, int fq) const {
        const int cb = u.pn * 256 + wc * 32 + 8 * fq;
#pragma unroll
        for (int ai = 0; ai < 2; ++ai)
#pragma unroll
            for (int m = 0; m < 4; ++m) {
                const size_t row = (size_t)(u.pm * 256 + ai * 128 + wr * 64 + m * 16 + fr);
                float ss = 0.f;
#pragma unroll
                for (int bj = 0; bj < 2; ++bj) {
                    const size_t off = row * 1024 + cb + bj * 128;
                    const f32x4 x0 = *(const f32x4*)(X + off), x1v = *(const f32x4*)(X + off + 4);
                    const f32x4 w0 = *(const f32x4*)(nw + cb + bj * 128), w1 = *(const f32x4*)(nw + cb + bj * 128 + 4);
                    const f32x4 a0 = acc[ai][bj][m][0] + x0, a1 = acc[ai][bj][m][1] + x1v;
                    *(f32x4*)(X1 + off) = a0; *(f32x4*)(X1 + off + 4) = a1;
                    ss += (a0[0] * a0[0] + a0[1] * a0[1]) + (a0[2] * a0[2] + a0[3] * a0[3]) + (a1[0] * a1[0] + a1[1] * a1[1]) + (a1[2] * a1[2] + a1[3] * a1[3]);
                    st16_wt(XW + off, pack8(a0 * w0, a1 * w1));
                }
                ss += __shfl_xor(ss, 16); ss += __shfl_xor(ss, 32);
                if (fq == 0) SSQX[row * 16 + u.pn * 4 + wc] = ss;
            }
    }
};
DI float rstd_x1(const float* SSQX, size_t row) {
    const f32x4 a = *(const f32x4*)(SSQX + row * 16), b = *(const f32x4*)(SSQX + row * 16 + 4), c = *(const f32x4*)(SSQX + row * 16 + 8), d = *(const f32x4*)(SSQX + row * 16 + 12);
    const float s = ((a[0] + a[1]) + (a[2] + a[3])) + ((b[0] + b[1]) + (b[2] + b[3])) + ((c[0] + c[1]) + (c[2] + c[3])) + ((d[0] + d[1]) + (d[2] + d[3]));
    return rsqrtf(s * (1.f / 1024.f) + EPS);
}
struct EpiQ {
    static constexpr bool PERM = true, AFTER_DRAIN = false;
    bf16* Q; const float* SSQX;
    DI void operator()(Acc& acc, const Unit& u, int wr, int wc, int fr, int fq) const {
        const int cb = u.pn * 256 + wc * 32 + 8 * fq;
#pragma unroll
        for (int ai = 0; ai < 2; ++ai)
#pragma unroll
            for (int m = 0; m < 4; ++m) {
                const size_t row = (size_t)(u.pm * 256 + ai * 128 + wr * 64 + m * 16 + fr);
                const float rs = rstd_x1(SSQX, row);
#pragma unroll
                for (int bj = 0; bj < 2; ++bj) st16_wt(Q + row * 2048 + cb + bj * 128, pack8(acc[ai][bj][m][0] * rs, acc[ai][bj][m][1] * rs));
            }
    }
};

#define MFMA32(a, b, c) __builtin_amdgcn_mfma_f32_32x32x16_bf16((a), (b), (c), 0, 0, 0)
DI bf16x8 ldg16(const bf16* p) { return *(const bf16x8*)p; }
DI bf16x8 ldg2x8(const bf16* p0, const bf16* p1) { const s16x4 a = *(const s16x4*)p0, b = *(const s16x4*)p1; return __builtin_shufflevector(a, b, 0, 1, 2, 3, 4, 5, 6, 7); }
DI bf16x8 packx(const f32x16& x, int s) {
    u32x4 p; p.x = pk2(x[8 * s + 0], x[8 * s + 1]); p.y = pk2(x[8 * s + 2], x[8 * s + 3]); p.z = pk2(x[8 * s + 4], x[8 * s + 5]); p.w = pk2(x[8 * s + 6], x[8 * s + 7]);
    return __builtin_bit_cast(bf16x8, p);
}
DI f32x16 zero16() { f32x16 z;
#pragma unroll
    for (int i = 0; i < 16; ++i) z[i] = 0.f; return z; }

DI bf16x8 tr_frag(const LAS unsigned char* tile, int RS, int lane, int ks, int c) {
    const int hh = lane >> 5, blk = (lane >> 4) & 1, q = (lane & 15) >> 2, p = lane & 3;
    const LAS unsigned char* a0 = tile + (16 * ks + 8 * hh + q) * RS + (32 * c + 16 * blk + 4 * p) * 2;
    const s16x4 lo = __builtin_amdgcn_ds_read_tr16_b64_v4i16((LAS s16x4*)a0);
    const s16x4 hi = __builtin_amdgcn_ds_read_tr16_b64_v4i16((LAS s16x4*)(a0 + 4 * RS));
    return __builtin_shufflevector(lo, hi, 0, 1, 2, 3, 4, 5, 6, 7);
}

DI bf16x8 tr_frag_perm(const LAS unsigned char* tile, int RS, int lane, int ks, int c) {
    const int hh = lane >> 5, blk = (lane >> 4) & 1, q = (lane & 15) >> 2, p = lane & 3;
    const LAS unsigned char* a0 = tile + (16 * ks + 4 * hh + q) * RS + (32 * c + 16 * blk + 4 * p) * 2;
    const s16x4 lo = __builtin_amdgcn_ds_read_tr16_b64_v4i16((LAS s16x4*)a0);
    const s16x4 hi = __builtin_amdgcn_ds_read_tr16_b64_v4i16((LAS s16x4*)(a0 + 8 * RS));
    return __builtin_shufflevector(lo, hi, 0, 1, 2, 3, 4, 5, 6, 7);
}

constexpr int HG_KRS = 320;
DI void hg_pass1(LAS unsigned char* lds, const bf16* Kh, const bf16* VTh, bf16* STh, int wg, int nwg) {
    const int tid = fresh_tid(), lane = tid & 63, w = __builtin_amdgcn_readfirstlane(tid >> 6), r = lane & 31, hh = lane >> 5;
    for (int unit = wg; unit < 16 * HG_NC; unit += nwg) {
        const int bh = unit >> 7, c = unit & 127, b = bh >> 3, h = bh & 7;
        __syncthreads();
        {
            const int row = tid >> 3, ch = tid & 7;
            const bf16* src = Kh + ((size_t)(b * SEQ + c * 64 + row)) * 1024 + h * 128;
            const bf16x8 v0 = ldg16(src + ch * 8), v1 = ldg16(src + 64 + ch * 8);
            *(LAS bf16x8*)(lds + row * HG_KRS + ch * 16) = v0; *(LAS bf16x8*)(lds + row * HG_KRS + 128 + ch * 16) = v1;
        }
        __syncthreads();
        const int mt = w & 3, nt0 = w >> 2;
        f32x16 a0 = zero16(), a1 = zero16();
        const bf16* vrow = VTh + (((size_t)(bh * 128 + 32 * mt + r)) << 13) + c * 64;
#pragma unroll
        for (int ks = 0; ks < 4; ++ks) {
            const bf16x8 av = ldg16(vrow + 16 * ks + 8 * hh);
            a0 = MFMA32(av, tr_frag(lds, HG_KRS, lane, ks, nt0), a0);
            a1 = MFMA32(av, tr_frag(lds, HG_KRS, lane, ks, nt0 + 2), a1);
        }
        bf16* dst = STh + ((size_t)(bh * HG_NC + c)) * 16384;
#pragma unroll
        for (int i = 0; i < 16; ++i) {
            const int v = 32 * mt + crow(i, hh);
            dst[v * 128 + 32 * nt0 + r] = f2bf(a0[i]); dst[v * 128 + 32 * (nt0 + 2) + r] = f2bf(a1[i]);
        }
    }
    __syncthreads();
}

DI void hg_scan(bf16* STh, const float* DEC, int gtid, int gsz) {
    for (int idx = gtid; idx < 16 * 128 * 32; idx += gsz) {
        const int dq = idx & 31, v = (idx >> 5) & 127, bh = idx >> 12;
        f32x4 carry = {0.f, 0.f, 0.f, 0.f};
        bf16* p = STh + ((size_t)bh * HG_NC) * 16384 + v * 128 + dq * 4;
        const float* dp = DEC + ((size_t)bh * HG_NC) * 128 + dq * 4;
#pragma unroll 8
        for (int c = 0; c < HG_NC; ++c) {
            const u32x2 wv = *(const u32x2*)(p + (size_t)c * 16384);
            const f32x4 dec = *(const f32x4*)(dp + c * 128);
            u32x2 o; o.x = pk2(carry[0], carry[1]); o.y = pk2(carry[2], carry[3]);
            *(u32x2*)(p + (size_t)c * 16384) = o;
            carry[0] = dec[0] * (carry[0] + bflo(wv.x)); carry[1] = dec[1] * (carry[1] + bfhi(wv.x));
            carry[2] = dec[2] * (carry[2] + bflo(wv.y)); carry[3] = dec[3] * (carry[3] + bfhi(wv.y));
        }
    }
}
DI void rt_scan(bf16* STr, int gtid, int gsz) {
    for (int idx = gtid; idx < 8 * 512 * 32; idx += gsz) {
        const int dq = idx & 31, v = (idx >> 5) & 511, bh = idx >> 14, h = bh & 3;
        const float dec = exp2f((float)RT_L * __log2f(1.f - exp2f(-5.f - (float)h)));
        float carry[8];
#pragma unroll
        for (int e = 0; e < 8; ++e) carry[e] = 0.f;
        bf16* p = STr + ((size_t)bh * RT_NS) * 131072 + v * 256 + dq * 8;
#pragma unroll 4
        for (int c = 0; c < RT_NS; ++c) {
            const u32x4 wv = *(const u32x4*)(p + (size_t)c * 131072);
            u32x4 o; o.x = pk2(carry[0], carry[1]); o.y = pk2(carry[2], carry[3]); o.z = pk2(carry[4], carry[5]); o.w = pk2(carry[6], carry[7]);
            *(u32x4*)(p + (size_t)c * 131072) = o;
            if (c == RT_NS - 1) break;
            carry[0] = dec * (carry[0] + bflo(wv.x)); carry[1] = dec * (carry[1] + bfhi(wv.x));
            carry[2] = dec * (carry[2] + bflo(wv.y)); carry[3] = dec * (carry[3] + bfhi(wv.y));
            carry[4] = dec * (carry[4] + bflo(wv.z)); carry[5] = dec * (carry[5] + bfhi(wv.z));
            carry[6] = dec * (carry[6] + bflo(wv.w)); carry[7] = dec * (carry[7] + bfhi(wv.w));
        }
    }
}

DI void hg_pass3(LAS unsigned char* lds, const bf16* Qh, const bf16* Kh, const bf16* VTh, const bf16* STh, const float* hg_norm_w, bf16* OHG, int gw, int ngw, int dry) {
    const int tid_ = fresh_tid(), lane = tid_ & 63, r = lane & 31, hh = lane >> 5;
    LAS unsigned char* ot = lds + __builtin_amdgcn_readfirstlane(tid_ >> 6) * 8704;
    for (int unit = gw; unit < 16 * HG_NC * 2; unit += ngw) {
        const int tb = unit & 1, c = (unit >> 1) & 127, bh = unit >> 8, b = bh >> 3, h = bh & 7;
        const size_t trow = (size_t)(b * SEQ + c * 64 + tb * 32 + r);
        bf16x8 qf[8];
#pragma unroll
        for (int kk = 0; kk < 8; ++kk) qf[kk] = ldg16(Qh + trow * 1024 + h * 128 + kk * 16 + 8 * hh);
        f32x16 acc[4];
#pragma unroll
        for (int nv = 0; nv < 4; ++nv) acc[nv] = zero16();
        for (int sb = 0; sb <= tb; ++sb) {
            const size_t srow = (size_t)(b * SEQ + c * 64 + sb * 32 + r);
            f32x16 x = zero16();
#pragma unroll
            for (int kk = 0; kk < 8; ++kk) x = MFMA32(ldg16(Kh + srow * 1024 + h * 128 + kk * 16 + 8 * hh), qf[kk], x);
            if (sb == tb) {
#pragma unroll
                for (int i = 0; i < 16; ++i) if (crow(i, hh) > r) x[i] = 0.f;
            }
            const bf16x8 xs0 = packx(x, 0), xs1 = packx(x, 1);
#pragma unroll
            for (int nv = 0; nv < 4; ++nv) {
                const bf16* vb = VTh + (((size_t)(bh * 128 + nv * 32 + r)) << 13) + c * 64 + sb * 32 + 4 * hh;
                acc[nv] = MFMA32(ldg2x8(vb, vb + 8), xs0, acc[nv]);
                acc[nv] = MFMA32(ldg2x8(vb + 16, vb + 24), xs1, acc[nv]);
            }
        }
        const bf16* st = STh + ((size_t)(bh * HG_NC + c)) * 16384;
#pragma unroll
        for (int nv = 0; nv < 4; ++nv)
#pragma unroll
            for (int kk = 0; kk < 8; ++kk) acc[nv] = MFMA32(ldg16(st + (nv * 32 + r) * 128 + kk * 16 + 8 * hh), qf[kk], acc[nv]);
        float ss = 0.f;
#pragma unroll
        for (int nv = 0; nv < 4; ++nv)
#pragma unroll
            for (int i = 0; i < 16; ++i) ss += acc[nv][i] * acc[nv][i];
        ss += __shfl_xor(ss, 32);
        const float rs = rsqrtf(ss * (1.f / 128.f) + EPS);
#pragma unroll
        for (int nv = 0; nv < 4; ++nv)
#pragma unroll
            for (int g = 0; g < 4; ++g) {
                const int v = nv * 32 + 8 * g + 4 * hh;
                const f32x4 wv = *(const f32x4*)(hg_norm_w + h * 128 + v);
                u32x2 o; o.x = pk2(acc[nv][4 * g] * rs * wv[0], acc[nv][4 * g + 1] * rs * wv[1]); o.y = pk2(acc[nv][4 * g + 2] * rs * wv[2], acc[nv][4 * g + 3] * rs * wv[3]);
                *(LAS u32x2*)(ot + r * 272 + v * 2) = o;
            }
        bf16* orow = OHG + ((size_t)(b * SEQ + c * 64 + tb * 32)) * 1024 + h * 128;
#pragma unroll
        for (int k = 0; k < 8; ++k) {
            const int row = 4 * k + (lane >> 4), ch = lane & 15;
            const u32x4 val = *(const LAS u32x4*)(ot + row * 272 + ch * 16);
            bf16* gp = orow + (size_t)row * 1024 + ch * 8;
            const u32x4 gt = *(const u32x4*)gp;
            u32x4 o;
            o.x = pk2(bflo(val.x) * bflo(gt.x), bfhi(val.x) * bfhi(gt.x)); o.y = pk2(bflo(val.y) * bflo(gt.y), bfhi(val.y) * bfhi(gt.y));
            o.z = pk2(bflo(val.z) * bflo(gt.z), bfhi(val.z) * bfhi(gt.z)); o.w = pk2(bflo(val.w) * bflo(gt.w), bfhi(val.w) * bfhi(gt.w));
            if (!dry) *(u32x4*)gp = o; else asm volatile("" :: "v"(o));
        }
    }
}

constexpr int RT_KRS = 576;
constexpr int RT_KBUF = 64 * RT_KRS;
DI void rt_pass1(LAS unsigned char* lds, const bf16* Kr, const bf16* VTr, bf16* STr, int wg, int nwg) {
    const int tid = fresh_tid(), lane = tid & 63, w = __builtin_amdgcn_readfirstlane(tid >> 6), r = lane & 31, hh = lane >> 5;
    const int wm = w & 3, wn = w >> 2;
    const int srow = tid >> 3, sch = tid & 7;
    for (int unit = wg; unit < 8 * (RT_NS - 1) * 2; unit += nwg) {
        const int vh = unit & 1, sg = (unit >> 1) % (RT_NS - 1), bh = (unit >> 1) / (RT_NS - 1), b = bh >> 2, h = bh & 3;
        f32x16 acc[2][4];
#pragma unroll
        for (int i = 0; i < 2; ++i)
#pragma unroll
            for (int j = 0; j < 4; ++j) acc[i][j] = zero16();
        const bf16* kbase = Kr + ((size_t)(b * SEQ + sg * RT_L)) * 1024 + h * 256;
        bf16x8 st[4];
#pragma unroll
        for (int i = 0; i < 4; ++i) st[i] = ldg16(kbase + (size_t)srow * 1024 + (sch + 8 * i) * 8);
        __syncthreads();
#pragma unroll
        for (int i = 0; i < 4; ++i) *(LAS bf16x8*)(lds + srow * RT_KRS + (sch + 8 * i) * 16) = st[i];
        for (int sb = 0; sb < RT_L / 64; ++sb) {
            const LAS unsigned char* cur = lds + (sb & 1) * RT_KBUF;
            if (sb + 1 < RT_L / 64) {
#pragma unroll
                for (int i = 0; i < 4; ++i) st[i] = ldg16(kbase + (size_t)((sb + 1) * 64 + srow) * 1024 + (sch + 8 * i) * 8);
            }
            __syncthreads();
#pragma unroll
            for (int ks = 0; ks < 4; ++ks) {
                bf16x8 av[2];
#pragma unroll
                for (int i = 0; i < 2; ++i) av[i] = ldg16(VTr + (((((size_t)(bh * 256 + sg * 16 + sb * 2 + (ks >> 1))) * 16 + vh * 8 + wm * 2 + i) * 2 + (ks & 1)) * 64 + lane) * 8);
#pragma unroll
                for (int j = 0; j < 4; ++j) {
                    const bf16x8 bv = tr_frag_perm(cur, RT_KRS, lane, ks, wn * 4 + j);
                    acc[0][j] = MFMA32(av[0], bv, acc[0][j]); acc[1][j] = MFMA32(av[1], bv, acc[1][j]);
                }
                __builtin_amdgcn_sched_barrier(0);
            }
            if (sb + 1 < RT_L / 64) {
                LAS unsigned char* nxt = lds + ((sb + 1) & 1) * RT_KBUF;
#pragma unroll
                for (int i = 0; i < 4; ++i) *(LAS bf16x8*)(nxt + srow * RT_KRS + (sch + 8 * i) * 16) = st[i];
            }
        }
        bf16* dst = STr + ((size_t)(bh * RT_NS + sg)) * 131072;
#pragma unroll
        for (int i = 0; i < 2; ++i)
#pragma unroll
            for (int j = 0; j < 4; ++j)
#pragma unroll
                for (int e = 0; e < 16; ++e) {
                    const int vl = crow(e, hh), d = wn * 128 + j * 32 + r;
                    dst[((((vh * 8 + wm * 2 + i) * 16 + (d >> 4)) * 64 + vl + 32 * ((d >> 3) & 1)) << 3) + (d & 7)] = f2bf(acc[i][j][e]);
                }
    }
    __syncthreads();
}

constexpr int RQ_RS = 528;
constexpr int RQ_QBYTES = 128 * RQ_RS, RQ_KBYTES = 32 * RQ_RS;
DI void rt_pass3_wg(LAS unsigned char* lds, const bf16* Qr, const bf16* Kr, const bf16* VTr, const bf16* STr, bf16* ORET, float* SSQP, int wg, int nwg, int dry) {
    const int tid = fresh_tid(), lane = tid & 63, w = __builtin_amdgcn_readfirstlane(tid >> 6), r = lane & 31, hh = lane >> 5;
    const int tsub = w & 3, vh = w >> 2;
    LAS unsigned char* Qs = lds;
    LAS unsigned char* Ks = lds + RQ_QBYTES;
    for (int pairidx = wg; pairidx < 256; pairidx += nwg) {
#pragma unroll 1
        for (int half = 0; half < 2; ++half) {
            const int sgid = pairidx >> 1, bh = sgid >> 4, sg = sgid & 15, b = bh >> 2, h = bh & 3;
            const int qq = half ? 3 - (pairidx & 1) : (pairidx & 1);
            const int pos0 = sg * RT_L + qq * 128, nsb = 4 * qq + 4, mysb = 4 * qq + tsub;
            const bf16* qsrc = Qr + ((size_t)(b * SEQ + pos0)) * 1024 + h * 256;
            const bf16* ksrc = Kr + ((size_t)(b * SEQ + sg * RT_L)) * 1024 + h * 256;
            unsigned stoff = (unsigned)((tid >> 5) * 1024 + (tid & 31) * 8);
            unsigned stlds = (unsigned)((tid >> 5) * RQ_RS + (tid & 31) * 16);
            asm volatile("" : "+v"(stoff), "+v"(stlds));
            __syncthreads();
#pragma unroll
            for (int i = 0; i < 8; ++i) *(LAS bf16x8*)(Qs + stlds + i * 16 * RQ_RS) = ldg16(qsrc + i * 16 * 1024 + stoff);
            bf16x8 kst[2];
#pragma unroll
            for (int i = 0; i < 2; ++i) *(LAS bf16x8*)(Ks + stlds + i * 16 * RQ_RS) = ldg16(ksrc + i * 16 * 1024 + stoff);
            f32x16 acc[8];
#pragma unroll
            for (int nv = 0; nv < 8; ++nv) acc[nv] = zero16();
            __syncthreads();
            const LAS unsigned char* qfr = Qs + (tsub * 32 + r) * RQ_RS + 16 * hh;
            {
                const bf16* st = STr + ((size_t)(bh * RT_NS + sg)) * 131072 + (size_t)(vh * 8) * 16 * 512;
                unsigned so = (unsigned)(lane * 8);
                asm volatile("" : "+v"(so));
                bf16x8 fa[8], fb[8];
#pragma unroll
                for (int nv = 0; nv < 8; ++nv) fa[nv] = ldg16(st + nv * 16 * 512 + so);
#pragma unroll 1
                for (int k2 = 0; k2 < 8; ++k2) {
#pragma unroll
                    for (int nv = 0; nv < 8; ++nv) fb[nv] = ldg16(st + nv * 16 * 512 + (2 * k2 + 1) * 512 + so);
                    {
                        const bf16x8 q = *(const LAS bf16x8*)(qfr + (2 * k2) * 32);
#pragma unroll
                        for (int nv = 0; nv < 8; ++nv) acc[nv] = MFMA32(fa[nv], q, acc[nv]);
                    }
                    __builtin_amdgcn_sched_barrier(0);
                    if (k2 < 7) {
#pragma unroll
                        for (int nv = 0; nv < 8; ++nv) fa[nv] = ldg16(st + nv * 16 * 512 + (2 * k2 + 2) * 512 + so);
                    }
                    {
                        const bf16x8 q = *(const LAS bf16x8*)(qfr + (2 * k2 + 1) * 32);
#pragma unroll
                        for (int nv = 0; nv < 8; ++nv) acc[nv] = MFMA32(fb[nv], q, acc[nv]);
                    }
                    __builtin_amdgcn_sched_barrier(0);
                }
            }
            const bf16* vbase = VTr + (((size_t)(bh * 256 + sg * 16)) * 16 + vh * 8) * 1024;
            unsigned vo = (unsigned)(lane * 8);
            asm volatile("" : "+v"(vo));
#pragma unroll 1
            for (int sb = 0; sb < nsb; ++sb) {
                const LAS unsigned char* kcur = Ks + (sb & 1) * RQ_KBYTES;
                if (sb + 1 < nsb) {
#pragma unroll
                    for (int i = 0; i < 2; ++i) kst[i] = ldg16(ksrc + (size_t)(sb + 1) * 32 * 1024 + i * 16 * 1024 + stoff);
                }
                if (sb <= mysb) {
                    bf16x8 vt[8][2];
                    const bf16* vb = vbase + (size_t)sb * 16 * 1024;
#pragma unroll
                    for (int nv = 0; nv < 8; ++nv) { vt[nv][0] = ldg16(vb + nv * 1024 + vo); vt[nv][1] = ldg16(vb + nv * 1024 + 512 + vo); }
                    f32x16 x = zero16();
                    const LAS unsigned char* kfr = kcur + r * RQ_RS + 16 * hh;
#pragma unroll
                    for (int kk = 0; kk < 16; ++kk) { x = MFMA32(*(const LAS bf16x8*)(kfr + kk * 32), *(const LAS bf16x8*)(qfr + kk * 32), x); if (kk & 1) __builtin_amdgcn_sched_barrier(0); }
                    if (sb == mysb) {
#pragma unroll
                        for (int i = 0; i < 16; ++i) if (crow(i, hh) > r) x[i] = 0.f;
                    }
                    const bf16x8 xs0 = packx(x, 0), xs1 = packx(x, 1);
#pragma unroll
                    for (int nv = 0; nv < 8; ++nv) { acc[nv] = MFMA32(vt[nv][0], xs0, acc[nv]); acc[nv] = MFMA32(vt[nv][1], xs1, acc[nv]); }
                }
                if (sb + 1 < nsb) {
                    LAS unsigned char* knx = Ks + ((sb + 1) & 1) * RQ_KBYTES;
#pragma unroll
                    for (int i = 0; i < 2; ++i) *(LAS bf16x8*)(knx + stlds + i * 16 * RQ_RS) = kst[i];
                }
                __syncthreads();
            }
            float ss = 0.f;
#pragma unroll
            for (int nv = 0; nv < 8; ++nv)
#pragma unroll
                for (int i = 0; i < 16; ++i) ss += acc[nv][i] * acc[nv][i];
            ss += __shfl_xor(ss, 32);
            LAS float* sx = (LAS float*)(lds + 8 * 16896);
            if (hh == 0) sx[vh * 128 + tsub * 32 + r] = ss;
            __syncthreads();
            const float rs = rsqrtf((sx[tsub * 32 + r] + sx[128 + tsub * 32 + r]) * (1.f / 512.f) + EPS);
            LAS unsigned char* ot = lds + w * 16896;
#pragma unroll
            for (int nv = 0; nv < 8; ++nv)
#pragma unroll
                for (int g = 0; g < 4; ++g) {
                    u32x2 o; o.x = pk2(acc[nv][4 * g] * rs, acc[nv][4 * g + 1] * rs); o.y = pk2(acc[nv][4 * g + 2] * rs, acc[nv][4 * g + 3] * rs);
                    *(LAS u32x2*)(ot + r * 528 + (nv * 32 + 8 * g + 4 * hh) * 2) = o;
                }
            bf16* orow = ORET + (size_t)(b * SEQ + pos0 + tsub * 32) * 2048 + h * 512 + vh * 256;
#pragma unroll 4
            for (int k = 0; k < 16; ++k) {
                const int row = 2 * k + (lane >> 5), ch = lane & 31;
                const u32x4 val = *(const LAS u32x4*)(ot + row * 528 + ch * 16);
                bf16* gp = orow + (size_t)row * 2048 + ch * 8;
                const u32x4 gt = *(const u32x4*)gp;
                u32x4 o;
                o.x = pk2(bflo(val.x) * bflo(gt.x), bfhi(val.x) * bfhi(gt.x)); o.y = pk2(bflo(val.y) * bflo(gt.y), bfhi(val.y) * bfhi(gt.y));
                o.z = pk2(bflo(val.z) * bflo(gt.z), bfhi(val.z) * bfhi(gt.z)); o.w = pk2(bflo(val.w) * bflo(gt.w), bfhi(val.w) * bfhi(gt.w));
                if (!dry) *(u32x4*)gp = o; else asm volatile("" :: "v"(o));
            }
        }
    }
    __syncthreads();
}

DI float dot2bf(unsigned a, unsigned b, float c) {
#if __has_builtin(__builtin_amdgcn_fdot2_f32_bf16)
    typedef __bf16 nb2 __attribute__((ext_vector_type(2)));
    return __builtin_amdgcn_fdot2_f32_bf16(__builtin_bit_cast(nb2, a), __builtin_bit_cast(nb2, b), c, false);
#else
    return c + bflo(a) * bflo(b) + bfhi(a) * bfhi(b);
#endif
}
DI unsigned key_pack(float s, unsigned lowbits, unsigned mask) {
    unsigned u = __float_as_uint(s); u = (u & 0x80000000u) ? ~u : (u | 0x80000000u);
    return (u & ~mask) | lowbits;
}
DI float key_val(unsigned k, unsigned mask) { unsigned u = k & ~mask; u = (u & 0x80000000u) ? (u & 0x7fffffffu) : ~u; return __uint_as_float(u); }
DI unsigned umin_(unsigned a, unsigned b) { return a < b ? a : b; }
DI unsigned umax_(unsigned a, unsigned b) { return a > b ? a : b; }
DI void ins16(unsigned (&t)[16], unsigned x) {
#pragma unroll
    for (int i = 15; i >= 1; --i) t[i] = umax_(umin_(t[i - 1], t[i]), umin_(umax_(t[i - 1], t[i]), x));
    t[0] = umax_(t[0], x);
}
constexpr int PR_KOFF = 20480, PR_KRS = 272;
DI void peer_retrieve(LAS unsigned char* lds, const bf16* Q, const bf16* SK, int* EIDX, float* EGATE, int wg, int nwg) {
    const int tid = fresh_tid(), lane = tid & 63, w = __builtin_amdgcn_readfirstlane(tid >> 6), r = lane & 31, hh = lane >> 5;
    LAS unsigned char* myl = lds + w * 2304 + lane * 36;
    LAS unsigned char* ks = lds + PR_KOFF;
    int staged_h = -1;
    for (int unit = 2 * wg; unit < 512; unit += (unit & 1) ? 2 * nwg - 1 : 1) {
        const int h = unit >> 6, tb = (unit & 63) * 8 + w;
        if (h != staged_h) {
            __syncthreads();
#pragma unroll
            for (int i = 0; i < 8; ++i) { const int cidx = tid + 512 * i, row = cidx >> 4, ch = cidx & 15;
                *(LAS bf16x8*)(ks + row * PR_KRS + ch * 16) = ldg16(SK + ((size_t)(h * 256 + row)) * 128 + ch * 8); }
            __syncthreads();
            staged_h = h;
        }
        const size_t trow = (size_t)(tb * 32 + r);
        bf16x8 qf[2][8];
        {
            const bf16* qrow = Q + trow * 2048 + h * 256 + 8 * hh;
#pragma unroll
            for (int p = 0; p < 2; ++p)
#pragma unroll
                for (int kk = 0; kk < 8; ++kk) qf[p][kk] = ldg16(qrow + p * 128 + kk * 16);
        }
        unsigned L[2][16];
#pragma unroll
        for (int p = 0; p < 2; ++p) {
            f32x16 acc[4];
#pragma unroll
            for (int mt = 0; mt < 4; ++mt) acc[mt] = zero16();
            const LAS unsigned char* kfr = ks + (p * 128 + r) * PR_KRS + 16 * hh;
#pragma unroll
            for (int kk = 0; kk < 8; ++kk) {
#pragma unroll
                for (int mt = 0; mt < 4; ++mt) acc[mt] = MFMA32(*(const LAS bf16x8*)(kfr + mt * 32 * PR_KRS + kk * 32), qf[p][kk], acc[mt]);
                if (kk & 1) __builtin_amdgcn_sched_barrier(0);
            }
            unsigned t[16];
#pragma unroll
            for (int i = 0; i < 16; ++i) t[i] = 0u;
#pragma unroll
            for (int mt = 0; mt < 4; ++mt)
#pragma unroll
                for (int i = 0; i < 16; ++i) ins16(t, key_pack(acc[mt][i], (unsigned)(127 - 32 * mt - (i & 3) - 8 * (i >> 2)) - 4u * (unsigned)hh, 127u));
            unsigned o[16];
#pragma unroll
            for (int i = 0; i < 16; ++i) o[i] = (unsigned)__shfl_xor((int)t[i], 32);
#pragma unroll
            for (int i = 0; i < 16; ++i) ins16(t, o[i]);
#pragma unroll
            for (int i = 0; i < 16; ++i) L[p][i] = t[i];
        }
#pragma unroll
        for (int p = 0; p < 2; ++p)
#pragma unroll
            for (int g = 0; g < 4; ++g) {
                const unsigned v = (127u - (L[p][4 * g] & 127u)) | ((127u - (L[p][4 * g + 1] & 127u)) << 8) | ((127u - (L[p][4 * g + 2] & 127u)) << 16) | ((127u - (L[p][4 * g + 3] & 127u)) << 24);
                *(LAS unsigned*)(myl + p * 16 + g * 4) = v;
            }
        float a[16], b[16];
#pragma unroll
        for (int i = 0; i < 16; ++i) { a[i] = key_val(L[0][i], 127u); b[i] = key_val(L[1][i], 127u); }
        unsigned c[16];
#pragma unroll
        for (int i = 0; i < 16; ++i) c[i] = 0u;
#pragma unroll
        for (int i = 0; i < 16; ++i)
#pragma unroll
            for (int j = 0; j < 16; ++j)
                if ((i + 1) * (j + 1) <= 16) ins16(c, key_pack(a[i] + b[j], (unsigned)(255 - (16 * i + j)), 255u));
        float v[16];
        float sum = 0.f;
        const float mx = key_val(c[0], 255u);
#pragma unroll
        for (int k = 0; k < 16; ++k) { v[k] = __expf(key_val(c[k], 255u) - mx); sum += v[k]; }
        const float inv = 1.f / sum;
        asm volatile("s_waitcnt lgkmcnt(0)" ::: "memory");
        if (hh == 0) {
            int e[16];
#pragma unroll
            for (int k = 0; k < 16; ++k) {
                const unsigned cc = 255u - (c[k] & 255u);
                const unsigned i1 = *(LAS unsigned char*)(myl + (cc >> 4)), i2 = *(LAS unsigned char*)(myl + 16 + (cc & 15u));
                e[k] = (int)(i1 * 128u + i2);
            }
            int* ep = EIDX + trow * 128 + h * 16;
#pragma unroll
            for (int g = 0; g < 4; ++g) *(u32x4*)(ep + 4 * g) = (u32x4){(unsigned)e[4 * g], (unsigned)e[4 * g + 1], (unsigned)e[4 * g + 2], (unsigned)e[4 * g + 3]};
        } else {
            float* gp = EGATE + trow * 128 + h * 16;
#pragma unroll
            for (int g = 0; g < 4; ++g) *(f32x4*)(gp + 4 * g) = (f32x4){v[4 * g] * inv, v[4 * g + 1] * inv, v[4 * g + 2] * inv, v[4 * g + 3] * inv};
        }
        asm volatile("s_waitcnt lgkmcnt(0)" ::: "memory");
    }
}

DI float gelu_tanh(float x) {
    const float u = 0.7978845608028654f * (x + 0.044715f * x * x * x);
    const float e = __expf(2.f * u);
    const float th = 1.f - 2.f / (e + 1.f);
    return 0.5f * x * (1.f + th);
}

DI float bcast_f(float v, int j) { return __int_as_float(__builtin_amdgcn_readfirstlane(__float_as_int(__shfl(v, j)))); }
DI void quant_rows(const float* __restrict__ src, unsigned char* __restrict__ dst, float* __restrict__ scale, int nrows, int offs, int gw, int ngw, int lane) {
    for (int row0 = gw; row0 < nrows; row0 += 2 * ngw) {
        const int rowb = row0 + ngw, row1 = rowb < nrows ? rowb : row0;
        f32x4 v[2][4];
#pragma unroll
        for (int rr = 0; rr < 2; ++rr) { const f32x4* p = (const f32x4*)(src + (size_t)(rr ? row1 : row0) * 1024 + lane * 16);
#pragma unroll
            for (int i = 0; i < 4; ++i) v[rr][i] = p[i]; }
#pragma unroll
        for (int rr = 0; rr < 2; ++rr) {
            const int row = rr ? row1 : row0;
            float am = 0.f;
#pragma unroll
            for (int i = 0; i < 4; ++i)
#pragma unroll
                for (int e = 0; e < 4; ++e) am = fmaxf(am, fabsf(v[rr][i][e]));
#pragma unroll
            for (int o = 1; o < 64; o <<= 1) am = fmaxf(am, __shfl_xor(am, o));
            const float inv = am > 0.f ? 127.f / am : 0.f;
            u32x4 w;
#pragma unroll
            for (int i = 0; i < 4; ++i) {
                unsigned pk = 0u;
#pragma unroll
                for (int e = 0; e < 4; ++e) { const int q = (int)rintf(v[rr][i][e] * inv) + offs; pk |= ((unsigned)q & 0xffu) << (8 * e); }
                w[i] = pk;
            }
            if (rr == 0 || rowb < nrows) {
                *(u32x4*)(dst + ((size_t)(lane >> 3) * nrows + row) * 128 + (lane & 7) * 16) = w;
                if (lane == 0) scale[row] = am > 0.f ? am * (1.f / 127.f) : 0.f;
            }
        }
    }
}
DI void quant_xw(const bf16* XW, unsigned char* XQ8, float* XS, int gw, int ngw, int lane) {
    for (int t = gw; t < T; t += ngw) {
        const u32x4 xa = *(const u32x4*)(XW + (size_t)t * 1024 + lane * 16), xb = *(const u32x4*)(XW + (size_t)t * 1024 + lane * 16 + 8);
        float xf[16] = {bflo(xa.x), bfhi(xa.x), bflo(xa.y), bfhi(xa.y), bflo(xa.z), bfhi(xa.z), bflo(xa.w), bfhi(xa.w),
                        bflo(xb.x), bfhi(xb.x), bflo(xb.y), bfhi(xb.y), bflo(xb.z), bfhi(xb.z), bflo(xb.w), bfhi(xb.w)};
        float am = 0.f;
#pragma unroll
        for (int i = 0; i < 16; ++i) am = fmaxf(am, fabsf(xf[i]));
#pragma unroll
        for (int o = 1; o < 64; o <<= 1) am = fmaxf(am, __shfl_xor(am, o));
        const float inv = am > 0.f ? 127.f / am : 0.f;
        u32x4 w;
#pragma unroll
        for (int i = 0; i < 4; ++i) { unsigned pk = 0u;
#pragma unroll
            for (int e = 0; e < 4; ++e) pk |= ((unsigned)((int)rintf(xf[4 * i + e] * inv)) & 0xffu) << (8 * e);
            w[i] = pk; }
        *(u32x4*)(XQ8 + ((size_t)(lane >> 3) * T + t) * 128 + (lane & 7) * 16) = w;
        if (lane == 0) XS[t] = am * (1.f / 127.f);
    }
}
DI int dpp_xor1(int v) { return __builtin_amdgcn_update_dpp(0, v, 0xB1, 0xF, 0xF, false); }
DI int dpp_xor2(int v) { return __builtin_amdgcn_update_dpp(0, v, 0x4E, 0xF, 0xF, false); }
DI int dpp_hmir(int v) { return __builtin_amdgcn_update_dpp(0, v, 0x141, 0xF, 0xF, false); }
DI void peer_u(const unsigned char* EU8, const unsigned char* XQ8, const int* EIDX, int* PART, int slice, int tok0, int tokstep, int lane) {
    const int q = lane >> 3, i = lane & 7;
    const unsigned char* tab = EU8 + (size_t)slice * PE_NE * 128 + i * 16;
#define PU_LOAD(dst, t_) do { const u32x4* ep_ = (const u32x4*)(EIDX + (size_t)(t_) * 128 + 16 * q); const u32x4 e0_ = ep_[0], e1_ = ep_[1], e2_ = ep_[2], e3_ = ep_[3]; \
        const unsigned ee_[16] = {e0_.x, e0_.y, e0_.z, e0_.w, e1_.x, e1_.y, e1_.z, e1_.w, e2_.x, e2_.y, e2_.z, e2_.w, e3_.x, e3_.y, e3_.z, e3_.w}; \
        _Pragma("unroll") for (int g = 0; g < 16; ++g) dst[g] = *(const u32x4*)(tab + (size_t)ee_[g] * 128); } while (0)
    u32x4 ub[16], nb[16];
    if (tok0 < T) PU_LOAD(ub, tok0);
    for (int t = tok0; t < T; t += tokstep) {
        const u32x4 xv = *(const u32x4*)(XQ8 + ((size_t)slice * T + t) * 128 + i * 16);
        if (t + tokstep < T) PU_LOAD(nb, t + tokstep);
        int d0 = 0, d1 = 0;
#pragma unroll
        for (int g = 0; g < 16; ++g) {
            int s = __builtin_amdgcn_sdot4((int)ub[g].x, (int)xv.x, 0, false);
            s = __builtin_amdgcn_sdot4((int)ub[g].y, (int)xv.y, s, false); s = __builtin_amdgcn_sdot4((int)ub[g].z, (int)xv.z, s, false); s = __builtin_amdgcn_sdot4((int)ub[g].w, (int)xv.w, s, false);
            s += dpp_xor1(s); s += dpp_xor2(s); s += dpp_hmir(s);
            if (g < 8) { if (i == g) d0 = s; } else { if (i == g - 8) d1 = s; }
        }
        int* pp = PART + ((size_t)slice * T + t) * 128 + 16 * q + i;
        pp[0] = d0; pp[8] = d1;
#pragma unroll
        for (int g = 0; g < 16; ++g) ub[g] = nb[g];
    }
#undef PU_LOAD
}
DI void peer_w(const int* PART, const int* EIDX, const float* EGATE, const float* SU, const float* SV, const float* XS, const float* SSQX, unsigned char* WQ8, float* WSC, int gw, int ngw, int lane) {
    for (int t = gw; t < T; t += ngw) {
        const size_t base = (size_t)t * 128 + 2 * lane;
        int d0 = 0, d1 = 0;
#pragma unroll
        for (int s = 0; s < 8; ++s) { const u32x2 pv = *(const u32x2*)(PART + (size_t)s * T * 128 + base); d0 += (int)pv.x; d1 += (int)pv.y; }
        const u32x2 ev = *(const u32x2*)(EIDX + base); const f32x2 gv = *(const f32x2*)(EGATE + base);
        const float sc = XS[t] * rstd_x1(SSQX, (size_t)t);
        const float w0 = gv[0] * SV[ev.x] * gelu_tanh((float)d0 * (SU[ev.x] * sc)), w1 = gv[1] * SV[ev.y] * gelu_tanh((float)d1 * (SU[ev.y] * sc));
        float am = fmaxf(fabsf(w0), fabsf(w1));
#pragma unroll
        for (int o = 1; o < 64; o <<= 1) am = fmaxf(am, __shfl_xor(am, o));
        const float inv = am > 0.f ? 127.f / am : 0.f;
        const unsigned q0 = (unsigned)((int)rintf(w0 * inv)) & 0xffu, q1 = (unsigned)((int)rintf(w1 * inv)) & 0xffu;
        *(unsigned short*)(WQ8 + base) = (unsigned short)(q0 | (q1 << 8));
        if (lane == 0) WSC[t] = am * (1.f / 127.f);
    }
}
DI unsigned perm_(unsigned s0, unsigned s1, unsigned sel) { return __builtin_amdgcn_perm(s0, s1, sel); }
DI void peer_v(const unsigned char* EV8, const int* EIDX, const unsigned char* WQ8, const float* WSC, float* X1, int slice, int tok0, int tokstep, int lane, int dry) {
    const int q = lane >> 3, i = lane & 7;
    const unsigned char* tab = EV8 + (size_t)slice * PE_NE * 128 + i * 16;
#define PV_LOAD(dst, t_) do { const u32x4* ep_ = (const u32x4*)(EIDX + (size_t)(t_) * 128 + 16 * q); const u32x4 e0_ = ep_[0], e1_ = ep_[1], e2_ = ep_[2], e3_ = ep_[3]; \
        const unsigned ee_[16] = {e0_.x, e0_.y, e0_.z, e0_.w, e1_.x, e1_.y, e1_.z, e1_.w, e2_.x, e2_.y, e2_.z, e2_.w, e3_.x, e3_.y, e3_.z, e3_.w}; \
        _Pragma("unroll") for (int g = 0; g < 16; ++g) dst[g] = *(const u32x4*)(tab + (size_t)ee_[g] * 128); } while (0)
    u32x4 vb[16], nb[16];
    if (tok0 < T) PV_LOAD(vb, tok0);
    for (int t = tok0; t < T; t += tokstep) {
        const u32x4 wqv = *(const u32x4*)(WQ8 + (size_t)t * 128 + 16 * q);
        const float wsc = WSC[t];
        if (t + tokstep < T) PV_LOAD(nb, t + tokstep);
        const int wq[4] = {(int)wqv.x, (int)wqv.y, (int)wqv.z, (int)wqv.w};
        int o[16];
#pragma unroll
        for (int c = 0; c < 16; ++c) o[c] = 0;
#pragma unroll
        for (int m = 0; m < 4; ++m) {
#pragma unroll
            for (int k = 0; k < 4; ++k) {
                const unsigned a = vb[4 * m][k], b = vb[4 * m + 1][k], c = vb[4 * m + 2][k], dd = vb[4 * m + 3][k];
                const unsigned ablo = perm_(b, a, 0x05010400u), abhi = perm_(b, a, 0x07030602u), cdlo = perm_(dd, c, 0x05010400u), cdhi = perm_(dd, c, 0x07030602u);
                o[4 * k + 0] = __builtin_amdgcn_sdot4((int)perm_(cdlo, ablo, 0x05040100u), wq[m], o[4 * k + 0], false);
                o[4 * k + 1] = __builtin_amdgcn_sdot4((int)perm_(cdlo, ablo, 0x07060302u), wq[m], o[4 * k + 1], false);
                o[4 * k + 2] = __builtin_amdgcn_sdot4((int)perm_(cdhi, abhi, 0x05040100u), wq[m], o[4 * k + 2], false);
                o[4 * k + 3] = __builtin_amdgcn_sdot4((int)perm_(cdhi, abhi, 0x07060302u), wq[m], o[4 * k + 3], false);
            }
        }
        int r8[8], r4[4], r2[2];
#pragma unroll
        for (int c = 0; c < 8; ++c) { const int mine = (q & 4) ? o[c + 8] : o[c], theirs = (q & 4) ? o[c] : o[c + 8]; r8[c] = mine + __shfl_xor(theirs, 32); }
#pragma unroll
        for (int c = 0; c < 4; ++c) { const int mine = (q & 2) ? r8[c + 4] : r8[c], theirs = (q & 2) ? r8[c] : r8[c + 4]; r4[c] = mine + __shfl_xor(theirs, 16); }
#pragma unroll
        for (int c = 0; c < 2; ++c) { const int mine = (q & 1) ? r4[c + 2] : r4[c], theirs = (q & 1) ? r4[c] : r4[c + 2]; r2[c] = mine + __shfl_xor(theirs, 8); }
        float* xp = X1 + (size_t)t * 1024 + slice * 128 + i * 16 + 2 * q;
        f32x2 xv = *(const f32x2*)xp;
        xv[0] += (float)r2[0] * wsc; xv[1] += (float)r2[1] * wsc;
        if (!dry) *(f32x2*)xp = xv; else asm volatile("" :: "v"(xv));
#pragma unroll
        for (int g = 0; g < 16; ++g) vb[g] = nb[g];
    }
#undef PV_LOAD
}
DI void final_norm(const float* __restrict__ Y, const float* __restrict__ fw, float* __restrict__ OUT, int gw, int ngw, int lane, float dscale) {
    for (int t0 = gw; t0 < T; t0 += 2 * ngw) {
        const int tb = t0 + ngw, t1 = tb < T ? tb : t0;
        f32x4 v[2][4];
#pragma unroll
        for (int rr = 0; rr < 2; ++rr) { const f32x4* yr = (const f32x4*)(Y + (size_t)(rr ? t1 : t0) * 1024) + lane;
#pragma unroll
            for (int j = 0; j < 4; ++j) v[rr][j] = yr[64 * j]; }
#pragma unroll
        for (int rr = 0; rr < 2; ++rr) {
            float s = 0.f;
#pragma unroll
            for (int j = 0; j < 4; ++j) s += (v[rr][j][0] * v[rr][j][0] + v[rr][j][1] * v[rr][j][1]) + (v[rr][j][2] * v[rr][j][2] + v[rr][j][3] * v[rr][j][3]);
            const float rs = rsqrtf(wave_sum(s) * (1.f / 1024.f) + EPS) * dscale;
            if (rr == 0 || tb < T) {
                f32x4* o = (f32x4*)(OUT + (size_t)(rr ? t1 : t0) * 1024) + lane; const f32x4* wr4 = (const f32x4*)fw + lane;
#pragma unroll
                for (int j = 0; j < 4; ++j) { const f32x4 ww = wr4[64 * j]; o[64 * j] = (f32x4){v[rr][j][0] * rs * ww[0], v[rr][j][1] * rs * ww[1], v[rr][j][2] * rs * ww[2], v[rr][j][3] * rs * ww[3]}; }
            }
        }
    }
}

DI void transpose_item(const float* W, int K, int N, bf16* WT, int n_src0, int n_dst0, int k0, LAS float* scr, int lane) {
#pragma unroll 16
    for (int i = 0; i < 32; ++i) { const int kk = 2 * i + (lane >> 5); scr[kk * 33 + (lane & 31)] = W[(size_t)(k0 + kk) * N + n_src0 + (lane & 31)]; }
    asm volatile("s_waitcnt lgkmcnt(0)" ::: "memory");
    const int c = lane & 7;
#pragma unroll
    for (int j = 0; j < 4; ++j) { const int n = (lane >> 3) + 8 * j; const LAS float* s = scr + (8 * c) * 33 + n;
        u32x4 o; o.x = pk2(s[0 * 33], s[1 * 33]); o.y = pk2(s[2 * 33], s[3 * 33]); o.z = pk2(s[4 * 33], s[5 * 33]); o.w = pk2(s[6 * 33], s[7 * 33]);
        *(u32x4*)(WT + (size_t)(n_dst0 + n) * K + k0 + 8 * c) = o; }
    asm volatile("s_waitcnt lgkmcnt(0)" ::: "memory");
}
DI int win_orig_col(int np) {
    if (np < 2048) { const int h = np >> 8, sel = (np >> 7) & 1, d = np & 127; return sel * 1024 + h * 128 + d; }
    return np;
}
DI void rmsnorm_row_bf16(const float* xrow, const float* w, bf16* orow, int lane) {
    const f32x4* xr = (const f32x4*)xrow + lane; const f32x4* wr4 = (const f32x4*)w + lane;
    f32x4 v[4]; float s = 0.f;
#pragma unroll
    for (int j = 0; j < 4; ++j) { v[j] = xr[64 * j]; s += (v[j][0] * v[j][0] + v[j][1] * v[j][1]) + (v[j][2] * v[j][2] + v[j][3] * v[j][3]); }
    const float rs = rsqrtf(wave_sum(s) * (1.f / 1024.f) + EPS);
    u32x2* o8 = (u32x2*)orow + lane;
#pragma unroll
    for (int j = 0; j < 4; ++j) { const f32x4 ww = wr4[64 * j]; u32x2 o; o.x = pk2(v[j][0] * rs * ww[0], v[j][1] * rs * ww[1]); o.y = pk2(v[j][2] * rs * ww[2], v[j][3] * rs * ww[3]); o8[64 * j] = o; }
}
DI void transpose_item_q8(const float* W, int N, unsigned char* WT8, const LAS float* cmax, int n_src0, int n_dst0, int k0, LAS float* scr, int lane) {
#pragma unroll 16
    for (int i = 0; i < 32; ++i) { const int kk = 2 * i + (lane >> 5); scr[kk * 33 + (lane & 31)] = W[(size_t)(k0 + kk) * N + n_src0 + (lane & 31)]; }
    asm volatile("s_waitcnt lgkmcnt(0)" ::: "memory");
    const int c = lane & 3;
#pragma unroll
    for (int j = 0; j < 2; ++j) {
        const int n = (lane >> 2) + 16 * j;
        const float am = cmax[n], inv = am > 0.f ? 127.f / am : 0.f;
        const LAS float* s = scr + (16 * c) * 33 + n;
        u32x4 o;
#pragma unroll
        for (int g = 0; g < 4; ++g) { unsigned pk = 0u;
#pragma unroll
            for (int e2 = 0; e2 < 4; ++e2) pk |= ((unsigned)((int)rintf(s[(4 * g + e2) * 33] * inv)) & 0xffu) << (8 * e2);
            o[g] = pk; }
        *(u32x4*)(WT8 + (size_t)(n_dst0 + n) * 1024 + k0 + 16 * c) = o;
    }
    asm volatile("s_waitcnt lgkmcnt(0)" ::: "memory");
}
DI void rmsnorm_rows_q8(const float* __restrict__ x, const float* __restrict__ w, unsigned char* __restrict__ HN8, float* __restrict__ SA, int gw, int ngw, int lane) {
    for (int m0 = gw; m0 < T; m0 += 2 * ngw) {
        const int mb = m0 + ngw, m1 = mb < T ? mb : m0;
        f32x4 v[2][4];
#pragma unroll
        for (int rr = 0; rr < 2; ++rr) { const f32x4* xr = (const f32x4*)(x + (size_t)(rr ? m1 : m0) * 1024) + lane;
#pragma unroll
            for (int j = 0; j < 4; ++j) v[rr][j] = xr[64 * j]; }
        const f32x4* wr4 = (const f32x4*)w + lane;
#pragma unroll
        for (int rr = 0; rr < 2; ++rr) {
            float s = 0.f;
#pragma unroll
            for (int j = 0; j < 4; ++j) s += (v[rr][j][0] * v[rr][j][0] + v[rr][j][1] * v[rr][j][1]) + (v[rr][j][2] * v[rr][j][2] + v[rr][j][3] * v[rr][j][3]);
            const float rs = rsqrtf(wave_sum(s) * (1.f / 1024.f) + EPS);
            float am = 0.f;
#pragma unroll
            for (int j = 0; j < 4; ++j) { const f32x4 ww = wr4[64 * j];
#pragma unroll
                for (int e2 = 0; e2 < 4; ++e2) { v[rr][j][e2] = v[rr][j][e2] * rs * ww[e2]; am = fmaxf(am, fabsf(v[rr][j][e2])); } }
#pragma unroll
            for (int o = 1; o < 64; o <<= 1) am = fmaxf(am, __shfl_xor(am, o));
            const float inv = am > 0.f ? 127.f / am : 0.f;
            if (rr == 0 || mb < T) {
                const int m = rr ? m1 : m0;
                unsigned* o4 = (unsigned*)(HN8 + (size_t)m * 1024) + lane;
#pragma unroll
                for (int j = 0; j < 4; ++j) { unsigned pk = 0u;
#pragma unroll
                    for (int e2 = 0; e2 < 4; ++e2) pk |= ((unsigned)((int)rintf(v[rr][j][e2] * inv)) & 0xffu) << (8 * e2);
                    o4[64 * j] = pk; }
                if (lane == 0) SA[m] = am * (1.f / 127.f);
            }
        }
    }
}
DI void convert_bf16(const float* src, bf16* dst, size_t n, size_t gtid, size_t gsz) {
    for (size_t i = gtid * 8; i < n; i += gsz * 8) {
        const f32x4 a = *(const f32x4*)(src + i), b = *(const f32x4*)(src + i + 4);
        *(u32x4*)(dst + i) = pack8(a, b);
    }
}

#define XB_TMO      128
#define XB_XCNT(j)  (256  + 64 * (j))
#define XB_XSUB(j)  (1280 + 64 * (j))
#define XB_XGEN(j)  (2304 + 64 * (j))
#define XB_TOP      3328
#define XB_TOPGEN   3392
#define XCD_BAR_WORDS 3456
#define XB_SPIN_CAP (1u << 18)

__device__ __forceinline__ unsigned xb_ld(unsigned* p)              { return __hip_atomic_load(p, __ATOMIC_RELAXED, __HIP_MEMORY_SCOPE_AGENT); }
__device__ __forceinline__ unsigned xb_add(unsigned* p, unsigned v) { return __hip_atomic_fetch_add(p, v, __ATOMIC_RELAXED, __HIP_MEMORY_SCOPE_AGENT); }
__device__ __forceinline__ unsigned xb_xcc_id() { return (unsigned)__builtin_amdgcn_s_getreg((3 << 11) | 20) & 0xFu; }
#define XB_SPIN(cond, bar) do { unsigned _sp = 0; while (cond) { __builtin_amdgcn_s_sleep(1); \
    if ((++_sp & 255u) == 0u) { if (xb_ld(&(bar)[XB_TMO])) break; if (_sp > XB_SPIN_CAP) { atomicAdd(&(bar)[XB_TMO], 1u); break; } } } } while (0)

struct XcdBarrier {
    unsigned* bar; unsigned x;
    volatile LAS unsigned* st;
};

__device__ __forceinline__ XcdBarrier xcd_barrier_post(unsigned* bar, volatile LAS unsigned* st) {
    XcdBarrier b; b.bar = bar; b.x = xb_xcc_id(); b.st = st;
    if (threadIdx.x == 0) (void)xb_add(&bar[XB_XCNT(b.x)], 1u);
    return b;
}
__device__ __forceinline__ void xcd_barrier_complete(unsigned* bar, unsigned x, unsigned& nloc, unsigned& nx) {
    const unsigned G = gridDim.x * gridDim.y * gridDim.z;
    unsigned sum, cnt, mine, sp = 0u;
    for (;;) {
        sum = 0u; cnt = 0u; mine = 0u;
#pragma unroll
        for (unsigned j = 0; j < 16; ++j) { const unsigned c = xb_ld(&bar[XB_XCNT(j)]); sum += c; cnt += (c > 0u) ? 1u : 0u; mine = (j == x) ? c : mine; }
        if (sum == G) break;
        __builtin_amdgcn_s_sleep(1);
        if ((++sp & 255u) == 0u) { if (xb_ld(&bar[XB_TMO])) break; if (sp > XB_SPIN_CAP) { atomicAdd(&bar[XB_TMO], 1u); break; } }
    }
    nloc = mine > 0u ? mine : 1u; nx = cnt > 0u ? cnt : 1u;
}

__device__ __forceinline__ void xcd_barrier(const XcdBarrier& b) {
    asm volatile("s_waitcnt vmcnt(0)" ::: "memory");
    __syncthreads();
    if (threadIdx.x == 0) {
        unsigned* bar = b.bar;
        __builtin_amdgcn_s_waitcnt(0);
        unsigned nloc = b.st[0], nx = b.st[1];
        if (nloc == 0u) { xcd_barrier_complete(bar, b.x, nloc, nx); b.st[0] = nloc; b.st[1] = nx; }
        const unsigned old = xb_add(&bar[XB_XSUB(b.x)], 1u);
        const unsigned gen = old / nloc;
        if (old + 1u == (gen + 1u) * nloc) {
            __builtin_amdgcn_fence(__ATOMIC_RELEASE, "agent");
            asm volatile("s_waitcnt vmcnt(0)" ::: "memory");
            const unsigned og = xb_add(&bar[XB_TOP], 1u);
            const unsigned tg = og / nx;
            if (og + 1u == (tg + 1u) * nx) xb_add(&bar[XB_TOPGEN], 1u);
            else XB_SPIN(xb_ld(&bar[XB_TOPGEN]) == tg, bar);
            __builtin_amdgcn_fence(__ATOMIC_ACQUIRE, "agent");
            xb_add(&bar[XB_XGEN(b.x)], 1u);
            asm volatile("s_waitcnt vmcnt(0)" ::: "memory");
        } else {
            XB_SPIN(xb_ld(&bar[XB_XGEN(b.x)]) == gen, bar);
            __builtin_amdgcn_fence(__ATOMIC_ACQUIRE, "agent");
            asm volatile("s_waitcnt vmcnt(0)" ::: "memory");
        }
    }
    __syncthreads();
}

struct Params { const float* in[14]; float* out; unsigned char* ws; };

__global__ void __launch_bounds__(NTHREADS, 2) fwd_megakernel(Params p) {
    extern __shared__ __attribute__((aligned(16))) unsigned char lds_raw[];
    LAS unsigned char* lds = (LAS unsigned char*)lds_raw;
    cg::grid_group grid = cg::this_grid();
    volatile LAS unsigned* bst = (volatile LAS unsigned*)(lds + LDS_BYTES - 64);
    if (threadIdx.x < 4) bst[threadIdx.x] = 0u;
    __syncthreads();
    XcdBarrier xbar = xcd_barrier_post((unsigned*)(p.ws + WS_CTL), bst);
    if (threadIdx.x == 0) bst[4] = xb_add((unsigned*)(p.ws + WS_CTL) + 3600 + xbar.x, 1u);
#if USE_CG_SYNC
#define GRID_SYNC() grid.sync()
#else
#define GRID_SYNC() xcd_barrier(xbar)
#endif
    unsigned long long* TS = (unsigned long long*)(p.ws + WS_CTL + 24576);
    int stamp_i_ = 0;
#define STAMP() do { if (STAMP_K >= 0 && blockIdx.x == 0 && threadIdx.x == 0) TS[stamp_i_] = __builtin_amdgcn_s_memrealtime(); ++stamp_i_; } while (0)
    STAMP();
    const int G = gridDim.x, wg = blockIdx.x;
#define PHASE_IDS const int tid = fresh_tid(), lane = tid & 63, wave = __builtin_amdgcn_readfirstlane(tid >> 6); \
    const int gw = wg * NWAVES + wave, ngw = G * NWAVES; const size_t gtid = (size_t)wg * NTHREADS + tid, gsz = (size_t)G * NTHREADS; \
    (void)lane; (void)gw; (void)ngw; (void)gtid; (void)gsz;
    unsigned char* ws = p.ws;
    const float* x = p.in[0];
    unsigned char* HN8 = ws + WS_HN; unsigned char* WinT8 = ws + WS_WINT; float* SA = (float*)(ws + WS_SA); float* SB = (float*)(ws + WS_SB);

    float* COS = (float*)(ws + WS_ROPE); float* SIN = COS + 8192 * 128;
    float* DEC = (float*)(ws + WS_DEC); float* SSQP = (float*)(ws + WS_SSQP); float* SSQX = (float*)(ws + WS_SSQX);
    bf16* BA = (bf16*)(ws + WS_A); bf16* BB = (bf16*)(ws + WS_B); bf16* BC = (bf16*)(ws + WS_C);
    bf16* STh = (bf16*)(ws + WS_STH); bf16* STr = (bf16*)(ws + WS_STR);
    bf16* OHG = (bf16*)(ws + WS_OHG); bf16* ORET = (bf16*)p.out;
    bf16* GA = (bf16*)(ws + WS_GA); bf16* GB = (bf16*)(ws + WS_GB);
    bf16* WhgT = (bf16*)(ws + WS_WHG); bf16* WretT = (bf16*)(ws + WS_WRET); bf16* WoutT = (bf16*)(ws + WS_WOUT); bf16* WqT = (bf16*)(ws + WS_WQ); bf16* SK = (bf16*)(ws + WS_SK);
    unsigned char* EV8 = ws + WS_EV; unsigned char* EU8 = ws + WS_EU; float* SU = (float*)(ws + WS_SCL); float* SV = SU + PE_NE;
    float* M1 = (float*)(ws + WS_M1); bf16* MERGED = (bf16*)(ws + WS_MERGED);
    float* X1 = (float*)(ws + WS_X1); bf16* XW = (bf16*)(ws + WS_XW); bf16* Qp = (bf16*)p.out;
    unsigned char* XQ8 = ws + WS_XQ8; float* XS = (float*)(ws + WS_XS); int* PART = (int*)(ws + WS_PART); unsigned char* WQ8 = ws + WS_WT; float* WSC = (float*)(ws + WS_WT + 4 * MiB);
    int* EIDX = (int*)(ws + WS_EIDX); float* EGATE = (float*)(ws + WS_EGATE);

    for (int rep_ = 0; rep_ < ((PROBE_MASK & 32) ? 2 : 1); ++rep_) {
    { PHASE_IDS LAS float* scr = (LAS float*)(lds + wave * 16384);
    LAS float* amx = (LAS float*)(lds + 131072); LAS float* cm = amx + 512;
    for (int strip = wg; strip < 192; strip += G) {
        const int nd0 = strip * 64, ns0 = win_orig_col(nd0);
        const float* wp = p.in[2] + (size_t)(wave * 128) * 12288 + ns0 + lane;
        float am = 0.f;
#pragma unroll 16
        for (int k = 0; k < 128; ++k) am = fmaxf(am, fabsf(wp[(size_t)k * 12288]));
        amx[wave * 64 + lane] = am;
        __syncthreads();
        if (tid < 64) { float m8 = 0.f;
#pragma unroll
            for (int w8 = 0; w8 < 8; ++w8) m8 = fmaxf(m8, amx[w8 * 64 + tid]);
            cm[tid] = m8; SB[nd0 + tid] = m8 * (1.f / 127.f); }
        __syncthreads();
#pragma unroll 1
        for (int q4 = 0; q4 < 4; ++q4) {
            const int kb = 2 * wave + (q4 >> 1), hf = q4 & 1;
            transpose_item_q8(p.in[2], 12288, WinT8, cm + hf * 32, ns0 + hf * 32, nd0 + hf * 32, kb * 64, scr, lane);
        }
        __syncthreads();
    }
    rmsnorm_rows_q8(x, p.in[1], HN8, SA, gw, ngw, lane);
    }
    __syncthreads(); }
    if (p.ws == nullptr) grid.sync();
    GRID_SYNC();
    STAMP();

    for (int rep_ = 0; rep_ < ((PROBE_MASK & 128) ? 2 : 1); ++rep_) {
    {
        pg8::Gemm g{(const bf16*)HN8, (const bf16*)WinT8, T, 4096, 512}; pg8::StaticOrder S; S.init(T, 4096, G, wg);
        EpiH E{BA, BB, BC, DEC, p.in[3], OHG, SA, SB};
        pg8::gemm_phase<EpiH, pg8::StaticOrder, true, true, true>(lds, g, S, E);
    }
    __syncthreads(); }
    GRID_SYNC();
    STAMP();
    hg_pass1(lds, BB, BC, STh, wg, G);
#if PROBE_MASK & 4
    hg_pass1(lds, BB, BC, STh, wg, G);
#endif
    GRID_SYNC();
    STAMP();
    { PHASE_IDS hg_scan(STh, DEC, (int)gtid, (int)gsz); }
    GRID_SYNC();
    STAMP();
#if PROBE_MASK & 16384
    hg_pass1(lds, BB, BC, STh, wg, G);
    GRID_SYNC();
    STAMP();
    { PHASE_IDS hg_scan(STh, DEC, (int)gtid, (int)gsz); }
    GRID_SYNC();
    STAMP();
#endif
#if PROBE_MASK & 4
    { PHASE_IDS hg_pass3(lds, BA, BB, BC, STh, p.in[4], OHG, gw, ngw, 1); }
#endif
    { PHASE_IDS hg_pass3(lds, BA, BB, BC, STh, p.in[4], OHG, gw, ngw, 0); }
    GRID_SYNC();
    STAMP();

    for (int rep_ = 0; rep_ < ((PROBE_MASK & 2048) ? 2 : 1); ++rep_) {
    {
        pg8::Gemm g{(const bf16*)HN8, (const bf16*)(WinT8 + (size_t)4096 * 1024), T, 6144, 512}; pg8::StaticOrder S; S.init(T, 6144, G, wg);
        EpiR E{BA, BB, BC, COS, SIN, ORET, SA, SB + 4096};
        pg8::gemm_phase<EpiR, pg8::StaticOrder, true, true, true>(lds, g, S, E);
    }
    __syncthreads(); }
    GRID_SYNC();
    STAMP();
    rt_pass1(lds, BB, BC, STr, wg, G);
#if PROBE_MASK & 8
    rt_pass1(lds, BB, BC, STr, wg, G);
#endif
    GRID_SYNC();
    STAMP();
    { PHASE_IDS rt_scan(STr, (int)gtid, (int)gsz); }
    GRID_SYNC();
    STAMP();
#if PROBE_MASK & 32768
    rt_pass1(lds, BB, BC, STr, wg, G);
    GRID_SYNC();
    STAMP();
    { PHASE_IDS rt_scan(STr, (int)gtid, (int)gsz); }
    GRID_SYNC();
    STAMP();
#endif
#if PROBE_MASK & 1024
    rt_pass3_wg(lds, BA, BB, BC, STr, ORET, SSQP, wg, G, 1);
#endif
    rt_pass3_wg(lds, BA, BB, BC, STr, ORET, SSQP, wg, G, 0);
    GRID_SYNC();
    STAMP();

    for (int rep_ = 0; rep_ < ((PROBE_MASK & 64) ? 2 : 1); ++rep_) {
    { PHASE_IDS LAS float* scr = (LAS float*)(lds + wave * 16384);
    for (int it = gw; it < 3072; it += ngw) {
        int r = it;
        if (r < 512) { transpose_item(p.in[5], 1024, 1024, WhgT, (r % 32) * 32, (r % 32) * 32, (r / 32) * 64, scr, lane); continue; } r -= 512;
        if (r < 1024) { transpose_item(p.in[6], 2048, 1024, WretT, (r % 32) * 32, (r % 32) * 32, (r / 32) * 64, scr, lane); continue; } r -= 1024;
        if (r < 512) { transpose_item(p.in[7], 1024, 1024, WoutT, (r % 32) * 32, (r % 32) * 32, (r / 32) * 64, scr, lane); continue; } r -= 512;
        transpose_item(p.in[9], 1024, 2048, WqT, (r % 64) * 32, (r % 64) * 32, (r / 64) * 64, scr, lane);
    }
    convert_bf16(p.in[10], SK, (size_t)16 * 128 * 128, gtid, gsz);
    quant_rows(p.in[12], EV8, SV, PE_NE, 0, gw, ngw, lane); }
    __syncthreads(); }
    __syncthreads();
    for (int rep_ = 0; rep_ < ((PROBE_MASK & 65536) ? 2 : 1); ++rep_) {
    {
        pg8::Gemm g{(const bf16*)HN8, (const bf16*)(WinT8 + (size_t)10240 * 1024), T, 2048, 512}; pg8::StaticOrder S; S.init(T, 2048, G, wg);
        EpiG E{GA, GB, SA, SB + 10240};
        pg8::gemm_phase<EpiG, pg8::StaticOrder, true, true, true>(lds, g, S, E);
    }
    __syncthreads(); }
    GRID_SYNC();
    STAMP();

    for (int rep_ = 0; rep_ < ((PROBE_MASK & 256) ? 2 : 1); ++rep_) {
    for (int rep2_ = 0; rep2_ < ((PROBE_MASK & 262144) ? 2 : 1); ++rep2_) {
    {
        pg8::Gemm g{OHG, WhgT, T, 1024, 1024}; pg8::StaticOrder S; S.init(T, 1024, G, wg);
        EpiM1 E{MERGED, GA};
        pg8::gemm_phase<EpiM1, pg8::StaticOrder, false, true>(lds, g, S, E);
    }
    __syncthreads(); }
    __syncthreads();
    {
        pg8::Gemm g{ORET, WretT, T, 1024, 2048}; pg8::StaticOrder S; S.init(T, 1024, G, wg);
        EpiMerge E{GB, MERGED};
        pg8::gemm_phase<EpiMerge, pg8::StaticOrder, false, true>(lds, g, S, E);
    }
    __syncthreads(); }
    GRID_SYNC();
    STAMP();
    for (int rep_ = 0; rep_ < ((PROBE_MASK & 4096) ? 2 : 1); ++rep_) {
    {
        pg8::Gemm g{MERGED, WoutT, T, 1024, 1024}; pg8::StaticOrder S; S.init(T, 1024, G, wg);
        EpiOut E{x, X1, XW, p.in[8], SSQX};
        pg8::gemm_phase<EpiOut, pg8::StaticOrder, false, true>(lds, g, S, E);
    }
    __syncthreads(); }
    GRID_SYNC();
    STAMP();
    for (int rep_ = 0; rep_ < ((PROBE_MASK & 64) ? 2 : 1); ++rep_) {
    { PHASE_IDS quant_rows(p.in[11], EU8, SU, PE_NE, 0, gw, ngw, lane); }
    __syncthreads(); }
    __syncthreads();
    for (int rep_ = 0; rep_ < ((PROBE_MASK & 8192) ? 2 : 1); ++rep_) {
    {
        pg8::Gemm g{XW, WqT, T, 2048, 1024}; pg8::StaticOrder S; S.init(T, 2048, G, wg);
        EpiQ E{Qp, SSQX};
        pg8::gemm_phase<EpiQ, pg8::StaticOrder, true, true>(lds, g, S, E);
    }
    __syncthreads(); }
    GRID_SYNC();
    STAMP();
    { PHASE_IDS peer_retrieve(lds, Qp, SK, EIDX, EGATE, wg, G); quant_xw(XW, XQ8, XS, gw, ngw, lane); }
#if PROBE_MASK & 2
    { PHASE_IDS peer_retrieve(lds, Qp, SK, EIDX, EGATE, wg, G); quant_xw(XW, XQ8, XS, gw, ngw, lane); }
#endif
    GRID_SYNC();
    STAMP();
    if (threadIdx.x == 0) {
        unsigned k = 0, n = 0, mine = 1;
        for (unsigned j = 0; j < 16; ++j) { const unsigned c = xb_ld((unsigned*)(p.ws + WS_CTL) + XB_XCNT(j)); if (c) { if (j < xbar.x) ++k; ++n; } if (j == xbar.x) mine = c ? c : 1; }
        bst[5] = k; bst[6] = n ? n : 1; bst[7] = mine;
    }
    __syncthreads();
    const int xrank = (int)bst[4], xk = (int)bst[5], xn = (int)bst[6], xloc = (int)bst[7];
    for (int rep_ = 0; rep_ < ((PROBE_MASK & 1) ? 2 : 1); ++rep_) {
    { PHASE_IDS for (int s = xk; s < 8; s += xn) peer_u(EU8, XQ8, EIDX, PART, s, xrank * NWAVES + wave, xloc * NWAVES, lane); }
    GRID_SYNC(); }
    STAMP();
    { PHASE_IDS peer_w(PART, EIDX, EGATE, SU, SV, XS, SSQX, WQ8, WSC, gw, ngw, lane); }
    GRID_SYNC();
    STAMP();
#if PROBE_MASK & 131072
    { PHASE_IDS for (int s = xk; s < 8; s += xn) peer_v(EV8, EIDX, WQ8, WSC, X1, s, xrank * NWAVES + wave, xloc * NWAVES, lane, 1); }
    GRID_SYNC();
    STAMP();
#endif
    { PHASE_IDS for (int s = xk; s < 8; s += xn) peer_v(EV8, EIDX, WQ8, WSC, X1, s, xrank * NWAVES + wave, xloc * NWAVES, lane, 0); }
    GRID_SYNC();
    STAMP();
    { PHASE_IDS float dscale = 1.f;
      if (STAMP_K >= 0) { const float dt_us = (float)(TS[STAMP_K + 1] - TS[STAMP_K]) * 0.01f; dscale = 1.f + sqrtf(dt_us * 2e-6f); }
      final_norm(X1, p.in[13], p.out, gw, ngw, lane, dscale); }
#if PROBE_MASK & 16
    for (int i = 0; i < 15; ++i) GRID_SYNC();
#endif
}

extern "C" void kernel_launch(void* const* d_in, const int* in_sizes, int n_in, void* d_out, int out_size, void* d_ws, size_t ws_size, hipStream_t stream) {
    static int grid_blocks = 0;
    if (!grid_blocks) {
        int dev = 0, cus = 0, per_cu = 0;
        (void)hipGetDevice(&dev);
        (void)hipDeviceGetAttribute(&cus, hipDeviceAttributeMultiprocessorCount, dev);
        (void)hipFuncSetAttribute((const void*)fwd_megakernel, hipFuncAttributeMaxDynamicSharedMemorySize, LDS_BYTES);
        (void)hipOccupancyMaxActiveBlocksPerMultiprocessor(&per_cu, (const void*)fwd_megakernel, NTHREADS, LDS_BYTES);
        if (per_cu < 1) per_cu = 1;
        grid_blocks = cus * 1;
        if (ws_size < WS_END || n_in != 14) { fprintf(stderr, "kernel_launch: unexpected ws_size %zu (need %zu) or n_in %d\n", ws_size, (size_t)WS_END, n_in); }
    }
    (void)hipMemsetAsync((char*)d_ws + WS_CTL, 0, 32768, stream);
    Params p{};
    for (int i = 0; i < 14; ++i) p.in[i] = (const float*)d_in[i];
    p.out = (float*)d_out; p.ws = (unsigned char*)d_ws;
    void* args[] = {&p};
    hipError_t e = hipLaunchCooperativeKernel((const void*)fwd_megakernel, dim3(grid_blocks), dim3(NTHREADS), args, LDS_BYTES, stream);
    if (e != hipSuccess) fprintf(stderr, "cooperative launch failed: %s (grid %d)\n", hipGetErrorString(e), grid_blocks);
}
```

```cpp
#include <hip/hip_runtime.h>
#include <hip/hip_cooperative_groups.h>
#include <cstdio>
#include <cstdint>
namespace cg = cooperative_groups;
#ifndef USE_CG_SYNC
#define USE_CG_SYNC 0
#endif
#ifndef USE_WT_STORES
#define USE_WT_STORES 0
#endif
#ifndef STAMP_K
#define STAMP_K -1
#endif
#ifndef PROBE_MASK
#define PROBE_MASK 0
#endif
#ifndef PROBE_SKIP
#define PROBE_SKIP 0
#endif

#define DI __device__ __forceinline__
#define LAS __attribute__((address_space(3)))
typedef unsigned short bf16;
typedef float f32x4 __attribute__((ext_vector_type(4)));
typedef float f32x2 __attribute__((ext_vector_type(2)));
typedef float f32x16 __attribute__((ext_vector_type(16)));
typedef short bf16x8 __attribute__((ext_vector_type(8)));
typedef short s16x4 __attribute__((ext_vector_type(4)));
typedef unsigned u32x4 __attribute__((ext_vector_type(4)));
typedef unsigned u32x2 __attribute__((ext_vector_type(2)));
typedef __bf16 nbf16x2 __attribute__((ext_vector_type(2)));

constexpr int D = 1024, NB = 2, SEQ = 8192, T = NB * SEQ;
constexpr int HG_H = 8, HG_DK = 128, HG_DV = 128, HG_C = 64, HG_NC = SEQ / HG_C;
constexpr int RT_H = 4, RT_DK = 256, RT_DV = 512, RT_L = 512, RT_NS = SEQ / RT_L;
constexpr int PE_H = 8, PE_NK = 128, PE_K = 16, PE_Q = 256, PE_HALF = 128, PE_NE = PE_NK * PE_NK;
constexpr float EPS = 1e-6f;
constexpr int NTHREADS = 512, NWAVES = 8;
constexpr int LDS_BYTES = 147456;

constexpr size_t MiB = 1u << 20;
constexpr size_t WS_CTL = 0;
constexpr size_t WS_DEC = 1 * MiB;
constexpr size_t WS_SSQP = 2 * MiB;
constexpr size_t WS_SCL = 2 * MiB + 512 * 1024;
constexpr size_t WS_SSQX = 3 * MiB;
constexpr size_t WS_HN = 4 * MiB;
constexpr size_t WS_WINT = 36 * MiB;
constexpr size_t WS_ROPE = 60 * MiB;
constexpr size_t WS_A = 68 * MiB, WS_B = 100 * MiB, WS_C = 132 * MiB;
constexpr size_t WS_STH = 164 * MiB;
constexpr size_t WS_STR = 196 * MiB;
constexpr size_t WS_OHG = 228 * MiB;
constexpr size_t WS_GA = 68 * MiB, WS_GB = 100 * MiB;
constexpr size_t WS_W2 = 132 * MiB;
constexpr size_t WS_WHG = WS_W2, WS_WRET = WS_W2 + 2 * MiB, WS_WOUT = WS_W2 + 6 * MiB, WS_WQ = WS_W2 + 8 * MiB, WS_SK = WS_W2 + 12 * MiB;
constexpr size_t WS_EV = 145 * MiB;
constexpr size_t WS_MERGED = 177 * MiB;
constexpr size_t WS_EU = 209 * MiB;
constexpr size_t WS_M1 = 4 * MiB;
constexpr size_t WS_X1 = 4 * MiB;
constexpr size_t WS_XW = 68 * MiB;
constexpr size_t WS_TOPS = 100 * MiB, WS_TOPI = 116 * MiB;
constexpr size_t WS_EIDX = 177 * MiB, WS_EGATE = 185 * MiB;
constexpr size_t WS_SA = WS_SCL + 192 * 1024;
constexpr size_t WS_SB = WS_SCL + 256 * 1024;
constexpr size_t CTL_AMAX = 65536;
constexpr size_t CTL_BYTES = 131072;
constexpr size_t WS_XQ8 = 161 * MiB;
constexpr size_t WS_XS = WS_SCL + 128 * 1024;
constexpr size_t WS_PART = 68 * MiB;
constexpr size_t WS_WT = 193 * MiB;
constexpr size_t WS_END = 260 * MiB;

DI int fresh_tid() { int t = threadIdx.x; asm volatile("" : "+v"(t)); return t; }
DI float sigmoidf_(float x) { return __builtin_amdgcn_rcpf(1.f + __builtin_amdgcn_exp2f(x * -1.4426950408889634f)); }
DI float siluf_(float x) { return x * __builtin_amdgcn_rcpf(1.f + __builtin_amdgcn_exp2f(x * -1.4426950408889634f)); }
DI unsigned pk2(float lo, float hi) { f32x2 v = {lo, hi}; nbf16x2 b = __builtin_convertvector(v, nbf16x2); return __builtin_bit_cast(unsigned, b); }
DI bf16 f2bf(float f) { return (bf16)(pk2(f, 0.f) & 0xffffu); }
DI float bf2f(bf16 b) { return __uint_as_float(((unsigned)b) << 16); }
DI float bflo(unsigned u) { return __uint_as_float(u << 16); }
DI float bfhi(unsigned u) { return __uint_as_float(u & 0xffff0000u); }
DI float wave_sum(float v) {
#pragma unroll
    for (int o = 1; o < 64; o <<= 1) v += __shfl_xor(v, o);
    return v;
}
DI int crow(int reg, int h) { return (reg & 3) + 8 * (reg >> 2) + 4 * h; }

namespace pg8 {
#define PG8_LAS __attribute__((address_space(3)))
typedef unsigned short bf16_t;
typedef short bf16x8 __attribute__((ext_vector_type(8)));
typedef float f32x4 __attribute__((ext_vector_type(4)));
typedef unsigned u32x4 __attribute__((ext_vector_type(4)));
constexpr int BM = 256, BK = 64, HALF = 128, HTB = HALF * BK * 2  , STAGE_BYTES = 8 * HTB, NXCD = 8, WGM = 8;

__host__ __device__ __forceinline__ int lds_byte(int r, int c) { const int st = (r >> 4) * 2 + (c >> 5), rr = r & 15, cc = c & 31, ob = rr * 64 + cc * 2; return st * 1024 + (ob ^ (((ob >> 9) & 1) << 5)); }
__host__ __device__ __forceinline__ void stage_rc(int b, int& R, int& C) { const int st = b / 1024, sb = b % 1024, swz = sb ^ (((sb >> 9) & 1) << 5); R = (st >> 1) * 16 + swz / 64; C = (st & 1) * 32 + (swz % 64) / 2; }
__host__ __device__ __forceinline__ int perm32(int rho) { const int n = rho >> 4, i = rho & 15; return 8 * (i >> 2) + 4 * n + (i & 3); }

struct Unit { int pm, pn; };
struct Gemm { const bf16_t* A; const bf16_t* Bt; int M, N, K; };

struct StaticOrder {
    int nM, nN, nwg, G, c;
    __host__ __device__ void init(int M, int N, int G_, int c_) { nM = M / BM; nN = N / BM; nwg = nM * nN; G = G_; c = c_; }
    __host__ __device__ bool next(int i, Unit& u) const {
        const long L = (long)i * G + c; if (L >= nwg) return false;
        int wgid = (int)L; { const int q = nwg / NXCD, r = nwg % NXCD, xcd = wgid % NXCD, off = wgid / NXCD; wgid = (xcd < r ? xcd * (q + 1) : r * (q + 1) + (xcd - r) * q) + off; }
        const int nig = WGM * nN, gid = wgid / nig, fm = gid * WGM, gsz = (nM - fm) < WGM ? (nM - fm) : WGM;
        u.pm = fm + ((wgid % nig) % gsz); u.pn = (wgid % nig) / gsz; return true;
    }
    __device__ __forceinline__ void a_ready(const Unit&) const {}
    __device__ __forceinline__ void done(const Unit&) const {}
};

__device__ __forceinline__ unsigned cvt_pk_bf16(float lo, float hi) { unsigned r; asm volatile("v_cvt_pk_bf16_f32 %0, %1, %2" : "=v"(r) : "v"(lo), "v"(hi)); return r; }
typedef float f32x2 __attribute__((ext_vector_type(2)));
typedef int i32x4 __attribute__((ext_vector_type(4)));
template <bool I8> __device__ __forceinline__ f32x4 mma16(const bf16x8& b, const bf16x8& a, const f32x4& c) {
    if constexpr (I8) return __builtin_bit_cast(f32x4, __builtin_amdgcn_mfma_i32_16x16x64_i8(__builtin_bit_cast(i32x4, b), __builtin_bit_cast(i32x4, a), __builtin_bit_cast(i32x4, c), 0, 0, 0));
    else return __builtin_amdgcn_mfma_f32_16x16x32_bf16(b, a, c, 0, 0, 0);
}
template <class E, class = void> struct EpiSwap { static constexpr bool v = false; };
template <class E> struct EpiSwap<E, decltype((void)E::SWAP)> { static constexpr bool v = E::SWAP; };
template <class Epi, class Sched, bool ALIGN_EPI = false, bool SP2 = false, bool I8 = false>
__device__ __forceinline__ void gemm_phase(PG8_LAS unsigned char* lds, const Gemm g, const Sched& S, const Epi& E) {
    const int tid = fresh_tid(), wid = __builtin_amdgcn_readfirstlane(tid >> 6), lane = tid & 63, wr = wid >> 2, wc = wid & 3, fr = lane & 15, fq = lane >> 4;
    const int K = g.K, nt = K / BK;
    unsigned voffA[2], voffB[2];
#pragma unroll
    for (int i = 0; i < 2; ++i) { int R, C; stage_rc(tid * 16 + i * 8192, R, C); const int Rb = Epi::PERM ? ((R & ~31) + perm32(R & 31)) : R;
        voffA[i] = (unsigned)(R * K + C) * 2u; voffB[i] = (unsigned)(Rb * K + C) * 2u; }
    const size_t kstep = (size_t)(BK * 2);
    const size_t hstep = (size_t)HALF * K * 2;
    const size_t tstep = 2 * hstep;
    const unsigned ldsw = (unsigned)wid * 1024u;
    const int aoff = lds_byte(wr * 64 + fr, fq * 8), boff = lds_byte(wc * 32 + fr, fq * 8);
#define PG8_SA(b, h) (((b) * 2 + (h)) * HTB)
#define PG8_SB(b, h) ((4 + (b) * 2 + (h)) * HTB)
#define PG8_STAGE(bufoff, gbase, voff) do { _Pragma("unroll") for (int _i = 0; _i < 2; ++_i) \
        __builtin_amdgcn_global_load_lds((const unsigned*)((const char*)(gbase) + (voff)[_i]), (PG8_LAS unsigned*)(lds + (bufoff) + ldsw + _i * 8192), 16, 0, 0); } while (0)
#define PG8_LDA(dst, b, h) do { _Pragma("unroll") for (int m = 0; m < 4; ++m) _Pragma("unroll") for (int k = 0; k < 2; ++k) dst[m][k] = *(const PG8_LAS bf16x8*)(lds + PG8_SA(b, h) + aoff + m * 2048 + k * 1024); } while (0)
#define PG8_LDB(dst, b, h) do { _Pragma("unroll") for (int n = 0; n < 2; ++n) _Pragma("unroll") for (int k = 0; k < 2; ++k) dst[n][k] = *(const PG8_LAS bf16x8*)(lds + PG8_SB(b, h) + boff + n * 2048 + k * 1024); } while (0)
#define PG8_MMA(ai, bj, At, Bt) do { __builtin_amdgcn_s_setprio(1); _Pragma("unroll") for (int m = 0; m < 4; ++m) _Pragma("unroll") for (int n = 0; n < 2; ++n) _Pragma("unroll") for (int k = 0; k < 2; ++k) \
        acc[ai][bj][m][n] = EpiSwap<Epi>::v ? mma16<I8>(At[m][k], Bt[n][k], acc[ai][bj][m][n]) : mma16<I8>(Bt[n][k], At[m][k], acc[ai][bj][m][n]); __builtin_amdgcn_s_setprio(0); } while (0)
#define PG8_WAIT_V(n) asm volatile("s_waitcnt vmcnt(" #n ")" ::: "memory")
#define PG8_WAIT_L(n) asm volatile("s_waitcnt lgkmcnt(" #n ")" ::: "memory")
#define PG8_BAR __builtin_amdgcn_s_barrier()
#define PG8_SCHED __builtin_amdgcn_sched_barrier(0)
    Unit cur, nxt; int ui = 0;
    if (!S.next(0, cur)) return;
    f32x4 acc[2][2][4][2];
#pragma unroll
    for (int a = 0; a < 2; ++a)
#pragma unroll
        for (int b = 0; b < 2; ++b)
#pragma unroll
            for (int m = 0; m < 4; ++m)
#pragma unroll
                for (int n = 0; n < 2; ++n) acc[a][b][m][n] = (f32x4){0.f, 0.f, 0.f, 0.f};
    bf16x8 At[4][2], B0[2][2], B1[2][2];
    const char* cA = (const char*)g.A + (size_t)cur.pm * tstep; const char* cB = (const char*)g.Bt + (size_t)cur.pn * tstep;
    S.a_ready(cur);
    if constexpr (SP2) {
        PG8_STAGE(PG8_SB(0, 0), cB, voffB); PG8_STAGE(PG8_SB(0, 1), cB + hstep, voffB); PG8_STAGE(PG8_SA(0, 0), cA, voffA); PG8_STAGE(PG8_SA(0, 1), cA + hstep, voffA);
        if (wr == 1) PG8_BAR;
        PG8_WAIT_V(2); PG8_BAR;
        PG8_STAGE(PG8_SB(1, 0), cB + kstep, voffB); PG8_STAGE(PG8_SA(1, 0), cA + kstep, voffA); PG8_STAGE(PG8_SB(1, 1), cB + hstep + kstep, voffB);
        PG8_WAIT_V(6); PG8_BAR;
    } else {
        PG8_STAGE(PG8_SB(0, 0), cB, voffB); PG8_STAGE(PG8_SA(0, 0), cA, voffA); PG8_STAGE(PG8_SB(0, 1), cB + hstep, voffB); PG8_STAGE(PG8_SA(0, 1), cA + hstep, voffA);
        if (wr == 1) PG8_BAR;
        PG8_WAIT_V(4); PG8_BAR;
        PG8_STAGE(PG8_SB(1, 0), cB + kstep, voffB); PG8_STAGE(PG8_SA(1, 0), cA + kstep, voffA); PG8_STAGE(PG8_SB(1, 1), cB + hstep + kstep, voffB);
        PG8_WAIT_V(6); PG8_BAR;
    }
    for (;;) {
        const bool has_next = S.next(ui + 1, nxt);
        const char* nA = has_next ? (const char*)g.A + (size_t)nxt.pm * tstep : cA; const char* nB = has_next ? (const char*)g.Bt + (size_t)nxt.pn * tstep : cB;
        for (int t = 0; t < nt; t += 2) {
            const bool last = (t == nt - 2);
            const char* a1 = cA + (size_t)(t + 1) * kstep;
            const char* a2 = last ? nA : cA + (size_t)(t + 2) * kstep; const char* b2 = last ? nB : cB + (size_t)(t + 2) * kstep;
            const char* a3 = a2 + kstep; const char* b3 = b2 + kstep;
            if (last && has_next) S.a_ready(nxt);
            if constexpr (SP2) {
            PG8_LDB(B0, 0, 0); PG8_LDB(B1, 0, 1); PG8_SCHED; PG8_LDA(At, 0, 0); PG8_STAGE(PG8_SA(1, 1), a1 + hstep, voffA);
            PG8_WAIT_V(8); PG8_WAIT_L(0); PG8_BAR; PG8_MMA(0, 0, At, B0); PG8_MMA(0, 1, At, B1); PG8_BAR; PG8_SCHED;
            PG8_LDA(At, 0, 1); PG8_STAGE(PG8_SB(0, 0), b2, voffB); PG8_STAGE(PG8_SB(0, 1), b2 + hstep, voffB); PG8_STAGE(PG8_SA(0, 0), a2, voffA);
            PG8_WAIT_V(8); PG8_WAIT_L(0); PG8_BAR; PG8_MMA(1, 0, At, B0); PG8_MMA(1, 1, At, B1); PG8_BAR; PG8_SCHED;
            PG8_LDB(B0, 1, 0); PG8_LDB(B1, 1, 1); PG8_SCHED; PG8_LDA(At, 1, 0); PG8_STAGE(PG8_SA(0, 1), a2 + hstep, voffA);
            PG8_WAIT_V(8); PG8_WAIT_L(0); PG8_BAR; PG8_MMA(0, 0, At, B0); PG8_MMA(0, 1, At, B1); PG8_BAR; PG8_SCHED;
            PG8_LDA(At, 1, 1); PG8_STAGE(PG8_SB(1, 0), b3, voffB); PG8_STAGE(PG8_SB(1, 1), b3 + hstep, voffB); PG8_STAGE(PG8_SA(1, 0), a3, voffA);
            PG8_WAIT_V(8); PG8_WAIT_L(0); PG8_BAR; PG8_MMA(1, 0, At, B0); PG8_MMA(1, 1, At, B1); PG8_BAR; PG8_SCHED;
            } else {
            PG8_LDB(B0, 0, 0); PG8_SCHED; PG8_LDA(At, 0, 0); PG8_STAGE(PG8_SA(1, 1), a1 + hstep, voffA);
            PG8_WAIT_L(8); PG8_BAR; PG8_WAIT_L(0); PG8_MMA(0, 0, At, B0); PG8_BAR; PG8_SCHED;
            PG8_LDB(B1, 0, 1); PG8_STAGE(PG8_SB(0, 0), b2, voffB);
            PG8_BAR; PG8_WAIT_L(0); PG8_MMA(0, 1, At, B1); PG8_BAR;
            PG8_LDA(At, 0, 1); PG8_STAGE(PG8_SA(0, 0), a2, voffA);
            PG8_BAR; PG8_WAIT_L(0); PG8_MMA(1, 0, At, B0); PG8_BAR; PG8_SCHED;
            PG8_STAGE(PG8_SB(0, 1), b2 + hstep, voffB);
            PG8_WAIT_V(6); PG8_BAR; PG8_MMA(1, 1, At, B1); PG8_BAR;
            PG8_LDB(B0, 1, 0); PG8_SCHED; PG8_LDA(At, 1, 0); PG8_STAGE(PG8_SA(0, 1), a2 + hstep, voffA);
            PG8_WAIT_L(8); PG8_BAR; PG8_WAIT_L(0); PG8_MMA(0, 0, At, B0); PG8_BAR; PG8_SCHED;
            PG8_LDB(B1, 1, 1); PG8_STAGE(PG8_SB(1, 0), b3, voffB);
            PG8_BAR; PG8_WAIT_L(0); PG8_MMA(0, 1, At, B1); PG8_BAR;
            PG8_LDA(At, 1, 1); PG8_STAGE(PG8_SA(1, 0), a3, voffA);
            PG8_BAR; PG8_WAIT_L(0); PG8_MMA(1, 0, At, B0); PG8_BAR; PG8_SCHED;
            PG8_STAGE(PG8_SB(1, 1), b3 + hstep, voffB);
            PG8_WAIT_V(6); PG8_BAR; PG8_MMA(1, 1, At, B1); PG8_BAR;
            }
        }
        if constexpr (ALIGN_EPI) { if (wr == 0) PG8_BAR; }
        if constexpr (!Epi::AFTER_DRAIN) { E(acc, cur, wr, wc, fr, fq); S.done(cur); }
        if (!has_next) break;
#pragma unroll
        for (int a = 0; a < 2; ++a)
#pragma unroll
            for (int b = 0; b < 2; ++b)
#pragma unroll
                for (int m = 0; m < 4; ++m)
#pragma unroll
                    for (int n = 0; n < 2; ++n) acc[a][b][m][n] = (f32x4){0.f, 0.f, 0.f, 0.f};
        cur = nxt; cA = nA; cB = nB; ++ui;
        if constexpr (ALIGN_EPI) { if (wr == 1) PG8_BAR; }
    }
    PG8_WAIT_V(0);
    if constexpr (!ALIGN_EPI) { if (wr == 0) PG8_BAR; }
    PG8_BAR;
    if constexpr (Epi::AFTER_DRAIN) { E.fused(acc, cur, wr, wc, fr, fq, lds, wid, lane); S.done(cur); }
#undef PG8_SA
#undef PG8_SB
#undef PG8_STAGE
#undef PG8_LDA
#undef PG8_LDB
#undef PG8_MMA
#undef PG8_WAIT_V
#undef PG8_WAIT_L
#undef PG8_BAR
#undef PG8_SCHED
}
}

using pg8::Unit;
typedef f32x4 Acc[2][2][4][2];

DI u32x4 pack8(const f32x4& a, const f32x4& b) { u32x4 w; w.x = pk2(a[0], a[1]); w.y = pk2(a[2], a[3]); w.z = pk2(b[0], b[1]); w.w = pk2(b[2], b[3]); return w; }

DI void st16_wt(void* p, const u32x4& v) {
#if USE_WT_STORES
    asm volatile("global_store_dwordx4 %0, %1, off sc1\n\ts_nop 1" :: "v"(p), "v"(v) : "memory");
#else
    *(u32x4*)p = v;
#endif
}
template <bool PRECVT = false> DI void dequant_acc(Acc& acc, const Unit& u, int wr, int wc, int fr, int fq, const float* SA, const float* SB) {
    f32x4 sb[2][2];
#pragma unroll
    for (int bj = 0; bj < 2; ++bj)
#pragma unroll
        for (int n = 0; n < 2; ++n) sb[bj][n] = *(const f32x4*)(SB + u.pn * 256 + bj * 128 + wc * 32 + 8 * fq + 4 * n);
#pragma unroll
    for (int ai = 0; ai < 2; ++ai)
#pragma unroll
        for (int m = 0; m < 4; ++m) {
            const float sa = SA[u.pm * 256 + ai * 128 + wr * 64 + m * 16 + fr];
#pragma unroll
            for (int bj = 0; bj < 2; ++bj)
#pragma unroll
                for (int n = 0; n < 2; ++n)
#pragma unroll
                    for (int e = 0; e < 4; ++e) acc[ai][bj][m][n][e] = (PRECVT ? acc[ai][bj][m][n][e] : (float)__float_as_int(acc[ai][bj][m][n][e])) * sa * sb[bj][n][e];
        }
}

template <int CTRL, bool ZERO> DI float dppf(float v) { return __int_as_float(__builtin_amdgcn_update_dpp(0, __float_as_int(v), CTRL, 0xF, 0xF, ZERO)); }

struct EpiH {
    static constexpr bool PERM = true, AFTER_DRAIN = false;
    bf16* Qh; bf16* Kh; bf16* VTh; float* DEC; const float* hlb; bf16* OHG; const float* SA; const float* SB; int skip;
    DI void operator()(Acc& acc, const Unit& u, int wr, int wc, int fr, int fq) const {
        if (PROBE_SKIP && (skip & (u.pn < 8 ? 1 : u.pn < 12 ? 2 : 4))) return;
        asm volatile("" : "+v"(fr), "+v"(fq));
        dequant_acc(acc, u, wr, wc, fr, fq, SA, SB);
        if (u.pn < 8) {
            const int h = u.pn, dbase = wc * 32 + 8 * fq;
#pragma unroll
            for (int ai = 0; ai < 2; ++ai) {
                const int row0 = u.pm * 256 + ai * 128 + wr * 64;
                const int bidx = row0 >> 13, chunk = (row0 & (SEQ - 1)) >> 6;
#pragma unroll
                for (int n = 0; n < 2; ++n) {
                    const f32x4 h0 = *(const f32x4*)(hlb + h * 128 + dbase + 4 * n), h1 = *(const f32x4*)(hlb + 1024 + h * 128 + dbase + 4 * n);
                    f32x4 ebl;
#pragma unroll
                    for (int e = 0; e < 4; ++e) {
                        const float lb = sigmoidf_(h0[e] - h1[e]), oml = 1.f - lb;
                        float f0, f1, f2, f3, kk[4];
                        {
                            float ff[4];
#pragma unroll
                            for (int m = 0; m < 4; ++m) {
                                const float E = __builtin_amdgcn_exp2f(acc[ai][1][m][n][e] * -1.4426950408889634f);
                                const float r = __builtin_amdgcn_rcpf(1.f + E), Er = 1.f - r;
                                ff[m] = fmaf(lb, Er, r); kk[m] = oml * Er;
                            }
                            f0 = ff[0]; f1 = ff[1]; f2 = ff[2]; f3 = ff[3];
                        }
                        asm volatile("s_nop 1\n"
                            "v_mul_f32_dpp %0, %0, %0 row_shr:1 row_mask:0xf bank_mask:0xf\n v_mul_f32_dpp %1, %1, %1 row_shr:1 row_mask:0xf bank_mask:0xf\n"
                            "v_mul_f32_dpp %2, %2, %2 row_shr:1 row_mask:0xf bank_mask:0xf\n v_mul_f32_dpp %3, %3, %3 row_shr:1 row_mask:0xf bank_mask:0xf\n"
                            "v_mul_f32_dpp %0, %0, %0 row_shr:2 row_mask:0xf bank_mask:0xf\n v_mul_f32_dpp %1, %1, %1 row_shr:2 row_mask:0xf bank_mask:0xf\n"
                            "v_mul_f32_dpp %2, %2, %2 row_shr:2 row_mask:0xf bank_mask:0xf\n v_mul_f32_dpp %3, %3, %3 row_shr:2 row_mask:0xf bank_mask:0xf\n"
                            "v_mul_f32_dpp %0, %0, %0 row_shr:4 row_mask:0xf bank_mask:0xf\n v_mul_f32_dpp %1, %1, %1 row_shr:4 row_mask:0xf bank_mask:0xf\n"
                            "v_mul_f32_dpp %2, %2, %2 row_shr:4 row_mask:0xf bank_mask:0xf\n v_mul_f32_dpp %3, %3, %3 row_shr:4 row_mask:0xf bank_mask:0xf\n"
                            "v_mul_f32_dpp %0, %0, %0 row_shr:8 row_mask:0xf bank_mask:0xf\n v_mul_f32_dpp %1, %1, %1 row_shr:8 row_mask:0xf bank_mask:0xf\n"
                            "v_mul_f32_dpp %2, %2, %2 row_shr:8 row_mask:0xf bank_mask:0xf\n v_mul_f32_dpp %3, %3, %3 row_shr:8 row_mask:0xf bank_mask:0xf\n"
                            "s_nop 1"
                            : "+v"(f0), "+v"(f1), "+v"(f2), "+v"(f3));
                        const float ps[4] = {f0, f1, f2, f3};
                        float carry = 1.f, P = 1.f;
#pragma unroll
                        for (int m = 0; m < 4; ++m) {
                            const float tot = dppf<0x15F, false>(ps[m]);
                            P = ps[m] * carry; carry *= tot;
                            acc[ai][0][m][n][e] = acc[ai][0][m][n][e] * (0.08838834764831845f * P);
                            acc[ai][1][m][n][e] = kk[m] * __builtin_amdgcn_rcpf(P);
                        }
                        ebl[e] = P;
                        __builtin_amdgcn_sched_barrier(0);
                    }
                    if (fr == 15) *(f32x4*)(DEC + ((size_t)((bidx * HG_H + h) * HG_NC + chunk)) * 128 + dbase + 4 * n) = ebl;
#pragma unroll
                    for (int m = 0; m < 4; ++m) {
                        const size_t row = (size_t)(row0 + m * 16 + fr);
                        const f32x4 qv = acc[ai][0][m][n], kv = acc[ai][1][m][n];
                        u32x2 oq, ok; oq.x = pk2(qv[0], qv[1]); oq.y = pk2(qv[2], qv[3]); ok.x = pk2(kv[0], kv[1]); ok.y = pk2(kv[2], kv[3]);
                        *(u32x2*)(Qh + row * 1024 + h * 128 + dbase + 4 * n) = oq;
                        *(u32x2*)(Kh + row * 1024 + h * 128 + dbase + 4 * n) = ok;
                    }
                    __builtin_amdgcn_sched_barrier(0);
                }
            }
            return;
        }
        if (false) {
        } else if (u.pn >= 12) {
            const int cb = (u.pn - 12) * 256 + wc * 32 + 8 * fq;
#pragma unroll
            for (int ai = 0; ai < 2; ++ai)
#pragma unroll
                for (int m = 0; m < 4; ++m) {
                    const size_t row = (size_t)(u.pm * 256 + ai * 128 + wr * 64 + m * 16 + fr);
#pragma unroll
                    for (int bj = 0; bj < 2; ++bj) {
                        f32x4 a0 = acc[ai][bj][m][0], a1 = acc[ai][bj][m][1];
#pragma unroll
                        for (int e = 0; e < 4; ++e) { a0[e] = siluf_(a0[e]); a1[e] = siluf_(a1[e]); }
                        st16_wt(OHG + row * 1024 + cb + bj * 128, pack8(a0, a1));
                    }
                }
        } else {
#pragma unroll
            for (int ai = 0; ai < 2; ++ai)
#pragma unroll
                for (int m = 0; m < 4; ++m) {
                    const int row = u.pm * 256 + ai * 128 + wr * 64 + m * 16 + fr, bidx = row >> 13, pos = row & (SEQ - 1);
                    bf16* ptr = VTh + (((size_t)(bidx * HG_H * 128 + (u.pn - 8) * 256 + wc * 32 + 8 * fq)) << 13) + pos;
#pragma unroll
                    for (int bj = 0; bj < 2; ++bj) {
#pragma unroll
                        for (int n = 0; n < 2; ++n)
#pragma unroll
                            for (int e = 0; e < 4; ++e) { asm volatile("" : "+v"(ptr)); *ptr = f2bf(acc[ai][bj][m][n][e]); ptr += 8192; }
                        ptr += (size_t)120 * 8192;
                    }
                }
        }
    }
};

struct EpiR {
    static constexpr bool PERM = true, AFTER_DRAIN = false;
    bf16* Qr; bf16* Kr; bf16* VTr; const float* COS; const float* SIN; bf16* ORET; const float* SA; const float* SB;
    DI void operator()(Acc& acc, const Unit& u, int wr, int wc, int fr, int fq) const {
        dequant_acc(acc, u, wr, wc, fr, fq, SA, SB);
        if (u.pn < 8) {
            const bool isk = u.pn >= 4; const int h = u.pn & 3;
            const float lg = __log2f(1.f - exp2f(-5.f - (float)h));
            bf16* dst = isk ? Kr : Qr;
            const int j0 = wc * 32 + 8 * fq;
            f32x4 cj[2];
#pragma unroll
            for (int n = 0; n < 2; ++n)
#pragma unroll
                for (int e = 0; e < 4; ++e) cj[n][e] = exp2f(-(float)(j0 + 4 * n + e) * 0.10381025296523008f) * 0.15915494309189535f;
#pragma unroll
            for (int ai = 0; ai < 2; ++ai)
#pragma unroll
                for (int m = 0; m < 4; ++m) {
                    const int row = u.pm * 256 + ai * 128 + wr * 64 + m * 16 + fr, pos = row & (SEQ - 1), il = pos & (RT_L - 1);
                    const float sc = isk ? exp2f(-lg * (float)il) * 0.0625f : exp2f(lg * (float)il);
                    const float fpos = (float)pos;
#pragma unroll
                    for (int n = 0; n < 2; ++n) {
                        f32x4 c, s;
#pragma unroll
                        for (int e = 0; e < 4; ++e) { const float rev = __builtin_amdgcn_fractf(fpos * cj[n][e]); c[e] = __builtin_amdgcn_cosf(rev); s[e] = __builtin_amdgcn_sinf(rev); }
                        const f32x4 x1 = acc[ai][0][m][n], x2 = acc[ai][1][m][n];
                        acc[ai][0][m][n] = (x1 * c - x2 * s) * sc; acc[ai][1][m][n] = (x1 * s + x2 * c) * sc;
                    }
                    st16_wt(dst + (size_t)row * 1024 + h * 256 + j0, pack8(acc[ai][0][m][0], acc[ai][0][m][1]));
                    st16_wt(dst + (size_t)row * 1024 + h * 256 + 128 + j0, pack8(acc[ai][1][m][0], acc[ai][1][m][1]));
                }
        } else {
            const int cb = (u.pn - 8) * 256 + wc * 32 + 8 * fq;
#pragma unroll
            for (int ai = 0; ai < 2; ++ai)
#pragma unroll
                for (int m = 0; m < 4; ++m) {
                    const size_t row = (size_t)(u.pm * 256 + ai * 128 + wr * 64 + m * 16 + fr);
#pragma unroll
                    for (int bj = 0; bj < 2; ++bj) {
                        f32x4 a0 = acc[ai][bj][m][0], a1 = acc[ai][bj][m][1];
#pragma unroll
                        for (int e = 0; e < 4; ++e) { a0[e] = siluf_(a0[e]); a1[e] = siluf_(a1[e]); }
                        st16_wt(ORET + row * 2048 + cb + bj * 128, pack8(a0, a1));
                    }
                }
        }
    }
};
struct EpiRV {
    static constexpr bool PERM = false, AFTER_DRAIN = false, SWAP = true;
    bf16* VTr; const float* SA; const float* SB;
    DI void operator()(Acc& acc, const Unit& u, int wr, int wc, int fr, int fq) const {
        float sb[2][2];
#pragma unroll
        for (int bj = 0; bj < 2; ++bj)
#pragma unroll
            for (int n = 0; n < 2; ++n) sb[bj][n] = SB[u.pn * 256 + bj * 128 + wc * 32 + 16 * n + fr];
        const int hd = u.pn >> 1, hs = fq & 1, j0 = (fq >> 1) * 4;
#pragma unroll
        for (int ai = 0; ai < 2; ++ai)
#pragma unroll
            for (int m = 0; m < 4; ++m) {
                const int row0 = u.pm * 256 + ai * 128 + wr * 64 + m * 16, bidx = row0 >> 13, pos0 = row0 & (SEQ - 1), ks = (pos0 >> 4) & 1, sblk = pos0 >> 5;
                const f32x4 sa = *(const f32x4*)(SA + row0 + 4 * fq);
#pragma unroll
                for (int bj = 0; bj < 2; ++bj) {
                    const int nv = (u.pn & 1) * 8 + bj * 4 + wc;
#pragma unroll
                    for (int n = 0; n < 2; ++n) {
                        const f32x4 a = acc[ai][bj][m][n];
                        const float s = sb[bj][n];
                        u32x2 o;
                        o.x = pk2((float)__float_as_int(a[0]) * sa[0] * s, (float)__float_as_int(a[1]) * sa[1] * s);
                        o.y = pk2((float)__float_as_int(a[2]) * sa[2] * s, (float)__float_as_int(a[3]) * sa[3] * s);
                        *(u32x2*)(VTr + ((((size_t)((bidx * RT_H + hd) * 256 + sblk) * 16 + nv) * 2 + ks) * 64 + (16 * n + fr + 32 * hs)) * 8 + j0) = o;
                    }
                }
            }
    }
};

struct EpiG {
    static constexpr bool PERM = true, AFTER_DRAIN = false;
    bf16* GA; bf16* GB; const float* SA; const float* SB;
    DI void operator()(Acc& acc, const Unit& u, int wr, int wc, int fr, int fq) const {
        dequant_acc(acc, u, wr, wc, fr, fq, SA, SB);
        const int cb = wc * 32 + 8 * fq;
        bf16* base = (u.pn < 4 ? GA + (size_t)u.pn * 256 : GB + (size_t)(u.pn - 4) * 256) + cb;
#pragma unroll
        for (int ai = 0; ai < 2; ++ai)
#pragma unroll
            for (int m = 0; m < 4; ++m) {
                const size_t row = (size_t)(u.pm * 256 + ai * 128 + wr * 64 + m * 16 + fr);
#pragma unroll
                for (int bj = 0; bj < 2; ++bj) {
                    f32x4 a0 = acc[ai][bj][m][0], a1 = acc[ai][bj][m][1];
#pragma unroll
                    for (int e = 0; e < 4; ++e) { a0[e] = sigmoidf_(a0[e]); a1[e] = sigmoidf_(a1[e]); }
                    st16_wt(base + row * 1024 + bj * 128, pack8(a0, a1));
                }
            }
    }
};

struct EpiM1 {
    static constexpr bool PERM = true, AFTER_DRAIN = false;
    bf16* MERGED; const bf16* GA;
    DI void operator()(Acc& acc, const Unit& u, int wr, int wc, int fr, int fq) const {
        const int cb = u.pn * 256 + wc * 32 + 8 * fq;
#pragma unroll
        for (int ai = 0; ai < 2; ++ai)
#pragma unroll
            for (int m = 0; m < 4; ++m) {
                const size_t row = (size_t)(u.pm * 256 + ai * 128 + wr * 64 + m * 16 + fr);
#pragma unroll
                for (int bj = 0; bj < 2; ++bj) {
                    const u32x4 g = *(const u32x4*)(GA + row * 1024 + cb + bj * 128);
                    f32x4 a0 = acc[ai][bj][m][0], a1 = acc[ai][bj][m][1];
                    a0[0] *= bflo(g.x); a0[1] *= bfhi(g.x); a0[2] *= bflo(g.y); a0[3] *= bfhi(g.y);
                    a1[0] *= bflo(g.z); a1[1] *= bfhi(g.z); a1[2] *= bflo(g.w); a1[3] *= bfhi(g.w);
                    st16_wt(MERGED + row * 1024 + cb + bj * 128, pack8(a0, a1));
                }
            }
    }
};
struct EpiMerge {
    static constexpr bool PERM = true, AFTER_DRAIN = false;
    const bf16* GB; bf16* MERGED;
    DI void operator()(Acc& acc, const Unit& u, int wr, int wc, int fr, int fq) const {
        const int cb = u.pn * 256 + wc * 32 + 8 * fq;
#pragma unroll
        for (int ai = 0; ai < 2; ++ai)
#pragma unroll
            for (int m = 0; m < 4; ++m) {
                const size_t row = (size_t)(u.pm * 256 + ai * 128 + wr * 64 + m * 16 + fr);
#pragma unroll
                for (int bj = 0; bj < 2; ++bj) {
                    const u32x4 g = *(const u32x4*)(GB + row * 1024 + cb + bj * 128);
                    const u32x4 mo = *(const u32x4*)(MERGED + row * 1024 + cb + bj * 128);
                    f32x4 a0 = acc[ai][bj][m][0], a1 = acc[ai][bj][m][1];
                    a0[0] = a0[0] * bflo(g.x) + bflo(mo.x); a0[1] = a0[1] * bfhi(g.x) + bfhi(mo.x); a0[2] = a0[2] * bflo(g.y) + bflo(mo.y); a0[3] = a0[3] * bfhi(g.y) + bfhi(mo.y);
                    a1[0] = a1[0] * bflo(g.z) + bflo(mo.z); a1[1] = a1[1] * bfhi(g.z) + bfhi(mo.z); a1[2] = a1[2] * bflo(g.w) + bflo(mo.w); a1[3] = a1[3] * bfhi(g.w) + bfhi(mo.w);
                    st16_wt(MERGED + row * 1024 + cb + bj * 128, pack8(a0, a1));
                }
            }
    }
};
struct EpiOut {
    static constexpr bool PERM = true, AFTER_DRAIN = false;
    const float* X; float* X1; bf16* XW; const float* nw; float* SSQX;
    DI void operator()(Acc& acc, const Unit& u, int wr, int wc, int fr, int fq) const {
        const int cb = u.pn * 256 + wc * 32 + 8 * fq;
#pragma unroll
        for (int ai = 0; ai < 2; ++ai)
#pragma unroll
            for (int m = 0; m < 4; ++m) {
                const size_t row = (size_t)(u.pm * 256 + ai * 128 + wr * 64 + m * 16 + fr);
                float ss = 0.f;
#pragma unroll
                for (int bj = 0; bj < 2; ++bj) {
                    const size_t off = row * 1024 + cb + bj * 128;
                    const f32x4 x0 = *(const f32x4*)(X + off), x1v = *(const f32x4*)(X + off + 4);
                    const f32x4 w0 = *(const f32x4*)(nw + cb + bj * 128), w1 = *(const f32x4*)(nw + cb + bj * 128 + 4);
                    const f32x4 a0 = acc[ai][bj][m][0] + x0, a1 = acc[ai][bj][m][1] + x1v;
                    *(f32x4*)(X1 + off) = a0; *(f32x4*)(X1 + off + 4) = a1;
                    ss += (a0[0] * a0[0] + a0[1] * a0[1]) + (a0[2] * a0[2] + a0[3] * a0[3]) + (a1[0] * a1[0] + a1[1] * a1[1]) + (a1[2] * a1[2] + a1[3] * a1[3]);
                    st16_wt(XW + off, pack8(a0 * w0, a1 * w1));
                }
                ss += __shfl_xor(ss, 16); ss += __shfl_xor(ss, 32);
                if (fq == 0) SSQX[row * 16 + u.pn * 4 + wc] = ss;
            }
    }
};
DI float rstd_x1(const float* SSQX, size_t row) {
    const f32x4 a = *(const f32x4*)(SSQX + row * 16), b = *(const f32x4*)(SSQX + row * 16 + 4), c = *(const f32x4*)(SSQX + row * 16 + 8), d = *(const f32x4*)(SSQX + row * 16 + 12);
    const float s = ((a[0] + a[1]) + (a[2] + a[3])) + ((b[0] + b[1]) + (b[2] + b[3])) + ((c[0] + c[1]) + (c[2] + c[3])) + ((d[0] + d[1]) + (d[2] + d[3]));
    return rsqrtf(s * (1.f / 1024.f) + EPS);
}
struct EpiQ {
    static constexpr bool PERM = true, AFTER_DRAIN = false;
    bf16* Q; const float* SSQX;
    DI void operator()(Acc& acc, const Unit& u, int wr, int wc, int fr, int fq) const {
        const int cb = u.pn * 256 + wc * 32 + 8 * fq;
#pragma unroll
        for (int ai = 0; ai < 2; ++ai)
#pragma unroll
            for (int m = 0; m < 4; ++m) {
                const size_t row = (size_t)(u.pm * 256 + ai * 128 + wr * 64 + m * 16 + fr);
                const float rs = rstd_x1(SSQX, row);
#pragma unroll
                for (int bj = 0; bj < 2; ++bj) st16_wt(Q + row * 2048 + cb + bj * 128, pack8(acc[ai][bj][m][0] * rs, acc[ai][bj][m][1] * rs));
            }
    }
};

#define MFMA32(a, b, c) __builtin_amdgcn_mfma_f32_32x32x16_bf16((a), (b), (c), 0, 0, 0)
DI bf16x8 ldg16(const bf16* p) { return *(const bf16x8*)p; }
DI bf16x8 ldg2x8(const bf16* p0, const bf16* p1) { const s16x4 a = *(const s16x4*)p0, b = *(const s16x4*)p1; return __builtin_shufflevector(a, b, 0, 1, 2, 3, 4, 5, 6, 7); }
DI bf16x8 packx(const f32x16& x, int s) {
    u32x4 p; p.x = pk2(x[8 * s + 0], x[8 * s + 1]); p.y = pk2(x[8 * s + 2], x[8 * s + 3]); p.z = pk2(x[8 * s + 4], x[8 * s + 5]); p.w = pk2(x[8 * s + 6], x[8 * s + 7]);
    return __builtin_bit_cast(bf16x8, p);
}
DI f32x16 zero16() { f32x16 z;
#pragma unroll
    for (int i = 0; i < 16; ++i) z[i] = 0.f; return z; }

DI bf16x8 tr_frag(const LAS unsigned char* tile, int RS, int lane, int ks, int c) {
    const int hh = lane >> 5, blk = (lane >> 4) & 1, q = (lane & 15) >> 2, p = lane & 3;
    const LAS unsigned char* a0 = tile + (16 * ks + 8 * hh + q) * RS + (32 * c + 16 * blk + 4 * p) * 2;
    const s16x4 lo = __builtin_amdgcn_ds_read_tr16_b64_v4i16((LAS s16x4*)a0);
    const s16x4 hi = __builtin_amdgcn_ds_read_tr16_b64_v4i16((LAS s16x4*)(a0 + 4 * RS));
    return __builtin_shufflevector(lo, hi, 0, 1, 2, 3, 4, 5, 6, 7);
}

DI bf16x8 tr_frag_perm(const LAS unsigned char* tile, int RS, int lane, int ks, int c) {
    const int hh = lane >> 5, blk = (lane >> 4) & 1, q = (lane & 15) >> 2, p = lane & 3;
    const LAS unsigned char* a0 = tile + (16 * ks + 4 * hh + q) * RS + (32 * c + 16 * blk + 4 * p) * 2;
    const s16x4 lo = __builtin_amdgcn_ds_read_tr16_b64_v4i16((LAS s16x4*)a0);
    const s16x4 hi = __builtin_amdgcn_ds_read_tr16_b64_v4i16((LAS s16x4*)(a0 + 8 * RS));
    return __builtin_shufflevector(lo, hi, 0, 1, 2, 3, 4, 5, 6, 7);
}

constexpr int HG_KRS = 320;
DI void hg_pass1(LAS unsigned char* lds, const bf16* Kh, const bf16* VTh, bf16* STh, int wg, int nwg) {
    const int tid = fresh_tid(), lane = tid & 63, w = __builtin_amdgcn_readfirstlane(tid >> 6), r = lane & 31, hh = lane >> 5;
    for (int unit = wg; unit < 16 * HG_NC; unit += nwg) {
        const int bh = unit >> 7, c = unit & 127, b = bh >> 3, h = bh & 7;
        __syncthreads();
        {
            const int row = tid >> 3, ch = tid & 7;
            const bf16* src = Kh + ((size_t)(b * SEQ + c * 64 + row)) * 1024 + h * 128;
            const bf16x8 v0 = ldg16(src + ch * 8), v1 = ldg16(src + 64 + ch * 8);
            *(LAS bf16x8*)(lds + row * HG_KRS + ch * 16) = v0; *(LAS bf16x8*)(lds + row * HG_KRS + 128 + ch * 16) = v1;
        }
        __syncthreads();
        const int mt = w & 3, nt0 = w >> 2;
        f32x16 a0 = zero16(), a1 = zero16();
        const bf16* vrow = VTh + (((size_t)(bh * 128 + 32 * mt + r)) << 13) + c * 64;
#pragma unroll
        for (int ks = 0; ks < 4; ++ks) {
            const bf16x8 av = ldg16(vrow + 16 * ks + 8 * hh);
            a0 = MFMA32(av, tr_frag(lds, HG_KRS, lane, ks, nt0), a0);
            a1 = MFMA32(av, tr_frag(lds, HG_KRS, lane, ks, nt0 + 2), a1);
        }
        bf16* dst = STh + ((size_t)(bh * HG_NC + c)) * 16384;
#pragma unroll
        for (int i = 0; i < 16; ++i) {
            const int v = 32 * mt + crow(i, hh);
            dst[v * 128 + 32 * nt0 + r] = f2bf(a0[i]); dst[v * 128 + 32 * (nt0 + 2) + r] = f2bf(a1[i]);
        }
    }
    __syncthreads();
}

DI void hg_scan(bf16* STh, const float* DEC, int gtid, int gsz) {
    for (int idx = gtid; idx < 16 * 128 * 32; idx += gsz) {
        const int dq = idx & 31, v = (idx >> 5) & 127, bh = idx >> 12;
        f32x4 carry = {0.f, 0.f, 0.f, 0.f};
        bf16* p = STh + ((size_t)bh * HG_NC) * 16384 + v * 128 + dq * 4;
        const float* dp = DEC + ((size_t)bh * HG_NC) * 128 + dq * 4;
#pragma unroll 8
        for (int c = 0; c < HG_NC; ++c) {
            const u32x2 wv = *(const u32x2*)(p + (size_t)c * 16384);
            const f32x4 dec = *(const f32x4*)(dp + c * 128);
            u32x2 o; o.x = pk2(carry[0], carry[1]); o.y = pk2(carry[2], carry[3]);
            *(u32x2*)(p + (size_t)c * 16384) = o;
            carry[0] = dec[0] * (carry[0] + bflo(wv.x)); carry[1] = dec[1] * (carry[1] + bfhi(wv.x));
            carry[2] = dec[2] * (carry[2] + bflo(wv.y)); carry[3] = dec[3] * (carry[3] + bfhi(wv.y));
        }
    }
}
DI void rt_scan(bf16* STr, int gtid, int gsz) {
    for (int idx = gtid; idx < 8 * 512 * 32; idx += gsz) {
        const int dq = idx & 31, v = (idx >> 5) & 511, bh = idx >> 14, h = bh & 3;
        const float dec = exp2f((float)RT_L * __log2f(1.f - exp2f(-5.f - (float)h)));
        float carry[8];
#pragma unroll
        for (int e = 0; e < 8; ++e) carry[e] = 0.f;
        bf16* p = STr + ((size_t)bh * RT_NS) * 131072 + v * 256 + dq * 8;
#pragma unroll 4
        for (int c = 0; c < RT_NS; ++c) {
            const u32x4 wv = *(const u32x4*)(p + (size_t)c * 131072);
            u32x4 o; o.x = pk2(carry[0], carry[1]); o.y = pk2(carry[2], carry[3]); o.z = pk2(carry[4], carry[5]); o.w = pk2(carry[6], carry[7]);
            *(u32x4*)(p + (size_t)c * 131072) = o;
            if (c == RT_NS - 1) break;
            carry[0] = dec * (carry[0] + bflo(wv.x)); carry[1] = dec * (carry[1] + bfhi(wv.x));
            carry[2] = dec * (carry[2] + bflo(wv.y)); carry[3] = dec * (carry[3] + bfhi(wv.y));
            carry[4] = dec * (carry[4] + bflo(wv.z)); carry[5] = dec * (carry[5] + bfhi(wv.z));
            carry[6] = dec * (carry[6] + bflo(wv.w)); carry[7] = dec * (carry[7] + bfhi(wv.w));
        }
    }
}

DI void hg_pass3(LAS unsigned char* lds, const bf16* Qh, const bf16* Kh, const bf16* VTh, const bf16* STh, const float* hg_norm_w, bf16* OHG, int gw, int ngw, int dry) {
    const int tid_ = fresh_tid(), lane = tid_ & 63, r = lane & 31, hh = lane >> 5;
    LAS unsigned char* ot = lds + __builtin_amdgcn_readfirstlane(tid_ >> 6) * 8704;
    for (int unit = gw; unit < 16 * HG_NC * 2; unit += ngw) {
        const int tb = unit & 1, c = (unit >> 1) & 127, bh = unit >> 8, b = bh >> 3, h = bh & 7;
        const size_t trow = (size_t)(b * SEQ + c * 64 + tb * 32 + r);
        bf16x8 qf[8];
#pragma unroll
        for (int kk = 0; kk < 8; ++kk) qf[kk] = ldg16(Qh + trow * 1024 + h * 128 + kk * 16 + 8 * hh);
        f32x16 acc[4];
#pragma unroll
        for (int nv = 0; nv < 4; ++nv) acc[nv] = zero16();
        for (int sb = 0; sb <= tb; ++sb) {
            const size_t srow = (size_t)(b * SEQ + c * 64 + sb * 32 + r);
            f32x16 x = zero16();
#pragma unroll
            for (int kk = 0; kk < 8; ++kk) x = MFMA32(ldg16(Kh + srow * 1024 + h * 128 + kk * 16 + 8 * hh), qf[kk], x);
            if (sb == tb) {
#pragma unroll
                for (int i = 0; i < 16; ++i) if (crow(i, hh) > r) x[i] = 0.f;
            }
            const bf16x8 xs0 = packx(x, 0), xs1 = packx(x, 1);
#pragma unroll
            for (int nv = 0; nv < 4; ++nv) {
                const bf16* vb = VTh + (((size_t)(bh * 128 + nv * 32 + r)) << 13) + c * 64 + sb * 32 + 4 * hh;
                acc[nv] = MFMA32(ldg2x8(vb, vb + 8), xs0, acc[nv]);
                acc[nv] = MFMA32(ldg2x8(vb + 16, vb + 24), xs1, acc[nv]);
            }
        }
        const bf16* st = STh + ((size_t)(bh * HG_NC + c)) * 16384;
#pragma unroll
        for (int nv = 0; nv < 4; ++nv)
#pragma unroll
            for (int kk = 0; kk < 8; ++kk) acc[nv] = MFMA32(ldg16(st + (nv * 32 + r) * 128 + kk * 16 + 8 * hh), qf[kk], acc[nv]);
        float ss = 0.f;
#pragma unroll
        for (int nv = 0; nv < 4; ++nv)
#pragma unroll
            for (int i = 0; i < 16; ++i) ss += acc[nv][i] * acc[nv][i];
        ss += __shfl_xor(ss, 32);
        const float rs = rsqrtf(ss * (1.f / 128.f) + EPS);
#pragma unroll
        for (int nv = 0; nv < 4; ++nv)
#pragma unroll
            for (int g = 0; g < 4; ++g) {
                const int v = nv * 32 + 8 * g + 4 * hh;
                const f32x4 wv = *(const f32x4*)(hg_norm_w + h * 128 + v);
                u32x2 o; o.x = pk2(acc[nv][4 * g] * rs * wv[0], acc[nv][4 * g + 1] * rs * wv[1]); o.y = pk2(acc[nv][4 * g + 2] * rs * wv[2], acc[nv][4 * g + 3] * rs * wv[3]);
                *(LAS u32x2*)(ot + r * 272 + v * 2) = o;
            }
        bf16* orow = OHG + ((size_t)(b * SEQ + c * 64 + tb * 32)) * 1024 + h * 128;
#pragma unroll
        for (int k = 0; k < 8; ++k) {
            const int row = 4 * k + (lane >> 4), ch = lane & 15;
            const u32x4 val = *(const LAS u32x4*)(ot + row * 272 + ch * 16);
            bf16* gp = orow + (size_t)row * 1024 + ch * 8;
            const u32x4 gt = *(const u32x4*)gp;
            u32x4 o;
            o.x = pk2(bflo(val.x) * bflo(gt.x), bfhi(val.x) * bfhi(gt.x)); o.y = pk2(bflo(val.y) * bflo(gt.y), bfhi(val.y) * bfhi(gt.y));
            o.z = pk2(bflo(val.z) * bflo(gt.z), bfhi(val.z) * bfhi(gt.z)); o.w = pk2(bflo(val.w) * bflo(gt.w), bfhi(val.w) * bfhi(gt.w));
            if (!dry) *(u32x4*)gp = o; else asm volatile("" :: "v"(o));
        }
    }
}

constexpr int RT_KRS = 576;
constexpr int RT_KBUF = 64 * RT_KRS;
DI void rt_pass1(LAS unsigned char* lds, const bf16* Kr, const bf16* VTr, bf16* STr, int wg, int nwg) {
    const int tid = fresh_tid(), lane = tid & 63, w = __builtin_amdgcn_readfirstlane(tid >> 6), r = lane & 31, hh = lane >> 5;
    const int wm = w & 3, wn = w >> 2;
    const int srow = tid >> 3, sch = tid & 7;
    for (int unit = wg; unit < 8 * (RT_NS - 1) * 2; unit += nwg) {
        const int vh = unit & 1, sg = (unit >> 1) % (RT_NS - 1), bh = (unit >> 1) / (RT_NS - 1), b = bh >> 2, h = bh & 3;
        f32x16 acc[2][4];
#pragma unroll
        for (int i = 0; i < 2; ++i)
#pragma unroll
            for (int j = 0; j < 4; ++j) acc[i][j] = zero16();
        const bf16* kbase = Kr + ((size_t)(b * SEQ + sg * RT_L)) * 1024 + h * 256;
        bf16x8 st[4];
#pragma unroll
        for (int i = 0; i < 4; ++i) st[i] = ldg16(kbase + (size_t)srow * 1024 + (sch + 8 * i) * 8);
        __syncthreads();
#pragma unroll
        for (int i = 0; i < 4; ++i) *(LAS bf16x8*)(lds + srow * RT_KRS + (sch + 8 * i) * 16) = st[i];
        for (int sb = 0; sb < RT_L / 64; ++sb) {
            const LAS unsigned char* cur = lds + (sb & 1) * RT_KBUF;
            if (sb + 1 < RT_L / 64) {
#pragma unroll
                for (int i = 0; i < 4; ++i) st[i] = ldg16(kbase + (size_t)((sb + 1) * 64 + srow) * 1024 + (sch + 8 * i) * 8);
            }
            __syncthreads();
#pragma unroll
            for (int ks = 0; ks < 4; ++ks) {
                bf16x8 av[2];
#pragma unroll
                for (int i = 0; i < 2; ++i) av[i] = ldg16(VTr + (((((size_t)(bh * 256 + sg * 16 + sb * 2 + (ks >> 1))) * 16 + vh * 8 + wm * 2 + i) * 2 + (ks & 1)) * 64 + lane) * 8);
#pragma unroll
                for (int j = 0; j < 4; ++j) {
                    const bf16x8 bv = tr_frag_perm(cur, RT_KRS, lane, ks, wn * 4 + j);
                    acc[0][j] = MFMA32(av[0], bv, acc[0][j]); acc[1][j] = MFMA32(av[1], bv, acc[1][j]);
                }
                __builtin_amdgcn_sched_barrier(0);
            }
            if (sb + 1 < RT_L / 64) {
                LAS unsigned char* nxt = lds + ((sb + 1) & 1) * RT_KBUF;
#pragma unroll
                for (int i = 0; i < 4; ++i) *(LAS bf16x8*)(nxt + srow * RT_KRS + (sch + 8 * i) * 16) = st[i];
            }
        }
        bf16* dst = STr + ((size_t)(bh * RT_NS + sg)) * 131072;
#pragma unroll
        for (int i = 0; i < 2; ++i)
#pragma unroll
            for (int j = 0; j < 4; ++j)
#pragma unroll
                for (int e = 0; e < 16; ++e) {
                    const int vl = crow(e, hh), d = wn * 128 + j * 32 + r;
                    dst[((((vh * 8 + wm * 2 + i) * 16 + (d >> 4)) * 64 + vl + 32 * ((d >> 3) & 1)) << 3) + (d & 7)] = f2bf(acc[i][j][e]);
                }
    }
    __syncthreads();
}

constexpr int RQ_RS = 528;
constexpr int RQ_QBYTES = 128 * RQ_RS, RQ_KBYTES = 32 * RQ_RS;
DI void rt_pass3_wg(LAS unsigned char* lds, const bf16* Qr, const bf16* Kr, const bf16* VTr, const bf16* STr, bf16* ORET, float* SSQP, int wg, int nwg, int dry) {
    const int tid = fresh_tid(), lane = tid & 63, w = __builtin_amdgcn_readfirstlane(tid >> 6), r = lane & 31, hh = lane >> 5;
    const int tsub = w & 3, vh = w >> 2;
    LAS unsigned char* Qs = lds;
    LAS unsigned char* Ks = lds + RQ_QBYTES;
    for (int pairidx = wg; pairidx < 256; pairidx += nwg) {
#pragma unroll 1
        for (int half = 0; half < 2; ++half) {
            const int sgid = pairidx >> 1, bh = sgid >> 4, sg = sgid & 15, b = bh >> 2, h = bh & 3;
            const int qq = half ? 3 - (pairidx & 1) : (pairidx & 1);
            const int pos0 = sg * RT_L + qq * 128, nsb = 4 * qq + 4, mysb = 4 * qq + tsub;
            const bf16* qsrc = Qr + ((size_t)(b * SEQ + pos0)) * 1024 + h * 256;
            const bf16* ksrc = Kr + ((size_t)(b * SEQ + sg * RT_L)) * 1024 + h * 256;
            unsigned stoff = (unsigned)((tid >> 5) * 1024 + (tid & 31) * 8);
            unsigned stlds = (unsigned)((tid >> 5) * RQ_RS + (tid & 31) * 16);
            asm volatile("" : "+v"(stoff), "+v"(stlds));
            __syncthreads();
#pragma unroll
            for (int i = 0; i < 8; ++i) *(LAS bf16x8*)(Qs + stlds + i * 16 * RQ_RS) = ldg16(qsrc + i * 16 * 1024 + stoff);
            bf16x8 kst[2];
#pragma unroll
            for (int i = 0; i < 2; ++i) *(LAS bf16x8*)(Ks + stlds + i * 16 * RQ_RS) = ldg16(ksrc + i * 16 * 1024 + stoff);
            f32x16 acc[8];
#pragma unroll
            for (int nv = 0; nv < 8; ++nv) acc[nv] = zero16();
            __syncthreads();
            const LAS unsigned char* qfr = Qs + (tsub * 32 + r) * RQ_RS + 16 * hh;
            {
                const bf16* st = STr + ((size_t)(bh * RT_NS + sg)) * 131072 + (size_t)(vh * 8) * 16 * 512;
                unsigned so = (unsigned)(lane * 8);
                asm volatile("" : "+v"(so));
                bf16x8 fa[8], fb[8];
#pragma unroll
                for (int nv = 0; nv < 8; ++nv) fa[nv] = ldg16(st + nv * 16 * 512 + so);
#pragma unroll 1
                for (int k2 = 0; k2 < 8; ++k2) {
#pragma unroll
                    for (int nv = 0; nv < 8; ++nv) fb[nv] = ldg16(st + nv * 16 * 512 + (2 * k2 + 1) * 512 + so);
                    {
                        const bf16x8 q = *(const LAS bf16x8*)(qfr + (2 * k2) * 32);
#pragma unroll
                        for (int nv = 0; nv < 8; ++nv) acc[nv] = MFMA32(fa[nv], q, acc[nv]);
                    }
                    __builtin_amdgcn_sched_barrier(0);
                    if (k2 < 7) {
#pragma unroll
                        for (int nv = 0; nv < 8; ++nv) fa[nv] = ldg16(st + nv * 16 * 512 + (2 * k2 + 2) * 512 + so);
                    }
                    {
                        const bf16x8 q = *(const LAS bf16x8*)(qfr + (2 * k2 + 1) * 32);
#pragma unroll
                        for (int nv = 0; nv < 8; ++nv) acc[nv] = MFMA32(fb[nv], q, acc[nv]);
                    }
                    __builtin_amdgcn_sched_barrier(0);
                }
            }
            const bf16* vbase = VTr + (((size_t)(bh * 256 + sg * 16)) * 16 + vh * 8) * 1024;
            unsigned vo = (unsigned)(lane * 8);
            asm volatile("" : "+v"(vo));
#pragma unroll 1
            for (int sb = 0; sb < nsb; ++sb) {
                const LAS unsigned char* kcur = Ks + (sb & 1) * RQ_KBYTES;
                if (sb + 1 < nsb) {
#pragma unroll
                    for (int i = 0; i < 2; ++i) kst[i] = ldg16(ksrc + (size_t)(sb + 1) * 32 * 1024 + i * 16 * 1024 + stoff);
                }
                if (sb <= mysb) {
                    bf16x8 vt[8][2];
                    const bf16* vb = vbase + (size_t)sb * 16 * 1024;
#pragma unroll
                    for (int nv = 0; nv < 8; ++nv) { vt[nv][0] = ldg16(vb + nv * 1024 + vo); vt[nv][1] = ldg16(vb + nv * 1024 + 512 + vo); }
                    f32x16 x = zero16();
                    const LAS unsigned char* kfr = kcur + r * RQ_RS + 16 * hh;
#pragma unroll
                    for (int kk = 0; kk < 16; ++kk) { x = MFMA32(*(const LAS bf16x8*)(kfr + kk * 32), *(const LAS bf16x8*)(qfr + kk * 32), x); if (kk & 1) __builtin_amdgcn_sched_barrier(0); }
                    if (sb == mysb) {
#pragma unroll
                        for (int i = 0; i < 16; ++i) if (crow(i, hh) > r) x[i] = 0.f;
                    }
                    const bf16x8 xs0 = packx(x, 0), xs1 = packx(x, 1);
#pragma unroll
                    for (int nv = 0; nv < 8; ++nv) { acc[nv] = MFMA32(vt[nv][0], xs0, acc[nv]); acc[nv] = MFMA32(vt[nv][1], xs1, acc[nv]); }
                }
                if (sb + 1 < nsb) {
                    LAS unsigned char* knx = Ks + ((sb + 1) & 1) * RQ_KBYTES;
#pragma unroll
                    for (int i = 0; i < 2; ++i) *(LAS bf16x8*)(knx + stlds + i * 16 * RQ_RS) = kst[i];
                }
                __syncthreads();
            }
            float ss = 0.f;
#pragma unroll
            for (int nv = 0; nv < 8; ++nv)
#pragma unroll
                for (int i = 0; i < 16; ++i) ss += acc[nv][i] * acc[nv][i];
            ss += __shfl_xor(ss, 32);
            LAS float* sx = (LAS float*)(lds + 8 * 16896);
            if (hh == 0) sx[vh * 128 + tsub * 32 + r] = ss;
            __syncthreads();
            const float rs = rsqrtf((sx[tsub * 32 + r] + sx[128 + tsub * 32 + r]) * (1.f / 512.f) + EPS);
            LAS unsigned char* ot = lds + w * 16896;
#pragma unroll
            for (int nv = 0; nv < 8; ++nv)
#pragma unroll
                for (int g = 0; g < 4; ++g) {
                    u32x2 o; o.x = pk2(acc[nv][4 * g] * rs, acc[nv][4 * g + 1] * rs); o.y = pk2(acc[nv][4 * g + 2] * rs, acc[nv][4 * g + 3] * rs);
                    *(LAS u32x2*)(ot + r * 528 + (nv * 32 + 8 * g + 4 * hh) * 2) = o;
                }
            bf16* orow = ORET + (size_t)(b * SEQ + pos0 + tsub * 32) * 2048 + h * 512 + vh * 256;
#pragma unroll 4
            for (int k = 0; k < 16; ++k) {
                const int row = 2 * k + (lane >> 5), ch = lane & 31;
                const u32x4 val = *(const LAS u32x4*)(ot + row * 528 + ch * 16);
                bf16* gp = orow + (size_t)row * 2048 + ch * 8;
                const u32x4 gt = *(const u32x4*)gp;
                u32x4 o;
                o.x = pk2(bflo(val.x) * bflo(gt.x), bfhi(val.x) * bfhi(gt.x)); o.y = pk2(bflo(val.y) * bflo(gt.y), bfhi(val.y) * bfhi(gt.y));
                o.z = pk2(bflo(val.z) * bflo(gt.z), bfhi(val.z) * bfhi(gt.z)); o.w = pk2(bflo(val.w) * bflo(gt.w), bfhi(val.w) * bfhi(gt.w));
                if (!dry) *(u32x4*)gp = o; else asm volatile("" :: "v"(o));
            }
        }
    }
    __syncthreads();
}

DI float dot2bf(unsigned a, unsigned b, float c) {
#if __has_builtin(__builtin_amdgcn_fdot2_f32_bf16)
    typedef __bf16 nb2 __attribute__((ext_vector_type(2)));
    return __builtin_amdgcn_fdot2_f32_bf16(__builtin_bit_cast(nb2, a), __builtin_bit_cast(nb2, b), c, false);
#else
    return c + bflo(a) * bflo(b) + bfhi(a) * bfhi(b);
#endif
}
DI unsigned key_pack(float s, unsigned lowbits, unsigned mask) {
    unsigned u = __float_as_uint(s); u = (u & 0x80000000u) ? ~u : (u | 0x80000000u);
    return (u & ~mask) | lowbits;
}
DI float key_val(unsigned k, unsigned mask) { unsigned u = k & ~mask; u = (u & 0x80000000u) ? (u & 0x7fffffffu) : ~u; return __uint_as_float(u); }
DI unsigned umin_(unsigned a, unsigned b) { return a < b ? a : b; }
DI unsigned umax_(unsigned a, unsigned b) { return a > b ? a : b; }
DI void ins16(unsigned (&t)[16], unsigned x) {
#pragma unroll
    for (int i = 15; i >= 1; --i) t[i] = umax_(umin_(t[i - 1], t[i]), umin_(umax_(t[i - 1], t[i]), x));
    t[0] = umax_(t[0], x);
}
constexpr int PR_KOFF = 20480, PR_KRS = 272;
DI void peer_retrieve(LAS unsigned char* lds, const bf16* Q, const bf16* SK, int* EIDX, float* EGATE, int wg, int nwg) {
    const int tid = fresh_tid(), lane = tid & 63, w = __builtin_amdgcn_readfirstlane(tid >> 6), r = lane & 31, hh = lane >> 5;
    LAS unsigned char* myl = lds + w * 2304 + lane * 36;
    LAS unsigned char* ks = lds + PR_KOFF;
    int staged_h = -1;
    for (int unit = 2 * wg; unit < 512; unit += (unit & 1) ? 2 * nwg - 1 : 1) {
        const int h = unit >> 6, tb = (unit & 63) * 8 + w;
        if (h != staged_h) {
            __syncthreads();
#pragma unroll
            for (int i = 0; i < 8; ++i) { const int cidx = tid + 512 * i, row = cidx >> 4, ch = cidx & 15;
                *(LAS bf16x8*)(ks + row * PR_KRS + ch * 16) = ldg16(SK + ((size_t)(h * 256 + row)) * 128 + ch * 8); }
            __syncthreads();
            staged_h = h;
        }
        const size_t trow = (size_t)(tb * 32 + r);
        bf16x8 qf[2][8];
        {
            const bf16* qrow = Q + trow * 2048 + h * 256 + 8 * hh;
#pragma unroll
            for (int p = 0; p < 2; ++p)
#pragma unroll
                for (int kk = 0; kk < 8; ++kk) qf[p][kk] = ldg16(qrow + p * 128 + kk * 16);
        }
        unsigned L[2][16];
#pragma unroll
        for (int p = 0; p < 2; ++p) {
            f32x16 acc[4];
#pragma unroll
            for (int mt = 0; mt < 4; ++mt) acc[mt] = zero16();
            const LAS unsigned char* kfr = ks + (p * 128 + r) * PR_KRS + 16 * hh;
#pragma unroll
            for (int kk = 0; kk < 8; ++kk) {
#pragma unroll
                for (int mt = 0; mt < 4; ++mt) acc[mt] = MFMA32(*(const LAS bf16x8*)(kfr + mt * 32 * PR_KRS + kk * 32), qf[p][kk], acc[mt]);
                if (kk & 1) __builtin_amdgcn_sched_barrier(0);
            }
            unsigned t[16];
#pragma unroll
            for (int i = 0; i < 16; ++i) t[i] = 0u;
#pragma unroll
            for (int mt = 0; mt < 4; ++mt)
#pragma unroll
                for (int i = 0; i < 16; ++i) ins16(t, key_pack(acc[mt][i], (unsigned)(127 - 32 * mt - (i & 3) - 8 * (i >> 2)) - 4u * (unsigned)hh, 127u));
            unsigned o[16];
#pragma unroll
            for (int i = 0; i < 16; ++i) o[i] = (unsigned)__shfl_xor((int)t[i], 32);
#pragma unroll
            for (int i = 0; i < 16; ++i) ins16(t, o[i]);
#pragma unroll
            for (int i = 0; i < 16; ++i) L[p][i] = t[i];
        }
#pragma unroll
        for (int p = 0; p < 2; ++p)
#pragma unroll
            for (int g = 0; g < 4; ++g) {
                const unsigned v = (127u - (L[p][4 * g] & 127u)) | ((127u - (L[p][4 * g + 1] & 127u)) << 8) | ((127u - (L[p][4 * g + 2] & 127u)) << 16) | ((127u - (L[p][4 * g + 3] & 127u)) << 24);
                *(LAS unsigned*)(myl + p * 16 + g * 4) = v;
            }
        float a[16], b[16];
#pragma unroll
        for (int i = 0; i < 16; ++i) { a[i] = key_val(L[0][i], 127u); b[i] = key_val(L[1][i], 127u); }
        unsigned c[16];
#pragma unroll
        for (int i = 0; i < 16; ++i) c[i] = 0u;
#pragma unroll
        for (int i = 0; i < 16; ++i)
#pragma unroll
            for (int j = 0; j < 16; ++j)
                if ((i + 1) * (j + 1) <= 16) ins16(c, key_pack(a[i] + b[j], (unsigned)(255 - (16 * i + j)), 255u));
        float v[16];
        float sum = 0.f;
        const float mx = key_val(c[0], 255u);
#pragma unroll
        for (int k = 0; k < 16; ++k) { v[k] = __expf(key_val(c[k], 255u) - mx); sum += v[k]; }
        const float inv = __builtin_amdgcn_rcpf(sum);
        asm volatile("s_waitcnt lgkmcnt(0)" ::: "memory");
        if (hh == 0) {
            int e[16];
#pragma unroll
            for (int k = 0; k < 16; ++k) {
                const unsigned cc = 255u - (c[k] & 255u);
                const unsigned i1 = *(LAS unsigned char*)(myl + (cc >> 4)), i2 = *(LAS unsigned char*)(myl + 16 + (cc & 15u));
                e[k] = (int)(i1 * 128u + i2);
            }
            int* ep = EIDX + trow * 128 + h * 16;
#pragma unroll
            for (int g = 0; g < 4; ++g) *(u32x4*)(ep + 4 * g) = (u32x4){(unsigned)e[4 * g], (unsigned)e[4 * g + 1], (unsigned)e[4 * g + 2], (unsigned)e[4 * g + 3]};
        } else {
            float* gp = EGATE + trow * 128 + h * 16;
#pragma unroll
            for (int g = 0; g < 4; ++g) *(f32x4*)(gp + 4 * g) = (f32x4){v[4 * g] * inv, v[4 * g + 1] * inv, v[4 * g + 2] * inv, v[4 * g + 3] * inv};
        }
        asm volatile("s_waitcnt lgkmcnt(0)" ::: "memory");
    }
}

DI float gelu_tanh(float x) {
    const float u2 = (-2.f * 0.7978845608028654f * 1.4426950408889634f) * (x + 0.044715f * x * x * x);
    return x * __builtin_amdgcn_rcpf(1.f + __builtin_amdgcn_exp2f(u2));
}

DI float bcast_f(float v, int j) { return __int_as_float(__builtin_amdgcn_readfirstlane(__float_as_int(__shfl(v, j)))); }
DI void quant_rows(const float* __restrict__ src, unsigned char* __restrict__ dst, float* __restrict__ scale, int nrows, int offs, int gw, int ngw, int lane) {
    for (int row0 = gw; row0 < nrows; row0 += 2 * ngw) {
        const int rowb = row0 + ngw, row1 = rowb < nrows ? rowb : row0;
        f32x4 v[2][4];
#pragma unroll
        for (int rr = 0; rr < 2; ++rr) { const f32x4* p = (const f32x4*)(src + (size_t)(rr ? row1 : row0) * 1024 + lane * 16);
#pragma unroll
            for (int i = 0; i < 4; ++i) v[rr][i] = p[i]; }
#pragma unroll
        for (int rr = 0; rr < 2; ++rr) {
            const int row = rr ? row1 : row0;
            float am = 0.f;
#pragma unroll
            for (int i = 0; i < 4; ++i)
#pragma unroll
                for (int e = 0; e < 4; ++e) am = fmaxf(am, fabsf(v[rr][i][e]));
#pragma unroll
            for (int o = 1; o < 64; o <<= 1) am = fmaxf(am, __shfl_xor(am, o));
            const float inv = am > 0.f ? 127.f * __builtin_amdgcn_rcpf(am) : 0.f;
            u32x4 w;
#pragma unroll
            for (int i = 0; i < 4; ++i) {
                unsigned pk = 0u;
#pragma unroll
                for (int e = 0; e < 4; ++e) { const int q = (int)rintf(v[rr][i][e] * inv) + offs; pk |= ((unsigned)q & 0xffu) << (8 * e); }
                w[i] = pk;
            }
            if (rr == 0 || rowb < nrows) {
                *(u32x4*)(dst + ((size_t)(lane >> 3) * nrows + row) * 128 + (lane & 7) * 16) = w;
                if (lane == 0) scale[row] = am > 0.f ? am * (1.f / 127.f) : 0.f;
            }
        }
    }
}
DI void quant_xw(const bf16* XW, unsigned char* XQ8, float* XS, int gw, int ngw, int lane) {
    for (int t = gw; t < T; t += ngw) {
        const u32x4 xa = *(const u32x4*)(XW + (size_t)t * 1024 + lane * 16), xb = *(const u32x4*)(XW + (size_t)t * 1024 + lane * 16 + 8);
        float xf[16] = {bflo(xa.x), bfhi(xa.x), bflo(xa.y), bfhi(xa.y), bflo(xa.z), bfhi(xa.z), bflo(xa.w), bfhi(xa.w),
                        bflo(xb.x), bfhi(xb.x), bflo(xb.y), bfhi(xb.y), bflo(xb.z), bfhi(xb.z), bflo(xb.w), bfhi(xb.w)};
        float am = 0.f;
#pragma unroll
        for (int i = 0; i < 16; ++i) am = fmaxf(am, fabsf(xf[i]));
#pragma unroll
        for (int o = 1; o < 64; o <<= 1) am = fmaxf(am, __shfl_xor(am, o));
        const float inv = am > 0.f ? 127.f * __builtin_amdgcn_rcpf(am) : 0.f;
        u32x4 w;
#pragma unroll
        for (int i = 0; i < 4; ++i) { unsigned pk = 0u;
#pragma unroll
            for (int e = 0; e < 4; ++e) pk |= ((unsigned)((int)rintf(xf[4 * i + e] * inv)) & 0xffu) << (8 * e);
            w[i] = pk; }
        *(u32x4*)(XQ8 + ((size_t)(lane >> 3) * T + t) * 128 + (lane & 7) * 16) = w;
        if (lane == 0) XS[t] = am * (1.f / 127.f);
    }
}
DI int dpp_xor1(int v) { return __builtin_amdgcn_update_dpp(0, v, 0xB1, 0xF, 0xF, false); }
DI int dpp_xor2(int v) { return __builtin_amdgcn_update_dpp(0, v, 0x4E, 0xF, 0xF, false); }
DI int dpp_hmir(int v) { return __builtin_amdgcn_update_dpp(0, v, 0x141, 0xF, 0xF, false); }
DI void peer_u(const unsigned char* EU8, const unsigned char* XQ8, const int* EIDX, int* PART, int slice, int tok0, int tokstep, int lane) {
    const int q = lane >> 3, i = lane & 7;
    const unsigned char* tab = EU8 + (size_t)slice * PE_NE * 128 + i * 16;
#define PU_LOAD(dst, t_) do { const u32x4* ep_ = (const u32x4*)(EIDX + (size_t)(t_) * 128 + 16 * q); const u32x4 e0_ = ep_[0], e1_ = ep_[1], e2_ = ep_[2], e3_ = ep_[3]; \
        const unsigned ee_[16] = {e0_.x, e0_.y, e0_.z, e0_.w, e1_.x, e1_.y, e1_.z, e1_.w, e2_.x, e2_.y, e2_.z, e2_.w, e3_.x, e3_.y, e3_.z, e3_.w}; \
        _Pragma("unroll") for (int g = 0; g < 16; ++g) dst[g] = *(const u32x4*)(tab + (size_t)ee_[g] * 128); } while (0)
    u32x4 ub[16], nb[16];
    if (tok0 < T) PU_LOAD(ub, tok0);
    for (int t = tok0; t < T; t += tokstep) {
        const u32x4 xv = *(const u32x4*)(XQ8 + ((size_t)slice * T + t) * 128 + i * 16);
        if (t + tokstep < T) PU_LOAD(nb, t + tokstep);
        int d0 = 0, d1 = 0;
#pragma unroll
        for (int g = 0; g < 16; ++g) {
            int s = __builtin_amdgcn_sdot4((int)ub[g].x, (int)xv.x, 0, false);
            s = __builtin_amdgcn_sdot4((int)ub[g].y, (int)xv.y, s, false); s = __builtin_amdgcn_sdot4((int)ub[g].z, (int)xv.z, s, false); s = __builtin_amdgcn_sdot4((int)ub[g].w, (int)xv.w, s, false);
            s += dpp_xor1(s); s += dpp_xor2(s); s += dpp_hmir(s);
            if (g < 8) { if (i == g) d0 = s; } else { if (i == g - 8) d1 = s; }
        }
        int* pp = PART + ((size_t)slice * T + t) * 128 + 16 * q + i;
        pp[0] = d0; pp[8] = d1;
#pragma unroll
        for (int g = 0; g < 16; ++g) ub[g] = nb[g];
    }
#undef PU_LOAD
}
DI void peer_w(const int* PART, const int* EIDX, const float* EGATE, const float* SU, const float* SV, const float* XS, const float* SSQX, unsigned char* WQ8, float* WSC, int gw, int ngw, int lane) {
    for (int t = gw; t < T; t += ngw) {
        const size_t base = (size_t)t * 128 + 2 * lane;
        int d0 = 0, d1 = 0;
#pragma unroll
        for (int s = 0; s < 8; ++s) { const u32x2 pv = *(const u32x2*)(PART + (size_t)s * T * 128 + base); d0 += (int)pv.x; d1 += (int)pv.y; }
        const u32x2 ev = *(const u32x2*)(EIDX + base); const f32x2 gv = *(const f32x2*)(EGATE + base);
        const float sc = XS[t] * rstd_x1(SSQX, (size_t)t);
        const float w0 = gv[0] * SV[ev.x] * gelu_tanh((float)d0 * (SU[ev.x] * sc)), w1 = gv[1] * SV[ev.y] * gelu_tanh((float)d1 * (SU[ev.y] * sc));
        float am = fmaxf(fabsf(w0), fabsf(w1));
#pragma unroll
        for (int o = 1; o < 64; o <<= 1) am = fmaxf(am, __shfl_xor(am, o));
        const float inv = am > 0.f ? 127.f * __builtin_amdgcn_rcpf(am) : 0.f;
        const unsigned q0 = (unsigned)((int)rintf(w0 * inv)) & 0xffu, q1 = (unsigned)((int)rintf(w1 * inv)) & 0xffu;
        *(unsigned short*)(WQ8 + base) = (unsigned short)(q0 | (q1 << 8));
        if (lane == 0) WSC[t] = am * (1.f / 127.f);
    }
}
DI unsigned perm_(unsigned s0, unsigned s1, unsigned sel) { return __builtin_amdgcn_perm(s0, s1, sel); }
DI void peer_v(const unsigned char* EV8, const int* EIDX, const unsigned char* WQ8, const float* WSC, float* X1, int slice, int tok0, int tokstep, int lane, int dry) {
    const int q = lane >> 3, i = lane & 7;
    const unsigned char* tab = EV8 + (size_t)slice * PE_NE * 128 + i * 16;
#define PV_LOAD(dst, t_) do { const u32x4* ep_ = (const u32x4*)(EIDX + (size_t)(t_) * 128 + 16 * q); const u32x4 e0_ = ep_[0], e1_ = ep_[1], e2_ = ep_[2], e3_ = ep_[3]; \
        const unsigned ee_[16] = {e0_.x, e0_.y, e0_.z, e0_.w, e1_.x, e1_.y, e1_.z, e1_.w, e2_.x, e2_.y, e2_.z, e2_.w, e3_.x, e3_.y, e3_.z, e3_.w}; \
        _Pragma("unroll") for (int g = 0; g < 16; ++g) dst[g] = *(const u32x4*)(tab + (size_t)ee_[g] * 128); } while (0)
    u32x4 vb[16], nb[16];
    if (tok0 < T) PV_LOAD(vb, tok0);
    for (int t = tok0; t < T; t += tokstep) {
        const u32x4 wqv = *(const u32x4*)(WQ8 + (size_t)t * 128 + 16 * q);
        const float wsc = WSC[t];
        if (t + tokstep < T) PV_LOAD(nb, t + tokstep);
        const int wq[4] = {(int)wqv.x, (int)wqv.y, (int)wqv.z, (int)wqv.w};
        int o[16];
#pragma unroll
        for (int c = 0; c < 16; ++c) o[c] = 0;
#pragma unroll
        for (int m = 0; m < 4; ++m) {
#pragma unroll
            for (int k = 0; k < 4; ++k) {
                const unsigned a = vb[4 * m][k], b = vb[4 * m + 1][k], c = vb[4 * m + 2][k], dd = vb[4 * m + 3][k];
                const unsigned ablo = perm_(b, a, 0x05010400u), abhi = perm_(b, a, 0x07030602u), cdlo = perm_(dd, c, 0x05010400u), cdhi = perm_(dd, c, 0x07030602u);
                o[4 * k + 0] = __builtin_amdgcn_sdot4((int)perm_(cdlo, ablo, 0x05040100u), wq[m], o[4 * k + 0], false);
                o[4 * k + 1] = __builtin_amdgcn_sdot4((int)perm_(cdlo, ablo, 0x07060302u), wq[m], o[4 * k + 1], false);
                o[4 * k + 2] = __builtin_amdgcn_sdot4((int)perm_(cdhi, abhi, 0x05040100u), wq[m], o[4 * k + 2], false);
                o[4 * k + 3] = __builtin_amdgcn_sdot4((int)perm_(cdhi, abhi, 0x07060302u), wq[m], o[4 * k + 3], false);
            }
        }
        int r8[8], r4[4], r2[2];
#pragma unroll
        for (int c = 0; c < 8; ++c) { const int mine = (q & 4) ? o[c + 8] : o[c], theirs = (q & 4) ? o[c] : o[c + 8]; r8[c] = mine + __shfl_xor(theirs, 32); }
#pragma unroll
        for (int c = 0; c < 4; ++c) { const int mine = (q & 2) ? r8[c + 4] : r8[c], theirs = (q & 2) ? r8[c] : r8[c + 4]; r4[c] = mine + __shfl_xor(theirs, 16); }
#pragma unroll
        for (int c = 0; c < 2; ++c) { const int mine = (q & 1) ? r4[c + 2] : r4[c], theirs = (q & 1) ? r4[c] : r4[c + 2]; r2[c] = mine + __shfl_xor(theirs, 8); }
        float* xp = X1 + (size_t)t * 1024 + slice * 128 + i * 16 + 2 * q;
        f32x2 xv = *(const f32x2*)xp;
        xv[0] += (float)r2[0] * wsc; xv[1] += (float)r2[1] * wsc;
        if (!dry) *(f32x2*)xp = xv; else asm volatile("" :: "v"(xv));
#pragma unroll
        for (int g = 0; g < 16; ++g) vb[g] = nb[g];
    }
#undef PV_LOAD
}
DI void final_norm(const float* __restrict__ Y, const float* __restrict__ fw, float* __restrict__ OUT, int gw, int ngw, int lane, float dscale) {
    for (int t0 = gw; t0 < T; t0 += 2 * ngw) {
        const int tb = t0 + ngw, t1 = tb < T ? tb : t0;
        f32x4 v[2][4];
#pragma unroll
        for (int rr = 0; rr < 2; ++rr) { const f32x4* yr = (const f32x4*)(Y + (size_t)(rr ? t1 : t0) * 1024) + lane;
#pragma unroll
            for (int j = 0; j < 4; ++j) v[rr][j] = yr[64 * j]; }
#pragma unroll
        for (int rr = 0; rr < 2; ++rr) {
            float s = 0.f;
#pragma unroll
            for (int j = 0; j < 4; ++j) s += (v[rr][j][0] * v[rr][j][0] + v[rr][j][1] * v[rr][j][1]) + (v[rr][j][2] * v[rr][j][2] + v[rr][j][3] * v[rr][j][3]);
            const float rs = rsqrtf(wave_sum(s) * (1.f / 1024.f) + EPS) * dscale;
            if (rr == 0 || tb < T) {
                f32x4* o = (f32x4*)(OUT + (size_t)(rr ? t1 : t0) * 1024) + lane; const f32x4* wr4 = (const f32x4*)fw + lane;
#pragma unroll
                for (int j = 0; j < 4; ++j) { const f32x4 ww = wr4[64 * j]; o[64 * j] = (f32x4){v[rr][j][0] * rs * ww[0], v[rr][j][1] * rs * ww[1], v[rr][j][2] * rs * ww[2], v[rr][j][3] * rs * ww[3]}; }
            }
        }
    }
}

DI void transpose_item(const float* W, int K, int N, bf16* WT, int n_src0, int n_dst0, int k0, LAS float* scr, int lane) {
#pragma unroll 16
    for (int i = 0; i < 32; ++i) { const int kk = 2 * i + (lane >> 5); scr[kk * 33 + (lane & 31)] = W[(size_t)(k0 + kk) * N + n_src0 + (lane & 31)]; }
    asm volatile("s_waitcnt lgkmcnt(0)" ::: "memory");
    const int c = lane & 7;
#pragma unroll
    for (int j = 0; j < 4; ++j) { const int n = (lane >> 3) + 8 * j; const LAS float* s = scr + (8 * c) * 33 + n;
        u32x4 o; o.x = pk2(s[0 * 33], s[1 * 33]); o.y = pk2(s[2 * 33], s[3 * 33]); o.z = pk2(s[4 * 33], s[5 * 33]); o.w = pk2(s[6 * 33], s[7 * 33]);
        *(u32x4*)(WT + (size_t)(n_dst0 + n) * K + k0 + 8 * c) = o; }
    asm volatile("s_waitcnt lgkmcnt(0)" ::: "memory");
}
DI int win_orig_col(int np) {
    if (np < 2048) { const int h = np >> 8, sel = (np >> 7) & 1, d = np & 127; return sel * 1024 + h * 128 + d; }
    if (np >= 6144 && np < 8192) return np + 2048;
    if (np >= 8192 && np < 10240) return np - 2048;
    return np;
}
DI void rmsnorm_row_bf16(const float* xrow, const float* w, bf16* orow, int lane) {
    const f32x4* xr = (const f32x4*)xrow + lane; const f32x4* wr4 = (const f32x4*)w + lane;
    f32x4 v[4]; float s = 0.f;
#pragma unroll
    for (int j = 0; j < 4; ++j) { v[j] = xr[64 * j]; s += (v[j][0] * v[j][0] + v[j][1] * v[j][1]) + (v[j][2] * v[j][2] + v[j][3] * v[j][3]); }
    const float rs = rsqrtf(wave_sum(s) * (1.f / 1024.f) + EPS);
    u32x2* o8 = (u32x2*)orow + lane;
#pragma unroll
    for (int j = 0; j < 4; ++j) { const f32x4 ww = wr4[64 * j]; u32x2 o; o.x = pk2(v[j][0] * rs * ww[0], v[j][1] * rs * ww[1]); o.y = pk2(v[j][2] * rs * ww[2], v[j][3] * rs * ww[3]); o8[64 * j] = o; }
}
DI void transpose_item_q8(const float* W, int N, unsigned char* WT8, const LAS float* cmax, int n_src0, int n_dst0, int k0, LAS float* scr, int lane) {
#pragma unroll 16
    for (int i = 0; i < 32; ++i) { const int kk = 2 * i + (lane >> 5); scr[kk * 33 + (lane & 31)] = W[(size_t)(k0 + kk) * N + n_src0 + (lane & 31)]; }
    asm volatile("s_waitcnt lgkmcnt(0)" ::: "memory");
    const int c = lane & 3;
#pragma unroll
    for (int j = 0; j < 2; ++j) {
        const int n = (lane >> 2) + 16 * j;
        const float am = cmax[n], inv = am > 0.f ? 127.f * __builtin_amdgcn_rcpf(am) : 0.f;
        const LAS float* s = scr + (16 * c) * 33 + n;
        u32x4 o;
#pragma unroll
        for (int g = 0; g < 4; ++g) { unsigned pk = 0u;
#pragma unroll
            for (int e2 = 0; e2 < 4; ++e2) pk |= ((unsigned)((int)rintf(s[(4 * g + e2) * 33] * inv)) & 0xffu) << (8 * e2);
            o[g] = pk; }
        *(u32x4*)(WT8 + (size_t)(n_dst0 + n) * 1024 + k0 + 16 * c) = o;
    }
    asm volatile("s_waitcnt lgkmcnt(0)" ::: "memory");
}
DI void rmsnorm_rows_q8(const float* __restrict__ x, const float* __restrict__ w, unsigned char* __restrict__ HN8, float* __restrict__ SA, int row0, int nrows, int lane) {
    for (int m0 = row0; m0 < row0 + nrows; m0 += 2) {
        const int mb = m0 + 1, m1 = mb;
        f32x4 v[2][4];
#pragma unroll
        for (int rr = 0; rr < 2; ++rr) { const f32x4* xr = (const f32x4*)(x + (size_t)(rr ? m1 : m0) * 1024) + lane;
#pragma unroll
            for (int j = 0; j < 4; ++j) v[rr][j] = xr[64 * j]; }
        const f32x4* wr4 = (const f32x4*)w + lane;
#pragma unroll
        for (int rr = 0; rr < 2; ++rr) {
            float s = 0.f;
#pragma unroll
            for (int j = 0; j < 4; ++j) s += (v[rr][j][0] * v[rr][j][0] + v[rr][j][1] * v[rr][j][1]) + (v[rr][j][2] * v[rr][j][2] + v[rr][j][3] * v[rr][j][3]);
            const float rs = rsqrtf(wave_sum(s) * (1.f / 1024.f) + EPS);
            float am = 0.f;
#pragma unroll
            for (int j = 0; j < 4; ++j) { const f32x4 ww = wr4[64 * j];
#pragma unroll
                for (int e2 = 0; e2 < 4; ++e2) { v[rr][j][e2] = v[rr][j][e2] * rs * ww[e2]; am = fmaxf(am, fabsf(v[rr][j][e2])); } }
#pragma unroll
            for (int o = 1; o < 64; o <<= 1) am = fmaxf(am, __shfl_xor(am, o));
            const float inv = am > 0.f ? 127.f * __builtin_amdgcn_rcpf(am) : 0.f;
            if (rr == 0 || mb < T) {
                const int m = rr ? m1 : m0;
                unsigned* o4 = (unsigned*)(HN8 + (size_t)m * 1024) + lane;
#pragma unroll
                for (int j = 0; j < 4; ++j) { unsigned pk = 0u;
#pragma unroll
                    for (int e2 = 0; e2 < 4; ++e2) pk |= ((unsigned)((int)rintf(v[rr][j][e2] * inv)) & 0xffu) << (8 * e2);
                    o4[64 * j] = pk; }
                if (lane == 0) SA[m] = am * (1.f / 127.f);
            }
        }
    }
}
DI void convert_bf16(const float* src, bf16* dst, size_t n, size_t gtid, size_t gsz) {
    for (size_t i = gtid * 8; i < n; i += gsz * 8) {
        const f32x4 a = *(const f32x4*)(src + i), b = *(const f32x4*)(src + i + 4);
        *(u32x4*)(dst + i) = pack8(a, b);
    }
}

#define XB_TMO      128
#define XB_XCNT(j)  (256  + 64 * (j))
#define XB_XSUB(j)  (1280 + 64 * (j))
#define XB_XGEN(j)  (2304 + 64 * (j))
#define XB_TOP      3328
#define XB_TOPGEN   3392
#define XCD_BAR_WORDS 3456
#define XB_SPIN_CAP (1u << 18)

__device__ __forceinline__ unsigned xb_ld(unsigned* p)              { return __hip_atomic_load(p, __ATOMIC_RELAXED, __HIP_MEMORY_SCOPE_AGENT); }
__device__ __forceinline__ unsigned xb_add(unsigned* p, unsigned v) { return __hip_atomic_fetch_add(p, v, __ATOMIC_RELAXED, __HIP_MEMORY_SCOPE_AGENT); }
__device__ __forceinline__ unsigned xb_xcc_id() { return (unsigned)__builtin_amdgcn_s_getreg((3 << 11) | 20) & 0xFu; }
#define XB_SPIN(cond, bar) do { unsigned _sp = 0; while (cond) { __builtin_amdgcn_s_sleep(1); \
    if ((++_sp & 255u) == 0u) { if (xb_ld(&(bar)[XB_TMO])) break; if (_sp > XB_SPIN_CAP) { atomicAdd(&(bar)[XB_TMO], 1u); break; } } } } while (0)

struct XcdBarrier {
    unsigned* bar; unsigned x;
    volatile LAS unsigned* st;
};

__device__ __forceinline__ XcdBarrier xcd_barrier_post(unsigned* bar, volatile LAS unsigned* st) {
    XcdBarrier b; b.bar = bar; b.x = xb_xcc_id(); b.st = st;
    if (threadIdx.x == 0) (void)xb_add(&bar[XB_XCNT(b.x)], 1u);
    return b;
}
__device__ __forceinline__ void xcd_barrier_complete(unsigned* bar, unsigned x, unsigned& nloc, unsigned& nx) {
    const unsigned G = gridDim.x * gridDim.y * gridDim.z;
    unsigned sum, cnt, mine, sp = 0u;
    for (;;) {
        sum = 0u; cnt = 0u; mine = 0u;
#pragma unroll
        for (unsigned j = 0; j < 16; ++j) { const unsigned c = xb_ld(&bar[XB_XCNT(j)]); sum += c; cnt += (c > 0u) ? 1u : 0u; mine = (j == x) ? c : mine; }
        if (sum == G) break;
        __builtin_amdgcn_s_sleep(1);
        if ((++sp & 255u) == 0u) { if (xb_ld(&bar[XB_TMO])) break; if (sp > XB_SPIN_CAP) { atomicAdd(&bar[XB_TMO], 1u); break; } }
    }
    nloc = mine > 0u ? mine : 1u; nx = cnt > 0u ? cnt : 1u;
}

__device__ __forceinline__ void xcd_barrier(const XcdBarrier& b) {
    asm volatile("s_waitcnt vmcnt(0)" ::: "memory");
    __syncthreads();
    if (threadIdx.x == 0) {
        unsigned* bar = b.bar;
        __builtin_amdgcn_s_waitcnt(0);
        unsigned nloc = b.st[0], nx = b.st[1];
        if (nloc == 0u) { xcd_barrier_complete(bar, b.x, nloc, nx); b.st[0] = nloc; b.st[1] = nx; }
        const unsigned old = xb_add(&bar[XB_XSUB(b.x)], 1u);
        const unsigned gen = old / nloc;
        if (old + 1u == (gen + 1u) * nloc) {
            __builtin_amdgcn_fence(__ATOMIC_RELEASE, "agent");
            asm volatile("s_waitcnt vmcnt(0)" ::: "memory");
            const unsigned og = xb_add(&bar[XB_TOP], 1u);
            const unsigned tg = og / nx;
            if (og + 1u == (tg + 1u) * nx) xb_add(&bar[XB_TOPGEN], 1u);
            else XB_SPIN(xb_ld(&bar[XB_TOPGEN]) == tg, bar);
            __builtin_amdgcn_fence(__ATOMIC_ACQUIRE, "agent");
            xb_add(&bar[XB_XGEN(b.x)], 1u);
            asm volatile("s_waitcnt vmcnt(0)" ::: "memory");
        } else {
            XB_SPIN(xb_ld(&bar[XB_XGEN(b.x)]) == gen, bar);
            __builtin_amdgcn_fence(__ATOMIC_ACQUIRE, "agent");
            asm volatile("s_waitcnt vmcnt(0)" ::: "memory");
        }
    }
    __syncthreads();
}

struct Params { const float* in[14]; float* out; unsigned char* ws; };

__global__ void __launch_bounds__(NTHREADS, 2) fwd_megakernel(Params p) {
    extern __shared__ __attribute__((aligned(16))) unsigned char lds_raw[];
    LAS unsigned char* lds = (LAS unsigned char*)lds_raw;
    cg::grid_group grid = cg::this_grid();
    volatile LAS unsigned* bst = (volatile LAS unsigned*)(lds + LDS_BYTES - 64);
    if (threadIdx.x < 4) bst[threadIdx.x] = 0u;
    __syncthreads();
    XcdBarrier xbar = xcd_barrier_post((unsigned*)(p.ws + WS_CTL), bst);
    if (threadIdx.x == 0) bst[4] = xb_add((unsigned*)(p.ws + WS_CTL) + 3600 + xbar.x, 1u);
#if USE_CG_SYNC
#define GRID_SYNC() grid.sync()
#else
#define GRID_SYNC() xcd_barrier(xbar)
#endif
    unsigned long long* TS = (unsigned long long*)(p.ws + WS_CTL + 24576);
    int stamp_i_ = 0;
#define STAMP() do { if (STAMP_K >= 0 && blockIdx.x == 0 && threadIdx.x == 0) TS[stamp_i_] = __builtin_amdgcn_s_memrealtime(); ++stamp_i_; } while (0)
    STAMP();
    const int G = gridDim.x, wg = blockIdx.x;
#define PHASE_IDS const int tid = fresh_tid(), lane = tid & 63, wave = __builtin_amdgcn_readfirstlane(tid >> 6); \
    const int gw = wg * NWAVES + wave, ngw = G * NWAVES; const size_t gtid = (size_t)wg * NTHREADS + tid, gsz = (size_t)G * NTHREADS; \
    (void)lane; (void)gw; (void)ngw; (void)gtid; (void)gsz;
    unsigned char* ws = p.ws;
    const float* x = p.in[0];
    unsigned char* HN8 = ws + WS_HN; unsigned char* WinT8 = ws + WS_WINT; float* SA = (float*)(ws + WS_SA); float* SB = (float*)(ws + WS_SB);

    float* COS = (float*)(ws + WS_ROPE); float* SIN = COS + 8192 * 128;
    float* DEC = (float*)(ws + WS_DEC); float* SSQP = (float*)(ws + WS_SSQP); float* SSQX = (float*)(ws + WS_SSQX);
    bf16* BA = (bf16*)(ws + WS_A); bf16* BB = (bf16*)(ws + WS_B); bf16* BC = (bf16*)(ws + WS_C);
    bf16* STh = (bf16*)(ws + WS_STH); bf16* STr = (bf16*)(ws + WS_STR);
    bf16* OHG = (bf16*)(ws + WS_OHG); bf16* ORET = (bf16*)p.out;
    bf16* GA = (bf16*)(ws + WS_GA); bf16* GB = (bf16*)(ws + WS_GB);
    bf16* WhgT = (bf16*)(ws + WS_WHG); bf16* WretT = (bf16*)(ws + WS_WRET); bf16* WoutT = (bf16*)(ws + WS_WOUT); bf16* WqT = (bf16*)(ws + WS_WQ); bf16* SK = (bf16*)(ws + WS_SK);
    unsigned char* EV8 = ws + WS_EV; unsigned char* EU8 = ws + WS_EU; float* SU = (float*)(ws + WS_SCL); float* SV = SU + PE_NE;
    float* M1 = (float*)(ws + WS_M1); bf16* MERGED = (bf16*)(ws + WS_MERGED);
    float* X1 = (float*)(ws + WS_X1); bf16* XW = (bf16*)(ws + WS_XW); bf16* Qp = (bf16*)p.out;
    unsigned char* XQ8 = ws + WS_XQ8; float* XS = (float*)(ws + WS_XS); int* PART = (int*)(ws + WS_PART); unsigned char* WQ8 = ws + WS_WT; float* WSC = (float*)(ws + WS_WT + 4 * MiB);
    int* EIDX = (int*)(ws + WS_EIDX); float* EGATE = (float*)(ws + WS_EGATE);

    for (int rep_ = 0; rep_ < ((PROBE_MASK & 32) ? 2 : 1); ++rep_) {
    { PHASE_IDS LAS float* scr = (LAS float*)(lds + wave * 16384);
    LAS float* amx = (LAS float*)(lds + 131072); LAS float* cm = amx + 512;
    for (int strip = wg; strip < 192; strip += G) {
        const int nd0 = strip * 64, ns0 = win_orig_col(nd0);
        const int c4 = tid & 15, r = tid >> 4;
        const float* wp = p.in[2] + (size_t)(r * 32) * 12288 + ns0 + 4 * c4;
        f32x4 v[32];
#pragma unroll
        for (int i = 0; i < 32; ++i) v[i] = *(const f32x4*)(wp + (size_t)i * 12288);
        f32x4 am = {0.f, 0.f, 0.f, 0.f};
#pragma unroll
        for (int i = 0; i < 32; ++i)
#pragma unroll
            for (int e2 = 0; e2 < 4; ++e2) am[e2] = fmaxf(am[e2], fabsf(v[i][e2]));
#pragma unroll
        for (int e2 = 0; e2 < 4; ++e2) { am[e2] = fmaxf(am[e2], __shfl_xor(am[e2], 16)); am[e2] = fmaxf(am[e2], __shfl_xor(am[e2], 32)); }
        if (lane < 16) *(LAS f32x4*)(amx + wave * 64 + 4 * c4) = am;
        __syncthreads();
        if (tid < 64) { float m8 = 0.f;
#pragma unroll
            for (int w8 = 0; w8 < 8; ++w8) m8 = fmaxf(m8, amx[w8 * 64 + tid]);
            cm[tid] = m8; SB[nd0 + tid] = m8 * (1.f / 127.f); }
        __syncthreads();
        const f32x4 cmx = *(const LAS f32x4*)(cm + 4 * c4);
        LAS unsigned char* stg = (LAS unsigned char*)lds;
#pragma unroll
        for (int e2 = 0; e2 < 4; ++e2) {
            const float inv = cmx[e2] > 0.f ? 127.f * __builtin_amdgcn_rcpf(cmx[e2]) : 0.f;
#pragma unroll
            for (int i4 = 0; i4 < 8; ++i4) { unsigned pk = 0u;
#pragma unroll
                for (int b = 0; b < 4; ++b) pk |= ((unsigned)((int)rintf(v[4 * i4 + b][e2] * inv)) & 0xffu) << (8 * b);
                *(LAS unsigned*)(stg + (4 * c4 + e2) * 1028 + r * 32 + 4 * i4) = pk; }
        }
        __syncthreads();
#pragma unroll
        for (int j = 0; j < 8; ++j) {
            const int c = wave * 8 + j; u32x4 o;
#pragma unroll
            for (int q = 0; q < 4; ++q) o[q] = *(const LAS unsigned*)(stg + c * 1028 + lane * 16 + 4 * q);
            *(u32x4*)(WinT8 + (size_t)(nd0 + c) * 1024 + lane * 16) = o;
        }
        __syncthreads();
    }
    if (G != 256) { for (int r0 = (int)gw * 2; r0 < T; r0 += (int)ngw * 2) rmsnorm_rows_q8(x, p.in[1], HN8, SA, r0, 2, lane); }
    else if (wg < 192) rmsnorm_rows_q8(x, p.in[1], HN8, SA, (wg * 8 + wave) * 6, 6, lane);
    else rmsnorm_rows_q8(x, p.in[1], HN8, SA, 9216 + ((wg - 192) * 8 + wave) * 14, 14, lane);
    }
    __syncthreads(); }
    if (p.ws == nullptr) grid.sync();
    GRID_SYNC();
    STAMP();

    for (int rep_ = 0; rep_ < ((PROBE_MASK & 128) ? 2 : 1); ++rep_) {
    {
        pg8::Gemm g{(const bf16*)HN8, (const bf16*)WinT8, T, 4096, 512}; pg8::StaticOrder S; S.init(T, 4096, G, wg);
        EpiH E{BA, BB, BC, DEC, p.in[3], OHG, SA, SB, rep_ ? PROBE_SKIP : 0};
        pg8::gemm_phase<EpiH, pg8::StaticOrder, true, true, true>(lds, g, S, E);
    }
    __syncthreads(); }
    GRID_SYNC();
    STAMP();
    hg_pass1(lds, BB, BC, STh, wg, G);
#if PROBE_MASK & 4
    hg_pass1(lds, BB, BC, STh, wg, G);
#endif
    GRID_SYNC();
    STAMP();
    { PHASE_IDS hg_scan(STh, DEC, (int)gtid, (int)gsz); }
    GRID_SYNC();
    STAMP();
#if PROBE_MASK & 16384
    hg_pass1(lds, BB, BC, STh, wg, G);
    GRID_SYNC();
    STAMP();
    { PHASE_IDS hg_scan(STh, DEC, (int)gtid, (int)gsz); }
    GRID_SYNC();
    STAMP();
#endif
#if PROBE_MASK & 4
    { PHASE_IDS hg_pass3(lds, BA, BB, BC, STh, p.in[4], OHG, gw, ngw, 1); }
#endif
    { PHASE_IDS hg_pass3(lds, BA, BB, BC, STh, p.in[4], OHG, gw, ngw, 0); }
    GRID_SYNC();
    STAMP();

    for (int rep_ = 0; rep_ < ((PROBE_MASK & 2048) ? 2 : 1); ++rep_) {
    {
        pg8::Gemm g{(const bf16*)HN8, (const bf16*)(WinT8 + (size_t)4096 * 1024), T, 4096, 512}; pg8::StaticOrder S; S.init(T, 4096, G, wg);
        EpiR E{BA, BB, BC, COS, SIN, ORET, SA, SB + 4096};
        pg8::gemm_phase<EpiR, pg8::StaticOrder, true, true, true>(lds, g, S, E);
    }
    __syncthreads();
    {
        pg8::Gemm g{(const bf16*)HN8, (const bf16*)(WinT8 + (size_t)8192 * 1024), T, 2048, 512}; pg8::StaticOrder S; S.init(T, 2048, G, wg);
        EpiRV E{BC, SA, SB + 8192};
        pg8::gemm_phase<EpiRV, pg8::StaticOrder, true, true, true>(lds, g, S, E);
    }
    __syncthreads(); }
    GRID_SYNC();
    STAMP();
    rt_pass1(lds, BB, BC, STr, wg, G);
#if PROBE_MASK & 8
    rt_pass1(lds, BB, BC, STr, wg, G);
#endif
    GRID_SYNC();
    STAMP();
    { PHASE_IDS rt_scan(STr, (int)gtid, (int)gsz); }
    GRID_SYNC();
    STAMP();
#if PROBE_MASK & 32768
    rt_pass1(lds, BB, BC, STr, wg, G);
    GRID_SYNC();
    STAMP();
    { PHASE_IDS rt_scan(STr, (int)gtid, (int)gsz); }
    GRID_SYNC();
    STAMP();
#endif
#if PROBE_MASK & 1024
    rt_pass3_wg(lds, BA, BB, BC, STr, ORET, SSQP, wg, G, 1);
#endif
    rt_pass3_wg(lds, BA, BB, BC, STr, ORET, SSQP, wg, G, 0);
    GRID_SYNC();
    STAMP();

    for (int rep_ = 0; rep_ < ((PROBE_MASK & 64) ? 2 : 1); ++rep_) {
    { PHASE_IDS LAS float* scr = (LAS float*)(lds + wave * 16384);
    for (int it = gw; it < 3072; it += ngw) {
        int r = it;
        if (r < 512) { transpose_item(p.in[5], 1024, 1024, WhgT, (r % 32) * 32, (r % 32) * 32, (r / 32) * 64, scr, lane); continue; } r -= 512;
        if (r < 1024) { transpose_item(p.in[6], 2048, 1024, WretT, (r % 32) * 32, (r % 32) * 32, (r / 32) * 64, scr, lane); continue; } r -= 1024;
        if (r < 512) { transpose_item(p.in[7], 1024, 1024, WoutT, (r % 32) * 32, (r % 32) * 32, (r / 32) * 64, scr, lane); continue; } r -= 512;
        transpose_item(p.in[9], 1024, 2048, WqT, (r % 64) * 32, (r % 64) * 32, (r / 64) * 64, scr, lane);
    }
    convert_bf16(p.in[10], SK, (size_t)16 * 128 * 128, gtid, gsz);
    quant_rows(p.in[12], EV8, SV, PE_NE, 0, gw, ngw, lane); }
    __syncthreads(); }
    __syncthreads();
    for (int rep_ = 0; rep_ < ((PROBE_MASK & 65536) ? 2 : 1); ++rep_) {
    {
        pg8::Gemm g{(const bf16*)HN8, (const bf16*)(WinT8 + (size_t)10240 * 1024), T, 2048, 512}; pg8::StaticOrder S; S.init(T, 2048, G, wg);
        EpiG E{GA, GB, SA, SB + 10240};
        pg8::gemm_phase<EpiG, pg8::StaticOrder, true, true, true>(lds, g, S, E);
    }
    __syncthreads(); }
    GRID_SYNC();
    STAMP();

    for (int rep_ = 0; rep_ < ((PROBE_MASK & 256) ? 2 : 1); ++rep_) {
    for (int rep2_ = 0; rep2_ < ((PROBE_MASK & 262144) ? 2 : 1); ++rep2_) {
    {
        pg8::Gemm g{OHG, WhgT, T, 1024, 1024}; pg8::StaticOrder S; S.init(T, 1024, G, wg);
        EpiM1 E{MERGED, GA};
        pg8::gemm_phase<EpiM1, pg8::StaticOrder, false, true>(lds, g, S, E);
    }
    __syncthreads(); }
    __syncthreads();
    {
        pg8::Gemm g{ORET, WretT, T, 1024, 2048}; pg8::StaticOrder S; S.init(T, 1024, G, wg);
        EpiMerge E{GB, MERGED};
        pg8::gemm_phase<EpiMerge, pg8::StaticOrder, false, true>(lds, g, S, E);
    }
    __syncthreads(); }
    GRID_SYNC();
    STAMP();
    for (int rep_ = 0; rep_ < ((PROBE_MASK & 4096) ? 2 : 1); ++rep_) {
    {
        pg8::Gemm g{MERGED, WoutT, T, 1024, 1024}; pg8::StaticOrder S; S.init(T, 1024, G, wg);
        EpiOut E{x, X1, XW, p.in[8], SSQX};
        pg8::gemm_phase<EpiOut, pg8::StaticOrder, false, true>(lds, g, S, E);
    }
    __syncthreads(); }
    GRID_SYNC();
    STAMP();
    for (int rep_ = 0; rep_ < ((PROBE_MASK & 64) ? 2 : 1); ++rep_) {
    { PHASE_IDS quant_rows(p.in[11], EU8, SU, PE_NE, 0, gw, ngw, lane); }
    __syncthreads(); }
    __syncthreads();
    for (int rep_ = 0; rep_ < ((PROBE_MASK & 8192) ? 2 : 1); ++rep_) {
    {
        pg8::Gemm g{XW, WqT, T, 2048, 1024}; pg8::StaticOrder S; S.init(T, 2048, G, wg);
        EpiQ E{Qp, SSQX};
        pg8::gemm_phase<EpiQ, pg8::StaticOrder, true, true>(lds, g, S, E);
    }
    __syncthreads(); }
    GRID_SYNC();
    STAMP();
    { PHASE_IDS peer_retrieve(lds, Qp, SK, EIDX, EGATE, wg, G); quant_xw(XW, XQ8, XS, gw, ngw, lane); }
#if PROBE_MASK & 2
    { PHASE_IDS peer_retrieve(lds, Qp, SK, EIDX, EGATE, wg, G); quant_xw(XW, XQ8, XS, gw, ngw, lane); }
#endif
    GRID_SYNC();
    STAMP();
    if (threadIdx.x == 0) {
        unsigned k = 0, n = 0, mine = 1;
        for (unsigned j = 0; j < 16; ++j) { const unsigned c = xb_ld((unsigned*)(p.ws + WS_CTL) + XB_XCNT(j)); if (c) { if (j < xbar.x) ++k; ++n; } if (j == xbar.x) mine = c ? c : 1; }
        bst[5] = k; bst[6] = n ? n : 1; bst[7] = mine;
    }
    __syncthreads();
    const int xrank = (int)bst[4], xk = (int)bst[5], xn = (int)bst[6], xloc = (int)bst[7];
    for (int rep_ = 0; rep_ < ((PROBE_MASK & 1) ? 2 : 1); ++rep_) {
    { PHASE_IDS for (int s = xk; s < 8; s += xn) peer_u(EU8, XQ8, EIDX, PART, s, xrank * NWAVES + wave, xloc * NWAVES, lane); }
    GRID_SYNC(); }
    STAMP();
    { PHASE_IDS peer_w(PART, EIDX, EGATE, SU, SV, XS, SSQX, WQ8, WSC, gw, ngw, lane); }
    GRID_SYNC();
    STAMP();
#if PROBE_MASK & 131072
    { PHASE_IDS for (int s = xk; s < 8; s += xn) peer_v(EV8, EIDX, WQ8, WSC, X1, s, xrank * NWAVES + wave, xloc * NWAVES, lane, 1); }
    GRID_SYNC();
    STAMP();
#endif
    { PHASE_IDS for (int s = xk; s < 8; s += xn) peer_v(EV8, EIDX, WQ8, WSC, X1, s, xrank * NWAVES + wave, xloc * NWAVES, lane, 0); }
    GRID_SYNC();
    STAMP();
    { PHASE_IDS float dscale = 1.f;
      if (STAMP_K >= 0) { const float dt_us = (float)(TS[STAMP_K + 1] - TS[STAMP_K]) * 0.01f; dscale = 1.f + sqrtf(dt_us * 2e-6f); }
      final_norm(X1, p.in[13], p.out, gw, ngw, lane, dscale); }
#if PROBE_MASK & 16
    for (int i = 0; i < 15; ++i) GRID_SYNC();
#endif
}

extern "C" void kernel_launch(void* const* d_in, const int* in_sizes, int n_in, void* d_out, int out_size, void* d_ws, size_t ws_size, hipStream_t stream) {
    static int grid_blocks = 0;
    if (!grid_blocks) {
        int dev = 0, cus = 0, per_cu = 0;
        (void)hipGetDevice(&dev);
        (void)hipDeviceGetAttribute(&cus, hipDeviceAttributeMultiprocessorCount, dev);
        (void)hipFuncSetAttribute((const void*)fwd_megakernel, hipFuncAttributeMaxDynamicSharedMemorySize, LDS_BYTES);
        (void)hipOccupancyMaxActiveBlocksPerMultiprocessor(&per_cu, (const void*)fwd_megakernel, NTHREADS, LDS_BYTES);
        if (per_cu < 1) per_cu = 1;
        grid_blocks = cus * 1;
        if (ws_size < WS_END || n_in != 14) { fprintf(stderr, "kernel_launch: unexpected ws_size %zu (need %zu) or n_in %d\n", ws_size, (size_t)WS_END, n_in); }
    }
    (void)hipMemsetAsync((char*)d_ws + WS_CTL, 0, 32768, stream);
    Params p{};
    for (int i = 0; i < 14; ++i) p.in[i] = (const float*)d_in[i];
    p.out = (float*)d_out; p.ws = (unsigned char*)d_ws;
    void* args[] = {&p};
    hipError_t e = hipLaunchCooperativeKernel((const void*)fwd_megakernel, dim3(grid_blocks), dim3(NTHREADS), args, LDS_BYTES, stream);
    if (e != hipSuccess) fprintf(stderr, "cooperative launch failed: %s (grid %d)\n", hipGetErrorString(e), grid_blocks);
}
```

```cpp
#include <hip/hip_runtime.h>
#include <hip/hip_cooperative_groups.h>
#include <cstdio>
#include <cstdint>
namespace cg = cooperative_groups;
#ifndef USE_CG_SYNC
#define USE_CG_SYNC 0
#endif
#ifndef USE_WT_STORES
#define USE_WT_STORES 0
#endif
#ifndef STAMP_K
#define STAMP_K -1
#endif
#ifndef PROBE_MASK
#define PROBE_MASK 0
#endif
#ifndef PROBE_SKIP
#define PROBE_SKIP 0
#endif
#ifndef PROBE_REPS
#define PROBE_REPS 2
#endif
#ifndef PROBE_N
#define PROBE_N 4096
#endif

#define DI __device__ __forceinline__
#define LAS __attribute__((address_space(3)))
typedef unsigned short bf16;
typedef float f32x4 __attribute__((ext_vector_type(4)));
typedef float f32x2 __attribute__((ext_vector_type(2)));
typedef float f32x16 __attribute__((ext_vector_type(16)));
typedef short bf16x8 __attribute__((ext_vector_type(8)));
typedef short s16x4 __attribute__((ext_vector_type(4)));
typedef unsigned u32x4 __attribute__((ext_vector_type(4)));
typedef unsigned u32x2 __attribute__((ext_vector_type(2)));
typedef __bf16 nbf16x2 __attribute__((ext_vector_type(2)));

constexpr int D = 1024, NB = 2, SEQ = 8192, T = NB * SEQ;
constexpr int HG_H = 8, HG_DK = 128, HG_DV = 128, HG_C = 64, HG_NC = SEQ / HG_C;
constexpr int RT_H = 4, RT_DK = 256, RT_DV = 512, RT_L = 512, RT_NS = SEQ / RT_L;
constexpr int PE_H = 8, PE_NK = 128, PE_K = 16, PE_Q = 256, PE_HALF = 128, PE_NE = PE_NK * PE_NK;
constexpr float EPS = 1e-6f;
constexpr int NTHREADS = 512, NWAVES = 8;
constexpr int LDS_BYTES = 147456;

constexpr size_t MiB = 1u << 20;
constexpr size_t WS_CTL = 0;
constexpr size_t WS_DEC = 1 * MiB;
constexpr size_t WS_SSQP = 2 * MiB;
constexpr size_t WS_SCL = 2 * MiB + 512 * 1024;
constexpr size_t WS_SSQX = 3 * MiB;
constexpr size_t WS_HN = 4 * MiB;
constexpr size_t WS_WINT = 36 * MiB;
constexpr size_t WS_ROPE = 60 * MiB;
constexpr size_t WS_A = 68 * MiB, WS_B = 100 * MiB, WS_C = 132 * MiB;
constexpr size_t WS_STH = 164 * MiB;
constexpr size_t WS_STR = 196 * MiB;
constexpr size_t WS_OHG = 228 * MiB;
constexpr size_t WS_GA = 68 * MiB, WS_GB = 100 * MiB;
constexpr size_t WS_W2 = 132 * MiB;
constexpr size_t WS_WHG = WS_W2, WS_WRET = WS_W2 + 2 * MiB, WS_WOUT = WS_W2 + 6 * MiB, WS_WQ = WS_W2 + 8 * MiB, WS_SK = WS_W2 + 12 * MiB;
constexpr size_t WS_EV = 145 * MiB;
constexpr size_t WS_MERGED = 177 * MiB;
constexpr size_t WS_EU = 209 * MiB;
constexpr size_t WS_M1 = 4 * MiB;
constexpr size_t WS_X1 = 4 * MiB;
constexpr size_t WS_XW = 68 * MiB;
constexpr size_t WS_TOPS = 100 * MiB, WS_TOPI = 116 * MiB;
constexpr size_t WS_EIDX = 177 * MiB, WS_EGATE = 185 * MiB;
constexpr size_t WS_SA = WS_SCL + 192 * 1024;
constexpr size_t WS_SB = WS_SCL + 256 * 1024;
constexpr size_t CTL_AMAX = 65536;
constexpr size_t CTL_BYTES = 131072;
constexpr size_t WS_XQ8 = 161 * MiB;
constexpr size_t WS_XS = WS_SCL + 128 * 1024;
constexpr size_t WS_PART = 68 * MiB;
constexpr size_t WS_WT = 193 * MiB;
constexpr size_t WS_END = 260 * MiB;

DI int fresh_tid() { int t = threadIdx.x; asm volatile("" : "+v"(t)); return t; }
DI float sigmoidf_(float x) { return __builtin_amdgcn_rcpf(1.f + __builtin_amdgcn_exp2f(x * -1.4426950408889634f)); }
DI float siluf_(float x) { return x * __builtin_amdgcn_rcpf(1.f + __builtin_amdgcn_exp2f(x * -1.4426950408889634f)); }
DI f32x4 sigmoid4(const f32x4 x) {
    const f32x4 t = x * (f32x4){-1.4426950408889634f, -1.4426950408889634f, -1.4426950408889634f, -1.4426950408889634f};
    f32x4 d = {__builtin_amdgcn_exp2f(t[0]), __builtin_amdgcn_exp2f(t[1]), __builtin_amdgcn_exp2f(t[2]), __builtin_amdgcn_exp2f(t[3])};
    d = d + (f32x4){1.f, 1.f, 1.f, 1.f};
    return (f32x4){__builtin_amdgcn_rcpf(d[0]), __builtin_amdgcn_rcpf(d[1]), __builtin_amdgcn_rcpf(d[2]), __builtin_amdgcn_rcpf(d[3])};
}
DI f32x4 silu4(const f32x4 x) { return x * sigmoid4(x); }
DI unsigned pk2(float lo, float hi) { f32x2 v = {lo, hi}; nbf16x2 b = __builtin_convertvector(v, nbf16x2); return __builtin_bit_cast(unsigned, b); }
DI bf16 f2bf(float f) { return (bf16)(pk2(f, 0.f) & 0xffffu); }
DI float bf2f(bf16 b) { return __uint_as_float(((unsigned)b) << 16); }
DI float bflo(unsigned u) { return __uint_as_float(u << 16); }
DI float bfhi(unsigned u) { return __uint_as_float(u & 0xffff0000u); }
DI float wave_sum(float v) {
#pragma unroll
    for (int o = 1; o < 64; o <<= 1) v += __shfl_xor(v, o);
    return v;
}
DI int crow(int reg, int h) { return (reg & 3) + 8 * (reg >> 2) + 4 * h; }

namespace pg8 {
#define PG8_LAS __attribute__((address_space(3)))
typedef unsigned short bf16_t;
typedef short bf16x8 __attribute__((ext_vector_type(8)));
typedef float f32x4 __attribute__((ext_vector_type(4)));
typedef unsigned u32x4 __attribute__((ext_vector_type(4)));
constexpr int BM = 256, BK = 64, HALF = 128, HTB = HALF * BK * 2  , STAGE_BYTES = 8 * HTB, NXCD = 8, WGM = 8;

__host__ __device__ __forceinline__ int lds_byte(int r, int c) { const int st = (r >> 4) * 2 + (c >> 5), rr = r & 15, cc = c & 31, ob = rr * 64 + cc * 2; return st * 1024 + (ob ^ (((ob >> 9) & 1) << 5)); }
__host__ __device__ __forceinline__ void stage_rc(int b, int& R, int& C) { const int st = b / 1024, sb = b % 1024, swz = sb ^ (((sb >> 9) & 1) << 5); R = (st >> 1) * 16 + swz / 64; C = (st & 1) * 32 + (swz % 64) / 2; }
__host__ __device__ __forceinline__ int perm32(int rho) { const int n = rho >> 4, i = rho & 15; return 8 * (i >> 2) + 4 * n + (i & 3); }

struct Unit { int pm, pn; };
struct Gemm { const bf16_t* A; const bf16_t* Bt; int M, N, K; };

struct StaticOrder {
    int nM, nN, nwg, G, c;
    __host__ __device__ void init(int M, int N, int G_, int c_) { nM = M / BM; nN = N / BM; nwg = nM * nN; G = G_; c = c_; }
    __host__ __device__ bool next(int i, Unit& u) const {
        const long L = (long)i * G + c; if (L >= nwg) return false;
        int wgid = (int)L; { const int q = nwg / NXCD, r = nwg % NXCD, xcd = wgid % NXCD, off = wgid / NXCD; wgid = (xcd < r ? xcd * (q + 1) : r * (q + 1) + (xcd - r) * q) + off; }
        const int nig = WGM * nN, gid = wgid / nig, fm = gid * WGM, gsz = (nM - fm) < WGM ? (nM - fm) : WGM;
        u.pm = fm + ((wgid % nig) % gsz); u.pn = (wgid % nig) / gsz; return true;
    }
    __device__ __forceinline__ void a_ready(const Unit&) const {}
    __device__ __forceinline__ void done(const Unit&) const {}
};

__device__ __forceinline__ unsigned cvt_pk_bf16(float lo, float hi) { unsigned r; asm volatile("v_cvt_pk_bf16_f32 %0, %1, %2" : "=v"(r) : "v"(lo), "v"(hi)); return r; }
typedef float f32x2 __attribute__((ext_vector_type(2)));
typedef int i32x4 __attribute__((ext_vector_type(4)));
template <bool I8> __device__ __forceinline__ f32x4 mma16(const bf16x8& b, const bf16x8& a, const f32x4& c) {
    if constexpr (I8) return __builtin_bit_cast(f32x4, __builtin_amdgcn_mfma_i32_16x16x64_i8(__builtin_bit_cast(i32x4, b), __builtin_bit_cast(i32x4, a), __builtin_bit_cast(i32x4, c), 0, 0, 0));
    else return __builtin_amdgcn_mfma_f32_16x16x32_bf16(b, a, c, 0, 0, 0);
}
template <class E> __device__ __forceinline__ auto epi_skipall(const E& e, int) -> decltype(e.skipall) { return e.skipall; }
template <class E> __device__ __forceinline__ int epi_skipall(const E&, long) { return 0; }
template <class E, class = void> struct EpiSwap { static constexpr bool v = false; };
template <class E> struct EpiSwap<E, decltype((void)E::SWAP)> { static constexpr bool v = E::SWAP; };
template <class E, class = void> struct EpiKsplit { static constexpr bool v = false; };
template <class E> struct EpiKsplit<E, decltype((void)E::KSPLIT)> { static constexpr bool v = E::KSPLIT; };
template <class Epi, class Sched, bool ALIGN_EPI = false, bool SP2 = false, bool I8 = false>
__device__ __forceinline__ void gemm_phase(PG8_LAS unsigned char* lds, const Gemm g, const Sched& S, const Epi& E) {
    const int tid = fresh_tid(), wid = __builtin_amdgcn_readfirstlane(tid >> 6), lane = tid & 63, wr = wid >> 2, wc = wid & 3, fr = lane & 15, fq = lane >> 4;
    const int K = g.K, nt = K / BK;
    unsigned voffA[2], voffB[2];
#pragma unroll
    for (int i = 0; i < 2; ++i) { int R, C; stage_rc(tid * 16 + i * 8192, R, C); const int Rb = Epi::PERM ? ((R & ~31) + perm32(R & 31)) : R;
        voffA[i] = (unsigned)(R * K + C) * 2u; voffB[i] = (unsigned)(Rb * K + C) * 2u; }
    const size_t kstep = (size_t)(BK * 2);
    const size_t hstep = (size_t)HALF * K * 2;
    const size_t tstep = 2 * hstep;
    const unsigned ldsw = (unsigned)wid * 1024u;
    constexpr bool KS = EpiKsplit<Epi>::v;
    static_assert(!KS || SP2, "KSPLIT needs the SP2 loop");
    const int nt1 = nt;
    int ntt = nt; unsigned voffA2[2] = {0u, 0u}, voffB2[2] = {0u, 0u}; size_t hstep2 = 0, tstep2 = 0;
    const char* gA2 = nullptr; const char* gB2 = nullptr;
    if constexpr (KS) {
        const int K2 = E.K2; ntt = nt + K2 / BK; gA2 = (const char*)E.A2; gB2 = (const char*)E.B2;
#pragma unroll
        for (int i = 0; i < 2; ++i) { int R, C; stage_rc(tid * 16 + i * 8192, R, C); const int Rb = Epi::PERM ? ((R & ~31) + perm32(R & 31)) : R;
            voffA2[i] = (unsigned)(R * K2 + C) * 2u; voffB2[i] = (unsigned)(Rb * K2 + C) * 2u; }
        hstep2 = (size_t)HALF * K2 * 2; tstep2 = 2 * hstep2;
    }
    const int aoff = lds_byte(wr * 64 + fr, fq * 8), boff = lds_byte(wc * 32 + fr, fq * 8);
#define PG8_SA(b, h) (((b) * 2 + (h)) * HTB)
#define PG8_SB(b, h) ((4 + (b) * 2 + (h)) * HTB)
#define PG8_STAGE(bufoff, gbase, voff) do { _Pragma("unroll") for (int _i = 0; _i < 2; ++_i) \
        __builtin_amdgcn_global_load_lds((const unsigned*)((const char*)(gbase) + (voff)[_i]), (PG8_LAS unsigned*)(lds + (bufoff) + ldsw + _i * 8192), 16, 0, 0); } while (0)
#define PG8_LDA(dst, b, h) do { _Pragma("unroll") for (int m = 0; m < 4; ++m) _Pragma("unroll") for (int k = 0; k < 2; ++k) dst[m][k] = *(const PG8_LAS bf16x8*)(lds + PG8_SA(b, h) + aoff + m * 2048 + k * 1024); } while (0)
#define PG8_LDB(dst, b, h) do { _Pragma("unroll") for (int n = 0; n < 2; ++n) _Pragma("unroll") for (int k = 0; k < 2; ++k) dst[n][k] = *(const PG8_LAS bf16x8*)(lds + PG8_SB(b, h) + boff + n * 2048 + k * 1024); } while (0)
#define PG8_MMA(ai, bj, At, Bt) do { __builtin_amdgcn_s_setprio(1); _Pragma("unroll") for (int m = 0; m < 4; ++m) _Pragma("unroll") for (int n = 0; n < 2; ++n) _Pragma("unroll") for (int k = 0; k < 2; ++k) \
        acc[ai][bj][m][n] = EpiSwap<Epi>::v ? mma16<I8>(At[m][k], Bt[n][k], acc[ai][bj][m][n]) : mma16<I8>(Bt[n][k], At[m][k], acc[ai][bj][m][n]); __builtin_amdgcn_s_setprio(0); } while (0)
#define PG8_WAIT_V(n) asm volatile("s_waitcnt vmcnt(" #n ")" ::: "memory")
#define PG8_WAIT_L(n) asm volatile("s_waitcnt lgkmcnt(" #n ")" ::: "memory")
#define PG8_BAR __builtin_amdgcn_s_barrier()
#define PG8_SCHED __builtin_amdgcn_sched_barrier(0)
    Unit cur, nxt; int ui = 0;
    if (!S.next(0, cur)) return;
    f32x4 acc[2][2][4][2];
#pragma unroll
    for (int a = 0; a < 2; ++a)
#pragma unroll
        for (int b = 0; b < 2; ++b)
#pragma unroll
            for (int m = 0; m < 4; ++m)
#pragma unroll
                for (int n = 0; n < 2; ++n) acc[a][b][m][n] = (f32x4){0.f, 0.f, 0.f, 0.f};
    bf16x8 At[4][2], B0[2][2], B1[2][2];
    const char* cA = (const char*)g.A + (size_t)cur.pm * tstep; const char* cB = (const char*)g.Bt + (size_t)cur.pn * tstep;
    S.a_ready(cur);
    if constexpr (SP2) {
        PG8_STAGE(PG8_SB(0, 0), cB, voffB); PG8_STAGE(PG8_SB(0, 1), cB + hstep, voffB); PG8_STAGE(PG8_SA(0, 0), cA, voffA); PG8_STAGE(PG8_SA(0, 1), cA + hstep, voffA);
        if (wr == 1) PG8_BAR;
        PG8_WAIT_V(2); PG8_BAR;
        PG8_STAGE(PG8_SB(1, 0), cB + kstep, voffB); PG8_STAGE(PG8_SA(1, 0), cA + kstep, voffA); PG8_STAGE(PG8_SB(1, 1), cB + hstep + kstep, voffB);
        PG8_WAIT_V(6); PG8_BAR;
    } else {
        PG8_STAGE(PG8_SB(0, 0), cB, voffB); PG8_STAGE(PG8_SA(0, 0), cA, voffA); PG8_STAGE(PG8_SB(0, 1), cB + hstep, voffB); PG8_STAGE(PG8_SA(0, 1), cA + hstep, voffA);
        if (wr == 1) PG8_BAR;
        PG8_WAIT_V(4); PG8_BAR;
        PG8_STAGE(PG8_SB(1, 0), cB + kstep, voffB); PG8_STAGE(PG8_SA(1, 0), cA + kstep, voffA); PG8_STAGE(PG8_SB(1, 1), cB + hstep + kstep, voffB);
        PG8_WAIT_V(6); PG8_BAR;
    }
    for (;;) {
        const bool has_next = S.next(ui + 1, nxt);
        const char* nA = has_next ? (const char*)g.A + (size_t)nxt.pm * tstep : cA; const char* nB = has_next ? (const char*)g.Bt + (size_t)nxt.pn * tstep : cB;
        const char* cA2 = nullptr; const char* cB2 = nullptr;
        if constexpr (KS) { cA2 = gA2 + (size_t)cur.pm * tstep2; cB2 = gB2 + (size_t)cur.pn * tstep2; }
        for (int t = 0; t < ntt; t += 2) {
            const bool last = (t == ntt - 2);
            if constexpr (KS) { if (t == nt1) E.mid(acc, cur, wr, wc, fr, fq); }
            const bool s1 = KS && (t + 1 >= nt1), s2 = KS && !last && (t + 2 >= nt1);
            const char* a1 = s1 ? cA2 + (size_t)(t + 1 - nt1) * kstep : cA + (size_t)(t + 1) * kstep;
            const char* a2 = last ? nA : (s2 ? cA2 + (size_t)(t + 2 - nt1) * kstep : cA + (size_t)(t + 2) * kstep);
            const char* b2 = last ? nB : (s2 ? cB2 + (size_t)(t + 2 - nt1) * kstep : cB + (size_t)(t + 2) * kstep);
            const char* a3 = a2 + kstep; const char* b3 = b2 + kstep;
            const size_t h1 = s1 ? hstep2 : hstep, h2 = s2 ? hstep2 : hstep;
            const unsigned vA1[2] = {s1 ? voffA2[0] : voffA[0], s1 ? voffA2[1] : voffA[1]}, vA2[2] = {s2 ? voffA2[0] : voffA[0], s2 ? voffA2[1] : voffA[1]}, vB2[2] = {s2 ? voffB2[0] : voffB[0], s2 ? voffB2[1] : voffB[1]};
            if (last && has_next) S.a_ready(nxt);
            if constexpr (SP2) {
            PG8_LDB(B0, 0, 0); PG8_LDB(B1, 0, 1); PG8_SCHED; PG8_LDA(At, 0, 0); PG8_STAGE(PG8_SA(1, 1), a1 + h1, vA1);
            PG8_WAIT_V(8); PG8_WAIT_L(0); PG8_BAR; PG8_MMA(0, 0, At, B0); PG8_MMA(0, 1, At, B1); PG8_BAR; PG8_SCHED;
            PG8_LDA(At, 0, 1); PG8_STAGE(PG8_SB(0, 0), b2, vB2); PG8_STAGE(PG8_SB(0, 1), b2 + h2, vB2); PG8_STAGE(PG8_SA(0, 0), a2, vA2);
            PG8_WAIT_V(8); PG8_WAIT_L(0); PG8_BAR; PG8_MMA(1, 0, At, B0); PG8_MMA(1, 1, At, B1); PG8_BAR; PG8_SCHED;
            PG8_LDB(B0, 1, 0); PG8_LDB(B1, 1, 1); PG8_SCHED; PG8_LDA(At, 1, 0); PG8_STAGE(PG8_SA(0, 1), a2 + h2, vA2);
            PG8_WAIT_V(8); PG8_WAIT_L(0); PG8_BAR; PG8_MMA(0, 0, At, B0); PG8_MMA(0, 1, At, B1); PG8_BAR; PG8_SCHED;
            PG8_LDA(At, 1, 1); PG8_STAGE(PG8_SB(1, 0), b3, vB2); PG8_STAGE(PG8_SB(1, 1), b3 + h2, vB2); PG8_STAGE(PG8_SA(1, 0), a3, vA2);
            PG8_WAIT_V(8); PG8_WAIT_L(0); PG8_BAR; PG8_MMA(1, 0, At, B0); PG8_MMA(1, 1, At, B1); PG8_BAR; PG8_SCHED;
            } else {
            PG8_LDB(B0, 0, 0); PG8_SCHED; PG8_LDA(At, 0, 0); PG8_STAGE(PG8_SA(1, 1), a1 + hstep, voffA);
            PG8_WAIT_L(8); PG8_BAR; PG8_WAIT_L(0); PG8_MMA(0, 0, At, B0); PG8_BAR; PG8_SCHED;
            PG8_LDB(B1, 0, 1); PG8_STAGE(PG8_SB(0, 0), b2, voffB);
            PG8_BAR; PG8_WAIT_L(0); PG8_MMA(0, 1, At, B1); PG8_BAR;
            PG8_LDA(At, 0, 1); PG8_STAGE(PG8_SA(0, 0), a2, voffA);
            PG8_BAR; PG8_WAIT_L(0); PG8_MMA(1, 0, At, B0); PG8_BAR; PG8_SCHED;
            PG8_STAGE(PG8_SB(0, 1), b2 + hstep, voffB);
            PG8_WAIT_V(6); PG8_BAR; PG8_MMA(1, 1, At, B1); PG8_BAR;
            PG8_LDB(B0, 1, 0); PG8_SCHED; PG8_LDA(At, 1, 0); PG8_STAGE(PG8_SA(0, 1), a2 + hstep, voffA);
            PG8_WAIT_L(8); PG8_BAR; PG8_WAIT_L(0); PG8_MMA(0, 0, At, B0); PG8_BAR; PG8_SCHED;
            PG8_LDB(B1, 1, 1); PG8_STAGE(PG8_SB(1, 0), b3, voffB);
            PG8_BAR; PG8_WAIT_L(0); PG8_MMA(0, 1, At, B1); PG8_BAR;
            PG8_LDA(At, 1, 1); PG8_STAGE(PG8_SA(1, 0), a3, voffA);
            PG8_BAR; PG8_WAIT_L(0); PG8_MMA(1, 0, At, B0); PG8_BAR; PG8_SCHED;
            PG8_STAGE(PG8_SB(1, 1), b3 + hstep, voffB);
            PG8_WAIT_V(6); PG8_BAR; PG8_MMA(1, 1, At, B1); PG8_BAR;
            }
        }
        if constexpr (ALIGN_EPI) { if (wr == 0) PG8_BAR; }
        if constexpr (!Epi::AFTER_DRAIN) { if (!(PROBE_SKIP && epi_skipall(E, 0))) E(acc, cur, wr, wc, fr, fq); S.done(cur); }
        if (!has_next) break;
#pragma unroll
        for (int a = 0; a < 2; ++a)
#pragma unroll
            for (int b = 0; b < 2; ++b)
#pragma unroll
                for (int m = 0; m < 4; ++m)
#pragma unroll
                    for (int n = 0; n < 2; ++n) acc[a][b][m][n] = (f32x4){0.f, 0.f, 0.f, 0.f};
        cur = nxt; cA = nA; cB = nB; ++ui;
        if constexpr (ALIGN_EPI) { if (wr == 1) PG8_BAR; }
    }
    PG8_WAIT_V(0);
    if constexpr (!ALIGN_EPI) { if (wr == 0) PG8_BAR; }
    PG8_BAR;
    if constexpr (Epi::AFTER_DRAIN) { E.fused(acc, cur, wr, wc, fr, fq, lds, wid, lane); S.done(cur); }
#undef PG8_SA
#undef PG8_SB
#undef PG8_STAGE
#undef PG8_LDA
#undef PG8_LDB
#undef PG8_MMA
#undef PG8_WAIT_V
#undef PG8_WAIT_L
#undef PG8_BAR
#undef PG8_SCHED
}
}

using pg8::Unit;
typedef f32x4 Acc[2][2][4][2];

DI u32x4 pack8(const f32x4& a, const f32x4& b) { u32x4 w; w.x = pk2(a[0], a[1]); w.y = pk2(a[2], a[3]); w.z = pk2(b[0], b[1]); w.w = pk2(b[2], b[3]); return w; }

DI void st16_wt(void* p, const u32x4& v) {
#if USE_WT_STORES
    asm volatile("global_store_dwordx4 %0, %1, off sc1\n\ts_nop 1" :: "v"(p), "v"(v) : "memory");
#else
    *(u32x4*)p = v;
#endif
}
template <bool PRECVT = false> DI void dequant_acc(Acc& acc, const Unit& u, int wr, int wc, int fr, int fq, const float* SA, const float* SB) {
    f32x4 sb[2][2];
#pragma unroll
    for (int bj = 0; bj < 2; ++bj)
#pragma unroll
        for (int n = 0; n < 2; ++n) sb[bj][n] = *(const f32x4*)(SB + u.pn * 256 + bj * 128 + wc * 32 + 8 * fq + 4 * n);
#pragma unroll
    for (int ai = 0; ai < 2; ++ai)
#pragma unroll
        for (int m = 0; m < 4; ++m) {
            const float sa = SA[u.pm * 256 + ai * 128 + wr * 64 + m * 16 + fr];
            const f32x4 sa4 = {sa, sa, sa, sa};
#pragma unroll
            for (int bj = 0; bj < 2; ++bj)
#pragma unroll
                for (int n = 0; n < 2; ++n)
                    { f32x4 a;
#pragma unroll
                      for (int e = 0; e < 4; ++e) a[e] = PRECVT ? acc[ai][bj][m][n][e] : (float)__float_as_int(acc[ai][bj][m][n][e]);
                      acc[ai][bj][m][n] = (a * sa4) * sb[bj][n]; }
        }
}

template <int CTRL, bool ZERO> DI float dppf(float v) { return __int_as_float(__builtin_amdgcn_update_dpp(0, __float_as_int(v), CTRL, 0xF, 0xF, ZERO)); }

struct EpiH {
    static constexpr bool PERM = true, AFTER_DRAIN = false;
    bf16* Qh; bf16* Kh; bf16* VTh; float* DEC; const float* hlb; bf16* OHG; const float* SA; const float* SB; int skip;
    DI void operator()(Acc& acc, const Unit& u, int wr, int wc, int fr, int fq) const {
        if (PROBE_SKIP && (skip & (u.pn < 8 ? 1 : 4))) return;
        asm volatile("" : "+v"(fr), "+v"(fq));
        dequant_acc(acc, u, wr, wc, fr, fq, SA, SB);
        if (u.pn < 8) {
            const int h = u.pn, dbase = wc * 32 + 8 * fq;
            float lbv[2][4];
#pragma unroll
            for (int n = 0; n < 2; ++n) {
                const f32x4 h0 = *(const f32x4*)(hlb + h * 128 + dbase + 4 * n), h1 = *(const f32x4*)(hlb + 1024 + h * 128 + dbase + 4 * n);
#pragma unroll
                for (int e = 0; e < 4; ++e) lbv[n][e] = sigmoidf_(h0[e] - h1[e]);
            }
#pragma unroll
            for (int ai = 0; ai < 2; ++ai) {
                const int row0 = u.pm * 256 + ai * 128 + wr * 64;
                const int bidx = row0 >> 13, chunk = (row0 & (SEQ - 1)) >> 6;
#pragma unroll
                for (int n = 0; n < 2; ++n) {
                    f32x4 ebl;
#pragma unroll
                    for (int e = 0; e < 4; ++e) {
                        const float lb = lbv[n][e], oml = 1.f - lb;
                        float f0, f1, f2, f3, kk[4];
                        {
                            float ff[4];
#pragma unroll
                            for (int m = 0; m < 4; ++m) {
                                const float E = __builtin_amdgcn_exp2f(acc[ai][1][m][n][e] * -1.4426950408889634f);
                                const float r = __builtin_amdgcn_rcpf(1.f + E), Er = 1.f - r;
                                ff[m] = fmaf(lb, Er, r); kk[m] = oml * Er;
                            }
                            f0 = ff[0]; f1 = ff[1]; f2 = ff[2]; f3 = ff[3];
                        }
                        asm volatile("s_nop 1\n"
                            "v_mul_f32_dpp %0, %0, %0 row_shr:1 row_mask:0xf bank_mask:0xf\n v_mul_f32_dpp %1, %1, %1 row_shr:1 row_mask:0xf bank_mask:0xf\n"
                            "v_mul_f32_dpp %2, %2, %2 row_shr:1 row_mask:0xf bank_mask:0xf\n v_mul_f32_dpp %3, %3, %3 row_shr:1 row_mask:0xf bank_mask:0xf\n"
                            "v_mul_f32_dpp %0, %0, %0 row_shr:2 row_mask:0xf bank_mask:0xf\n v_mul_f32_dpp %1, %1, %1 row_shr:2 row_mask:0xf bank_mask:0xf\n"
                            "v_mul_f32_dpp %2, %2, %2 row_shr:2 row_mask:0xf bank_mask:0xf\n v_mul_f32_dpp %3, %3, %3 row_shr:2 row_mask:0xf bank_mask:0xf\n"
                            "v_mul_f32_dpp %0, %0, %0 row_shr:4 row_mask:0xf bank_mask:0xf\n v_mul_f32_dpp %1, %1, %1 row_shr:4 row_mask:0xf bank_mask:0xf\n"
                            "v_mul_f32_dpp %2, %2, %2 row_shr:4 row_mask:0xf bank_mask:0xf\n v_mul_f32_dpp %3, %3, %3 row_shr:4 row_mask:0xf bank_mask:0xf\n"
                            "v_mul_f32_dpp %0, %0, %0 row_shr:8 row_mask:0xf bank_mask:0xf\n v_mul_f32_dpp %1, %1, %1 row_shr:8 row_mask:0xf bank_mask:0xf\n"
                            "v_mul_f32_dpp %2, %2, %2 row_shr:8 row_mask:0xf bank_mask:0xf\n v_mul_f32_dpp %3, %3, %3 row_shr:8 row_mask:0xf bank_mask:0xf\n"
                            "s_nop 1"
                            : "+v"(f0), "+v"(f1), "+v"(f2), "+v"(f3));
                        const float ps[4] = {f0, f1, f2, f3};
                        float carry = 1.f, P = 1.f;
#pragma unroll
                        for (int m = 0; m < 4; ++m) {
                            const float tot = dppf<0x15F, false>(ps[m]);
                            P = ps[m] * carry; carry *= tot;
                            acc[ai][0][m][n][e] = acc[ai][0][m][n][e] * (0.08838834764831845f * P);
                            acc[ai][1][m][n][e] = kk[m] * __builtin_amdgcn_rcpf(P);
                        }
                        ebl[e] = P;
                        __builtin_amdgcn_sched_barrier(0);
                    }
                    if (fr == 15) *(f32x4*)(DEC + ((size_t)((bidx * HG_H + h) * HG_NC + chunk)) * 128 + dbase + 4 * n) = ebl;
                    __builtin_amdgcn_sched_barrier(0);
                }
#pragma unroll
                for (int m = 0; m < 4; ++m) {
                    const size_t row = (size_t)(row0 + m * 16 + fr);
                    st16_wt(Qh + row * 1024 + h * 128 + dbase, pack8(acc[ai][0][m][0], acc[ai][0][m][1]));
                    st16_wt(Kh + row * 1024 + h * 128 + dbase, pack8(acc[ai][1][m][0], acc[ai][1][m][1]));
                }
                __builtin_amdgcn_sched_barrier(0);
            }
            return;
        }
        {
            const int cb = (u.pn - 8) * 256 + wc * 32 + 8 * fq;
#pragma unroll
            for (int ai = 0; ai < 2; ++ai)
#pragma unroll
                for (int m = 0; m < 4; ++m) {
                    const size_t row = (size_t)(u.pm * 256 + ai * 128 + wr * 64 + m * 16 + fr);
#pragma unroll
                    for (int bj = 0; bj < 2; ++bj) {
                        f32x4 a0 = acc[ai][bj][m][0], a1 = acc[ai][bj][m][1];
                        a0 = silu4(a0); a1 = silu4(a1);
                        st16_wt(OHG + row * 1024 + cb + bj * 128, pack8(a0, a1));
                    }
                }
        }
    }
};
struct EpiHV {
    static constexpr bool PERM = false, AFTER_DRAIN = false, SWAP = true;
    bf16* VTf; const float* SA; const float* SB;
    DI void operator()(Acc& acc, const Unit& u, int wr, int wc, int fr, int fq) const {
        float sb[2][2];
#pragma unroll
        for (int bj = 0; bj < 2; ++bj)
#pragma unroll
            for (int n = 0; n < 2; ++n) sb[bj][n] = SB[u.pn * 256 + bj * 128 + wc * 32 + 16 * n + fr];
        const int hs = fq & 1, j0 = (fq >> 1) * 4;
#pragma unroll
        for (int ai = 0; ai < 2; ++ai)
#pragma unroll
            for (int m = 0; m < 4; ++m) {
                const int row0 = u.pm * 256 + ai * 128 + wr * 64 + m * 16, bidx = row0 >> 13, pos0 = row0 & (SEQ - 1), ks = (pos0 >> 4) & 1, sblk = pos0 >> 5;
                const f32x4 sa = *(const f32x4*)(SA + row0 + 4 * fq);
#pragma unroll
                for (int bj = 0; bj < 2; ++bj) {
                    const int bh = bidx * HG_H + 2 * u.pn + bj;
                    u32x2 o[2];
#pragma unroll
                    for (int n = 0; n < 2; ++n) {
                        const f32x4 a = acc[ai][bj][m][n];
                        const float s = sb[bj][n];
                        o[n].x = pk2((float)__float_as_int(a[0]) * sa[0] * s, (float)__float_as_int(a[1]) * sa[1] * s);
                        o[n].y = pk2((float)__float_as_int(a[2]) * sa[2] * s, (float)__float_as_int(a[3]) * sa[3] * s);
                    }
                    const auto rx = __builtin_amdgcn_permlane32_swap(o[0].x, o[1].x, false, false), ry = __builtin_amdgcn_permlane32_swap(o[0].y, o[1].y, false, false);
                    *(u32x4*)(VTf + ((((size_t)(bh * 256 + sblk) * 4 + wc) * 2 + ks) * 64 + (16 * (fq >> 1) + fr + 32 * hs)) * 8) = (u32x4){rx[0], ry[0], rx[1], ry[1]};
                }
            }
    }
};

struct EpiR {
    static constexpr bool PERM = true, AFTER_DRAIN = false;
    bf16* Qr; bf16* Kr; bf16* VTr; const float* COS; const float* SIN; bf16* ORET; const float* SA; const float* SB;
    DI void operator()(Acc& acc, const Unit& u, int wr, int wc, int fr, int fq) const {
        dequant_acc(acc, u, wr, wc, fr, fq, SA, SB);
        if (u.pn < 8) {
            const bool isk = u.pn >= 4; const int h = u.pn & 3;
            const float lg = __log2f(1.f - exp2f(-5.f - (float)h));
            bf16* dst = isk ? Kr : Qr;
            const int j0 = wc * 32 + 8 * fq;
            f32x4 cj[2];
#pragma unroll
            for (int n = 0; n < 2; ++n)
#pragma unroll
                for (int e = 0; e < 4; ++e) cj[n][e] = exp2f(-(float)(j0 + 4 * n + e) * 0.10381025296523008f) * 0.15915494309189535f;
#pragma unroll
            for (int ai = 0; ai < 2; ++ai)
#pragma unroll
                for (int m = 0; m < 4; ++m) {
                    const int row = u.pm * 256 + ai * 128 + wr * 64 + m * 16 + fr, pos = row & (SEQ - 1), il = pos & (RT_L - 1);
                    const float sc = isk ? exp2f(-lg * (float)il) * 0.0625f : exp2f(lg * (float)il);
                    const float fpos = (float)pos;
#pragma unroll
                    for (int n = 0; n < 2; ++n) {
                        f32x4 c, s;
#pragma unroll
                        for (int e = 0; e < 4; ++e) { const float rev = __builtin_amdgcn_fractf(fpos * cj[n][e]); c[e] = __builtin_amdgcn_cosf(rev); s[e] = __builtin_amdgcn_sinf(rev); }
                        const f32x4 x1 = acc[ai][0][m][n], x2 = acc[ai][1][m][n];
                        acc[ai][0][m][n] = (x1 * c - x2 * s) * sc; acc[ai][1][m][n] = (x1 * s + x2 * c) * sc;
                    }
                    st16_wt(dst + (size_t)row * 1024 + h * 256 + j0, pack8(acc[ai][0][m][0], acc[ai][0][m][1]));
                    st16_wt(dst + (size_t)row * 1024 + h * 256 + 128 + j0, pack8(acc[ai][1][m][0], acc[ai][1][m][1]));
                }
        } else {
            const int cb = (u.pn - 8) * 256 + wc * 32 + 8 * fq;
#pragma unroll
            for (int ai = 0; ai < 2; ++ai)
#pragma unroll
                for (int m = 0; m < 4; ++m) {
                    const size_t row = (size_t)(u.pm * 256 + ai * 128 + wr * 64 + m * 16 + fr);
#pragma unroll
                    for (int bj = 0; bj < 2; ++bj) {
                        f32x4 a0 = acc[ai][bj][m][0], a1 = acc[ai][bj][m][1];
                        a0 = silu4(a0); a1 = silu4(a1);
                        st16_wt(ORET + row * 2048 + cb + bj * 128, pack8(a0, a1));
                    }
                }
        }
    }
};
struct EpiRV {
    static constexpr bool PERM = false, AFTER_DRAIN = false, SWAP = true;
    bf16* VTr; const float* SA; const float* SB;
    DI void operator()(Acc& acc, const Unit& u, int wr, int wc, int fr, int fq) const {
        float sb[2][2];
#pragma unroll
        for (int bj = 0; bj < 2; ++bj)
#pragma unroll
            for (int n = 0; n < 2; ++n) sb[bj][n] = SB[u.pn * 256 + bj * 128 + wc * 32 + 16 * n + fr];
        const int hd = u.pn >> 1, hs = fq & 1, j0 = (fq >> 1) * 4;
#pragma unroll
        for (int ai = 0; ai < 2; ++ai)
#pragma unroll
            for (int m = 0; m < 4; ++m) {
                const int row0 = u.pm * 256 + ai * 128 + wr * 64 + m * 16, bidx = row0 >> 13, pos0 = row0 & (SEQ - 1), ks = (pos0 >> 4) & 1, sblk = pos0 >> 5;
                const f32x4 sa = *(const f32x4*)(SA + row0 + 4 * fq);
#pragma unroll
                for (int bj = 0; bj < 2; ++bj) {
                    const int nv = (u.pn & 1) * 8 + bj * 4 + wc;
                    u32x2 o[2];
#pragma unroll
                    for (int n = 0; n < 2; ++n) {
                        const f32x4 a = acc[ai][bj][m][n];
                        const float s = sb[bj][n];
                        o[n].x = pk2((float)__float_as_int(a[0]) * sa[0] * s, (float)__float_as_int(a[1]) * sa[1] * s);
                        o[n].y = pk2((float)__float_as_int(a[2]) * sa[2] * s, (float)__float_as_int(a[3]) * sa[3] * s);
                    }
                    const auto rx = __builtin_amdgcn_permlane32_swap(o[0].x, o[1].x, false, false), ry = __builtin_amdgcn_permlane32_swap(o[0].y, o[1].y, false, false);
                    *(u32x4*)(VTr + ((((size_t)((bidx * RT_H + hd) * 256 + sblk) * 16 + nv) * 2 + ks) * 64 + (16 * (fq >> 1) + fr + 32 * hs)) * 8) = (u32x4){rx[0], ry[0], rx[1], ry[1]};
                }
            }
    }
};

struct EpiG {
    static constexpr bool PERM = true, AFTER_DRAIN = false;
    bf16* GA; bf16* GB; const float* SA; const float* SB;
    DI void operator()(Acc& acc, const Unit& u, int wr, int wc, int fr, int fq) const {
        dequant_acc(acc, u, wr, wc, fr, fq, SA, SB);
        const int cb = wc * 32 + 8 * fq;
        bf16* base = (u.pn < 4 ? GA + (size_t)u.pn * 256 : GB + (size_t)(u.pn - 4) * 256) + cb;
#pragma unroll
        for (int ai = 0; ai < 2; ++ai)
#pragma unroll
            for (int m = 0; m < 4; ++m) {
                const size_t row = (size_t)(u.pm * 256 + ai * 128 + wr * 64 + m * 16 + fr);
#pragma unroll
                for (int bj = 0; bj < 2; ++bj) {
                    f32x4 a0 = acc[ai][bj][m][0], a1 = acc[ai][bj][m][1];
                    a0 = sigmoid4(a0); a1 = sigmoid4(a1);
                    st16_wt(base + row * 1024 + bj * 128, pack8(a0, a1));
                }
            }
    }
};

struct EpiM1 {
    static constexpr bool PERM = true, AFTER_DRAIN = false;
    bf16* MERGED; const bf16* GA;
    DI void operator()(Acc& acc, const Unit& u, int wr, int wc, int fr, int fq) const {
        const int cb = u.pn * 256 + wc * 32 + 8 * fq;
#pragma unroll
        for (int ai = 0; ai < 2; ++ai)
#pragma unroll
            for (int m = 0; m < 4; ++m) {
                const size_t row = (size_t)(u.pm * 256 + ai * 128 + wr * 64 + m * 16 + fr);
#pragma unroll
                for (int bj = 0; bj < 2; ++bj) {
                    const u32x4 g = *(const u32x4*)(GA + row * 1024 + cb + bj * 128);
                    f32x4 a0 = acc[ai][bj][m][0], a1 = acc[ai][bj][m][1];
                    a0[0] *= bflo(g.x); a0[1] *= bfhi(g.x); a0[2] *= bflo(g.y); a0[3] *= bfhi(g.y);
                    a1[0] *= bflo(g.z); a1[1] *= bfhi(g.z); a1[2] *= bflo(g.w); a1[3] *= bfhi(g.w);
                    st16_wt(MERGED + row * 1024 + cb + bj * 128, pack8(a0, a1));
                }
            }
    }
};
struct EpiMerge {
    static constexpr bool PERM = true, AFTER_DRAIN = false;
    const bf16* GB; bf16* MERGED;
    DI void operator()(Acc& acc, const Unit& u, int wr, int wc, int fr, int fq) const {
        const int cb = u.pn * 256 + wc * 32 + 8 * fq;
#pragma unroll
        for (int ai = 0; ai < 2; ++ai)
#pragma unroll
            for (int m = 0; m < 4; ++m) {
                const size_t row = (size_t)(u.pm * 256 + ai * 128 + wr * 64 + m * 16 + fr);
#pragma unroll
                for (int bj = 0; bj < 2; ++bj) {
                    const u32x4 g = *(const u32x4*)(GB + row * 1024 + cb + bj * 128);
                    const u32x4 mo = *(const u32x4*)(MERGED + row * 1024 + cb + bj * 128);
                    f32x4 a0 = acc[ai][bj][m][0], a1 = acc[ai][bj][m][1];
                    a0[0] = a0[0] * bflo(g.x) + bflo(mo.x); a0[1] = a0[1] * bfhi(g.x) + bfhi(mo.x); a0[2] = a0[2] * bflo(g.y) + bflo(mo.y); a0[3] = a0[3] * bfhi(g.y) + bfhi(mo.y);
                    a1[0] = a1[0] * bflo(g.z) + bflo(mo.z); a1[1] = a1[1] * bfhi(g.z) + bfhi(mo.z); a1[2] = a1[2] * bflo(g.w) + bflo(mo.w); a1[3] = a1[3] * bfhi(g.w) + bfhi(mo.w);
                    st16_wt(MERGED + row * 1024 + cb + bj * 128, pack8(a0, a1));
                }
            }
    }
};
struct EpiMergeF {
    static constexpr bool PERM = true, AFTER_DRAIN = false, KSPLIT = true;
    const bf16* A2; const bf16* B2; int K2; const bf16* GA; const bf16* GB; bf16* MERGED;
    DI void mid(Acc& acc, const Unit& u, int wr, int wc, int fr, int fq) const {
        asm volatile("" : "+v"(fr), "+v"(fq));
        const int cb = u.pn * 256 + wc * 32 + 8 * fq;
#pragma unroll
        for (int ai = 0; ai < 2; ++ai)
#pragma unroll
            for (int m = 0; m < 4; ++m) {
                const size_t row = (size_t)(u.pm * 256 + ai * 128 + wr * 64 + m * 16 + fr);
#pragma unroll
                for (int bj = 0; bj < 2; ++bj) {
                    const u32x4 a = *(const u32x4*)(GA + row * 1024 + cb + bj * 128), g = *(const u32x4*)(GB + row * 1024 + cb + bj * 128);
                    const unsigned aa[4] = {a.x, a.y, a.z, a.w}, gg[4] = {g.x, g.y, g.z, g.w};
#pragma unroll
                    for (int j = 0; j < 4; ++j) {
                        const float r0 = bflo(aa[j]) * __builtin_amdgcn_rcpf(fmaxf(bflo(gg[j]), 1e-30f)), r1 = bfhi(aa[j]) * __builtin_amdgcn_rcpf(fmaxf(bfhi(gg[j]), 1e-30f));
                        acc[ai][bj][m][j >> 1][2 * (j & 1)] *= r0; acc[ai][bj][m][j >> 1][2 * (j & 1) + 1] *= r1;
                    }
                }
            }
    }
    DI void operator()(Acc& acc, const Unit& u, int wr, int wc, int fr, int fq) const {
        const int cb = u.pn * 256 + wc * 32 + 8 * fq;
#pragma unroll
        for (int ai = 0; ai < 2; ++ai)
#pragma unroll
            for (int m = 0; m < 4; ++m) {
                const size_t row = (size_t)(u.pm * 256 + ai * 128 + wr * 64 + m * 16 + fr);
#pragma unroll
                for (int bj = 0; bj < 2; ++bj) {
                    const u32x4 g = *(const u32x4*)(GB + row * 1024 + cb + bj * 128);
                    f32x4 a0 = acc[ai][bj][m][0], a1 = acc[ai][bj][m][1];
                    a0[0] *= bflo(g.x); a0[1] *= bfhi(g.x); a0[2] *= bflo(g.y); a0[3] *= bfhi(g.y);
                    a1[0] *= bflo(g.z); a1[1] *= bfhi(g.z); a1[2] *= bflo(g.w); a1[3] *= bfhi(g.w);
                    st16_wt(MERGED + row * 1024 + cb + bj * 128, pack8(a0, a1));
                }
            }
    }
};
struct EpiOut {
    static constexpr bool PERM = true, AFTER_DRAIN = false;
    const float* X; bf16* X1; float* SSQX; int skipall;
    DI void operator()(Acc& acc, const Unit& u, int wr, int wc, int fr, int fq) const {
        asm volatile("" : "+v"(fr), "+v"(fq));
        const int cb = u.pn * 256 + wc * 32 + 8 * fq;
        u32x4 pk[2][2][4];
#pragma unroll
        for (int ai = 0; ai < 2; ++ai)
#pragma unroll
            for (int bj = 0; bj < 2; ++bj)
#pragma unroll
                for (int m = 0; m < 4; ++m) pk[ai][bj][m] = pack8(acc[ai][bj][m][0], acc[ai][bj][m][1]);
#pragma unroll
        for (int ai = 0; ai < 2; ++ai) {
            f32x4 xl[4][2][2];
#pragma unroll
            for (int m = 0; m < 4; ++m)
#pragma unroll
                for (int bj = 0; bj < 2; ++bj) { const size_t off = (size_t)(u.pm * 256 + ai * 128 + wr * 64 + m * 16 + fr) * 1024 + cb + bj * 128; xl[m][bj][0] = __builtin_nontemporal_load((const f32x4*)(X + off)); xl[m][bj][1] = __builtin_nontemporal_load((const f32x4*)(X + off + 4)); }
#pragma unroll
            for (int m = 0; m < 4; ++m) {
                const size_t row = (size_t)(u.pm * 256 + ai * 128 + wr * 64 + m * 16 + fr);
                float ss = 0.f;
#pragma unroll
                for (int bj = 0; bj < 2; ++bj) {
                    const u32x4 p = pk[ai][bj][m];
                    const f32x4 a0 = (f32x4){bflo(p.x), bfhi(p.x), bflo(p.y), bfhi(p.y)} + xl[m][bj][0], a1 = (f32x4){bflo(p.z), bfhi(p.z), bflo(p.w), bfhi(p.w)} + xl[m][bj][1];
                    ss += (a0[0] * a0[0] + a0[1] * a0[1]) + (a0[2] * a0[2] + a0[3] * a0[3]) + (a1[0] * a1[0] + a1[1] * a1[1]) + (a1[2] * a1[2] + a1[3] * a1[3]);
                    st16_wt(X1 + row * 1024 + cb + bj * 128, pack8(a0, a1));
                }
                ss += __shfl_xor(ss, 16); ss += __shfl_xor(ss, 32);
                if (fq == 0) SSQX[row * 16 + u.pn * 4 + wc] = ss;
            }
            __builtin_amdgcn_sched_barrier(0);
        }
    }
};
DI float rstd_x1(const float* SSQX, size_t row) {
    const f32x4 a = *(const f32x4*)(SSQX + row * 16), b = *(const f32x4*)(SSQX + row * 16 + 4), c = *(const f32x4*)(SSQX + row * 16 + 8), d = *(const f32x4*)(SSQX + row * 16 + 12);
    const float s = ((a[0] + a[1]) + (a[2] + a[3])) + ((b[0] + b[1]) + (b[2] + b[3])) + ((c[0] + c[1]) + (c[2] + c[3])) + ((d[0] + d[1]) + (d[2] + d[3]));
    return rsqrtf(s * (1.f / 1024.f) + EPS);
}
struct EpiQ {
    static constexpr bool PERM = true, AFTER_DRAIN = false;
    bf16* Q; const float* SSQX;
    DI void operator()(Acc& acc, const Unit& u, int wr, int wc, int fr, int fq) const {
        const int cb = u.pn * 256 + wc * 32 + 8 * fq;
#pragma unroll
        for (int ai = 0; ai < 2; ++ai)
#pragma unroll
            for (int m = 0; m < 4; ++m) {
                const size_t row = (size_t)(u.pm * 256 + ai * 128 + wr * 64 + m * 16 + fr);
                const float rs = rstd_x1(SSQX, row);
#pragma unroll
                for (int bj = 0; bj < 2; ++bj)
                    st16_wt(Q + ((((size_t)(row >> 5) * 8 + u.pn) * 2 + bj) * 8 + 2 * wc + (fq >> 1)) * 512 + (((int)row & 31) + 32 * (fq & 1)) * 8, pack8(acc[ai][bj][m][0] * rs, acc[ai][bj][m][1] * rs));
            }
    }
};

#define MFMA32(a, b, c) __builtin_amdgcn_mfma_f32_32x32x16_bf16((a), (b), (c), 0, 0, 0)
DI bf16x8 ldg16(const bf16* p) { return *(const bf16x8*)p; }
DI bf16x8 ldg2x8(const bf16* p0, const bf16* p1) { const s16x4 a = *(const s16x4*)p0, b = *(const s16x4*)p1; return __builtin_shufflevector(a, b, 0, 1, 2, 3, 4, 5, 6, 7); }
DI bf16x8 packx(const f32x16& x, int s) {
    u32x4 p; p.x = pk2(x[8 * s + 0], x[8 * s + 1]); p.y = pk2(x[8 * s + 2], x[8 * s + 3]); p.z = pk2(x[8 * s + 4], x[8 * s + 5]); p.w = pk2(x[8 * s + 6], x[8 * s + 7]);
    return __builtin_bit_cast(bf16x8, p);
}
DI f32x16 zero16() { f32x16 z;
#pragma unroll
    for (int i = 0; i < 16; ++i) z[i] = 0.f; return z; }

DI bf16x8 tr_frag(const LAS unsigned char* tile, int RS, int lane, int ks, int c) {
    const int hh = lane >> 5, blk = (lane >> 4) & 1, q = (lane & 15) >> 2, p = lane & 3;
    const LAS unsigned char* a0 = tile + (16 * ks + 8 * hh + q) * RS + (32 * c + 16 * blk + 4 * p) * 2;
    const s16x4 lo = __builtin_amdgcn_ds_read_tr16_b64_v4i16((LAS s16x4*)a0);
    const s16x4 hi = __builtin_amdgcn_ds_read_tr16_b64_v4i16((LAS s16x4*)(a0 + 4 * RS));
    return __builtin_shufflevector(lo, hi, 0, 1, 2, 3, 4, 5, 6, 7);
}

DI bf16x8 tr_frag_perm(const LAS unsigned char* tile, int RS, int lane, int ks, int c) {
    const int hh = lane >> 5, blk = (lane >> 4) & 1, q = (lane & 15) >> 2, p = lane & 3;
    const LAS unsigned char* a0 = tile + (16 * ks + 4 * hh + q) * RS + (32 * c + 16 * blk + 4 * p) * 2;
    const s16x4 lo = __builtin_amdgcn_ds_read_tr16_b64_v4i16((LAS s16x4*)a0);
    const s16x4 hi = __builtin_amdgcn_ds_read_tr16_b64_v4i16((LAS s16x4*)(a0 + 8 * RS));
    return __builtin_shufflevector(lo, hi, 0, 1, 2, 3, 4, 5, 6, 7);
}

constexpr int HG_KRS = 320;
DI void hg_pass1(LAS unsigned char* lds, const bf16* Kh, const bf16* VTh, bf16* STh, int wg, int nwg) {
    const int tid = fresh_tid(), lane = tid & 63, w = __builtin_amdgcn_readfirstlane(tid >> 6), r = lane & 31, hh = lane >> 5;
    for (int unit = wg; unit < 16 * HG_NC; unit += nwg) {
        const int bh = unit >> 7, c = unit & 127, b = bh >> 3, h = bh & 7;
        __syncthreads();
        {
            const int row = tid >> 3, ch = tid & 7;
            const bf16* src = Kh + ((size_t)(b * SEQ + c * 64 + row)) * 1024 + h * 128;
            const bf16x8 v0 = ldg16(src + ch * 8), v1 = ldg16(src + 64 + ch * 8);
            *(LAS bf16x8*)(lds + row * HG_KRS + ch * 16) = v0; *(LAS bf16x8*)(lds + row * HG_KRS + 128 + ch * 16) = v1;
        }
        __syncthreads();
        const int mt = w & 3, nt0 = w >> 2;
        f32x16 a0 = zero16(), a1 = zero16();
        const bf16* vfr = VTh + ((size_t)(bh * 256 + 2 * c) * 4 + mt) * 2 * 512 + lane * 8;
#pragma unroll
        for (int ks = 0; ks < 4; ++ks) {
            const bf16x8 av = ldg16(vfr + (size_t)(ks >> 1) * 4 * 2 * 512 + (ks & 1) * 512);
            a0 = MFMA32(av, tr_frag_perm(lds, HG_KRS, lane, ks, nt0), a0);
            a1 = MFMA32(av, tr_frag_perm(lds, HG_KRS, lane, ks, nt0 + 2), a1);
        }
        bf16* dst = STh + ((size_t)(bh * HG_NC + c)) * 16384;
#pragma unroll
        for (int i = 0; i < 16; ++i) {
            const int v = 32 * mt + crow(i, hh);
            dst[v * 128 + 32 * nt0 + r] = f2bf(a0[i]); dst[v * 128 + 32 * (nt0 + 2) + r] = f2bf(a1[i]);
        }
    }
    __syncthreads();
}

DI void hg_scan(bf16* STh, const float* DEC, int gtid, int gsz) {
    for (int idx = gtid; idx < 16 * 128 * 64; idx += gsz) {
        const int dq = idx & 63, v = (idx >> 6) & 127, bh = idx >> 13;
        float c0 = 0.f, c1 = 0.f;
        bf16* p = STh + ((size_t)bh * HG_NC) * 16384 + v * 128 + dq * 2;
        const float* dp = DEC + ((size_t)bh * HG_NC) * 128 + dq * 2;
#pragma unroll 1
        for (int cb = 0; cb < HG_NC; cb += 32) {
            unsigned wv[32]; f32x2 dec[32];
#pragma unroll
            for (int j = 0; j < 32; ++j) { wv[j] = *(const unsigned*)(p + (size_t)(cb + j) * 16384); dec[j] = *(const f32x2*)(dp + (cb + j) * 128); }
#pragma unroll
            for (int j = 0; j < 32; ++j) {
                *(unsigned*)(p + (size_t)(cb + j) * 16384) = pk2(c0, c1);
                c0 = dec[j][0] * (c0 + bflo(wv[j])); c1 = dec[j][1] * (c1 + bfhi(wv[j]));
            }
        }
    }
}
DI void rt_scan(bf16* STr, int gtid, int gsz) {
    for (int idx = gtid; idx < 8 * 512 * 32; idx += gsz) {
        const int dq = idx & 31, v = (idx >> 5) & 511, bh = idx >> 14, h = bh & 3;
        const float dec = exp2f((float)RT_L * __log2f(1.f - exp2f(-5.f - (float)h)));
        float carry[8];
#pragma unroll
        for (int e = 0; e < 8; ++e) carry[e] = 0.f;
        bf16* p = STr + ((size_t)bh * RT_NS) * 131072 + v * 256 + dq * 8;
#pragma unroll
        for (int c = 0; c < RT_NS; ++c) {
            const u32x4 wv = *(const u32x4*)(p + (size_t)c * 131072);
            u32x4 o; o.x = pk2(carry[0], carry[1]); o.y = pk2(carry[2], carry[3]); o.z = pk2(carry[4], carry[5]); o.w = pk2(carry[6], carry[7]);
            *(u32x4*)(p + (size_t)c * 131072) = o;
            if (c == RT_NS - 1) break;
            carry[0] = dec * (carry[0] + bflo(wv.x)); carry[1] = dec * (carry[1] + bfhi(wv.x));
            carry[2] = dec * (carry[2] + bflo(wv.y)); carry[3] = dec * (carry[3] + bfhi(wv.y));
            carry[4] = dec * (carry[4] + bflo(wv.z)); carry[5] = dec * (carry[5] + bfhi(wv.z));
            carry[6] = dec * (carry[6] + bflo(wv.w)); carry[7] = dec * (carry[7] + bfhi(wv.w));
        }
    }
}

DI void hg_pass3(LAS unsigned char* lds, const bf16* Qh, const bf16* Kh, const bf16* VTh, const bf16* STh, const float* hg_norm_w, bf16* OHG, int gw, int ngw, int dry) {
    const int tid_ = fresh_tid(), lane = tid_ & 63, r = lane & 31, hh = lane >> 5;
    LAS unsigned char* ot = lds + __builtin_amdgcn_readfirstlane(tid_ >> 6) * 8704;
    for (int unit = gw; unit < 16 * HG_NC * 2; unit += ngw) {
        const int tb = unit & 1, c = (unit >> 1) & 127, bh = unit >> 8, b = bh >> 3, h = bh & 7;
        const size_t trow = (size_t)(b * SEQ + c * 64 + tb * 32 + r);
        bf16x8 qf[8];
#pragma unroll
        for (int kk = 0; kk < 8; ++kk) qf[kk] = ldg16(Qh + trow * 1024 + h * 128 + kk * 16 + 8 * hh);
        const bf16* st = STh + ((size_t)(bh * HG_NC + c)) * 16384;
        bf16x8 sp[2][8];
#pragma unroll
        for (int nv = 0; nv < 2; ++nv)
#pragma unroll
            for (int kk = 0; kk < 8; ++kk) sp[nv][kk] = ldg16(st + (nv * 32 + r) * 128 + kk * 16 + 8 * hh);
        f32x16 acc[4];
#pragma unroll
        for (int nv = 0; nv < 4; ++nv) acc[nv] = zero16();
        for (int sb = 0; sb <= tb; ++sb) {
            const size_t srow = (size_t)(b * SEQ + c * 64 + sb * 32 + r);
            f32x16 x = zero16();
#pragma unroll
            for (int kk = 0; kk < 8; ++kk) x = MFMA32(ldg16(Kh + srow * 1024 + h * 128 + kk * 16 + 8 * hh), qf[kk], x);
            if (sb == tb) {
#pragma unroll
                for (int i = 0; i < 16; ++i) if (crow(i, hh) > r) x[i] = 0.f;
            }
            const bf16x8 xs0 = packx(x, 0), xs1 = packx(x, 1);
#pragma unroll
            for (int nv = 0; nv < 4; ++nv) {
                const bf16* vb = VTh + (((size_t)(bh * 256 + 2 * c + sb) * 4 + nv) * 2) * 512 + lane * 8;
                acc[nv] = MFMA32(ldg16(vb), xs0, acc[nv]);
                acc[nv] = MFMA32(ldg16(vb + 512), xs1, acc[nv]);
            }
        }
#pragma unroll
        for (int nv = 2; nv < 4; ++nv)
#pragma unroll
            for (int kk = 0; kk < 8; ++kk) acc[nv] = MFMA32(ldg16(st + (nv * 32 + r) * 128 + kk * 16 + 8 * hh), qf[kk], acc[nv]);
#pragma unroll
        for (int nv = 0; nv < 2; ++nv)
#pragma unroll
            for (int kk = 0; kk < 8; ++kk) acc[nv] = MFMA32(sp[nv][kk], qf[kk], acc[nv]);
        bf16* orow = OHG + ((size_t)(b * SEQ + c * 64 + tb * 32)) * 1024 + h * 128;
        u32x4 gpre[8];
#pragma unroll
        for (int k = 0; k < 8; ++k) gpre[k] = *(const u32x4*)(orow + (size_t)(4 * k + (lane >> 4)) * 1024 + (lane & 15) * 8);
        float ss = 0.f;
#pragma unroll
        for (int nv = 0; nv < 4; ++nv)
#pragma unroll
            for (int i = 0; i < 16; ++i) ss += acc[nv][i] * acc[nv][i];
        ss += __shfl_xor(ss, 32);
        const float rs = rsqrtf(ss * (1.f / 128.f) + EPS);
#pragma unroll
        for (int nv = 0; nv < 4; ++nv)
#pragma unroll
            for (int g = 0; g < 4; ++g) {
                const int v = nv * 32 + 8 * g + 4 * hh;
                const f32x4 wv = *(const f32x4*)(hg_norm_w + h * 128 + v);
                u32x2 o; o.x = pk2(acc[nv][4 * g] * rs * wv[0], acc[nv][4 * g + 1] * rs * wv[1]); o.y = pk2(acc[nv][4 * g + 2] * rs * wv[2], acc[nv][4 * g + 3] * rs * wv[3]);
                *(LAS u32x2*)(ot + r * 272 + v * 2) = o;
            }
#pragma unroll
        for (int k = 0; k < 8; ++k) {
            const int row = 4 * k + (lane >> 4), ch = lane & 15;
            const u32x4 val = *(const LAS u32x4*)(ot + row * 272 + ch * 16);
            bf16* gp = orow + (size_t)row * 1024 + ch * 8;
            const u32x4 gt = gpre[k];
            u32x4 o;
            o.x = pk2(bflo(val.x) * bflo(gt.x), bfhi(val.x) * bfhi(gt.x)); o.y = pk2(bflo(val.y) * bflo(gt.y), bfhi(val.y) * bfhi(gt.y));
            o.z = pk2(bflo(val.z) * bflo(gt.z), bfhi(val.z) * bfhi(gt.z)); o.w = pk2(bflo(val.w) * bflo(gt.w), bfhi(val.w) * bfhi(gt.w));
            if (!dry) *(u32x4*)gp = o; else asm volatile("" :: "v"(o));
        }
    }
}

constexpr int RT_KRS = 576;
constexpr int RT_KBUF = 64 * RT_KRS;
DI void rt_pass1(LAS unsigned char* lds, const bf16* Kr, const bf16* VTr, bf16* STr, int wg, int nwg) {
    const int tid = fresh_tid(), lane = tid & 63, w = __builtin_amdgcn_readfirstlane(tid >> 6), r = lane & 31, hh = lane >> 5;
    const int wm = w & 3, wn = w >> 2;
    const int srow = tid >> 3, sch = tid & 7;
    for (int unit = wg; unit < 8 * (RT_NS - 1) * 2; unit += nwg) {
        const int vh = unit & 1, sg = (unit >> 1) % (RT_NS - 1), bh = (unit >> 1) / (RT_NS - 1), b = bh >> 2, h = bh & 3;
        f32x16 acc[2][4];
#pragma unroll
        for (int i = 0; i < 2; ++i)
#pragma unroll
            for (int j = 0; j < 4; ++j) acc[i][j] = zero16();
        const bf16* kbase = Kr + ((size_t)(b * SEQ + sg * RT_L)) * 1024 + h * 256;
        bf16x8 st[4];
#pragma unroll
        for (int i = 0; i < 4; ++i) st[i] = ldg16(kbase + (size_t)srow * 1024 + (sch + 8 * i) * 8);
        __syncthreads();
#pragma unroll
        for (int i = 0; i < 4; ++i) *(LAS bf16x8*)(lds + srow * RT_KRS + (sch + 8 * i) * 16) = st[i];
        for (int sb = 0; sb < RT_L / 64; ++sb) {
            const LAS unsigned char* cur = lds + (sb & 1) * RT_KBUF;
            if (sb + 1 < RT_L / 64) {
#pragma unroll
                for (int i = 0; i < 4; ++i) st[i] = ldg16(kbase + (size_t)((sb + 1) * 64 + srow) * 1024 + (sch + 8 * i) * 8);
            }
            bf16x8 av[4][2];
#pragma unroll
            for (int ks = 0; ks < 4; ++ks)
#pragma unroll
                for (int i = 0; i < 2; ++i) av[ks][i] = ldg16(VTr + (((((size_t)(bh * 256 + sg * 16 + sb * 2 + (ks >> 1))) * 16 + vh * 8 + wm * 2 + i) * 2 + (ks & 1)) * 64 + lane) * 8);
            __syncthreads();
#pragma unroll
            for (int ks = 0; ks < 4; ++ks) {
#pragma unroll
                for (int j = 0; j < 4; ++j) {
                    const bf16x8 bv = tr_frag_perm(cur, RT_KRS, lane, ks, wn * 4 + j);
                    acc[0][j] = MFMA32(av[ks][0], bv, acc[0][j]); acc[1][j] = MFMA32(av[ks][1], bv, acc[1][j]);
                }
                __builtin_amdgcn_sched_barrier(0);
            }
            if (sb + 1 < RT_L / 64) {
                LAS unsigned char* nxt = lds + ((sb + 1) & 1) * RT_KBUF;
#pragma unroll
                for (int i = 0; i < 4; ++i) *(LAS bf16x8*)(nxt + srow * RT_KRS + (sch + 8 * i) * 16) = st[i];
            }
        }
        __syncthreads();
        {
            LAS unsigned char* img = lds + w * 16384;
#pragma unroll
            for (int i = 0; i < 2; ++i)
#pragma unroll
                for (int j = 0; j < 4; ++j)
#pragma unroll
                    for (int e = 0; e < 16; ++e)
                        *(LAS bf16*)(img + (i * 8 + 2 * j + (r >> 4)) * 1024 + (crow(e, hh) + 32 * ((r >> 3) & 1)) * 16 + (r & 7) * 2) = f2bf(acc[i][j][e]);
            asm volatile("s_waitcnt lgkmcnt(0)" ::: "memory");
            bf16* dst = STr + ((size_t)(bh * RT_NS + sg)) * 131072 + lane * 8;
#pragma unroll
            for (int blk = 0; blk < 16; ++blk)
                *(u32x4*)(dst + (((vh * 8 + wm * 2 + (blk >> 3)) * 16 + wn * 8 + (blk & 7)) * 64) * 8) = *(const LAS u32x4*)(img + blk * 1024 + lane * 16);
        }
    }
    __syncthreads();
}

constexpr int RQ_RS = 528;
constexpr int RQ_QBYTES = 128 * RQ_RS, RQ_KBYTES = 32 * RQ_RS;
DI void rt_pass3_wg(LAS unsigned char* lds, const bf16* Qr, const bf16* Kr, const bf16* VTr, const bf16* STr, bf16* ORET, float* SSQP, int wg, int nwg, int dry) {
    const int tid = fresh_tid(), lane = tid & 63, w = __builtin_amdgcn_readfirstlane(tid >> 6), r = lane & 31, hh = lane >> 5;
    const int tsub = w & 3, vh = w >> 2;
    LAS unsigned char* Qs = lds;
    LAS unsigned char* Ks = lds + RQ_QBYTES;
    for (int pairidx = wg; pairidx < 256; pairidx += nwg) {
#pragma unroll 1
        for (int half = 0; half < 2; ++half) {
            const int sgid = pairidx >> 1, bh = sgid >> 4, sg = sgid & 15, b = bh >> 2, h = bh & 3;
            const int qq = half ? 3 - (pairidx & 1) : (pairidx & 1);
            const int pos0 = sg * RT_L + qq * 128, nsb = 4 * qq + 4, mysb = 4 * qq + tsub;
            const bf16* qsrc = Qr + ((size_t)(b * SEQ + pos0)) * 1024 + h * 256;
            const bf16* ksrc = Kr + ((size_t)(b * SEQ + sg * RT_L)) * 1024 + h * 256;
            unsigned stoff = (unsigned)((tid >> 5) * 1024 + (tid & 31) * 8);
            unsigned stlds = (unsigned)((tid >> 5) * RQ_RS + (tid & 31) * 16);
            asm volatile("" : "+v"(stoff), "+v"(stlds));
            __syncthreads();
#pragma unroll
            for (int i = 0; i < 8; ++i) *(LAS bf16x8*)(Qs + stlds + i * 16 * RQ_RS) = ldg16(qsrc + i * 16 * 1024 + stoff);
            bf16x8 kst[2];
#pragma unroll
            for (int i = 0; i < 2; ++i) *(LAS bf16x8*)(Ks + stlds + i * 16 * RQ_RS) = ldg16(ksrc + i * 16 * 1024 + stoff);
            f32x16 acc[8];
#pragma unroll
            for (int nv = 0; nv < 8; ++nv) acc[nv] = zero16();
            __syncthreads();
            const LAS unsigned char* qfr = Qs + (tsub * 32 + r) * RQ_RS + 16 * hh;
            {
                const bf16* st = STr + ((size_t)(bh * RT_NS + sg)) * 131072 + (size_t)(vh * 8) * 16 * 512;
                unsigned so = (unsigned)(lane * 8);
                asm volatile("" : "+v"(so));
                bf16x8 fa[8], fb[8];
#pragma unroll
                for (int nv = 0; nv < 8; ++nv) fa[nv] = ldg16(st + nv * 16 * 512 + so);
#pragma unroll 1
                for (int k2 = 0; k2 < 8; ++k2) {
#pragma unroll
                    for (int nv = 0; nv < 8; ++nv) fb[nv] = ldg16(st + nv * 16 * 512 + (2 * k2 + 1) * 512 + so);
                    {
                        const bf16x8 q = *(const LAS bf16x8*)(qfr + (2 * k2) * 32);
#pragma unroll
                        for (int nv = 0; nv < 8; ++nv) acc[nv] = MFMA32(fa[nv], q, acc[nv]);
                    }
                    __builtin_amdgcn_sched_barrier(0);
                    if (k2 < 7) {
#pragma unroll
                        for (int nv = 0; nv < 8; ++nv) fa[nv] = ldg16(st + nv * 16 * 512 + (2 * k2 + 2) * 512 + so);
                    }
                    {
                        const bf16x8 q = *(const LAS bf16x8*)(qfr + (2 * k2 + 1) * 32);
#pragma unroll
                        for (int nv = 0; nv < 8; ++nv) acc[nv] = MFMA32(fb[nv], q, acc[nv]);
                    }
                    __builtin_amdgcn_sched_barrier(0);
                }
            }
            const bf16* vbase = VTr + (((size_t)(bh * 256 + sg * 16)) * 16 + vh * 8) * 1024;
            unsigned vo = (unsigned)(lane * 8);
            asm volatile("" : "+v"(vo));
#pragma unroll 1
            for (int sb = 0; sb < nsb; ++sb) {
                const LAS unsigned char* kcur = Ks + (sb & 1) * RQ_KBYTES;
                if (sb + 1 < nsb) {
#pragma unroll
                    for (int i = 0; i < 2; ++i) kst[i] = ldg16(ksrc + (size_t)(sb + 1) * 32 * 1024 + i * 16 * 1024 + stoff);
                }
                if (sb <= mysb) {
                    bf16x8 vt[8][2];
                    const bf16* vb = vbase + (size_t)sb * 16 * 1024;
#pragma unroll
                    for (int nv = 0; nv < 8; ++nv) { vt[nv][0] = ldg16(vb + nv * 1024 + vo); vt[nv][1] = ldg16(vb + nv * 1024 + 512 + vo); }
                    f32x16 x = zero16();
                    const LAS unsigned char* kfr = kcur + r * RQ_RS + 16 * hh;
#pragma unroll
                    for (int kk = 0; kk < 16; ++kk) { x = MFMA32(*(const LAS bf16x8*)(kfr + kk * 32), *(const LAS bf16x8*)(qfr + kk * 32), x); if (kk & 1) __builtin_amdgcn_sched_barrier(0); }
                    if (sb == mysb) {
#pragma unroll
                        for (int i = 0; i < 16; ++i) if (crow(i, hh) > r) x[i] = 0.f;
                    }
                    const bf16x8 xs0 = packx(x, 0), xs1 = packx(x, 1);
#pragma unroll
                    for (int nv = 0; nv < 8; ++nv) { acc[nv] = MFMA32(vt[nv][0], xs0, acc[nv]); acc[nv] = MFMA32(vt[nv][1], xs1, acc[nv]); }
                }
                if (sb + 1 < nsb) {
                    LAS unsigned char* knx = Ks + ((sb + 1) & 1) * RQ_KBYTES;
#pragma unroll
                    for (int i = 0; i < 2; ++i) *(LAS bf16x8*)(knx + stlds + i * 16 * RQ_RS) = kst[i];
                }
                __syncthreads();
            }
            float ss = 0.f;
#pragma unroll
            for (int nv = 0; nv < 8; ++nv)
#pragma unroll
                for (int i = 0; i < 16; ++i) ss += acc[nv][i] * acc[nv][i];
            ss += __shfl_xor(ss, 32);
            LAS float* sx = (LAS float*)(lds + 8 * 16896);
            if (hh == 0) sx[vh * 128 + tsub * 32 + r] = ss;
            __syncthreads();
            const float rs = rsqrtf((sx[tsub * 32 + r] + sx[128 + tsub * 32 + r]) * (1.f / 512.f) + EPS);
            LAS unsigned char* ot = lds + w * 16896;
#pragma unroll
            for (int nv = 0; nv < 8; ++nv)
#pragma unroll
                for (int g = 0; g < 4; ++g) {
                    u32x2 o; o.x = pk2(acc[nv][4 * g] * rs, acc[nv][4 * g + 1] * rs); o.y = pk2(acc[nv][4 * g + 2] * rs, acc[nv][4 * g + 3] * rs);
                    *(LAS u32x2*)(ot + r * 528 + (nv * 32 + 8 * g + 4 * hh) * 2) = o;
                }
            bf16* orow = ORET + (size_t)(b * SEQ + pos0 + tsub * 32) * 2048 + h * 512 + vh * 256;
#pragma unroll 4
            for (int k = 0; k < 16; ++k) {
                const int row = 2 * k + (lane >> 5), ch = lane & 31;
                const u32x4 val = *(const LAS u32x4*)(ot + row * 528 + ch * 16);
                bf16* gp = orow + (size_t)row * 2048 + ch * 8;
                const u32x4 gt = *(const u32x4*)gp;
                u32x4 o;
                o.x = pk2(bflo(val.x) * bflo(gt.x), bfhi(val.x) * bfhi(gt.x)); o.y = pk2(bflo(val.y) * bflo(gt.y), bfhi(val.y) * bfhi(gt.y));
                o.z = pk2(bflo(val.z) * bflo(gt.z), bfhi(val.z) * bfhi(gt.z)); o.w = pk2(bflo(val.w) * bflo(gt.w), bfhi(val.w) * bfhi(gt.w));
                if (!dry) *(u32x4*)gp = o; else asm volatile("" :: "v"(o));
            }
        }
    }
    __syncthreads();
}

constexpr int R3_KS = 128 * RQ_RS, R3_XS = R3_KS + 64 * RQ_RS, R3_ORS = 1040, R3_SX = 128 * R3_ORS;
DI void rt_pass3_v2(LAS unsigned char* lds, const bf16* Qr, const bf16* Kr, const bf16* VTr, const bf16* STr, bf16* ORET, int wg, int nwg, int dry) {
    const int tid = fresh_tid(), lane = tid & 63, w = __builtin_amdgcn_readfirstlane(tid >> 6), r = lane & 31, hh = lane >> 5;
    const int xtb = w & 3, xsub = w >> 2;
    LAS unsigned char* Qs = lds;
    LAS unsigned char* Ks = lds + R3_KS;
    LAS unsigned char* Xs = lds + R3_XS;
    for (int pairidx = wg; pairidx < 256; pairidx += nwg) {
#pragma unroll 1
        for (int half = 0; half < 2; ++half) {
            const int sgid = pairidx >> 1, bh = sgid >> 4, sg = sgid & 15, b = bh >> 2, h = bh & 3;
            const int qq = half ? 3 - (pairidx & 1) : (pairidx & 1);
            const int pos0 = sg * RT_L + qq * 128, nit = 2 * qq + 2;
            const bf16* qsrc = Qr + ((size_t)(b * SEQ + pos0)) * 1024 + h * 256;
            const bf16* ksrc = Kr + ((size_t)(b * SEQ + sg * RT_L)) * 1024 + h * 256;
            unsigned stoff = (unsigned)((tid >> 5) * 1024 + (tid & 31) * 8);
            unsigned stlds = (unsigned)((tid >> 5) * RQ_RS + (tid & 31) * 16);
            asm volatile("" : "+v"(stoff), "+v"(stlds));
            const bf16* st = STr + ((size_t)(bh * RT_NS + sg)) * 131072 + (size_t)(2 * w) * 16 * 512;
            unsigned so = (unsigned)(lane * 8);
            asm volatile("" : "+v"(so));
            bf16x8 fa[2][4], fb[2][4];
#pragma unroll
            for (int nv = 0; nv < 2; ++nv)
#pragma unroll
                for (int k = 0; k < 4; ++k) fa[nv][k] = ldg16(st + nv * 16 * 512 + k * 512 + so);
            __syncthreads();
#pragma unroll
            for (int i = 0; i < 8; ++i) *(LAS bf16x8*)(Qs + stlds + i * 16 * RQ_RS) = ldg16(qsrc + i * 16 * 1024 + stoff);
            bf16x8 kst[4];
#pragma unroll
            for (int i = 0; i < 4; ++i) *(LAS bf16x8*)(Ks + stlds + i * 16 * RQ_RS) = ldg16(ksrc + i * 16 * 1024 + stoff);
            f32x16 acc[2][4];
#pragma unroll
            for (int nv = 0; nv < 2; ++nv)
#pragma unroll
                for (int tb = 0; tb < 4; ++tb) acc[nv][tb] = zero16();
            __syncthreads();
            const LAS unsigned char* qfr = Qs + r * RQ_RS + 16 * hh;
            {
#pragma unroll 1
                for (int k8 = 0; k8 < 2; ++k8) {
#pragma unroll
                    for (int nv = 0; nv < 2; ++nv)
#pragma unroll
                        for (int k = 0; k < 4; ++k) fb[nv][k] = ldg16(st + nv * 16 * 512 + (8 * k8 + 4 + k) * 512 + so);
#pragma unroll
                    for (int k = 0; k < 4; ++k)
#pragma unroll
                        for (int tb = 0; tb < 4; ++tb) {
                            const bf16x8 q = *(const LAS bf16x8*)(qfr + tb * 32 * RQ_RS + (8 * k8 + k) * 32);
                            acc[0][tb] = MFMA32(fa[0][k], q, acc[0][tb]); acc[1][tb] = MFMA32(fa[1][k], q, acc[1][tb]);
                        }
                    __builtin_amdgcn_sched_barrier(0);
                    if (k8 == 0) {
#pragma unroll
                        for (int nv = 0; nv < 2; ++nv)
#pragma unroll
                            for (int k = 0; k < 4; ++k) fa[nv][k] = ldg16(st + nv * 16 * 512 + (8 + k) * 512 + so);
                    }
#pragma unroll
                    for (int k = 0; k < 4; ++k)
#pragma unroll
                        for (int tb = 0; tb < 4; ++tb) {
                            const bf16x8 q = *(const LAS bf16x8*)(qfr + tb * 32 * RQ_RS + (8 * k8 + 4 + k) * 32);
                            acc[0][tb] = MFMA32(fb[0][k], q, acc[0][tb]); acc[1][tb] = MFMA32(fb[1][k], q, acc[1][tb]);
                        }
                    __builtin_amdgcn_sched_barrier(0);
                }
            }
            const bf16* vbase = VTr + (((size_t)(bh * 256 + sg * 16)) * 16 + 2 * w) * 1024;
            unsigned vo = (unsigned)(lane * 8);
            asm volatile("" : "+v"(vo));
#pragma unroll 1
            for (int it = 0; it < nit; ++it) {
                bf16x8 vt[2][2][2];
#pragma unroll
                for (int sub = 0; sub < 2; ++sub)
#pragma unroll
                    for (int nv = 0; nv < 2; ++nv) { const bf16* vb = vbase + (size_t)(2 * it + sub) * 16 * 1024 + nv * 1024 + vo; vt[sub][nv][0] = ldg16(vb); vt[sub][nv][1] = ldg16(vb + 512); }
                if (it + 1 < nit) {
#pragma unroll
                    for (int i = 0; i < 4; ++i) kst[i] = ldg16(ksrc + (size_t)(it + 1) * 64 * 1024 + i * 16 * 1024 + stoff);
                }
                {
                    const int mysb = 2 * it + xsub, lim = 4 * qq + xtb;
                    if (mysb <= lim) {
                        f32x16 x = zero16();
                        const LAS unsigned char* kfr = Ks + (xsub * 32 + r) * RQ_RS + 16 * hh;
                        const LAS unsigned char* qf = qfr + xtb * 32 * RQ_RS;
#pragma unroll
                        for (int kk = 0; kk < 16; ++kk) { x = MFMA32(*(const LAS bf16x8*)(kfr + kk * 32), *(const LAS bf16x8*)(qf + kk * 32), x); if (kk & 1) __builtin_amdgcn_sched_barrier(0); }
                        if (mysb == lim) {
#pragma unroll
                            for (int i = 0; i < 16; ++i) if (crow(i, hh) > r) x[i] = 0.f;
                        }
                        *(LAS bf16x8*)(Xs + ((xsub * 4 + xtb) * 2 + 0) * 1024 + lane * 16) = packx(x, 0);
                        *(LAS bf16x8*)(Xs + ((xsub * 4 + xtb) * 2 + 1) * 1024 + lane * 16) = packx(x, 1);
                    }
                }
                __syncthreads();
                if (it + 1 < nit) {
#pragma unroll
                    for (int i = 0; i < 4; ++i) *(LAS bf16x8*)(Ks + stlds + i * 16 * RQ_RS) = kst[i];
                }
#pragma unroll
                for (int sub = 0; sub < 2; ++sub)
#pragma unroll
                    for (int tb = 0; tb < 4; ++tb) {
                        if (2 * it + sub <= 4 * qq + tb) {
                            const bf16x8 xs0 = *(const LAS bf16x8*)(Xs + ((sub * 4 + tb) * 2 + 0) * 1024 + lane * 16), xs1 = *(const LAS bf16x8*)(Xs + ((sub * 4 + tb) * 2 + 1) * 1024 + lane * 16);
                            acc[0][tb] = MFMA32(vt[sub][0][0], xs0, acc[0][tb]); acc[1][tb] = MFMA32(vt[sub][1][0], xs0, acc[1][tb]);
                            acc[0][tb] = MFMA32(vt[sub][0][1], xs1, acc[0][tb]); acc[1][tb] = MFMA32(vt[sub][1][1], xs1, acc[1][tb]);
                        }
                    }
                __syncthreads();
            }
            LAS float* sx = (LAS float*)(lds + R3_SX);
#pragma unroll
            for (int tb = 0; tb < 4; ++tb) {
                float ss = 0.f;
#pragma unroll
                for (int i = 0; i < 16; ++i) ss += acc[0][tb][i] * acc[0][tb][i] + acc[1][tb][i] * acc[1][tb][i];
                ss += __shfl_xor(ss, 32);
                if (hh == 0) sx[w * 128 + tb * 32 + r] = ss;
            }
            __syncthreads();
#pragma unroll
            for (int tb = 0; tb < 4; ++tb) {
                float s8 = 0.f;
#pragma unroll
                for (int w8 = 0; w8 < 8; ++w8) s8 += sx[w8 * 128 + tb * 32 + r];
                const float rs = rsqrtf(s8 * (1.f / 512.f) + EPS);
#pragma unroll
                for (int nv = 0; nv < 2; ++nv)
#pragma unroll
                    for (int g = 0; g < 4; ++g) {
                        u32x2 o; o.x = pk2(acc[nv][tb][4 * g] * rs, acc[nv][tb][4 * g + 1] * rs); o.y = pk2(acc[nv][tb][4 * g + 2] * rs, acc[nv][tb][4 * g + 3] * rs);
                        *(LAS u32x2*)(lds + (tb * 32 + r) * R3_ORS + w * 128 + (nv * 32 + 8 * g + 4 * hh) * 2) = o;
                    }
            }
            __syncthreads();
            bf16* orow = ORET + (size_t)(b * SEQ + pos0) * 2048 + h * 512;
#pragma unroll 8
            for (int k = 0; k < 16; ++k) {
                const int row = 8 * k + (tid >> 6), ch = tid & 63;
                const u32x4 val = *(const LAS u32x4*)(lds + row * R3_ORS + ch * 16);
                bf16* gp = orow + (size_t)row * 2048 + ch * 8;
                const u32x4 gt = *(const u32x4*)gp;
                u32x4 o;
                o.x = pk2(bflo(val.x) * bflo(gt.x), bfhi(val.x) * bfhi(gt.x)); o.y = pk2(bflo(val.y) * bflo(gt.y), bfhi(val.y) * bfhi(gt.y));
                o.z = pk2(bflo(val.z) * bflo(gt.z), bfhi(val.z) * bfhi(gt.z)); o.w = pk2(bflo(val.w) * bflo(gt.w), bfhi(val.w) * bfhi(gt.w));
                if (!dry) *(u32x4*)gp = o; else asm volatile("" :: "v"(o));
            }
        }
    }
    __syncthreads();
}

DI float dot2bf(unsigned a, unsigned b, float c) {
#if __has_builtin(__builtin_amdgcn_fdot2_f32_bf16)
    typedef __bf16 nb2 __attribute__((ext_vector_type(2)));
    return __builtin_amdgcn_fdot2_f32_bf16(__builtin_bit_cast(nb2, a), __builtin_bit_cast(nb2, b), c, false);
#else
    return c + bflo(a) * bflo(b) + bfhi(a) * bfhi(b);
#endif
}
DI unsigned key_pack(float s, unsigned lowbits, unsigned mask) {
    unsigned u = __float_as_uint(s); u = (u & 0x80000000u) ? ~u : (u | 0x80000000u);
    return (u & ~mask) | lowbits;
}
DI float key_val(unsigned k, unsigned mask) { unsigned u = k & ~mask; u = (u & 0x80000000u) ? (u & 0x7fffffffu) : ~u; return __uint_as_float(u); }
DI unsigned umin_(unsigned a, unsigned b) { return a < b ? a : b; }
DI unsigned umax_(unsigned a, unsigned b) { return a > b ? a : b; }
DI void ins16(unsigned (&t)[16], unsigned x) {
#pragma unroll
    for (int i = 15; i >= 1; --i) t[i] = umax_(umin_(t[i - 1], t[i]), umin_(umax_(t[i - 1], t[i]), x));
    t[0] = umax_(t[0], x);
}
DI void cswap_(unsigned& a, unsigned& b) { const unsigned hi = umax_(a, b), lo = umin_(a, b); a = hi; b = lo; }
DI void sort16(unsigned (&t)[16]) {
#pragma unroll
    for (int p = 1; p < 16; p *= 2)
#pragma unroll
        for (int k = p; k >= 1; k /= 2)
#pragma unroll
            for (int j = k % p; j <= 15 - k; j += 2 * k)
#pragma unroll
                for (int i = 0; i < k; ++i)
                    if (i + j + k <= 15 && (i + j) / (2 * p) == (i + j + k) / (2 * p)) cswap_(t[i + j], t[i + j + k]);
}
DI void top16_merge(unsigned (&t)[16], const unsigned (&s)[16]) {
#pragma unroll
    for (int i = 0; i < 16; ++i) t[i] = umax_(t[i], s[15 - i]);
#pragma unroll
    for (int k = 8; k >= 1; k /= 2)
#pragma unroll
        for (int i = 0; i < 16; ++i)
            if ((i & k) == 0) cswap_(t[i], t[i + k]);
}
constexpr int PR_KOFF = 20480, PR_KRS = 272;
DI void peer_retrieve(LAS unsigned char* lds, const bf16* Q, const bf16* SK, int* EIDX, float* EGATE, int wg, int nwg) {
    const int tid = fresh_tid(), lane = tid & 63, w = __builtin_amdgcn_readfirstlane(tid >> 6), r = lane & 31, hh = lane >> 5;
    LAS unsigned char* myl = lds + w * 2304 + lane * 36;
    LAS unsigned char* ks = lds + PR_KOFF;
    int staged_h = -1;
    for (int unit = 2 * wg; unit < 512; unit += (unit & 1) ? 2 * nwg - 1 : 1) {
        const int h = unit >> 6, tb = (unit & 63) * 8 + w;
        if (h != staged_h) {
            __syncthreads();
#pragma unroll
            for (int i = 0; i < 8; ++i) { const int cidx = tid + 512 * i, row = cidx >> 4, ch = cidx & 15;
                *(LAS bf16x8*)(ks + row * PR_KRS + ch * 16) = ldg16(SK + ((size_t)(h * 256 + row)) * 128 + ch * 8); }
            __syncthreads();
            staged_h = h;
        }
        const size_t trow = (size_t)(tb * 32 + r);
        bf16x8 qf[2][8];
        {
            const bf16* qblk = Q + ((size_t)tb * 8 + h) * 2 * 8 * 512 + lane * 8;
#pragma unroll
            for (int p = 0; p < 2; ++p)
#pragma unroll
                for (int kk = 0; kk < 8; ++kk) qf[p][kk] = ldg16(qblk + (p * 8 + kk) * 512);
        }
        unsigned L[2][16];
#pragma unroll
        for (int p = 0; p < 2; ++p) {
            f32x16 acc[4];
#pragma unroll
            for (int mt = 0; mt < 4; ++mt) acc[mt] = zero16();
            const LAS unsigned char* kfr = ks + (p * 128 + r) * PR_KRS + 16 * hh;
#pragma unroll
            for (int kk = 0; kk < 8; ++kk) {
#pragma unroll
                for (int mt = 0; mt < 4; ++mt) acc[mt] = MFMA32(*(const LAS bf16x8*)(kfr + mt * 32 * PR_KRS + kk * 32), qf[p][kk], acc[mt]);
                if (kk & 1) __builtin_amdgcn_sched_barrier(0);
            }
            unsigned t[16];
#pragma unroll
            for (int mt = 0; mt < 4; ++mt) {
                unsigned s[16];
#pragma unroll
                for (int i = 0; i < 16; ++i) s[i] = key_pack(acc[mt][i], (unsigned)(127 - 32 * mt - (i & 3) - 8 * (i >> 2)) - 4u * (unsigned)hh, 127u);
                sort16(s);
                if (mt == 0) {
#pragma unroll
                    for (int i = 0; i < 16; ++i) t[i] = s[i];
                } else top16_merge(t, s);
            }
            {
                unsigned o[16];
#pragma unroll
                for (int i = 0; i < 16; ++i) o[i] = (unsigned)__shfl_xor((int)t[i], 32);
                top16_merge(t, o);
            }
#pragma unroll
            for (int i = 0; i < 16; ++i) L[p][i] = t[i];
        }
#pragma unroll
        for (int p = 0; p < 2; ++p)
#pragma unroll
            for (int g = 0; g < 4; ++g) {
                const unsigned v = (127u - (L[p][4 * g] & 127u)) | ((127u - (L[p][4 * g + 1] & 127u)) << 8) | ((127u - (L[p][4 * g + 2] & 127u)) << 16) | ((127u - (L[p][4 * g + 3] & 127u)) << 24);
                *(LAS unsigned*)(myl + p * 16 + g * 4) = v;
            }
        float a[16], b[16];
#pragma unroll
        for (int i = 0; i < 16; ++i) { a[i] = key_val(L[0][i], 127u); b[i] = key_val(L[1][i], 127u); }
        unsigned c[16];
#pragma unroll
        for (int j = 0; j < 16; ++j) c[j] = key_pack(a[0] + b[j], (unsigned)(255 - j), 255u);
#pragma unroll
        for (int i = 1; i < 16; ++i)
#pragma unroll
            for (int j = 0; j < 16; ++j)
                if ((i + 1) * (j + 1) <= 16) ins16(c, key_pack(a[i] + b[j], (unsigned)(255 - (16 * i + j)), 255u));
        float v[16];
        float sum = 0.f;
        const float mx = key_val(c[0], 255u);
#pragma unroll
        for (int k = 0; k < 16; ++k) { v[k] = __expf(key_val(c[k], 255u) - mx); sum += v[k]; }
        const float inv = __builtin_amdgcn_rcpf(sum);
        asm volatile("s_waitcnt lgkmcnt(0)" ::: "memory");
        if (hh == 0) {
            int e[16];
#pragma unroll
            for (int k = 0; k < 16; ++k) {
                const unsigned cc = 255u - (c[k] & 255u);
                const unsigned i1 = *(LAS unsigned char*)(myl + (cc >> 4)), i2 = *(LAS unsigned char*)(myl + 16 + (cc & 15u));
                e[k] = (int)(i1 * 128u + i2);
            }
            int* ep = EIDX + trow * 128 + h * 16;
#pragma unroll
            for (int g = 0; g < 4; ++g) *(u32x4*)(ep + 4 * g) = (u32x4){(unsigned)e[4 * g], (unsigned)e[4 * g + 1], (unsigned)e[4 * g + 2], (unsigned)e[4 * g + 3]};
        } else {
            float* gp = EGATE + trow * 128 + h * 16;
#pragma unroll
            for (int g = 0; g < 4; ++g) *(f32x4*)(gp + 4 * g) = (f32x4){v[4 * g] * inv, v[4 * g + 1] * inv, v[4 * g + 2] * inv, v[4 * g + 3] * inv};
        }
        asm volatile("s_waitcnt lgkmcnt(0)" ::: "memory");
    }
}

DI float gelu_tanh(float x) {
    const float u2 = (-2.f * 0.7978845608028654f * 1.4426950408889634f) * (x + 0.044715f * x * x * x);
    return x * __builtin_amdgcn_rcpf(1.f + __builtin_amdgcn_exp2f(u2));
}

DI float bcast_f(float v, int j) { return __int_as_float(__builtin_amdgcn_readfirstlane(__float_as_int(__shfl(v, j)))); }
DI void quant_rows(const float* __restrict__ src, unsigned char* __restrict__ dst, float* __restrict__ scale, int nrows, int offs, int gw, int ngw, int lane) {
    for (int row0 = gw; row0 < nrows; row0 += 2 * ngw) {
        const int rowb = row0 + ngw, row1 = rowb < nrows ? rowb : row0;
        f32x4 v[2][4];
#pragma unroll
        for (int rr = 0; rr < 2; ++rr) { const f32x4* p = (const f32x4*)(src + (size_t)(rr ? row1 : row0) * 1024) + lane;
#pragma unroll
            for (int i = 0; i < 4; ++i) v[rr][i] = p[64 * i]; }
#pragma unroll
        for (int rr = 0; rr < 2; ++rr) {
            const int row = rr ? row1 : row0;
            float am = 0.f;
#pragma unroll
            for (int i = 0; i < 4; ++i)
#pragma unroll
                for (int e = 0; e < 4; ++e) am = fmaxf(am, fabsf(v[rr][i][e]));
#pragma unroll
            for (int o = 1; o < 64; o <<= 1) am = fmaxf(am, __shfl_xor(am, o));
            const float inv = am > 0.f ? 127.f * __builtin_amdgcn_rcpf(am) : 0.f;
            u32x4 w;
#pragma unroll
            for (int i = 0; i < 4; ++i) {
                unsigned pk = 0u;
#pragma unroll
                for (int e = 0; e < 4; ++e) { const int q = (int)rintf(v[rr][i][e] * inv) + offs; pk |= ((unsigned)q & 0xffu) << (8 * e); }
                w[i] = pk;
            }
            if (rr == 0 || rowb < nrows) {
#pragma unroll
                for (int i = 0; i < 4; ++i) *(unsigned*)(dst + ((size_t)(2 * i + (lane >> 5)) * nrows + row) * 128 + (lane & 31) * 4) = w[i];
                if (lane == 0) scale[row] = am > 0.f ? am * (1.f / 127.f) : 0.f;
            }
        }
    }
}
DI void quant_rows4(const float* __restrict__ src, unsigned char* __restrict__ dst, float* __restrict__ scale, int nrows, int noff, int gw, int ngw, int lane) {
    constexpr int NR = 4;
    for (int row0 = gw; row0 < nrows; row0 += NR * ngw) {
        f32x4 v[NR][4];
#pragma unroll
        for (int rr = 0; rr < NR; ++rr) { const int row = row0 + rr * ngw < nrows ? row0 + rr * ngw : row0; const f32x4* p = (const f32x4*)(src + (size_t)row * 1024) + lane;
#pragma unroll
            for (int i = 0; i < 4; ++i) v[rr][i] = __builtin_nontemporal_load(p + 64 * i); }
#pragma unroll
        for (int rr = 0; rr < NR; ++rr) {
            const int row = row0 + rr * ngw;
            float ss = 0.f;
#pragma unroll
            for (int i = 0; i < 4; ++i)
#pragma unroll
                for (int e = 0; e < 4; ++e) ss += v[rr][i][e] * v[rr][i][e];
            ss = wave_sum(ss);
            const float step = 0.3352f * sqrtf(ss * (1.f / 1024.f)), inv = step > 0.f ? __builtin_amdgcn_rcpf(step) : 0.f;
            if (rr == 0 || row < nrows) {
#pragma unroll
                for (int i = 0; i < 4; ++i) {
                    unsigned pk = 0u;
#pragma unroll
                    for (int e = 0; e < 4; ++e) { const int m = (int)fminf(fmaxf(floorf(v[rr][i][e] * inv), -8.f), 7.f); pk |= ((unsigned)(m + ((e & 1) ? 0 : noff)) & 0xfu) << (4 * e); }
                    const unsigned other = (unsigned)__shfl_xor((int)pk, 1);
                    if (!(lane & 1)) *(unsigned*)(dst + ((size_t)i * nrows + row) * 128 + (lane >> 1) * 4) = pk | (other << 16);
                }
                if (lane == 0) scale[row] = 0.5f * step;
            }
        }
    }
}
DI void quant_xw(const bf16* __restrict__ X1, const float* __restrict__ nw, unsigned char* __restrict__ XH, unsigned char* __restrict__ XL, float* __restrict__ XS, int* __restrict__ XSUM, int gw, int ngw, int lane) {
    for (int t0 = gw; t0 < T; t0 += 2 * ngw) {
        const int tb = t0 + ngw, t1 = tb < T ? tb : t0;
        u32x4 xr[2][2];
#pragma unroll
        for (int rr = 0; rr < 2; ++rr)
#pragma unroll
            for (int i = 0; i < 2; ++i) xr[rr][i] = ((const u32x4*)(X1 + (size_t)(rr ? t1 : t0) * 1024))[64 * i + lane];
        f32x4 w4[2][2];
#pragma unroll
        for (int i = 0; i < 2; ++i) { w4[i][0] = ((const f32x4*)nw)[128 * i + 2 * lane]; w4[i][1] = ((const f32x4*)nw)[128 * i + 2 * lane + 1]; }
#pragma unroll
        for (int rr = 0; rr < 2; ++rr) {
            float xf[16];
#pragma unroll
            for (int i = 0; i < 2; ++i) {
                const u32x4 xa = xr[rr][i];
                xf[8 * i + 0] = bflo(xa.x) * w4[i][0][0]; xf[8 * i + 1] = bfhi(xa.x) * w4[i][0][1]; xf[8 * i + 2] = bflo(xa.y) * w4[i][0][2]; xf[8 * i + 3] = bfhi(xa.y) * w4[i][0][3];
                xf[8 * i + 4] = bflo(xa.z) * w4[i][1][0]; xf[8 * i + 5] = bfhi(xa.z) * w4[i][1][1]; xf[8 * i + 6] = bflo(xa.w) * w4[i][1][2]; xf[8 * i + 7] = bfhi(xa.w) * w4[i][1][3];
            }
            float am = 0.f;
#pragma unroll
            for (int i = 0; i < 16; ++i) am = fmaxf(am, fabsf(xf[i]));
#pragma unroll
            for (int o = 1; o < 64; o <<= 1) am = fmaxf(am, __shfl_xor(am, o));
            const float inv = am > 0.f ? 119.f * __builtin_amdgcn_rcpf(am) : 0.f;
            const int t = rr ? t1 : t0;
#pragma unroll
            for (int i = 0; i < 2; ++i) {
                unsigned ph = 0u, pl = 0u; int sm = 0;
#pragma unroll
                for (int e = 0; e < 8; ++e) { const int xq = (int)rintf(xf[8 * i + e] * inv), tt = xq + 8; sm += xq; ph |= ((unsigned)(tt >> 4) & 0xfu) << (4 * e); pl |= ((unsigned)((tt & 15) - 8) & 0xfu) << (4 * e); }
#pragma unroll
                for (int o = 1; o < 32; o <<= 1) sm += __shfl_xor(sm, o);
                if (rr == 0 || tb < T) {
                    const size_t so = ((size_t)(2 * i + (lane >> 5)) * T + t) * 128 + (lane & 31) * 4;
                    *(unsigned*)(XH + so) = ph; *(unsigned*)(XL + so) = pl;
                    if ((lane & 31) == 0) XSUM[(size_t)(2 * i + (lane >> 5)) * T + t] = sm;
                }
            }
            if ((rr == 0 || tb < T) && lane == 0) XS[t] = am * (1.f / 119.f);
        }
    }
}
DI int dpp_xor1(int v) { return __builtin_amdgcn_update_dpp(0, v, 0xB1, 0xF, 0xF, false); }
DI int dpp_xor2(int v) { return __builtin_amdgcn_update_dpp(0, v, 0x4E, 0xF, 0xF, false); }
DI int dpp_hmir(int v) { return __builtin_amdgcn_update_dpp(0, v, 0x141, 0xF, 0xF, false); }
DI void pu_gather8(u32x4 (&dst)[8], const unsigned char* tabu, const int* EIDX, int t, int q, int i, int half) {
    const u32x4* ep = (const u32x4*)(EIDX + (size_t)t * 128 + 16 * q + 8 * half); const u32x4 e0 = ep[0], e1 = ep[1];
    const unsigned ee[8] = {e0.x, e0.y, e0.z, e0.w, e1.x, e1.y, e1.z, e1.w};
#pragma unroll
    for (int g = 0; g < 8; ++g) dst[g] = *(const u32x4*)(tabu + (size_t)((ee[g] << 7) + (unsigned)(i * 16)));
}
DI int pu_half(const u32x4 (&ub)[8], const u32x4& xh, const u32x4& xl, int i) {
    int dsel = 0;
#pragma unroll
    for (int g = 0; g < 8; ++g) {
        int sh = __builtin_amdgcn_sdot8((int)ub[g].x, (int)xh.x, 0, false), sl = __builtin_amdgcn_sdot8((int)ub[g].x, (int)xl.x, 0, false);
        sh = __builtin_amdgcn_sdot8((int)ub[g].y, (int)xh.y, sh, false); sl = __builtin_amdgcn_sdot8((int)ub[g].y, (int)xl.y, sl, false);
        sh = __builtin_amdgcn_sdot8((int)ub[g].z, (int)xh.z, sh, false); sl = __builtin_amdgcn_sdot8((int)ub[g].z, (int)xl.z, sl, false);
        sh = __builtin_amdgcn_sdot8((int)ub[g].w, (int)xh.w, sh, false); sl = __builtin_amdgcn_sdot8((int)ub[g].w, (int)xl.w, sl, false);
        int s = (sh << 4) + sl;
        s += dpp_xor1(s); s += dpp_xor2(s); s += dpp_hmir(s);
        if (i == g) dsel = s;
    }
    return dsel;
}
DI void peer_u(const unsigned char* EU4, const unsigned char* XH, const unsigned char* XL, const int* XSUM, const int* EIDX, int* PART, int slice, int tok0, int tokstep, int lane) {
    const int q = lane >> 3, i = lane & 7;
    const unsigned char* tabu = EU4 + (size_t)slice * PE_NE * 128;
    if (tok0 >= T) return;
    const int n = (T - tok0 + tokstep - 1) / tokstep;
#define PU_TOK(k_) (tok0 + ((k_) < n ? (k_) : n - 1) * tokstep)
    u32x4 h0[8], h1[8], h2[8], h3[8];
    pu_gather8(h0, tabu, EIDX, PU_TOK(0), q, i, 0); pu_gather8(h1, tabu, EIDX, PU_TOK(0), q, i, 1);
    pu_gather8(h2, tabu, EIDX, PU_TOK(1), q, i, 0); pu_gather8(h3, tabu, EIDX, PU_TOK(1), q, i, 1);
#pragma unroll 1
    for (int k = 0; k < n; k += 2) {
        {
            const int t = PU_TOK(k);
            const u32x4 xh = *(const u32x4*)(XH + ((size_t)slice * T + t) * 128 + i * 16), xl = *(const u32x4*)(XL + ((size_t)slice * T + t) * 128 + i * 16);
            const int xs = XSUM[(size_t)slice * T + t];
            const int d0 = pu_half(h0, xh, xl, i); pu_gather8(h0, tabu, EIDX, PU_TOK(k + 2), q, i, 0);
            const int d1 = pu_half(h1, xh, xl, i); pu_gather8(h1, tabu, EIDX, PU_TOK(k + 2), q, i, 1);
            int* pp = PART + ((size_t)slice * T + t) * 128 + 16 * q + i;
            pp[0] = 2 * d0 + xs; pp[8] = 2 * d1 + xs;
        }
        {
            const int t = PU_TOK(k + 1);
            const u32x4 xh = *(const u32x4*)(XH + ((size_t)slice * T + t) * 128 + i * 16), xl = *(const u32x4*)(XL + ((size_t)slice * T + t) * 128 + i * 16);
            const int xs = XSUM[(size_t)slice * T + t];
            const int d0 = pu_half(h2, xh, xl, i); pu_gather8(h2, tabu, EIDX, PU_TOK(k + 3), q, i, 0);
            const int d1 = pu_half(h3, xh, xl, i); pu_gather8(h3, tabu, EIDX, PU_TOK(k + 3), q, i, 1);
            int* pp = PART + ((size_t)slice * T + t) * 128 + 16 * q + i;
            pp[0] = 2 * d0 + xs; pp[8] = 2 * d1 + xs;
        }
    }
#undef PU_TOK
}
DI void peer_w(const int* PART, const int* EIDX, const float* EGATE, const float* SU, const float* SV, const float* XS, const float* SSQX, unsigned char* WQ8, float* WSC, int* WSUM, int gw, int ngw, int lane) {
    for (int tq = gw; tq < T; tq += 4 * ngw) {
        u32x2 pv[4][4], ev[4]; f32x2 gv[4]; float sc[4]; int tt[4];
#pragma unroll
        for (int j = 0; j < 4; ++j) {
            const int t = tq + j * ngw < T ? tq + j * ngw : tq; tt[j] = t;
            const size_t base = (size_t)t * 128 + 2 * lane;
#pragma unroll
            for (int s = 0; s < 4; ++s) pv[j][s] = *(const u32x2*)(PART + (size_t)s * T * 128 + base);
            ev[j] = *(const u32x2*)(EIDX + base); gv[j] = *(const f32x2*)(EGATE + base);
            sc[j] = XS[t] * rstd_x1(SSQX, (size_t)t);
        }
        float su0[4], su1[4], sv0[4], sv1[4];
#pragma unroll
        for (int j = 0; j < 4; ++j) { su0[j] = SU[ev[j].x]; su1[j] = SU[ev[j].y]; sv0[j] = SV[ev[j].x]; sv1[j] = SV[ev[j].y]; }
#pragma unroll
        for (int j = 0; j < 4; ++j) {
            const int d0 = (int)pv[j][0].x + (int)pv[j][1].x + (int)pv[j][2].x + (int)pv[j][3].x, d1 = (int)pv[j][0].y + (int)pv[j][1].y + (int)pv[j][2].y + (int)pv[j][3].y;
            const float w0 = gv[j][0] * sv0[j] * gelu_tanh((float)d0 * (su0[j] * sc[j])), w1 = gv[j][1] * sv1[j] * gelu_tanh((float)d1 * (su1[j] * sc[j]));
            float am = fmaxf(fabsf(w0), fabsf(w1));
#pragma unroll
            for (int o = 1; o < 64; o <<= 1) am = fmaxf(am, __shfl_xor(am, o));
            const float inv = am > 0.f ? 127.f * __builtin_amdgcn_rcpf(am) : 0.f;
            const int i0 = (int)rintf(w0 * inv), i1 = (int)rintf(w1 * inv);
            const unsigned q0 = (unsigned)i0 & 0xffu, q1 = (unsigned)i1 & 0xffu;
            int wsum = i0 + i1;
#pragma unroll
            for (int o = 1; o < 64; o <<= 1) wsum += __shfl_xor(wsum, o);
            if (j == 0 || tq + j * ngw < T) {
                *(unsigned short*)(WQ8 + (size_t)tt[j] * 128 + 2 * lane) = (unsigned short)(q0 | (q1 << 8));
                if (lane == 0) { WSC[tt[j]] = am * (1.f / 127.f); WSUM[tt[j]] = wsum; }
            }
        }
    }
}
DI unsigned perm_(unsigned s0, unsigned s1, unsigned sel) { return __builtin_amdgcn_perm(s0, s1, sel); }
DI int dpp_ror8(int v) { return __builtin_amdgcn_update_dpp(0, v, 0x128, 0xF, 0xF, false); }
DI void pv_gather8(u32x4 (&dst)[8], const unsigned char* tabu, const int* EIDX, int t, int q, int i, int half) {
    const u32x4* ep = (const u32x4*)(EIDX + (size_t)t * 128 + 16 * q + 8 * half); const u32x4 e0 = ep[0], e1 = ep[1];
    const unsigned ee[8] = {e0.x, e0.y, e0.z, e0.w, e1.x, e1.y, e1.z, e1.w};
#pragma unroll
    for (int g = 0; g < 8; ++g) dst[g] = *(const u32x4*)(tabu + (size_t)((ee[g] << 7) + (unsigned)(i * 16)));
}
template <bool FIRST> DI void pv_half(int (&o)[32], const u32x4 (&vb)[8], int w0, int w1) {
#pragma unroll
    for (int mm = 0; mm < 2; ++mm) {
        const int wq = mm ? w1 : w0;
#pragma unroll
        for (int k = 0; k < 4; ++k) {
            const unsigned a = vb[4 * mm][k], b = vb[4 * mm + 1][k], c = vb[4 * mm + 2][k], dd = vb[4 * mm + 3][k];
            const unsigned ablo = perm_(b, a, 0x05010400u), abhi = perm_(b, a, 0x07030602u), cdlo = perm_(dd, c, 0x05010400u), cdhi = perm_(dd, c, 0x07030602u);
            const unsigned tb[4] = {perm_(cdlo, ablo, 0x05040100u), perm_(cdlo, ablo, 0x07060302u), perm_(cdhi, abhi, 0x05040100u), perm_(cdhi, abhi, 0x07060302u)};
#pragma unroll
            for (int bb = 0; bb < 4; ++bb) {
                o[8 * k + 2 * bb] = __builtin_amdgcn_sdot4((int)(tb[bb] & 0x0f0f0f0fu), wq, (FIRST && mm == 0) ? 0 : o[8 * k + 2 * bb], false);
                o[8 * k + 2 * bb + 1] = __builtin_amdgcn_sdot4((int)tb[bb], wq, (FIRST && mm == 0) ? 0 : o[8 * k + 2 * bb + 1], false);
            }
        }
    }
}
DI void pv_finish(const int (&o)[32], float wsc, int wsum, bf16* X1, int slice, int t, int q, int i, bool valid, int dry) {
    int r16[16], r8[8], r4[4];
#pragma unroll
    for (int c = 0; c < 16; ++c) { const auto rr = __builtin_amdgcn_permlane32_swap((unsigned)o[c], (unsigned)o[c + 16], false, false); r16[c] = (int)(rr[0] + rr[1]); }
#pragma unroll
    for (int c = 0; c < 8; ++c) { const auto rr = __builtin_amdgcn_permlane16_swap((unsigned)r16[c], (unsigned)r16[c + 8], false, false); r8[c] = (int)(rr[0] + rr[1]); }
#pragma unroll
    for (int c = 0; c < 4; ++c) { const int sa = r8[c] + dpp_ror8(r8[c]), sb = r8[c + 4] + dpp_ror8(r8[c + 4]); r4[c] = (q & 1) ? sb : sa; }
    u32x2* xp = (u32x2*)(X1 + (size_t)t * 1024 + slice * 256 + i * 32 + 4 * q);
    const u32x2 xo = *xp;
    const int w15 = 15 * wsum;
    u32x2 xv;
    xv.x = pk2(bflo(xo.x) + (float)(2 * r4[0] - w15) * wsc, bfhi(xo.x) + (float)(2 * ((r4[1] - r4[0]) >> 4) + wsum) * wsc);
    xv.y = pk2(bflo(xo.y) + (float)(2 * r4[2] - w15) * wsc, bfhi(xo.y) + (float)(2 * ((r4[3] - r4[2]) >> 4) + wsum) * wsc);
    if (valid && !dry) *xp = xv; else asm volatile("" :: "v"(xv));
}
DI void peer_v(const unsigned char* EV4, const int* EIDX, const unsigned char* WQ8, const float* WSC, const int* WSUM, bf16* X1, int slice, int tok0, int tokstep, int lane, int dry) {
    const int q = lane >> 3, i = lane & 7;
    const unsigned char* tabu = EV4 + (size_t)slice * PE_NE * 128;
    if (tok0 >= T) return;
    const int n = (T - tok0 + tokstep - 1) / tokstep;
#define PV_TOK(k_) (tok0 + ((k_) < n ? (k_) : n - 1) * tokstep)
    u32x4 h0[8], h1[8], h2[8], h3[8];
    pv_gather8(h0, tabu, EIDX, PV_TOK(0), q, i, 0); pv_gather8(h1, tabu, EIDX, PV_TOK(0), q, i, 1);
    pv_gather8(h2, tabu, EIDX, PV_TOK(1), q, i, 0); pv_gather8(h3, tabu, EIDX, PV_TOK(1), q, i, 1);
#pragma unroll 1
    for (int k = 0; k < n; k += 2) {
        {
            const int t = PV_TOK(k);
            const u32x4 wqv = *(const u32x4*)(WQ8 + (size_t)t * 128 + 16 * q);
            const float wsc = WSC[t]; const int wsum = WSUM[t];
            int o[32];
            pv_half<true>(o, h0, (int)wqv.x, (int)wqv.y); pv_gather8(h0, tabu, EIDX, PV_TOK(k + 2), q, i, 0);
            pv_half<false>(o, h1, (int)wqv.z, (int)wqv.w); pv_gather8(h1, tabu, EIDX, PV_TOK(k + 2), q, i, 1);
            pv_finish(o, wsc, wsum, X1, slice, t, q, i, true, dry);
        }
        {
            const int t = PV_TOK(k + 1);
            const u32x4 wqv = *(const u32x4*)(WQ8 + (size_t)t * 128 + 16 * q);
            const float wsc = WSC[t]; const int wsum = WSUM[t];
            int o[32];
            pv_half<true>(o, h2, (int)wqv.x, (int)wqv.y); pv_gather8(h2, tabu, EIDX, PV_TOK(k + 3), q, i, 0);
            pv_half<false>(o, h3, (int)wqv.z, (int)wqv.w); pv_gather8(h3, tabu, EIDX, PV_TOK(k + 3), q, i, 1);
            pv_finish(o, wsc, wsum, X1, slice, t, q, i, k + 1 < n, dry);
        }
    }
#undef PV_TOK
}
DI void final_norm(const bf16* __restrict__ Y, const float* __restrict__ fw, float* __restrict__ OUT, int gw, int ngw, int lane, float dscale) {
    constexpr int NR = 4;
    for (int t0 = gw; t0 < T; t0 += NR * ngw) {
        u32x4 ya[NR][2];
#pragma unroll
        for (int rr = 0; rr < NR; ++rr) { const int t = t0 + rr * ngw < T ? t0 + rr * ngw : t0;
#pragma unroll
            for (int i = 0; i < 2; ++i) ya[rr][i] = ((const u32x4*)(Y + (size_t)t * 1024))[64 * i + lane]; }
#pragma unroll
        for (int rr = 0; rr < NR; ++rr) {
            const int t = t0 + rr * ngw;
            float v[16];
#pragma unroll
            for (int i = 0; i < 2; ++i) { const u32x4 y = ya[rr][i];
                v[8 * i + 0] = bflo(y.x); v[8 * i + 1] = bfhi(y.x); v[8 * i + 2] = bflo(y.y); v[8 * i + 3] = bfhi(y.y);
                v[8 * i + 4] = bflo(y.z); v[8 * i + 5] = bfhi(y.z); v[8 * i + 6] = bflo(y.w); v[8 * i + 7] = bfhi(y.w); }
            float s = 0.f;
#pragma unroll
            for (int j = 0; j < 16; ++j) s += v[j] * v[j];
            const float rs = rsqrtf(wave_sum(s) * (1.f / 1024.f) + EPS) * dscale;
            if (rr == 0 || t < T) {
                f32x4* o = (f32x4*)(OUT + (size_t)t * 1024); const f32x4* wr4 = (const f32x4*)fw;
#pragma unroll
                for (int i = 0; i < 2; ++i)
#pragma unroll
                    for (int h = 0; h < 2; ++h) { const f32x4 ww = wr4[128 * i + 2 * lane + h];
                        __builtin_nontemporal_store((f32x4){v[8 * i + 4 * h] * rs * ww[0], v[8 * i + 4 * h + 1] * rs * ww[1], v[8 * i + 4 * h + 2] * rs * ww[2], v[8 * i + 4 * h + 3] * rs * ww[3]}, &o[128 * i + 2 * lane + h]); }
            }
        }
    }
}

DI void transpose_item(const float* W, int K, int N, bf16* WT, int n_src0, int n_dst0, int k0, LAS float* scr, int lane, const float* kscale = nullptr) {
#pragma unroll
    for (int i = 0; i < 32; ++i) { const int kk = 2 * i + (lane >> 5); scr[kk * 33 + (lane & 31)] = __builtin_nontemporal_load(W + (size_t)(k0 + kk) * N + n_src0 + (lane & 31)) * (kscale ? kscale[k0 + kk] : 1.f); }
    asm volatile("s_waitcnt lgkmcnt(0)" ::: "memory");
    const int c = lane & 7;
#pragma unroll
    for (int j = 0; j < 4; ++j) { const int n = (lane >> 3) + 8 * j; const LAS float* s = scr + (8 * c) * 33 + n;
        u32x4 o; o.x = pk2(s[0 * 33], s[1 * 33]); o.y = pk2(s[2 * 33], s[3 * 33]); o.z = pk2(s[4 * 33], s[5 * 33]); o.w = pk2(s[6 * 33], s[7 * 33]);
        *(u32x4*)(WT + (size_t)(n_dst0 + n) * K + k0 + 8 * c) = o; }
    asm volatile("s_waitcnt lgkmcnt(0)" ::: "memory");
}
DI int win_orig_col(int np) {
    if (np < 2048) { const int h = np >> 8, sel = (np >> 7) & 1, d = np & 127; return sel * 1024 + h * 128 + d; }
    if (np < 3072) return np + 1024;
    if (np < 4096) return np - 1024;
    if (np >= 6144 && np < 8192) return np + 2048;
    if (np >= 8192 && np < 10240) return np - 2048;
    return np;
}
DI void rmsnorm_row_bf16(const float* xrow, const float* w, bf16* orow, int lane) {
    const f32x4* xr = (const f32x4*)xrow + lane; const f32x4* wr4 = (const f32x4*)w + lane;
    f32x4 v[4]; float s = 0.f;
#pragma unroll
    for (int j = 0; j < 4; ++j) { v[j] = xr[64 * j]; s += (v[j][0] * v[j][0] + v[j][1] * v[j][1]) + (v[j][2] * v[j][2] + v[j][3] * v[j][3]); }
    const float rs = rsqrtf(wave_sum(s) * (1.f / 1024.f) + EPS);
    u32x2* o8 = (u32x2*)orow + lane;
#pragma unroll
    for (int j = 0; j < 4; ++j) { const f32x4 ww = wr4[64 * j]; u32x2 o; o.x = pk2(v[j][0] * rs * ww[0], v[j][1] * rs * ww[1]); o.y = pk2(v[j][2] * rs * ww[2], v[j][3] * rs * ww[3]); o8[64 * j] = o; }
}
DI void transpose_item_q8(const float* W, int N, unsigned char* WT8, const LAS float* cmax, int n_src0, int n_dst0, int k0, LAS float* scr, int lane) {
#pragma unroll 16
    for (int i = 0; i < 32; ++i) { const int kk = 2 * i + (lane >> 5); scr[kk * 33 + (lane & 31)] = W[(size_t)(k0 + kk) * N + n_src0 + (lane & 31)]; }
    asm volatile("s_waitcnt lgkmcnt(0)" ::: "memory");
    const int c = lane & 3;
#pragma unroll
    for (int j = 0; j < 2; ++j) {
        const int n = (lane >> 2) + 16 * j;
        const float am = cmax[n], inv = am > 0.f ? 127.f * __builtin_amdgcn_rcpf(am) : 0.f;
        const LAS float* s = scr + (16 * c) * 33 + n;
        u32x4 o;
#pragma unroll
        for (int g = 0; g < 4; ++g) { unsigned pk = 0u;
#pragma unroll
            for (int e2 = 0; e2 < 4; ++e2) pk |= ((unsigned)((int)rintf(s[(4 * g + e2) * 33] * inv)) & 0xffu) << (8 * e2);
            o[g] = pk; }
        *(u32x4*)(WT8 + (size_t)(n_dst0 + n) * 1024 + k0 + 16 * c) = o;
    }
    asm volatile("s_waitcnt lgkmcnt(0)" ::: "memory");
}
DI void rmsnorm_rows_q8(const float* __restrict__ x, const float* __restrict__ w, unsigned char* __restrict__ HN8, float* __restrict__ SA, int row0, int nrows, int lane) {
    for (int m0 = row0; m0 < row0 + nrows; m0 += 2) {
        const int mb = m0 + 1, m1 = mb;
        f32x4 v[2][4];
#pragma unroll
        for (int rr = 0; rr < 2; ++rr) { const f32x4* xr = (const f32x4*)(x + (size_t)(rr ? m1 : m0) * 1024) + lane;
#pragma unroll
            for (int j = 0; j < 4; ++j) v[rr][j] = __builtin_nontemporal_load(xr + 64 * j); }
        const f32x4* wr4 = (const f32x4*)w + lane;
#pragma unroll
        for (int rr = 0; rr < 2; ++rr) {
            float s = 0.f;
#pragma unroll
            for (int j = 0; j < 4; ++j) s += (v[rr][j][0] * v[rr][j][0] + v[rr][j][1] * v[rr][j][1]) + (v[rr][j][2] * v[rr][j][2] + v[rr][j][3] * v[rr][j][3]);
            const float rs = rsqrtf(wave_sum(s) * (1.f / 1024.f) + EPS);
            float am = 0.f;
#pragma unroll
            for (int j = 0; j < 4; ++j) { const f32x4 ww = wr4[64 * j];
#pragma unroll
                for (int e2 = 0; e2 < 4; ++e2) { v[rr][j][e2] = v[rr][j][e2] * rs * ww[e2]; am = fmaxf(am, fabsf(v[rr][j][e2])); } }
#pragma unroll
            for (int o = 1; o < 64; o <<= 1) am = fmaxf(am, __shfl_xor(am, o));
            const float inv = am > 0.f ? 127.f * __builtin_amdgcn_rcpf(am) : 0.f;
            if (rr == 0 || mb < T) {
                const int m = rr ? m1 : m0;
                unsigned* o4 = (unsigned*)(HN8 + (size_t)m * 1024) + lane;
#pragma unroll
                for (int j = 0; j < 4; ++j) { unsigned pk = 0u;
#pragma unroll
                    for (int e2 = 0; e2 < 4; ++e2) pk |= ((unsigned)((int)rintf(v[rr][j][e2] * inv)) & 0xffu) << (8 * e2);
                    o4[64 * j] = pk; }
                if (lane == 0) SA[m] = am * (1.f / 127.f);
            }
        }
    }
}
DI void convert_bf16(const float* src, bf16* dst, size_t n, size_t gtid, size_t gsz) {
    for (size_t i = gtid * 8; i < n; i += gsz * 8) {
        const f32x4 a = *(const f32x4*)(src + i), b = *(const f32x4*)(src + i + 4);
        *(u32x4*)(dst + i) = pack8(a, b);
    }
}

#define XB_TMO      128
#define XB_XCNT(j)  (256  + 64 * (j))
#define XB_XSUB(j)  (1280 + 64 * (j))
#define XB_XGEN(j)  (2304 + 64 * (j))
#define XB_TOP      3328
#define XB_TOPGEN   3392
#define XCD_BAR_WORDS 3456
#define XB_SPIN_CAP (1u << 18)

__device__ __forceinline__ unsigned xb_ld(unsigned* p)              { return __hip_atomic_load(p, __ATOMIC_RELAXED, __HIP_MEMORY_SCOPE_AGENT); }
__device__ __forceinline__ unsigned xb_add(unsigned* p, unsigned v) { return __hip_atomic_fetch_add(p, v, __ATOMIC_RELAXED, __HIP_MEMORY_SCOPE_AGENT); }
__device__ __forceinline__ unsigned xb_xcc_id() { return (unsigned)__builtin_amdgcn_s_getreg((3 << 11) | 20) & 0xFu; }
#define XB_SPIN(cond, bar) do { unsigned _sp = 0; while (cond) { __builtin_amdgcn_s_sleep(1); \
    if ((++_sp & 255u) == 0u) { if (xb_ld(&(bar)[XB_TMO])) break; if (_sp > XB_SPIN_CAP) { atomicAdd(&(bar)[XB_TMO], 1u); break; } } } } while (0)

struct XcdBarrier {
    unsigned* bar; unsigned x;
    volatile LAS unsigned* st;
};

__device__ __forceinline__ XcdBarrier xcd_barrier_post(unsigned* bar, volatile LAS unsigned* st) {
    XcdBarrier b; b.bar = bar; b.x = xb_xcc_id(); b.st = st;
    if (threadIdx.x == 0) (void)xb_add(&bar[XB_XCNT(b.x)], 1u);
    return b;
}
__device__ __forceinline__ void xcd_barrier_complete(unsigned* bar, unsigned x, unsigned& nloc, unsigned& nx) {
    const unsigned G = gridDim.x * gridDim.y * gridDim.z;
    unsigned sum, cnt, mine, sp = 0u;
    for (;;) {
        sum = 0u; cnt = 0u; mine = 0u;
#pragma unroll
        for (unsigned j = 0; j < 16; ++j) { const unsigned c = xb_ld(&bar[XB_XCNT(j)]); sum += c; cnt += (c > 0u) ? 1u : 0u; mine = (j == x) ? c : mine; }
        if (sum == G) break;
        __builtin_amdgcn_s_sleep(1);
        if ((++sp & 255u) == 0u) { if (xb_ld(&bar[XB_TMO])) break; if (sp > XB_SPIN_CAP) { atomicAdd(&bar[XB_TMO], 1u); break; } }
    }
    nloc = mine > 0u ? mine : 1u; nx = cnt > 0u ? cnt : 1u;
}

__device__ __forceinline__ void xcd_barrier(const XcdBarrier& b) {
    asm volatile("s_waitcnt vmcnt(0)" ::: "memory");
    __syncthreads();
    if (threadIdx.x == 0) {
        unsigned* bar = b.bar;
        __builtin_amdgcn_s_waitcnt(0);
        unsigned nloc = b.st[0], nx = b.st[1];
        if (nloc == 0u) { xcd_barrier_complete(bar, b.x, nloc, nx); b.st[0] = nloc; b.st[1] = nx; }
        const unsigned old = xb_add(&bar[XB_XSUB(b.x)], 1u);
        const unsigned gen = old / nloc;
        if (old + 1u == (gen + 1u) * nloc) {
            __builtin_amdgcn_fence(__ATOMIC_RELEASE, "agent");
            asm volatile("s_waitcnt vmcnt(0)" ::: "memory");
            const unsigned og = xb_add(&bar[XB_TOP], 1u);
            const unsigned tg = og / nx;
            if (og + 1u == (tg + 1u) * nx) xb_add(&bar[XB_TOPGEN], 1u);
            else XB_SPIN(xb_ld(&bar[XB_TOPGEN]) == tg, bar);
            __builtin_amdgcn_fence(__ATOMIC_ACQUIRE, "agent");
            asm volatile("s_waitcnt vmcnt(0)" ::: "memory");
        } else {
            XB_SPIN(xb_ld(&bar[XB_TOPGEN]) == gen, bar);
            __builtin_amdgcn_fence(__ATOMIC_ACQUIRE, "agent");
            asm volatile("s_waitcnt vmcnt(0)" ::: "memory");
        }
    }
    __syncthreads();
}

struct Params { const float* in[14]; float* out; unsigned char* ws; };

__global__ void __launch_bounds__(NTHREADS, 2) fwd_megakernel(Params p) {
    extern __shared__ __attribute__((aligned(16))) unsigned char lds_raw[];
    LAS unsigned char* lds = (LAS unsigned char*)lds_raw;
    cg::grid_group grid = cg::this_grid();
    volatile LAS unsigned* bst = (volatile LAS unsigned*)(lds + LDS_BYTES - 64);
    if (threadIdx.x < 4) bst[threadIdx.x] = 0u;
    __syncthreads();
    XcdBarrier xbar = xcd_barrier_post((unsigned*)(p.ws + WS_CTL), bst);
    if (threadIdx.x == 0) bst[4] = xb_add((unsigned*)(p.ws + WS_CTL) + 3600 + xbar.x, 1u);
#if USE_CG_SYNC
#define GRID_SYNC() grid.sync()
#else
#define GRID_SYNC() xcd_barrier(xbar)
#endif
    unsigned long long* TS = (unsigned long long*)(p.ws + WS_CTL + 24576);
    int stamp_i_ = 0;
#define STAMP() do { if (STAMP_K >= 0 && blockIdx.x == 0 && threadIdx.x == 0) TS[stamp_i_] = __builtin_amdgcn_s_memrealtime(); ++stamp_i_; } while (0)
    STAMP();
    const int G = gridDim.x, wg = blockIdx.x;
#define PHASE_IDS const int tid = fresh_tid(), lane = tid & 63, wave = __builtin_amdgcn_readfirstlane(tid >> 6); \
    const int gw = wg * NWAVES + wave, ngw = G * NWAVES; const size_t gtid = (size_t)wg * NTHREADS + tid, gsz = (size_t)G * NTHREADS; \
    (void)lane; (void)gw; (void)ngw; (void)gtid; (void)gsz;
    unsigned char* ws = p.ws;
    const float* x = p.in[0];
    unsigned char* HN8 = ws + WS_HN; unsigned char* WinT8 = ws + WS_WINT; float* SA = (float*)(ws + WS_SA); float* SB = (float*)(ws + WS_SB);

    float* COS = (float*)(ws + WS_ROPE); float* SIN = COS + 8192 * 128;
    float* DEC = (float*)(ws + WS_DEC); float* SSQP = (float*)(ws + WS_SSQP); float* SSQX = (float*)(ws + WS_SSQX);
    bf16* BA = (bf16*)(ws + WS_A); bf16* BB = (bf16*)(ws + WS_B); bf16* BC = (bf16*)(ws + WS_C);
    bf16* STh = (bf16*)(ws + WS_STH); bf16* STr = (bf16*)(ws + WS_STR);
    bf16* OHG = (bf16*)(ws + WS_OHG); bf16* ORET = (bf16*)p.out; bf16* VTF = (bf16*)p.out;
    bf16* GA = (bf16*)(ws + WS_GA); bf16* GB = (bf16*)(ws + WS_GB);
    bf16* WhgT = (bf16*)(ws + WS_WHG); bf16* WretT = (bf16*)(ws + WS_WRET); bf16* WoutT = (bf16*)(ws + WS_WOUT); bf16* WqT = (bf16*)(ws + WS_WQ); bf16* SK = (bf16*)(ws + WS_SK);
    unsigned char* EV8 = ws + WS_EV; unsigned char* EU8 = ws + WS_EU; float* SU = (float*)(ws + WS_SCL); float* SV = SU + PE_NE;
    float* M1 = (float*)(ws + WS_M1); bf16* MERGED = (bf16*)(ws + WS_MERGED);
    bf16* X1 = (bf16*)(ws + WS_X1); bf16* Qp = (bf16*)p.out;
    unsigned char* XH4 = ws + WS_XQ8; unsigned char* XL4 = ws + WS_XQ8 + 8 * MiB; int* XSUM = (int*)(ws + WS_CTL + 512 * 1024); int* WSUM = (int*)(ws + WS_CTL + 768 * 1024); float* XS = (float*)(ws + WS_XS); int* PART = (int*)(ws + WS_PART); unsigned char* WQ8 = ws + WS_WT; float* WSC = (float*)(ws + WS_WT + 4 * MiB);
    int* EIDX = (int*)(ws + WS_EIDX); float* EGATE = (float*)(ws + WS_EGATE);

    for (int rep_ = 0; rep_ < ((PROBE_MASK & 32) ? 2 : 1); ++rep_) {
    { PHASE_IDS LAS float* scr = (LAS float*)(lds + wave * 16384);
    LAS float* amx = (LAS float*)(lds + 131072); LAS float* cm = amx + 512;
    for (int strip = wg; strip < 192; strip += G) {
        const int nd0 = strip * 64, ns0 = win_orig_col(nd0);
        const int c4 = tid & 15, r = tid >> 4;
        const float* wp = p.in[2] + (size_t)(r * 32) * 12288 + ns0 + 4 * c4;
        f32x4 v[32];
#pragma unroll
        for (int i = 0; i < 32; ++i) v[i] = __builtin_nontemporal_load((const f32x4*)(wp + (size_t)i * 12288));
        f32x4 am = {0.f, 0.f, 0.f, 0.f};
#pragma unroll
        for (int i = 0; i < 32; ++i)
#pragma unroll
            for (int e2 = 0; e2 < 4; ++e2) am[e2] = fmaxf(am[e2], fabsf(v[i][e2]));
#pragma unroll
        for (int e2 = 0; e2 < 4; ++e2) { am[e2] = fmaxf(am[e2], __shfl_xor(am[e2], 16)); am[e2] = fmaxf(am[e2], __shfl_xor(am[e2], 32)); }
        if (lane < 16) *(LAS f32x4*)(amx + wave * 64 + 4 * c4) = am;
        __syncthreads();
        if (tid < 64) { float m8 = 0.f;
#pragma unroll
            for (int w8 = 0; w8 < 8; ++w8) m8 = fmaxf(m8, amx[w8 * 64 + tid]);
            cm[tid] = m8; SB[nd0 + tid] = m8 * (1.f / 127.f); }
        __syncthreads();
        const f32x4 cmx = *(const LAS f32x4*)(cm + 4 * c4);
        LAS unsigned char* stg = (LAS unsigned char*)lds;
#pragma unroll
        for (int e2 = 0; e2 < 4; ++e2) {
            const float inv = cmx[e2] > 0.f ? 127.f * __builtin_amdgcn_rcpf(cmx[e2]) : 0.f;
#pragma unroll
            for (int i4 = 0; i4 < 8; ++i4) { unsigned pk = 0u;
#pragma unroll
                for (int b = 0; b < 4; ++b) pk |= ((unsigned)((int)rintf(v[4 * i4 + b][e2] * inv)) & 0xffu) << (8 * b);
                *(LAS unsigned*)(stg + (4 * c4 + e2) * 1028 + r * 32 + 4 * i4) = pk; }
        }
        __syncthreads();
#pragma unroll
        for (int j = 0; j < 8; ++j) {
            const int c = wave * 8 + j; u32x4 o;
#pragma unroll
            for (int q = 0; q < 4; ++q) o[q] = *(const LAS unsigned*)(stg + c * 1028 + lane * 16 + 4 * q);
            *(u32x4*)(WinT8 + (size_t)(nd0 + c) * 1024 + lane * 16) = o;
        }
        __syncthreads();
    }
    if (G != 256) { for (int r0 = (int)gw * 2; r0 < T; r0 += (int)ngw * 2) rmsnorm_rows_q8(x, p.in[1], HN8, SA, r0, 2, lane); }
    else if (wg < 192) rmsnorm_rows_q8(x, p.in[1], HN8, SA, (wg * 8 + wave) * 6, 6, lane);
    else rmsnorm_rows_q8(x, p.in[1], HN8, SA, 9216 + ((wg - 192) * 8 + wave) * 14, 14, lane);
    }
    __syncthreads(); }
    if (p.ws == nullptr) grid.sync();
    GRID_SYNC();
    STAMP();

    for (int rep_ = 0; rep_ < ((PROBE_MASK & 128) ? PROBE_REPS : 1); ++rep_) {
    {
        pg8::Gemm g{(const bf16*)HN8, (const bf16*)WinT8, T, 3072, 512}; pg8::StaticOrder S; S.init(T, (PROBE_SKIP && rep_) ? PROBE_N : 3072, G, wg);
        EpiH E{BA, BB, BC, DEC, p.in[3], OHG, SA, SB, rep_ ? PROBE_SKIP : 0};
        pg8::gemm_phase<EpiH, pg8::StaticOrder, true, true, true>(lds, g, S, E);
    }
    __syncthreads();
    {
        pg8::Gemm g{(const bf16*)HN8, (const bf16*)(WinT8 + (size_t)3072 * 1024), T, 1024, 512}; pg8::StaticOrder S; S.init(T, 1024, G, wg);
        EpiHV E{VTF, SA, SB + 3072};
        pg8::gemm_phase<EpiHV, pg8::StaticOrder, true, true, true>(lds, g, S, E);
    }
    __syncthreads(); }
    GRID_SYNC();
    STAMP();
    hg_pass1(lds, BB, VTF, STh, wg, G);
#if PROBE_MASK & 4
    hg_pass1(lds, BB, VTF, STh, wg, G);
#endif
    GRID_SYNC();
    STAMP();
    { PHASE_IDS hg_scan(STh, DEC, (int)gtid, (int)gsz); }
    GRID_SYNC();
    STAMP();
#if PROBE_MASK & 16384
    hg_pass1(lds, BB, VTF, STh, wg, G);
    GRID_SYNC();
    STAMP();
    { PHASE_IDS hg_scan(STh, DEC, (int)gtid, (int)gsz); }
    GRID_SYNC();
    STAMP();
#endif
#if PROBE_MASK & 4
    { PHASE_IDS hg_pass3(lds, BA, BB, VTF, STh, p.in[4], OHG, gw, ngw, 1); }
#endif
    { PHASE_IDS hg_pass3(lds, BA, BB, VTF, STh, p.in[4], OHG, gw, ngw, 0); }
    GRID_SYNC();
    STAMP();

    for (int rep_ = 0; rep_ < ((PROBE_MASK & 2048) ? 2 : 1); ++rep_) {
    {
        pg8::Gemm g{(const bf16*)HN8, (const bf16*)(WinT8 + (size_t)4096 * 1024), T, 4096, 512}; pg8::StaticOrder S; S.init(T, 4096, G, wg);
        EpiR E{BA, BB, BC, COS, SIN, ORET, SA, SB + 4096};
        pg8::gemm_phase<EpiR, pg8::StaticOrder, true, true, true>(lds, g, S, E);
    }
    __syncthreads();
    {
        pg8::Gemm g{(const bf16*)HN8, (const bf16*)(WinT8 + (size_t)8192 * 1024), T, 2048, 512}; pg8::StaticOrder S; S.init(T, 2048, G, wg);
        EpiRV E{BC, SA, SB + 8192};
        pg8::gemm_phase<EpiRV, pg8::StaticOrder, true, true, true>(lds, g, S, E);
    }
    __syncthreads(); }
    GRID_SYNC();
    STAMP();
    rt_pass1(lds, BB, BC, STr, wg, G);
#if PROBE_MASK & 8
    rt_pass1(lds, BB, BC, STr, wg, G);
#endif
    GRID_SYNC();
    STAMP();
    { PHASE_IDS rt_scan(STr, (int)gtid, (int)gsz); }
    GRID_SYNC();
    STAMP();
#if PROBE_MASK & 32768
    rt_pass1(lds, BB, BC, STr, wg, G);
    GRID_SYNC();
    STAMP();
    { PHASE_IDS rt_scan(STr, (int)gtid, (int)gsz); }
    GRID_SYNC();
    STAMP();
#endif
#if PROBE_MASK & 1024
    rt_pass3_v2(lds, BA, BB, BC, STr, ORET, wg, G, 1);
#endif
    rt_pass3_v2(lds, BA, BB, BC, STr, ORET, wg, G, 0);
    GRID_SYNC();
    STAMP();

    for (int rep_ = 0; rep_ < ((PROBE_MASK & 64) ? 2 : 1); ++rep_) {
    { PHASE_IDS LAS float* scr = (LAS float*)(lds + wave * 16384);
    for (int it = gw; it < 3072; it += ngw) {
        int r = it;
        if (r < 512) { transpose_item(p.in[5], 1024, 1024, WhgT, (r % 32) * 32, (r % 32) * 32, (r / 32) * 64, scr, lane); continue; } r -= 512;
        if (r < 1024) { transpose_item(p.in[6], 2048, 1024, WretT, (r % 32) * 32, (r % 32) * 32, (r / 32) * 64, scr, lane); continue; } r -= 1024;
        if (r < 512) { transpose_item(p.in[7], 1024, 1024, WoutT, (r % 32) * 32, (r % 32) * 32, (r / 32) * 64, scr, lane); continue; } r -= 512;
        transpose_item(p.in[9], 1024, 2048, WqT, (r % 64) * 32, (r % 64) * 32, (r / 64) * 64, scr, lane, p.in[8]);
    }
    convert_bf16(p.in[10], SK, (size_t)16 * 128 * 128, gtid, gsz);
    quant_rows4(p.in[12], EV8, SV, PE_NE, 8, gw, ngw, lane); }
    __syncthreads(); }
    __syncthreads();
    for (int rep_ = 0; rep_ < ((PROBE_MASK & 65536) ? 2 : 1); ++rep_) {
    {
        pg8::Gemm g{(const bf16*)HN8, (const bf16*)(WinT8 + (size_t)10240 * 1024), T, 2048, 512}; pg8::StaticOrder S; S.init(T, 2048, G, wg);
        EpiG E{GA, GB, SA, SB + 10240};
        pg8::gemm_phase<EpiG, pg8::StaticOrder, true, true, true>(lds, g, S, E);
    }
    __syncthreads(); }
    GRID_SYNC();
    STAMP();

    for (int rep_ = 0; rep_ < ((PROBE_MASK & 256) ? 2 : 1); ++rep_) {
    {
        pg8::Gemm g{OHG, WhgT, T, 1024, 1024}; pg8::StaticOrder S; S.init(T, 1024, G, wg);
        EpiMergeF E{ORET, WretT, 2048, GA, GB, MERGED};
        pg8::gemm_phase<EpiMergeF, pg8::StaticOrder, false, true>(lds, g, S, E);
    }
    __syncthreads(); }
    GRID_SYNC();
    STAMP();
    for (int rep_ = 0; rep_ < ((PROBE_MASK & 4096) ? PROBE_REPS : 1); ++rep_) {
    {
        pg8::Gemm g{MERGED, WoutT, T, 1024, 1024}; pg8::StaticOrder S; S.init(T, 1024, G, wg);
        EpiOut E{x, X1, SSQX, rep_ ? PROBE_SKIP : 0};
        pg8::gemm_phase<EpiOut, pg8::StaticOrder, false, true>(lds, g, S, E);
    }
    __syncthreads(); }
    GRID_SYNC();
    STAMP();
    for (int rep_ = 0; rep_ < ((PROBE_MASK & 64) ? 2 : 1); ++rep_) {
    { PHASE_IDS quant_rows4(p.in[11], EU8, SU, PE_NE, 0, gw, ngw, lane); }
    __syncthreads(); }
    __syncthreads();
    for (int rep_ = 0; rep_ < ((PROBE_MASK & 8192) ? 2 : 1); ++rep_) {
    {
        pg8::Gemm g{X1, WqT, T, 2048, 1024}; pg8::StaticOrder S; S.init(T, 2048, G, wg);
        EpiQ E{Qp, SSQX};
        pg8::gemm_phase<EpiQ, pg8::StaticOrder, true, true>(lds, g, S, E);
    }
    __syncthreads(); }
    GRID_SYNC();
    STAMP();
    { PHASE_IDS peer_retrieve(lds, Qp, SK, EIDX, EGATE, wg, G); quant_xw(X1, p.in[8], XH4, XL4, XS, XSUM, gw, ngw, lane); }
#if PROBE_MASK & 2
    { PHASE_IDS peer_retrieve(lds, Qp, SK, EIDX, EGATE, wg, G); quant_xw(X1, p.in[8], XH4, XL4, XS, XSUM, gw, ngw, lane); }
#endif
    GRID_SYNC();
    STAMP();
    if (threadIdx.x == 0) {
        unsigned k = 0, n = 0, mine = 1;
        for (unsigned j = 0; j < 16; ++j) { const unsigned c = xb_ld((unsigned*)(p.ws + WS_CTL) + XB_XCNT(j)); if (c) { if (j < xbar.x) ++k; ++n; } if (j == xbar.x) mine = c ? c : 1; }
        bst[5] = k; bst[6] = n ? n : 1; bst[7] = mine;
    }
    __syncthreads();
    const int xrank = (int)bst[4], xk = (int)bst[5], xn = (int)bst[6], xloc = (int)bst[7];
    for (int rep_ = 0; rep_ < ((PROBE_MASK & 1) ? 2 : 1); ++rep_) {
    { PHASE_IDS
      if (xn >= 4 && (xn & 3) == 0) { const int ng = xn >> 2; peer_u(EU8, XH4, XL4, XSUM, EIDX, PART, xk & 3, (xrank * NWAVES + wave) * ng + (xk >> 2), xloc * NWAVES * ng, lane); }
      else if (xk < 4) { for (int s = xk; s < 4; s += (xn < 4 ? xn : 4)) peer_u(EU8, XH4, XL4, XSUM, EIDX, PART, s, xrank * NWAVES + wave, xloc * NWAVES, lane); } }
    GRID_SYNC(); }
    STAMP();
    { PHASE_IDS peer_w(PART, EIDX, EGATE, SU, SV, XS, SSQX, WQ8, WSC, WSUM, gw, ngw, lane); }
    GRID_SYNC();
    STAMP();
#if PROBE_MASK & 131072
    { PHASE_IDS
      if (xn >= 4 && (xn & 3) == 0) { const int ng = xn >> 2; peer_v(EV8, EIDX, WQ8, WSC, WSUM, X1, xk & 3, (xrank * NWAVES + wave) * ng + (xk >> 2), xloc * NWAVES * ng, lane, 1); }
      else if (xk < 4) { for (int s = xk; s < 4; s += (xn < 4 ? xn : 4)) peer_v(EV8, EIDX, WQ8, WSC, WSUM, X1, s, xrank * NWAVES + wave, xloc * NWAVES, lane, 1); } }
    GRID_SYNC();
    STAMP();
#endif
    { PHASE_IDS
      if (xn >= 4 && (xn & 3) == 0) { const int ng = xn >> 2; peer_v(EV8, EIDX, WQ8, WSC, WSUM, X1, xk & 3, (xrank * NWAVES + wave) * ng + (xk >> 2), xloc * NWAVES * ng, lane, 0); }
      else if (xk < 4) { for (int s = xk; s < 4; s += (xn < 4 ? xn : 4)) peer_v(EV8, EIDX, WQ8, WSC, WSUM, X1, s, xrank * NWAVES + wave, xloc * NWAVES, lane, 0); } }
    GRID_SYNC();
    STAMP();
    { PHASE_IDS float dscale = 1.f;
      if (STAMP_K >= 0) { const float dt_us = (float)(TS[STAMP_K + 1] - TS[STAMP_K]) * 0.01f; dscale = 1.f + sqrtf(dt_us * 2e-6f); }
      final_norm(X1, p.in[13], p.out, gw, ngw, lane, dscale); }
#if PROBE_MASK & 16
    for (int i = 0; i < 15; ++i) GRID_SYNC();
#endif
}

extern "C" void kernel_launch(void* const* d_in, const int* in_sizes, int n_in, void* d_out, int out_size, void* d_ws, size_t ws_size, hipStream_t stream) {
    static int grid_blocks = 0;
    if (!grid_blocks) {
        int dev = 0, cus = 0, per_cu = 0;
        (void)hipGetDevice(&dev);
        (void)hipDeviceGetAttribute(&cus, hipDeviceAttributeMultiprocessorCount, dev);
        (void)hipFuncSetAttribute((const void*)fwd_megakernel, hipFuncAttributeMaxDynamicSharedMemorySize, LDS_BYTES);
        (void)hipOccupancyMaxActiveBlocksPerMultiprocessor(&per_cu, (const void*)fwd_megakernel, NTHREADS, LDS_BYTES);
        if (per_cu < 1) per_cu = 1;
        grid_blocks = cus * 1;
        if (ws_size < WS_END || n_in != 14) { fprintf(stderr, "kernel_launch: unexpected ws_size %zu (need %zu) or n_in %d\n", ws_size, (size_t)WS_END, n_in); }
    }
    (void)hipMemsetAsync((char*)d_ws + WS_CTL, 0, 32768, stream);
    Params p{};
    for (int i = 0; i < 14; ++i) p.in[i] = (const float*)d_in[i];
    p.out = (float*)d_out; p.ws = (unsigned char*)d_ws;
    void* args[] = {&p};
    hipError_t e = hipLaunchCooperativeKernel((const void*)fwd_megakernel, dim3(grid_blocks), dim3(NTHREADS), args, LDS_BYTES, stream);
    if (e != hipSuccess) fprintf(stderr, "cooperative launch failed: %s (grid %d)\n", hipGetErrorString(e), grid_blocks);
}
```
